# Optimizing an MI355X kernel written in HIP

```python
import math
import jax, jax.numpy as jnp
from jax import lax
import numpy as np

D_MODEL = 1024
BATCH = 8
SEQ = 2048
DEPTH = 4

GRID_W = 64
CTX_LEN = 256
ROPE_BASE = 10000.0
LN_EPS = 1e-5
DEEPNORM_ALPHA = (2 * DEPTH) ** 0.25
DEEPNORM_BETA = (8 * DEPTH) ** -0.25
N_EVEN = (DEPTH + 1) // 2
N_ODD = DEPTH // 2
H_A = 4
DK_A = D_MODEL // 8
DV_A = D_MODEL // 8
CHUNK_A = 128
RET_EXP_FWD = 5.0
RET_EXP_BWD = 5.5
H_B = 4
DK_B = D_MODEL // 16
DV_B = D_MODEL // 8
GLA_RANK = 16
GLA_TAU = 16.0
CHUNK_B = 64
AB_SPLITS = (H_A * DK_A, H_A * DK_A, H_A * DV_A, H_A * DV_A,
             H_B * DK_B, H_B * DK_B, H_B * DV_B, H_B * DV_B, GLA_RANK, GLA_RANK)
AB_IN = sum(AB_SPLITS)
AB_OUT = H_A * DV_A + H_B * DV_B
H_C = 8
DH_C = D_MODEL // 16
DV_C = 2 * DH_C
Q_BLOCK = 128
C_SPLITS = (H_C * 2 * DH_C, H_C * 2 * DH_C, H_C * DV_C)
C_IN = sum(C_SPLITS)
C_OUT = H_C * DV_C
LAMBDA_STD = 0.1
N_GROUPS = 4
EXPERTS_PER_GROUP = 8
N_EXPERTS = N_GROUPS * EXPERTS_PER_GROUP
TOP_K_EXPERT = 2
D_EXPERT = D_MODEL // 2
MOE_BLOCK = 128

kernel_name = 'hybrid_retention_gla_diffattn_hmoe_dit'


def layer_norm(x, g, b):
    xf = x.astype(jnp.float32)
    mu = jnp.mean(xf, axis=-1, keepdims=True)
    var = jnp.mean(jnp.square(xf - mu), axis=-1, keepdims=True)
    return ((xf - mu) * lax.rsqrt(var + LN_EPS) * g + b).astype(x.dtype)


def head_norm(o, center):
    of = o.astype(jnp.float32)
    if center:
        of = of - jnp.mean(of, axis=-1, keepdims=True)
    return of * lax.rsqrt(jnp.mean(jnp.square(of), axis=-1, keepdims=True) + LN_EPS)


def split_sizes(t, sizes):
    cuts = [int(s) for s in np.cumsum(sizes)[:-1]]
    return jnp.split(t, cuts, axis=-1)


def axial_rope(rows, head_dim):
    row = jnp.repeat(jnp.arange(rows, dtype=jnp.float32), GRID_W)
    col = jnp.tile(jnp.arange(GRID_W, dtype=jnp.float32), rows)
    quarter = head_dim // 4
    inv = ROPE_BASE ** (-jnp.arange(quarter, dtype=jnp.float32) / quarter)
    ang_r = row[:, None] * inv
    ang_c = col[:, None] * inv
    ang = jnp.concatenate([ang_r, ang_r, ang_c, ang_c], axis=-1)
    return jnp.cos(ang), jnp.sin(ang)


def rope(x, cos, sin):
    a, b, c, d = jnp.split(x, 4, axis=-1)
    rot = jnp.concatenate([-b, a, -d, c], axis=-1)
    return (x * cos + rot * sin).astype(x.dtype)


def chunk_scan(q, k, v, log_a, s0, chunk, inclusive):
    bn, h, t, dk = q.shape
    dv = v.shape[-1]
    n = t // chunk

    def to_chunks(z):
        return jnp.moveaxis(z.reshape(bn, h, n, chunk, z.shape[-1]), 2, 0)

    mask = jnp.tril(jnp.ones((chunk, chunk), dtype=bool), 0 if inclusive else -1)

    def step(s, inp):
        qi, ki, vi, li = inp
        b = jnp.cumsum(li, axis=-2)
        bq = b if inclusive else b - li
        btot = b[..., -1:, :]
        qd = qi * jnp.exp(bq)
        kd = ki * jnp.exp(-b)
        att = jnp.where(mask, jnp.einsum('bhid,bhjd->bhij', qd, kd), 0.0)
        o = jnp.einsum('bhij,bhje->bhie', att, vi) + jnp.einsum('bhid,bhde->bhie', qd, s)
        kt = ki * jnp.exp(btot - b)
        s = jnp.exp(btot)[..., 0, :, None] * s + jnp.einsum('bhjd,bhje->bhde', kt, vi)
        return s, o

    s_fin, o = lax.scan(step, s0, (to_chunks(q), to_chunks(k), to_chunks(v), to_chunks(log_a)))
    return jnp.moveaxis(o, 0, 2).reshape(bn, h, t, dv), s_fin


def bidir_scan(q, k, v, la_f, la_b, s0_f, s0_b, chunk):
    q, k, v = (z.astype(jnp.float32) for z in (q, k, v))
    o_f, s_f = chunk_scan(q, k, v, la_f, s0_f, chunk, True)
    flip = lambda z: jnp.flip(z, axis=2)
    o_b, s_b = chunk_scan(flip(q), flip(k), flip(v), flip(la_b), s0_b, chunk, False)
    return o_f + flip(o_b), s_f, s_b


def ret_logdecay(exp0, like):
    gam = jnp.log1p(-jnp.exp2(-(exp0 + jnp.arange(H_A, dtype=jnp.float32))))
    return jnp.broadcast_to(gam[None, :, None, None], like.shape)


def ab_heads(z, w_in, w_lr_f, b_lr_f, w_lr_b, b_lr_b, cs):
    bn, t, _ = z.shape
    qa, ka, va, ga, qb, kb, vb, gb, lr_f, lr_b = split_sizes(z @ w_in, AB_SPLITS)
    qa = qa.reshape(bn, t, H_A, DK_A)
    ka = ka.reshape(bn, t, H_A, DK_A)
    if cs is not None:
        qa = rope(qa, *cs)
        ka = rope(ka, *cs)
    qa = qa * (DK_A ** -0.5)
    va = va.reshape(bn, t, H_A, DV_A)
    qb = qb.reshape(bn, t, H_B, DK_B) * (DK_B ** -0.5)
    kb = kb.reshape(bn, t, H_B, DK_B)
    vb = vb.reshape(bn, t, H_B, DV_B)

    def gla_logdecay(lr, w, b):
        g = (lr @ w + b).astype(jnp.float32)
        return (jax.nn.log_sigmoid(g) / GLA_TAU).reshape(bn, t, H_B, DK_B)

    la_f = gla_logdecay(lr_f, w_lr_f, b_lr_f)
    la_b = gla_logdecay(lr_b, w_lr_b, b_lr_b)
    bhtd = lambda u: jnp.swapaxes(u, 1, 2)
    return (bhtd(qa), bhtd(ka), bhtd(va), ga, bhtd(qb), bhtd(kb), bhtd(vb), gb, bhtd(la_f), bhtd(la_b))


def mixer_ab(ux, uc, w_in, w_lr_f, b_lr_f, w_lr_b, b_lr_b, gn_a, gn_b, w_out, cs, need_ctx):
    fx = ab_heads(ux, w_in, w_lr_f, b_lr_f, w_lr_b, b_lr_b, cs)
    fc = ab_heads(uc, w_in, w_lr_f, b_lr_f, w_lr_b, b_lr_b, None)
    bn = ux.shape[0]
    za = jnp.zeros((bn, H_A, DK_A, DV_A), jnp.float32)
    zb = jnp.zeros((bn, H_B, DK_B, DV_B), jnp.float32)

    def mix(f, st):
        qa, ka, va, ga, qb, kb, vb, gb, laf, lab = f
        oa, saf, sab = bidir_scan(qa, ka, va, ret_logdecay(RET_EXP_FWD, qa),
                                  ret_logdecay(RET_EXP_BWD, qa), st[0], st[1], CHUNK_A)
        ob, sbf, sbb = bidir_scan(qb, kb, vb, laf, lab, st[2], st[3], CHUNK_B)
        return (oa, ga, ob, gb), (saf, sab, sbf, sbb)

    out_c, st_c = mix(fc, (za, za, zb, zb))
    out_x, _ = mix(fx, st_c)

    def merge(oa, ga, ob, gb):
        b_, _, t_, _ = oa.shape
        ya = jnp.swapaxes(head_norm(oa, True), 1, 2).reshape(b_, t_, H_A * DV_A) * gn_a
        yb = jnp.swapaxes(head_norm(ob, False), 1, 2).reshape(b_, t_, H_B * DV_B) * gn_b
        y = jnp.concatenate([jax.nn.silu(ga.astype(jnp.float32)) * ya,
                             jax.nn.silu(gb.astype(jnp.float32)) * yb], axis=-1)
        return y.astype(ux.dtype) @ w_out

    yx = merge(*out_x)
    yc = merge(*out_c) if need_ctx else None
    return yx, yc


def c_heads(z, w_qkv, cs):
    bn, t, _ = z.shape
    q, k, v = split_sizes(z @ w_qkv, C_SPLITS)
    q = q.reshape(bn, t, H_C, 2, DH_C)
    k = k.reshape(bn, t, H_C, 2, DH_C)
    if cs is not None:
        q = rope(q, *cs)
        k = rope(k, *cs)
    return q * (DH_C ** -0.5), k, v.reshape(bn, t, H_C, DV_C)


def diff_attend(q, k, v, lam):
    s = jnp.einsum('bqhcd,bkhcd->bchqk', q, k).astype(jnp.float32)
    p = jax.nn.softmax(s, axis=-1)
    a = p[:, 0] - lam[:, None, None] * p[:, 1]
    return jnp.einsum('bhqk,bkhe->bqhe', a.astype(v.dtype), v)


def mixer_c(ux, uc, w_qkv, lq1, lk1, lq2, lk2, subln_g, w_out, lam_init, cs, need_ctx):
    qx, kx, vx = c_heads(ux, w_qkv, cs)
    qc, kc, vc = c_heads(uc, w_qkv, None)
    lam = (jnp.exp(jnp.sum(lq1 * lk1, axis=-1)) - jnp.exp(jnp.sum(lq2 * lk2, axis=-1))).astype(jnp.float32) + lam_init
    k_all = jnp.concatenate([kc, kx], axis=1)
    v_all = jnp.concatenate([vc, vx], axis=1)
    bn, t = qx.shape[:2]
    qb = jnp.moveaxis(qx.reshape(bn, t // Q_BLOCK, Q_BLOCK, H_C, 2, DH_C), 1, 0)
    ox = lax.map(lambda qi: diff_attend(qi, k_all, v_all, lam), qb)
    ox = jnp.moveaxis(ox, 0, 1).reshape(bn, t, H_C, DV_C)

    def finish(o):
        b_, t_ = o.shape[:2]
        y = head_norm(o, False).reshape(b_, t_, C_OUT) * subln_g * (1.0 - lam_init)
        return y.astype(ux.dtype) @ w_out

    yx = finish(ox)
    yc = finish(diff_attend(qc, kc, vc, lam)) if need_ctx else None
    return yx, yc


def hier_moe(z, w_grp, b_grp, w_rexp, b_rexp, w_gate, w_up, w_down):
    n, d = z.shape
    zf = z.astype(jnp.float32)
    g_logits = zf @ w_grp.astype(jnp.float32) + b_grp
    g_prob = jax.nn.softmax(g_logits, axis=-1)
    grp = jnp.argmax(g_logits, axis=-1).astype(jnp.int32)
    g_oh = jax.nn.one_hot(grp, N_GROUPS, dtype=jnp.float32)
    g_w = jnp.sum(g_prob * g_oh, axis=-1)
    e_logits = (zf @ w_rexp.astype(jnp.float32) + b_rexp).reshape(n, N_GROUPS, EXPERTS_PER_GROUP)
    e_sel = jnp.einsum('nge,ng->ne', e_logits, g_oh)
    top_v, top_i = lax.top_k(e_sel, TOP_K_EXPERT)
    comb = g_w[:, None] * jax.nn.softmax(top_v, axis=-1)
    eid = grp[:, None] * EXPERTS_PER_GROUP + top_i.astype(jnp.int32)
    na = n * TOP_K_EXPERT
    e_flat = eid.reshape(-1)
    t_flat = jnp.repeat(jnp.arange(n, dtype=jnp.int32), TOP_K_EXPERT)
    w_flat = comb.reshape(-1)
    order = jnp.argsort(e_flat)
    e_sorted = e_flat[order]
    counts = jnp.bincount(e_flat, length=N_EXPERTS)
    padded = (counts + MOE_BLOCK - 1) // MOE_BLOCK * MOE_BLOCK
    pad_end = jnp.cumsum(padded)
    pad_start = pad_end - padded
    raw_start = jnp.cumsum(counts) - counts
    dest = pad_start[e_sorted] + jnp.arange(na) - raw_start[e_sorted]
    p_rows = -(-na // MOE_BLOCK) * MOE_BLOCK + N_EXPERTS * MOE_BLOCK
    n_blocks = p_rows // MOE_BLOCK
    row_tok = jnp.full((p_rows,), n, jnp.int32).at[dest].set(t_flat[order])
    row_w = jnp.zeros((p_rows,), jnp.float32).at[dest].set(w_flat[order])
    blk_exp = jnp.minimum(jnp.searchsorted(pad_end, jnp.arange(n_blocks) * MOE_BLOCK, side='right'),
                          N_EXPERTS - 1)
    z_pad = jnp.concatenate([z, jnp.zeros((1, d), z.dtype)], axis=0)
    xs = z_pad[row_tok].reshape(n_blocks, MOE_BLOCK, d)

    def run(args):
        xb, e = args
        h = jax.nn.silu(xb @ w_gate[e]) * (xb @ w_up[e])
        return h @ w_down[e]

    ys = lax.map(run, (xs, blk_exp)).reshape(p_rows, d)
    out = jnp.zeros((n + 1, d), z.dtype).at[row_tok].add(ys * row_w[:, None].astype(z.dtype))
    return out[:n]


def setup_inputs(seed: int = 0) -> dict:
    key = jax.random.key(seed)
    ks = iter(jax.random.split(key, 40))
    nrm = lambda shape, scale: jax.random.normal(next(ks), shape, jnp.float32) * scale
    gain = lambda shape: 1.0 + nrm(shape, 0.05)
    d = D_MODEL
    return {
        'x': nrm((BATCH, SEQ, d), 1.0),
        'c': nrm((BATCH, d), 1.0),
        'ctx': nrm((BATCH, CTX_LEN, d), 1.0),
        'c_ctx': nrm((d,), 1.0),
        'ada_w': nrm((DEPTH, d, 6 * d), 0.5 * d ** -0.5),
        'ada_b': nrm((DEPTH, 6 * d), 0.01),
        'ln1_g': gain((DEPTH, d)),
        'ln1_b': nrm((DEPTH, d), 0.01),
        'ln2_g': gain((DEPTH, d)),
        'ln2_b': nrm((DEPTH, d), 0.01),
        'ab_w_in': nrm((N_EVEN, d, AB_IN), d ** -0.5),
        'ab_w_lr_f': nrm((N_EVEN, GLA_RANK, H_B * DK_B), GLA_RANK ** -0.5),
        'ab_b_lr_f': nrm((N_EVEN, H_B * DK_B), 0.01),
        'ab_w_lr_b': nrm((N_EVEN, GLA_RANK, H_B * DK_B), GLA_RANK ** -0.5),
        'ab_b_lr_b': nrm((N_EVEN, H_B * DK_B), 0.01),
        'ab_gn_a': gain((N_EVEN, H_A * DV_A)),
        'ab_gn_b': gain((N_EVEN, H_B * DV_B)),
        'ab_w_out': nrm((N_EVEN, AB_OUT, d), DEEPNORM_BETA * AB_OUT ** -0.5),
        'c_w_qkv': nrm((N_ODD, d, C_IN), d ** -0.5),
        'c_lq1': nrm((N_ODD, H_C, DH_C), LAMBDA_STD),
        'c_lk1': nrm((N_ODD, H_C, DH_C), LAMBDA_STD),
        'c_lq2': nrm((N_ODD, H_C, DH_C), LAMBDA_STD),
        'c_lk2': nrm((N_ODD, H_C, DH_C), LAMBDA_STD),
        'c_subln_g': gain((N_ODD, C_OUT)),
        'c_w_out': nrm((N_ODD, C_OUT, d), DEEPNORM_BETA * C_OUT ** -0.5),
        'moe_w_grp': nrm((DEPTH, d, N_GROUPS), d ** -0.5),
        'moe_b_grp': nrm((DEPTH, N_GROUPS), 0.01),
        'moe_w_rexp': nrm((DEPTH, d, N_EXPERTS), d ** -0.5),
        'moe_b_rexp': nrm((DEPTH, N_EXPERTS), 0.01),
        'moe_w_gate': nrm((DEPTH, N_EXPERTS, d, D_EXPERT), d ** -0.5),
        'moe_w_up': nrm((DEPTH, N_EXPERTS, d, D_EXPERT), d ** -0.5),
        'moe_w_down': nrm((DEPTH, N_EXPERTS, D_EXPERT, d), DEEPNORM_BETA * D_EXPERT ** -0.5),
    }


def reference(x, c, ctx, c_ctx, ada_w, ada_b, ln1_g, ln1_b, ln2_g, ln2_b,
              ab_w_in, ab_w_lr_f, ab_b_lr_f, ab_w_lr_b, ab_b_lr_b, ab_gn_a, ab_gn_b, ab_w_out,
              c_w_qkv, c_lq1, c_lk1, c_lq2, c_lk2, c_subln_g, c_w_out,
              moe_w_grp, moe_b_grp, moe_w_rexp, moe_b_rexp, moe_w_gate, moe_w_up, moe_w_down):
    bn, t, d = x.shape
    n_ctx = ctx.shape[1]
    rows = t // GRID_W
    cos_a, sin_a = axial_rope(rows, DK_A)
    cs_a = (cos_a[:, None, :], sin_a[:, None, :])
    cos_c, sin_c = axial_rope(rows, DH_C)
    cs_c = (cos_c[:, None, None, :], sin_c[:, None, None, :])
    sc = jax.nn.silu(c)
    scc = jax.nn.silu(c_ctx)
    for l in range(DEPTH):
        last = l == DEPTH - 1
        i = l // 2
        sh1x, s1x, g1x, sh2x, s2x, g2x = jnp.split(sc @ ada_w[l] + ada_b[l], 6, axis=-1)
        sh1c, s1c, g1c, sh2c, s2c, g2c = jnp.split(scc @ ada_w[l] + ada_b[l], 6, axis=-1)
        ux = x * (1.0 + s1x[:, None, :]) + sh1x[:, None, :]
        uc = ctx * (1.0 + s1c) + sh1c
        if l % 2 == 0:
            yx, yc = mixer_ab(ux, uc, ab_w_in[i], ab_w_lr_f[i], ab_b_lr_f[i], ab_w_lr_b[i], ab_b_lr_b[i],
                              ab_gn_a[i], ab_gn_b[i], ab_w_out[i], cs_a, not last)
        else:
            lam_init = 0.8 - 0.6 * math.exp(-0.3 * l)
            yx, yc = mixer_c(ux, uc, c_w_qkv[i], c_lq1[i], c_lk1[i], c_lq2[i], c_lk2[i], c_subln_g[i],
                             c_w_out[i], lam_init, cs_c, not last)
        x = layer_norm(DEEPNORM_ALPHA * x + g1x[:, None, :] * yx, ln1_g[l], ln1_b[l])
        if not last:
            ctx = layer_norm(DEEPNORM_ALPHA * ctx + g1c * yc, ln1_g[l], ln1_b[l])
        ux = x * (1.0 + s2x[:, None, :]) + sh2x[:, None, :]
        tok = ux.reshape(bn * t, d)
        if not last:
            uc = ctx * (1.0 + s2c) + sh2c
            tok = jnp.concatenate([tok, uc.reshape(bn * n_ctx, d)], axis=0)
        y = hier_moe(tok, moe_w_grp[l], moe_b_grp[l], moe_w_rexp[l], moe_b_rexp[l],
                     moe_w_gate[l], moe_w_up[l], moe_w_down[l])
        x = layer_norm(DEEPNORM_ALPHA * x + g2x[:, None, :] * y[:bn * t].reshape(bn, t, d), ln2_g[l], ln2_b[l])
        if not last:
            ctx = layer_norm(DEEPNORM_ALPHA * ctx + g2c * y[bn * t:].reshape(bn, n_ctx, d), ln2_g[l], ln2_b[l])
    return x
```

```cpp
#include <hip/hip_runtime.h>
#include <hip/hip_cooperative_groups.h>
#include <cstdio>
#include <cstdint>
namespace cg = cooperative_groups;

#ifndef N_LAUNCH_MODE
#define N_LAUNCH_MODE 1
#endif

#define DI __device__ __forceinline__
#define LAS __attribute__((address_space(3)))
typedef unsigned short bf16_t;
typedef short bf16x8 __attribute__((ext_vector_type(8)));
typedef short s16x4 __attribute__((ext_vector_type(4)));
typedef float f32x4 __attribute__((ext_vector_type(4)));
typedef float f32x16 __attribute__((ext_vector_type(16)));
typedef unsigned u32x4 __attribute__((ext_vector_type(4)));
typedef unsigned u32x2 __attribute__((ext_vector_type(2)));

constexpr int D = 1024, NB = 8, T = 2048, TC = 256, TA = T + TC;
constexpr int ML = NB * T, MC = NB * TC, MT = ML + MC;
constexpr int NIN = 3616, NINP = 3712, ZS = 3712;
constexpr int NSLOT = 2 * MT;
constexpr float LN_EPS = 1e-5f;
constexpr float ALPHA = 1.6817928305074290f;
constexpr float L2E = 1.4426950408889634f;

constexpr size_t MiB = 1ull << 20;
constexpr size_t WS_CTL = 0;
constexpr size_t WS_MOD = 1 * MiB;
constexpr size_t WS_ROPEA = 2 * MiB;
constexpr size_t WS_ROPEC = 3 * MiB;
constexpr size_t WS_LR = 4 * MiB;
constexpr size_t WS_SLOTW = 7 * MiB;
constexpr size_t WS_LIST = 8 * MiB;
constexpr size_t WS_WRT = 13 * MiB;
constexpr size_t WS_WIN = 16 * MiB;
constexpr size_t WS_WABO = 32 * MiB;
constexpr size_t WS_WQKV = 36 * MiB;
constexpr size_t WS_WCO = 48 * MiB;
constexpr size_t WS_WGU = 64 * MiB;
constexpr size_t WS_WD = 320 * MiB;
constexpr size_t WS_X = 448 * MiB;
constexpr size_t WS_U = 520 * MiB;
constexpr size_t WS_Y = 556 * MiB;
constexpr size_t WS_Z = 592 * MiB;
constexpr size_t WS_O = 724 * MiB;
constexpr size_t WS_PF = 868 * MiB, WS_SQ = 886 * MiB, WS_SK = 904 * MiB, WS_TOT = 922 * MiB;
constexpr size_t WS_END = 923 * MiB;
constexpr size_t WS_QC = WS_Z, WS_KC = WS_Z + 36 * MiB, WS_VT = WS_Z + 72 * MiB;
constexpr size_t WS_YS = WS_Z;
constexpr size_t WS_OF = WS_O, WS_OB = WS_O + 72 * MiB, WS_P = WS_O, WS_H = WS_O + 72 * MiB;

#ifndef XBF16
#define XBF16 0
#endif
#if XBF16
typedef bf16_t xres_t;
#else
typedef float xres_t;
#endif
struct Params { const float* in[32]; float* out; unsigned char* ws; int ph_lo, ph_hi; };
typedef const __attribute__((address_space(4))) Params* KP;

DI int TIDX() { int t = threadIdx.x; asm volatile("" : "+v"(t)); return t; }
DI int BIDX() { int b = blockIdx.x; asm volatile("" : "+s"(b)); return b; }
DI unsigned pk2(float lo, float hi);
DI unsigned f2bf(float f) { return pk2(f, 0.f) & 0xffffu; }
typedef float f32x2_t __attribute__((ext_vector_type(2))); typedef __bf16 bf16x2_t __attribute__((ext_vector_type(2)));
DI unsigned pk2(float lo, float hi) { f32x2_t v = {lo, hi}; bf16x2_t b = __builtin_convertvector(v, bf16x2_t); return __builtin_bit_cast(unsigned, b); }
DI float bflo(unsigned w) { return __uint_as_float(w << 16); }
DI float bfhi(unsigned w) { return __uint_as_float(w & 0xffff0000u); }
DI f32x4 xload(const xres_t* p) {
#if XBF16
    const u32x2 w = *(const u32x2*)p; return (f32x4){bflo(w.x), bfhi(w.x), bflo(w.y), bfhi(w.y)};
#else
    return *(const f32x4*)p;
#endif
}
DI void xstore(xres_t* p, f32x4 v) {
#if XBF16
    u32x2 w; w.x = pk2(v[0], v[1]); w.y = pk2(v[2], v[3]); *(u32x2*)p = w;
#else
    *(f32x4*)p = v;
#endif
}
DI float wave_sum(float v) {
#pragma unroll
    for (int o = 1; o < 64; o <<= 1) v += __shfl_xor(v, o);
    return v;
}
DI float siluf(float v) { return v * __builtin_amdgcn_rcpf(1.0f + __expf(-v)); }

DI int gemm_chunk(int tid) { return (tid & 7) ^ ((tid >> 4) & 7); }
template <bool TRN>
DI void gemm_tile(unsigned char* shm, const bf16_t* const (&ap)[4], const bf16_t* const (&bp)[4], int K, f32x4 (&acc)[4][4],
                  bool first, bool has_next, const bf16_t* const (&apn)[4], const bf16_t* const (&bpn)[4]) {
    const int tid = TIDX(), wid = tid >> 6, lane = tid & 63, wr = wid >> 1, wc = wid & 1, fr = lane & 15, fq = lane >> 4;
#pragma unroll
    for (int m = 0; m < 4; ++m)
#pragma unroll
        for (int n = 0; n < 4; ++n) acc[m][n] = (f32x4){0.f, 0.f, 0.f, 0.f};
    const int nt = K >> 6;
    const int sw = fr >> 1;
    const unsigned aoff = (unsigned)((wr * 64 + fr) * 128), boff = (unsigned)(16384 + (wc * 64 + fr) * 128);
#define GEMM_STAGE(buf, A_, B_, t) do { _Pragma("unroll") for (int i_ = 0; i_ < 4; ++i_) { \
        __builtin_amdgcn_global_load_lds((const unsigned*)(A_[i_] + (t) * 64), (LAS unsigned*)(shm + (buf) * 32768 + i_ * 4096 + tid * 16), 16, 0, 0); \
        __builtin_amdgcn_global_load_lds((const unsigned*)(B_[i_] + (t) * 64), (LAS unsigned*)(shm + (buf) * 32768 + 16384 + i_ * 4096 + tid * 16), 16, 0, 0); } } while (0)
    if (first) {
        GEMM_STAGE(0, ap, bp, 0);
        asm volatile("s_waitcnt vmcnt(0)" ::: "memory");
        __syncthreads();
    }
    for (int t = 0; t < nt; ++t) {
        const int cur = t & 1;
        if (t + 1 < nt) GEMM_STAGE(cur ^ 1, ap, bp, t + 1);
        else if (has_next) GEMM_STAGE(cur ^ 1, apn, bpn, 0);
        const unsigned char* base = shm + cur * 32768;
        bf16x8 At[2][4], Bt[2][4];
#pragma unroll
        for (int ks = 0; ks < 2; ++ks) {
            const unsigned co = (unsigned)(((ks * 4 + fq) ^ sw) << 4);
#pragma unroll
            for (int m = 0; m < 4; ++m) At[ks][m] = *(const bf16x8*)(base + aoff + m * 2048 + co);
#pragma unroll
            for (int n = 0; n < 4; ++n) Bt[ks][n] = *(const bf16x8*)(base + boff + n * 2048 + co);
        }
        __builtin_amdgcn_s_setprio(1);
#pragma unroll
        for (int ks = 0; ks < 2; ++ks)
#pragma unroll
            for (int m = 0; m < 4; ++m)
#pragma unroll
                for (int n = 0; n < 4; ++n)
                    acc[m][n] = TRN ? __builtin_amdgcn_mfma_f32_16x16x32_bf16(Bt[ks][n], At[ks][m], acc[m][n], 0, 0, 0)
                                    : __builtin_amdgcn_mfma_f32_16x16x32_bf16(At[ks][m], Bt[ks][n], acc[m][n], 0, 0, 0);
        __builtin_amdgcn_s_setprio(0);
        asm volatile("s_waitcnt vmcnt(0)" ::: "memory");
        __syncthreads();
    }
#undef GEMM_STAGE
}
#define GEMM_ADVANCE() do { _Pragma("unroll") for (int k_ = 0; k_ < 4; ++k_) { ap[k_] = apn[k_]; bp[k_] = bpn[k_]; } } while (0)
DI void gemm_rows(const bf16_t* base, int r0, int ld, int tid, const bf16_t* (&pp)[4]) {
    const bf16_t* q = base + (size_t)(r0 + (tid >> 3)) * ld + gemm_chunk(tid) * 8;
#pragma unroll
    for (int i = 0; i < 4; ++i) pp[i] = q + (size_t)(32 * i) * ld;
}
DI bool tile_seq(int q, int nrt, int nct, int& rt, int& ct) {
    if (q >= nrt * nct) return false;
    const int band = q / (8 * nct), rem = q - band * 8 * nct;
    const int rows = (nrt - band * 8) < 8 ? (nrt - band * 8) : 8;
    ct = rem / rows; rt = band * 8 + rem % rows;
    return true;
}
DI int xcd_seq(int i, int total) {
    const int G = gridDim.x, bid = BIDX();
    if ((G & 7) != 0) { const int q = i * G + bid; return q < total ? q : -1; }
    const int x = bid & 7, j = bid >> 3, per = (total + 7) >> 3, gx = G >> 3;
    const int q = i * gx + j;
    if (q >= per) return -1;
    const int g = x * per + q;
    return g < total ? g : -1;
}

template <int MODE>
DI void tr_item(const float* W, int K, int N, bf16_t* WT, float* scr, int item, int lane) {
    const int nblk = N / 32, kb = item / nblk, nb = item % nblk, k0 = 64 * kb, n0 = 32 * nb;
    float wv[32];
#pragma unroll
    for (int i = 0; i < 32; ++i) wv[i] = W[(size_t)(k0 + 2 * i + (lane >> 5)) * N + n0 + (lane & 31)];
#pragma unroll
    for (int i = 0; i < 32; ++i) scr[(2 * i + (lane >> 5)) * 33 + (lane & 31)] = wv[i];
    asm volatile("s_waitcnt lgkmcnt(0)" ::: "memory");
    const int c = lane & 7;
#pragma unroll
    for (int j = 0; j < 4; ++j) {
        const int n = (lane >> 3) + 8 * j; const float* s = scr + (8 * c) * 33 + n;
        u32x4 o; o.x = pk2(s[0 * 33], s[1 * 33]); o.y = pk2(s[2 * 33], s[3 * 33]); o.z = pk2(s[4 * 33], s[5 * 33]); o.w = pk2(s[6 * 33], s[7 * 33]);
        const int nn = n0 + n;
        const int drow = (MODE == 0) ? nn : ((nn >> 4) * 32 + (nn & 15) + (MODE == 2 ? 16 : 0));
        *(u32x4*)(WT + (size_t)drow * K + k0 + 8 * c) = o;
    }
    asm volatile("s_waitcnt lgkmcnt(0)" ::: "memory");
}

DI void phase_pre0(KP p, unsigned char* smem) {
    const int tid = TIDX(), wave = tid >> 6, lane = tid & 63;
    unsigned char* ws = p->ws;
    {
        float* s_sc = (float*)smem;
        float* s_red = s_sc + 9 * 1024;
        const float* c = p->in[1]; const float* cc = p->in[3];
        for (int i = tid; i < 9 * 1024; i += 256) { const int r = i >> 10, k = i & 1023; const float v = r < 8 ? c[r * 1024 + k] : cc[k]; s_sc[i] = v / (1.0f + expf(-v)); }
        __syncthreads();
        float* MOD = (float*)(ws + WS_MOD);
        for (int item = BIDX(); item < 384; item += gridDim.x) {
            const int l = item / 96, n0 = (item % 96) * 64;
            const float* W = p->in[4] + (size_t)l * 1024 * 6144 + n0 + lane;
            float acc[9];
#pragma unroll
            for (int r = 0; r < 9; ++r) acc[r] = 0.f;
#pragma unroll 16
            for (int k = wave * 256; k < wave * 256 + 256; ++k) {
                const float w = W[(size_t)k * 6144];
#pragma unroll
                for (int r = 0; r < 9; ++r) acc[r] += s_sc[r * 1024 + k] * w;
            }
#pragma unroll
            for (int r = 0; r < 9; ++r) s_red[(wave * 9 + r) * 64 + lane] = acc[r];
            __syncthreads();
            for (int i = tid; i < 9 * 64; i += 256) {
                const int r = i >> 6, ln = i & 63;
                const float v = s_red[(0 * 9 + r) * 64 + ln] + s_red[(1 * 9 + r) * 64 + ln] + s_red[(2 * 9 + r) * 64 + ln] + s_red[(3 * 9 + r) * 64 + ln];
                MOD[(size_t)(l * 9 + r) * 6144 + n0 + ln] = v + p->in[5][l * 6144 + n0 + ln];
            }
            __syncthreads();
        }
    }
    {
        const int gt = BIDX() * 256 + tid, NT = gridDim.x * 256;
        float* ca = (float*)(ws + WS_ROPEA); float* sa = ca + 2048 * 64;
        for (int i = gt; i < 2048 * 64; i += NT) {
            const int t = i >> 6, f = i & 63; const int pos = f < 32 ? (t >> 6) : (t & 63); const int ff = f & 31;
            const float inv = powf(10000.0f, -(float)ff / 32.0f); const float a = (float)pos * inv;
            ca[i] = cosf(a); sa[i] = sinf(a);
        }
        float* cc_ = (float*)(ws + WS_ROPEC); float* sc_ = cc_ + 2048 * 32;
        for (int i = gt; i < 2048 * 32; i += NT) {
            const int t = i >> 5, f = i & 31; const int pos = f < 16 ? (t >> 6) : (t & 63); const int ff = f & 15;
            const float inv = powf(10000.0f, -(float)ff / 16.0f); const float a = (float)pos * inv;
            cc_[i] = cosf(a); sc_[i] = sinf(a);
        }
        float* wrt = (float*)(ws + WS_WRT);
        for (int i = gt; i < 4 * 36 * 1024; i += NT) {
            const int l = i / (36 * 1024), o = (i / 1024) % 36, k = i & 1023;
            wrt[i] = o < 4 ? p->in[25][((size_t)l * 1024 + k) * 4 + o] : p->in[27][((size_t)l * 1024 + k) * 32 + (o - 4)];
        }
        unsigned* wpad = (unsigned*)(ws + WS_WIN);
        for (int i = gt; i < 2 * 96 * 512; i += NT) { const int li = i / (96 * 512), r = i % (96 * 512); wpad[((size_t)li * NINP + NIN) * 512 + r] = 0u; }
    }
    __syncthreads();
    {
        float* scr = (float*)smem + wave * (64 * 33);
        constexpr int I_IN = 16 * 113, I_SQ = 16 * 32, I_QKV = 16 * 96, I_E = 256;
        constexpr int R0 = 2 * I_IN, R1 = R0 + 2 * I_SQ, R2 = R1 + 2 * I_QKV, R3 = R2 + 2 * I_SQ, R4 = R3 + 128 * I_E, R5 = R4 + 128 * I_E, R6 = R5 + 128 * I_E;
        for (int it = BIDX() * 4 + wave; it < R6; it += gridDim.x * 4) {
            if (it < R0) { const int i = it / I_IN, r = it % I_IN; tr_item<0>(p->in[10] + (size_t)i * 1024 * NIN, 1024, NIN, (bf16_t*)(ws + WS_WIN) + (size_t)i * NINP * 1024, scr, r, lane); }
            else if (it < R1) { const int q = it - R0, i = q / I_SQ, r = q % I_SQ; tr_item<0>(p->in[17] + (size_t)i * 1024 * 1024, 1024, 1024, (bf16_t*)(ws + WS_WABO) + (size_t)i * 1024 * 1024, scr, r, lane); }
            else if (it < R2) { const int q = it - R1, i = q / I_QKV, r = q % I_QKV; tr_item<0>(p->in[18] + (size_t)i * 1024 * 3072, 1024, 3072, (bf16_t*)(ws + WS_WQKV) + (size_t)i * 3072 * 1024, scr, r, lane); }
            else if (it < R3) { const int q = it - R2, i = q / I_SQ, r = q % I_SQ; tr_item<0>(p->in[24] + (size_t)i * 1024 * 1024, 1024, 1024, (bf16_t*)(ws + WS_WCO) + (size_t)i * 1024 * 1024, scr, r, lane); }
            else if (it < R4) { const int q = it - R3, le = q / I_E, r = q % I_E; tr_item<1>(p->in[29] + (size_t)le * 1024 * 512, 1024, 512, (bf16_t*)(ws + WS_WGU) + (size_t)le * 1024 * 1024, scr, r, lane); }
            else if (it < R5) { const int q = it - R4, le = q / I_E, r = q % I_E; tr_item<2>(p->in[30] + (size_t)le * 1024 * 512, 1024, 512, (bf16_t*)(ws + WS_WGU) + (size_t)le * 1024 * 1024, scr, r, lane); }
            else { const int q = it - R5, le = q / I_E, r = q % I_E; tr_item<0>(p->in[31] + (size_t)le * 512 * 1024, 512, 1024, (bf16_t*)(ws + WS_WD) + (size_t)le * 1024 * 512, scr, r, lane); }
        }
    }
}

DI void phase_pre1(KP p) {
    const int tid = TIDX(), wave = tid >> 6, lane = tid & 63;
    xres_t* X = (xres_t*)(p->ws + WS_X); bf16_t* U = (bf16_t*)(p->ws + WS_U); const float* MOD = (const float*)(p->ws + WS_MOD);
    for (int row = BIDX() * 4 + wave; row < MT; row += gridDim.x * 4) {
        const float* src = row < ML ? p->in[0] + (size_t)row * 1024 : p->in[2] + (size_t)(row - ML) * 1024;
        const int r = row < ML ? (row >> 11) : 8;
        const float* mod = MOD + (size_t)r * 6144;
#pragma unroll
        for (int j = 0; j < 4; ++j) {
            const int k = 256 * j + 4 * lane;
            const f32x4 v = *(const f32x4*)(src + k), sh = *(const f32x4*)(mod + k), sc = *(const f32x4*)(mod + 1024 + k);
            const f32x4 u = v * (1.0f + sc) + sh;
            u32x2 w; w.x = pk2(u[0], u[1]); w.y = pk2(u[2], u[3]);
            *(u32x2*)(U + (size_t)row * 1024 + k) = w;
        }
    }
}

DI void phase_g1e(KP p, int l, unsigned char* smem) {
    const int tid = TIDX(), wid = tid >> 6, lane = tid & 63, wr = wid >> 1, wc = wid & 1, fr = lane & 15, fq = lane >> 4;
    const int li = l >> 1;
    const bf16_t* U = (const bf16_t*)(p->ws + WS_U); const bf16_t* W = (const bf16_t*)(p->ws + WS_WIN) + (size_t)li * NINP * 1024;
    bf16_t* Z = (bf16_t*)(p->ws + WS_Z); float* LR = (float*)(p->ws + WS_LR);
    const float* ca = (const float*)(p->ws + WS_ROPEA); const float* sa = ca + 2048 * 64;
    constexpr int NTN = NINP / 128;
    auto decode = [&](int i, int& brow, int& bcol) -> bool {
        const int q = xcd_seq(i, (MT / 128) * NTN); if (q < 0) return false;
        int rt, nt; tile_seq(q, MT / 128, NTN, rt, nt); brow = rt * 128; bcol = nt * 128; return true; };
    auto epi = [&](int brow, int bcol, f32x4 (&acc)[4][4]) {
        const int colw = bcol + wc * 64;
        if (colw >= NIN) return;
        if (colw >= 3584) {
#pragma unroll
            for (int m = 0; m < 4; ++m) { const int row = brow + wr * 64 + m * 16 + fr;
#pragma unroll
                for (int n = 0; n < 2; ++n) *(f32x4*)(LR + (size_t)row * 32 + n * 16 + fq * 4) = acc[m][n]; }
            return;
        }
        const bool ropeR = colw < 1024; const int half = (colw >> 6) & 1;
        const float scale = colw < 512 ? 0.08838834764831845f : ((colw >= 2048 && colw < 2304) ? 0.125f : 1.0f);
#pragma unroll
        for (int m = 0; m < 4; ++m) {
            const int row = brow + wr * 64 + m * 16 + fr;
            if (ropeR && row < ML) {
                const int t = row & 2047;
#pragma unroll
                for (int n = 0; n < 2; ++n) {
                    const f32x4 c4 = *(const f32x4*)(ca + t * 64 + half * 32 + n * 16 + fq * 4), s4 = *(const f32x4*)(sa + t * 64 + half * 32 + n * 16 + fq * 4);
                    const f32x4 a = acc[m][n], b = acc[m][n + 2];
                    acc[m][n] = a * c4 - b * s4; acc[m][n + 2] = b * c4 + a * s4;
                }
            }
#pragma unroll
            for (int n = 0; n < 4; ++n) {
                const f32x4 v = acc[m][n] * scale; u32x2 w; w.x = pk2(v[0], v[1]); w.y = pk2(v[2], v[3]);
                *(u32x2*)(Z + (size_t)row * ZS + colw + n * 16 + fq * 4) = w;
            }
        }
    };
    int brow, bcol;
    if (!decode(0, brow, bcol)) return;
    const bf16_t* ap[4]; const bf16_t* bp[4]; const bf16_t* apn[4]; const bf16_t* bpn[4];
    gemm_rows(U, brow, 1024, tid, ap); gemm_rows(W, bcol, 1024, tid, bp);
    bool first = true;
    for (int i = 0;; ++i) {
        int nbrow = brow, nbcol = bcol; const bool hn = decode(i + 1, nbrow, nbcol);
        gemm_rows(U, nbrow, 1024, tid, apn); gemm_rows(W, nbcol, 1024, tid, bpn);
        f32x4 acc[4][4];
        gemm_tile<true>(smem, ap, bp, 1024, acc, first, hn, apn, bpn);
        epi(brow, bcol, acc);
        if (!hn) break;
        brow = nbrow; bcol = nbcol; GEMM_ADVANCE(); first = false;
    }
}

DI void phase_g1o(KP p, int l, unsigned char* smem) {
    const int tid = TIDX(), wid = tid >> 6, lane = tid & 63, wr = wid >> 1, wc = wid & 1, fr = lane & 15, fq = lane >> 4;
    const int li = l >> 1;
    const bf16_t* U = (const bf16_t*)(p->ws + WS_U); const bf16_t* W = (const bf16_t*)(p->ws + WS_WQKV) + (size_t)li * 3072 * 1024;
    bf16_t* Qc = (bf16_t*)(p->ws + WS_QC); bf16_t* Kc = (bf16_t*)(p->ws + WS_KC); bf16_t* Vt = (bf16_t*)(p->ws + WS_VT);
    const float* cc = (const float*)(p->ws + WS_ROPEC); const float* sc = cc + 2048 * 32;
    auto decode = [&](int i, int& brow, int& bcol) -> bool {
        const int q = xcd_seq(i, (MT / 128) * 24); if (q < 0) return false;
        int rt, nt; tile_seq(q, MT / 128, 24, rt, nt); brow = rt * 128; bcol = nt * 128; return true; };
    int brow, bcol;
    if (!decode(0, brow, bcol)) return;
    const bf16_t* ap[4]; const bf16_t* bp[4]; const bf16_t* apn[4]; const bf16_t* bpn[4];
    gemm_rows(U, brow, 1024, tid, ap); gemm_rows(W, bcol, 1024, tid, bp);
    bool first = true;
    for (int i = 0;; ++i) {
        int nbrow = brow, nbcol = bcol; const bool hn = decode(i + 1, nbrow, nbcol);
        gemm_rows(U, nbrow, 1024, tid, apn); gemm_rows(W, nbcol, 1024, tid, bpn);
        f32x4 acc[4][4];
        if (bcol < 2048) {
            gemm_tile<true>(smem, ap, bp, 1024, acc, first, hn, apn, bpn);
            const int colw = bcol + wc * 64; const bool isk = colw >= 1024; const int hc = (colw & 1023) >> 6;
            bf16_t* dst = isk ? Kc : Qc; const float scale = isk ? 1.0f : 0.125f;
#pragma unroll
            for (int m = 0; m < 4; ++m) {
                const int row = brow + wr * 64 + m * 16 + fr;
                int b, pidx;
                if (row < ML) {
                    b = row >> 11; const int t = row & 2047; pidx = 256 + t;
#pragma unroll
                    for (int n = 0; n < 4; n += 2) {
                        const f32x4 c4 = *(const f32x4*)(cc + t * 32 + (n >> 1) * 16 + fq * 4), s4 = *(const f32x4*)(sc + t * 32 + (n >> 1) * 16 + fq * 4);
                        const f32x4 a = acc[m][n], bb = acc[m][n + 1];
                        acc[m][n] = a * c4 - bb * s4; acc[m][n + 1] = bb * c4 + a * s4;
                    }
                } else { b = (row - ML) >> 8; pidx = (row - ML) & 255; }
                bf16_t* o = dst + ((size_t)(b * 16 + hc) * TA + pidx) * 64;
#pragma unroll
                for (int n = 0; n < 4; ++n) { const f32x4 v = acc[m][n] * scale; u32x2 w; w.x = pk2(v[0], v[1]); w.y = pk2(v[2], v[3]); *(u32x2*)(o + n * 16 + fq * 4) = w; }
            }
        } else {
            gemm_tile<false>(smem, ap, bp, 1024, acc, first, hn, apn, bpn);
#pragma unroll
            for (int m = 0; m < 4; ++m) {
                const int row = brow + wr * 64 + m * 16 + fq * 4;
                int b, pidx;
                if (row < ML) { b = row >> 11; pidx = 256 + (row & 2047); } else { b = (row - ML) >> 8; pidx = (row - ML) & 255; }
                const int ppos = (pidx & ~12) | ((pidx & 8) >> 1) | ((pidx & 4) << 1);
#pragma unroll
                for (int n = 0; n < 4; ++n) {
                    const int col = bcol - 2048 + wc * 64 + n * 16 + fr; const int h = col >> 7, d = col & 127;
                    const f32x4 v = acc[m][n]; u32x2 w; w.x = pk2(v[0], v[1]); w.y = pk2(v[2], v[3]);
                    *(u32x2*)(Vt + ((size_t)(b * 8 + h) * 128 + d) * TA + ppos) = w;
                }
            }
        }
        if (!hn) break;
        brow = nbrow; bcol = nbcol; GEMM_ADVANCE(); first = false;
    }
}

DI void phase_g2(KP p, int l, unsigned char* smem) {
    const int tid = TIDX(), wid = tid >> 6, lane = tid & 63, wr = wid >> 1, wc = wid & 1, fr = lane & 15, fq = lane >> 4;
    const int li = l >> 1;
    const bf16_t* Y = (const bf16_t*)(p->ws + WS_Y);
    const bf16_t* W = (const bf16_t*)(p->ws + ((l & 1) ? WS_WCO : WS_WABO)) + (size_t)li * 1024 * 1024;
    bf16_t* P = (bf16_t*)(p->ws + WS_P);
    const int nrt = (l == 3 ? ML : MT) / 128;
    auto decode = [&](int i, int& brow, int& bcol) -> bool {
        const int q = xcd_seq(i, nrt * 8); if (q < 0) return false;
        int rt, nt; tile_seq(q, nrt, 8, rt, nt); brow = rt * 128; bcol = nt * 128; return true; };
    int brow, bcol;
    if (!decode(0, brow, bcol)) return;
    const bf16_t* ap[4]; const bf16_t* bp[4]; const bf16_t* apn[4]; const bf16_t* bpn[4];
    gemm_rows(Y, brow, 1024, tid, ap); gemm_rows(W, bcol, 1024, tid, bp);
    bool first = true;
    for (int i = 0;; ++i) {
        int nbrow = brow, nbcol = bcol; const bool hn = decode(i + 1, nbrow, nbcol);
        gemm_rows(Y, nbrow, 1024, tid, apn); gemm_rows(W, nbcol, 1024, tid, bpn);
        f32x4 acc[4][4];
        gemm_tile<true>(smem, ap, bp, 1024, acc, first, hn, apn, bpn);
#pragma unroll
        for (int m = 0; m < 4; ++m) { const int row = brow + wr * 64 + m * 16 + fr;
#pragma unroll
            for (int n = 0; n < 4; ++n) { const f32x4 v = acc[m][n]; u32x2 w; w.x = pk2(v[0], v[1]); w.y = pk2(v[2], v[3]); *(u32x2*)(P + (size_t)row * 1024 + bcol + wc * 64 + n * 16 + fq * 4) = w; } }
        if (!hn) break;
        brow = nbrow; bcol = nbcol; GEMM_ADVANCE(); first = false;
    }
}

template <bool DRY>
DI void phase_ln1r(KP p, int l, unsigned char* smem) {
    constexpr int US = 1028;
    constexpr int RB = 12;
    float* Us = (float*)smem;
    float* Ps = Us + RB * US;
    const int tid = TIDX(), wave = tid >> 6, lane = tid & 63;
    const xres_t* X = (const xres_t*)(p->ws + WS_X); xres_t* Xo = (xres_t*)(p->ws + (DRY ? WS_OB : WS_X)); const bf16_t* P = (const bf16_t*)(p->ws + WS_P); bf16_t* U = (bf16_t*)(p->ws + (DRY ? WS_Y : WS_U));
    const float* MOD = (const float*)(p->ws + WS_MOD); const float* WrT = (const float*)(p->ws + WS_WRT) + (size_t)l * 36 * 1024;
    const float* lng = p->in[6] + l * 1024; const float* lnb = p->in[7] + l * 1024;
    const float* bgrp = p->in[26] + l * 4; const float* brex = p->in[28] + l * 32;
    unsigned* cnt = (unsigned*)(p->ws + WS_CTL) + l * 32 + (DRY ? 256 : 0); int* list = (int*)(p->ws + WS_LIST); float* slotw = (float*)(p->ws + WS_SLOTW);
    const int rows_total = (l == 3) ? ML : MT;
    const int mi = lane & 15, mq = lane >> 4;
    int pend_slot = -1, pend_e = 0; unsigned pend_pos = 0u;
    for (int it = BIDX(); it * RB < rows_total; it += gridDim.x) {
        const int row0 = it * RB + wave * 3;
#pragma unroll
        for (int rr = 0; rr < 3; ++rr) {
            const int rowr = row0 + rr; const bool rvalid = rowr < rows_total; const int row = rvalid ? rowr : rows_total - 1;
            const int r = row < ML ? (row >> 11) : 8;
            const float* mod = MOD + (size_t)(l * 9 + r) * 6144;
            f32x4 v[4]; float s = 0.f;
#pragma unroll
            for (int j = 0; j < 4; ++j) {
                const int k = 256 * j + 4 * lane;
                const f32x4 xv = (l == 0) ? *(const f32x4*)((row < ML ? p->in[0] + (size_t)row * 1024 : p->in[2] + (size_t)(row - ML) * 1024) + k) : xload(X + (size_t)row * 1024 + k);
                const f32x4 g1 = *(const f32x4*)(mod + 2048 + k);
                const u32x2 pw_ = *(const u32x2*)(P + (size_t)row * 1024 + k); const f32x4 pv = (f32x4){bflo(pw_.x), bfhi(pw_.x), bflo(pw_.y), bfhi(pw_.y)};
                v[j] = xv * ALPHA + g1 * pv; s += (v[j][0] + v[j][1]) + (v[j][2] + v[j][3]);
            }
            const float mean = wave_sum(s) * (1.0f / 1024.0f); float s2 = 0.f;
#pragma unroll
            for (int j = 0; j < 4; ++j) { v[j] = v[j] - mean; s2 += (v[j][0] * v[j][0] + v[j][1] * v[j][1]) + (v[j][2] * v[j][2] + v[j][3] * v[j][3]); }
            const float rstd = 1.0f / sqrtf(wave_sum(s2) * (1.0f / 1024.0f) + LN_EPS);
#pragma unroll
            for (int j = 0; j < 4; ++j) {
                const int k = 256 * j + 4 * lane;
                const f32x4 xn = v[j] * rstd * *(const f32x4*)(lng + k) + *(const f32x4*)(lnb + k);
                const f32x4 uu = xn * (1.0f + *(const f32x4*)(mod + 4096 + k)) + *(const f32x4*)(mod + 3072 + k);
                *(f32x4*)(Us + (wave * 3 + rr) * US + k) = uu;
                if (rvalid) {
                    xstore(Xo + (size_t)row * 1024 + k, xn);
                    u32x2 w; w.x = pk2(uu[0], uu[1]); w.y = pk2(uu[2], uu[3]);
                    *(u32x2*)(U + (size_t)row * 1024 + k) = w;
                }
            }
        }
        __syncthreads();
        {
            f32x4 acc[3] = {(f32x4){0.f, 0.f, 0.f, 0.f}, (f32x4){0.f, 0.f, 0.f, 0.f}, (f32x4){0.f, 0.f, 0.f, 0.f}};
            const float* ap = Us + (mi < RB ? mi : mi - RB) * US + 256 * wave + 4 * mq;
            const float* bp0 = WrT + (size_t)mi * 1024 + 256 * wave + 4 * mq;
            const float* bp1 = WrT + (size_t)(16 + mi) * 1024 + 256 * wave + 4 * mq;
            const float* bp2 = WrT + (size_t)(32 + (mi & 3)) * 1024 + 256 * wave + 4 * mq;
#pragma unroll 4
            for (int sb = 0; sb < 16; ++sb) {
                const f32x4 a = *(const f32x4*)(ap + 16 * sb);
                const f32x4 b0 = *(const f32x4*)(bp0 + 16 * sb), b1 = *(const f32x4*)(bp1 + 16 * sb), b2 = *(const f32x4*)(bp2 + 16 * sb);
#pragma unroll
                for (int e = 0; e < 4; ++e) {
                    acc[0] = __builtin_amdgcn_mfma_f32_16x16x4f32(a[e], b0[e], acc[0], 0, 0, 0);
                    acc[1] = __builtin_amdgcn_mfma_f32_16x16x4f32(a[e], b1[e], acc[1], 0, 0, 0);
                    acc[2] = __builtin_amdgcn_mfma_f32_16x16x4f32(a[e], b2[e], acc[2], 0, 0, 0);
                }
            }
            if (mq < 3) {
#pragma unroll
                for (int nt = 0; nt < 3; ++nt)
#pragma unroll
                    for (int rg = 0; rg < 4; ++rg) Ps[(wave * RB + mq * 4 + rg) * 48 + nt * 16 + mi] = acc[nt][rg];
            }
        }
        __syncthreads();
        if (wave < 2) {
            const int r = wave * 8 + (lane >> 3), c = lane & 7;
            const int rq = r < RB ? r : RB - 1;
            const int row = it * RB + rq;
            float lgv[5];
#pragma unroll
            for (int k = 0; k < 5; ++k) {
                const int o = c + 8 * k; const int oo = o < 36 ? o : 35;
                lgv[k] = (Ps[(0 * RB + rq) * 48 + oo] + Ps[(1 * RB + rq) * 48 + oo]) + (Ps[(2 * RB + rq) * 48 + oo] + Ps[(3 * RB + rq) * 48 + oo]);
            }
            float gv = c < 4 ? lgv[0] + bgrp[c & 3] : -3.0e38f; int gi = c;
#pragma unroll
            for (int off = 1; off < 4; off <<= 1) {
                const float ov = __shfl_xor(gv, off); const int oi = __shfl_xor(gi, off);
                if (ov > gv || (ov == gv && oi < gi)) { gv = ov; gi = oi; }
            }
            const int src0 = lane & ~7;
            const float gmax = __shfl(gv, src0); const int grp = __shfl(gi, src0);
            float ge = c < 4 ? expf(lgv[0] + bgrp[c & 3] - gmax) : 0.f;
            ge += __shfl_xor(ge, 1); ge += __shfl_xor(ge, 2);
            const float gw = 1.0f / __shfl(ge, src0);
            const int j = (c + 4) & 7; const int kk = c >= 4 ? grp : grp + 1;
            float ev = lgv[0];
#pragma unroll
            for (int k = 1; k < 5; ++k) ev = (kk == k) ? lgv[k] : ev;
            ev += brex[grp * 8 + j];
            float v1 = ev; int i1 = j;
#pragma unroll
            for (int off = 1; off < 8; off <<= 1) {
                const float ov = __shfl_xor(v1, off); const int oi = __shfl_xor(i1, off);
                if (ov > v1 || (ov == v1 && oi < i1)) { v1 = ov; i1 = oi; }
            }
            float v2 = (j == i1) ? -3.0e38f : ev; int i2 = (j == i1) ? 99 : j;
#pragma unroll
            for (int off = 1; off < 8; off <<= 1) {
                const float ov = __shfl_xor(v2, off); const int oi = __shfl_xor(i2, off);
                if (ov > v2 || (ov == v2 && oi < i2)) { v2 = ov; i2 = oi; }
            }
            const float e2 = expf(v2 - v1);
            const float w1 = 1.0f / (1.0f + e2), w2 = e2 / (1.0f + e2);
            if (c < 2 && r < RB && row < rows_total) {
                if (pend_slot >= 0) list[(size_t)pend_e * NSLOT + pend_pos] = pend_slot;
                const int e = grp * 8 + (c ? i2 : i1); const float w = gw * (c ? w2 : w1);
                const int slot = row * 2 + c;
                slotw[slot] = w;
                pend_pos = atomicAdd(&cnt[e], 1u); pend_e = e; pend_slot = slot;
            }
        }
        __syncthreads();
    }
    if (pend_slot >= 0) list[(size_t)pend_e * NSLOT + pend_pos] = pend_slot;
}

DI void moe_prefix(KP p, int l, int* s_cnt, int* s_tb, int* s_rb) {
    const int tid = TIDX();
    const unsigned* cnt = (const unsigned*)(p->ws + WS_CTL) + l * 32;
    __syncthreads();
    if (tid < 32) s_cnt[tid] = (int)__hip_atomic_load(cnt + tid, __ATOMIC_RELAXED, __HIP_MEMORY_SCOPE_AGENT);
    __syncthreads();
    if (tid == 0) { int tb = 0; for (int e = 0; e < 32; ++e) { s_tb[e] = tb; s_rb[e] = tb * 128; tb += (s_cnt[e] + 127) >> 7; } s_tb[32] = tb; s_rb[32] = tb * 128; }
    __syncthreads();
}
DI void phase_mg1(KP p, int l, unsigned char* smem) {
    const int tid = TIDX(), wid = tid >> 6, lane = tid & 63, wr = wid >> 1, wc = wid & 1, fr = lane & 15, fq = lane >> 4;
    int* s_cnt = (int*)(smem + 65536 + 64); int* s_tb = s_cnt + 32; int* s_rb = s_tb + 33;
    moe_prefix(p, l, s_cnt, s_tb, s_rb);
    const bf16_t* U = (const bf16_t*)(p->ws + WS_U); const int* list = (const int*)(p->ws + WS_LIST);
    bf16_t* H = (bf16_t*)(p->ws + WS_H);
    const int ntiles = s_tb[32] * 8;
    struct TI { int e, rt, nt, cnt_e; };
    auto decode = [&](int i, TI& t) -> bool {
        const int tile = xcd_seq(i, ntiles); if (tile < 0) return false;
        const int rtg = tile >> 3; t.nt = tile & 7;
        int e = 0;
        for (int q = 1; q < 32; ++q) if (rtg >= s_tb[q]) e = q;
        t.e = e; t.rt = rtg - s_tb[e]; t.cnt_e = s_cnt[e]; return true; };
    auto rows = [&](const TI& t, const bf16_t* (&a)[4], const bf16_t* (&b)[4]) {
#pragma unroll
        for (int i_ = 0; i_ < 4; ++i_) {
            const int pos = t.rt * 128 + (tid >> 3) + 32 * i_;
            const int tok = pos < t.cnt_e ? (list[(size_t)t.e * NSLOT + pos] >> 1) : 0;
            a[i_] = U + (size_t)tok * 1024 + gemm_chunk(tid) * 8;
        }
        gemm_rows((const bf16_t*)(p->ws + WS_WGU) + (size_t)(l * 32 + t.e) * 1024 * 1024, t.nt * 128, 1024, tid, b); };
    TI cur, nxt;
    if (!decode(0, cur)) return;
    const bf16_t* ap[4]; const bf16_t* bp[4]; const bf16_t* apn[4]; const bf16_t* bpn[4];
    rows(cur, ap, bp);
    bool first = true;
    for (int i = 0;; ++i) {
        nxt = cur; const bool hn = decode(i + 1, nxt);
        rows(nxt, apn, bpn);
        f32x4 acc[4][4];
        gemm_tile<true>(smem, ap, bp, 1024, acc, first, hn, apn, bpn);
        const int hrow0 = s_rb[cur.e] + cur.rt * 128 + wr * 64;
#pragma unroll
        for (int m = 0; m < 4; ++m) {
            bf16_t* o = H + (size_t)(hrow0 + m * 16 + fr) * 512 + cur.nt * 64 + wc * 32 + fq * 4;
#pragma unroll
            for (int n = 0; n < 4; n += 2) {
                const f32x4 g = acc[m][n], uu = acc[m][n + 1]; f32x4 h;
#pragma unroll
                for (int j = 0; j < 4; ++j) h[j] = siluf(g[j]) * uu[j];
                u32x2 w; w.x = pk2(h[0], h[1]); w.y = pk2(h[2], h[3]);
                *(u32x2*)(o + (n >> 1) * 16) = w;
            }
        }
        if (!hn) break;
        cur = nxt; GEMM_ADVANCE(); first = false;
    }
}
DI void phase_mg2(KP p, int l, unsigned char* smem) {
    const int tid = TIDX(), wid = tid >> 6, lane = tid & 63, wr = wid >> 1, wc = wid & 1, fr = lane & 15, fq = lane >> 4;
    int* s_cnt = (int*)(smem + 65536 + 64); int* s_tb = s_cnt + 32; int* s_rb = s_tb + 33;
    moe_prefix(p, l, s_cnt, s_tb, s_rb);
    const bf16_t* H = (const bf16_t*)(p->ws + WS_H); const int* list = (const int*)(p->ws + WS_LIST); const float* slotw = (const float*)(p->ws + WS_SLOTW);
    bf16_t* YS = (bf16_t*)(p->ws + WS_YS);
    const int ntiles = s_tb[32] * 8;
    struct TI { int e, rt, nt, cnt_e; };
    auto decode = [&](int i, TI& t) -> bool {
        const int tile = xcd_seq(i, ntiles); if (tile < 0) return false;
        const int rtg = tile >> 3; t.nt = tile & 7;
        int e = 0;
        for (int q = 1; q < 32; ++q) if (rtg >= s_tb[q]) e = q;
        t.e = e; t.rt = rtg - s_tb[e]; t.cnt_e = s_cnt[e]; return true; };
    auto rows = [&](const TI& t, const bf16_t* (&a)[4], const bf16_t* (&b)[4]) {
        gemm_rows(H, s_rb[t.e] + t.rt * 128, 512, tid, a);
        gemm_rows((const bf16_t*)(p->ws + WS_WD) + (size_t)(l * 32 + t.e) * 1024 * 512, t.nt * 128, 512, tid, b); };
    TI cur, nxt;
    if (!decode(0, cur)) return;
    const bf16_t* ap[4]; const bf16_t* bp[4]; const bf16_t* apn[4]; const bf16_t* bpn[4];
    rows(cur, ap, bp);
    bool first = true;
    for (int i = 0;; ++i) {
        nxt = cur; const bool hn = decode(i + 1, nxt);
        rows(nxt, apn, bpn);
        f32x4 acc[4][4];
        gemm_tile<true>(smem, ap, bp, 512, acc, first, hn, apn, bpn);
#pragma unroll
        for (int m = 0; m < 4; ++m) {
            const int pos = cur.rt * 128 + wr * 64 + m * 16 + fr;
            if (pos < cur.cnt_e) {
                const int slot = list[(size_t)cur.e * NSLOT + pos]; const float w = slotw[slot];
                bf16_t* o = YS + (size_t)slot * 1024 + cur.nt * 128 + wc * 64 + fq * 4;
#pragma unroll
                for (int n = 0; n < 4; ++n) { const f32x4 v = acc[m][n] * w; u32x2 ww; ww.x = pk2(v[0], v[1]); ww.y = pk2(v[2], v[3]); *(u32x2*)(o + n * 16) = ww; }
            }
        }
        if (!hn) break;
        cur = nxt; GEMM_ADVANCE(); first = false;
    }
}

template <bool DRY>
DI void phase_ln2(KP p, int l) {
    const int tid = TIDX(), wave = tid >> 6, lane = tid & 63;
    const xres_t* X = (const xres_t*)(p->ws + WS_X); xres_t* Xo = (xres_t*)(p->ws + (DRY ? WS_OB : WS_X)); const bf16_t* YS = (const bf16_t*)(p->ws + WS_YS); bf16_t* U = (bf16_t*)(p->ws + (DRY ? WS_Y : WS_U));
    const float* MOD = (const float*)(p->ws + WS_MOD);
    const float* lng = p->in[8] + l * 1024; const float* lnb = p->in[9] + l * 1024;
    const int rows_total = (l == 3) ? ML : MT;
    for (int row0 = (BIDX() * 4 + wave) * 2; row0 < rows_total; row0 += gridDim.x * 8) {
        f32x4 v[2][4]; float s[2] = {0.f, 0.f};
        const float* mod[2];
#pragma unroll
        for (int q = 0; q < 2; ++q) {
            const int row = row0 + q; const int r = row < ML ? (row >> 11) : 8;
            mod[q] = MOD + (size_t)(l * 9 + r) * 6144;
#pragma unroll
            for (int j = 0; j < 4; ++j) {
                const int k = 256 * j + 4 * lane;
                const u32x2 y0 = *(const u32x2*)(YS + (size_t)(2 * row) * 1024 + k), y1 = *(const u32x2*)(YS + (size_t)(2 * row + 1) * 1024 + k);
                f32x4 y; y[0] = bflo(y0.x) + bflo(y1.x); y[1] = bfhi(y0.x) + bfhi(y1.x); y[2] = bflo(y0.y) + bflo(y1.y); y[3] = bfhi(y0.y) + bfhi(y1.y);
                const f32x4 xv = xload(X + (size_t)row * 1024 + k), g2 = *(const f32x4*)(mod[q] + 5120 + k);
                v[q][j] = xv * ALPHA + g2 * y; s[q] += (v[q][j][0] + v[q][j][1]) + (v[q][j][2] + v[q][j][3]);
            }
        }
        float mean[2], rstd[2];
#pragma unroll
        for (int q = 0; q < 2; ++q) mean[q] = wave_sum(s[q]) * (1.0f / 1024.0f);
#pragma unroll
        for (int q = 0; q < 2; ++q) {
            float s2 = 0.f;
#pragma unroll
            for (int j = 0; j < 4; ++j) { v[q][j] = v[q][j] - mean[q]; s2 += (v[q][j][0] * v[q][j][0] + v[q][j][1] * v[q][j][1]) + (v[q][j][2] * v[q][j][2] + v[q][j][3] * v[q][j][3]); }
            s[q] = s2;
        }
#pragma unroll
        for (int q = 0; q < 2; ++q) rstd[q] = 1.0f / sqrtf(wave_sum(s[q]) * (1.0f / 1024.0f) + LN_EPS);
#pragma unroll
        for (int q = 0; q < 2; ++q) {
            const int row = row0 + q;
            const float* modn = mod[q] + (l + 1 < 4 ? 9 * 6144 : 0);
#pragma unroll
            for (int j = 0; j < 4; ++j) {
                const int k = 256 * j + 4 * lane;
                const f32x4 xn = v[q][j] * rstd[q] * *(const f32x4*)(lng + k) + *(const f32x4*)(lnb + k);
                if (l < 3) {
                    xstore(Xo + (size_t)row * 1024 + k, xn);
                    const f32x4 uu = xn * (1.0f + *(const f32x4*)(modn + 1024 + k)) + *(const f32x4*)(modn + k);
                    u32x2 w; w.x = pk2(uu[0], uu[1]); w.y = pk2(uu[2], uu[3]);
                    *(u32x2*)(U + (size_t)row * 1024 + k) = w;
                } else {
                    *(f32x4*)(p->out + (size_t)row * 1024 + k) = xn;
                }
            }
        }
    }
}

DI s16x4 tr_read(const unsigned char* ptr) {
    typedef short v4i16_t __attribute__((ext_vector_type(4)));
    return __builtin_bit_cast(s16x4, __builtin_amdgcn_ds_read_tr16_b64_v4i16((LAS v4i16_t*)ptr));
}
DI bf16x8 cat8(s16x4 a, s16x4 b) { return __builtin_shufflevector(a, b, 0, 1, 2, 3, 4, 5, 6, 7); }

DI void phase_decay(KP p, int l, unsigned char* smem) {
    const int tid = TIDX();
    const int li = l >> 1;
    const float* LR = (const float*)(p->ws + WS_LR);
    float* PF = (float*)(p->ws + WS_PF); float* SQ = (float*)(p->ws + WS_SQ); float* SK = (float*)(p->ws + WS_SK); float* TOT = (float*)(p->ws + WS_TOT);
    float* lrs = (float*)smem;
    float wf[16], wb[16];
#pragma unroll
    for (int r = 0; r < 16; ++r) { wf[r] = p->in[11][(size_t)li * 16 * 256 + r * 256 + tid]; wb[r] = p->in[13][(size_t)li * 16 * 256 + r * 256 + tid]; }
    const float bf = p->in[12][li * 256 + tid], bb = p->in[14][li * 256 + tid];
    for (int it = BIDX(); it < 2 * (MT / 64); it += gridDim.x) {
        const int ch = it >> 1, dr = it & 1;
        const int row0 = ch * 64;
        __syncthreads();
        { const int tok = tid >> 2, q4 = tid & 3; *(f32x4*)(lrs + tok * 16 + q4 * 4) = *(const f32x4*)(LR + (size_t)(row0 + tok) * 32 + dr * 16 + q4 * 4); }
        __syncthreads();
        float run = 0.f;
        if (dr == 0) {
            for (int t = 0; t < 64; ++t) {
                float g = bf;
#pragma unroll
                for (int r = 0; r < 16; ++r) g += lrs[t * 16 + r] * wf[r];
                run += (fminf(g, 0.f) - __logf(1.0f + __expf(-fabsf(g)))) * (1.0f / 16.0f);
                PF[(size_t)(row0 + t) * 256 + tid] = run;
            }
        } else {
            for (int t = 63; t >= 0; --t) {
                float g = bb;
#pragma unroll
                for (int r = 0; r < 16; ++r) g += lrs[t * 16 + r] * wb[r];
                SQ[(size_t)(row0 + t) * 256 + tid] = run;
                run += (fminf(g, 0.f) - __logf(1.0f + __expf(-fabsf(g)))) * (1.0f / 16.0f);
                SK[(size_t)(row0 + t) * 256 + tid] = run;
            }
        }
        TOT[(size_t)(ch * 2 + dr) * 256 + tid] = run;
    }
}

template <int DK>
DI void scan_item(KP p, int l, int item, unsigned char* smem) {
    constexpr bool ISA = (DK == 128);
    constexpr int QS = DK * 2 + 16, KS = DK * 2 + 32, VS = 96, AS_ = 144, SS = DK * 2 + 16, NKS = DK / 32, NMT = DK / 64;
    constexpr int O_QD = 0, O_KD = O_QD + 64 * QS, O_V = O_KD + 64 * KS, O_ATT = O_V + 64 * VS, O_ST = O_ATT + 64 * AS_, O_END = O_ST + 32 * SS;
    static_assert(O_END <= 65536, "scan LDS");
    constexpr int NP = DK / 64 * 2;
    constexpr int CPR = DK / 8;
    const int tid = TIDX(), wid = tid >> 6, lane = tid & 63, fr = lane & 15, fq = lane >> 4;
    const int b = item >> 5, h = (item >> 3) & 3, dir = (item >> 2) & 1, dvq = item & 3;
    const bf16_t* Z = (const bf16_t*)(p->ws + WS_Z);
    const float* EQ = (const float*)(p->ws + (dir ? WS_SQ : WS_PF)); const float* EK = (const float*)(p->ws + (dir ? WS_SK : WS_PF)); const float* TOT = (const float*)(p->ws + WS_TOT);
    bf16_t* OUT = (bf16_t*)(p->ws + (dir ? WS_OB : WS_OF));
    const int qcol = ISA ? h * 128 : 2048 + h * 64, kcol = ISA ? 512 + h * 128 : 2304 + h * 64, vcol = (ISA ? 1024 : 2560) + h * 128 + dvq * 32;
    const int ocol = (ISA ? 0 : 512) + h * 128 + dvq * 32;
    float lam = 0.f;
    if (ISA) lam = log1pf(-exp2f(-((dir ? 5.5f : 5.0f) + (float)h)));
    f32x4 S[NMT][2];
#pragma unroll
    for (int a = 0; a < NMT; ++a) { S[a][0] = (f32x4){0.f, 0.f, 0.f, 0.f}; S[a][1] = (f32x4){0.f, 0.f, 0.f, 0.f}; }
    __syncthreads();
    for (int i = tid; i < 32 * SS / 4; i += 256) ((unsigned*)(smem + O_ST))[i] = 0u;
    auto chunk_row0 = [&](int cc) -> int {
        const int ci = dir ? 35 - cc : cc; const int pp = ci * 64;
        if (!dir) return pp < 256 ? ML + b * 256 + pp : b * 2048 + (pp - 256);
        return pp < 2048 ? b * 2048 + pp : ML + b * 256 + (pp - 2048);
    };
    u32x4 rq[NP], rk[NP], rv; f32x4 eq[ISA ? 1 : NP][2], ek[ISA ? 1 : NP][2]; f32x4 tv[NMT];
    auto fetch = [&](int cc) {
        const int row0 = chunk_row0(cc);
        if (!ISA) {
#pragma unroll
            for (int a = 0; a < NMT; ++a) tv[a] = *(const f32x4*)(TOT + (size_t)((row0 >> 6) * 2 + dir) * 256 + h * 64 + (wid * NMT + a) * 16 + fq * 4);
        }
#pragma unroll
        for (int i = 0; i < NP; ++i) {
            const int id = tid + 256 * i, tok = id / CPR, cg_ = id % CPR;
            const size_t ro = (size_t)(row0 + tok) * ZS;
            rq[i] = *(const u32x4*)(Z + ro + qcol + cg_ * 8); rk[i] = *(const u32x4*)(Z + ro + kcol + cg_ * 8);
            if (!ISA) {
                const size_t eo = (size_t)(row0 + tok) * 256 + h * 64 + cg_ * 8;
                eq[i][0] = *(const f32x4*)(EQ + eo); eq[i][1] = *(const f32x4*)(EQ + eo + 4);
                ek[i][0] = *(const f32x4*)(EK + eo); ek[i][1] = *(const f32x4*)(EK + eo + 4);
            }
        }
        { const int tok = tid >> 2, cg_ = tid & 3; rv = *(const u32x4*)(Z + (size_t)(row0 + tok) * ZS + vcol + cg_ * 8); }
    };
    float ra[NP], rc[NP];
#pragma unroll
    for (int i = 0; i < NP; ++i) {
        const int tok = (tid + 256 * i) / CPR;
        ra[i] = dir ? __expf(lam * (float)(63 - tok)) : __expf(lam * (float)(tok + 1));
        rc[i] = dir ? __expf(-lam * (float)(64 - tok)) : __expf(-lam * (float)(tok + 1));
    }
    const float decA = __expf(lam * 64.0f);
    fetch(0);
    for (int cc = 0; cc < 36; ++cc) {
        const int row0 = chunk_row0(cc);
#pragma unroll
        for (int i = 0; i < NP; ++i) {
            const int id = tid + 256 * i, tok = id / CPR, cg_ = id % CPR;
            float fqv[8], fkv[8];
            if (ISA) {
#pragma unroll
                for (int e = 0; e < 8; ++e) { fqv[e] = ra[i]; fkv[e] = rc[i]; }
            } else {
#pragma unroll
                for (int e = 0; e < 8; ++e) { fqv[e] = __expf(eq[i][e >> 2][e & 3]); fkv[e] = __expf(-ek[i][e >> 2][e & 3]); }
            }
            const u32x4 q = rq[i], k = rk[i]; u32x4 qo, ko;
            qo.x = pk2(bflo(q.x) * fqv[0], bfhi(q.x) * fqv[1]); qo.y = pk2(bflo(q.y) * fqv[2], bfhi(q.y) * fqv[3]); qo.z = pk2(bflo(q.z) * fqv[4], bfhi(q.z) * fqv[5]); qo.w = pk2(bflo(q.w) * fqv[6], bfhi(q.w) * fqv[7]);
            ko.x = pk2(bflo(k.x) * fkv[0], bfhi(k.x) * fkv[1]); ko.y = pk2(bflo(k.y) * fkv[2], bfhi(k.y) * fkv[3]); ko.z = pk2(bflo(k.z) * fkv[4], bfhi(k.z) * fkv[5]); ko.w = pk2(bflo(k.w) * fkv[6], bfhi(k.w) * fkv[7]);
            *(u32x4*)(smem + O_QD + tok * QS + cg_ * 16) = qo;
            *(u32x4*)(smem + O_KD + tok * KS + cg_ * 16) = ko;
        }
        { const int tok = tid >> 2, cg_ = tid & 3; *(u32x4*)(smem + O_V + tok * VS + cg_ * 16) = rv; }
        f32x4 dec[NMT];
#pragma unroll
        for (int a = 0; a < NMT; ++a) {
            if (ISA) dec[a] = (f32x4){decA, decA, decA, decA};
            else dec[a] = (f32x4){__expf(tv[a][0]), __expf(tv[a][1]), __expf(tv[a][2]), __expf(tv[a][3])};
        }
        if (cc + 1 < 36) fetch(cc + 1);
        __syncthreads();
        bf16x8 afr[2];
        {
            f32x4 at[4];
#pragma unroll
            for (int n = 0; n < 4; ++n) at[n] = (f32x4){0.f, 0.f, 0.f, 0.f};
#pragma unroll
            for (int ks = 0; ks < NKS; ++ks) {
                const bf16x8 qf = *(const bf16x8*)(smem + O_QD + (16 * wid + fr) * QS + (32 * ks + 8 * fq) * 2);
#pragma unroll
                for (int n = 0; n < 4; ++n) {
                    const bf16x8 kf = *(const bf16x8*)(smem + O_KD + (16 * n + fr) * KS + (32 * ks + 8 * fq) * 2);
                    at[n] = __builtin_amdgcn_mfma_f32_16x16x32_bf16(kf, qf, at[n], 0, 0, 0);
                }
            }
            const int i = 16 * wid + fr;
#pragma unroll
            for (int n = 0; n < 4; ++n)
#pragma unroll
                for (int jj = 0; jj < 4; ++jj) { const int j = n * 16 + fq * 4 + jj; const bool keep = dir ? (j > i) : (j <= i); at[n][jj] = keep ? at[n][jj] : 0.f; }
#pragma unroll
            for (int ks = 0; ks < 2; ++ks) {
                u32x4 w; w.x = pk2(at[2 * ks][0], at[2 * ks][1]); w.y = pk2(at[2 * ks][2], at[2 * ks][3]); w.z = pk2(at[2 * ks + 1][0], at[2 * ks + 1][1]); w.w = pk2(at[2 * ks + 1][2], at[2 * ks + 1][3]);
                afr[ks] = __builtin_bit_cast(bf16x8, w);
            }
        }
        bf16x8 vf[2][2];
        {
            const int g = lane >> 4, i16 = lane & 15, q = i16 >> 2, pq = i16 & 3;
#pragma unroll
            for (int ks = 0; ks < 2; ++ks)
#pragma unroll
                for (int n = 0; n < 2; ++n) {
                    const unsigned char* a = smem + O_V + (32 * ks + 4 * g + q) * VS + (n * 16 + 4 * pq) * 2;
                    vf[ks][n] = cat8(tr_read(a), tr_read(a + 16 * VS));
                }
        }
        {
            f32x4 oa[2] = {(f32x4){0.f, 0.f, 0.f, 0.f}, (f32x4){0.f, 0.f, 0.f, 0.f}};
#pragma unroll
            for (int ks = 0; ks < 2; ++ks)
#pragma unroll
                for (int n = 0; n < 2; ++n) oa[n] = __builtin_amdgcn_mfma_f32_16x16x32_bf16(vf[ks][n], afr[ks], oa[n], 0, 0, 0);
#pragma unroll
            for (int ks = 0; ks < NKS; ++ks) {
                const bf16x8 qf = *(const bf16x8*)(smem + O_QD + (16 * wid + fr) * QS + (32 * ks + 8 * fq) * 2);
#pragma unroll
                for (int n = 0; n < 2; ++n) {
                    const bf16x8 sf = *(const bf16x8*)(smem + O_ST + (16 * n + fr) * SS + (32 * ks + 8 * fq) * 2);
                    oa[n] = __builtin_amdgcn_mfma_f32_16x16x32_bf16(sf, qf, oa[n], 0, 0, 0);
                }
            }
            bf16_t* o = OUT + (size_t)(row0 + 16 * wid + fr) * 1024 + ocol + fq * 4;
            u32x2 w0, w1; w0.x = pk2(oa[0][0], oa[0][1]); w0.y = pk2(oa[0][2], oa[0][3]); w1.x = pk2(oa[1][0], oa[1][1]); w1.y = pk2(oa[1][2], oa[1][3]);
            *(u32x2*)(o) = w0; *(u32x2*)(o + 16) = w1;
        }
        {
            const int g = lane >> 4, i16 = lane & 15, q = i16 >> 2, pq = i16 & 3;
#pragma unroll
            for (int a = 0; a < NMT; ++a) {
                const int mt = wid * NMT + a;
#pragma unroll
                for (int ks = 0; ks < 2; ++ks) {
                    const unsigned char* ka = smem + O_KD + (32 * ks + 4 * g + q) * KS + (mt * 16 + 4 * pq) * 2;
                    const bf16x8 kf = cat8(tr_read(ka), tr_read(ka + 16 * KS));
#pragma unroll
                    for (int n = 0; n < 2; ++n) S[a][n] = __builtin_amdgcn_mfma_f32_16x16x32_bf16(kf, vf[ks][n], S[a][n], 0, 0, 0);
                }
                S[a][0] *= dec[a]; S[a][1] *= dec[a];
            }
        }
        __syncthreads();
#pragma unroll
        for (int a = 0; a < NMT; ++a) {
            const int mt = wid * NMT + a;
#pragma unroll
            for (int n = 0; n < 2; ++n) { u32x2 w; w.x = pk2(S[a][n][0], S[a][n][1]); w.y = pk2(S[a][n][2], S[a][n][3]); *(u32x2*)(smem + O_ST + (n * 16 + fr) * SS + (mt * 16 + fq * 4) * 2) = w; }
        }
    }
    __syncthreads();
}
DI void phase_scan(KP p, int l, unsigned char* smem) {
    for (int it = BIDX(); it < 512; it += gridDim.x) {
        if (it < 256) scan_item<128>(p, l, it, smem); else scan_item<64>(p, l, it - 256, smem);
    }
}

DI void phase_merge(KP p, int l) {
    const int tid = TIDX(), wave = tid >> 6, lane = tid & 63;
    const int li = l >> 1;
    const bf16_t* OF = (const bf16_t*)(p->ws + WS_OF); const bf16_t* OB = (const bf16_t*)(p->ws + WS_OB);
    const bf16_t* Z = (const bf16_t*)(p->ws + WS_Z); bf16_t* Y = (bf16_t*)(p->ws + WS_Y);
    const bool isA = lane < 32;
    const float* gn = isA ? p->in[15] + li * 512 + lane * 16 : p->in[16] + li * 512 + (lane - 32) * 16;
    const int gcol = isA ? 1536 + lane * 16 : 3072 + (lane - 32) * 16;
    for (int row = BIDX() * 4 + wave; row < MT; row += gridDim.x * 4) {
        float o[16]; float s = 0.f;
#pragma unroll
        for (int j = 0; j < 2; ++j) {
            const u32x4 a = *(const u32x4*)(OF + (size_t)row * 1024 + lane * 16 + j * 8), bb = *(const u32x4*)(OB + (size_t)row * 1024 + lane * 16 + j * 8);
            o[j * 8 + 0] = bflo(a.x) + bflo(bb.x); o[j * 8 + 1] = bfhi(a.x) + bfhi(bb.x); o[j * 8 + 2] = bflo(a.y) + bflo(bb.y); o[j * 8 + 3] = bfhi(a.y) + bfhi(bb.y);
            o[j * 8 + 4] = bflo(a.z) + bflo(bb.z); o[j * 8 + 5] = bfhi(a.z) + bfhi(bb.z); o[j * 8 + 6] = bflo(a.w) + bflo(bb.w); o[j * 8 + 7] = bfhi(a.w) + bfhi(bb.w);
        }
#pragma unroll
        for (int e = 0; e < 16; ++e) s += o[e];
        s += __shfl_xor(s, 1); s += __shfl_xor(s, 2); s += __shfl_xor(s, 4);
        const float mean = isA ? s * (1.0f / 128.0f) : 0.f;
        float s2 = 0.f;
#pragma unroll
        for (int e = 0; e < 16; ++e) { o[e] -= mean; s2 += o[e] * o[e]; }
        s2 += __shfl_xor(s2, 1); s2 += __shfl_xor(s2, 2); s2 += __shfl_xor(s2, 4);
        const float rs = 1.0f / sqrtf(s2 * (1.0f / 128.0f) + LN_EPS);
        const u32x4 g0 = *(const u32x4*)(Z + (size_t)row * ZS + gcol), g1 = *(const u32x4*)(Z + (size_t)row * ZS + gcol + 8);
        float gt[16];
        gt[0] = bflo(g0.x); gt[1] = bfhi(g0.x); gt[2] = bflo(g0.y); gt[3] = bfhi(g0.y); gt[4] = bflo(g0.z); gt[5] = bfhi(g0.z); gt[6] = bflo(g0.w); gt[7] = bfhi(g0.w);
        gt[8] = bflo(g1.x); gt[9] = bfhi(g1.x); gt[10] = bflo(g1.y); gt[11] = bfhi(g1.y); gt[12] = bflo(g1.z); gt[13] = bfhi(g1.z); gt[14] = bflo(g1.w); gt[15] = bfhi(g1.w);
        float y[16];
#pragma unroll
        for (int e = 0; e < 16; ++e) y[e] = siluf(gt[e]) * (o[e] * rs * gn[e]);
        u32x4 w0, w1;
        w0.x = pk2(y[0], y[1]); w0.y = pk2(y[2], y[3]); w0.z = pk2(y[4], y[5]); w0.w = pk2(y[6], y[7]);
        w1.x = pk2(y[8], y[9]); w1.y = pk2(y[10], y[11]); w1.z = pk2(y[12], y[13]); w1.w = pk2(y[14], y[15]);
        *(u32x4*)(Y + (size_t)row * 1024 + lane * 16) = w0; *(u32x4*)(Y + (size_t)row * 1024 + lane * 16 + 8) = w1;
    }
}

DI int crow(int r, int hi) { return (r & 3) + 8 * (r >> 2) + 4 * hi; }
constexpr int ATT_BUF = 24576;
DI void att_component(const bf16_t* Qc, const bf16_t* Kc, const bf16_t* Vt, unsigned char* smem, float* wsf, int b, int h, int comp, int p0, int nkv, f32x16 (&O)[4]) {
    const int tid = TIDX(), wid = tid >> 6, lane = tid & 63, r32 = lane & 31, hi = lane >> 5;
    const int hc = h * 2 + comp;
    const bf16_t* Qb = Qc + ((size_t)(b * 16 + hc) * TA + p0 + wid * 32 + r32) * 64;
    const int gch = gemm_chunk(tid);
    const bf16_t* Kg = Kc + (size_t)(b * 16 + hc) * TA * 64 + (size_t)(tid >> 3) * 64 + gch * 8;
    const bf16_t* Vg = Vt + (size_t)(b * 8 + h) * 128 * TA + (size_t)(tid >> 3) * TA + gch * 8;
#define ATT_STAGE(buf, kt) do { \
        _Pragma("unroll") for (int i_ = 0; i_ < 2; ++i_) __builtin_amdgcn_global_load_lds((const unsigned*)(Kg + (size_t)((kt) + 32 * i_) * 64), (LAS unsigned*)(smem + (buf) * ATT_BUF + i_ * 4096 + tid * 16), 16, 0, 0); \
        _Pragma("unroll") for (int i_ = 0; i_ < 4; ++i_) __builtin_amdgcn_global_load_lds((const unsigned*)(Vg + (size_t)(32 * i_) * TA + (kt)), (LAS unsigned*)(smem + (buf) * ATT_BUF + 8192 + i_ * 4096 + tid * 16), 16, 0, 0); } while (0)
    ATT_STAGE(0, 0);
    bf16x8 qf[4];
#pragma unroll
    for (int ks = 0; ks < 4; ++ks) qf[ks] = *(const bf16x8*)(Qb + ks * 16 + hi * 8);
#pragma unroll
    for (int d0 = 0; d0 < 4; ++d0)
#pragma unroll
        for (int r = 0; r < 16; ++r) O[d0][r] = 0.f;
    float m_run = -1.0e30f, l_run = 0.f;
    const int sw = (r32 >> 1) & 7;
    const int nt = nkv >> 6;
    for (int t = 0; t < nt; ++t) {
        asm volatile("s_waitcnt vmcnt(0)" ::: "memory");
        __syncthreads();
        if (t + 1 < nt) ATT_STAGE((t + 1) & 1, (t + 1) * 64);
        const unsigned char* Kt = smem + (t & 1) * ATT_BUF; const unsigned char* Vtl = Kt + 8192;
        bf16x8 kf0[4], kf1[4];
#pragma unroll
        for (int ks = 0; ks < 4; ++ks) {
            const unsigned co = (unsigned)(((ks * 2 + hi) ^ sw) << 4);
            kf0[ks] = *(const bf16x8*)(Kt + r32 * 128 + co);
            kf1[ks] = *(const bf16x8*)(Kt + (32 + r32) * 128 + co);
        }
        const unsigned char* vr = Vtl + r32 * 128;
#define ATT_VLOAD(dst, st_) do { const unsigned o1_ = (unsigned)((((st_) * 2 + hi) ^ sw) << 4); \
        _Pragma("unroll") for (int d0_ = 0; d0_ < 4; ++d0_) dst[d0_] = *(const bf16x8*)(vr + d0_ * 4096 + o1_); } while (0)
        bf16x8 va[4], vb[4];
        ATT_VLOAD(va, 0);
        f32x16 s0, s1;
#pragma unroll
        for (int r = 0; r < 16; ++r) { s0[r] = 0.f; s1[r] = 0.f; }
#pragma unroll
        for (int ks = 0; ks < 4; ++ks) {
            s0 = __builtin_amdgcn_mfma_f32_32x32x16_bf16(kf0[ks], qf[ks], s0, 0, 0, 0);
            s1 = __builtin_amdgcn_mfma_f32_32x32x16_bf16(kf1[ks], qf[ks], s1, 0, 0, 0);
        }
        float mxa[8];
#pragma unroll
        for (int i_ = 0; i_ < 8; ++i_) mxa[i_] = fmaxf(fmaxf(s0[2 * i_], s0[2 * i_ + 1]), fmaxf(s1[2 * i_], s1[2 * i_ + 1]));
        float mx = fmaxf(fmaxf(fmaxf(mxa[0], mxa[1]), fmaxf(mxa[2], mxa[3])), fmaxf(fmaxf(mxa[4], mxa[5]), fmaxf(mxa[6], mxa[7])));
        mx = fmaxf(mx, __shfl_xor(mx, 32));
        if (__any(mx > m_run + 8.0f)) {
            const float m_new = fmaxf(m_run, mx);
            const float alpha = __builtin_amdgcn_exp2f((m_run - m_new) * L2E);
            l_run *= alpha; m_run = m_new;
            if (hi == 0) wsf[r32] = alpha;
            asm volatile("s_waitcnt lgkmcnt(0)" ::: "memory");
            float ar[16];
#pragma unroll
            for (int r = 0; r < 16; ++r) ar[r] = wsf[crow(r, hi)];
#pragma unroll
            for (int d0 = 0; d0 < 4; ++d0)
#pragma unroll
                for (int r = 0; r < 16; ++r) O[d0][r] *= ar[r];
            asm volatile("s_waitcnt lgkmcnt(0)" ::: "memory");
        }
        const float mb = m_run * L2E;
        float ps = 0.f;
#pragma unroll
        for (int r = 0; r < 16; ++r) { s0[r] = __builtin_amdgcn_exp2f(s0[r] * L2E - mb); s1[r] = __builtin_amdgcn_exp2f(s1[r] * L2E - mb); ps += s0[r] + s1[r]; }
        l_run += ps;
        u32x4 pw[4];
#pragma unroll
        for (int s = 0; s < 2; ++s) {
            pw[s].x = pk2(s0[8 * s + 0], s0[8 * s + 1]); pw[s].y = pk2(s0[8 * s + 2], s0[8 * s + 3]); pw[s].z = pk2(s0[8 * s + 4], s0[8 * s + 5]); pw[s].w = pk2(s0[8 * s + 6], s0[8 * s + 7]);
            pw[2 + s].x = pk2(s1[8 * s + 0], s1[8 * s + 1]); pw[2 + s].y = pk2(s1[8 * s + 2], s1[8 * s + 3]); pw[2 + s].z = pk2(s1[8 * s + 4], s1[8 * s + 5]); pw[2 + s].w = pk2(s1[8 * s + 6], s1[8 * s + 7]);
        }
#pragma unroll
        ATT_VLOAD(vb, 1);
#pragma unroll
        for (int d0 = 0; d0 < 4; ++d0) O[d0] = __builtin_amdgcn_mfma_f32_32x32x16_bf16(__builtin_bit_cast(bf16x8, pw[0]), va[d0], O[d0], 0, 0, 0);
        ATT_VLOAD(va, 2);
#pragma unroll
        for (int d0 = 0; d0 < 4; ++d0) O[d0] = __builtin_amdgcn_mfma_f32_32x32x16_bf16(__builtin_bit_cast(bf16x8, pw[1]), vb[d0], O[d0], 0, 0, 0);
        ATT_VLOAD(vb, 3);
#pragma unroll
        for (int d0 = 0; d0 < 4; ++d0) O[d0] = __builtin_amdgcn_mfma_f32_32x32x16_bf16(__builtin_bit_cast(bf16x8, pw[2]), va[d0], O[d0], 0, 0, 0);
#pragma unroll
        for (int d0 = 0; d0 < 4; ++d0) O[d0] = __builtin_amdgcn_mfma_f32_32x32x16_bf16(__builtin_bit_cast(bf16x8, pw[3]), vb[d0], O[d0], 0, 0, 0);
#undef ATT_VLOAD
    }
#undef ATT_STAGE
    l_run += __shfl_xor(l_run, 32);
    asm volatile("s_waitcnt lgkmcnt(0)" ::: "memory");
    if (hi == 0) wsf[r32] = 1.0f / l_run;
    asm volatile("s_waitcnt lgkmcnt(0)" ::: "memory");
    float ar[16];
#pragma unroll
    for (int r = 0; r < 16; ++r) ar[r] = wsf[crow(r, hi)];
    asm volatile("s_waitcnt lgkmcnt(0)" ::: "memory");
#pragma unroll
    for (int d0 = 0; d0 < 4; ++d0)
#pragma unroll
        for (int r = 0; r < 16; ++r) O[d0][r] *= ar[r];
}

DI void phase_att(KP p, int l, unsigned char* smem) {
    constexpr int O_WS = 2 * ATT_BUF;
    const int tid = TIDX(), wid = tid >> 6, lane = tid & 63, r32 = lane & 31, hi = lane >> 5;
    const int li = l >> 1;
    const bf16_t* Qc = (const bf16_t*)(p->ws + WS_QC); const bf16_t* Kc = (const bf16_t*)(p->ws + WS_KC); const bf16_t* Vt = (const bf16_t*)(p->ws + WS_VT);
    bf16_t* Y = (bf16_t*)(p->ws + WS_Y);
    float* stash = (float*)(p->ws + WS_P) + ((size_t)BIDX() * 256 + tid) * 64;
    const float lam_init = 0.8f - 0.6f * expf(-0.3f * (float)l);
    float* wsf = (float*)(smem + O_WS) + wid * 32;
    const int per_x = (l == 3) ? 128 : 144;
    for (int i = 0;; ++i) {
        int b, h, p0, nkv;
        {
            const int G = gridDim.x, bid = BIDX();
            int item;
            if ((G & 7) == 0) { const int x = bid & 7, q = i * (G >> 3) + (bid >> 3); if (q >= per_x) break; item = q < 128 ? x * 128 + q : 1024 + x * 16 + (q - 128); }
            else { item = i * G + bid; if (item >= 8 * per_x) break; }
            if (item < 1024) { b = item >> 7; h = (item >> 4) & 7; p0 = 256 + (item & 15) * 128; nkv = TA; }
            else { const int q = item - 1024; b = q >> 4; h = (q >> 1) & 7; p0 = (q & 1) * 128; nkv = TC; }
        }
        float d1 = 0.f, d2 = 0.f;
        { const float* lq1 = p->in[19] + (li * 8 + h) * 64, *lk1 = p->in[20] + (li * 8 + h) * 64, *lq2 = p->in[21] + (li * 8 + h) * 64, *lk2 = p->in[22] + (li * 8 + h) * 64;
          d1 = wave_sum(lq1[lane] * lk1[lane]); d2 = wave_sum(lq2[lane] * lk2[lane]); }
        const float lamv = expf(d1) - expf(d2) + lam_init;
        f32x16 On[4];
        __syncthreads();
        att_component(Qc, Kc, Vt, smem, wsf, b, h, 0, p0, nkv, On);
#pragma unroll
        for (int d0 = 0; d0 < 4; ++d0)
#pragma unroll
            for (int r = 0; r < 16; r += 4) *(f32x4*)(stash + d0 * 16 + r) = (f32x4){On[d0][r], On[d0][r + 1], On[d0][r + 2], On[d0][r + 3]};
        __syncthreads();
        att_component(Qc, Kc, Vt, smem, wsf, b, h, 1, p0, nkv, On);
#pragma unroll
        for (int d0 = 0; d0 < 4; ++d0)
#pragma unroll
            for (int r = 0; r < 16; r += 4) {
                const f32x4 sv = *(const f32x4*)(stash + d0 * 16 + r);
                On[d0][r] = sv[0] - lamv * On[d0][r]; On[d0][r + 1] = sv[1] - lamv * On[d0][r + 1]; On[d0][r + 2] = sv[2] - lamv * On[d0][r + 2]; On[d0][r + 3] = sv[3] - lamv * On[d0][r + 3];
            }
        float ms[16];
#pragma unroll
        for (int r = 0; r < 16; ++r) {
            float s = (On[0][r] * On[0][r] + On[1][r] * On[1][r]) + (On[2][r] * On[2][r] + On[3][r] * On[3][r]);
            s += __shfl_xor(s, 1); s += __shfl_xor(s, 2); s += __shfl_xor(s, 4); s += __shfl_xor(s, 8); s += __shfl_xor(s, 16);
            ms[r] = __builtin_amdgcn_rsqf(s * (1.0f / 128.0f) + LN_EPS);
        }
        const float* sg = p->in[23] + li * 1024 + h * 128;
        const float post = 1.0f - lam_init;
        float gsc[4];
#pragma unroll
        for (int d0 = 0; d0 < 4; ++d0) gsc[d0] = sg[d0 * 32 + r32] * post;
        __syncthreads();
        unsigned char* stg = smem + wid * 8192;
#pragma unroll
        for (int r = 0; r < 16; ++r) {
            unsigned char* sp = stg + crow(r, hi) * 256 + r32 * 2;
#pragma unroll
            for (int d0 = 0; d0 < 4; ++d0) *(unsigned short*)(sp + d0 * 64) = (unsigned short)f2bf(On[d0][r] * ms[r] * gsc[d0]);
        }
        asm volatile("s_waitcnt lgkmcnt(0)" ::: "memory");
#pragma unroll
        for (int i2 = 0; i2 < 8; ++i2) {
            const int id = lane + 64 * i2, qr = id >> 4, ch = id & 15;
            const int pq = p0 + wid * 32 + qr;
            const int row = pq < 256 ? ML + b * 256 + pq : b * 2048 + (pq - 256);
            *(u32x4*)(Y + (size_t)row * 1024 + h * 128 + ch * 8) = *(const u32x4*)(stg + qr * 256 + ch * 16);
        }
        asm volatile("s_waitcnt lgkmcnt(0)" ::: "memory");
    }
}

#define XB_TMO      128
#define XB_XCNT(j)  (256  + 64 * (j))
#define XB_XSUB(j)  (1280 + 64 * (j))
#define XB_XGEN(j)  (2304 + 64 * (j))
#define XB_TOP      3328
#define XB_TOPGEN   3392
#define XCD_BAR_WORDS 3456
#define XB_SPIN_CAP (1u << 22)
DI unsigned xb_ld(unsigned* p)              { return __hip_atomic_load(p, __ATOMIC_RELAXED, __HIP_MEMORY_SCOPE_AGENT); }
DI unsigned xb_add(unsigned* p, unsigned v) { return __hip_atomic_fetch_add(p, v, __ATOMIC_RELAXED, __HIP_MEMORY_SCOPE_AGENT); }
DI unsigned xb_xcc_id() { return (unsigned)__builtin_amdgcn_s_getreg((3 << 11) | 20) & 0xFu; }
#define XB_SPIN(cond, bar) do { unsigned _sp = 0; while (cond) { __builtin_amdgcn_s_sleep(1); \
    if ((++_sp & 255u) == 0u) { if (xb_ld(&(bar)[XB_TMO])) break; if (_sp > XB_SPIN_CAP) { atomicAdd(&(bar)[XB_TMO], 1u); break; } } } } while (0)
struct XcdBarrier { unsigned* bar; unsigned x; volatile LAS unsigned* st; };
DI XcdBarrier xcd_barrier_post(unsigned* bar, volatile LAS unsigned* st) {
    XcdBarrier b; b.bar = bar; b.x = xb_xcc_id(); b.st = st;
    if (threadIdx.x == 0) (void)xb_add(&bar[XB_XCNT(b.x)], 1u);
    return b;
}
DI void xcd_barrier_complete(unsigned* bar, unsigned x, unsigned& nloc, unsigned& nx) {
    const unsigned G = gridDim.x * gridDim.y * gridDim.z;
    unsigned sum, cnt, mine, sp = 0u;
    for (;;) {
        sum = 0u; cnt = 0u; mine = 0u;
#pragma unroll
        for (unsigned j = 0; j < 16; ++j) { const unsigned c = xb_ld(&bar[XB_XCNT(j)]); sum += c; cnt += (c > 0u) ? 1u : 0u; mine = (j == x) ? c : mine; }
        if (sum == G) break;
        __builtin_amdgcn_s_sleep(1);
        if ((++sp & 255u) == 0u) { if (xb_ld(&bar[XB_TMO])) break; if (sp > XB_SPIN_CAP) { atomicAdd(&bar[XB_TMO], 1u); break; } }
    }
    nloc = mine > 0u ? mine : 1u; nx = cnt > 0u ? cnt : 1u;
}
DI void xcd_barrier(const XcdBarrier& b) {
    asm volatile("s_waitcnt vmcnt(0)" ::: "memory");
    __syncthreads();
    if (threadIdx.x == 0) {
        unsigned* bar = b.bar;
        __builtin_amdgcn_s_waitcnt(0);
        unsigned nloc = b.st[0], nx = b.st[1];
        if (nloc == 0u) { xcd_barrier_complete(bar, b.x, nloc, nx); b.st[0] = nloc; b.st[1] = nx; }
        const unsigned old = xb_add(&bar[XB_XSUB(b.x)], 1u);
        const unsigned gen = old / nloc;
        if (old + 1u == (gen + 1u) * nloc) {
            __builtin_amdgcn_fence(__ATOMIC_RELEASE, "agent");
            asm volatile("s_waitcnt vmcnt(0)" ::: "memory");
            const unsigned og = xb_add(&bar[XB_TOP], 1u);
            const unsigned tg = og / nx;
            if (og + 1u == (tg + 1u) * nx) xb_add(&bar[XB_TOPGEN], 1u);
            else XB_SPIN(xb_ld(&bar[XB_TOPGEN]) == tg, bar);
            __builtin_amdgcn_fence(__ATOMIC_ACQUIRE, "agent");
            xb_add(&bar[XB_XGEN(b.x)], 1u);
            asm volatile("s_waitcnt vmcnt(0)" ::: "memory");
        } else {
            XB_SPIN(xb_ld(&bar[XB_XGEN(b.x)]) == gen, bar);
            __builtin_amdgcn_fence(__ATOMIC_ACQUIRE, "agent");
            asm volatile("s_waitcnt vmcnt(0)" ::: "memory");
        }
    }
    __syncthreads();
}

#ifdef DOUBLE_MASK
#define DRYCOND (rep_ == 0 && nrep_ == 2)
#else
#define DRYCOND false
#endif
constexpr int NPHASE = 34;
constexpr int LDS_BYTES = 65536 + 1024;
__global__ void __launch_bounds__(256, 2) mega(Params pv) {
    extern __shared__ __attribute__((aligned(16))) unsigned char smem[];
    const int ph_lo = pv.ph_lo, ph_hi = pv.ph_hi;
    volatile LAS unsigned* bar_st = (volatile LAS unsigned*)(LAS unsigned char*)(smem + 65536);
    if (threadIdx.x == 0) { bar_st[0] = 0u; bar_st[1] = 0u; }
    __syncthreads();
    XcdBarrier xbar = xcd_barrier_post((unsigned*)(pv.ws + WS_CTL) + 4096, bar_st);
    for (int ph = ph_lo; ph < ph_hi; ++ph) {
        KP p = (KP)__builtin_amdgcn_kernarg_segment_ptr();
        asm volatile("" : "+s"(p) :: "memory");
#ifdef DOUBLE_MASK
        int kind_;
        if (ph == 0) kind_ = 0; else if (ph == 1) kind_ = 1;
        else { const int rem_ = (ph - 2) % 16; kind_ = rem_ == 0 ? 2 : (rem_ == 1 ? 12 : (rem_ < 9 ? rem_ + 1 : (rem_ == 9 ? 10 : (rem_ == 10 ? 11 : (rem_ - 11 + 5))))); }
        const int nrep_ = ((DOUBLE_MASK >> kind_) & 1) ? 2 : 1;
        for (int rep_ = 0; rep_ < nrep_; ++rep_) {
        if (rep_) xcd_barrier(xbar);
#endif
        if (ph == 0) phase_pre0(p, smem);
        else if (ph == 1) phase_pre1(p);
        else {
            const int q = ph - 2, lp = q / 16, rem = q % 16;
            if (rem < 9) {
                const int l = 2 * lp;
                switch (rem) {
                    case 0: phase_g1e(p, l, smem); break;
                    case 1: phase_decay(p, l, smem); break;
                    case 2: phase_scan(p, l, smem); break;
                    case 3: phase_merge(p, l); break;
                    case 4: phase_g2(p, l, smem); break;
                    case 5: if (DRYCOND) phase_ln1r<true>(p, l, smem); else phase_ln1r<false>(p, l, smem); break;
                    case 6: phase_mg1(p, l, smem); break;
                    case 7: phase_mg2(p, l, smem); break;
                    default: if (DRYCOND) phase_ln2<true>(p, l); else phase_ln2<false>(p, l); break;
                }
            } else {
                const int l = 2 * lp + 1;
                switch (rem - 9) {
                    case 0: phase_g1o(p, l, smem); break;
                    case 1: phase_att(p, l, smem); break;
                    case 2: phase_g2(p, l, smem); break;
                    case 3: if (DRYCOND) phase_ln1r<true>(p, l, smem); else phase_ln1r<false>(p, l, smem); break;
                    case 4: phase_mg1(p, l, smem); break;
                    case 5: phase_mg2(p, l, smem); break;
                    default: if (DRYCOND) phase_ln2<true>(p, l); else phase_ln2<false>(p, l); break;
                }
            }
        }
#ifdef DOUBLE_MASK
        }
#endif
        if (ph + 1 < ph_hi) xcd_barrier(xbar);
    }
}

extern "C" void kernel_launch(void* const* d_in, const int* in_sizes, int n_in, void* d_out, int out_size, void* d_ws, size_t ws_size, hipStream_t stream) {
    static int grid_blocks = 0;
    if (grid_blocks == 0) {
        if (n_in != 32 || ws_size < WS_END) { fprintf(stderr, "kernel_launch: unexpected n_in %d or ws_size %zu\n", n_in, ws_size); grid_blocks = -1; return; }
        int dev = 0, cus = 0, per_cu = 0;
        hipGetDevice(&dev);
        hipDeviceGetAttribute(&cus, hipDeviceAttributeMultiprocessorCount, dev);
        hipFuncSetAttribute((const void*)mega, hipFuncAttributeMaxDynamicSharedMemorySize, LDS_BYTES);
        hipOccupancyMaxActiveBlocksPerMultiprocessor(&per_cu, mega, 256, LDS_BYTES);
        if (per_cu > 2) per_cu = 2;
        if (per_cu < 1) per_cu = 1;
        grid_blocks = cus * per_cu;
    }
    if (grid_blocks < 0) return;
    hipMemsetAsync((char*)d_ws + WS_CTL, 0, 1 * MiB, stream);
    Params p{};
    for (int i = 0; i < 32; ++i) p.in[i] = (const float*)d_in[i];
    p.out = (float*)d_out; p.ws = (unsigned char*)d_ws;
#if N_LAUNCH_MODE == 1
    p.ph_lo = 0; p.ph_hi = NPHASE;
    void* args[] = {&p};
    hipError_t e = hipLaunchCooperativeKernel((void*)mega, dim3(grid_blocks), dim3(256), args, LDS_BYTES, stream);
    if (e != hipSuccess) fprintf(stderr, "cooperative launch failed: %s (grid %d)\n", hipGetErrorString(e), grid_blocks);
#else
    for (int ph = 0; ph < NPHASE; ++ph) {
        p.ph_lo = ph; p.ph_hi = ph + 1;
        hipLaunchKernelGGL(mega, dim3(grid_blocks), dim3(256), LDS_BYTES, stream, p);
    }
#endif
}
```

```cpp
#include <hip/hip_runtime.h>
#include <hip/hip_cooperative_groups.h>
#include <cstdio>
#include <cstdint>
namespace cg = cooperative_groups;

#ifndef N_LAUNCH_MODE
#define N_LAUNCH_MODE 1
#endif

#define DI __device__ __forceinline__
#define LAS __attribute__((address_space(3)))
typedef unsigned short bf16_t;
typedef short bf16x8 __attribute__((ext_vector_type(8)));
typedef short s16x4 __attribute__((ext_vector_type(4)));
typedef float f32x4 __attribute__((ext_vector_type(4)));
typedef float f32x16 __attribute__((ext_vector_type(16)));
typedef unsigned u32x4 __attribute__((ext_vector_type(4)));
typedef unsigned u32x2 __attribute__((ext_vector_type(2)));

constexpr int D = 1024, NB = 8, T = 2048, TC = 256, TA = T + TC;
constexpr int ML = NB * T, MC = NB * TC, MT = ML + MC;
constexpr int NIN = 3616, NINP = 3712, ZS = 3712;
constexpr int NSLOT = 2 * MT;
constexpr float LN_EPS = 1e-5f;
constexpr float ALPHA = 1.6817928305074290f;
constexpr float L2E = 1.4426950408889634f;

constexpr size_t MiB = 1ull << 20;
constexpr size_t WS_CTL = 0;
constexpr size_t WS_MOD = 1 * MiB;
constexpr size_t WS_ROPEA = 2 * MiB;
constexpr size_t WS_ROPEC = 3 * MiB;
constexpr size_t WS_LR = 4 * MiB;
constexpr size_t WS_SLOTW = 7 * MiB;
constexpr size_t WS_LIST = 8 * MiB;
constexpr size_t WS_WRT = 13 * MiB;
constexpr size_t WS_WIN = 16 * MiB;
constexpr size_t WS_WABO = 32 * MiB;
constexpr size_t WS_WQKV = 36 * MiB;
constexpr size_t WS_WCO = 48 * MiB;
constexpr size_t WS_WGU = 64 * MiB;
constexpr size_t WS_WD = 320 * MiB;
constexpr size_t WS_X = 448 * MiB;
constexpr size_t WS_U = 520 * MiB;
constexpr size_t WS_Y = 556 * MiB;
constexpr size_t WS_Z = 592 * MiB;
constexpr size_t WS_O = 724 * MiB;
constexpr size_t WS_PF = 868 * MiB, WS_SQ = 886 * MiB, WS_SK = 904 * MiB, WS_TOT = 922 * MiB;
constexpr size_t WS_END = 923 * MiB;
constexpr size_t WS_QC = WS_Z, WS_KC = WS_Z + 36 * MiB, WS_VT = WS_Z + 72 * MiB;
constexpr size_t WS_YS = WS_Z;
constexpr size_t WS_OF = WS_O, WS_OB = WS_O + 72 * MiB, WS_P = WS_O, WS_H = WS_O + 72 * MiB;

#ifndef XBF16
#define XBF16 0
#endif
#if XBF16
typedef bf16_t xres_t;
#else
typedef float xres_t;
#endif
struct Params { const float* in[32]; float* out; unsigned char* ws; int ph_lo, ph_hi; };
typedef const __attribute__((address_space(4))) Params* KP;

DI int TIDX() { int t = threadIdx.x; asm volatile("" : "+v"(t)); return t; }
DI int BIDX() { int b = blockIdx.x; asm volatile("" : "+s"(b)); return b; }
DI unsigned pk2(float lo, float hi);
DI unsigned f2bf(float f) { return pk2(f, 0.f) & 0xffffu; }
typedef float f32x2_t __attribute__((ext_vector_type(2))); typedef __bf16 bf16x2_t __attribute__((ext_vector_type(2)));
DI unsigned pk2(float lo, float hi) { f32x2_t v = {lo, hi}; bf16x2_t b = __builtin_convertvector(v, bf16x2_t); return __builtin_bit_cast(unsigned, b); }
DI float bflo(unsigned w) { return __uint_as_float(w << 16); }
DI float bfhi(unsigned w) { return __uint_as_float(w & 0xffff0000u); }
DI f32x4 xload(const xres_t* p) {
#if XBF16
    const u32x2 w = *(const u32x2*)p; return (f32x4){bflo(w.x), bfhi(w.x), bflo(w.y), bfhi(w.y)};
#else
    return *(const f32x4*)p;
#endif
}
DI void xstore(xres_t* p, f32x4 v) {
#if XBF16
    u32x2 w; w.x = pk2(v[0], v[1]); w.y = pk2(v[2], v[3]); *(u32x2*)p = w;
#else
    *(f32x4*)p = v;
#endif
}
DI float wave_sum(float v) {
#pragma unroll
    for (int o = 1; o < 64; o <<= 1) v += __shfl_xor(v, o);
    return v;
}
DI float siluf(float v) { return v * __builtin_amdgcn_rcpf(1.0f + __expf(-v)); }

DI int gemm_chunk(int tid) { return (tid & 7) ^ ((tid >> 4) & 7); }
template <bool TRN>
DI void gemm_tile(unsigned char* shm, const bf16_t* const (&ap)[4], const bf16_t* const (&bp)[4], int K, f32x4 (&acc)[4][4],
                  bool first, bool has_next, const bf16_t* const (&apn)[4], const bf16_t* const (&bpn)[4]) {
    const int tid = TIDX(), wid = tid >> 6, lane = tid & 63, wr = wid >> 1, wc = wid & 1, fr = lane & 15, fq = lane >> 4;
#pragma unroll
    for (int m = 0; m < 4; ++m)
#pragma unroll
        for (int n = 0; n < 4; ++n) acc[m][n] = (f32x4){0.f, 0.f, 0.f, 0.f};
    const int nt = K >> 6;
    const int sw = fr >> 1;
    const unsigned aoff = (unsigned)((wr * 64 + fr) * 128), boff = (unsigned)(16384 + (wc * 64 + fr) * 128);
#define GEMM_STAGE(buf, A_, B_, t) do { _Pragma("unroll") for (int i_ = 0; i_ < 4; ++i_) { \
        __builtin_amdgcn_global_load_lds((const unsigned*)(A_[i_] + (t) * 64), (LAS unsigned*)(shm + (buf) * 32768 + i_ * 4096 + tid * 16), 16, 0, 0); \
        __builtin_amdgcn_global_load_lds((const unsigned*)(B_[i_] + (t) * 64), (LAS unsigned*)(shm + (buf) * 32768 + 16384 + i_ * 4096 + tid * 16), 16, 0, 0); } } while (0)
    if (first) {
        GEMM_STAGE(0, ap, bp, 0);
        asm volatile("s_waitcnt vmcnt(0)" ::: "memory");
        __syncthreads();
    }
    for (int t = 0; t < nt; ++t) {
        const int cur = t & 1;
        if (t + 1 < nt) GEMM_STAGE(cur ^ 1, ap, bp, t + 1);
        else if (has_next) GEMM_STAGE(cur ^ 1, apn, bpn, 0);
        const unsigned char* base = shm + cur * 32768;
        bf16x8 At[2][4], Bt[2][4];
#pragma unroll
        for (int ks = 0; ks < 2; ++ks) {
            const unsigned co = (unsigned)(((ks * 4 + fq) ^ sw) << 4);
#pragma unroll
            for (int m = 0; m < 4; ++m) At[ks][m] = *(const bf16x8*)(base + aoff + m * 2048 + co);
#pragma unroll
            for (int n = 0; n < 4; ++n) Bt[ks][n] = *(const bf16x8*)(base + boff + n * 2048 + co);
        }
        __builtin_amdgcn_s_setprio(1);
#pragma unroll
        for (int ks = 0; ks < 2; ++ks)
#pragma unroll
            for (int m = 0; m < 4; ++m)
#pragma unroll
                for (int n = 0; n < 4; ++n)
                    acc[m][n] = TRN ? __builtin_amdgcn_mfma_f32_16x16x32_bf16(Bt[ks][n], At[ks][m], acc[m][n], 0, 0, 0)
                                    : __builtin_amdgcn_mfma_f32_16x16x32_bf16(At[ks][m], Bt[ks][n], acc[m][n], 0, 0, 0);
        __builtin_amdgcn_s_setprio(0);
        asm volatile("s_waitcnt vmcnt(0)" ::: "memory");
        __syncthreads();
    }
#undef GEMM_STAGE
}
#define GEMM_ADVANCE() do { _Pragma("unroll") for (int k_ = 0; k_ < 4; ++k_) { ap[k_] = apn[k_]; bp[k_] = bpn[k_]; } } while (0)
DI void gemm_rows(const bf16_t* base, int r0, int ld, int tid, const bf16_t* (&pp)[4]) {
    const bf16_t* q = base + (size_t)(r0 + (tid >> 3)) * ld + gemm_chunk(tid) * 8;
#pragma unroll
    for (int i = 0; i < 4; ++i) pp[i] = q + (size_t)(32 * i) * ld;
}
DI bool tile_seq(int q, int nrt, int nct, int& rt, int& ct) {
    if (q >= nrt * nct) return false;
    const int band = q / (8 * nct), rem = q - band * 8 * nct;
    const int rows = (nrt - band * 8) < 8 ? (nrt - band * 8) : 8;
    ct = rem / rows; rt = band * 8 + rem % rows;
    return true;
}
DI int xcd_seq(int i, int total) {
    const int G = gridDim.x, bid = BIDX();
    if ((G & 7) != 0) { const int q = i * G + bid; return q < total ? q : -1; }
    const int x = bid & 7, j = bid >> 3, per = (total + 7) >> 3, gx = G >> 3;
    const int q = i * gx + j;
    if (q >= per) return -1;
    const int g = x * per + q;
    return g < total ? g : -1;
}

template <int MODE>
DI void tr_item(const float* W, int K, int N, bf16_t* WT, float* scr, int item, int lane) {
    const int nblk = N / 32, kb = item / nblk, nb = item % nblk, k0 = 64 * kb, n0 = 32 * nb;
    float wv[32];
#pragma unroll
    for (int i = 0; i < 32; ++i) wv[i] = W[(size_t)(k0 + 2 * i + (lane >> 5)) * N + n0 + (lane & 31)];
#pragma unroll
    for (int i = 0; i < 32; ++i) scr[(2 * i + (lane >> 5)) * 33 + (lane & 31)] = wv[i];
    asm volatile("s_waitcnt lgkmcnt(0)" ::: "memory");
    const int c = lane & 7;
#pragma unroll
    for (int j = 0; j < 4; ++j) {
        const int n = (lane >> 3) + 8 * j; const float* s = scr + (8 * c) * 33 + n;
        u32x4 o; o.x = pk2(s[0 * 33], s[1 * 33]); o.y = pk2(s[2 * 33], s[3 * 33]); o.z = pk2(s[4 * 33], s[5 * 33]); o.w = pk2(s[6 * 33], s[7 * 33]);
        const int nn = n0 + n;
        const int drow = (MODE == 0) ? nn : ((nn >> 4) * 32 + (nn & 15) + (MODE == 2 ? 16 : 0));
        *(u32x4*)(WT + (size_t)drow * K + k0 + 8 * c) = o;
    }
    asm volatile("s_waitcnt lgkmcnt(0)" ::: "memory");
}

DI void phase_pre0(KP p, unsigned char* smem) {
    const int tid = TIDX(), wave = tid >> 6, lane = tid & 63;
    unsigned char* ws = p->ws;
    {
        float* s_sc = (float*)smem;
        float* s_red = s_sc + 9 * 1024;
        const float* c = p->in[1]; const float* cc = p->in[3];
        for (int i = tid; i < 9 * 1024; i += 256) { const int r = i >> 10, k = i & 1023; const float v = r < 8 ? c[r * 1024 + k] : cc[k]; s_sc[i] = v / (1.0f + expf(-v)); }
        __syncthreads();
        float* MOD = (float*)(ws + WS_MOD);
        for (int item = BIDX(); item < 384; item += gridDim.x) {
            const int l = item / 96, n0 = (item % 96) * 64;
            const float* W = p->in[4] + (size_t)l * 1024 * 6144 + n0 + lane;
            float acc[9];
#pragma unroll
            for (int r = 0; r < 9; ++r) acc[r] = 0.f;
#pragma unroll 16
            for (int k = wave * 256; k < wave * 256 + 256; ++k) {
                const float w = W[(size_t)k * 6144];
#pragma unroll
                for (int r = 0; r < 9; ++r) acc[r] += s_sc[r * 1024 + k] * w;
            }
#pragma unroll
            for (int r = 0; r < 9; ++r) s_red[(wave * 9 + r) * 64 + lane] = acc[r];
            __syncthreads();
            for (int i = tid; i < 9 * 64; i += 256) {
                const int r = i >> 6, ln = i & 63;
                const float v = s_red[(0 * 9 + r) * 64 + ln] + s_red[(1 * 9 + r) * 64 + ln] + s_red[(2 * 9 + r) * 64 + ln] + s_red[(3 * 9 + r) * 64 + ln];
                MOD[(size_t)(l * 9 + r) * 6144 + n0 + ln] = v + p->in[5][l * 6144 + n0 + ln];
            }
            __syncthreads();
        }
    }
    {
        const int gt = BIDX() * 256 + tid, NT = gridDim.x * 256;
        float* ca = (float*)(ws + WS_ROPEA); float* sa = ca + 2048 * 64;
        for (int i = gt; i < 2048 * 64; i += NT) {
            const int t = i >> 6, f = i & 63; const int pos = f < 32 ? (t >> 6) : (t & 63); const int ff = f & 31;
            const float inv = powf(10000.0f, -(float)ff / 32.0f); const float a = (float)pos * inv;
            ca[i] = cosf(a); sa[i] = sinf(a);
        }
        float* cc_ = (float*)(ws + WS_ROPEC); float* sc_ = cc_ + 2048 * 32;
        for (int i = gt; i < 2048 * 32; i += NT) {
            const int t = i >> 5, f = i & 31; const int pos = f < 16 ? (t >> 6) : (t & 63); const int ff = f & 15;
            const float inv = powf(10000.0f, -(float)ff / 16.0f); const float a = (float)pos * inv;
            cc_[i] = cosf(a); sc_[i] = sinf(a);
        }
        float* wrt = (float*)(ws + WS_WRT);
        for (int i = gt; i < 4 * 36 * 1024; i += NT) {
            const int l = i / (36 * 1024), o = (i / 1024) % 36, k = i & 1023;
            wrt[i] = o < 4 ? p->in[25][((size_t)l * 1024 + k) * 4 + o] : p->in[27][((size_t)l * 1024 + k) * 32 + (o - 4)];
        }
        unsigned* wpad = (unsigned*)(ws + WS_WIN);
        for (int i = gt; i < 2 * 96 * 512; i += NT) { const int li = i / (96 * 512), r = i % (96 * 512); wpad[((size_t)li * NINP + NIN) * 512 + r] = 0u; }
    }
    __syncthreads();
    {
        float* scr = (float*)smem + wave * (64 * 33);
        constexpr int I_IN = 16 * 113, I_SQ = 16 * 32, I_QKV = 16 * 96, I_E = 256;
        constexpr int R0 = 2 * I_IN, R1 = R0 + 2 * I_SQ, R2 = R1 + 2 * I_QKV, R3 = R2 + 2 * I_SQ, R4 = R3 + 128 * I_E, R5 = R4 + 128 * I_E, R6 = R5 + 128 * I_E;
        for (int it = BIDX() * 4 + wave; it < R6; it += gridDim.x * 4) {
            if (it < R0) { const int i = it / I_IN, r = it % I_IN; tr_item<0>(p->in[10] + (size_t)i * 1024 * NIN, 1024, NIN, (bf16_t*)(ws + WS_WIN) + (size_t)i * NINP * 1024, scr, r, lane); }
            else if (it < R1) { const int q = it - R0, i = q / I_SQ, r = q % I_SQ; tr_item<0>(p->in[17] + (size_t)i * 1024 * 1024, 1024, 1024, (bf16_t*)(ws + WS_WABO) + (size_t)i * 1024 * 1024, scr, r, lane); }
            else if (it < R2) { const int q = it - R1, i = q / I_QKV, r = q % I_QKV; tr_item<0>(p->in[18] + (size_t)i * 1024 * 3072, 1024, 3072, (bf16_t*)(ws + WS_WQKV) + (size_t)i * 3072 * 1024, scr, r, lane); }
            else if (it < R3) { const int q = it - R2, i = q / I_SQ, r = q % I_SQ; tr_item<0>(p->in[24] + (size_t)i * 1024 * 1024, 1024, 1024, (bf16_t*)(ws + WS_WCO) + (size_t)i * 1024 * 1024, scr, r, lane); }
            else if (it < R4) { const int q = it - R3, le = q / I_E, r = q % I_E; tr_item<1>(p->in[29] + (size_t)le * 1024 * 512, 1024, 512, (bf16_t*)(ws + WS_WGU) + (size_t)le * 1024 * 1024, scr, r, lane); }
            else if (it < R5) { const int q = it - R4, le = q / I_E, r = q % I_E; tr_item<2>(p->in[30] + (size_t)le * 1024 * 512, 1024, 512, (bf16_t*)(ws + WS_WGU) + (size_t)le * 1024 * 1024, scr, r, lane); }
            else { const int q = it - R5, le = q / I_E, r = q % I_E; tr_item<0>(p->in[31] + (size_t)le * 512 * 1024, 512, 1024, (bf16_t*)(ws + WS_WD) + (size_t)le * 1024 * 512, scr, r, lane); }
        }
    }
}

DI void phase_pre1(KP p) {
    const int tid = TIDX(), wave = tid >> 6, lane = tid & 63;
    xres_t* X = (xres_t*)(p->ws + WS_X); bf16_t* U = (bf16_t*)(p->ws + WS_U); const float* MOD = (const float*)(p->ws + WS_MOD);
    for (int row = BIDX() * 4 + wave; row < MT; row += gridDim.x * 4) {
        const float* src = row < ML ? p->in[0] + (size_t)row * 1024 : p->in[2] + (size_t)(row - ML) * 1024;
        const int r = row < ML ? (row >> 11) : 8;
        const float* mod = MOD + (size_t)r * 6144;
#pragma unroll
        for (int j = 0; j < 4; ++j) {
            const int k = 256 * j + 4 * lane;
            const f32x4 v = *(const f32x4*)(src + k), sh = *(const f32x4*)(mod + k), sc = *(const f32x4*)(mod + 1024 + k);
            const f32x4 u = v * (1.0f + sc) + sh;
            u32x2 w; w.x = pk2(u[0], u[1]); w.y = pk2(u[2], u[3]);
            *(u32x2*)(U + (size_t)row * 1024 + k) = w;
        }
    }
}

DI void phase_g1e(KP p, int l, unsigned char* smem) {
    const int tid = TIDX(), wid = tid >> 6, lane = tid & 63, wr = wid >> 1, wc = wid & 1, fr = lane & 15, fq = lane >> 4;
    const int li = l >> 1;
    const bf16_t* U = (const bf16_t*)(p->ws + WS_U); const bf16_t* W = (const bf16_t*)(p->ws + WS_WIN) + (size_t)li * NINP * 1024;
    bf16_t* Z = (bf16_t*)(p->ws + WS_Z); float* LR = (float*)(p->ws + WS_LR);
    const float* ca = (const float*)(p->ws + WS_ROPEA); const float* sa = ca + 2048 * 64;
    constexpr int NTN = NINP / 128;
    auto decode = [&](int i, int& brow, int& bcol) -> bool {
        const int q = xcd_seq(i, (MT / 128) * NTN); if (q < 0) return false;
        int rt, nt; tile_seq(q, MT / 128, NTN, rt, nt); brow = rt * 128; bcol = nt * 128; return true; };
    auto epi = [&](int brow, int bcol, f32x4 (&acc)[4][4]) {
        const int colw = bcol + wc * 64;
        if (colw >= NIN) return;
        if (colw >= 3584) {
#pragma unroll
            for (int m = 0; m < 4; ++m) { const int row = brow + wr * 64 + m * 16 + fr;
#pragma unroll
                for (int n = 0; n < 2; ++n) *(f32x4*)(LR + (size_t)row * 32 + n * 16 + fq * 4) = acc[m][n]; }
            return;
        }
        const bool ropeR = colw < 1024; const int half = (colw >> 6) & 1;
        const float scale = colw < 512 ? 0.08838834764831845f : ((colw >= 2048 && colw < 2304) ? 0.125f : 1.0f);
#pragma unroll
        for (int m = 0; m < 4; ++m) {
            const int row = brow + wr * 64 + m * 16 + fr;
            if (ropeR && row < ML) {
                const int t = row & 2047;
#pragma unroll
                for (int n = 0; n < 2; ++n) {
                    const f32x4 c4 = *(const f32x4*)(ca + t * 64 + half * 32 + n * 16 + fq * 4), s4 = *(const f32x4*)(sa + t * 64 + half * 32 + n * 16 + fq * 4);
                    const f32x4 a = acc[m][n], b = acc[m][n + 2];
                    acc[m][n] = a * c4 - b * s4; acc[m][n + 2] = b * c4 + a * s4;
                }
            }
#pragma unroll
            for (int n = 0; n < 4; ++n) {
                const f32x4 v = acc[m][n] * scale; u32x2 w; w.x = pk2(v[0], v[1]); w.y = pk2(v[2], v[3]);
                *(u32x2*)(Z + (size_t)row * ZS + colw + n * 16 + fq * 4) = w;
            }
        }
    };
    int brow, bcol;
    if (!decode(0, brow, bcol)) return;
    const bf16_t* ap[4]; const bf16_t* bp[4]; const bf16_t* apn[4]; const bf16_t* bpn[4];
    gemm_rows(U, brow, 1024, tid, ap); gemm_rows(W, bcol, 1024, tid, bp);
    bool first = true;
    for (int i = 0;; ++i) {
        int nbrow = brow, nbcol = bcol; const bool hn = decode(i + 1, nbrow, nbcol);
        gemm_rows(U, nbrow, 1024, tid, apn); gemm_rows(W, nbcol, 1024, tid, bpn);
        f32x4 acc[4][4];
        gemm_tile<true>(smem, ap, bp, 1024, acc, first, hn, apn, bpn);
        epi(brow, bcol, acc);
        if (!hn) break;
        brow = nbrow; bcol = nbcol; GEMM_ADVANCE(); first = false;
    }
}

DI void phase_g1o(KP p, int l, unsigned char* smem) {
    const int tid = TIDX(), wid = tid >> 6, lane = tid & 63, wr = wid >> 1, wc = wid & 1, fr = lane & 15, fq = lane >> 4;
    const int li = l >> 1;
    const bf16_t* U = (const bf16_t*)(p->ws + WS_U); const bf16_t* W = (const bf16_t*)(p->ws + WS_WQKV) + (size_t)li * 3072 * 1024;
    bf16_t* Qc = (bf16_t*)(p->ws + WS_QC); bf16_t* Kc = (bf16_t*)(p->ws + WS_KC); bf16_t* Vt = (bf16_t*)(p->ws + WS_VT);
    const float* cc = (const float*)(p->ws + WS_ROPEC); const float* sc = cc + 2048 * 32;
    auto decode = [&](int i, int& brow, int& bcol) -> bool {
        const int q = xcd_seq(i, (MT / 128) * 24); if (q < 0) return false;
        int rt, nt; tile_seq(q, MT / 128, 24, rt, nt); brow = rt * 128; bcol = nt * 128; return true; };
    int brow, bcol;
    if (!decode(0, brow, bcol)) return;
    const bf16_t* ap[4]; const bf16_t* bp[4]; const bf16_t* apn[4]; const bf16_t* bpn[4];
    gemm_rows(U, brow, 1024, tid, ap); gemm_rows(W, bcol, 1024, tid, bp);
    bool first = true;
    for (int i = 0;; ++i) {
        int nbrow = brow, nbcol = bcol; const bool hn = decode(i + 1, nbrow, nbcol);
        gemm_rows(U, nbrow, 1024, tid, apn); gemm_rows(W, nbcol, 1024, tid, bpn);
        f32x4 acc[4][4];
        if (bcol < 2048) {
            gemm_tile<true>(smem, ap, bp, 1024, acc, first, hn, apn, bpn);
            const int colw = bcol + wc * 64; const bool isk = colw >= 1024; const int hc = (colw & 1023) >> 6;
            bf16_t* dst = isk ? Kc : Qc; const float scale = isk ? 1.0f : 0.125f;
#pragma unroll
            for (int m = 0; m < 4; ++m) {
                const int row = brow + wr * 64 + m * 16 + fr;
                int b, pidx;
                if (row < ML) {
                    b = row >> 11; const int t = row & 2047; pidx = 256 + t;
#pragma unroll
                    for (int n = 0; n < 4; n += 2) {
                        const f32x4 c4 = *(const f32x4*)(cc + t * 32 + (n >> 1) * 16 + fq * 4), s4 = *(const f32x4*)(sc + t * 32 + (n >> 1) * 16 + fq * 4);
                        const f32x4 a = acc[m][n], bb = acc[m][n + 1];
                        acc[m][n] = a * c4 - bb * s4; acc[m][n + 1] = bb * c4 + a * s4;
                    }
                } else { b = (row - ML) >> 8; pidx = (row - ML) & 255; }
                bf16_t* o = dst + ((size_t)(b * 16 + hc) * TA + pidx) * 64;
#pragma unroll
                for (int n = 0; n < 4; ++n) { const f32x4 v = acc[m][n] * scale; u32x2 w; w.x = pk2(v[0], v[1]); w.y = pk2(v[2], v[3]); *(u32x2*)(o + n * 16 + fq * 4) = w; }
            }
        } else {
            gemm_tile<false>(smem, ap, bp, 1024, acc, first, hn, apn, bpn);
#pragma unroll
            for (int m = 0; m < 4; ++m) {
                const int row = brow + wr * 64 + m * 16 + fq * 4;
                int b, pidx;
                if (row < ML) { b = row >> 11; pidx = 256 + (row & 2047); } else { b = (row - ML) >> 8; pidx = (row - ML) & 255; }
                const int ppos = (pidx & ~12) | ((pidx & 8) >> 1) | ((pidx & 4) << 1);
#pragma unroll
                for (int n = 0; n < 4; ++n) {
                    const int col = bcol - 2048 + wc * 64 + n * 16 + fr; const int h = col >> 7, d = col & 127;
                    const f32x4 v = acc[m][n]; u32x2 w; w.x = pk2(v[0], v[1]); w.y = pk2(v[2], v[3]);
                    *(u32x2*)(Vt + ((size_t)(b * 8 + h) * 128 + d) * TA + ppos) = w;
                }
            }
        }
        if (!hn) break;
        brow = nbrow; bcol = nbcol; GEMM_ADVANCE(); first = false;
    }
}

DI void phase_g2(KP p, int l, unsigned char* smem) {
    const int tid = TIDX(), wid = tid >> 6, lane = tid & 63, wr = wid >> 1, wc = wid & 1, fr = lane & 15, fq = lane >> 4;
    const int li = l >> 1;
    const bf16_t* Y = (const bf16_t*)(p->ws + WS_Y);
    const bf16_t* W = (const bf16_t*)(p->ws + ((l & 1) ? WS_WCO : WS_WABO)) + (size_t)li * 1024 * 1024;
    bf16_t* P = (bf16_t*)(p->ws + WS_P);
    const int nrt = (l == 3 ? ML : MT) / 128;
    auto decode = [&](int i, int& brow, int& bcol) -> bool {
        const int q = xcd_seq(i, nrt * 8); if (q < 0) return false;
        int rt, nt; tile_seq(q, nrt, 8, rt, nt); brow = rt * 128; bcol = nt * 128; return true; };
    int brow, bcol;
    if (!decode(0, brow, bcol)) return;
    const bf16_t* ap[4]; const bf16_t* bp[4]; const bf16_t* apn[4]; const bf16_t* bpn[4];
    gemm_rows(Y, brow, 1024, tid, ap); gemm_rows(W, bcol, 1024, tid, bp);
    bool first = true;
    for (int i = 0;; ++i) {
        int nbrow = brow, nbcol = bcol; const bool hn = decode(i + 1, nbrow, nbcol);
        gemm_rows(Y, nbrow, 1024, tid, apn); gemm_rows(W, nbcol, 1024, tid, bpn);
        f32x4 acc[4][4];
        gemm_tile<true>(smem, ap, bp, 1024, acc, first, hn, apn, bpn);
#pragma unroll
        for (int m = 0; m < 4; ++m) { const int row = brow + wr * 64 + m * 16 + fr;
#pragma unroll
            for (int n = 0; n < 4; ++n) { const f32x4 v = acc[m][n]; u32x2 w; w.x = pk2(v[0], v[1]); w.y = pk2(v[2], v[3]); *(u32x2*)(P + (size_t)row * 1024 + bcol + wc * 64 + n * 16 + fq * 4) = w; } }
        if (!hn) break;
        brow = nbrow; bcol = nbcol; GEMM_ADVANCE(); first = false;
    }
}

template <bool DRY>
DI void phase_ln1r(KP p, int l, unsigned char* smem) {
    constexpr int US = 1028;
    constexpr int RB = 12;
    float* Us = (float*)smem;
    float* Ps = Us + RB * US;
    const int tid = TIDX(), wave = tid >> 6, lane = tid & 63;
    const xres_t* X = (const xres_t*)(p->ws + WS_X); xres_t* Xo = (xres_t*)(p->ws + (DRY ? WS_OB : WS_X)); const bf16_t* P = (const bf16_t*)(p->ws + WS_P); bf16_t* U = (bf16_t*)(p->ws + (DRY ? WS_Y : WS_U));
    const float* MOD = (const float*)(p->ws + WS_MOD); const float* WrT = (const float*)(p->ws + WS_WRT) + (size_t)l * 36 * 1024;
    const float* lng = p->in[6] + l * 1024; const float* lnb = p->in[7] + l * 1024;
    const float* bgrp = p->in[26] + l * 4; const float* brex = p->in[28] + l * 32;
    unsigned* cnt = (unsigned*)(p->ws + WS_CTL) + l * 32 + (DRY ? 256 : 0); int* list = (int*)(p->ws + WS_LIST); float* slotw = (float*)(p->ws + WS_SLOTW);
    const int rows_total = (l == 3) ? ML : MT;
    const int mi = lane & 15, mq = lane >> 4;
    int pend_slot = -1, pend_e = 0; unsigned pend_pos = 0u;
    for (int it = BIDX(); it * RB < rows_total; it += gridDim.x) {
        const int row0 = it * RB + wave * 3;
#pragma unroll
        for (int rr = 0; rr < 3; ++rr) {
            const int rowr = row0 + rr; const bool rvalid = rowr < rows_total; const int row = rvalid ? rowr : rows_total - 1;
            const int r = row < ML ? (row >> 11) : 8;
            const float* mod = MOD + (size_t)(l * 9 + r) * 6144;
            f32x4 v[4]; float s = 0.f;
#pragma unroll
            for (int j = 0; j < 4; ++j) {
                const int k = 256 * j + 4 * lane;
                const f32x4 xv = (l == 0) ? *(const f32x4*)((row < ML ? p->in[0] + (size_t)row * 1024 : p->in[2] + (size_t)(row - ML) * 1024) + k) : xload(X + (size_t)row * 1024 + k);
                const f32x4 g1 = *(const f32x4*)(mod + 2048 + k);
                const u32x2 pw_ = *(const u32x2*)(P + (size_t)row * 1024 + k); const f32x4 pv = (f32x4){bflo(pw_.x), bfhi(pw_.x), bflo(pw_.y), bfhi(pw_.y)};
                v[j] = xv * ALPHA + g1 * pv; s += (v[j][0] + v[j][1]) + (v[j][2] + v[j][3]);
            }
            const float mean = wave_sum(s) * (1.0f / 1024.0f); float s2 = 0.f;
#pragma unroll
            for (int j = 0; j < 4; ++j) { v[j] = v[j] - mean; s2 += (v[j][0] * v[j][0] + v[j][1] * v[j][1]) + (v[j][2] * v[j][2] + v[j][3] * v[j][3]); }
            const float rstd = 1.0f / sqrtf(wave_sum(s2) * (1.0f / 1024.0f) + LN_EPS);
#pragma unroll
            for (int j = 0; j < 4; ++j) {
                const int k = 256 * j + 4 * lane;
                const f32x4 xn = v[j] * rstd * *(const f32x4*)(lng + k) + *(const f32x4*)(lnb + k);
                const f32x4 uu = xn * (1.0f + *(const f32x4*)(mod + 4096 + k)) + *(const f32x4*)(mod + 3072 + k);
                *(f32x4*)(Us + (wave * 3 + rr) * US + k) = uu;
                if (rvalid) {
                    xstore(Xo + (size_t)row * 1024 + k, xn);
                    u32x2 w; w.x = pk2(uu[0], uu[1]); w.y = pk2(uu[2], uu[3]);
                    *(u32x2*)(U + (size_t)row * 1024 + k) = w;
                }
            }
        }
        __syncthreads();
        {
            f32x4 acc[3] = {(f32x4){0.f, 0.f, 0.f, 0.f}, (f32x4){0.f, 0.f, 0.f, 0.f}, (f32x4){0.f, 0.f, 0.f, 0.f}};
            const float* ap = Us + (mi < RB ? mi : mi - RB) * US + 256 * wave + 4 * mq;
            const float* bp0 = WrT + (size_t)mi * 1024 + 256 * wave + 4 * mq;
            const float* bp1 = WrT + (size_t)(16 + mi) * 1024 + 256 * wave + 4 * mq;
            const float* bp2 = WrT + (size_t)(32 + (mi & 3)) * 1024 + 256 * wave + 4 * mq;
#pragma unroll 4
            for (int sb = 0; sb < 16; ++sb) {
                const f32x4 a = *(const f32x4*)(ap + 16 * sb);
                const f32x4 b0 = *(const f32x4*)(bp0 + 16 * sb), b1 = *(const f32x4*)(bp1 + 16 * sb), b2 = *(const f32x4*)(bp2 + 16 * sb);
#pragma unroll
                for (int e = 0; e < 4; ++e) {
                    acc[0] = __builtin_amdgcn_mfma_f32_16x16x4f32(a[e], b0[e], acc[0], 0, 0, 0);
                    acc[1] = __builtin_amdgcn_mfma_f32_16x16x4f32(a[e], b1[e], acc[1], 0, 0, 0);
                    acc[2] = __builtin_amdgcn_mfma_f32_16x16x4f32(a[e], b2[e], acc[2], 0, 0, 0);
                }
            }
            if (mq < 3) {
#pragma unroll
                for (int nt = 0; nt < 3; ++nt)
#pragma unroll
                    for (int rg = 0; rg < 4; ++rg) Ps[(wave * RB + mq * 4 + rg) * 48 + nt * 16 + mi] = acc[nt][rg];
            }
        }
        __syncthreads();
        if (wave < 2) {
            const int r = wave * 8 + (lane >> 3), c = lane & 7;
            const int rq = r < RB ? r : RB - 1;
            const int row = it * RB + rq;
            float lgv[5];
#pragma unroll
            for (int k = 0; k < 5; ++k) {
                const int o = c + 8 * k; const int oo = o < 36 ? o : 35;
                lgv[k] = (Ps[(0 * RB + rq) * 48 + oo] + Ps[(1 * RB + rq) * 48 + oo]) + (Ps[(2 * RB + rq) * 48 + oo] + Ps[(3 * RB + rq) * 48 + oo]);
            }
            float gv = c < 4 ? lgv[0] + bgrp[c & 3] : -3.0e38f; int gi = c;
#pragma unroll
            for (int off = 1; off < 4; off <<= 1) {
                const float ov = __shfl_xor(gv, off); const int oi = __shfl_xor(gi, off);
                if (ov > gv || (ov == gv && oi < gi)) { gv = ov; gi = oi; }
            }
            const int src0 = lane & ~7;
            const float gmax = __shfl(gv, src0); const int grp = __shfl(gi, src0);
            float ge = c < 4 ? expf(lgv[0] + bgrp[c & 3] - gmax) : 0.f;
            ge += __shfl_xor(ge, 1); ge += __shfl_xor(ge, 2);
            const float gw = 1.0f / __shfl(ge, src0);
            const int j = (c + 4) & 7; const int kk = c >= 4 ? grp : grp + 1;
            float ev = lgv[0];
#pragma unroll
            for (int k = 1; k < 5; ++k) ev = (kk == k) ? lgv[k] : ev;
            ev += brex[grp * 8 + j];
            float v1 = ev; int i1 = j;
#pragma unroll
            for (int off = 1; off < 8; off <<= 1) {
                const float ov = __shfl_xor(v1, off); const int oi = __shfl_xor(i1, off);
                if (ov > v1 || (ov == v1 && oi < i1)) { v1 = ov; i1 = oi; }
            }
            float v2 = (j == i1) ? -3.0e38f : ev; int i2 = (j == i1) ? 99 : j;
#pragma unroll
            for (int off = 1; off < 8; off <<= 1) {
                const float ov = __shfl_xor(v2, off); const int oi = __shfl_xor(i2, off);
                if (ov > v2 || (ov == v2 && oi < i2)) { v2 = ov; i2 = oi; }
            }
            const float e2 = expf(v2 - v1);
            const float w1 = 1.0f / (1.0f + e2), w2 = e2 / (1.0f + e2);
            if (c < 2 && r < RB && row < rows_total) {
                if (pend_slot >= 0) list[(size_t)pend_e * NSLOT + pend_pos] = pend_slot;
                const int e = grp * 8 + (c ? i2 : i1); const float w = gw * (c ? w2 : w1);
                const int slot = row * 2 + c;
                slotw[slot] = w;
                pend_pos = atomicAdd(&cnt[e], 1u); pend_e = e; pend_slot = slot;
            }
        }
        __syncthreads();
    }
    if (pend_slot >= 0) list[(size_t)pend_e * NSLOT + pend_pos] = pend_slot;
}

DI void moe_prefix(KP p, int l, int* s_cnt, int* s_tb, int* s_rb) {
    const int tid = TIDX();
    const unsigned* cnt = (const unsigned*)(p->ws + WS_CTL) + l * 32;
    __syncthreads();
    if (tid < 32) s_cnt[tid] = (int)__hip_atomic_load(cnt + tid, __ATOMIC_RELAXED, __HIP_MEMORY_SCOPE_AGENT);
    __syncthreads();
    if (tid == 0) { int tb = 0; for (int e = 0; e < 32; ++e) { s_tb[e] = tb; s_rb[e] = tb * 128; tb += (s_cnt[e] + 127) >> 7; } s_tb[32] = tb; s_rb[32] = tb * 128; }
    __syncthreads();
}
DI void phase_mg1(KP p, int l, unsigned char* smem) {
    const int tid = TIDX(), wid = tid >> 6, lane = tid & 63, wr = wid >> 1, wc = wid & 1, fr = lane & 15, fq = lane >> 4;
    int* s_cnt = (int*)(smem + 65536 + 64); int* s_tb = s_cnt + 32; int* s_rb = s_tb + 33;
    moe_prefix(p, l, s_cnt, s_tb, s_rb);
    const bf16_t* U = (const bf16_t*)(p->ws + WS_U); const int* list = (const int*)(p->ws + WS_LIST);
    bf16_t* H = (bf16_t*)(p->ws + WS_H);
    const int ntiles = s_tb[32] * 8;
    struct TI { int e, rt, nt, cnt_e; };
    auto decode = [&](int i, TI& t) -> bool {
        const int tile = xcd_seq(i, ntiles); if (tile < 0) return false;
        const int rtg = tile >> 3; t.nt = tile & 7;
        int e = 0;
        for (int q = 1; q < 32; ++q) if (rtg >= s_tb[q]) e = q;
        t.e = e; t.rt = rtg - s_tb[e]; t.cnt_e = s_cnt[e]; return true; };
    auto rows = [&](const TI& t, const bf16_t* (&a)[4], const bf16_t* (&b)[4]) {
#pragma unroll
        for (int i_ = 0; i_ < 4; ++i_) {
            const int pos = t.rt * 128 + (tid >> 3) + 32 * i_;
            const int tok = pos < t.cnt_e ? (list[(size_t)t.e * NSLOT + pos] >> 1) : 0;
            a[i_] = U + (size_t)tok * 1024 + gemm_chunk(tid) * 8;
        }
        gemm_rows((const bf16_t*)(p->ws + WS_WGU) + (size_t)(l * 32 + t.e) * 1024 * 1024, t.nt * 128, 1024, tid, b); };
    TI cur, nxt;
    if (!decode(0, cur)) return;
    const bf16_t* ap[4]; const bf16_t* bp[4]; const bf16_t* apn[4]; const bf16_t* bpn[4];
    rows(cur, ap, bp);
    bool first = true;
    for (int i = 0;; ++i) {
        nxt = cur; const bool hn = decode(i + 1, nxt);
        rows(nxt, apn, bpn);
        f32x4 acc[4][4];
        gemm_tile<true>(smem, ap, bp, 1024, acc, first, hn, apn, bpn);
        const int hrow0 = s_rb[cur.e] + cur.rt * 128 + wr * 64;
#pragma unroll
        for (int m = 0; m < 4; ++m) {
            bf16_t* o = H + (size_t)(hrow0 + m * 16 + fr) * 512 + cur.nt * 64 + wc * 32 + fq * 4;
#pragma unroll
            for (int n = 0; n < 4; n += 2) {
                const f32x4 g = acc[m][n], uu = acc[m][n + 1]; f32x4 h;
#pragma unroll
                for (int j = 0; j < 4; ++j) h[j] = siluf(g[j]) * uu[j];
                u32x2 w; w.x = pk2(h[0], h[1]); w.y = pk2(h[2], h[3]);
                *(u32x2*)(o + (n >> 1) * 16) = w;
            }
        }
        if (!hn) break;
        cur = nxt; GEMM_ADVANCE(); first = false;
    }
}
DI void phase_mg2(KP p, int l, unsigned char* smem) {
    const int tid = TIDX(), wid = tid >> 6, lane = tid & 63, wr = wid >> 1, wc = wid & 1, fr = lane & 15, fq = lane >> 4;
    int* s_cnt = (int*)(smem + 65536 + 64); int* s_tb = s_cnt + 32; int* s_rb = s_tb + 33;
    moe_prefix(p, l, s_cnt, s_tb, s_rb);
    const bf16_t* H = (const bf16_t*)(p->ws + WS_H); const int* list = (const int*)(p->ws + WS_LIST); const float* slotw = (const float*)(p->ws + WS_SLOTW);
    bf16_t* YS = (bf16_t*)(p->ws + WS_YS);
    const int ntiles = s_tb[32] * 8;
    struct TI { int e, rt, nt, cnt_e; };
    auto decode = [&](int i, TI& t) -> bool {
        const int tile = xcd_seq(i, ntiles); if (tile < 0) return false;
        const int rtg = tile >> 3; t.nt = tile & 7;
        int e = 0;
        for (int q = 1; q < 32; ++q) if (rtg >= s_tb[q]) e = q;
        t.e = e; t.rt = rtg - s_tb[e]; t.cnt_e = s_cnt[e]; return true; };
    auto rows = [&](const TI& t, const bf16_t* (&a)[4], const bf16_t* (&b)[4]) {
        gemm_rows(H, s_rb[t.e] + t.rt * 128, 512, tid, a);
        gemm_rows((const bf16_t*)(p->ws + WS_WD) + (size_t)(l * 32 + t.e) * 1024 * 512, t.nt * 128, 512, tid, b); };
    TI cur, nxt;
    if (!decode(0, cur)) return;
    const bf16_t* ap[4]; const bf16_t* bp[4]; const bf16_t* apn[4]; const bf16_t* bpn[4];
    rows(cur, ap, bp);
    bool first = true;
    for (int i = 0;; ++i) {
        nxt = cur; const bool hn = decode(i + 1, nxt);
        rows(nxt, apn, bpn);
        f32x4 acc[4][4];
        gemm_tile<true>(smem, ap, bp, 512, acc, first, hn, apn, bpn);
#pragma unroll
        for (int m = 0; m < 4; ++m) {
            const int pos = cur.rt * 128 + wr * 64 + m * 16 + fr;
            if (pos < cur.cnt_e) {
                const int slot = list[(size_t)cur.e * NSLOT + pos]; const float w = slotw[slot];
                bf16_t* o = YS + (size_t)slot * 1024 + cur.nt * 128 + wc * 64 + fq * 4;
#pragma unroll
                for (int n = 0; n < 4; ++n) { const f32x4 v = acc[m][n] * w; u32x2 ww; ww.x = pk2(v[0], v[1]); ww.y = pk2(v[2], v[3]); *(u32x2*)(o + n * 16) = ww; }
            }
        }
        if (!hn) break;
        cur = nxt; GEMM_ADVANCE(); first = false;
    }
}

template <bool DRY>
DI void phase_ln2(KP p, int l) {
    const int tid = TIDX(), wave = tid >> 6, lane = tid & 63;
    const xres_t* X = (const xres_t*)(p->ws + WS_X); xres_t* Xo = (xres_t*)(p->ws + (DRY ? WS_OB : WS_X)); const bf16_t* YS = (const bf16_t*)(p->ws + WS_YS); bf16_t* U = (bf16_t*)(p->ws + (DRY ? WS_Y : WS_U));
    const float* MOD = (const float*)(p->ws + WS_MOD);
    const float* lng = p->in[8] + l * 1024; const float* lnb = p->in[9] + l * 1024;
    const int rows_total = (l == 3) ? ML : MT;
    for (int row0 = (BIDX() * 4 + wave) * 2; row0 < rows_total; row0 += gridDim.x * 8) {
        f32x4 v[2][4]; float s[2] = {0.f, 0.f};
        const float* mod[2];
#pragma unroll
        for (int q = 0; q < 2; ++q) {
            const int row = row0 + q; const int r = row < ML ? (row >> 11) : 8;
            mod[q] = MOD + (size_t)(l * 9 + r) * 6144;
#pragma unroll
            for (int j = 0; j < 4; ++j) {
                const int k = 256 * j + 4 * lane;
                const u32x2 y0 = *(const u32x2*)(YS + (size_t)(2 * row) * 1024 + k), y1 = *(const u32x2*)(YS + (size_t)(2 * row + 1) * 1024 + k);
                f32x4 y; y[0] = bflo(y0.x) + bflo(y1.x); y[1] = bfhi(y0.x) + bfhi(y1.x); y[2] = bflo(y0.y) + bflo(y1.y); y[3] = bfhi(y0.y) + bfhi(y1.y);
                const f32x4 xv = xload(X + (size_t)row * 1024 + k), g2 = *(const f32x4*)(mod[q] + 5120 + k);
                v[q][j] = xv * ALPHA + g2 * y; s[q] += (v[q][j][0] + v[q][j][1]) + (v[q][j][2] + v[q][j][3]);
            }
        }
        float mean[2], rstd[2];
#pragma unroll
        for (int q = 0; q < 2; ++q) mean[q] = wave_sum(s[q]) * (1.0f / 1024.0f);
#pragma unroll
        for (int q = 0; q < 2; ++q) {
            float s2 = 0.f;
#pragma unroll
            for (int j = 0; j < 4; ++j) { v[q][j] = v[q][j] - mean[q]; s2 += (v[q][j][0] * v[q][j][0] + v[q][j][1] * v[q][j][1]) + (v[q][j][2] * v[q][j][2] + v[q][j][3] * v[q][j][3]); }
            s[q] = s2;
        }
#pragma unroll
        for (int q = 0; q < 2; ++q) rstd[q] = 1.0f / sqrtf(wave_sum(s[q]) * (1.0f / 1024.0f) + LN_EPS);
#pragma unroll
        for (int q = 0; q < 2; ++q) {
            const int row = row0 + q;
            const float* modn = mod[q] + (l + 1 < 4 ? 9 * 6144 : 0);
#pragma unroll
            for (int j = 0; j < 4; ++j) {
                const int k = 256 * j + 4 * lane;
                const f32x4 xn = v[q][j] * rstd[q] * *(const f32x4*)(lng + k) + *(const f32x4*)(lnb + k);
                if (l < 3) {
                    xstore(Xo + (size_t)row * 1024 + k, xn);
                    const f32x4 uu = xn * (1.0f + *(const f32x4*)(modn + 1024 + k)) + *(const f32x4*)(modn + k);
                    u32x2 w; w.x = pk2(uu[0], uu[1]); w.y = pk2(uu[2], uu[3]);
                    *(u32x2*)(U + (size_t)row * 1024 + k) = w;
                } else {
                    *(f32x4*)(p->out + (size_t)row * 1024 + k) = xn;
                }
            }
        }
    }
}

DI s16x4 tr_read(const unsigned char* ptr) {
    typedef short v4i16_t __attribute__((ext_vector_type(4)));
    return __builtin_bit_cast(s16x4, __builtin_amdgcn_ds_read_tr16_b64_v4i16((LAS v4i16_t*)ptr));
}
DI bf16x8 cat8(s16x4 a, s16x4 b) { return __builtin_shufflevector(a, b, 0, 1, 2, 3, 4, 5, 6, 7); }

DI void phase_decay(KP p, int l, unsigned char* smem) {
    const int tid = TIDX();
    const int li = l >> 1;
    const float* LR = (const float*)(p->ws + WS_LR);
    float* PF = (float*)(p->ws + WS_PF); float* SQ = (float*)(p->ws + WS_SQ); float* SK = (float*)(p->ws + WS_SK); float* TOT = (float*)(p->ws + WS_TOT);
    float* lrs = (float*)smem;
    float wf[16], wb[16];
#pragma unroll
    for (int r = 0; r < 16; ++r) { wf[r] = p->in[11][(size_t)li * 16 * 256 + r * 256 + tid]; wb[r] = p->in[13][(size_t)li * 16 * 256 + r * 256 + tid]; }
    const float bf = p->in[12][li * 256 + tid], bb = p->in[14][li * 256 + tid];
    for (int it = BIDX(); it < 2 * (MT / 64); it += gridDim.x) {
        const int ch = it >> 1, dr = it & 1;
        const int row0 = ch * 64;
        __syncthreads();
        { const int tok = tid >> 2, q4 = tid & 3; *(f32x4*)(lrs + tok * 16 + q4 * 4) = *(const f32x4*)(LR + (size_t)(row0 + tok) * 32 + dr * 16 + q4 * 4); }
        __syncthreads();
        float run = 0.f;
        if (dr == 0) {
            for (int t = 0; t < 64; ++t) {
                float g = bf;
#pragma unroll
                for (int r = 0; r < 16; ++r) g += lrs[t * 16 + r] * wf[r];
                run += (fminf(g, 0.f) - __logf(1.0f + __expf(-fabsf(g)))) * (1.0f / 16.0f);
                PF[(size_t)(row0 + t) * 256 + tid] = run;
            }
        } else {
            for (int t = 63; t >= 0; --t) {
                float g = bb;
#pragma unroll
                for (int r = 0; r < 16; ++r) g += lrs[t * 16 + r] * wb[r];
                SQ[(size_t)(row0 + t) * 256 + tid] = run;
                run += (fminf(g, 0.f) - __logf(1.0f + __expf(-fabsf(g)))) * (1.0f / 16.0f);
                SK[(size_t)(row0 + t) * 256 + tid] = run;
            }
        }
        TOT[(size_t)(ch * 2 + dr) * 256 + tid] = run;
    }
}

template <int DK>
DI void scan_item(KP p, int l, int item, unsigned char* smem) {
    constexpr bool ISA = (DK == 128);
    constexpr int QS = DK * 2 + 16, KS = DK * 2 + 32, VS = 96, AS_ = 144, SS = DK * 2 + 16, NKS = DK / 32, NMT = DK / 64;
    constexpr int O_QD = 0, O_KD = O_QD + 64 * QS, O_V = O_KD + 64 * KS, O_ATT = O_V + 64 * VS, O_ST = O_ATT + 64 * AS_, O_END = O_ST + 32 * SS;
    static_assert(O_END <= 65536, "scan LDS");
    constexpr int NP = DK / 64 * 2;
    constexpr int CPR = DK / 8;
    const int tid = TIDX(), wid = tid >> 6, lane = tid & 63, fr = lane & 15, fq = lane >> 4;
    const int b = item >> 5, h = (item >> 3) & 3, dir = (item >> 2) & 1, dvq = item & 3;
    const bf16_t* Z = (const bf16_t*)(p->ws + WS_Z);
    const float* EQ = (const float*)(p->ws + (dir ? WS_SQ : WS_PF)); const float* EK = (const float*)(p->ws + (dir ? WS_SK : WS_PF)); const float* TOT = (const float*)(p->ws + WS_TOT);
    bf16_t* OUT = (bf16_t*)(p->ws + (dir ? WS_OB : WS_OF));
    const int qcol = ISA ? h * 128 : 2048 + h * 64, kcol = ISA ? 512 + h * 128 : 2304 + h * 64, vcol = (ISA ? 1024 : 2560) + h * 128 + dvq * 32;
    const int ocol = (ISA ? 0 : 512) + h * 128 + dvq * 32;
    float lam = 0.f;
    if (ISA) lam = log1pf(-exp2f(-((dir ? 5.5f : 5.0f) + (float)h)));
    f32x4 S[NMT][2];
#pragma unroll
    for (int a = 0; a < NMT; ++a) { S[a][0] = (f32x4){0.f, 0.f, 0.f, 0.f}; S[a][1] = (f32x4){0.f, 0.f, 0.f, 0.f}; }
    __syncthreads();
    for (int i = tid; i < 32 * SS / 4; i += 256) ((unsigned*)(smem + O_ST))[i] = 0u;
    auto chunk_row0 = [&](int cc) -> int {
        const int ci = dir ? 35 - cc : cc; const int pp = ci * 64;
        if (!dir) return pp < 256 ? ML + b * 256 + pp : b * 2048 + (pp - 256);
        return pp < 2048 ? b * 2048 + pp : ML + b * 256 + (pp - 2048);
    };
    u32x4 rq[NP], rk[NP], rv; f32x4 eq[ISA ? 1 : NP][2], ek[ISA ? 1 : NP][2]; f32x4 tv[NMT];
    auto fetch = [&](int cc) {
        const int row0 = chunk_row0(cc);
        if (!ISA) {
#pragma unroll
            for (int a = 0; a < NMT; ++a) tv[a] = *(const f32x4*)(TOT + (size_t)((row0 >> 6) * 2 + dir) * 256 + h * 64 + (wid * NMT + a) * 16 + fq * 4);
        }
#pragma unroll
        for (int i = 0; i < NP; ++i) {
            const int id = tid + 256 * i, tok = id / CPR, cg_ = id % CPR;
            const size_t ro = (size_t)(row0 + tok) * ZS;
            rq[i] = *(const u32x4*)(Z + ro + qcol + cg_ * 8); rk[i] = *(const u32x4*)(Z + ro + kcol + cg_ * 8);
            if (!ISA) {
                const size_t eo = (size_t)(row0 + tok) * 256 + h * 64 + cg_ * 8;
                eq[i][0] = *(const f32x4*)(EQ + eo); eq[i][1] = *(const f32x4*)(EQ + eo + 4);
                ek[i][0] = *(const f32x4*)(EK + eo); ek[i][1] = *(const f32x4*)(EK + eo + 4);
            }
        }
        { const int tok = tid >> 2, cg_ = tid & 3; rv = *(const u32x4*)(Z + (size_t)(row0 + tok) * ZS + vcol + cg_ * 8); }
    };
    float ra[NP], rc[NP];
#pragma unroll
    for (int i = 0; i < NP; ++i) {
        const int tok = (tid + 256 * i) / CPR;
        ra[i] = dir ? __expf(lam * (float)(63 - tok)) : __expf(lam * (float)(tok + 1));
        rc[i] = dir ? __expf(-lam * (float)(64 - tok)) : __expf(-lam * (float)(tok + 1));
    }
    const float decA = __expf(lam * 64.0f);
    fetch(0);
    for (int cc = 0; cc < 36; ++cc) {
        const int row0 = chunk_row0(cc);
#pragma unroll
        for (int i = 0; i < NP; ++i) {
            const int id = tid + 256 * i, tok = id / CPR, cg_ = id % CPR;
            float fqv[8], fkv[8];
            if (ISA) {
#pragma unroll
                for (int e = 0; e < 8; ++e) { fqv[e] = ra[i]; fkv[e] = rc[i]; }
            } else {
#pragma unroll
                for (int e = 0; e < 8; ++e) { fqv[e] = __expf(eq[i][e >> 2][e & 3]); fkv[e] = __expf(-ek[i][e >> 2][e & 3]); }
            }
            const u32x4 q = rq[i], k = rk[i]; u32x4 qo, ko;
            qo.x = pk2(bflo(q.x) * fqv[0], bfhi(q.x) * fqv[1]); qo.y = pk2(bflo(q.y) * fqv[2], bfhi(q.y) * fqv[3]); qo.z = pk2(bflo(q.z) * fqv[4], bfhi(q.z) * fqv[5]); qo.w = pk2(bflo(q.w) * fqv[6], bfhi(q.w) * fqv[7]);
            ko.x = pk2(bflo(k.x) * fkv[0], bfhi(k.x) * fkv[1]); ko.y = pk2(bflo(k.y) * fkv[2], bfhi(k.y) * fkv[3]); ko.z = pk2(bflo(k.z) * fkv[4], bfhi(k.z) * fkv[5]); ko.w = pk2(bflo(k.w) * fkv[6], bfhi(k.w) * fkv[7]);
            *(u32x4*)(smem + O_QD + tok * QS + cg_ * 16) = qo;
            *(u32x4*)(smem + O_KD + tok * KS + cg_ * 16) = ko;
        }
        { const int tok = tid >> 2, cg_ = tid & 3; *(u32x4*)(smem + O_V + tok * VS + cg_ * 16) = rv; }
        f32x4 dec[NMT];
#pragma unroll
        for (int a = 0; a < NMT; ++a) {
            if (ISA) dec[a] = (f32x4){decA, decA, decA, decA};
            else dec[a] = (f32x4){__expf(tv[a][0]), __expf(tv[a][1]), __expf(tv[a][2]), __expf(tv[a][3])};
        }
        if (cc + 1 < 36) fetch(cc + 1);
        __syncthreads();
        bf16x8 afr[2];
        {
            f32x4 at[4];
#pragma unroll
            for (int n = 0; n < 4; ++n) at[n] = (f32x4){0.f, 0.f, 0.f, 0.f};
#pragma unroll
            for (int ks = 0; ks < NKS; ++ks) {
                const bf16x8 qf = *(const bf16x8*)(smem + O_QD + (16 * wid + fr) * QS + (32 * ks + 8 * fq) * 2);
#pragma unroll
                for (int n = 0; n < 4; ++n) {
                    const bf16x8 kf = *(const bf16x8*)(smem + O_KD + (16 * n + fr) * KS + (32 * ks + 8 * fq) * 2);
                    at[n] = __builtin_amdgcn_mfma_f32_16x16x32_bf16(kf, qf, at[n], 0, 0, 0);
                }
            }
            const int i = 16 * wid + fr;
#pragma unroll
            for (int n = 0; n < 4; ++n)
#pragma unroll
                for (int jj = 0; jj < 4; ++jj) { const int j = n * 16 + fq * 4 + jj; const bool keep = dir ? (j > i) : (j <= i); at[n][jj] = keep ? at[n][jj] : 0.f; }
#pragma unroll
            for (int ks = 0; ks < 2; ++ks) {
                u32x4 w; w.x = pk2(at[2 * ks][0], at[2 * ks][1]); w.y = pk2(at[2 * ks][2], at[2 * ks][3]); w.z = pk2(at[2 * ks + 1][0], at[2 * ks + 1][1]); w.w = pk2(at[2 * ks + 1][2], at[2 * ks + 1][3]);
                afr[ks] = __builtin_bit_cast(bf16x8, w);
            }
        }
        bf16x8 vf[2][2];
        {
            const int g = lane >> 4, i16 = lane & 15, q = i16 >> 2, pq = i16 & 3;
#pragma unroll
            for (int ks = 0; ks < 2; ++ks)
#pragma unroll
                for (int n = 0; n < 2; ++n) {
                    const unsigned char* a = smem + O_V + (32 * ks + 4 * g + q) * VS + (n * 16 + 4 * pq) * 2;
                    vf[ks][n] = cat8(tr_read(a), tr_read(a + 16 * VS));
                }
        }
        {
            f32x4 oa[2] = {(f32x4){0.f, 0.f, 0.f, 0.f}, (f32x4){0.f, 0.f, 0.f, 0.f}};
#pragma unroll
            for (int ks = 0; ks < 2; ++ks)
#pragma unroll
                for (int n = 0; n < 2; ++n) oa[n] = __builtin_amdgcn_mfma_f32_16x16x32_bf16(vf[ks][n], afr[ks], oa[n], 0, 0, 0);
#pragma unroll
            for (int ks = 0; ks < NKS; ++ks) {
                const bf16x8 qf = *(const bf16x8*)(smem + O_QD + (16 * wid + fr) * QS + (32 * ks + 8 * fq) * 2);
#pragma unroll
                for (int n = 0; n < 2; ++n) {
                    const bf16x8 sf = *(const bf16x8*)(smem + O_ST + (16 * n + fr) * SS + (32 * ks + 8 * fq) * 2);
                    oa[n] = __builtin_amdgcn_mfma_f32_16x16x32_bf16(sf, qf, oa[n], 0, 0, 0);
                }
            }
            bf16_t* o = OUT + (size_t)(row0 + 16 * wid + fr) * 1024 + ocol + fq * 4;
            u32x2 w0, w1; w0.x = pk2(oa[0][0], oa[0][1]); w0.y = pk2(oa[0][2], oa[0][3]); w1.x = pk2(oa[1][0], oa[1][1]); w1.y = pk2(oa[1][2], oa[1][3]);
            *(u32x2*)(o) = w0; *(u32x2*)(o + 16) = w1;
        }
        {
            const int g = lane >> 4, i16 = lane & 15, q = i16 >> 2, pq = i16 & 3;
#pragma unroll
            for (int a = 0; a < NMT; ++a) {
                const int mt = wid * NMT + a;
#pragma unroll
                for (int ks = 0; ks < 2; ++ks) {
                    const unsigned char* ka = smem + O_KD + (32 * ks + 4 * g + q) * KS + (mt * 16 + 4 * pq) * 2;
                    const bf16x8 kf = cat8(tr_read(ka), tr_read(ka + 16 * KS));
#pragma unroll
                    for (int n = 0; n < 2; ++n) S[a][n] = __builtin_amdgcn_mfma_f32_16x16x32_bf16(kf, vf[ks][n], S[a][n], 0, 0, 0);
                }
                S[a][0] *= dec[a]; S[a][1] *= dec[a];
            }
        }
        __syncthreads();
#pragma unroll
        for (int a = 0; a < NMT; ++a) {
            const int mt = wid * NMT + a;
#pragma unroll
            for (int n = 0; n < 2; ++n) { u32x2 w; w.x = pk2(S[a][n][0], S[a][n][1]); w.y = pk2(S[a][n][2], S[a][n][3]); *(u32x2*)(smem + O_ST + (n * 16 + fr) * SS + (mt * 16 + fq * 4) * 2) = w; }
        }
    }
    __syncthreads();
}
DI void phase_scan(KP p, int l, unsigned char* smem) {
    for (int it = BIDX(); it < 512; it += gridDim.x) {
        if (it < 256) scan_item<128>(p, l, it, smem); else scan_item<64>(p, l, it - 256, smem);
    }
}

DI void phase_merge(KP p, int l) {
    const int tid = TIDX(), wave = tid >> 6, lane = tid & 63;
    const int li = l >> 1;
    const bf16_t* OF = (const bf16_t*)(p->ws + WS_OF); const bf16_t* OB = (const bf16_t*)(p->ws + WS_OB);
    const bf16_t* Z = (const bf16_t*)(p->ws + WS_Z); bf16_t* Y = (bf16_t*)(p->ws + WS_Y);
    const bool isA = lane < 32;
    const float* gn = isA ? p->in[15] + li * 512 + lane * 16 : p->in[16] + li * 512 + (lane - 32) * 16;
    const int gcol = isA ? 1536 + lane * 16 : 3072 + (lane - 32) * 16;
    for (int row = BIDX() * 4 + wave; row < MT; row += gridDim.x * 4) {
        float o[16]; float s = 0.f;
#pragma unroll
        for (int j = 0; j < 2; ++j) {
            const u32x4 a = *(const u32x4*)(OF + (size_t)row * 1024 + lane * 16 + j * 8), bb = *(const u32x4*)(OB + (size_t)row * 1024 + lane * 16 + j * 8);
            o[j * 8 + 0] = bflo(a.x) + bflo(bb.x); o[j * 8 + 1] = bfhi(a.x) + bfhi(bb.x); o[j * 8 + 2] = bflo(a.y) + bflo(bb.y); o[j * 8 + 3] = bfhi(a.y) + bfhi(bb.y);
            o[j * 8 + 4] = bflo(a.z) + bflo(bb.z); o[j * 8 + 5] = bfhi(a.z) + bfhi(bb.z); o[j * 8 + 6] = bflo(a.w) + bflo(bb.w); o[j * 8 + 7] = bfhi(a.w) + bfhi(bb.w);
        }
#pragma unroll
        for (int e = 0; e < 16; ++e) s += o[e];
        s += __shfl_xor(s, 1); s += __shfl_xor(s, 2); s += __shfl_xor(s, 4);
        const float mean = isA ? s * (1.0f / 128.0f) : 0.f;
        float s2 = 0.f;
#pragma unroll
        for (int e = 0; e < 16; ++e) { o[e] -= mean; s2 += o[e] * o[e]; }
        s2 += __shfl_xor(s2, 1); s2 += __shfl_xor(s2, 2); s2 += __shfl_xor(s2, 4);
        const float rs = 1.0f / sqrtf(s2 * (1.0f / 128.0f) + LN_EPS);
        const u32x4 g0 = *(const u32x4*)(Z + (size_t)row * ZS + gcol), g1 = *(const u32x4*)(Z + (size_t)row * ZS + gcol + 8);
        float gt[16];
        gt[0] = bflo(g0.x); gt[1] = bfhi(g0.x); gt[2] = bflo(g0.y); gt[3] = bfhi(g0.y); gt[4] = bflo(g0.z); gt[5] = bfhi(g0.z); gt[6] = bflo(g0.w); gt[7] = bfhi(g0.w);
        gt[8] = bflo(g1.x); gt[9] = bfhi(g1.x); gt[10] = bflo(g1.y); gt[11] = bfhi(g1.y); gt[12] = bflo(g1.z); gt[13] = bfhi(g1.z); gt[14] = bflo(g1.w); gt[15] = bfhi(g1.w);
        float y[16];
#pragma unroll
        for (int e = 0; e < 16; ++e) y[e] = siluf(gt[e]) * (o[e] * rs * gn[e]);
        u32x4 w0, w1;
        w0.x = pk2(y[0], y[1]); w0.y = pk2(y[2], y[3]); w0.z = pk2(y[4], y[5]); w0.w = pk2(y[6], y[7]);
        w1.x = pk2(y[8], y[9]); w1.y = pk2(y[10], y[11]); w1.z = pk2(y[12], y[13]); w1.w = pk2(y[14], y[15]);
        *(u32x4*)(Y + (size_t)row * 1024 + lane * 16) = w0; *(u32x4*)(Y + (size_t)row * 1024 + lane * 16 + 8) = w1;
    }
}

DI int crow(int r, int hi) { return (r & 3) + 8 * (r >> 2) + 4 * hi; }
constexpr int ATT_BUF = 24576;
DI void att_component(const bf16_t* Qc, const bf16_t* Kc, const bf16_t* Vt, unsigned char* smem, float* wsf, int b, int h, int comp, int p0, int nkv, f32x16 (&O)[4]) {
    const int tid = TIDX(), wid = tid >> 6, lane = tid & 63, r32 = lane & 31, hi = lane >> 5;
    const int hc = h * 2 + comp;
    const bf16_t* Qb = Qc + ((size_t)(b * 16 + hc) * TA + p0 + wid * 32 + r32) * 64;
    const int gch = gemm_chunk(tid);
    const bf16_t* Kg = Kc + (size_t)(b * 16 + hc) * TA * 64 + (size_t)(tid >> 3) * 64 + gch * 8;
    const bf16_t* Vg = Vt + (size_t)(b * 8 + h) * 128 * TA + (size_t)(tid >> 3) * TA + gch * 8;
#define ATT_STAGE(buf, kt) do { \
        _Pragma("unroll") for (int i_ = 0; i_ < 2; ++i_) __builtin_amdgcn_global_load_lds((const unsigned*)(Kg + (size_t)((kt) + 32 * i_) * 64), (LAS unsigned*)(smem + (buf) * ATT_BUF + i_ * 4096 + tid * 16), 16, 0, 0); \
        _Pragma("unroll") for (int i_ = 0; i_ < 4; ++i_) __builtin_amdgcn_global_load_lds((const unsigned*)(Vg + (size_t)(32 * i_) * TA + (kt)), (LAS unsigned*)(smem + (buf) * ATT_BUF + 8192 + i_ * 4096 + tid * 16), 16, 0, 0); } while (0)
    ATT_STAGE(0, 0);
    bf16x8 qf[4];
#pragma unroll
    for (int ks = 0; ks < 4; ++ks) qf[ks] = *(const bf16x8*)(Qb + ks * 16 + hi * 8);
#pragma unroll
    for (int d0 = 0; d0 < 4; ++d0)
#pragma unroll
        for (int r = 0; r < 16; ++r) O[d0][r] = 0.f;
    float m_run = -1.0e30f, l_run = 0.f;
    const int sw = (r32 >> 1) & 7;
    const int nt = nkv >> 6;
    for (int t = 0; t < nt; ++t) {
        asm volatile("s_waitcnt vmcnt(0)" ::: "memory");
        __syncthreads();
        if (t + 1 < nt) ATT_STAGE((t + 1) & 1, (t + 1) * 64);
        const unsigned char* Kt = smem + (t & 1) * ATT_BUF; const unsigned char* Vtl = Kt + 8192;
        bf16x8 kf0[4], kf1[4];
#pragma unroll
        for (int ks = 0; ks < 4; ++ks) {
            const unsigned co = (unsigned)(((ks * 2 + hi) ^ sw) << 4);
            kf0[ks] = *(const bf16x8*)(Kt + r32 * 128 + co);
            kf1[ks] = *(const bf16x8*)(Kt + (32 + r32) * 128 + co);
        }
        const unsigned char* vr = Vtl + r32 * 128;
#define ATT_VLOAD(dst, st_) do { const unsigned o1_ = (unsigned)((((st_) * 2 + hi) ^ sw) << 4); \
        _Pragma("unroll") for (int d0_ = 0; d0_ < 4; ++d0_) dst[d0_] = *(const bf16x8*)(vr + d0_ * 4096 + o1_); } while (0)
        bf16x8 va[4], vb[4];
        ATT_VLOAD(va, 0);
        f32x16 s0, s1;
#pragma unroll
        for (int r = 0; r < 16; ++r) { s0[r] = 0.f; s1[r] = 0.f; }
#pragma unroll
        for (int ks = 0; ks < 4; ++ks) {
            s0 = __builtin_amdgcn_mfma_f32_32x32x16_bf16(kf0[ks], qf[ks], s0, 0, 0, 0);
            s1 = __builtin_amdgcn_mfma_f32_32x32x16_bf16(kf1[ks], qf[ks], s1, 0, 0, 0);
        }
        float mxa[8];
#pragma unroll
        for (int i_ = 0; i_ < 8; ++i_) mxa[i_] = fmaxf(fmaxf(s0[2 * i_], s0[2 * i_ + 1]), fmaxf(s1[2 * i_], s1[2 * i_ + 1]));
        float mx = fmaxf(fmaxf(fmaxf(mxa[0], mxa[1]), fmaxf(mxa[2], mxa[3])), fmaxf(fmaxf(mxa[4], mxa[5]), fmaxf(mxa[6], mxa[7])));
        mx = fmaxf(mx, __shfl_xor(mx, 32));
        if (__any(mx > m_run + 8.0f)) {
            const float m_new = fmaxf(m_run, mx);
            const float alpha = __builtin_amdgcn_exp2f((m_run - m_new) * L2E);
            l_run *= alpha; m_run = m_new;
            if (hi == 0) wsf[r32] = alpha;
            asm volatile("s_waitcnt lgkmcnt(0)" ::: "memory");
            float ar[16];
#pragma unroll
            for (int r = 0; r < 16; ++r) ar[r] = wsf[crow(r, hi)];
#pragma unroll
            for (int d0 = 0; d0 < 4; ++d0)
#pragma unroll
                for (int r = 0; r < 16; ++r) O[d0][r] *= ar[r];
            asm volatile("s_waitcnt lgkmcnt(0)" ::: "memory");
        }
        const float mb = m_run * L2E;
        float ps = 0.f;
#pragma unroll
        for (int r = 0; r < 16; ++r) { s0[r] = __builtin_amdgcn_exp2f(s0[r] * L2E - mb); s1[r] = __builtin_amdgcn_exp2f(s1[r] * L2E - mb); ps += s0[r] + s1[r]; }
        l_run += ps;
        u32x4 pw[4];
#pragma unroll
        for (int s = 0; s < 2; ++s) {
            pw[s].x = pk2(s0[8 * s + 0], s0[8 * s + 1]); pw[s].y = pk2(s0[8 * s + 2], s0[8 * s + 3]); pw[s].z = pk2(s0[8 * s + 4], s0[8 * s + 5]); pw[s].w = pk2(s0[8 * s + 6], s0[8 * s + 7]);
            pw[2 + s].x = pk2(s1[8 * s + 0], s1[8 * s + 1]); pw[2 + s].y = pk2(s1[8 * s + 2], s1[8 * s + 3]); pw[2 + s].z = pk2(s1[8 * s + 4], s1[8 * s + 5]); pw[2 + s].w = pk2(s1[8 * s + 6], s1[8 * s + 7]);
        }
#pragma unroll
        ATT_VLOAD(vb, 1);
#pragma unroll
        for (int d0 = 0; d0 < 4; ++d0) O[d0] = __builtin_amdgcn_mfma_f32_32x32x16_bf16(__builtin_bit_cast(bf16x8, pw[0]), va[d0], O[d0], 0, 0, 0);
        ATT_VLOAD(va, 2);
#pragma unroll
        for (int d0 = 0; d0 < 4; ++d0) O[d0] = __builtin_amdgcn_mfma_f32_32x32x16_bf16(__builtin_bit_cast(bf16x8, pw[1]), vb[d0], O[d0], 0, 0, 0);
        ATT_VLOAD(vb, 3);
#pragma unroll
        for (int d0 = 0; d0 < 4; ++d0) O[d0] = __builtin_amdgcn_mfma_f32_32x32x16_bf16(__builtin_bit_cast(bf16x8, pw[2]), va[d0], O[d0], 0, 0, 0);
#pragma unroll
        for (int d0 = 0; d0 < 4; ++d0) O[d0] = __builtin_amdgcn_mfma_f32_32x32x16_bf16(__builtin_bit_cast(bf16x8, pw[3]), vb[d0], O[d0], 0, 0, 0);
#undef ATT_VLOAD
    }
#undef ATT_STAGE
    l_run += __shfl_xor(l_run, 32);
    asm volatile("s_waitcnt lgkmcnt(0)" ::: "memory");
    if (hi == 0) wsf[r32] = 1.0f / l_run;
    asm volatile("s_waitcnt lgkmcnt(0)" ::: "memory");
    float ar[16];
#pragma unroll
    for (int r = 0; r < 16; ++r) ar[r] = wsf[crow(r, hi)];
    asm volatile("s_waitcnt lgkmcnt(0)" ::: "memory");
#pragma unroll
    for (int d0 = 0; d0 < 4; ++d0)
#pragma unroll
        for (int r = 0; r < 16; ++r) O[d0][r] *= ar[r];
}

DI void phase_att(KP p, int l, unsigned char* smem) {
    constexpr int O_WS = 2 * ATT_BUF;
    const int tid = TIDX(), wid = tid >> 6, lane = tid & 63, r32 = lane & 31, hi = lane >> 5;
    const int li = l >> 1;
    const bf16_t* Qc = (const bf16_t*)(p->ws + WS_QC); const bf16_t* Kc = (const bf16_t*)(p->ws + WS_KC); const bf16_t* Vt = (const bf16_t*)(p->ws + WS_VT);
    bf16_t* Y = (bf16_t*)(p->ws + WS_Y);
    float* stash = (float*)(p->ws + WS_P) + ((size_t)BIDX() * 256 + tid) * 64;
    const float lam_init = 0.8f - 0.6f * expf(-0.3f * (float)l);
    float* wsf = (float*)(smem + O_WS) + wid * 32;
    const int per_x = (l == 3) ? 128 : 144;
    for (int i = 0;; ++i) {
        int b, h, p0, nkv;
        {
            const int G = gridDim.x, bid = BIDX();
            int item;
            if ((G & 7) == 0) { const int x = bid & 7, q = i * (G >> 3) + (bid >> 3); if (q >= per_x) break; item = q < 128 ? x * 128 + q : 1024 + x * 16 + (q - 128); }
            else { item = i * G + bid; if (item >= 8 * per_x) break; }
            if (item < 1024) { b = item >> 7; h = (item >> 4) & 7; p0 = 256 + (item & 15) * 128; nkv = TA; }
            else { const int q = item - 1024; b = q >> 4; h = (q >> 1) & 7; p0 = (q & 1) * 128; nkv = TC; }
        }
        float d1 = 0.f, d2 = 0.f;
        { const float* lq1 = p->in[19] + (li * 8 + h) * 64, *lk1 = p->in[20] + (li * 8 + h) * 64, *lq2 = p->in[21] + (li * 8 + h) * 64, *lk2 = p->in[22] + (li * 8 + h) * 64;
          d1 = wave_sum(lq1[lane] * lk1[lane]); d2 = wave_sum(lq2[lane] * lk2[lane]); }
        const float lamv = expf(d1) - expf(d2) + lam_init;
        f32x16 On[4];
        __syncthreads();
        att_component(Qc, Kc, Vt, smem, wsf, b, h, 0, p0, nkv, On);
#pragma unroll
        for (int d0 = 0; d0 < 4; ++d0)
#pragma unroll
            for (int r = 0; r < 16; r += 4) *(f32x4*)(stash + d0 * 16 + r) = (f32x4){On[d0][r], On[d0][r + 1], On[d0][r + 2], On[d0][r + 3]};
        __syncthreads();
        att_component(Qc, Kc, Vt, smem, wsf, b, h, 1, p0, nkv, On);
#pragma unroll
        for (int d0 = 0; d0 < 4; ++d0)
#pragma unroll
            for (int r = 0; r < 16; r += 4) {
                const f32x4 sv = *(const f32x4*)(stash + d0 * 16 + r);
                On[d0][r] = sv[0] - lamv * On[d0][r]; On[d0][r + 1] = sv[1] - lamv * On[d0][r + 1]; On[d0][r + 2] = sv[2] - lamv * On[d0][r + 2]; On[d0][r + 3] = sv[3] - lamv * On[d0][r + 3];
            }
        float ms[16];
#pragma unroll
        for (int r = 0; r < 16; ++r) {
            float s = (On[0][r] * On[0][r] + On[1][r] * On[1][r]) + (On[2][r] * On[2][r] + On[3][r] * On[3][r]);
            s += __shfl_xor(s, 1); s += __shfl_xor(s, 2); s += __shfl_xor(s, 4); s += __shfl_xor(s, 8); s += __shfl_xor(s, 16);
            ms[r] = __builtin_amdgcn_rsqf(s * (1.0f / 128.0f) + LN_EPS);
        }
        const float* sg = p->in[23] + li * 1024 + h * 128;
        const float post = 1.0f - lam_init;
        float gsc[4];
#pragma unroll
        for (int d0 = 0; d0 < 4; ++d0) gsc[d0] = sg[d0 * 32 + r32] * post;
        __syncthreads();
        unsigned char* stg = smem + wid * 8192;
#pragma unroll
        for (int r = 0; r < 16; ++r) {
            unsigned char* sp = stg + crow(r, hi) * 256 + r32 * 2;
#pragma unroll
            for (int d0 = 0; d0 < 4; ++d0) *(unsigned short*)(sp + d0 * 64) = (unsigned short)f2bf(On[d0][r] * ms[r] * gsc[d0]);
        }
        asm volatile("s_waitcnt lgkmcnt(0)" ::: "memory");
#pragma unroll
        for (int i2 = 0; i2 < 8; ++i2) {
            const int id = lane + 64 * i2, qr = id >> 4, ch = id & 15;
            const int pq = p0 + wid * 32 + qr;
            const int row = pq < 256 ? ML + b * 256 + pq : b * 2048 + (pq - 256);
            *(u32x4*)(Y + (size_t)row * 1024 + h * 128 + ch * 8) = *(const u32x4*)(stg + qr * 256 + ch * 16);
        }
        asm volatile("s_waitcnt lgkmcnt(0)" ::: "memory");
    }
}

#define XB_TMO      128
#define XB_XCNT(j)  (256  + 64 * (j))
#define XB_XSUB(j)  (1280 + 64 * (j))
#define XB_XGEN(j)  (2304 + 64 * (j))
#define XB_TOP      3328
#define XB_TOPGEN   3392
#define XCD_BAR_WORDS 3456
#define XB_SPIN_CAP (1u << 22)
DI unsigned xb_ld(unsigned* p)              { return __hip_atomic_load(p, __ATOMIC_RELAXED, __HIP_MEMORY_SCOPE_AGENT); }
DI unsigned xb_add(unsigned* p, unsigned v) { return __hip_atomic_fetch_add(p, v, __ATOMIC_RELAXED, __HIP_MEMORY_SCOPE_AGENT); }
DI unsigned xb_xcc_id() { return (unsigned)__builtin_amdgcn_s_getreg((3 << 11) | 20) & 0xFu; }
#define XB_SPIN(cond, bar) do { unsigned _sp = 0; while (cond) { __builtin_amdgcn_s_sleep(1); \
    if ((++_sp & 255u) == 0u) { if (xb_ld(&(bar)[XB_TMO])) break; if (_sp > XB_SPIN_CAP) { atomicAdd(&(bar)[XB_TMO], 1u); break; } } } } while (0)
struct XcdBarrier { unsigned* bar; unsigned x; volatile LAS unsigned* st; };
DI XcdBarrier xcd_barrier_post(unsigned* bar, volatile LAS unsigned* st) {
    XcdBarrier b; b.bar = bar; b.x = xb_xcc_id(); b.st = st;
    if (threadIdx.x == 0) (void)xb_add(&bar[XB_XCNT(b.x)], 1u);
    return b;
}
DI void xcd_barrier_complete(unsigned* bar, unsigned x, unsigned& nloc, unsigned& nx) {
    const unsigned G = gridDim.x * gridDim.y * gridDim.z;
    unsigned sum, cnt, mine, sp = 0u;
    for (;;) {
        sum = 0u; cnt = 0u; mine = 0u;
#pragma unroll
        for (unsigned j = 0; j < 16; ++j) { const unsigned c = xb_ld(&bar[XB_XCNT(j)]); sum += c; cnt += (c > 0u) ? 1u : 0u; mine = (j == x) ? c : mine; }
        if (sum == G) break;
        __builtin_amdgcn_s_sleep(1);
        if ((++sp & 255u) == 0u) { if (xb_ld(&bar[XB_TMO])) break; if (sp > XB_SPIN_CAP) { atomicAdd(&bar[XB_TMO], 1u); break; } }
    }
    nloc = mine > 0u ? mine : 1u; nx = cnt > 0u ? cnt : 1u;
}
DI void xcd_barrier(const XcdBarrier& b) {
    asm volatile("s_waitcnt vmcnt(0)" ::: "memory");
    __syncthreads();
    if (threadIdx.x == 0) {
        unsigned* bar = b.bar;
        __builtin_amdgcn_s_waitcnt(0);
        unsigned nloc = b.st[0], nx = b.st[1];
        if (nloc == 0u) { xcd_barrier_complete(bar, b.x, nloc, nx); b.st[0] = nloc; b.st[1] = nx; }
        const unsigned old = xb_add(&bar[XB_XSUB(b.x)], 1u);
        const unsigned gen = old / nloc;
        if (old + 1u == (gen + 1u) * nloc) {
            __builtin_amdgcn_fence(__ATOMIC_RELEASE, "agent");
            asm volatile("s_waitcnt vmcnt(0)" ::: "memory");
            const unsigned og = xb_add(&bar[XB_TOP], 1u);
            const unsigned tg = og / nx;
            if (og + 1u == (tg + 1u) * nx) xb_add(&bar[XB_TOPGEN], 1u);
            else XB_SPIN(xb_ld(&bar[XB_TOPGEN]) == tg, bar);
            __builtin_amdgcn_fence(__ATOMIC_ACQUIRE, "agent");
            xb_add(&bar[XB_XGEN(b.x)], 1u);
            asm volatile("s_waitcnt vmcnt(0)" ::: "memory");
        } else {
            XB_SPIN(xb_ld(&bar[XB_XGEN(b.x)]) == gen, bar);
            __builtin_amdgcn_fence(__ATOMIC_ACQUIRE, "agent");
            asm volatile("s_waitcnt vmcnt(0)" ::: "memory");
        }
    }
    __syncthreads();
}

#ifdef DOUBLE_MASK
#define DRYCOND (rep_ == 0 && nrep_ == 2)
#else
#define DRYCOND false
#endif
constexpr int NPHASE = 34;
constexpr int LDS_BYTES = 65536 + 1024;
__global__ void __launch_bounds__(256, 2) mega(Params pv) {
    extern __shared__ __attribute__((aligned(16))) unsigned char smem[];
    const int ph_lo = pv.ph_lo, ph_hi = pv.ph_hi;
    volatile LAS unsigned* bar_st = (volatile LAS unsigned*)(LAS unsigned char*)(smem + 65536);
    if (threadIdx.x == 0) { bar_st[0] = 0u; bar_st[1] = 0u; }
    __syncthreads();
    XcdBarrier xbar = xcd_barrier_post((unsigned*)(pv.ws + WS_CTL) + 4096, bar_st);
    for (int ph = ph_lo; ph < ph_hi; ++ph) {
        KP p = (KP)__builtin_amdgcn_kernarg_segment_ptr();
        asm volatile("" : "+s"(p) :: "memory");
#ifdef DOUBLE_MASK
        int kind_;
        if (ph == 0) kind_ = 0; else if (ph == 1) kind_ = 1;
        else { const int rem_ = (ph - 2) % 16; kind_ = rem_ == 0 ? 2 : (rem_ == 1 ? 12 : (rem_ < 9 ? rem_ + 1 : (rem_ == 9 ? 10 : (rem_ == 10 ? 11 : (rem_ - 11 + 5))))); }
        const int nrep_ = ((DOUBLE_MASK >> kind_) & 1) ? 2 : 1;
        for (int rep_ = 0; rep_ < nrep_; ++rep_) {
        if (rep_) xcd_barrier(xbar);
#endif
        if (ph == 0) phase_pre0(p, smem);
        else if (ph == 1) phase_pre1(p);
        else {
            const int q = ph - 2, lp = q / 16, rem = q % 16;
            if (rem < 9) {
                const int l = 2 * lp;
                switch (rem) {
                    case 0: phase_g1e(p, l, smem); break;
                    case 1: phase_decay(p, l, smem); break;
                    case 2: phase_scan(p, l, smem); break;
                    case 3: phase_merge(p, l); break;
                    case 4: phase_g2(p, l, smem); break;
                    case 5: if (DRYCOND) phase_ln1r<true>(p, l, smem); else phase_ln1r<false>(p, l, smem); break;
                    case 6: phase_mg1(p, l, smem); break;
                    case 7: phase_mg2(p, l, smem); break;
                    default: if (DRYCOND) phase_ln2<true>(p, l); else phase_ln2<false>(p, l); break;
                }
            } else {
                const int l = 2 * lp + 1;
                switch (rem - 9) {
                    case 0: phase_g1o(p, l, smem); break;
                    case 1: phase_att(p, l, smem); break;
                    case 2: phase_g2(p, l, smem); break;
                    case 3: if (DRYCOND) phase_ln1r<true>(p, l, smem); else phase_ln1r<false>(p, l, smem); break;
                    case 4: phase_mg1(p, l, smem); break;
                    case 5: phase_mg2(p, l, smem); break;
                    default: if (DRYCOND) phase_ln2<true>(p, l); else phase_ln2<false>(p, l); break;
                }
            }
        }
#ifdef DOUBLE_MASK
        }
#endif
        if (ph + 1 < ph_hi) xcd_barrier(xbar);
    }
}

extern "C" void kernel_launch(void* const* d_in, const int* in_sizes, int n_in, void* d_out, int out_size, void* d_ws, size_t ws_size, hipStream_t stream) {
    static int grid_blocks = 0;
    if (grid_blocks == 0) {
        if (n_in != 32 || ws_size < WS_END) { fprintf(stderr, "kernel_launch: unexpected n_in %d or ws_size %zu\n", n_in, ws_size); grid_blocks = -1; return; }
        int dev = 0, cus = 0, per_cu = 0;
        hipGetDevice(&dev);
        hipDeviceGetAttribute(&cus, hipDeviceAttributeMultiprocessorCount, dev);
        hipFuncSetAttribute((const void*)mega, hipFuncAttributeMaxDynamicSharedMemorySize, LDS_BYTES);
        hipOccupancyMaxActiveBlocksPerMultiprocessor(&per_cu, mega, 256, LDS_BYTES);
        if (per_cu > 2) per_cu = 2;
        if (per_cu < 1) per_cu = 1;
        grid_blocks = cus * per_cu;
    }
    if (grid_blocks < 0) return;
    hipMemsetAsync((char*)d_ws + WS_CTL, 0, 32768, stream);
    Params p{};
    for (int i = 0; i < 32; ++i) p.in[i] = (const float*)d_in[i];
    p.out = (float*)d_out; p.ws = (unsigned char*)d_ws;
#if N_LAUNCH_MODE == 1
    p.ph_lo = 0; p.ph_hi = NPHASE;
    void* args[] = {&p};
    hipError_t e = hipLaunchCooperativeKernel((void*)mega, dim3(grid_blocks), dim3(256), args, LDS_BYTES, stream);
    if (e != hipSuccess) fprintf(stderr, "cooperative launch failed: %s (grid %d)\n", hipGetErrorString(e), grid_blocks);
#else
    for (int ph = 0; ph < NPHASE; ++ph) {
        p.ph_lo = ph; p.ph_hi = ph + 1;
        hipLaunchKernelGGL(mega, dim3(grid_blocks), dim3(256), LDS_BYTES, stream, p);
    }
#endif
}
```

```cpp
#include <hip/hip_runtime.h>
#include <hip/hip_cooperative_groups.h>
#include <cstdio>
#include <cstdint>
namespace cg = cooperative_groups;

#ifndef N_LAUNCH_MODE
#define N_LAUNCH_MODE 1
#endif

#define DI __device__ __forceinline__
#define LAS __attribute__((address_space(3)))
typedef unsigned short bf16_t;
typedef short bf16x8 __attribute__((ext_vector_type(8)));
typedef short s16x4 __attribute__((ext_vector_type(4)));
typedef float f32x4 __attribute__((ext_vector_type(4)));
typedef float f32x16 __attribute__((ext_vector_type(16)));
typedef unsigned u32x4 __attribute__((ext_vector_type(4)));
typedef unsigned u32x2 __attribute__((ext_vector_type(2)));

constexpr int D = 1024, NB = 8, T = 2048, TC = 256, TA = T + TC;
constexpr int ML = NB * T, MC = NB * TC, MT = ML + MC;
constexpr int NIN = 3616, NINP = 3712, ZS = 3712;
constexpr int NSLOT = 2 * MT;
constexpr float LN_EPS = 1e-5f;
constexpr float ALPHA = 1.6817928305074290f;
constexpr float L2E = 1.4426950408889634f;

constexpr size_t MiB = 1ull << 20;
constexpr size_t WS_CTL = 0;
constexpr size_t WS_MOD = 1 * MiB;
constexpr size_t WS_ROPEA = 2 * MiB;
constexpr size_t WS_ROPEC = 3 * MiB;
constexpr size_t WS_LR = 4 * MiB;
constexpr size_t WS_SLOTW = 7 * MiB;
constexpr size_t WS_LIST = 8 * MiB;
constexpr size_t WS_WRT = 13 * MiB;
constexpr size_t WS_WIN = 16 * MiB;
constexpr size_t WS_WABO = 32 * MiB;
constexpr size_t WS_WQKV = 36 * MiB;
constexpr size_t WS_WCO = 48 * MiB;
constexpr size_t WS_WGU = 64 * MiB;
constexpr size_t WS_WD = 320 * MiB;
constexpr size_t WS_X = 448 * MiB;
constexpr size_t WS_U = 520 * MiB;
constexpr size_t WS_Y = 556 * MiB;
constexpr size_t WS_Z = 592 * MiB;
constexpr size_t WS_O = 724 * MiB;
constexpr size_t WS_PF = 868 * MiB, WS_SQ = 886 * MiB, WS_SK = 904 * MiB, WS_TOT = 922 * MiB;
constexpr size_t WS_END = 923 * MiB;
constexpr size_t WS_QC = WS_Z, WS_KC = WS_Z + 36 * MiB, WS_VT = WS_Z + 72 * MiB;
constexpr size_t WS_YS = WS_Z;
constexpr size_t WS_OF = WS_O, WS_OB = WS_O + 72 * MiB, WS_P = WS_O, WS_H = WS_O + 72 * MiB;

#ifndef XBF16
#define XBF16 0
#endif
#if XBF16
typedef bf16_t xres_t;
#else
typedef float xres_t;
#endif
struct Params { const float* in[32]; float* out; unsigned char* ws; int ph_lo, ph_hi; };
typedef const __attribute__((address_space(4))) Params* KP;

DI int TIDX() { int t = threadIdx.x; asm volatile("" : "+v"(t)); return t; }
DI int BIDX() { int b = blockIdx.x; asm volatile("" : "+s"(b)); return b; }
DI unsigned pk2(float lo, float hi);
DI unsigned f2bf(float f) { return pk2(f, 0.f) & 0xffffu; }
typedef float f32x2_t __attribute__((ext_vector_type(2))); typedef __bf16 bf16x2_t __attribute__((ext_vector_type(2)));
DI unsigned pk2(float lo, float hi) { f32x2_t v = {lo, hi}; bf16x2_t b = __builtin_convertvector(v, bf16x2_t); return __builtin_bit_cast(unsigned, b); }
DI float bflo(unsigned w) { return __uint_as_float(w << 16); }
DI float bfhi(unsigned w) { return __uint_as_float(w & 0xffff0000u); }
DI f32x4 xload(const xres_t* p) {
#if XBF16
    const u32x2 w = *(const u32x2*)p; return (f32x4){bflo(w.x), bfhi(w.x), bflo(w.y), bfhi(w.y)};
#else
    return *(const f32x4*)p;
#endif
}
DI void xstore(xres_t* p, f32x4 v) {
#if XBF16
    u32x2 w; w.x = pk2(v[0], v[1]); w.y = pk2(v[2], v[3]); *(u32x2*)p = w;
#else
    *(f32x4*)p = v;
#endif
}
DI float wave_sum(float v) {
#pragma unroll
    for (int o = 1; o < 64; o <<= 1) v += __shfl_xor(v, o);
    return v;
}
DI float siluf(float v) { return v * __builtin_amdgcn_rcpf(1.0f + __expf(-v)); }

DI int gemm_chunk(int tid) { return (tid & 7) ^ ((tid >> 4) & 7); }
template <bool TRN>
DI void gemm_tile(unsigned char* shm, const bf16_t* const (&ap)[4], const bf16_t* const (&bp)[4], int K, f32x4 (&acc)[4][4],
                  bool first, bool has_next, const bf16_t* const (&apn)[4], const bf16_t* const (&bpn)[4]) {
    const int tid = TIDX(), wid = tid >> 6, lane = tid & 63, wr = wid >> 1, wc = wid & 1, fr = lane & 15, fq = lane >> 4;
#pragma unroll
    for (int m = 0; m < 4; ++m)
#pragma unroll
        for (int n = 0; n < 4; ++n) acc[m][n] = (f32x4){0.f, 0.f, 0.f, 0.f};
    const int nt = K >> 6;
    const int sw = fr >> 1;
    const unsigned aoff = (unsigned)((wr * 64 + fr) * 128), boff = (unsigned)(16384 + (wc * 64 + fr) * 128);
#define GEMM_STAGE(buf, A_, B_, t) do { _Pragma("unroll") for (int i_ = 0; i_ < 4; ++i_) { \
        __builtin_amdgcn_global_load_lds((const unsigned*)(A_[i_] + (t) * 64), (LAS unsigned*)(shm + (buf) * 32768 + i_ * 4096 + tid * 16), 16, 0, 0); \
        __builtin_amdgcn_global_load_lds((const unsigned*)(B_[i_] + (t) * 64), (LAS unsigned*)(shm + (buf) * 32768 + 16384 + i_ * 4096 + tid * 16), 16, 0, 0); } } while (0)
    if (first) {
        GEMM_STAGE(0, ap, bp, 0);
        asm volatile("s_waitcnt vmcnt(0)" ::: "memory");
        __syncthreads();
    }
    for (int t = 0; t < nt; ++t) {
        const int cur = t & 1;
        if (t + 1 < nt) GEMM_STAGE(cur ^ 1, ap, bp, t + 1);
        else if (has_next) GEMM_STAGE(cur ^ 1, apn, bpn, 0);
        const unsigned char* base = shm + cur * 32768;
        bf16x8 At[2][4], Bt[2][4];
#pragma unroll
        for (int ks = 0; ks < 2; ++ks) {
            const unsigned co = (unsigned)(((ks * 4 + fq) ^ sw) << 4);
#pragma unroll
            for (int m = 0; m < 4; ++m) At[ks][m] = *(const bf16x8*)(base + aoff + m * 2048 + co);
#pragma unroll
            for (int n = 0; n < 4; ++n) Bt[ks][n] = *(const bf16x8*)(base + boff + n * 2048 + co);
        }
        __builtin_amdgcn_s_setprio(1);
#pragma unroll
        for (int ks = 0; ks < 2; ++ks)
#pragma unroll
            for (int m = 0; m < 4; ++m)
#pragma unroll
                for (int n = 0; n < 4; ++n)
                    acc[m][n] = TRN ? __builtin_amdgcn_mfma_f32_16x16x32_bf16(Bt[ks][n], At[ks][m], acc[m][n], 0, 0, 0)
                                    : __builtin_amdgcn_mfma_f32_16x16x32_bf16(At[ks][m], Bt[ks][n], acc[m][n], 0, 0, 0);
        __builtin_amdgcn_s_setprio(0);
        asm volatile("s_waitcnt vmcnt(0)" ::: "memory");
        __syncthreads();
    }
#undef GEMM_STAGE
}
#define GEMM_ADVANCE() do { _Pragma("unroll") for (int k_ = 0; k_ < 4; ++k_) { ap[k_] = apn[k_]; bp[k_] = bpn[k_]; } } while (0)
DI void gemm_rows(const bf16_t* base, int r0, int ld, int tid, const bf16_t* (&pp)[4]) {
    const bf16_t* q = base + (size_t)(r0 + (tid >> 3)) * ld + gemm_chunk(tid) * 8;
#pragma unroll
    for (int i = 0; i < 4; ++i) pp[i] = q + (size_t)(32 * i) * ld;
}
DI bool tile_seq(int q, int nrt, int nct, int& rt, int& ct) {
    if (q >= nrt * nct) return false;
    const int band = q / (8 * nct), rem = q - band * 8 * nct;
    const int rows = (nrt - band * 8) < 8 ? (nrt - band * 8) : 8;
    ct = rem / rows; rt = band * 8 + rem % rows;
    return true;
}
DI int xcd_seq(int i, int total) {
    const int G = gridDim.x, bid = BIDX();
    if ((G & 7) != 0) { const int q = i * G + bid; return q < total ? q : -1; }
    const int x = bid & 7, j = bid >> 3, per = (total + 7) >> 3, gx = G >> 3;
    const int q = i * gx + j;
    if (q >= per) return -1;
    const int g = x * per + q;
    return g < total ? g : -1;
}

template <int MODE>
DI void tr_item(const float* W, int K, int N, bf16_t* WT, float* scr, int item, int lane) {
    const int nblk = N / 32, kb = item / nblk, nb = item % nblk, k0 = 64 * kb, n0 = 32 * nb;
    float wv[32];
#pragma unroll
    for (int i = 0; i < 32; ++i) wv[i] = W[(size_t)(k0 + 2 * i + (lane >> 5)) * N + n0 + (lane & 31)];
#pragma unroll
    for (int i = 0; i < 32; ++i) scr[(2 * i + (lane >> 5)) * 33 + (lane & 31)] = wv[i];
    asm volatile("s_waitcnt lgkmcnt(0)" ::: "memory");
    const int c = lane & 7;
#pragma unroll
    for (int j = 0; j < 4; ++j) {
        const int n = (lane >> 3) + 8 * j; const float* s = scr + (8 * c) * 33 + n;
        u32x4 o; o.x = pk2(s[0 * 33], s[1 * 33]); o.y = pk2(s[2 * 33], s[3 * 33]); o.z = pk2(s[4 * 33], s[5 * 33]); o.w = pk2(s[6 * 33], s[7 * 33]);
        const int nn = n0 + n;
        const int drow = (MODE == 0) ? nn : ((nn >> 4) * 32 + (nn & 15) + (MODE == 2 ? 16 : 0));
        *(u32x4*)(WT + (size_t)drow * K + k0 + 8 * c) = o;
    }
    asm volatile("s_waitcnt lgkmcnt(0)" ::: "memory");
}

DI void phase_pre0(KP p, unsigned char* smem) {
    const int tid = TIDX(), wave = tid >> 6, lane = tid & 63;
    unsigned char* ws = p->ws;
    {
        float* s_sc = (float*)smem;
        float* s_red = s_sc + 9 * 1024;
        const float* c = p->in[1]; const float* cc = p->in[3];
        for (int i = tid; i < 9 * 1024; i += 256) { const int r = i >> 10, k = i & 1023; const float v = r < 8 ? c[r * 1024 + k] : cc[k]; s_sc[i] = v / (1.0f + expf(-v)); }
        __syncthreads();
        float* MOD = (float*)(ws + WS_MOD);
        for (int item = BIDX(); item < 384; item += gridDim.x) {
            const int l = item / 96, n0 = (item % 96) * 64;
            const float* W = p->in[4] + (size_t)l * 1024 * 6144 + n0 + lane;
            float acc[9];
#pragma unroll
            for (int r = 0; r < 9; ++r) acc[r] = 0.f;
#pragma unroll 16
            for (int k = wave * 256; k < wave * 256 + 256; ++k) {
                const float w = W[(size_t)k * 6144];
#pragma unroll
                for (int r = 0; r < 9; ++r) acc[r] += s_sc[r * 1024 + k] * w;
            }
#pragma unroll
            for (int r = 0; r < 9; ++r) s_red[(wave * 9 + r) * 64 + lane] = acc[r];
            __syncthreads();
            for (int i = tid; i < 9 * 64; i += 256) {
                const int r = i >> 6, ln = i & 63;
                const float v = s_red[(0 * 9 + r) * 64 + ln] + s_red[(1 * 9 + r) * 64 + ln] + s_red[(2 * 9 + r) * 64 + ln] + s_red[(3 * 9 + r) * 64 + ln];
                MOD[(size_t)(l * 9 + r) * 6144 + n0 + ln] = v + p->in[5][l * 6144 + n0 + ln];
            }
            __syncthreads();
        }
    }
    {
        const int gt = BIDX() * 256 + tid, NT = gridDim.x * 256;
        float* ca = (float*)(ws + WS_ROPEA); float* sa = ca + 2048 * 64;
        for (int i = gt; i < 2048 * 64; i += NT) {
            const int t = i >> 6, f = i & 63; const int pos = f < 32 ? (t >> 6) : (t & 63); const int ff = f & 31;
            const float inv = powf(10000.0f, -(float)ff / 32.0f); const float a = (float)pos * inv;
            ca[i] = cosf(a); sa[i] = sinf(a);
        }
        float* cc_ = (float*)(ws + WS_ROPEC); float* sc_ = cc_ + 2048 * 32;
        for (int i = gt; i < 2048 * 32; i += NT) {
            const int t = i >> 5, f = i & 31; const int pos = f < 16 ? (t >> 6) : (t & 63); const int ff = f & 15;
            const float inv = powf(10000.0f, -(float)ff / 16.0f); const float a = (float)pos * inv;
            cc_[i] = cosf(a); sc_[i] = sinf(a);
        }
        float* wrt = (float*)(ws + WS_WRT);
        for (int i = gt; i < 4 * 36 * 1024; i += NT) {
            const int l = i / (36 * 1024), o = (i / 1024) % 36, k = i & 1023;
            wrt[i] = o < 4 ? p->in[25][((size_t)l * 1024 + k) * 4 + o] : p->in[27][((size_t)l * 1024 + k) * 32 + (o - 4)];
        }
        unsigned* wpad = (unsigned*)(ws + WS_WIN);
        for (int i = gt; i < 2 * 96 * 512; i += NT) { const int li = i / (96 * 512), r = i % (96 * 512); wpad[((size_t)li * NINP + NIN) * 512 + r] = 0u; }
    }
    __syncthreads();
    {
        float* scr = (float*)smem + wave * (64 * 33);
        constexpr int I_IN = 16 * 113, I_SQ = 16 * 32, I_QKV = 16 * 96, I_E = 256;
        constexpr int R0 = 2 * I_IN, R1 = R0 + 2 * I_SQ, R2 = R1 + 2 * I_QKV, R3 = R2 + 2 * I_SQ, R4 = R3 + 128 * I_E, R5 = R4 + 128 * I_E, R6 = R5 + 128 * I_E;
        for (int it = BIDX() * 4 + wave; it < R6; it += gridDim.x * 4) {
            if (it < R0) { const int i = it / I_IN, r = it % I_IN; tr_item<0>(p->in[10] + (size_t)i * 1024 * NIN, 1024, NIN, (bf16_t*)(ws + WS_WIN) + (size_t)i * NINP * 1024, scr, r, lane); }
            else if (it < R1) { const int q = it - R0, i = q / I_SQ, r = q % I_SQ; tr_item<0>(p->in[17] + (size_t)i * 1024 * 1024, 1024, 1024, (bf16_t*)(ws + WS_WABO) + (size_t)i * 1024 * 1024, scr, r, lane); }
            else if (it < R2) { const int q = it - R1, i = q / I_QKV, r = q % I_QKV; tr_item<0>(p->in[18] + (size_t)i * 1024 * 3072, 1024, 3072, (bf16_t*)(ws + WS_WQKV) + (size_t)i * 3072 * 1024, scr, r, lane); }
            else if (it < R3) { const int q = it - R2, i = q / I_SQ, r = q % I_SQ; tr_item<0>(p->in[24] + (size_t)i * 1024 * 1024, 1024, 1024, (bf16_t*)(ws + WS_WCO) + (size_t)i * 1024 * 1024, scr, r, lane); }
            else if (it < R4) { const int q = it - R3, le = q / I_E, r = q % I_E; tr_item<1>(p->in[29] + (size_t)le * 1024 * 512, 1024, 512, (bf16_t*)(ws + WS_WGU) + (size_t)le * 1024 * 1024, scr, r, lane); }
            else if (it < R5) { const int q = it - R4, le = q / I_E, r = q % I_E; tr_item<2>(p->in[30] + (size_t)le * 1024 * 512, 1024, 512, (bf16_t*)(ws + WS_WGU) + (size_t)le * 1024 * 1024, scr, r, lane); }
            else { const int q = it - R5, le = q / I_E, r = q % I_E; tr_item<0>(p->in[31] + (size_t)le * 512 * 1024, 512, 1024, (bf16_t*)(ws + WS_WD) + (size_t)le * 1024 * 512, scr, r, lane); }
        }
    }
}

DI void phase_pre1(KP p) {
    const int tid = TIDX(), wave = tid >> 6, lane = tid & 63;
    xres_t* X = (xres_t*)(p->ws + WS_X); bf16_t* U = (bf16_t*)(p->ws + WS_U); const float* MOD = (const float*)(p->ws + WS_MOD);
    for (int row = BIDX() * 4 + wave; row < MT; row += gridDim.x * 4) {
        const float* src = row < ML ? p->in[0] + (size_t)row * 1024 : p->in[2] + (size_t)(row - ML) * 1024;
        const int r = row < ML ? (row >> 11) : 8;
        const float* mod = MOD + (size_t)r * 6144;
#pragma unroll
        for (int j = 0; j < 4; ++j) {
            const int k = 256 * j + 4 * lane;
            const f32x4 v = *(const f32x4*)(src + k), sh = *(const f32x4*)(mod + k), sc = *(const f32x4*)(mod + 1024 + k);
            const f32x4 u = v * (1.0f + sc) + sh;
            u32x2 w; w.x = pk2(u[0], u[1]); w.y = pk2(u[2], u[3]);
            *(u32x2*)(U + (size_t)row * 1024 + k) = w;
        }
    }
}

DI void phase_g1e(KP p, int l, unsigned char* smem) {
    const int tid = TIDX(), wid = tid >> 6, lane = tid & 63, wr = wid >> 1, wc = wid & 1, fr = lane & 15, fq = lane >> 4;
    const int li = l >> 1;
    const bf16_t* U = (const bf16_t*)(p->ws + WS_U); const bf16_t* W = (const bf16_t*)(p->ws + WS_WIN) + (size_t)li * NINP * 1024;
    bf16_t* Z = (bf16_t*)(p->ws + WS_Z); float* LR = (float*)(p->ws + WS_LR);
    const float* ca = (const float*)(p->ws + WS_ROPEA); const float* sa = ca + 2048 * 64;
    constexpr int NTN = NINP / 128;
    auto decode = [&](int i, int& brow, int& bcol) -> bool {
        const int q = xcd_seq(i, (MT / 128) * NTN); if (q < 0) return false;
        int rt, nt; tile_seq(q, MT / 128, NTN, rt, nt); brow = rt * 128; bcol = nt * 128; return true; };
    auto epi = [&](int brow, int bcol, f32x4 (&acc)[4][4]) {
        const int colw = bcol + wc * 64;
        if (colw >= NIN) return;
        if (colw >= 3584) {
#pragma unroll
            for (int m = 0; m < 4; ++m) { const int row = brow + wr * 64 + m * 16 + fr;
#pragma unroll
                for (int n = 0; n < 2; ++n) *(f32x4*)(LR + (size_t)row * 32 + n * 16 + fq * 4) = acc[m][n]; }
            return;
        }
        const bool ropeR = colw < 1024; const int half = (colw >> 6) & 1;
        const float scale = colw < 512 ? 0.08838834764831845f : ((colw >= 2048 && colw < 2304) ? 0.125f : 1.0f);
#pragma unroll
        for (int m = 0; m < 4; ++m) {
            const int row = brow + wr * 64 + m * 16 + fr;
            if (ropeR && row < ML) {
                const int t = row & 2047;
#pragma unroll
                for (int n = 0; n < 2; ++n) {
                    const f32x4 c4 = *(const f32x4*)(ca + t * 64 + half * 32 + n * 16 + fq * 4), s4 = *(const f32x4*)(sa + t * 64 + half * 32 + n * 16 + fq * 4);
                    const f32x4 a = acc[m][n], b = acc[m][n + 2];
                    acc[m][n] = a * c4 - b * s4; acc[m][n + 2] = b * c4 + a * s4;
                }
            }
#pragma unroll
            for (int n = 0; n < 4; ++n) {
                const f32x4 v = acc[m][n] * scale; u32x2 w; w.x = pk2(v[0], v[1]); w.y = pk2(v[2], v[3]);
                *(u32x2*)(Z + (size_t)row * ZS + colw + n * 16 + fq * 4) = w;
            }
        }
    };
    int brow, bcol;
    if (!decode(0, brow, bcol)) return;
    const bf16_t* ap[4]; const bf16_t* bp[4]; const bf16_t* apn[4]; const bf16_t* bpn[4];
    gemm_rows(U, brow, 1024, tid, ap); gemm_rows(W, bcol, 1024, tid, bp);
    bool first = true;
    for (int i = 0;; ++i) {
        int nbrow = brow, nbcol = bcol; const bool hn = decode(i + 1, nbrow, nbcol);
        gemm_rows(U, nbrow, 1024, tid, apn); gemm_rows(W, nbcol, 1024, tid, bpn);
        f32x4 acc[4][4];
        gemm_tile<true>(smem, ap, bp, 1024, acc, first, hn, apn, bpn);
        epi(brow, bcol, acc);
        if (!hn) break;
        brow = nbrow; bcol = nbcol; GEMM_ADVANCE(); first = false;
    }
}

DI void phase_g1o(KP p, int l, unsigned char* smem) {
    const int tid = TIDX(), wid = tid >> 6, lane = tid & 63, wr = wid >> 1, wc = wid & 1, fr = lane & 15, fq = lane >> 4;
    const int li = l >> 1;
    const bf16_t* U = (const bf16_t*)(p->ws + WS_U); const bf16_t* W = (const bf16_t*)(p->ws + WS_WQKV) + (size_t)li * 3072 * 1024;
    bf16_t* Qc = (bf16_t*)(p->ws + WS_QC); bf16_t* Kc = (bf16_t*)(p->ws + WS_KC); bf16_t* Vt = (bf16_t*)(p->ws + WS_VT);
    const float* cc = (const float*)(p->ws + WS_ROPEC); const float* sc = cc + 2048 * 32;
    auto decode = [&](int i, int& brow, int& bcol) -> bool {
        const int q = xcd_seq(i, (MT / 128) * 24); if (q < 0) return false;
        int rt, nt; tile_seq(q, MT / 128, 24, rt, nt); brow = rt * 128; bcol = nt * 128; return true; };
    int brow, bcol;
    if (!decode(0, brow, bcol)) return;
    const bf16_t* ap[4]; const bf16_t* bp[4]; const bf16_t* apn[4]; const bf16_t* bpn[4];
    gemm_rows(U, brow, 1024, tid, ap); gemm_rows(W, bcol, 1024, tid, bp);
    bool first = true;
    for (int i = 0;; ++i) {
        int nbrow = brow, nbcol = bcol; const bool hn = decode(i + 1, nbrow, nbcol);
        gemm_rows(U, nbrow, 1024, tid, apn); gemm_rows(W, nbcol, 1024, tid, bpn);
        f32x4 acc[4][4];
        if (bcol < 2048) {
            gemm_tile<true>(smem, ap, bp, 1024, acc, first, hn, apn, bpn);
            const int colw = bcol + wc * 64; const bool isk = colw >= 1024; const int hc = (colw & 1023) >> 6;
            bf16_t* dst = isk ? Kc : Qc; const float scale = isk ? 1.0f : 0.125f;
#pragma unroll
            for (int m = 0; m < 4; ++m) {
                const int row = brow + wr * 64 + m * 16 + fr;
                int b, pidx;
                if (row < ML) {
                    b = row >> 11; const int t = row & 2047; pidx = 256 + t;
#pragma unroll
                    for (int n = 0; n < 4; n += 2) {
                        const f32x4 c4 = *(const f32x4*)(cc + t * 32 + (n >> 1) * 16 + fq * 4), s4 = *(const f32x4*)(sc + t * 32 + (n >> 1) * 16 + fq * 4);
                        const f32x4 a = acc[m][n], bb = acc[m][n + 1];
                        acc[m][n] = a * c4 - bb * s4; acc[m][n + 1] = bb * c4 + a * s4;
                    }
                } else { b = (row - ML) >> 8; pidx = (row - ML) & 255; }
                bf16_t* o = dst + ((size_t)(b * 16 + hc) * TA + pidx) * 64;
#pragma unroll
                for (int n = 0; n < 4; ++n) { const f32x4 v = acc[m][n] * scale; u32x2 w; w.x = pk2(v[0], v[1]); w.y = pk2(v[2], v[3]); *(u32x2*)(o + n * 16 + fq * 4) = w; }
            }
        } else {
            gemm_tile<false>(smem, ap, bp, 1024, acc, first, hn, apn, bpn);
#pragma unroll
            for (int m = 0; m < 4; ++m) {
                const int row = brow + wr * 64 + m * 16 + fq * 4;
                int b, pidx;
                if (row < ML) { b = row >> 11; pidx = 256 + (row & 2047); } else { b = (row - ML) >> 8; pidx = (row - ML) & 255; }
                const int ppos = (pidx & ~12) | ((pidx & 8) >> 1) | ((pidx & 4) << 1);
#pragma unroll
                for (int n = 0; n < 4; ++n) {
                    const int col = bcol - 2048 + wc * 64 + n * 16 + fr; const int h = col >> 7, d = col & 127;
                    const f32x4 v = acc[m][n]; u32x2 w; w.x = pk2(v[0], v[1]); w.y = pk2(v[2], v[3]);
                    *(u32x2*)(Vt + ((size_t)(b * 8 + h) * 128 + d) * TA + ppos) = w;
                }
            }
        }
        if (!hn) break;
        brow = nbrow; bcol = nbcol; GEMM_ADVANCE(); first = false;
    }
}

DI void phase_g2(KP p, int l, unsigned char* smem) {
    const int tid = TIDX(), wid = tid >> 6, lane = tid & 63, wr = wid >> 1, wc = wid & 1, fr = lane & 15, fq = lane >> 4;
    const int li = l >> 1;
    const bf16_t* Y = (const bf16_t*)(p->ws + WS_Y);
    const bf16_t* W = (const bf16_t*)(p->ws + ((l & 1) ? WS_WCO : WS_WABO)) + (size_t)li * 1024 * 1024;
    bf16_t* P = (bf16_t*)(p->ws + WS_P);
    const int nrt = (l == 3 ? ML : MT) / 128;
    auto decode = [&](int i, int& brow, int& bcol) -> bool {
        const int q = xcd_seq(i, nrt * 8); if (q < 0) return false;
        int rt, nt; tile_seq(q, nrt, 8, rt, nt); brow = rt * 128; bcol = nt * 128; return true; };
    int brow, bcol;
    if (!decode(0, brow, bcol)) return;
    const bf16_t* ap[4]; const bf16_t* bp[4]; const bf16_t* apn[4]; const bf16_t* bpn[4];
    gemm_rows(Y, brow, 1024, tid, ap); gemm_rows(W, bcol, 1024, tid, bp);
    bool first = true;
    for (int i = 0;; ++i) {
        int nbrow = brow, nbcol = bcol; const bool hn = decode(i + 1, nbrow, nbcol);
        gemm_rows(Y, nbrow, 1024, tid, apn); gemm_rows(W, nbcol, 1024, tid, bpn);
        f32x4 acc[4][4];
        gemm_tile<true>(smem, ap, bp, 1024, acc, first, hn, apn, bpn);
#pragma unroll
        for (int m = 0; m < 4; ++m) { const int row = brow + wr * 64 + m * 16 + fr;
#pragma unroll
            for (int n = 0; n < 4; ++n) { const f32x4 v = acc[m][n]; u32x2 w; w.x = pk2(v[0], v[1]); w.y = pk2(v[2], v[3]); *(u32x2*)(P + (size_t)row * 1024 + bcol + wc * 64 + n * 16 + fq * 4) = w; } }
        if (!hn) break;
        brow = nbrow; bcol = nbcol; GEMM_ADVANCE(); first = false;
    }
}

template <bool DRY>
DI void phase_ln1r(KP p, int l, unsigned char* smem) {
    constexpr int US = 1028;
    constexpr int RB = 12;
    float* Us = (float*)smem;
    float* Ps = Us + RB * US;
    const int tid = TIDX(), wave = tid >> 6, lane = tid & 63;
    const xres_t* X = (const xres_t*)(p->ws + WS_X); xres_t* Xo = (xres_t*)(p->ws + (DRY ? WS_OB : WS_X)); const bf16_t* P = (const bf16_t*)(p->ws + WS_P); bf16_t* U = (bf16_t*)(p->ws + (DRY ? WS_Y : WS_U));
    const float* MOD = (const float*)(p->ws + WS_MOD); const float* WrT = (const float*)(p->ws + WS_WRT) + (size_t)l * 36 * 1024;
    const float* lng = p->in[6] + l * 1024; const float* lnb = p->in[7] + l * 1024;
    const float* bgrp = p->in[26] + l * 4; const float* brex = p->in[28] + l * 32;
    unsigned* cnt = (unsigned*)(p->ws + WS_CTL) + l * 32 + (DRY ? 256 : 0); int* list = (int*)(p->ws + WS_LIST); float* slotw = (float*)(p->ws + WS_SLOTW);
    const int rows_total = (l == 3) ? ML : MT;
    const int mi = lane & 15, mq = lane >> 4;
    int pend_slot = -1, pend_e = 0; unsigned pend_pos = 0u;
    for (int it = BIDX(); it * RB < rows_total; it += gridDim.x) {
        const int row0 = it * RB + wave * 3;
#pragma unroll
        for (int rr = 0; rr < 3; ++rr) {
            const int rowr = row0 + rr; const bool rvalid = rowr < rows_total; const int row = rvalid ? rowr : rows_total - 1;
            const int r = row < ML ? (row >> 11) : 8;
            const float* mod = MOD + (size_t)(l * 9 + r) * 6144;
            f32x4 v[4]; float s = 0.f;
#pragma unroll
            for (int j = 0; j < 4; ++j) {
                const int k = 256 * j + 4 * lane;
                const f32x4 xv = (l == 0) ? *(const f32x4*)((row < ML ? p->in[0] + (size_t)row * 1024 : p->in[2] + (size_t)(row - ML) * 1024) + k) : xload(X + (size_t)row * 1024 + k);
                const f32x4 g1 = *(const f32x4*)(mod + 2048 + k);
                const u32x2 pw_ = *(const u32x2*)(P + (size_t)row * 1024 + k); const f32x4 pv = (f32x4){bflo(pw_.x), bfhi(pw_.x), bflo(pw_.y), bfhi(pw_.y)};
                v[j] = xv * ALPHA + g1 * pv; s += (v[j][0] + v[j][1]) + (v[j][2] + v[j][3]);
            }
            const float mean = wave_sum(s) * (1.0f / 1024.0f); float s2 = 0.f;
#pragma unroll
            for (int j = 0; j < 4; ++j) { v[j] = v[j] - mean; s2 += (v[j][0] * v[j][0] + v[j][1] * v[j][1]) + (v[j][2] * v[j][2] + v[j][3] * v[j][3]); }
            const float rstd = 1.0f / sqrtf(wave_sum(s2) * (1.0f / 1024.0f) + LN_EPS);
#pragma unroll
            for (int j = 0; j < 4; ++j) {
                const int k = 256 * j + 4 * lane;
                const f32x4 xn = v[j] * rstd * *(const f32x4*)(lng + k) + *(const f32x4*)(lnb + k);
                const f32x4 uu = xn * (1.0f + *(const f32x4*)(mod + 4096 + k)) + *(const f32x4*)(mod + 3072 + k);
                *(f32x4*)(Us + (wave * 3 + rr) * US + k) = uu;
                if (rvalid) {
                    xstore(Xo + (size_t)row * 1024 + k, xn);
                    u32x2 w; w.x = pk2(uu[0], uu[1]); w.y = pk2(uu[2], uu[3]);
                    *(u32x2*)(U + (size_t)row * 1024 + k) = w;
                }
            }
        }
        __syncthreads();
        {
            f32x4 acc[3] = {(f32x4){0.f, 0.f, 0.f, 0.f}, (f32x4){0.f, 0.f, 0.f, 0.f}, (f32x4){0.f, 0.f, 0.f, 0.f}};
            const float* ap = Us + (mi < RB ? mi : mi - RB) * US + 256 * wave + 4 * mq;
            const float* bp0 = WrT + (size_t)mi * 1024 + 256 * wave + 4 * mq;
            const float* bp1 = WrT + (size_t)(16 + mi) * 1024 + 256 * wave + 4 * mq;
            const float* bp2 = WrT + (size_t)(32 + (mi & 3)) * 1024 + 256 * wave + 4 * mq;
#pragma unroll 4
            for (int sb = 0; sb < 16; ++sb) {
                const f32x4 a = *(const f32x4*)(ap + 16 * sb);
                const f32x4 b0 = *(const f32x4*)(bp0 + 16 * sb), b1 = *(const f32x4*)(bp1 + 16 * sb), b2 = *(const f32x4*)(bp2 + 16 * sb);
#pragma unroll
                for (int e = 0; e < 4; ++e) {
                    acc[0] = __builtin_amdgcn_mfma_f32_16x16x4f32(a[e], b0[e], acc[0], 0, 0, 0);
                    acc[1] = __builtin_amdgcn_mfma_f32_16x16x4f32(a[e], b1[e], acc[1], 0, 0, 0);
                    acc[2] = __builtin_amdgcn_mfma_f32_16x16x4f32(a[e], b2[e], acc[2], 0, 0, 0);
                }
            }
            if (mq < 3) {
#pragma unroll
                for (int nt = 0; nt < 3; ++nt)
#pragma unroll
                    for (int rg = 0; rg < 4; ++rg) Ps[(wave * RB + mq * 4 + rg) * 48 + nt * 16 + mi] = acc[nt][rg];
            }
        }
        __syncthreads();
        if (wave < 2) {
            const int r = wave * 8 + (lane >> 3), c = lane & 7;
            const int rq = r < RB ? r : RB - 1;
            const int row = it * RB + rq;
            float lgv[5];
#pragma unroll
            for (int k = 0; k < 5; ++k) {
                const int o = c + 8 * k; const int oo = o < 36 ? o : 35;
                lgv[k] = (Ps[(0 * RB + rq) * 48 + oo] + Ps[(1 * RB + rq) * 48 + oo]) + (Ps[(2 * RB + rq) * 48 + oo] + Ps[(3 * RB + rq) * 48 + oo]);
            }
            float gv = c < 4 ? lgv[0] + bgrp[c & 3] : -3.0e38f; int gi = c;
#pragma unroll
            for (int off = 1; off < 4; off <<= 1) {
                const float ov = __shfl_xor(gv, off); const int oi = __shfl_xor(gi, off);
                if (ov > gv || (ov == gv && oi < gi)) { gv = ov; gi = oi; }
            }
            const int src0 = lane & ~7;
            const float gmax = __shfl(gv, src0); const int grp = __shfl(gi, src0);
            float ge = c < 4 ? expf(lgv[0] + bgrp[c & 3] - gmax) : 0.f;
            ge += __shfl_xor(ge, 1); ge += __shfl_xor(ge, 2);
            const float gw = 1.0f / __shfl(ge, src0);
            const int j = (c + 4) & 7; const int kk = c >= 4 ? grp : grp + 1;
            float ev = lgv[0];
#pragma unroll
            for (int k = 1; k < 5; ++k) ev = (kk == k) ? lgv[k] : ev;
            ev += brex[grp * 8 + j];
            float v1 = ev; int i1 = j;
#pragma unroll
            for (int off = 1; off < 8; off <<= 1) {
                const float ov = __shfl_xor(v1, off); const int oi = __shfl_xor(i1, off);
                if (ov > v1 || (ov == v1 && oi < i1)) { v1 = ov; i1 = oi; }
            }
            float v2 = (j == i1) ? -3.0e38f : ev; int i2 = (j == i1) ? 99 : j;
#pragma unroll
            for (int off = 1; off < 8; off <<= 1) {
                const float ov = __shfl_xor(v2, off); const int oi = __shfl_xor(i2, off);
                if (ov > v2 || (ov == v2 && oi < i2)) { v2 = ov; i2 = oi; }
            }
            const float e2 = expf(v2 - v1);
            const float w1 = 1.0f / (1.0f + e2), w2 = e2 / (1.0f + e2);
            if (c < 2 && r < RB && row < rows_total) {
                if (pend_slot >= 0) list[(size_t)pend_e * NSLOT + pend_pos] = pend_slot;
                const int e = grp * 8 + (c ? i2 : i1); const float w = gw * (c ? w2 : w1);
                const int slot = row * 2 + c;
                slotw[slot] = w;
                pend_pos = atomicAdd(&cnt[e], 1u); pend_e = e; pend_slot = slot;
            }
        }
        __syncthreads();
    }
    if (pend_slot >= 0) list[(size_t)pend_e * NSLOT + pend_pos] = pend_slot;
}

DI void moe_prefix(KP p, int l, int* s_cnt, int* s_tb, int* s_rb) {
    const int tid = TIDX();
    const unsigned* cnt = (const unsigned*)(p->ws + WS_CTL) + l * 32;
    __syncthreads();
    if (tid < 32) s_cnt[tid] = (int)__hip_atomic_load(cnt + tid, __ATOMIC_RELAXED, __HIP_MEMORY_SCOPE_AGENT);
    __syncthreads();
    if (tid == 0) { int tb = 0; for (int e = 0; e < 32; ++e) { s_tb[e] = tb; s_rb[e] = tb * 128; tb += (s_cnt[e] + 127) >> 7; } s_tb[32] = tb; s_rb[32] = tb * 128; }
    __syncthreads();
}
DI void phase_mg1(KP p, int l, unsigned char* smem) {
    const int tid = TIDX(), wid = tid >> 6, lane = tid & 63, wr = wid >> 1, wc = wid & 1, fr = lane & 15, fq = lane >> 4;
    int* s_cnt = (int*)(smem + 65536 + 64); int* s_tb = s_cnt + 32; int* s_rb = s_tb + 33;
    moe_prefix(p, l, s_cnt, s_tb, s_rb);
    const bf16_t* U = (const bf16_t*)(p->ws + WS_U); const int* list = (const int*)(p->ws + WS_LIST);
    bf16_t* H = (bf16_t*)(p->ws + WS_H);
    const int ntiles = s_tb[32] * 8;
    struct TI { int e, rt, nt, cnt_e; };
    auto decode = [&](int i, TI& t) -> bool {
        const int tile = xcd_seq(i, ntiles); if (tile < 0) return false;
        const int rtg = tile >> 3; t.nt = tile & 7;
        int e = 0;
        for (int q = 1; q < 32; ++q) if (rtg >= s_tb[q]) e = q;
        t.e = e; t.rt = rtg - s_tb[e]; t.cnt_e = s_cnt[e]; return true; };
    auto rows = [&](const TI& t, const bf16_t* (&a)[4], const bf16_t* (&b)[4]) {
#pragma unroll
        for (int i_ = 0; i_ < 4; ++i_) {
            const int pos = t.rt * 128 + (tid >> 3) + 32 * i_;
            const int tok = pos < t.cnt_e ? (list[(size_t)t.e * NSLOT + pos] >> 1) : 0;
            a[i_] = U + (size_t)tok * 1024 + gemm_chunk(tid) * 8;
        }
        gemm_rows((const bf16_t*)(p->ws + WS_WGU) + (size_t)(l * 32 + t.e) * 1024 * 1024, t.nt * 128, 1024, tid, b); };
    TI cur, nxt;
    if (!decode(0, cur)) return;
    const bf16_t* ap[4]; const bf16_t* bp[4]; const bf16_t* apn[4]; const bf16_t* bpn[4];
    rows(cur, ap, bp);
    bool first = true;
    for (int i = 0;; ++i) {
        nxt = cur; const bool hn = decode(i + 1, nxt);
        rows(nxt, apn, bpn);
        f32x4 acc[4][4];
        gemm_tile<true>(smem, ap, bp, 1024, acc, first, hn, apn, bpn);
        const int hrow0 = s_rb[cur.e] + cur.rt * 128 + wr * 64;
#pragma unroll
        for (int m = 0; m < 4; ++m) {
            bf16_t* o = H + (size_t)(hrow0 + m * 16 + fr) * 512 + cur.nt * 64 + wc * 32 + fq * 4;
#pragma unroll
            for (int n = 0; n < 4; n += 2) {
                const f32x4 g = acc[m][n], uu = acc[m][n + 1]; f32x4 h;
#pragma unroll
                for (int j = 0; j < 4; ++j) h[j] = siluf(g[j]) * uu[j];
                u32x2 w; w.x = pk2(h[0], h[1]); w.y = pk2(h[2], h[3]);
                *(u32x2*)(o + (n >> 1) * 16) = w;
            }
        }
        if (!hn) break;
        cur = nxt; GEMM_ADVANCE(); first = false;
    }
}
DI void phase_mg2(KP p, int l, unsigned char* smem) {
    const int tid = TIDX(), wid = tid >> 6, lane = tid & 63, wr = wid >> 1, wc = wid & 1, fr = lane & 15, fq = lane >> 4;
    int* s_cnt = (int*)(smem + 65536 + 64); int* s_tb = s_cnt + 32; int* s_rb = s_tb + 33;
    moe_prefix(p, l, s_cnt, s_tb, s_rb);
    const bf16_t* H = (const bf16_t*)(p->ws + WS_H); const int* list = (const int*)(p->ws + WS_LIST); const float* slotw = (const float*)(p->ws + WS_SLOTW);
    bf16_t* YS = (bf16_t*)(p->ws + WS_YS);
    const int ntiles = s_tb[32] * 8;
    struct TI { int e, rt, nt, cnt_e; };
    auto decode = [&](int i, TI& t) -> bool {
        const int tile = xcd_seq(i, ntiles); if (tile < 0) return false;
        const int rtg = tile >> 3; t.nt = tile & 7;
        int e = 0;
        for (int q = 1; q < 32; ++q) if (rtg >= s_tb[q]) e = q;
        t.e = e; t.rt = rtg - s_tb[e]; t.cnt_e = s_cnt[e]; return true; };
    auto rows = [&](const TI& t, const bf16_t* (&a)[4], const bf16_t* (&b)[4]) {
        gemm_rows(H, s_rb[t.e] + t.rt * 128, 512, tid, a);
        gemm_rows((const bf16_t*)(p->ws + WS_WD) + (size_t)(l * 32 + t.e) * 1024 * 512, t.nt * 128, 512, tid, b); };
    TI cur, nxt;
    if (!decode(0, cur)) return;
    const bf16_t* ap[4]; const bf16_t* bp[4]; const bf16_t* apn[4]; const bf16_t* bpn[4];
    rows(cur, ap, bp);
    bool first = true;
    for (int i = 0;; ++i) {
        nxt = cur; const bool hn = decode(i + 1, nxt);
        rows(nxt, apn, bpn);
        f32x4 acc[4][4];
        gemm_tile<true>(smem, ap, bp, 512, acc, first, hn, apn, bpn);
#pragma unroll
        for (int m = 0; m < 4; ++m) {
            const int pos = cur.rt * 128 + wr * 64 + m * 16 + fr;
            if (pos < cur.cnt_e) {
                const int slot = list[(size_t)cur.e * NSLOT + pos]; const float w = slotw[slot];
                bf16_t* o = YS + (size_t)slot * 1024 + cur.nt * 128 + wc * 64 + fq * 4;
#pragma unroll
                for (int n = 0; n < 4; ++n) { const f32x4 v = acc[m][n] * w; u32x2 ww; ww.x = pk2(v[0], v[1]); ww.y = pk2(v[2], v[3]); *(u32x2*)(o + n * 16) = ww; }
            }
        }
        if (!hn) break;
        cur = nxt; GEMM_ADVANCE(); first = false;
    }
}

template <bool DRY>
DI void phase_ln2(KP p, int l) {
    const int tid = TIDX(), wave = tid >> 6, lane = tid & 63;
    const xres_t* X = (const xres_t*)(p->ws + WS_X); xres_t* Xo = (xres_t*)(p->ws + (DRY ? WS_OB : WS_X)); const bf16_t* YS = (const bf16_t*)(p->ws + WS_YS); bf16_t* U = (bf16_t*)(p->ws + (DRY ? WS_Y : WS_U));
    const float* MOD = (const float*)(p->ws + WS_MOD);
    const float* lng = p->in[8] + l * 1024; const float* lnb = p->in[9] + l * 1024;
    const int rows_total = (l == 3) ? ML : MT;
    for (int row0 = (BIDX() * 4 + wave) * 2; row0 < rows_total; row0 += gridDim.x * 8) {
        f32x4 v[2][4]; float s[2] = {0.f, 0.f};
        const float* mod[2];
#pragma unroll
        for (int q = 0; q < 2; ++q) {
            const int row = row0 + q; const int r = row < ML ? (row >> 11) : 8;
            mod[q] = MOD + (size_t)(l * 9 + r) * 6144;
#pragma unroll
            for (int j = 0; j < 4; ++j) {
                const int k = 256 * j + 4 * lane;
                const u32x2 y0 = *(const u32x2*)(YS + (size_t)(2 * row) * 1024 + k), y1 = *(const u32x2*)(YS + (size_t)(2 * row + 1) * 1024 + k);
                f32x4 y; y[0] = bflo(y0.x) + bflo(y1.x); y[1] = bfhi(y0.x) + bfhi(y1.x); y[2] = bflo(y0.y) + bflo(y1.y); y[3] = bfhi(y0.y) + bfhi(y1.y);
                const f32x4 xv = xload(X + (size_t)row * 1024 + k), g2 = *(const f32x4*)(mod[q] + 5120 + k);
                v[q][j] = xv * ALPHA + g2 * y; s[q] += (v[q][j][0] + v[q][j][1]) + (v[q][j][2] + v[q][j][3]);
            }
        }
        float mean[2], rstd[2];
#pragma unroll
        for (int q = 0; q < 2; ++q) mean[q] = wave_sum(s[q]) * (1.0f / 1024.0f);
#pragma unroll
        for (int q = 0; q < 2; ++q) {
            float s2 = 0.f;
#pragma unroll
            for (int j = 0; j < 4; ++j) { v[q][j] = v[q][j] - mean[q]; s2 += (v[q][j][0] * v[q][j][0] + v[q][j][1] * v[q][j][1]) + (v[q][j][2] * v[q][j][2] + v[q][j][3] * v[q][j][3]); }
            s[q] = s2;
        }
#pragma unroll
        for (int q = 0; q < 2; ++q) rstd[q] = 1.0f / sqrtf(wave_sum(s[q]) * (1.0f / 1024.0f) + LN_EPS);
#pragma unroll
        for (int q = 0; q < 2; ++q) {
            const int row = row0 + q;
            const float* modn = mod[q] + (l + 1 < 4 ? 9 * 6144 : 0);
#pragma unroll
            for (int j = 0; j < 4; ++j) {
                const int k = 256 * j + 4 * lane;
                const f32x4 xn = v[q][j] * rstd[q] * *(const f32x4*)(lng + k) + *(const f32x4*)(lnb + k);
                if (l < 3) {
                    xstore(Xo + (size_t)row * 1024 + k, xn);
                    const f32x4 uu = xn * (1.0f + *(const f32x4*)(modn + 1024 + k)) + *(const f32x4*)(modn + k);
                    u32x2 w; w.x = pk2(uu[0], uu[1]); w.y = pk2(uu[2], uu[3]);
                    *(u32x2*)(U + (size_t)row * 1024 + k) = w;
                } else {
                    *(f32x4*)(p->out + (size_t)row * 1024 + k) = xn;
                }
            }
        }
    }
}

DI s16x4 tr_read(const unsigned char* ptr) {
    typedef short v4i16_t __attribute__((ext_vector_type(4)));
    return __builtin_bit_cast(s16x4, __builtin_amdgcn_ds_read_tr16_b64_v4i16((LAS v4i16_t*)ptr));
}
DI bf16x8 cat8(s16x4 a, s16x4 b) { return __builtin_shufflevector(a, b, 0, 1, 2, 3, 4, 5, 6, 7); }

DI void phase_decay(KP p, int l, unsigned char* smem) {
    const int tid = TIDX();
    const int li = l >> 1;
    const float* LR = (const float*)(p->ws + WS_LR);
    float* PF = (float*)(p->ws + WS_PF); float* SQ = (float*)(p->ws + WS_SQ); float* SK = (float*)(p->ws + WS_SK); float* TOT = (float*)(p->ws + WS_TOT);
    float* lrs = (float*)smem;
    float wf[16], wb[16];
#pragma unroll
    for (int r = 0; r < 16; ++r) { wf[r] = p->in[11][(size_t)li * 16 * 256 + r * 256 + tid]; wb[r] = p->in[13][(size_t)li * 16 * 256 + r * 256 + tid]; }
    const float bf = p->in[12][li * 256 + tid], bb = p->in[14][li * 256 + tid];
    for (int it = BIDX(); it < 2 * (MT / 64); it += gridDim.x) {
        const int ch = it >> 1, dr = it & 1;
        const int row0 = ch * 64;
        __syncthreads();
        { const int tok = tid >> 2, q4 = tid & 3; *(f32x4*)(lrs + tok * 16 + q4 * 4) = *(const f32x4*)(LR + (size_t)(row0 + tok) * 32 + dr * 16 + q4 * 4); }
        __syncthreads();
        float run = 0.f;
        if (dr == 0) {
            for (int t = 0; t < 64; ++t) {
                float g = bf;
#pragma unroll
                for (int r = 0; r < 16; ++r) g += lrs[t * 16 + r] * wf[r];
                run += (fminf(g, 0.f) - __logf(1.0f + __expf(-fabsf(g)))) * (1.0f / 16.0f);
                PF[(size_t)(row0 + t) * 256 + tid] = run;
            }
        } else {
            for (int t = 63; t >= 0; --t) {
                float g = bb;
#pragma unroll
                for (int r = 0; r < 16; ++r) g += lrs[t * 16 + r] * wb[r];
                SQ[(size_t)(row0 + t) * 256 + tid] = run;
                run += (fminf(g, 0.f) - __logf(1.0f + __expf(-fabsf(g)))) * (1.0f / 16.0f);
                SK[(size_t)(row0 + t) * 256 + tid] = run;
            }
        }
        TOT[(size_t)(ch * 2 + dr) * 256 + tid] = run;
    }
}

template <int DK>
DI void scan_item(KP p, int l, int item, unsigned char* smem) {
    constexpr bool ISA = (DK == 128);
    constexpr int QS = DK * 2 + 16, KS = DK * 2 + 32, VS = 96, AS_ = 144, SS = DK * 2 + 16, NKS = DK / 32, NMT = DK / 64;
    constexpr int O_QD = 0, O_KD = O_QD + 64 * QS, O_V = O_KD + 64 * KS, O_ATT = O_V + 64 * VS, O_ST = O_ATT + 64 * AS_, O_END = O_ST + 32 * SS;
    static_assert(O_END <= 65536, "scan LDS");
    constexpr int NP = DK / 64 * 2;
    constexpr int CPR = DK / 8;
    const int tid = TIDX(), wid = tid >> 6, lane = tid & 63, fr = lane & 15, fq = lane >> 4;
    const int b = item >> 5, h = (item >> 3) & 3, dir = (item >> 2) & 1, dvq = item & 3;
    const bf16_t* Z = (const bf16_t*)(p->ws + WS_Z);
    const float* EQ = (const float*)(p->ws + (dir ? WS_SQ : WS_PF)); const float* EK = (const float*)(p->ws + (dir ? WS_SK : WS_PF)); const float* TOT = (const float*)(p->ws + WS_TOT);
    bf16_t* OUT = (bf16_t*)(p->ws + (dir ? WS_OB : WS_OF));
    const int qcol = ISA ? h * 128 : 2048 + h * 64, kcol = ISA ? 512 + h * 128 : 2304 + h * 64, vcol = (ISA ? 1024 : 2560) + h * 128 + dvq * 32;
    const int ocol = (ISA ? 0 : 512) + h * 128 + dvq * 32;
    float lam = 0.f;
    if (ISA) lam = log1pf(-exp2f(-((dir ? 5.5f : 5.0f) + (float)h)));
    f32x4 S[NMT][2];
#pragma unroll
    for (int a = 0; a < NMT; ++a) { S[a][0] = (f32x4){0.f, 0.f, 0.f, 0.f}; S[a][1] = (f32x4){0.f, 0.f, 0.f, 0.f}; }
    __syncthreads();
    for (int i = tid; i < 32 * SS / 4; i += 256) ((unsigned*)(smem + O_ST))[i] = 0u;
    auto chunk_row0 = [&](int cc) -> int {
        const int ci = dir ? 35 - cc : cc; const int pp = ci * 64;
        if (!dir) return pp < 256 ? ML + b * 256 + pp : b * 2048 + (pp - 256);
        return pp < 2048 ? b * 2048 + pp : ML + b * 256 + (pp - 2048);
    };
    u32x4 rq[NP], rk[NP], rv; f32x4 eq[ISA ? 1 : NP][2], ek[ISA ? 1 : NP][2]; f32x4 tv[NMT];
    auto fetch = [&](int cc) {
        const int row0 = chunk_row0(cc);
        if (!ISA) {
#pragma unroll
            for (int a = 0; a < NMT; ++a) tv[a] = *(const f32x4*)(TOT + (size_t)((row0 >> 6) * 2 + dir) * 256 + h * 64 + (wid * NMT + a) * 16 + fq * 4);
        }
#pragma unroll
        for (int i = 0; i < NP; ++i) {
            const int id = tid + 256 * i, tok = id / CPR, cg_ = id % CPR;
            const size_t ro = (size_t)(row0 + tok) * ZS;
            rq[i] = *(const u32x4*)(Z + ro + qcol + cg_ * 8); rk[i] = *(const u32x4*)(Z + ro + kcol + cg_ * 8);
            if (!ISA) {
                const size_t eo = (size_t)(row0 + tok) * 256 + h * 64 + cg_ * 8;
                eq[i][0] = *(const f32x4*)(EQ + eo); eq[i][1] = *(const f32x4*)(EQ + eo + 4);
                ek[i][0] = *(const f32x4*)(EK + eo); ek[i][1] = *(const f32x4*)(EK + eo + 4);
            }
        }
        { const int tok = tid >> 2, cg_ = tid & 3; rv = *(const u32x4*)(Z + (size_t)(row0 + tok) * ZS + vcol + cg_ * 8); }
    };
    float ra[NP], rc[NP];
#pragma unroll
    for (int i = 0; i < NP; ++i) {
        const int tok = (tid + 256 * i) / CPR;
        ra[i] = dir ? __expf(lam * (float)(63 - tok)) : __expf(lam * (float)(tok + 1));
        rc[i] = dir ? __expf(-lam * (float)(64 - tok)) : __expf(-lam * (float)(tok + 1));
    }
    const float decA = __expf(lam * 64.0f);
    fetch(0);
    for (int cc = 0; cc < 36; ++cc) {
        const int row0 = chunk_row0(cc);
#pragma unroll
        for (int i = 0; i < NP; ++i) {
            const int id = tid + 256 * i, tok = id / CPR, cg_ = id % CPR;
            float fqv[8], fkv[8];
            if (ISA) {
#pragma unroll
                for (int e = 0; e < 8; ++e) { fqv[e] = ra[i]; fkv[e] = rc[i]; }
            } else {
#pragma unroll
                for (int e = 0; e < 8; ++e) { fqv[e] = __expf(eq[i][e >> 2][e & 3]); fkv[e] = __expf(-ek[i][e >> 2][e & 3]); }
            }
            const u32x4 q = rq[i], k = rk[i]; u32x4 qo, ko;
            qo.x = pk2(bflo(q.x) * fqv[0], bfhi(q.x) * fqv[1]); qo.y = pk2(bflo(q.y) * fqv[2], bfhi(q.y) * fqv[3]); qo.z = pk2(bflo(q.z) * fqv[4], bfhi(q.z) * fqv[5]); qo.w = pk2(bflo(q.w) * fqv[6], bfhi(q.w) * fqv[7]);
            ko.x = pk2(bflo(k.x) * fkv[0], bfhi(k.x) * fkv[1]); ko.y = pk2(bflo(k.y) * fkv[2], bfhi(k.y) * fkv[3]); ko.z = pk2(bflo(k.z) * fkv[4], bfhi(k.z) * fkv[5]); ko.w = pk2(bflo(k.w) * fkv[6], bfhi(k.w) * fkv[7]);
            *(u32x4*)(smem + O_QD + tok * QS + cg_ * 16) = qo;
            *(u32x4*)(smem + O_KD + tok * KS + cg_ * 16) = ko;
        }
        { const int tok = tid >> 2, cg_ = tid & 3; *(u32x4*)(smem + O_V + tok * VS + cg_ * 16) = rv; }
        f32x4 dec[NMT];
#pragma unroll
        for (int a = 0; a < NMT; ++a) {
            if (ISA) dec[a] = (f32x4){decA, decA, decA, decA};
            else dec[a] = (f32x4){__expf(tv[a][0]), __expf(tv[a][1]), __expf(tv[a][2]), __expf(tv[a][3])};
        }
        if (cc + 1 < 36) fetch(cc + 1);
        __syncthreads();
        bf16x8 afr[2];
        {
            f32x4 at[4];
#pragma unroll
            for (int n = 0; n < 4; ++n) at[n] = (f32x4){0.f, 0.f, 0.f, 0.f};
#pragma unroll
            for (int ks = 0; ks < NKS; ++ks) {
                const bf16x8 qf = *(const bf16x8*)(smem + O_QD + (16 * wid + fr) * QS + (32 * ks + 8 * fq) * 2);
#pragma unroll
                for (int n = 0; n < 4; ++n) {
                    const bf16x8 kf = *(const bf16x8*)(smem + O_KD + (16 * n + fr) * KS + (32 * ks + 8 * fq) * 2);
                    at[n] = __builtin_amdgcn_mfma_f32_16x16x32_bf16(kf, qf, at[n], 0, 0, 0);
                }
            }
            const int i = 16 * wid + fr;
#pragma unroll
            for (int n = 0; n < 4; ++n)
#pragma unroll
                for (int jj = 0; jj < 4; ++jj) { const int j = n * 16 + fq * 4 + jj; const bool keep = dir ? (j > i) : (j <= i); at[n][jj] = keep ? at[n][jj] : 0.f; }
#pragma unroll
            for (int ks = 0; ks < 2; ++ks) {
                u32x4 w; w.x = pk2(at[2 * ks][0], at[2 * ks][1]); w.y = pk2(at[2 * ks][2], at[2 * ks][3]); w.z = pk2(at[2 * ks + 1][0], at[2 * ks + 1][1]); w.w = pk2(at[2 * ks + 1][2], at[2 * ks + 1][3]);
                afr[ks] = __builtin_bit_cast(bf16x8, w);
            }
        }
        bf16x8 vf[2][2];
        {
            const int g = lane >> 4, i16 = lane & 15, q = i16 >> 2, pq = i16 & 3;
#pragma unroll
            for (int ks = 0; ks < 2; ++ks)
#pragma unroll
                for (int n = 0; n < 2; ++n) {
                    const unsigned char* a = smem + O_V + (32 * ks + 4 * g + q) * VS + (n * 16 + 4 * pq) * 2;
                    vf[ks][n] = cat8(tr_read(a), tr_read(a + 16 * VS));
                }
        }
        {
            f32x4 oa[2] = {(f32x4){0.f, 0.f, 0.f, 0.f}, (f32x4){0.f, 0.f, 0.f, 0.f}};
#pragma unroll
            for (int ks = 0; ks < 2; ++ks)
#pragma unroll
                for (int n = 0; n < 2; ++n) oa[n] = __builtin_amdgcn_mfma_f32_16x16x32_bf16(vf[ks][n], afr[ks], oa[n], 0, 0, 0);
#pragma unroll
            for (int ks = 0; ks < NKS; ++ks) {
                const bf16x8 qf = *(const bf16x8*)(smem + O_QD + (16 * wid + fr) * QS + (32 * ks + 8 * fq) * 2);
#pragma unroll
                for (int n = 0; n < 2; ++n) {
                    const bf16x8 sf = *(const bf16x8*)(smem + O_ST + (16 * n + fr) * SS + (32 * ks + 8 * fq) * 2);
                    oa[n] = __builtin_amdgcn_mfma_f32_16x16x32_bf16(sf, qf, oa[n], 0, 0, 0);
                }
            }
            bf16_t* o = OUT + (size_t)(row0 + 16 * wid + fr) * 1024 + ocol + fq * 4;
            u32x2 w0, w1; w0.x = pk2(oa[0][0], oa[0][1]); w0.y = pk2(oa[0][2], oa[0][3]); w1.x = pk2(oa[1][0], oa[1][1]); w1.y = pk2(oa[1][2], oa[1][3]);
            *(u32x2*)(o) = w0; *(u32x2*)(o + 16) = w1;
        }
        {
            const int g = lane >> 4, i16 = lane & 15, q = i16 >> 2, pq = i16 & 3;
#pragma unroll
            for (int a = 0; a < NMT; ++a) {
                const int mt = wid * NMT + a;
#pragma unroll
                for (int ks = 0; ks < 2; ++ks) {
                    const unsigned char* ka = smem + O_KD + (32 * ks + 4 * g + q) * KS + (mt * 16 + 4 * pq) * 2;
                    const bf16x8 kf = cat8(tr_read(ka), tr_read(ka + 16 * KS));
#pragma unroll
                    for (int n = 0; n < 2; ++n) S[a][n] = __builtin_amdgcn_mfma_f32_16x16x32_bf16(kf, vf[ks][n], S[a][n], 0, 0, 0);
                }
                S[a][0] *= dec[a]; S[a][1] *= dec[a];
            }
        }
        __syncthreads();
#pragma unroll
        for (int a = 0; a < NMT; ++a) {
            const int mt = wid * NMT + a;
#pragma unroll
            for (int n = 0; n < 2; ++n) { u32x2 w; w.x = pk2(S[a][n][0], S[a][n][1]); w.y = pk2(S[a][n][2], S[a][n][3]); *(u32x2*)(smem + O_ST + (n * 16 + fr) * SS + (mt * 16 + fq * 4) * 2) = w; }
        }
    }
    __syncthreads();
}
DI void phase_scan(KP p, int l, unsigned char* smem) {
    for (int it = BIDX(); it < 512; it += gridDim.x) {
        if (it < 256) scan_item<128>(p, l, it, smem); else scan_item<64>(p, l, it - 256, smem);
    }
}

DI void phase_merge(KP p, int l) {
    const int tid = TIDX(), wave = tid >> 6, lane = tid & 63;
    const int li = l >> 1;
    const bf16_t* OF = (const bf16_t*)(p->ws + WS_OF); const bf16_t* OB = (const bf16_t*)(p->ws + WS_OB);
    const bf16_t* Z = (const bf16_t*)(p->ws + WS_Z); bf16_t* Y = (bf16_t*)(p->ws + WS_Y);
    const bool isA = lane < 32;
    const float* gn = isA ? p->in[15] + li * 512 + lane * 16 : p->in[16] + li * 512 + (lane - 32) * 16;
    const int gcol = isA ? 1536 + lane * 16 : 3072 + (lane - 32) * 16;
    for (int row = BIDX() * 4 + wave; row < MT; row += gridDim.x * 4) {
        float o[16]; float s = 0.f;
#pragma unroll
        for (int j = 0; j < 2; ++j) {
            const u32x4 a = *(const u32x4*)(OF + (size_t)row * 1024 + lane * 16 + j * 8), bb = *(const u32x4*)(OB + (size_t)row * 1024 + lane * 16 + j * 8);
            o[j * 8 + 0] = bflo(a.x) + bflo(bb.x); o[j * 8 + 1] = bfhi(a.x) + bfhi(bb.x); o[j * 8 + 2] = bflo(a.y) + bflo(bb.y); o[j * 8 + 3] = bfhi(a.y) + bfhi(bb.y);
            o[j * 8 + 4] = bflo(a.z) + bflo(bb.z); o[j * 8 + 5] = bfhi(a.z) + bfhi(bb.z); o[j * 8 + 6] = bflo(a.w) + bflo(bb.w); o[j * 8 + 7] = bfhi(a.w) + bfhi(bb.w);
        }
#pragma unroll
        for (int e = 0; e < 16; ++e) s += o[e];
        s += __shfl_xor(s, 1); s += __shfl_xor(s, 2); s += __shfl_xor(s, 4);
        const float mean = isA ? s * (1.0f / 128.0f) : 0.f;
        float s2 = 0.f;
#pragma unroll
        for (int e = 0; e < 16; ++e) { o[e] -= mean; s2 += o[e] * o[e]; }
        s2 += __shfl_xor(s2, 1); s2 += __shfl_xor(s2, 2); s2 += __shfl_xor(s2, 4);
        const float rs = 1.0f / sqrtf(s2 * (1.0f / 128.0f) + LN_EPS);
        const u32x4 g0 = *(const u32x4*)(Z + (size_t)row * ZS + gcol), g1 = *(const u32x4*)(Z + (size_t)row * ZS + gcol + 8);
        float gt[16];
        gt[0] = bflo(g0.x); gt[1] = bfhi(g0.x); gt[2] = bflo(g0.y); gt[3] = bfhi(g0.y); gt[4] = bflo(g0.z); gt[5] = bfhi(g0.z); gt[6] = bflo(g0.w); gt[7] = bfhi(g0.w);
        gt[8] = bflo(g1.x); gt[9] = bfhi(g1.x); gt[10] = bflo(g1.y); gt[11] = bfhi(g1.y); gt[12] = bflo(g1.z); gt[13] = bfhi(g1.z); gt[14] = bflo(g1.w); gt[15] = bfhi(g1.w);
        float y[16];
#pragma unroll
        for (int e = 0; e < 16; ++e) y[e] = siluf(gt[e]) * (o[e] * rs * gn[e]);
        u32x4 w0, w1;
        w0.x = pk2(y[0], y[1]); w0.y = pk2(y[2], y[3]); w0.z = pk2(y[4], y[5]); w0.w = pk2(y[6], y[7]);
        w1.x = pk2(y[8], y[9]); w1.y = pk2(y[10], y[11]); w1.z = pk2(y[12], y[13]); w1.w = pk2(y[14], y[15]);
        *(u32x4*)(Y + (size_t)row * 1024 + lane * 16) = w0; *(u32x4*)(Y + (size_t)row * 1024 + lane * 16 + 8) = w1;
    }
}

DI int crow(int r, int hi) { return (r & 3) + 8 * (r >> 2) + 4 * hi; }
constexpr int ATT_BUF = 24576;
DI void att_component(const bf16_t* Qc, const bf16_t* Kc, const bf16_t* Vt, unsigned char* smem, float* wsf, int b, int h, int comp, int p0, int nkv, f32x16 (&O)[4]) {
    const int tid = TIDX(), wid = tid >> 6, lane = tid & 63, r32 = lane & 31, hi = lane >> 5;
    const int hc = h * 2 + comp;
    const bf16_t* Qb = Qc + ((size_t)(b * 16 + hc) * TA + p0 + wid * 32 + r32) * 64;
    const int gch = gemm_chunk(tid);
    const bf16_t* Kg = Kc + (size_t)(b * 16 + hc) * TA * 64 + (size_t)(tid >> 3) * 64 + gch * 8;
    const bf16_t* Vg = Vt + (size_t)(b * 8 + h) * 128 * TA + (size_t)(tid >> 3) * TA + gch * 8;
#define ATT_STAGE(buf, kt) do { \
        _Pragma("unroll") for (int i_ = 0; i_ < 2; ++i_) __builtin_amdgcn_global_load_lds((const unsigned*)(Kg + (size_t)((kt) + 32 * i_) * 64), (LAS unsigned*)(smem + (buf) * ATT_BUF + i_ * 4096 + tid * 16), 16, 0, 0); \
        _Pragma("unroll") for (int i_ = 0; i_ < 4; ++i_) __builtin_amdgcn_global_load_lds((const unsigned*)(Vg + (size_t)(32 * i_) * TA + (kt)), (LAS unsigned*)(smem + (buf) * ATT_BUF + 8192 + i_ * 4096 + tid * 16), 16, 0, 0); } while (0)
    ATT_STAGE(0, 0);
    bf16x8 qf[4];
#pragma unroll
    for (int ks = 0; ks < 4; ++ks) qf[ks] = *(const bf16x8*)(Qb + ks * 16 + hi * 8);
#pragma unroll
    for (int d0 = 0; d0 < 4; ++d0)
#pragma unroll
        for (int r = 0; r < 16; ++r) O[d0][r] = 0.f;
    float m_run = -1.0e30f, l_run = 0.f;
    const int sw = (r32 >> 1) & 7;
    const int nt = nkv >> 6;
    for (int t = 0; t < nt; ++t) {
        asm volatile("s_waitcnt vmcnt(0)" ::: "memory");
        __syncthreads();
        if (t + 1 < nt) ATT_STAGE((t + 1) & 1, (t + 1) * 64);
        const unsigned char* Kt = smem + (t & 1) * ATT_BUF; const unsigned char* Vtl = Kt + 8192;
        bf16x8 kf0[4], kf1[4];
#pragma unroll
        for (int ks = 0; ks < 4; ++ks) {
            const unsigned co = (unsigned)(((ks * 2 + hi) ^ sw) << 4);
            kf0[ks] = *(const bf16x8*)(Kt + r32 * 128 + co);
            kf1[ks] = *(const bf16x8*)(Kt + (32 + r32) * 128 + co);
        }
        const unsigned char* vr = Vtl + r32 * 128;
#define ATT_VLOAD(dst, st_) do { const unsigned o1_ = (unsigned)((((st_) * 2 + hi) ^ sw) << 4); \
        _Pragma("unroll") for (int d0_ = 0; d0_ < 4; ++d0_) dst[d0_] = *(const bf16x8*)(vr + d0_ * 4096 + o1_); } while (0)
        bf16x8 va[4], vb[4];
        ATT_VLOAD(va, 0);
        f32x16 s0, s1;
#pragma unroll
        for (int r = 0; r < 16; ++r) { s0[r] = 0.f; s1[r] = 0.f; }
#pragma unroll
        for (int ks = 0; ks < 4; ++ks) {
            s0 = __builtin_amdgcn_mfma_f32_32x32x16_bf16(kf0[ks], qf[ks], s0, 0, 0, 0);
            s1 = __builtin_amdgcn_mfma_f32_32x32x16_bf16(kf1[ks], qf[ks], s1, 0, 0, 0);
        }
        float mxa[8];
#pragma unroll
        for (int i_ = 0; i_ < 8; ++i_) mxa[i_] = fmaxf(fmaxf(s0[2 * i_], s0[2 * i_ + 1]), fmaxf(s1[2 * i_], s1[2 * i_ + 1]));
        float mx = fmaxf(fmaxf(fmaxf(mxa[0], mxa[1]), fmaxf(mxa[2], mxa[3])), fmaxf(fmaxf(mxa[4], mxa[5]), fmaxf(mxa[6], mxa[7])));
        mx = fmaxf(mx, __shfl_xor(mx, 32));
        if (__any(mx > m_run + 8.0f)) {
            const float m_new = fmaxf(m_run, mx);
            const float alpha = __builtin_amdgcn_exp2f((m_run - m_new) * L2E);
            l_run *= alpha; m_run = m_new;
            if (hi == 0) wsf[r32] = alpha;
            asm volatile("s_waitcnt lgkmcnt(0)" ::: "memory");
            float ar[16];
#pragma unroll
            for (int r = 0; r < 16; ++r) ar[r] = wsf[crow(r, hi)];
#pragma unroll
            for (int d0 = 0; d0 < 4; ++d0)
#pragma unroll
                for (int r = 0; r < 16; ++r) O[d0][r] *= ar[r];
            asm volatile("s_waitcnt lgkmcnt(0)" ::: "memory");
        }
        const float mb = m_run * L2E;
        float ps = 0.f;
#pragma unroll
        for (int r = 0; r < 16; ++r) { s0[r] = __builtin_amdgcn_exp2f(s0[r] * L2E - mb); s1[r] = __builtin_amdgcn_exp2f(s1[r] * L2E - mb); ps += s0[r] + s1[r]; }
        l_run += ps;
        u32x4 pw[4];
#pragma unroll
        for (int s = 0; s < 2; ++s) {
            pw[s].x = pk2(s0[8 * s + 0], s0[8 * s + 1]); pw[s].y = pk2(s0[8 * s + 2], s0[8 * s + 3]); pw[s].z = pk2(s0[8 * s + 4], s0[8 * s + 5]); pw[s].w = pk2(s0[8 * s + 6], s0[8 * s + 7]);
            pw[2 + s].x = pk2(s1[8 * s + 0], s1[8 * s + 1]); pw[2 + s].y = pk2(s1[8 * s + 2], s1[8 * s + 3]); pw[2 + s].z = pk2(s1[8 * s + 4], s1[8 * s + 5]); pw[2 + s].w = pk2(s1[8 * s + 6], s1[8 * s + 7]);
        }
#pragma unroll
        ATT_VLOAD(vb, 1);
#pragma unroll
        for (int d0 = 0; d0 < 4; ++d0) O[d0] = __builtin_amdgcn_mfma_f32_32x32x16_bf16(__builtin_bit_cast(bf16x8, pw[0]), va[d0], O[d0], 0, 0, 0);
        ATT_VLOAD(va, 2);
#pragma unroll
        for (int d0 = 0; d0 < 4; ++d0) O[d0] = __builtin_amdgcn_mfma_f32_32x32x16_bf16(__builtin_bit_cast(bf16x8, pw[1]), vb[d0], O[d0], 0, 0, 0);
        ATT_VLOAD(vb, 3);
#pragma unroll
        for (int d0 = 0; d0 < 4; ++d0) O[d0] = __builtin_amdgcn_mfma_f32_32x32x16_bf16(__builtin_bit_cast(bf16x8, pw[2]), va[d0], O[d0], 0, 0, 0);
#pragma unroll
        for (int d0 = 0; d0 < 4; ++d0) O[d0] = __builtin_amdgcn_mfma_f32_32x32x16_bf16(__builtin_bit_cast(bf16x8, pw[3]), vb[d0], O[d0], 0, 0, 0);
#undef ATT_VLOAD
    }
#undef ATT_STAGE
    l_run += __shfl_xor(l_run, 32);
    asm volatile("s_waitcnt lgkmcnt(0)" ::: "memory");
    if (hi == 0) wsf[r32] = 1.0f / l_run;
    asm volatile("s_waitcnt lgkmcnt(0)" ::: "memory");
    float ar[16];
#pragma unroll
    for (int r = 0; r < 16; ++r) ar[r] = wsf[crow(r, hi)];
    asm volatile("s_waitcnt lgkmcnt(0)" ::: "memory");
#pragma unroll
    for (int d0 = 0; d0 < 4; ++d0)
#pragma unroll
        for (int r = 0; r < 16; ++r) O[d0][r] *= ar[r];
}

DI void phase_att(KP p, int l, unsigned char* smem) {
    constexpr int O_WS = 2 * ATT_BUF;
    const int tid = TIDX(), wid = tid >> 6, lane = tid & 63, r32 = lane & 31, hi = lane >> 5;
    const int li = l >> 1;
    const bf16_t* Qc = (const bf16_t*)(p->ws + WS_QC); const bf16_t* Kc = (const bf16_t*)(p->ws + WS_KC); const bf16_t* Vt = (const bf16_t*)(p->ws + WS_VT);
    bf16_t* Y = (bf16_t*)(p->ws + WS_Y);
    float* stash = (float*)(p->ws + WS_P) + ((size_t)BIDX() * 256 + tid) * 32;
    const float lam_init = 0.8f - 0.6f * expf(-0.3f * (float)l);
    float* wsf = (float*)(smem + O_WS) + wid * 32;
    const int per_x = (l == 3) ? 128 : 144;
    for (int i = 0;; ++i) {
        int b, h, p0, nkv;
        {
            const int G = gridDim.x, bid = BIDX();
            int item;
            if ((G & 7) == 0) { const int x = bid & 7, q = i * (G >> 3) + (bid >> 3); if (q >= per_x) break; item = q < 128 ? x * 128 + q : 1024 + x * 16 + (q - 128); }
            else { item = i * G + bid; if (item >= 8 * per_x) break; }
            if (item < 1024) { b = item >> 7; h = (item >> 4) & 7; p0 = 256 + (item & 15) * 128; nkv = TA; }
            else { const int q = item - 1024; b = q >> 4; h = (q >> 1) & 7; p0 = (q & 1) * 128; nkv = TC; }
        }
        float d1 = 0.f, d2 = 0.f;
        { const float* lq1 = p->in[19] + (li * 8 + h) * 64, *lk1 = p->in[20] + (li * 8 + h) * 64, *lq2 = p->in[21] + (li * 8 + h) * 64, *lk2 = p->in[22] + (li * 8 + h) * 64;
          d1 = wave_sum(lq1[lane] * lk1[lane]); d2 = wave_sum(lq2[lane] * lk2[lane]); }
        const float lamv = expf(d1) - expf(d2) + lam_init;
        f32x16 On[4];
        __syncthreads();
        att_component(Qc, Kc, Vt, smem, wsf, b, h, 0, p0, nkv, On);
#pragma unroll
        for (int d0 = 0; d0 < 4; ++d0)
#pragma unroll
            for (int r = 0; r < 16; r += 8) {
                u32x4 w; w.x = pk2(On[d0][r], On[d0][r + 1]); w.y = pk2(On[d0][r + 2], On[d0][r + 3]); w.z = pk2(On[d0][r + 4], On[d0][r + 5]); w.w = pk2(On[d0][r + 6], On[d0][r + 7]);
                *(u32x4*)(stash + (d0 * 16 + r) / 2) = w;
            }
        __syncthreads();
        att_component(Qc, Kc, Vt, smem, wsf, b, h, 1, p0, nkv, On);
#pragma unroll
        for (int d0 = 0; d0 < 4; ++d0)
#pragma unroll
            for (int r = 0; r < 16; r += 8) {
                const u32x4 w = *(const u32x4*)(stash + (d0 * 16 + r) / 2);
                On[d0][r] = bflo(w.x) - lamv * On[d0][r]; On[d0][r + 1] = bfhi(w.x) - lamv * On[d0][r + 1]; On[d0][r + 2] = bflo(w.y) - lamv * On[d0][r + 2]; On[d0][r + 3] = bfhi(w.y) - lamv * On[d0][r + 3];
                On[d0][r + 4] = bflo(w.z) - lamv * On[d0][r + 4]; On[d0][r + 5] = bfhi(w.z) - lamv * On[d0][r + 5]; On[d0][r + 6] = bflo(w.w) - lamv * On[d0][r + 6]; On[d0][r + 7] = bfhi(w.w) - lamv * On[d0][r + 7];
            }
        float ms[16];
#pragma unroll
        for (int r = 0; r < 16; ++r) {
            float s = (On[0][r] * On[0][r] + On[1][r] * On[1][r]) + (On[2][r] * On[2][r] + On[3][r] * On[3][r]);
            s += __shfl_xor(s, 1); s += __shfl_xor(s, 2); s += __shfl_xor(s, 4); s += __shfl_xor(s, 8); s += __shfl_xor(s, 16);
            ms[r] = __builtin_amdgcn_rsqf(s * (1.0f / 128.0f) + LN_EPS);
        }
        const float* sg = p->in[23] + li * 1024 + h * 128;
        const float post = 1.0f - lam_init;
        float gsc[4];
#pragma unroll
        for (int d0 = 0; d0 < 4; ++d0) gsc[d0] = sg[d0 * 32 + r32] * post;
        __syncthreads();
        unsigned char* stg = smem + wid * 8192;
#pragma unroll
        for (int r = 0; r < 16; ++r) {
            unsigned char* sp = stg + crow(r, hi) * 256 + r32 * 2;
#pragma unroll
            for (int d0 = 0; d0 < 4; ++d0) *(unsigned short*)(sp + d0 * 64) = (unsigned short)f2bf(On[d0][r] * ms[r] * gsc[d0]);
        }
        asm volatile("s_waitcnt lgkmcnt(0)" ::: "memory");
#pragma unroll
        for (int i2 = 0; i2 < 8; ++i2) {
            const int id = lane + 64 * i2, qr = id >> 4, ch = id & 15;
            const int pq = p0 + wid * 32 + qr;
            const int row = pq < 256 ? ML + b * 256 + pq : b * 2048 + (pq - 256);
            *(u32x4*)(Y + (size_t)row * 1024 + h * 128 + ch * 8) = *(const u32x4*)(stg + qr * 256 + ch * 16);
        }
        asm volatile("s_waitcnt lgkmcnt(0)" ::: "memory");
    }
}

#define XB_TMO      128
#define XB_XCNT(j)  (256  + 64 * (j))
#define XB_XSUB(j)  (1280 + 64 * (j))
#define XB_XGEN(j)  (2304 + 64 * (j))
#define XB_TOP      3328
#define XB_TOPGEN   3392
#define XCD_BAR_WORDS 3456
#define XB_SPIN_CAP (1u << 22)
DI unsigned xb_ld(unsigned* p)              { return __hip_atomic_load(p, __ATOMIC_RELAXED, __HIP_MEMORY_SCOPE_AGENT); }
DI unsigned xb_add(unsigned* p, unsigned v) { return __hip_atomic_fetch_add(p, v, __ATOMIC_RELAXED, __HIP_MEMORY_SCOPE_AGENT); }
DI unsigned xb_xcc_id() { return (unsigned)__builtin_amdgcn_s_getreg((3 << 11) | 20) & 0xFu; }
#define XB_SPIN(cond, bar) do { unsigned _sp = 0; while (cond) { __builtin_amdgcn_s_sleep(1); \
    if ((++_sp & 255u) == 0u) { if (xb_ld(&(bar)[XB_TMO])) break; if (_sp > XB_SPIN_CAP) { atomicAdd(&(bar)[XB_TMO], 1u); break; } } } } while (0)
struct XcdBarrier { unsigned* bar; unsigned x; volatile LAS unsigned* st; };
DI XcdBarrier xcd_barrier_post(unsigned* bar, volatile LAS unsigned* st) {
    XcdBarrier b; b.bar = bar; b.x = xb_xcc_id(); b.st = st;
    if (threadIdx.x == 0) (void)xb_add(&bar[XB_XCNT(b.x)], 1u);
    return b;
}
DI void xcd_barrier_complete(unsigned* bar, unsigned x, unsigned& nloc, unsigned& nx) {
    const unsigned G = gridDim.x * gridDim.y * gridDim.z;
    unsigned sum, cnt, mine, sp = 0u;
    for (;;) {
        sum = 0u; cnt = 0u; mine = 0u;
#pragma unroll
        for (unsigned j = 0; j < 16; ++j) { const unsigned c = xb_ld(&bar[XB_XCNT(j)]); sum += c; cnt += (c > 0u) ? 1u : 0u; mine = (j == x) ? c : mine; }
        if (sum == G) break;
        __builtin_amdgcn_s_sleep(1);
        if ((++sp & 255u) == 0u) { if (xb_ld(&bar[XB_TMO])) break; if (sp > XB_SPIN_CAP) { atomicAdd(&bar[XB_TMO], 1u); break; } }
    }
    nloc = mine > 0u ? mine : 1u; nx = cnt > 0u ? cnt : 1u;
}
DI void xcd_barrier(const XcdBarrier& b) {
    asm volatile("s_waitcnt vmcnt(0)" ::: "memory");
    __syncthreads();
    if (threadIdx.x == 0) {
        unsigned* bar = b.bar;
        __builtin_amdgcn_s_waitcnt(0);
        unsigned nloc = b.st[0], nx = b.st[1];
        if (nloc == 0u) { xcd_barrier_complete(bar, b.x, nloc, nx); b.st[0] = nloc; b.st[1] = nx; }
        const unsigned old = xb_add(&bar[XB_XSUB(b.x)], 1u);
        const unsigned gen = old / nloc;
        if (old + 1u == (gen + 1u) * nloc) {
            __builtin_amdgcn_fence(__ATOMIC_RELEASE, "agent");
            asm volatile("s_waitcnt vmcnt(0)" ::: "memory");
            const unsigned og = xb_add(&bar[XB_TOP], 1u);
            const unsigned tg = og / nx;
            if (og + 1u == (tg + 1u) * nx) xb_add(&bar[XB_TOPGEN], 1u);
            else XB_SPIN(xb_ld(&bar[XB_TOPGEN]) == tg, bar);
            __builtin_amdgcn_fence(__ATOMIC_ACQUIRE, "agent");
            xb_add(&bar[XB_XGEN(b.x)], 1u);
            asm volatile("s_waitcnt vmcnt(0)" ::: "memory");
        } else {
            XB_SPIN(xb_ld(&bar[XB_XGEN(b.x)]) == gen, bar);
            __builtin_amdgcn_fence(__ATOMIC_ACQUIRE, "agent");
            asm volatile("s_waitcnt vmcnt(0)" ::: "memory");
        }
    }
    __syncthreads();
}

#ifdef DOUBLE_MASK
#define DRYCOND (rep_ == 0 && nrep_ == 2)
#else
#define DRYCOND false
#endif
constexpr int NPHASE = 34;
constexpr int LDS_BYTES = 65536 + 1024;
__global__ void __launch_bounds__(256, 2) mega(Params pv) {
    extern __shared__ __attribute__((aligned(16))) unsigned char smem[];
    const int ph_lo = pv.ph_lo, ph_hi = pv.ph_hi;
    volatile LAS unsigned* bar_st = (volatile LAS unsigned*)(LAS unsigned char*)(smem + 65536);
    if (threadIdx.x == 0) { bar_st[0] = 0u; bar_st[1] = 0u; }
    __syncthreads();
    XcdBarrier xbar = xcd_barrier_post((unsigned*)(pv.ws + WS_CTL) + 4096, bar_st);
    for (int ph = ph_lo; ph < ph_hi; ++ph) {
        KP p = (KP)__builtin_amdgcn_kernarg_segment_ptr();
        asm volatile("" : "+s"(p) :: "memory");
#ifdef DOUBLE_MASK
        int kind_;
        if (ph == 0) kind_ = 0; else if (ph == 1) kind_ = 1;
        else { const int rem_ = (ph - 2) % 16; kind_ = rem_ == 0 ? 2 : (rem_ == 1 ? 12 : (rem_ < 9 ? rem_ + 1 : (rem_ == 9 ? 10 : (rem_ == 10 ? 11 : (rem_ - 11 + 5))))); }
        const int nrep_ = ((DOUBLE_MASK >> kind_) & 1) ? 2 : 1;
        for (int rep_ = 0; rep_ < nrep_; ++rep_) {
        if (rep_) xcd_barrier(xbar);
#endif
        if (ph == 0) phase_pre0(p, smem);
        else if (ph == 1) phase_pre1(p);
        else {
            const int q = ph - 2, lp = q / 16, rem = q % 16;
            if (rem < 9) {
                const int l = 2 * lp;
                switch (rem) {
                    case 0: phase_g1e(p, l, smem); break;
                    case 1: phase_decay(p, l, smem); break;
                    case 2: phase_scan(p, l, smem); break;
                    case 3: phase_merge(p, l); break;
                    case 4: phase_g2(p, l, smem); break;
                    case 5: if (DRYCOND) phase_ln1r<true>(p, l, smem); else phase_ln1r<false>(p, l, smem); break;
                    case 6: phase_mg1(p, l, smem); break;
                    case 7: phase_mg2(p, l, smem); break;
                    default: if (DRYCOND) phase_ln2<true>(p, l); else phase_ln2<false>(p, l); break;
                }
            } else {
                const int l = 2 * lp + 1;
                switch (rem - 9) {
                    case 0: phase_g1o(p, l, smem); break;
                    case 1: phase_att(p, l, smem); break;
                    case 2: phase_g2(p, l, smem); break;
                    case 3: if (DRYCOND) phase_ln1r<true>(p, l, smem); else phase_ln1r<false>(p, l, smem); break;
                    case 4: phase_mg1(p, l, smem); break;
                    case 5: phase_mg2(p, l, smem); break;
                    default: if (DRYCOND) phase_ln2<true>(p, l); else phase_ln2<false>(p, l); break;
                }
            }
        }
#ifdef DOUBLE_MASK
        }
#endif
        if (ph + 1 < ph_hi) xcd_barrier(xbar);
    }
}

extern "C" void kernel_launch(void* const* d_in, const int* in_sizes, int n_in, void* d_out, int out_size, void* d_ws, size_t ws_size, hipStream_t stream) {
    static int grid_blocks = 0;
    if (grid_blocks == 0) {
        if (n_in != 32 || ws_size < WS_END) { fprintf(stderr, "kernel_launch: unexpected n_in %d or ws_size %zu\n", n_in, ws_size); grid_blocks = -1; return; }
        int dev = 0, cus = 0, per_cu = 0;
        hipGetDevice(&dev);
        hipDeviceGetAttribute(&cus, hipDeviceAttributeMultiprocessorCount, dev);
        hipFuncSetAttribute((const void*)mega, hipFuncAttributeMaxDynamicSharedMemorySize, LDS_BYTES);
        hipOccupancyMaxActiveBlocksPerMultiprocessor(&per_cu, mega, 256, LDS_BYTES);
        if (per_cu > 2) per_cu = 2;
        if (per_cu < 1) per_cu = 1;
        grid_blocks = cus * per_cu;
    }
    if (grid_blocks < 0) return;
    hipMemsetAsync((char*)d_ws + WS_CTL, 0, 32768, stream);
    Params p{};
    for (int i = 0; i < 32; ++i) p.in[i] = (const float*)d_in[i];
    p.out = (float*)d_out; p.ws = (unsigned char*)d_ws;
#if N_LAUNCH_MODE == 1
    p.ph_lo = 0; p.ph_hi = NPHASE;
    void* args[] = {&p};
    hipError_t e = hipLaunchCooperativeKernel((void*)mega, dim3(grid_blocks), dim3(256), args, LDS_BYTES, stream);
    if (e != hipSuccess) fprintf(stderr, "cooperative launch failed: %s (grid %d)\n", hipGetErrorString(e), grid_blocks);
#else
    for (int ph = 0; ph < NPHASE; ++ph) {
        p.ph_lo = ph; p.ph_hi = ph + 1;
        hipLaunchKernelGGL(mega, dim3(grid_blocks), dim3(256), LDS_BYTES, stream, p);
    }
#endif
}
```

```cpp
#include <hip/hip_runtime.h>
#include <hip/hip_cooperative_groups.h>
#include <cstdio>
#include <cstdint>
namespace cg = cooperative_groups;

#ifndef N_LAUNCH_MODE
#define N_LAUNCH_MODE 1
#endif

#define DI __device__ __forceinline__
#define LAS __attribute__((address_space(3)))
typedef unsigned short bf16_t;
typedef short bf16x8 __attribute__((ext_vector_type(8)));
typedef short s16x4 __attribute__((ext_vector_type(4)));
typedef float f32x4 __attribute__((ext_vector_type(4)));
typedef float f32x16 __attribute__((ext_vector_type(16)));
typedef unsigned u32x4 __attribute__((ext_vector_type(4)));
typedef unsigned u32x2 __attribute__((ext_vector_type(2)));

constexpr int D = 1024, NB = 8, T = 2048, TC = 256, TA = T + TC;
constexpr int ML = NB * T, MC = NB * TC, MT = ML + MC;
constexpr int NIN = 3616, NINP = 3712, ZS = 3712;
constexpr int NSLOT = 2 * MT;
constexpr float LN_EPS = 1e-5f;
constexpr float ALPHA = 1.6817928305074290f;
constexpr float L2E = 1.4426950408889634f;

constexpr size_t MiB = 1ull << 20;
constexpr size_t WS_CTL = 0;
constexpr size_t WS_MOD = 1 * MiB;
constexpr size_t WS_ROPEA = 2 * MiB;
constexpr size_t WS_ROPEC = 3 * MiB;
constexpr size_t WS_LR = 4 * MiB;
constexpr size_t WS_SLOTW = 7 * MiB;
constexpr size_t WS_LIST = 8 * MiB;
constexpr size_t WS_WRT = 13 * MiB;
constexpr size_t WS_WIN = 16 * MiB;
constexpr size_t WS_WABO = 32 * MiB;
constexpr size_t WS_WQKV = 36 * MiB;
constexpr size_t WS_WCO = 48 * MiB;
constexpr size_t WS_WGU = 64 * MiB;
constexpr size_t WS_WD = 320 * MiB;
constexpr size_t WS_X = 448 * MiB;
constexpr size_t WS_U = 520 * MiB;
constexpr size_t WS_Y = 556 * MiB;
constexpr size_t WS_Z = 592 * MiB;
constexpr size_t WS_O = 724 * MiB;
constexpr size_t WS_PF = 868 * MiB, WS_SQ = 886 * MiB, WS_SK = 904 * MiB, WS_TOT = 922 * MiB;
constexpr size_t WS_END = 923 * MiB;
constexpr size_t WS_QC = WS_Z, WS_KC = WS_Z + 36 * MiB, WS_VT = WS_Z + 72 * MiB;
constexpr size_t WS_YS = WS_Z;
constexpr size_t WS_OF = WS_O, WS_OB = WS_O + 72 * MiB, WS_P = WS_O, WS_H = WS_O + 72 * MiB;

#ifndef XBF16
#define XBF16 0
#endif
#if XBF16
typedef bf16_t xres_t;
#else
typedef float xres_t;
#endif
struct Params { const float* in[32]; float* out; unsigned char* ws; int ph_lo, ph_hi; };
typedef const __attribute__((address_space(4))) Params* KP;

DI int TIDX() { int t = threadIdx.x; asm volatile("" : "+v"(t)); return t; }
DI int BIDX() { int b = blockIdx.x; asm volatile("" : "+s"(b)); return b; }
DI unsigned pk2(float lo, float hi);
DI unsigned f2bf(float f) { return pk2(f, 0.f) & 0xffffu; }
typedef float f32x2_t __attribute__((ext_vector_type(2))); typedef __bf16 bf16x2_t __attribute__((ext_vector_type(2)));
DI unsigned pk2(float lo, float hi) { f32x2_t v = {lo, hi}; bf16x2_t b = __builtin_convertvector(v, bf16x2_t); return __builtin_bit_cast(unsigned, b); }
DI float bflo(unsigned w) { return __uint_as_float(w << 16); }
DI float bfhi(unsigned w) { return __uint_as_float(w & 0xffff0000u); }
DI f32x4 xload(const xres_t* p) {
#if XBF16
    const u32x2 w = *(const u32x2*)p; return (f32x4){bflo(w.x), bfhi(w.x), bflo(w.y), bfhi(w.y)};
#else
    return *(const f32x4*)p;
#endif
}
DI void xstore(xres_t* p, f32x4 v) {
#if XBF16
    u32x2 w; w.x = pk2(v[0], v[1]); w.y = pk2(v[2], v[3]); *(u32x2*)p = w;
#else
    *(f32x4*)p = v;
#endif
}
DI float wave_sum(float v) {
#pragma unroll
    for (int o = 1; o < 64; o <<= 1) v += __shfl_xor(v, o);
    return v;
}
DI float siluf(float v) { return v * __builtin_amdgcn_rcpf(1.0f + __expf(-v)); }

DI int gemm_chunk(int tid) { return (tid & 7) ^ ((tid >> 4) & 7); }
template <bool TRN>
DI void gemm_tile(unsigned char* shm, const bf16_t* const (&ap)[4], const bf16_t* const (&bp)[4], int K, f32x4 (&acc)[4][4],
                  bool first, bool has_next, const bf16_t* const (&apn)[4], const bf16_t* const (&bpn)[4]) {
    const int tid = TIDX(), wid = tid >> 6, lane = tid & 63, wr = wid >> 1, wc = wid & 1, fr = lane & 15, fq = lane >> 4;
#pragma unroll
    for (int m = 0; m < 4; ++m)
#pragma unroll
        for (int n = 0; n < 4; ++n) acc[m][n] = (f32x4){0.f, 0.f, 0.f, 0.f};
    const int nt = K >> 6;
    const int sw = fr >> 1;
    const unsigned aoff = (unsigned)((wr * 64 + fr) * 128), boff = (unsigned)(16384 + (wc * 64 + fr) * 128);
#define GEMM_STAGE(buf, A_, B_, t) do { _Pragma("unroll") for (int i_ = 0; i_ < 4; ++i_) { \
        __builtin_amdgcn_global_load_lds((const unsigned*)(A_[i_] + (t) * 64), (LAS unsigned*)(shm + (buf) * 32768 + i_ * 4096 + tid * 16), 16, 0, 0); \
        __builtin_amdgcn_global_load_lds((const unsigned*)(B_[i_] + (t) * 64), (LAS unsigned*)(shm + (buf) * 32768 + 16384 + i_ * 4096 + tid * 16), 16, 0, 0); } } while (0)
    if (first) {
        GEMM_STAGE(0, ap, bp, 0);
        asm volatile("s_waitcnt vmcnt(0)" ::: "memory");
        __syncthreads();
    }
    for (int t = 0; t < nt; ++t) {
        const int cur = t & 1;
        if (t + 1 < nt) GEMM_STAGE(cur ^ 1, ap, bp, t + 1);
        else if (has_next) GEMM_STAGE(cur ^ 1, apn, bpn, 0);
        const unsigned char* base = shm + cur * 32768;
        bf16x8 At[2][4], Bt[2][4];
#pragma unroll
        for (int ks = 0; ks < 2; ++ks) {
            const unsigned co = (unsigned)(((ks * 4 + fq) ^ sw) << 4);
#pragma unroll
            for (int m = 0; m < 4; ++m) At[ks][m] = *(const bf16x8*)(base + aoff + m * 2048 + co);
#pragma unroll
            for (int n = 0; n < 4; ++n) Bt[ks][n] = *(const bf16x8*)(base + boff + n * 2048 + co);
        }
        __builtin_amdgcn_s_setprio(1);
#pragma unroll
        for (int ks = 0; ks < 2; ++ks)
#pragma unroll
            for (int m = 0; m < 4; ++m)
#pragma unroll
                for (int n = 0; n < 4; ++n)
                    acc[m][n] = TRN ? __builtin_amdgcn_mfma_f32_16x16x32_bf16(Bt[ks][n], At[ks][m], acc[m][n], 0, 0, 0)
                                    : __builtin_amdgcn_mfma_f32_16x16x32_bf16(At[ks][m], Bt[ks][n], acc[m][n], 0, 0, 0);
        __builtin_amdgcn_s_setprio(0);
        asm volatile("s_waitcnt vmcnt(0)" ::: "memory");
        __syncthreads();
    }
#undef GEMM_STAGE
}
#define GEMM_ADVANCE() do { _Pragma("unroll") for (int k_ = 0; k_ < 4; ++k_) { ap[k_] = apn[k_]; bp[k_] = bpn[k_]; } } while (0)
DI void gemm_rows(const bf16_t* base, int r0, int ld, int tid, const bf16_t* (&pp)[4]) {
    const bf16_t* q = base + (size_t)(r0 + (tid >> 3)) * ld + gemm_chunk(tid) * 8;
#pragma unroll
    for (int i = 0; i < 4; ++i) pp[i] = q + (size_t)(32 * i) * ld;
}
DI bool tile_seq(int q, int nrt, int nct, int& rt, int& ct) {
    if (q >= nrt * nct) return false;
    const int band = q / (8 * nct), rem = q - band * 8 * nct;
    const int rows = (nrt - band * 8) < 8 ? (nrt - band * 8) : 8;
    ct = rem / rows; rt = band * 8 + rem % rows;
    return true;
}
DI int xcd_seq(int i, int total) {
    const int G = gridDim.x, bid = BIDX();
    if ((G & 7) != 0) { const int q = i * G + bid; return q < total ? q : -1; }
    const int x = bid & 7, j = bid >> 3, per = (total + 7) >> 3, gx = G >> 3;
    const int q = i * gx + j;
    if (q >= per) return -1;
    const int g = x * per + q;
    return g < total ? g : -1;
}

template <int MODE>
DI void tr_item(const float* W, int K, int N, bf16_t* WT, float* scr, int item, int lane) {
    const int nblk = N / 32, kb = item / nblk, nb = item % nblk, k0 = 64 * kb, n0 = 32 * nb;
    float wv[32];
#pragma unroll
    for (int i = 0; i < 32; ++i) wv[i] = W[(size_t)(k0 + 2 * i + (lane >> 5)) * N + n0 + (lane & 31)];
#pragma unroll
    for (int i = 0; i < 32; ++i) scr[(2 * i + (lane >> 5)) * 33 + (lane & 31)] = wv[i];
    asm volatile("s_waitcnt lgkmcnt(0)" ::: "memory");
    const int c = lane & 7;
#pragma unroll
    for (int j = 0; j < 4; ++j) {
        const int n = (lane >> 3) + 8 * j; const float* s = scr + (8 * c) * 33 + n;
        u32x4 o; o.x = pk2(s[0 * 33], s[1 * 33]); o.y = pk2(s[2 * 33], s[3 * 33]); o.z = pk2(s[4 * 33], s[5 * 33]); o.w = pk2(s[6 * 33], s[7 * 33]);
        const int nn = n0 + n;
        const int drow = (MODE == 0) ? nn : ((nn >> 4) * 32 + (nn & 15) + (MODE == 2 ? 16 : 0));
        *(u32x4*)(WT + (size_t)drow * K + k0 + 8 * c) = o;
    }
    asm volatile("s_waitcnt lgkmcnt(0)" ::: "memory");
}

DI void phase_pre0(KP p, unsigned char* smem) {
    const int tid = TIDX(), wave = tid >> 6, lane = tid & 63;
    unsigned char* ws = p->ws;
    {
        float* s_sc = (float*)smem;
        float* s_red = s_sc + 9 * 1024;
        const float* c = p->in[1]; const float* cc = p->in[3];
        for (int i = tid; i < 9 * 1024; i += 256) { const int r = i >> 10, k = i & 1023; const float v = r < 8 ? c[r * 1024 + k] : cc[k]; s_sc[i] = v / (1.0f + expf(-v)); }
        __syncthreads();
        float* MOD = (float*)(ws + WS_MOD);
        for (int item = BIDX(); item < 384; item += gridDim.x) {
            const int l = item / 96, n0 = (item % 96) * 64;
            const float* W = p->in[4] + (size_t)l * 1024 * 6144 + n0 + lane;
            float acc[9];
#pragma unroll
            for (int r = 0; r < 9; ++r) acc[r] = 0.f;
#pragma unroll 16
            for (int k = wave * 256; k < wave * 256 + 256; ++k) {
                const float w = W[(size_t)k * 6144];
#pragma unroll
                for (int r = 0; r < 9; ++r) acc[r] += s_sc[r * 1024 + k] * w;
            }
#pragma unroll
            for (int r = 0; r < 9; ++r) s_red[(wave * 9 + r) * 64 + lane] = acc[r];
            __syncthreads();
            for (int i = tid; i < 9 * 64; i += 256) {
                const int r = i >> 6, ln = i & 63;
                const float v = s_red[(0 * 9 + r) * 64 + ln] + s_red[(1 * 9 + r) * 64 + ln] + s_red[(2 * 9 + r) * 64 + ln] + s_red[(3 * 9 + r) * 64 + ln];
                MOD[(size_t)(l * 9 + r) * 6144 + n0 + ln] = v + p->in[5][l * 6144 + n0 + ln];
            }
            __syncthreads();
        }
    }
    {
        const int gt = BIDX() * 256 + tid, NT = gridDim.x * 256;
        float* ca = (float*)(ws + WS_ROPEA); float* sa = ca + 2048 * 64;
        for (int i = gt; i < 2048 * 64; i += NT) {
            const int t = i >> 6, f = i & 63; const int pos = f < 32 ? (t >> 6) : (t & 63); const int ff = f & 31;
            const float inv = powf(10000.0f, -(float)ff / 32.0f); const float a = (float)pos * inv;
            ca[i] = cosf(a); sa[i] = sinf(a);
        }
        float* cc_ = (float*)(ws + WS_ROPEC); float* sc_ = cc_ + 2048 * 32;
        for (int i = gt; i < 2048 * 32; i += NT) {
            const int t = i >> 5, f = i & 31; const int pos = f < 16 ? (t >> 6) : (t & 63); const int ff = f & 15;
            const float inv = powf(10000.0f, -(float)ff / 16.0f); const float a = (float)pos * inv;
            cc_[i] = cosf(a); sc_[i] = sinf(a);
        }
        float* wrt = (float*)(ws + WS_WRT);
        for (int i = gt; i < 4 * 36 * 1024; i += NT) {
            const int l = i / (36 * 1024), o = (i / 1024) % 36, k = i & 1023;
            wrt[i] = o < 4 ? p->in[25][((size_t)l * 1024 + k) * 4 + o] : p->in[27][((size_t)l * 1024 + k) * 32 + (o - 4)];
        }
        unsigned* wpad = (unsigned*)(ws + WS_WIN);
        for (int i = gt; i < 2 * 96 * 512; i += NT) { const int li = i / (96 * 512), r = i % (96 * 512); wpad[((size_t)li * NINP + NIN) * 512 + r] = 0u; }
    }
    __syncthreads();
    {
        float* scr = (float*)smem + wave * (64 * 33);
        constexpr int I_IN = 16 * 113, I_SQ = 16 * 32, I_QKV = 16 * 96, I_E = 256;
        constexpr int R0 = 2 * I_IN, R1 = R0 + 2 * I_SQ, R2 = R1 + 2 * I_QKV, R3 = R2 + 2 * I_SQ, R4 = R3 + 128 * I_E, R5 = R4 + 128 * I_E, R6 = R5 + 128 * I_E;
        for (int it = BIDX() * 4 + wave; it < R6; it += gridDim.x * 4) {
            if (it < R0) { const int i = it / I_IN, r = it % I_IN; tr_item<0>(p->in[10] + (size_t)i * 1024 * NIN, 1024, NIN, (bf16_t*)(ws + WS_WIN) + (size_t)i * NINP * 1024, scr, r, lane); }
            else if (it < R1) { const int q = it - R0, i = q / I_SQ, r = q % I_SQ; tr_item<0>(p->in[17] + (size_t)i * 1024 * 1024, 1024, 1024, (bf16_t*)(ws + WS_WABO) + (size_t)i * 1024 * 1024, scr, r, lane); }
            else if (it < R2) { const int q = it - R1, i = q / I_QKV, r = q % I_QKV; tr_item<0>(p->in[18] + (size_t)i * 1024 * 3072, 1024, 3072, (bf16_t*)(ws + WS_WQKV) + (size_t)i * 3072 * 1024, scr, r, lane); }
            else if (it < R3) { const int q = it - R2, i = q / I_SQ, r = q % I_SQ; tr_item<0>(p->in[24] + (size_t)i * 1024 * 1024, 1024, 1024, (bf16_t*)(ws + WS_WCO) + (size_t)i * 1024 * 1024, scr, r, lane); }
            else if (it < R4) { const int q = it - R3, le = q / I_E, r = q % I_E; tr_item<1>(p->in[29] + (size_t)le * 1024 * 512, 1024, 512, (bf16_t*)(ws + WS_WGU) + (size_t)le * 1024 * 1024, scr, r, lane); }
            else if (it < R5) { const int q = it - R4, le = q / I_E, r = q % I_E; tr_item<2>(p->in[30] + (size_t)le * 1024 * 512, 1024, 512, (bf16_t*)(ws + WS_WGU) + (size_t)le * 1024 * 1024, scr, r, lane); }
            else { const int q = it - R5, le = q / I_E, r = q % I_E; tr_item<0>(p->in[31] + (size_t)le * 512 * 1024, 512, 1024, (bf16_t*)(ws + WS_WD) + (size_t)le * 1024 * 512, scr, r, lane); }
        }
    }
}

DI void phase_pre1(KP p) {
    const int tid = TIDX(), wave = tid >> 6, lane = tid & 63;
    xres_t* X = (xres_t*)(p->ws + WS_X); bf16_t* U = (bf16_t*)(p->ws + WS_U); const float* MOD = (const float*)(p->ws + WS_MOD);
    for (int row = BIDX() * 4 + wave; row < MT; row += gridDim.x * 4) {
        const float* src = row < ML ? p->in[0] + (size_t)row * 1024 : p->in[2] + (size_t)(row - ML) * 1024;
        const int r = row < ML ? (row >> 11) : 8;
        const float* mod = MOD + (size_t)r * 6144;
#pragma unroll
        for (int j = 0; j < 4; ++j) {
            const int k = 256 * j + 4 * lane;
            const f32x4 v = *(const f32x4*)(src + k), sh = *(const f32x4*)(mod + k), sc = *(const f32x4*)(mod + 1024 + k);
            const f32x4 u = v * (1.0f + sc) + sh;
            u32x2 w; w.x = pk2(u[0], u[1]); w.y = pk2(u[2], u[3]);
            *(u32x2*)(U + (size_t)row * 1024 + k) = w;
        }
    }
}

DI void phase_g1e(KP p, int l, unsigned char* smem) {
    const int tid = TIDX(), wid = tid >> 6, lane = tid & 63, wr = wid >> 1, wc = wid & 1, fr = lane & 15, fq = lane >> 4;
    const int li = l >> 1;
    const bf16_t* U = (const bf16_t*)(p->ws + WS_U); const bf16_t* W = (const bf16_t*)(p->ws + WS_WIN) + (size_t)li * NINP * 1024;
    bf16_t* Z = (bf16_t*)(p->ws + WS_Z); float* LR = (float*)(p->ws + WS_LR);
    const float* ca = (const float*)(p->ws + WS_ROPEA); const float* sa = ca + 2048 * 64;
    constexpr int NTN = NINP / 128;
    auto decode = [&](int i, int& brow, int& bcol) -> bool {
        const int q = xcd_seq(i, (MT / 128) * NTN); if (q < 0) return false;
        int rt, nt; tile_seq(q, MT / 128, NTN, rt, nt); brow = rt * 128; bcol = nt * 128; return true; };
    auto epi = [&](int brow, int bcol, f32x4 (&acc)[4][4]) {
        const int colw = bcol + wc * 64;
        if (colw >= NIN) return;
        if (colw >= 3584) {
#pragma unroll
            for (int m = 0; m < 4; ++m) { const int row = brow + wr * 64 + m * 16 + fr;
#pragma unroll
                for (int n = 0; n < 2; ++n) *(f32x4*)(LR + (size_t)row * 32 + n * 16 + fq * 4) = acc[m][n]; }
            return;
        }
        const bool ropeR = colw < 1024; const int half = (colw >> 6) & 1;
        const float scale = colw < 512 ? 0.08838834764831845f : ((colw >= 2048 && colw < 2304) ? 0.125f : 1.0f);
#pragma unroll
        for (int m = 0; m < 4; ++m) {
            const int row = brow + wr * 64 + m * 16 + fr;
            if (ropeR && row < ML) {
                const int t = row & 2047;
#pragma unroll
                for (int n = 0; n < 2; ++n) {
                    const f32x4 c4 = *(const f32x4*)(ca + t * 64 + half * 32 + n * 16 + fq * 4), s4 = *(const f32x4*)(sa + t * 64 + half * 32 + n * 16 + fq * 4);
                    const f32x4 a = acc[m][n], b = acc[m][n + 2];
                    acc[m][n] = a * c4 - b * s4; acc[m][n + 2] = b * c4 + a * s4;
                }
            }
#pragma unroll
            for (int n = 0; n < 4; ++n) {
                const f32x4 v = acc[m][n] * scale; u32x2 w; w.x = pk2(v[0], v[1]); w.y = pk2(v[2], v[3]);
                *(u32x2*)(Z + (size_t)row * ZS + colw + n * 16 + fq * 4) = w;
            }
        }
    };
    int brow, bcol;
    if (!decode(0, brow, bcol)) return;
    const bf16_t* ap[4]; const bf16_t* bp[4]; const bf16_t* apn[4]; const bf16_t* bpn[4];
    gemm_rows(U, brow, 1024, tid, ap); gemm_rows(W, bcol, 1024, tid, bp);
    bool first = true;
    for (int i = 0;; ++i) {
        int nbrow = brow, nbcol = bcol; const bool hn = decode(i + 1, nbrow, nbcol);
        gemm_rows(U, nbrow, 1024, tid, apn); gemm_rows(W, nbcol, 1024, tid, bpn);
        f32x4 acc[4][4];
        gemm_tile<true>(smem, ap, bp, 1024, acc, first, hn, apn, bpn);
        epi(brow, bcol, acc);
        if (!hn) break;
        brow = nbrow; bcol = nbcol; GEMM_ADVANCE(); first = false;
    }
}

DI void phase_g1o(KP p, int l, unsigned char* smem) {
    const int tid = TIDX(), wid = tid >> 6, lane = tid & 63, wr = wid >> 1, wc = wid & 1, fr = lane & 15, fq = lane >> 4;
    const int li = l >> 1;
    const bf16_t* U = (const bf16_t*)(p->ws + WS_U); const bf16_t* W = (const bf16_t*)(p->ws + WS_WQKV) + (size_t)li * 3072 * 1024;
    bf16_t* Qc = (bf16_t*)(p->ws + WS_QC); bf16_t* Kc = (bf16_t*)(p->ws + WS_KC); bf16_t* Vt = (bf16_t*)(p->ws + WS_VT);
    const float* cc = (const float*)(p->ws + WS_ROPEC); const float* sc = cc + 2048 * 32;
    auto decode = [&](int i, int& brow, int& bcol) -> bool {
        const int q = xcd_seq(i, (MT / 128) * 24); if (q < 0) return false;
        int rt, nt; tile_seq(q, MT / 128, 24, rt, nt); brow = rt * 128; bcol = nt * 128; return true; };
    int brow, bcol;
    if (!decode(0, brow, bcol)) return;
    const bf16_t* ap[4]; const bf16_t* bp[4]; const bf16_t* apn[4]; const bf16_t* bpn[4];
    gemm_rows(U, brow, 1024, tid, ap); gemm_rows(W, bcol, 1024, tid, bp);
    bool first = true;
    for (int i = 0;; ++i) {
        int nbrow = brow, nbcol = bcol; const bool hn = decode(i + 1, nbrow, nbcol);
        gemm_rows(U, nbrow, 1024, tid, apn); gemm_rows(W, nbcol, 1024, tid, bpn);
        f32x4 acc[4][4];
        if (bcol < 2048) {
            gemm_tile<true>(smem, ap, bp, 1024, acc, first, hn, apn, bpn);
            const int colw = bcol + wc * 64; const bool isk = colw >= 1024; const int hc = (colw & 1023) >> 6;
            bf16_t* dst = isk ? Kc : Qc; const float scale = isk ? 1.0f : 0.125f;
#pragma unroll
            for (int m = 0; m < 4; ++m) {
                const int row = brow + wr * 64 + m * 16 + fr;
                int b, pidx;
                if (row < ML) {
                    b = row >> 11; const int t = row & 2047; pidx = 256 + t;
#pragma unroll
                    for (int n = 0; n < 4; n += 2) {
                        const f32x4 c4 = *(const f32x4*)(cc + t * 32 + (n >> 1) * 16 + fq * 4), s4 = *(const f32x4*)(sc + t * 32 + (n >> 1) * 16 + fq * 4);
                        const f32x4 a = acc[m][n], bb = acc[m][n + 1];
                        acc[m][n] = a * c4 - bb * s4; acc[m][n + 1] = bb * c4 + a * s4;
                    }
                } else { b = (row - ML) >> 8; pidx = (row - ML) & 255; }
                bf16_t* o = dst + ((size_t)(b * 16 + hc) * TA + pidx) * 64;
#pragma unroll
                for (int n = 0; n < 4; ++n) { const f32x4 v = acc[m][n] * scale; u32x2 w; w.x = pk2(v[0], v[1]); w.y = pk2(v[2], v[3]); *(u32x2*)(o + n * 16 + fq * 4) = w; }
            }
        } else {
            gemm_tile<false>(smem, ap, bp, 1024, acc, first, hn, apn, bpn);
#pragma unroll
            for (int m = 0; m < 4; ++m) {
                const int row = brow + wr * 64 + m * 16 + fq * 4;
                int b, pidx;
                if (row < ML) { b = row >> 11; pidx = 256 + (row & 2047); } else { b = (row - ML) >> 8; pidx = (row - ML) & 255; }
                const int ppos = (pidx & ~12) | ((pidx & 8) >> 1) | ((pidx & 4) << 1);
#pragma unroll
                for (int n = 0; n < 4; ++n) {
                    const int col = bcol - 2048 + wc * 64 + n * 16 + fr; const int h = col >> 7, d = col & 127;
                    const f32x4 v = acc[m][n]; u32x2 w; w.x = pk2(v[0], v[1]); w.y = pk2(v[2], v[3]);
                    *(u32x2*)(Vt + ((size_t)(b * 8 + h) * 128 + d) * TA + ppos) = w;
                }
            }
        }
        if (!hn) break;
        brow = nbrow; bcol = nbcol; GEMM_ADVANCE(); first = false;
    }
}

DI void phase_g2(KP p, int l, unsigned char* smem) {
    const int tid = TIDX(), wid = tid >> 6, lane = tid & 63, wr = wid >> 1, wc = wid & 1, fr = lane & 15, fq = lane >> 4;
    const int li = l >> 1;
    const bf16_t* Y = (const bf16_t*)(p->ws + WS_Y);
    const bf16_t* W = (const bf16_t*)(p->ws + ((l & 1) ? WS_WCO : WS_WABO)) + (size_t)li * 1024 * 1024;
    bf16_t* P = (bf16_t*)(p->ws + WS_P);
    const int nrt = (l == 3 ? ML : MT) / 128;
    auto decode = [&](int i, int& brow, int& bcol) -> bool {
        const int q = xcd_seq(i, nrt * 8); if (q < 0) return false;
        int rt, nt; tile_seq(q, nrt, 8, rt, nt); brow = rt * 128; bcol = nt * 128; return true; };
    int brow, bcol;
    if (!decode(0, brow, bcol)) return;
    const bf16_t* ap[4]; const bf16_t* bp[4]; const bf16_t* apn[4]; const bf16_t* bpn[4];
    gemm_rows(Y, brow, 1024, tid, ap); gemm_rows(W, bcol, 1024, tid, bp);
    bool first = true;
    for (int i = 0;; ++i) {
        int nbrow = brow, nbcol = bcol; const bool hn = decode(i + 1, nbrow, nbcol);
        gemm_rows(Y, nbrow, 1024, tid, apn); gemm_rows(W, nbcol, 1024, tid, bpn);
        f32x4 acc[4][4];
        gemm_tile<true>(smem, ap, bp, 1024, acc, first, hn, apn, bpn);
#pragma unroll
        for (int m = 0; m < 4; ++m) { const int row = brow + wr * 64 + m * 16 + fr;
#pragma unroll
            for (int n = 0; n < 4; ++n) { const f32x4 v = acc[m][n]; u32x2 w; w.x = pk2(v[0], v[1]); w.y = pk2(v[2], v[3]); *(u32x2*)(P + (size_t)row * 1024 + bcol + wc * 64 + n * 16 + fq * 4) = w; } }
        if (!hn) break;
        brow = nbrow; bcol = nbcol; GEMM_ADVANCE(); first = false;
    }
}

template <bool DRY>
DI void phase_ln1r(KP p, int l, unsigned char* smem) {
    constexpr int US = 1028;
    constexpr int RB = 12;
    float* Us = (float*)smem;
    float* Ps = Us + RB * US;
    const int tid = TIDX(), wave = tid >> 6, lane = tid & 63;
    const xres_t* X = (const xres_t*)(p->ws + WS_X); xres_t* Xo = (xres_t*)(p->ws + (DRY ? WS_OB : WS_X)); const bf16_t* P = (const bf16_t*)(p->ws + WS_P); bf16_t* U = (bf16_t*)(p->ws + (DRY ? WS_Y : WS_U));
    const float* MOD = (const float*)(p->ws + WS_MOD); const float* WrT = (const float*)(p->ws + WS_WRT) + (size_t)l * 36 * 1024;
    const float* lng = p->in[6] + l * 1024; const float* lnb = p->in[7] + l * 1024;
    const float* bgrp = p->in[26] + l * 4; const float* brex = p->in[28] + l * 32;
    unsigned* cnt = (unsigned*)(p->ws + WS_CTL) + l * 32 + (DRY ? 256 : 0); int* list = (int*)(p->ws + WS_LIST); float* slotw = (float*)(p->ws + WS_SLOTW);
    const int rows_total = (l == 3) ? ML : MT;
    const int mi = lane & 15, mq = lane >> 4;
    int pend_slot = -1, pend_e = 0; unsigned pend_pos = 0u;
    for (int it = BIDX(); it * RB < rows_total; it += gridDim.x) {
        const int row0 = it * RB + wave * 3;
#pragma unroll
        for (int rr = 0; rr < 3; ++rr) {
            const int rowr = row0 + rr; const bool rvalid = rowr < rows_total; const int row = rvalid ? rowr : rows_total - 1;
            const int r = row < ML ? (row >> 11) : 8;
            const float* mod = MOD + (size_t)(l * 9 + r) * 6144;
            f32x4 v[4]; float s = 0.f;
#pragma unroll
            for (int j = 0; j < 4; ++j) {
                const int k = 256 * j + 4 * lane;
                const f32x4 xv = (l == 0) ? *(const f32x4*)((row < ML ? p->in[0] + (size_t)row * 1024 : p->in[2] + (size_t)(row - ML) * 1024) + k) : xload(X + (size_t)row * 1024 + k);
                const f32x4 g1 = *(const f32x4*)(mod + 2048 + k);
                const u32x2 pw_ = *(const u32x2*)(P + (size_t)row * 1024 + k); const f32x4 pv = (f32x4){bflo(pw_.x), bfhi(pw_.x), bflo(pw_.y), bfhi(pw_.y)};
                v[j] = xv * ALPHA + g1 * pv; s += (v[j][0] + v[j][1]) + (v[j][2] + v[j][3]);
            }
            const float mean = wave_sum(s) * (1.0f / 1024.0f); float s2 = 0.f;
#pragma unroll
            for (int j = 0; j < 4; ++j) { v[j] = v[j] - mean; s2 += (v[j][0] * v[j][0] + v[j][1] * v[j][1]) + (v[j][2] * v[j][2] + v[j][3] * v[j][3]); }
            const float rstd = 1.0f / sqrtf(wave_sum(s2) * (1.0f / 1024.0f) + LN_EPS);
#pragma unroll
            for (int j = 0; j < 4; ++j) {
                const int k = 256 * j + 4 * lane;
                const f32x4 xn = v[j] * rstd * *(const f32x4*)(lng + k) + *(const f32x4*)(lnb + k);
                const f32x4 uu = xn * (1.0f + *(const f32x4*)(mod + 4096 + k)) + *(const f32x4*)(mod + 3072 + k);
                *(f32x4*)(Us + (wave * 3 + rr) * US + k) = uu;
                if (rvalid) {
                    xstore(Xo + (size_t)row * 1024 + k, xn);
                    u32x2 w; w.x = pk2(uu[0], uu[1]); w.y = pk2(uu[2], uu[3]);
                    *(u32x2*)(U + (size_t)row * 1024 + k) = w;
                }
            }
        }
        __syncthreads();
        {
            f32x4 acc[3] = {(f32x4){0.f, 0.f, 0.f, 0.f}, (f32x4){0.f, 0.f, 0.f, 0.f}, (f32x4){0.f, 0.f, 0.f, 0.f}};
            const float* ap = Us + (mi < RB ? mi : mi - RB) * US + 256 * wave + 4 * mq;
            const float* bp0 = WrT + (size_t)mi * 1024 + 256 * wave + 4 * mq;
            const float* bp1 = WrT + (size_t)(16 + mi) * 1024 + 256 * wave + 4 * mq;
            const float* bp2 = WrT + (size_t)(32 + (mi & 3)) * 1024 + 256 * wave + 4 * mq;
#pragma unroll 4
            for (int sb = 0; sb < 16; ++sb) {
                const f32x4 a = *(const f32x4*)(ap + 16 * sb);
                const f32x4 b0 = *(const f32x4*)(bp0 + 16 * sb), b1 = *(const f32x4*)(bp1 + 16 * sb), b2 = *(const f32x4*)(bp2 + 16 * sb);
#pragma unroll
                for (int e = 0; e < 4; ++e) {
                    acc[0] = __builtin_amdgcn_mfma_f32_16x16x4f32(a[e], b0[e], acc[0], 0, 0, 0);
                    acc[1] = __builtin_amdgcn_mfma_f32_16x16x4f32(a[e], b1[e], acc[1], 0, 0, 0);
                    acc[2] = __builtin_amdgcn_mfma_f32_16x16x4f32(a[e], b2[e], acc[2], 0, 0, 0);
                }
            }
            if (mq < 3) {
#pragma unroll
                for (int nt = 0; nt < 3; ++nt)
#pragma unroll
                    for (int rg = 0; rg < 4; ++rg) Ps[(wave * RB + mq * 4 + rg) * 48 + nt * 16 + mi] = acc[nt][rg];
            }
        }
        __syncthreads();
        if (wave < 2) {
            const int r = wave * 8 + (lane >> 3), c = lane & 7;
            const int rq = r < RB ? r : RB - 1;
            const int row = it * RB + rq;
            float lgv[5];
#pragma unroll
            for (int k = 0; k < 5; ++k) {
                const int o = c + 8 * k; const int oo = o < 36 ? o : 35;
                lgv[k] = (Ps[(0 * RB + rq) * 48 + oo] + Ps[(1 * RB + rq) * 48 + oo]) + (Ps[(2 * RB + rq) * 48 + oo] + Ps[(3 * RB + rq) * 48 + oo]);
            }
            float gv = c < 4 ? lgv[0] + bgrp[c & 3] : -3.0e38f; int gi = c;
#pragma unroll
            for (int off = 1; off < 4; off <<= 1) {
                const float ov = __shfl_xor(gv, off); const int oi = __shfl_xor(gi, off);
                if (ov > gv || (ov == gv && oi < gi)) { gv = ov; gi = oi; }
            }
            const int src0 = lane & ~7;
            const float gmax = __shfl(gv, src0); const int grp = __shfl(gi, src0);
            float ge = c < 4 ? expf(lgv[0] + bgrp[c & 3] - gmax) : 0.f;
            ge += __shfl_xor(ge, 1); ge += __shfl_xor(ge, 2);
            const float gw = 1.0f / __shfl(ge, src0);
            const int j = (c + 4) & 7; const int kk = c >= 4 ? grp : grp + 1;
            float ev = lgv[0];
#pragma unroll
            for (int k = 1; k < 5; ++k) ev = (kk == k) ? lgv[k] : ev;
            ev += brex[grp * 8 + j];
            float v1 = ev; int i1 = j;
#pragma unroll
            for (int off = 1; off < 8; off <<= 1) {
                const float ov = __shfl_xor(v1, off); const int oi = __shfl_xor(i1, off);
                if (ov > v1 || (ov == v1 && oi < i1)) { v1 = ov; i1 = oi; }
            }
            float v2 = (j == i1) ? -3.0e38f : ev; int i2 = (j == i1) ? 99 : j;
#pragma unroll
            for (int off = 1; off < 8; off <<= 1) {
                const float ov = __shfl_xor(v2, off); const int oi = __shfl_xor(i2, off);
                if (ov > v2 || (ov == v2 && oi < i2)) { v2 = ov; i2 = oi; }
            }
            const float e2 = expf(v2 - v1);
            const float w1 = 1.0f / (1.0f + e2), w2 = e2 / (1.0f + e2);
            if (c < 2 && r < RB && row < rows_total) {
                if (pend_slot >= 0) list[(size_t)pend_e * NSLOT + pend_pos] = pend_slot;
                const int e = grp * 8 + (c ? i2 : i1); const float w = gw * (c ? w2 : w1);
                const int slot = row * 2 + c;
                slotw[slot] = w;
                pend_pos = atomicAdd(&cnt[e], 1u); pend_e = e; pend_slot = slot;
            }
        }
        __syncthreads();
    }
    if (pend_slot >= 0) list[(size_t)pend_e * NSLOT + pend_pos] = pend_slot;
}

DI void moe_prefix(KP p, int l, int* s_cnt, int* s_tb, int* s_rb) {
    const int tid = TIDX();
    const unsigned* cnt = (const unsigned*)(p->ws + WS_CTL) + l * 32;
    __syncthreads();
    if (tid < 32) s_cnt[tid] = (int)__hip_atomic_load(cnt + tid, __ATOMIC_RELAXED, __HIP_MEMORY_SCOPE_AGENT);
    __syncthreads();
    if (tid == 0) { int tb = 0; for (int e = 0; e < 32; ++e) { s_tb[e] = tb; s_rb[e] = tb * 128; tb += (s_cnt[e] + 127) >> 7; } s_tb[32] = tb; s_rb[32] = tb * 128; }
    __syncthreads();
}
DI void phase_mg1(KP p, int l, unsigned char* smem) {
    const int tid = TIDX(), wid = tid >> 6, lane = tid & 63, wr = wid >> 1, wc = wid & 1, fr = lane & 15, fq = lane >> 4;
    int* s_cnt = (int*)(smem + 65536 + 64); int* s_tb = s_cnt + 32; int* s_rb = s_tb + 33;
    moe_prefix(p, l, s_cnt, s_tb, s_rb);
    const bf16_t* U = (const bf16_t*)(p->ws + WS_U); const int* list = (const int*)(p->ws + WS_LIST);
    bf16_t* H = (bf16_t*)(p->ws + WS_H);
    const int ntiles = s_tb[32] * 8;
    struct TI { int e, rt, nt, cnt_e; };
    auto decode = [&](int i, TI& t) -> bool {
        const int tile = xcd_seq(i, ntiles); if (tile < 0) return false;
        const int rtg = tile >> 3; t.nt = tile & 7;
        int e = 0;
        for (int q = 1; q < 32; ++q) if (rtg >= s_tb[q]) e = q;
        t.e = e; t.rt = rtg - s_tb[e]; t.cnt_e = s_cnt[e]; return true; };
    auto rows = [&](const TI& t, const bf16_t* (&a)[4], const bf16_t* (&b)[4]) {
#pragma unroll
        for (int i_ = 0; i_ < 4; ++i_) {
            const int pos = t.rt * 128 + (tid >> 3) + 32 * i_;
            const int tok = pos < t.cnt_e ? (list[(size_t)t.e * NSLOT + pos] >> 1) : 0;
            a[i_] = U + (size_t)tok * 1024 + gemm_chunk(tid) * 8;
        }
        gemm_rows((const bf16_t*)(p->ws + WS_WGU) + (size_t)(l * 32 + t.e) * 1024 * 1024, t.nt * 128, 1024, tid, b); };
    TI cur, nxt;
    if (!decode(0, cur)) return;
    const bf16_t* ap[4]; const bf16_t* bp[4]; const bf16_t* apn[4]; const bf16_t* bpn[4];
    rows(cur, ap, bp);
    bool first = true;
    for (int i = 0;; ++i) {
        nxt = cur; const bool hn = decode(i + 1, nxt);
        rows(nxt, apn, bpn);
        f32x4 acc[4][4];
        gemm_tile<true>(smem, ap, bp, 1024, acc, first, hn, apn, bpn);
        const int hrow0 = s_rb[cur.e] + cur.rt * 128 + wr * 64;
#pragma unroll
        for (int m = 0; m < 4; ++m) {
            bf16_t* o = H + (size_t)(hrow0 + m * 16 + fr) * 512 + cur.nt * 64 + wc * 32 + fq * 4;
#pragma unroll
            for (int n = 0; n < 4; n += 2) {
                const f32x4 g = acc[m][n], uu = acc[m][n + 1]; f32x4 h;
#pragma unroll
                for (int j = 0; j < 4; ++j) h[j] = siluf(g[j]) * uu[j];
                u32x2 w; w.x = pk2(h[0], h[1]); w.y = pk2(h[2], h[3]);
                *(u32x2*)(o + (n >> 1) * 16) = w;
            }
        }
        if (!hn) break;
        cur = nxt; GEMM_ADVANCE(); first = false;
    }
}
DI void phase_mg2(KP p, int l, unsigned char* smem) {
    const int tid = TIDX(), wid = tid >> 6, lane = tid & 63, wr = wid >> 1, wc = wid & 1, fr = lane & 15, fq = lane >> 4;
    int* s_cnt = (int*)(smem + 65536 + 64); int* s_tb = s_cnt + 32; int* s_rb = s_tb + 33;
    moe_prefix(p, l, s_cnt, s_tb, s_rb);
    const bf16_t* H = (const bf16_t*)(p->ws + WS_H); const int* list = (const int*)(p->ws + WS_LIST); const float* slotw = (const float*)(p->ws + WS_SLOTW);
    bf16_t* YS = (bf16_t*)(p->ws + WS_YS);
    const int ntiles = s_tb[32] * 8;
    struct TI { int e, rt, nt, cnt_e; };
    auto decode = [&](int i, TI& t) -> bool {
        const int tile = xcd_seq(i, ntiles); if (tile < 0) return false;
        const int rtg = tile >> 3; t.nt = tile & 7;
        int e = 0;
        for (int q = 1; q < 32; ++q) if (rtg >= s_tb[q]) e = q;
        t.e = e; t.rt = rtg - s_tb[e]; t.cnt_e = s_cnt[e]; return true; };
    auto rows = [&](const TI& t, const bf16_t* (&a)[4], const bf16_t* (&b)[4]) {
        gemm_rows(H, s_rb[t.e] + t.rt * 128, 512, tid, a);
        gemm_rows((const bf16_t*)(p->ws + WS_WD) + (size_t)(l * 32 + t.e) * 1024 * 512, t.nt * 128, 512, tid, b); };
    TI cur, nxt;
    if (!decode(0, cur)) return;
    const bf16_t* ap[4]; const bf16_t* bp[4]; const bf16_t* apn[4]; const bf16_t* bpn[4];
    rows(cur, ap, bp);
    bool first = true;
    for (int i = 0;; ++i) {
        nxt = cur; const bool hn = decode(i + 1, nxt);
        rows(nxt, apn, bpn);
        f32x4 acc[4][4];
        gemm_tile<true>(smem, ap, bp, 512, acc, first, hn, apn, bpn);
#pragma unroll
        for (int m = 0; m < 4; ++m) {
            const int pos = cur.rt * 128 + wr * 64 + m * 16 + fr;
            if (pos < cur.cnt_e) {
                const int slot = list[(size_t)cur.e * NSLOT + pos]; const float w = slotw[slot];
                bf16_t* o = YS + (size_t)slot * 1024 + cur.nt * 128 + wc * 64 + fq * 4;
#pragma unroll
                for (int n = 0; n < 4; ++n) { const f32x4 v = acc[m][n] * w; u32x2 ww; ww.x = pk2(v[0], v[1]); ww.y = pk2(v[2], v[3]); *(u32x2*)(o + n * 16) = ww; }
            }
        }
        if (!hn) break;
        cur = nxt; GEMM_ADVANCE(); first = false;
    }
}

template <bool DRY>
DI void phase_ln2(KP p, int l) {
    const int tid = TIDX(), wave = tid >> 6, lane = tid & 63;
    const xres_t* X = (const xres_t*)(p->ws + WS_X); xres_t* Xo = (xres_t*)(p->ws + (DRY ? WS_OB : WS_X)); const bf16_t* YS = (const bf16_t*)(p->ws + WS_YS); bf16_t* U = (bf16_t*)(p->ws + (DRY ? WS_Y : WS_U));
    const float* MOD = (const float*)(p->ws + WS_MOD);
    const float* lng = p->in[8] + l * 1024; const float* lnb = p->in[9] + l * 1024;
    const int rows_total = (l == 3) ? ML : MT;
    for (int row0 = (BIDX() * 4 + wave) * 2; row0 < rows_total; row0 += gridDim.x * 8) {
        f32x4 v[2][4]; float s[2] = {0.f, 0.f};
        const float* mod[2];
#pragma unroll
        for (int q = 0; q < 2; ++q) {
            const int row = row0 + q; const int r = row < ML ? (row >> 11) : 8;
            mod[q] = MOD + (size_t)(l * 9 + r) * 6144;
#pragma unroll
            for (int j = 0; j < 4; ++j) {
                const int k = 256 * j + 4 * lane;
                const u32x2 y0 = *(const u32x2*)(YS + (size_t)(2 * row) * 1024 + k), y1 = *(const u32x2*)(YS + (size_t)(2 * row + 1) * 1024 + k);
                f32x4 y; y[0] = bflo(y0.x) + bflo(y1.x); y[1] = bfhi(y0.x) + bfhi(y1.x); y[2] = bflo(y0.y) + bflo(y1.y); y[3] = bfhi(y0.y) + bfhi(y1.y);
                const f32x4 xv = xload(X + (size_t)row * 1024 + k), g2 = *(const f32x4*)(mod[q] + 5120 + k);
                v[q][j] = xv * ALPHA + g2 * y; s[q] += (v[q][j][0] + v[q][j][1]) + (v[q][j][2] + v[q][j][3]);
            }
        }
        float mean[2], rstd[2];
#pragma unroll
        for (int q = 0; q < 2; ++q) mean[q] = wave_sum(s[q]) * (1.0f / 1024.0f);
#pragma unroll
        for (int q = 0; q < 2; ++q) {
            float s2 = 0.f;
#pragma unroll
            for (int j = 0; j < 4; ++j) { v[q][j] = v[q][j] - mean[q]; s2 += (v[q][j][0] * v[q][j][0] + v[q][j][1] * v[q][j][1]) + (v[q][j][2] * v[q][j][2] + v[q][j][3] * v[q][j][3]); }
            s[q] = s2;
        }
#pragma unroll
        for (int q = 0; q < 2; ++q) rstd[q] = 1.0f / sqrtf(wave_sum(s[q]) * (1.0f / 1024.0f) + LN_EPS);
#pragma unroll
        for (int q = 0; q < 2; ++q) {
            const int row = row0 + q;
            const float* modn = mod[q] + (l + 1 < 4 ? 9 * 6144 : 0);
#pragma unroll
            for (int j = 0; j < 4; ++j) {
                const int k = 256 * j + 4 * lane;
                const f32x4 xn = v[q][j] * rstd[q] * *(const f32x4*)(lng + k) + *(const f32x4*)(lnb + k);
                if (l < 3) {
                    xstore(Xo + (size_t)row * 1024 + k, xn);
                    const f32x4 uu = xn * (1.0f + *(const f32x4*)(modn + 1024 + k)) + *(const f32x4*)(modn + k);
                    u32x2 w; w.x = pk2(uu[0], uu[1]); w.y = pk2(uu[2], uu[3]);
                    *(u32x2*)(U + (size_t)row * 1024 + k) = w;
                } else {
                    *(f32x4*)(p->out + (size_t)row * 1024 + k) = xn;
                }
            }
        }
    }
}

DI s16x4 tr_read(const unsigned char* ptr) {
    typedef short v4i16_t __attribute__((ext_vector_type(4)));
    return __builtin_bit_cast(s16x4, __builtin_amdgcn_ds_read_tr16_b64_v4i16((LAS v4i16_t*)ptr));
}
DI bf16x8 cat8(s16x4 a, s16x4 b) { return __builtin_shufflevector(a, b, 0, 1, 2, 3, 4, 5, 6, 7); }

DI void phase_decay(KP p, int l, unsigned char* smem) {
    const int tid = TIDX();
    const int li = l >> 1;
    const float* LR = (const float*)(p->ws + WS_LR);
    float* PF = (float*)(p->ws + WS_PF); float* SQ = (float*)(p->ws + WS_SQ); float* SK = (float*)(p->ws + WS_SK); float* TOT = (float*)(p->ws + WS_TOT);
    float* lrs = (float*)smem;
    float wf[16], wb[16];
#pragma unroll
    for (int r = 0; r < 16; ++r) { wf[r] = p->in[11][(size_t)li * 16 * 256 + r * 256 + tid]; wb[r] = p->in[13][(size_t)li * 16 * 256 + r * 256 + tid]; }
    const float bf = p->in[12][li * 256 + tid], bb = p->in[14][li * 256 + tid];
    for (int it = BIDX(); it < 2 * (MT / 64); it += gridDim.x) {
        const int ch = it >> 1, dr = it & 1;
        const int row0 = ch * 64;
        __syncthreads();
        { const int tok = tid >> 2, q4 = tid & 3; *(f32x4*)(lrs + tok * 16 + q4 * 4) = *(const f32x4*)(LR + (size_t)(row0 + tok) * 32 + dr * 16 + q4 * 4); }
        __syncthreads();
        float run = 0.f;
        if (dr == 0) {
            for (int t = 0; t < 64; ++t) {
                float g = bf;
#pragma unroll
                for (int r = 0; r < 16; ++r) g += lrs[t * 16 + r] * wf[r];
                run += (fminf(g, 0.f) - __logf(1.0f + __expf(-fabsf(g)))) * (1.0f / 16.0f);
                PF[(size_t)(row0 + t) * 256 + tid] = run;
            }
        } else {
            for (int t = 63; t >= 0; --t) {
                float g = bb;
#pragma unroll
                for (int r = 0; r < 16; ++r) g += lrs[t * 16 + r] * wb[r];
                SQ[(size_t)(row0 + t) * 256 + tid] = run;
                run += (fminf(g, 0.f) - __logf(1.0f + __expf(-fabsf(g)))) * (1.0f / 16.0f);
                SK[(size_t)(row0 + t) * 256 + tid] = run;
            }
        }
        TOT[(size_t)(ch * 2 + dr) * 256 + tid] = run;
    }
}

template <int DK>
DI void scan_item(KP p, int l, int item, unsigned char* smem) {
    constexpr bool ISA = (DK == 128);
    constexpr int QS = DK * 2 + 16, KS = DK * 2 + 32, VS = 96, AS_ = 144, SS = DK * 2 + 16, NKS = DK / 32, NMT = DK / 64;
    constexpr int O_QD = 0, O_KD = O_QD + 64 * QS, O_V = O_KD + 64 * KS, O_ATT = O_V + 64 * VS, O_ST = O_ATT + 64 * AS_, O_END = O_ST + 32 * SS;
    static_assert(O_END <= 65536, "scan LDS");
    constexpr int NP = DK / 64 * 2;
    constexpr int CPR = DK / 8;
    const int tid = TIDX(), wid = tid >> 6, lane = tid & 63, fr = lane & 15, fq = lane >> 4;
    const int b = item >> 5, h = (item >> 3) & 3, dir = (item >> 2) & 1, dvq = item & 3;
    const bf16_t* Z = (const bf16_t*)(p->ws + WS_Z);
    const float* EQ = (const float*)(p->ws + (dir ? WS_SQ : WS_PF)); const float* EK = (const float*)(p->ws + (dir ? WS_SK : WS_PF)); const float* TOT = (const float*)(p->ws + WS_TOT);
    bf16_t* OUT = (bf16_t*)(p->ws + (dir ? WS_OB : WS_OF));
    const int qcol = ISA ? h * 128 : 2048 + h * 64, kcol = ISA ? 512 + h * 128 : 2304 + h * 64, vcol = (ISA ? 1024 : 2560) + h * 128 + dvq * 32;
    const int ocol = (ISA ? 0 : 512) + h * 128 + dvq * 32;
    float lam = 0.f;
    if (ISA) lam = log1pf(-exp2f(-((dir ? 5.5f : 5.0f) + (float)h)));
    f32x4 S[NMT][2];
#pragma unroll
    for (int a = 0; a < NMT; ++a) { S[a][0] = (f32x4){0.f, 0.f, 0.f, 0.f}; S[a][1] = (f32x4){0.f, 0.f, 0.f, 0.f}; }
    __syncthreads();
    for (int i = tid; i < 32 * SS / 4; i += 256) ((unsigned*)(smem + O_ST))[i] = 0u;
    auto chunk_row0 = [&](int cc) -> int {
        const int ci = dir ? 35 - cc : cc; const int pp = ci * 64;
        if (!dir) return pp < 256 ? ML + b * 256 + pp : b * 2048 + (pp - 256);
        return pp < 2048 ? b * 2048 + pp : ML + b * 256 + (pp - 2048);
    };
    u32x4 rq[NP], rk[NP], rv; f32x4 eq[ISA ? 1 : NP][2], ek[ISA ? 1 : NP][2]; f32x4 tv[NMT];
    auto fetch = [&](int cc) {
        const int row0 = chunk_row0(cc);
        if (!ISA) {
#pragma unroll
            for (int a = 0; a < NMT; ++a) tv[a] = *(const f32x4*)(TOT + (size_t)((row0 >> 6) * 2 + dir) * 256 + h * 64 + (wid * NMT + a) * 16 + fq * 4);
        }
#pragma unroll
        for (int i = 0; i < NP; ++i) {
            const int id = tid + 256 * i, tok = id / CPR, cg_ = id % CPR;
            const size_t ro = (size_t)(row0 + tok) * ZS;
            rq[i] = *(const u32x4*)(Z + ro + qcol + cg_ * 8); rk[i] = *(const u32x4*)(Z + ro + kcol + cg_ * 8);
            if (!ISA) {
                const size_t eo = (size_t)(row0 + tok) * 256 + h * 64 + cg_ * 8;
                eq[i][0] = *(const f32x4*)(EQ + eo); eq[i][1] = *(const f32x4*)(EQ + eo + 4);
                ek[i][0] = *(const f32x4*)(EK + eo); ek[i][1] = *(const f32x4*)(EK + eo + 4);
            }
        }
        { const int tok = tid >> 2, cg_ = tid & 3; rv = *(const u32x4*)(Z + (size_t)(row0 + tok) * ZS + vcol + cg_ * 8); }
    };
    float ra[NP], rc[NP];
#pragma unroll
    for (int i = 0; i < NP; ++i) {
        const int tok = (tid + 256 * i) / CPR;
        ra[i] = dir ? __expf(lam * (float)(63 - tok)) : __expf(lam * (float)(tok + 1));
        rc[i] = dir ? __expf(-lam * (float)(64 - tok)) : __expf(-lam * (float)(tok + 1));
    }
    const float decA = __expf(lam * 64.0f);
    fetch(0);
    for (int cc = 0; cc < 36; ++cc) {
        const int row0 = chunk_row0(cc);
#pragma unroll
        for (int i = 0; i < NP; ++i) {
            const int id = tid + 256 * i, tok = id / CPR, cg_ = id % CPR;
            float fqv[8], fkv[8];
            if (ISA) {
#pragma unroll
                for (int e = 0; e < 8; ++e) { fqv[e] = ra[i]; fkv[e] = rc[i]; }
            } else {
#pragma unroll
                for (int e = 0; e < 8; ++e) { fqv[e] = __expf(eq[i][e >> 2][e & 3]); fkv[e] = __expf(-ek[i][e >> 2][e & 3]); }
            }
            const u32x4 q = rq[i], k = rk[i]; u32x4 qo, ko;
            qo.x = pk2(bflo(q.x) * fqv[0], bfhi(q.x) * fqv[1]); qo.y = pk2(bflo(q.y) * fqv[2], bfhi(q.y) * fqv[3]); qo.z = pk2(bflo(q.z) * fqv[4], bfhi(q.z) * fqv[5]); qo.w = pk2(bflo(q.w) * fqv[6], bfhi(q.w) * fqv[7]);
            ko.x = pk2(bflo(k.x) * fkv[0], bfhi(k.x) * fkv[1]); ko.y = pk2(bflo(k.y) * fkv[2], bfhi(k.y) * fkv[3]); ko.z = pk2(bflo(k.z) * fkv[4], bfhi(k.z) * fkv[5]); ko.w = pk2(bflo(k.w) * fkv[6], bfhi(k.w) * fkv[7]);
            *(u32x4*)(smem + O_QD + tok * QS + cg_ * 16) = qo;
            *(u32x4*)(smem + O_KD + tok * KS + cg_ * 16) = ko;
        }
        { const int tok = tid >> 2, cg_ = tid & 3; *(u32x4*)(smem + O_V + tok * VS + cg_ * 16) = rv; }
        f32x4 dec[NMT];
#pragma unroll
        for (int a = 0; a < NMT; ++a) {
            if (ISA) dec[a] = (f32x4){decA, decA, decA, decA};
            else dec[a] = (f32x4){__expf(tv[a][0]), __expf(tv[a][1]), __expf(tv[a][2]), __expf(tv[a][3])};
        }
        if (cc + 1 < 36) fetch(cc + 1);
        __syncthreads();
        bf16x8 afr[2];
        {
            f32x4 at[4];
#pragma unroll
            for (int n = 0; n < 4; ++n) at[n] = (f32x4){0.f, 0.f, 0.f, 0.f};
#pragma unroll
            for (int ks = 0; ks < NKS; ++ks) {
                const bf16x8 qf = *(const bf16x8*)(smem + O_QD + (16 * wid + fr) * QS + (32 * ks + 8 * fq) * 2);
#pragma unroll
                for (int n = 0; n < 4; ++n) {
                    const bf16x8 kf = *(const bf16x8*)(smem + O_KD + (16 * n + fr) * KS + (32 * ks + 8 * fq) * 2);
                    at[n] = __builtin_amdgcn_mfma_f32_16x16x32_bf16(kf, qf, at[n], 0, 0, 0);
                }
            }
            const int i = 16 * wid + fr;
#pragma unroll
            for (int n = 0; n < 4; ++n)
#pragma unroll
                for (int jj = 0; jj < 4; ++jj) { const int j = n * 16 + fq * 4 + jj; const bool keep = dir ? (j > i) : (j <= i); at[n][jj] = keep ? at[n][jj] : 0.f; }
#pragma unroll
            for (int ks = 0; ks < 2; ++ks) {
                u32x4 w; w.x = pk2(at[2 * ks][0], at[2 * ks][1]); w.y = pk2(at[2 * ks][2], at[2 * ks][3]); w.z = pk2(at[2 * ks + 1][0], at[2 * ks + 1][1]); w.w = pk2(at[2 * ks + 1][2], at[2 * ks + 1][3]);
                afr[ks] = __builtin_bit_cast(bf16x8, w);
            }
        }
        bf16x8 vf[2][2];
        {
            const int g = lane >> 4, i16 = lane & 15, q = i16 >> 2, pq = i16 & 3;
#pragma unroll
            for (int ks = 0; ks < 2; ++ks)
#pragma unroll
                for (int n = 0; n < 2; ++n) {
                    const unsigned char* a = smem + O_V + (32 * ks + 4 * g + q) * VS + (n * 16 + 4 * pq) * 2;
                    vf[ks][n] = cat8(tr_read(a), tr_read(a + 16 * VS));
                }
        }
        {
            f32x4 oa[2] = {(f32x4){0.f, 0.f, 0.f, 0.f}, (f32x4){0.f, 0.f, 0.f, 0.f}};
#pragma unroll
            for (int ks = 0; ks < 2; ++ks)
#pragma unroll
                for (int n = 0; n < 2; ++n) oa[n] = __builtin_amdgcn_mfma_f32_16x16x32_bf16(vf[ks][n], afr[ks], oa[n], 0, 0, 0);
#pragma unroll
            for (int ks = 0; ks < NKS; ++ks) {
                const bf16x8 qf = *(const bf16x8*)(smem + O_QD + (16 * wid + fr) * QS + (32 * ks + 8 * fq) * 2);
#pragma unroll
                for (int n = 0; n < 2; ++n) {
                    const bf16x8 sf = *(const bf16x8*)(smem + O_ST + (16 * n + fr) * SS + (32 * ks + 8 * fq) * 2);
                    oa[n] = __builtin_amdgcn_mfma_f32_16x16x32_bf16(sf, qf, oa[n], 0, 0, 0);
                }
            }
            bf16_t* o = OUT + (size_t)(row0 + 16 * wid + fr) * 1024 + ocol + fq * 4;
            u32x2 w0, w1; w0.x = pk2(oa[0][0], oa[0][1]); w0.y = pk2(oa[0][2], oa[0][3]); w1.x = pk2(oa[1][0], oa[1][1]); w1.y = pk2(oa[1][2], oa[1][3]);
            *(u32x2*)(o) = w0; *(u32x2*)(o + 16) = w1;
        }
        {
            const int g = lane >> 4, i16 = lane & 15, q = i16 >> 2, pq = i16 & 3;
#pragma unroll
            for (int a = 0; a < NMT; ++a) {
                const int mt = wid * NMT + a;
#pragma unroll
                for (int ks = 0; ks < 2; ++ks) {
                    const unsigned char* ka = smem + O_KD + (32 * ks + 4 * g + q) * KS + (mt * 16 + 4 * pq) * 2;
                    const bf16x8 kf = cat8(tr_read(ka), tr_read(ka + 16 * KS));
#pragma unroll
                    for (int n = 0; n < 2; ++n) S[a][n] = __builtin_amdgcn_mfma_f32_16x16x32_bf16(kf, vf[ks][n], S[a][n], 0, 0, 0);
                }
                S[a][0] *= dec[a]; S[a][1] *= dec[a];
            }
        }
        __syncthreads();
#pragma unroll
        for (int a = 0; a < NMT; ++a) {
            const int mt = wid * NMT + a;
#pragma unroll
            for (int n = 0; n < 2; ++n) { u32x2 w; w.x = pk2(S[a][n][0], S[a][n][1]); w.y = pk2(S[a][n][2], S[a][n][3]); *(u32x2*)(smem + O_ST + (n * 16 + fr) * SS + (mt * 16 + fq * 4) * 2) = w; }
        }
    }
    __syncthreads();
}
DI void phase_scan(KP p, int l, unsigned char* smem) {
    for (int it = BIDX(); it < 512; it += gridDim.x) {
        if (it < 256) scan_item<128>(p, l, it, smem); else scan_item<64>(p, l, it - 256, smem);
    }
}

DI void phase_merge(KP p, int l) {
    const int tid = TIDX(), wave = tid >> 6, lane = tid & 63;
    const int li = l >> 1;
    const bf16_t* OF = (const bf16_t*)(p->ws + WS_OF); const bf16_t* OB = (const bf16_t*)(p->ws + WS_OB);
    const bf16_t* Z = (const bf16_t*)(p->ws + WS_Z); bf16_t* Y = (bf16_t*)(p->ws + WS_Y);
    const bool isA = lane < 32;
    const float* gn = isA ? p->in[15] + li * 512 + lane * 16 : p->in[16] + li * 512 + (lane - 32) * 16;
    const int gcol = isA ? 1536 + lane * 16 : 3072 + (lane - 32) * 16;
    for (int row = BIDX() * 4 + wave; row < MT; row += gridDim.x * 4) {
        float o[16]; float s = 0.f;
#pragma unroll
        for (int j = 0; j < 2; ++j) {
            const u32x4 a = *(const u32x4*)(OF + (size_t)row * 1024 + lane * 16 + j * 8), bb = *(const u32x4*)(OB + (size_t)row * 1024 + lane * 16 + j * 8);
            o[j * 8 + 0] = bflo(a.x) + bflo(bb.x); o[j * 8 + 1] = bfhi(a.x) + bfhi(bb.x); o[j * 8 + 2] = bflo(a.y) + bflo(bb.y); o[j * 8 + 3] = bfhi(a.y) + bfhi(bb.y);
            o[j * 8 + 4] = bflo(a.z) + bflo(bb.z); o[j * 8 + 5] = bfhi(a.z) + bfhi(bb.z); o[j * 8 + 6] = bflo(a.w) + bflo(bb.w); o[j * 8 + 7] = bfhi(a.w) + bfhi(bb.w);
        }
#pragma unroll
        for (int e = 0; e < 16; ++e) s += o[e];
        s += __shfl_xor(s, 1); s += __shfl_xor(s, 2); s += __shfl_xor(s, 4);
        const float mean = isA ? s * (1.0f / 128.0f) : 0.f;
        float s2 = 0.f;
#pragma unroll
        for (int e = 0; e < 16; ++e) { o[e] -= mean; s2 += o[e] * o[e]; }
        s2 += __shfl_xor(s2, 1); s2 += __shfl_xor(s2, 2); s2 += __shfl_xor(s2, 4);
        const float rs = 1.0f / sqrtf(s2 * (1.0f / 128.0f) + LN_EPS);
        const u32x4 g0 = *(const u32x4*)(Z + (size_t)row * ZS + gcol), g1 = *(const u32x4*)(Z + (size_t)row * ZS + gcol + 8);
        float gt[16];
        gt[0] = bflo(g0.x); gt[1] = bfhi(g0.x); gt[2] = bflo(g0.y); gt[3] = bfhi(g0.y); gt[4] = bflo(g0.z); gt[5] = bfhi(g0.z); gt[6] = bflo(g0.w); gt[7] = bfhi(g0.w);
        gt[8] = bflo(g1.x); gt[9] = bfhi(g1.x); gt[10] = bflo(g1.y); gt[11] = bfhi(g1.y); gt[12] = bflo(g1.z); gt[13] = bfhi(g1.z); gt[14] = bflo(g1.w); gt[15] = bfhi(g1.w);
        float y[16];
#pragma unroll
        for (int e = 0; e < 16; ++e) y[e] = siluf(gt[e]) * (o[e] * rs * gn[e]);
        u32x4 w0, w1;
        w0.x = pk2(y[0], y[1]); w0.y = pk2(y[2], y[3]); w0.z = pk2(y[4], y[5]); w0.w = pk2(y[6], y[7]);
        w1.x = pk2(y[8], y[9]); w1.y = pk2(y[10], y[11]); w1.z = pk2(y[12], y[13]); w1.w = pk2(y[14], y[15]);
        *(u32x4*)(Y + (size_t)row * 1024 + lane * 16) = w0; *(u32x4*)(Y + (size_t)row * 1024 + lane * 16 + 8) = w1;
    }
}

DI int crow(int r, int hi) { return (r & 3) + 8 * (r >> 2) + 4 * hi; }
constexpr int ATT_BUF = 24576;
DI void att_component(const bf16_t* Qc, const bf16_t* Kc, const bf16_t* Vt, unsigned char* smem, float* wsf, int b, int h, int comp, int p0, int nkv, f32x16 (&O)[4]) {
    const int tid = TIDX(), wid = tid >> 6, lane = tid & 63, r32 = lane & 31, hi = lane >> 5;
    const int hc = h * 2 + comp;
    const bf16_t* Qb = Qc + ((size_t)(b * 16 + hc) * TA + p0 + wid * 32 + r32) * 64;
    const int gch = gemm_chunk(tid);
    const bf16_t* Kg = Kc + (size_t)(b * 16 + hc) * TA * 64 + (size_t)(tid >> 3) * 64 + gch * 8;
    const bf16_t* Vg = Vt + (size_t)(b * 8 + h) * 128 * TA + (size_t)(tid >> 3) * TA + gch * 8;
#define ATT_STAGE(buf, kt) do { \
        _Pragma("unroll") for (int i_ = 0; i_ < 2; ++i_) __builtin_amdgcn_global_load_lds((const unsigned*)(Kg + (size_t)((kt) + 32 * i_) * 64), (LAS unsigned*)(smem + (buf) * ATT_BUF + i_ * 4096 + tid * 16), 16, 0, 0); \
        _Pragma("unroll") for (int i_ = 0; i_ < 4; ++i_) __builtin_amdgcn_global_load_lds((const unsigned*)(Vg + (size_t)(32 * i_) * TA + (kt)), (LAS unsigned*)(smem + (buf) * ATT_BUF + 8192 + i_ * 4096 + tid * 16), 16, 0, 0); } while (0)
    ATT_STAGE(0, 0);
    bf16x8 qf[4];
#pragma unroll
    for (int ks = 0; ks < 4; ++ks) qf[ks] = *(const bf16x8*)(Qb + ks * 16 + hi * 8);
#pragma unroll
    for (int d0 = 0; d0 < 4; ++d0)
#pragma unroll
        for (int r = 0; r < 16; ++r) O[d0][r] = 0.f;
    float m_run = -1.0e30f, l_run = 0.f;
    const int sw = (r32 >> 1) & 7;
    const int nt = nkv >> 6;
    for (int t = 0; t < nt; ++t) {
        asm volatile("s_waitcnt vmcnt(0)" ::: "memory");
        __syncthreads();
        if (t + 1 < nt) ATT_STAGE((t + 1) & 1, (t + 1) * 64);
        const unsigned char* Kt = smem + (t & 1) * ATT_BUF; const unsigned char* Vtl = Kt + 8192;
        bf16x8 kf0[4], kf1[4];
#pragma unroll
        for (int ks = 0; ks < 4; ++ks) {
            const unsigned co = (unsigned)(((ks * 2 + hi) ^ sw) << 4);
            kf0[ks] = *(const bf16x8*)(Kt + r32 * 128 + co);
            kf1[ks] = *(const bf16x8*)(Kt + (32 + r32) * 128 + co);
        }
        const unsigned char* vr = Vtl + r32 * 128;
#define ATT_VLOAD(dst, st_) do { const unsigned o1_ = (unsigned)((((st_) * 2 + hi) ^ sw) << 4); \
        _Pragma("unroll") for (int d0_ = 0; d0_ < 4; ++d0_) dst[d0_] = *(const bf16x8*)(vr + d0_ * 4096 + o1_); } while (0)
        bf16x8 va[4], vb[4];
        ATT_VLOAD(va, 0);
        f32x16 s0, s1;
#pragma unroll
        for (int r = 0; r < 16; ++r) { s0[r] = 0.f; s1[r] = 0.f; }
#pragma unroll
        for (int ks = 0; ks < 4; ++ks) {
            s0 = __builtin_amdgcn_mfma_f32_32x32x16_bf16(kf0[ks], qf[ks], s0, 0, 0, 0);
            s1 = __builtin_amdgcn_mfma_f32_32x32x16_bf16(kf1[ks], qf[ks], s1, 0, 0, 0);
        }
        float mxa[8];
#pragma unroll
        for (int i_ = 0; i_ < 8; ++i_) mxa[i_] = fmaxf(fmaxf(s0[2 * i_], s0[2 * i_ + 1]), fmaxf(s1[2 * i_], s1[2 * i_ + 1]));
        float mx = fmaxf(fmaxf(fmaxf(mxa[0], mxa[1]), fmaxf(mxa[2], mxa[3])), fmaxf(fmaxf(mxa[4], mxa[5]), fmaxf(mxa[6], mxa[7])));
        { const auto rr = __builtin_amdgcn_permlane32_swap(__float_as_uint(mx), __float_as_uint(mx), false, false); mx = fmaxf(__uint_as_float(rr[0]), __uint_as_float(rr[1])); }
        if (__any(mx > m_run + 8.0f)) {
            const float m_new = fmaxf(m_run, mx);
            const float alpha = __builtin_amdgcn_exp2f((m_run - m_new) * L2E);
            l_run *= alpha; m_run = m_new;
            if (hi == 0) wsf[r32] = alpha;
            asm volatile("s_waitcnt lgkmcnt(0)" ::: "memory");
            float ar[16];
#pragma unroll
            for (int r = 0; r < 16; ++r) ar[r] = wsf[crow(r, hi)];
#pragma unroll
            for (int d0 = 0; d0 < 4; ++d0)
#pragma unroll
                for (int r = 0; r < 16; ++r) O[d0][r] *= ar[r];
            asm volatile("s_waitcnt lgkmcnt(0)" ::: "memory");
        }
        const float mb = m_run * L2E;
        float ps = 0.f;
#pragma unroll
        for (int r = 0; r < 16; ++r) { s0[r] = __builtin_amdgcn_exp2f(s0[r] * L2E - mb); s1[r] = __builtin_amdgcn_exp2f(s1[r] * L2E - mb); ps += s0[r] + s1[r]; }
        l_run += ps;
        u32x4 pw[4];
#pragma unroll
        for (int s = 0; s < 2; ++s) {
            pw[s].x = pk2(s0[8 * s + 0], s0[8 * s + 1]); pw[s].y = pk2(s0[8 * s + 2], s0[8 * s + 3]); pw[s].z = pk2(s0[8 * s + 4], s0[8 * s + 5]); pw[s].w = pk2(s0[8 * s + 6], s0[8 * s + 7]);
            pw[2 + s].x = pk2(s1[8 * s + 0], s1[8 * s + 1]); pw[2 + s].y = pk2(s1[8 * s + 2], s1[8 * s + 3]); pw[2 + s].z = pk2(s1[8 * s + 4], s1[8 * s + 5]); pw[2 + s].w = pk2(s1[8 * s + 6], s1[8 * s + 7]);
        }
#pragma unroll
        ATT_VLOAD(vb, 1);
#pragma unroll
        for (int d0 = 0; d0 < 4; ++d0) O[d0] = __builtin_amdgcn_mfma_f32_32x32x16_bf16(__builtin_bit_cast(bf16x8, pw[0]), va[d0], O[d0], 0, 0, 0);
        ATT_VLOAD(va, 2);
#pragma unroll
        for (int d0 = 0; d0 < 4; ++d0) O[d0] = __builtin_amdgcn_mfma_f32_32x32x16_bf16(__builtin_bit_cast(bf16x8, pw[1]), vb[d0], O[d0], 0, 0, 0);
        ATT_VLOAD(vb, 3);
#pragma unroll
        for (int d0 = 0; d0 < 4; ++d0) O[d0] = __builtin_amdgcn_mfma_f32_32x32x16_bf16(__builtin_bit_cast(bf16x8, pw[2]), va[d0], O[d0], 0, 0, 0);
#pragma unroll
        for (int d0 = 0; d0 < 4; ++d0) O[d0] = __builtin_amdgcn_mfma_f32_32x32x16_bf16(__builtin_bit_cast(bf16x8, pw[3]), vb[d0], O[d0], 0, 0, 0);
#undef ATT_VLOAD
    }
#undef ATT_STAGE
    l_run += __shfl_xor(l_run, 32);
    asm volatile("s_waitcnt lgkmcnt(0)" ::: "memory");
    if (hi == 0) wsf[r32] = 1.0f / l_run;
    asm volatile("s_waitcnt lgkmcnt(0)" ::: "memory");
    float ar[16];
#pragma unroll
    for (int r = 0; r < 16; ++r) ar[r] = wsf[crow(r, hi)];
    asm volatile("s_waitcnt lgkmcnt(0)" ::: "memory");
#pragma unroll
    for (int d0 = 0; d0 < 4; ++d0)
#pragma unroll
        for (int r = 0; r < 16; ++r) O[d0][r] *= ar[r];
}

DI void phase_att(KP p, int l, unsigned char* smem) {
    constexpr int O_WS = 2 * ATT_BUF;
    const int tid = TIDX(), wid = tid >> 6, lane = tid & 63, r32 = lane & 31, hi = lane >> 5;
    const int li = l >> 1;
    const bf16_t* Qc = (const bf16_t*)(p->ws + WS_QC); const bf16_t* Kc = (const bf16_t*)(p->ws + WS_KC); const bf16_t* Vt = (const bf16_t*)(p->ws + WS_VT);
    bf16_t* Y = (bf16_t*)(p->ws + WS_Y);
    float* stash = (float*)(p->ws + WS_P) + ((size_t)BIDX() * 256 + tid) * 32;
    const float lam_init = 0.8f - 0.6f * expf(-0.3f * (float)l);
    float* wsf = (float*)(smem + O_WS) + wid * 32;
    const int per_x = (l == 3) ? 128 : 144;
    for (int i = 0;; ++i) {
        int b, h, p0, nkv;
        {
            const int G = gridDim.x, bid = BIDX();
            int item;
            if ((G & 7) == 0) { const int x = bid & 7, q = i * (G >> 3) + (bid >> 3); if (q >= per_x) break; item = q < 128 ? x * 128 + q : 1024 + x * 16 + (q - 128); }
            else { item = i * G + bid; if (item >= 8 * per_x) break; }
            if (item < 1024) { b = item >> 7; h = (item >> 4) & 7; p0 = 256 + (item & 15) * 128; nkv = TA; }
            else { const int q = item - 1024; b = q >> 4; h = (q >> 1) & 7; p0 = (q & 1) * 128; nkv = TC; }
        }
        float d1 = 0.f, d2 = 0.f;
        { const float* lq1 = p->in[19] + (li * 8 + h) * 64, *lk1 = p->in[20] + (li * 8 + h) * 64, *lq2 = p->in[21] + (li * 8 + h) * 64, *lk2 = p->in[22] + (li * 8 + h) * 64;
          d1 = wave_sum(lq1[lane] * lk1[lane]); d2 = wave_sum(lq2[lane] * lk2[lane]); }
        const float lamv = expf(d1) - expf(d2) + lam_init;
        f32x16 On[4];
        __syncthreads();
        att_component(Qc, Kc, Vt, smem, wsf, b, h, 0, p0, nkv, On);
#pragma unroll
        for (int d0 = 0; d0 < 4; ++d0)
#pragma unroll
            for (int r = 0; r < 16; r += 8) {
                u32x4 w; w.x = pk2(On[d0][r], On[d0][r + 1]); w.y = pk2(On[d0][r + 2], On[d0][r + 3]); w.z = pk2(On[d0][r + 4], On[d0][r + 5]); w.w = pk2(On[d0][r + 6], On[d0][r + 7]);
                *(u32x4*)(stash + (d0 * 16 + r) / 2) = w;
            }
        __syncthreads();
        att_component(Qc, Kc, Vt, smem, wsf, b, h, 1, p0, nkv, On);
#pragma unroll
        for (int d0 = 0; d0 < 4; ++d0)
#pragma unroll
            for (int r = 0; r < 16; r += 8) {
                const u32x4 w = *(const u32x4*)(stash + (d0 * 16 + r) / 2);
                On[d0][r] = bflo(w.x) - lamv * On[d0][r]; On[d0][r + 1] = bfhi(w.x) - lamv * On[d0][r + 1]; On[d0][r + 2] = bflo(w.y) - lamv * On[d0][r + 2]; On[d0][r + 3] = bfhi(w.y) - lamv * On[d0][r + 3];
                On[d0][r + 4] = bflo(w.z) - lamv * On[d0][r + 4]; On[d0][r + 5] = bfhi(w.z) - lamv * On[d0][r + 5]; On[d0][r + 6] = bflo(w.w) - lamv * On[d0][r + 6]; On[d0][r + 7] = bfhi(w.w) - lamv * On[d0][r + 7];
            }
        float ms[16];
#pragma unroll
        for (int r = 0; r < 16; ++r) {
            float s = (On[0][r] * On[0][r] + On[1][r] * On[1][r]) + (On[2][r] * On[2][r] + On[3][r] * On[3][r]);
            s += __shfl_xor(s, 1); s += __shfl_xor(s, 2); s += __shfl_xor(s, 4); s += __shfl_xor(s, 8); s += __shfl_xor(s, 16);
            ms[r] = __builtin_amdgcn_rsqf(s * (1.0f / 128.0f) + LN_EPS);
        }
        const float* sg = p->in[23] + li * 1024 + h * 128;
        const float post = 1.0f - lam_init;
        float gsc[4];
#pragma unroll
        for (int d0 = 0; d0 < 4; ++d0) gsc[d0] = sg[d0 * 32 + r32] * post;
        __syncthreads();
        unsigned char* stg = smem + wid * 8192;
#pragma unroll
        for (int r = 0; r < 16; ++r) {
            unsigned char* sp = stg + crow(r, hi) * 256 + r32 * 2;
#pragma unroll
            for (int d0 = 0; d0 < 4; ++d0) *(unsigned short*)(sp + d0 * 64) = (unsigned short)f2bf(On[d0][r] * ms[r] * gsc[d0]);
        }
        asm volatile("s_waitcnt lgkmcnt(0)" ::: "memory");
#pragma unroll
        for (int i2 = 0; i2 < 8; ++i2) {
            const int id = lane + 64 * i2, qr = id >> 4, ch = id & 15;
            const int pq = p0 + wid * 32 + qr;
            const int row = pq < 256 ? ML + b * 256 + pq : b * 2048 + (pq - 256);
            *(u32x4*)(Y + (size_t)row * 1024 + h * 128 + ch * 8) = *(const u32x4*)(stg + qr * 256 + ch * 16);
        }
        asm volatile("s_waitcnt lgkmcnt(0)" ::: "memory");
    }
}

#define XB_TMO      128
#define XB_XCNT(j)  (256  + 64 * (j))
#define XB_XSUB(j)  (1280 + 64 * (j))
#define XB_XGEN(j)  (2304 + 64 * (j))
#define XB_TOP      3328
#define XB_TOPGEN   3392
#define XCD_BAR_WORDS 3456
#define XB_SPIN_CAP (1u << 22)
DI unsigned xb_ld(unsigned* p)              { return __hip_atomic_load(p, __ATOMIC_RELAXED, __HIP_MEMORY_SCOPE_AGENT); }
DI unsigned xb_add(unsigned* p, unsigned v) { return __hip_atomic_fetch_add(p, v, __ATOMIC_RELAXED, __HIP_MEMORY_SCOPE_AGENT); }
DI unsigned xb_xcc_id() { return (unsigned)__builtin_amdgcn_s_getreg((3 << 11) | 20) & 0xFu; }
#define XB_SPIN(cond, bar) do { unsigned _sp = 0; while (cond) { __builtin_amdgcn_s_sleep(1); \
    if ((++_sp & 255u) == 0u) { if (xb_ld(&(bar)[XB_TMO])) break; if (_sp > XB_SPIN_CAP) { atomicAdd(&(bar)[XB_TMO], 1u); break; } } } } while (0)
struct XcdBarrier { unsigned* bar; unsigned x; volatile LAS unsigned* st; };
DI XcdBarrier xcd_barrier_post(unsigned* bar, volatile LAS unsigned* st) {
    XcdBarrier b; b.bar = bar; b.x = xb_xcc_id(); b.st = st;
    if (threadIdx.x == 0) (void)xb_add(&bar[XB_XCNT(b.x)], 1u);
    return b;
}
DI void xcd_barrier_complete(unsigned* bar, unsigned x, unsigned& nloc, unsigned& nx) {
    const unsigned G = gridDim.x * gridDim.y * gridDim.z;
    unsigned sum, cnt, mine, sp = 0u;
    for (;;) {
        sum = 0u; cnt = 0u; mine = 0u;
#pragma unroll
        for (unsigned j = 0; j < 16; ++j) { const unsigned c = xb_ld(&bar[XB_XCNT(j)]); sum += c; cnt += (c > 0u) ? 1u : 0u; mine = (j == x) ? c : mine; }
        if (sum == G) break;
        __builtin_amdgcn_s_sleep(1);
        if ((++sp & 255u) == 0u) { if (xb_ld(&bar[XB_TMO])) break; if (sp > XB_SPIN_CAP) { atomicAdd(&bar[XB_TMO], 1u); break; } }
    }
    nloc = mine > 0u ? mine : 1u; nx = cnt > 0u ? cnt : 1u;
}
DI void xcd_barrier(const XcdBarrier& b) {
    asm volatile("s_waitcnt vmcnt(0)" ::: "memory");
    __syncthreads();
    if (threadIdx.x == 0) {
        unsigned* bar = b.bar;
        __builtin_amdgcn_s_waitcnt(0);
        unsigned nloc = b.st[0], nx = b.st[1];
        if (nloc == 0u) { xcd_barrier_complete(bar, b.x, nloc, nx); b.st[0] = nloc; b.st[1] = nx; }
        const unsigned old = xb_add(&bar[XB_XSUB(b.x)], 1u);
        const unsigned gen = old / nloc;
        if (old + 1u == (gen + 1u) * nloc) {
            __builtin_amdgcn_fence(__ATOMIC_RELEASE, "agent");
            asm volatile("s_waitcnt vmcnt(0)" ::: "memory");
            const unsigned og = xb_add(&bar[XB_TOP], 1u);
            const unsigned tg = og / nx;
            if (og + 1u == (tg + 1u) * nx) xb_add(&bar[XB_TOPGEN], 1u);
            else XB_SPIN(xb_ld(&bar[XB_TOPGEN]) == tg, bar);
            __builtin_amdgcn_fence(__ATOMIC_ACQUIRE, "agent");
            xb_add(&bar[XB_XGEN(b.x)], 1u);
            asm volatile("s_waitcnt vmcnt(0)" ::: "memory");
        } else {
            XB_SPIN(xb_ld(&bar[XB_XGEN(b.x)]) == gen, bar);
            __builtin_amdgcn_fence(__ATOMIC_ACQUIRE, "agent");
            asm volatile("s_waitcnt vmcnt(0)" ::: "memory");
        }
    }
    __syncthreads();
}

#ifdef DOUBLE_MASK
#define DRYCOND (rep_ == 0 && nrep_ == 2)
#else
#define DRYCOND false
#endif
constexpr int NPHASE = 34;
constexpr int LDS_BYTES = 65536 + 1024;
__global__ void __launch_bounds__(256, 2) mega(Params pv) {
    extern __shared__ __attribute__((aligned(16))) unsigned char smem[];
    const int ph_lo = pv.ph_lo, ph_hi = pv.ph_hi;
    volatile LAS unsigned* bar_st = (volatile LAS unsigned*)(LAS unsigned char*)(smem + 65536);
    if (threadIdx.x == 0) { bar_st[0] = 0u; bar_st[1] = 0u; }
    __syncthreads();
    XcdBarrier xbar = xcd_barrier_post((unsigned*)(pv.ws + WS_CTL) + 4096, bar_st);
    for (int ph = ph_lo; ph < ph_hi; ++ph) {
        KP p = (KP)__builtin_amdgcn_kernarg_segment_ptr();
        asm volatile("" : "+s"(p) :: "memory");
#ifdef DOUBLE_MASK
        int kind_;
        if (ph == 0) kind_ = 0; else if (ph == 1) kind_ = 1;
        else { const int rem_ = (ph - 2) % 16; kind_ = rem_ == 0 ? 2 : (rem_ == 1 ? 12 : (rem_ < 9 ? rem_ + 1 : (rem_ == 9 ? 10 : (rem_ == 10 ? 11 : (rem_ - 11 + 5))))); }
        const int nrep_ = ((DOUBLE_MASK >> kind_) & 1) ? 2 : 1;
        for (int rep_ = 0; rep_ < nrep_; ++rep_) {
        if (rep_) xcd_barrier(xbar);
#endif
        if (ph == 0) phase_pre0(p, smem);
        else if (ph == 1) phase_pre1(p);
        else {
            const int q = ph - 2, lp = q / 16, rem = q % 16;
            if (rem < 9) {
                const int l = 2 * lp;
                switch (rem) {
                    case 0: phase_g1e(p, l, smem); break;
                    case 1: phase_decay(p, l, smem); break;
                    case 2: phase_scan(p, l, smem); break;
                    case 3: phase_merge(p, l); break;
                    case 4: phase_g2(p, l, smem); break;
                    case 5: if (DRYCOND) phase_ln1r<true>(p, l, smem); else phase_ln1r<false>(p, l, smem); break;
                    case 6: phase_mg1(p, l, smem); break;
                    case 7: phase_mg2(p, l, smem); break;
                    default: if (DRYCOND) phase_ln2<true>(p, l); else phase_ln2<false>(p, l); break;
                }
            } else {
                const int l = 2 * lp + 1;
                switch (rem - 9) {
                    case 0: phase_g1o(p, l, smem); break;
                    case 1: phase_att(p, l, smem); break;
                    case 2: phase_g2(p, l, smem); break;
                    case 3: if (DRYCOND) phase_ln1r<true>(p, l, smem); else phase_ln1r<false>(p, l, smem); break;
                    case 4: phase_mg1(p, l, smem); break;
                    case 5: phase_mg2(p, l, smem); break;
                    default: if (DRYCOND) phase_ln2<true>(p, l); else phase_ln2<false>(p, l); break;
                }
            }
        }
#ifdef DOUBLE_MASK
        }
#endif
        if (ph + 1 < ph_hi) xcd_barrier(xbar);
    }
}

extern "C" void kernel_launch(void* const* d_in, const int* in_sizes, int n_in, void* d_out, int out_size, void* d_ws, size_t ws_size, hipStream_t stream) {
    static int grid_blocks = 0;
    if (grid_blocks == 0) {
        if (n_in != 32 || ws_size < WS_END) { fprintf(stderr, "kernel_launch: unexpected n_in %d or ws_size %zu\n", n_in, ws_size); grid_blocks = -1; return; }
        int dev = 0, cus = 0, per_cu = 0;
        hipGetDevice(&dev);
        hipDeviceGetAttribute(&cus, hipDeviceAttributeMultiprocessorCount, dev);
        hipFuncSetAttribute((const void*)mega, hipFuncAttributeMaxDynamicSharedMemorySize, LDS_BYTES);
        hipOccupancyMaxActiveBlocksPerMultiprocessor(&per_cu, mega, 256, LDS_BYTES);
        if (per_cu > 2) per_cu = 2;
        if (per_cu < 1) per_cu = 1;
        grid_blocks = cus * per_cu;
    }
    if (grid_blocks < 0) return;
    hipMemsetAsync((char*)d_ws + WS_CTL, 0, 32768, stream);
    Params p{};
    for (int i = 0; i < 32; ++i) p.in[i] = (const float*)d_in[i];
    p.out = (float*)d_out; p.ws = (unsigned char*)d_ws;
#if N_LAUNCH_MODE == 1
    p.ph_lo = 0; p.ph_hi = NPHASE;
    void* args[] = {&p};
    hipError_t e = hipLaunchCooperativeKernel((void*)mega, dim3(grid_blocks), dim3(256), args, LDS_BYTES, stream);
    if (e != hipSuccess) fprintf(stderr, "cooperative launch failed: %s (grid %d)\n", hipGetErrorString(e), grid_blocks);
#else
    for (int ph = 0; ph < NPHASE; ++ph) {
        p.ph_lo = ph; p.ph_hi = ph + 1;
        hipLaunchKernelGGL(mega, dim3(grid_blocks), dim3(256), LDS_BYTES, stream, p);
    }
#endif
}
```

```cpp
#include <hip/hip_runtime.h>
#include <hip/hip_cooperative_groups.h>
#include <cstdio>
#include <cstdint>
namespace cg = cooperative_groups;

#ifndef N_LAUNCH_MODE
#define N_LAUNCH_MODE 1
#endif

#define DI __device__ __forceinline__
#define LAS __attribute__((address_space(3)))
typedef unsigned short bf16_t;
typedef short bf16x8 __attribute__((ext_vector_type(8)));
typedef short s16x4 __attribute__((ext_vector_type(4)));
typedef float f32x4 __attribute__((ext_vector_type(4)));
typedef float f32x16 __attribute__((ext_vector_type(16)));
typedef unsigned u32x4 __attribute__((ext_vector_type(4)));
typedef unsigned u32x2 __attribute__((ext_vector_type(2)));

constexpr int D = 1024, NB = 8, T = 2048, TC = 256, TA = T + TC;
constexpr int ML = NB * T, MC = NB * TC, MT = ML + MC;
constexpr int NIN = 3616, NINP = 3712, ZS = 3712;
constexpr int NSLOT = 2 * MT;
constexpr float LN_EPS = 1e-5f;
constexpr float ALPHA = 1.6817928305074290f;
constexpr float L2E = 1.4426950408889634f;

constexpr size_t MiB = 1ull << 20;
constexpr size_t WS_CTL = 0;
constexpr size_t WS_MOD = 1 * MiB;
constexpr size_t WS_ROPEA = 2 * MiB;
constexpr size_t WS_ROPEC = 3 * MiB;
constexpr size_t WS_LR = 4 * MiB;
constexpr size_t WS_SLOTW = 7 * MiB;
constexpr size_t WS_LIST = 8 * MiB;
constexpr size_t WS_WRT = 13 * MiB;
constexpr size_t WS_WIN = 16 * MiB;
constexpr size_t WS_WABO = 32 * MiB;
constexpr size_t WS_WQKV = 36 * MiB;
constexpr size_t WS_WCO = 48 * MiB;
constexpr size_t WS_WGU = 64 * MiB;
constexpr size_t WS_WD = 320 * MiB;
constexpr size_t WS_X = 448 * MiB;
constexpr size_t WS_U = 520 * MiB;
constexpr size_t WS_Y = 556 * MiB;
constexpr size_t WS_Z = 592 * MiB;
constexpr size_t WS_O = 724 * MiB;
constexpr size_t WS_PF = 868 * MiB, WS_SQ = 886 * MiB, WS_SK = 904 * MiB, WS_TOT = 922 * MiB;
constexpr size_t WS_END = 923 * MiB;
constexpr size_t WS_QC = WS_Z, WS_KC = WS_Z + 36 * MiB, WS_VT = WS_Z + 72 * MiB;
constexpr size_t WS_YS = WS_Z;
constexpr size_t WS_OF = WS_O, WS_OB = WS_O + 72 * MiB, WS_P = WS_O, WS_H = WS_O + 72 * MiB;

#ifndef XBF16
#define XBF16 0
#endif
#if XBF16
typedef bf16_t xres_t;
#else
typedef float xres_t;
#endif
struct Params { const float* in[32]; float* out; unsigned char* ws; int ph_lo, ph_hi; };
typedef const __attribute__((address_space(4))) Params* KP;

DI int TIDX() { int t = threadIdx.x; asm volatile("" : "+v"(t)); return t; }
DI int BIDX() { int b = blockIdx.x; asm volatile("" : "+s"(b)); return b; }
DI unsigned pk2(float lo, float hi);
DI unsigned f2bf(float f) { return pk2(f, 0.f) & 0xffffu; }
typedef float f32x2_t __attribute__((ext_vector_type(2))); typedef __bf16 bf16x2_t __attribute__((ext_vector_type(2)));
DI unsigned pk2(float lo, float hi) { f32x2_t v = {lo, hi}; bf16x2_t b = __builtin_convertvector(v, bf16x2_t); return __builtin_bit_cast(unsigned, b); }
DI float bflo(unsigned w) { return __uint_as_float(w << 16); }
DI float bfhi(unsigned w) { return __uint_as_float(w & 0xffff0000u); }
DI f32x4 xload(const xres_t* p) {
#if XBF16
    const u32x2 w = *(const u32x2*)p; return (f32x4){bflo(w.x), bfhi(w.x), bflo(w.y), bfhi(w.y)};
#else
    return *(const f32x4*)p;
#endif
}
DI void xstore(xres_t* p, f32x4 v) {
#if XBF16
    u32x2 w; w.x = pk2(v[0], v[1]); w.y = pk2(v[2], v[3]); *(u32x2*)p = w;
#else
    *(f32x4*)p = v;
#endif
}
DI float wave_sum(float v) {
#pragma unroll
    for (int o = 1; o < 64; o <<= 1) v += __shfl_xor(v, o);
    return v;
}
DI float siluf(float v) { return v * __builtin_amdgcn_rcpf(1.0f + __expf(-v)); }

DI int gemm_chunk(int tid) { return (tid & 7) ^ ((tid >> 4) & 7); }
template <bool TRN>
DI void gemm_tile(unsigned char* shm, const bf16_t* const (&ap)[4], const bf16_t* const (&bp)[4], int K, f32x4 (&acc)[4][4],
                  bool first, bool has_next, const bf16_t* const (&apn)[4], const bf16_t* const (&bpn)[4]) {
    const int tid = TIDX(), wid = tid >> 6, lane = tid & 63, wr = wid >> 1, wc = wid & 1, fr = lane & 15, fq = lane >> 4;
#pragma unroll
    for (int m = 0; m < 4; ++m)
#pragma unroll
        for (int n = 0; n < 4; ++n) acc[m][n] = (f32x4){0.f, 0.f, 0.f, 0.f};
    const int nt = K >> 6;
    const int sw = fr >> 1;
    const unsigned aoff = (unsigned)((wr * 64 + fr) * 128), boff = (unsigned)(16384 + (wc * 64 + fr) * 128);
#define GEMM_STAGE(buf, A_, B_, t) do { _Pragma("unroll") for (int i_ = 0; i_ < 4; ++i_) { \
        __builtin_amdgcn_global_load_lds((const unsigned*)(A_[i_] + (t) * 64), (LAS unsigned*)(shm + (buf) * 32768 + i_ * 4096 + tid * 16), 16, 0, 0); \
        __builtin_amdgcn_global_load_lds((const unsigned*)(B_[i_] + (t) * 64), (LAS unsigned*)(shm + (buf) * 32768 + 16384 + i_ * 4096 + tid * 16), 16, 0, 0); } } while (0)
    if (first) {
        GEMM_STAGE(0, ap, bp, 0);
        asm volatile("s_waitcnt vmcnt(0)" ::: "memory");
        __syncthreads();
    }
    for (int t = 0; t < nt; ++t) {
        const int cur = t & 1;
        if (t + 1 < nt) GEMM_STAGE(cur ^ 1, ap, bp, t + 1);
        else if (has_next) GEMM_STAGE(cur ^ 1, apn, bpn, 0);
        const unsigned char* base = shm + cur * 32768;
        bf16x8 At[2][4], Bt[2][4];
#pragma unroll
        for (int ks = 0; ks < 2; ++ks) {
            const unsigned co = (unsigned)(((ks * 4 + fq) ^ sw) << 4);
#pragma unroll
            for (int m = 0; m < 4; ++m) At[ks][m] = *(const bf16x8*)(base + aoff + m * 2048 + co);
#pragma unroll
            for (int n = 0; n < 4; ++n) Bt[ks][n] = *(const bf16x8*)(base + boff + n * 2048 + co);
        }
        __builtin_amdgcn_s_setprio(1);
#pragma unroll
        for (int ks = 0; ks < 2; ++ks)
#pragma unroll
            for (int m = 0; m < 4; ++m)
#pragma unroll
                for (int n = 0; n < 4; ++n)
                    acc[m][n] = TRN ? __builtin_amdgcn_mfma_f32_16x16x32_bf16(Bt[ks][n], At[ks][m], acc[m][n], 0, 0, 0)
                                    : __builtin_amdgcn_mfma_f32_16x16x32_bf16(At[ks][m], Bt[ks][n], acc[m][n], 0, 0, 0);
        __builtin_amdgcn_s_setprio(0);
        asm volatile("s_waitcnt vmcnt(0)" ::: "memory");
        __syncthreads();
    }
#undef GEMM_STAGE
}
#define GEMM_ADVANCE() do { _Pragma("unroll") for (int k_ = 0; k_ < 4; ++k_) { ap[k_] = apn[k_]; bp[k_] = bpn[k_]; } } while (0)
DI void gemm_rows(const bf16_t* base, int r0, int ld, int tid, const bf16_t* (&pp)[4]) {
    const bf16_t* q = base + (size_t)(r0 + (tid >> 3)) * ld + gemm_chunk(tid) * 8;
#pragma unroll
    for (int i = 0; i < 4; ++i) pp[i] = q + (size_t)(32 * i) * ld;
}
DI bool tile_seq(int q, int nrt, int nct, int& rt, int& ct) {
    if (q >= nrt * nct) return false;
    const int band = q / (8 * nct), rem = q - band * 8 * nct;
    const int rows = (nrt - band * 8) < 8 ? (nrt - band * 8) : 8;
    ct = rem / rows; rt = band * 8 + rem % rows;
    return true;
}
DI int xcd_seq(int i, int total) {
    const int G = gridDim.x, bid = BIDX();
    if ((G & 7) != 0) { const int q = i * G + bid; return q < total ? q : -1; }
    const int x = bid & 7, j = bid >> 3, per = (total + 7) >> 3, gx = G >> 3;
    const int q = i * gx + j;
    if (q >= per) return -1;
    const int g = x * per + q;
    return g < total ? g : -1;
}

template <int MODE>
DI void tr_item(const float* W, int K, int N, bf16_t* WT, float* scr, int item, int lane) {
    const int nblk = N / 32, kb = item / nblk, nb = item % nblk, k0 = 64 * kb, n0 = 32 * nb;
    float wv[32];
#pragma unroll
    for (int i = 0; i < 32; ++i) wv[i] = W[(size_t)(k0 + 2 * i + (lane >> 5)) * N + n0 + (lane & 31)];
#pragma unroll
    for (int i = 0; i < 32; ++i) scr[(2 * i + (lane >> 5)) * 33 + (lane & 31)] = wv[i];
    asm volatile("s_waitcnt lgkmcnt(0)" ::: "memory");
    const int c = lane & 7;
#pragma unroll
    for (int j = 0; j < 4; ++j) {
        const int n = (lane >> 3) + 8 * j; const float* s = scr + (8 * c) * 33 + n;
        u32x4 o; o.x = pk2(s[0 * 33], s[1 * 33]); o.y = pk2(s[2 * 33], s[3 * 33]); o.z = pk2(s[4 * 33], s[5 * 33]); o.w = pk2(s[6 * 33], s[7 * 33]);
        const int nn = n0 + n;
        const int drow = (MODE == 0) ? nn : ((nn >> 4) * 32 + (nn & 15) + (MODE == 2 ? 16 : 0));
        *(u32x4*)(WT + (size_t)drow * K + k0 + 8 * c) = o;
    }
    asm volatile("s_waitcnt lgkmcnt(0)" ::: "memory");
}

DI void phase_pre0(KP p, unsigned char* smem) {
    const int tid = TIDX(), wave = tid >> 6, lane = tid & 63;
    unsigned char* ws = p->ws;
    {
        float* s_sc = (float*)smem;
        float* s_red = s_sc + 9 * 1024;
        const float* c = p->in[1]; const float* cc = p->in[3];
        for (int i = tid; i < 9 * 1024; i += 256) { const int r = i >> 10, k = i & 1023; const float v = r < 8 ? c[r * 1024 + k] : cc[k]; s_sc[i] = v / (1.0f + expf(-v)); }
        __syncthreads();
        float* MOD = (float*)(ws + WS_MOD);
        for (int item = BIDX(); item < 384; item += gridDim.x) {
            const int l = item / 96, n0 = (item % 96) * 64;
            const float* W = p->in[4] + (size_t)l * 1024 * 6144 + n0 + lane;
            float acc[9];
#pragma unroll
            for (int r = 0; r < 9; ++r) acc[r] = 0.f;
#pragma unroll 16
            for (int k = wave * 256; k < wave * 256 + 256; ++k) {
                const float w = W[(size_t)k * 6144];
#pragma unroll
                for (int r = 0; r < 9; ++r) acc[r] += s_sc[r * 1024 + k] * w;
            }
#pragma unroll
            for (int r = 0; r < 9; ++r) s_red[(wave * 9 + r) * 64 + lane] = acc[r];
            __syncthreads();
            for (int i = tid; i < 9 * 64; i += 256) {
                const int r = i >> 6, ln = i & 63;
                const float v = s_red[(0 * 9 + r) * 64 + ln] + s_red[(1 * 9 + r) * 64 + ln] + s_red[(2 * 9 + r) * 64 + ln] + s_red[(3 * 9 + r) * 64 + ln];
                MOD[(size_t)(l * 9 + r) * 6144 + n0 + ln] = v + p->in[5][l * 6144 + n0 + ln];
            }
            __syncthreads();
        }
    }
    {
        const int gt = BIDX() * 256 + tid, NT = gridDim.x * 256;
        float* ca = (float*)(ws + WS_ROPEA); float* sa = ca + 2048 * 64;
        for (int i = gt; i < 2048 * 64; i += NT) {
            const int t = i >> 6, f = i & 63; const int pos = f < 32 ? (t >> 6) : (t & 63); const int ff = f & 31;
            const float inv = powf(10000.0f, -(float)ff / 32.0f); const float a = (float)pos * inv;
            ca[i] = cosf(a); sa[i] = sinf(a);
        }
        float* cc_ = (float*)(ws + WS_ROPEC); float* sc_ = cc_ + 2048 * 32;
        for (int i = gt; i < 2048 * 32; i += NT) {
            const int t = i >> 5, f = i & 31; const int pos = f < 16 ? (t >> 6) : (t & 63); const int ff = f & 15;
            const float inv = powf(10000.0f, -(float)ff / 16.0f); const float a = (float)pos * inv;
            cc_[i] = cosf(a); sc_[i] = sinf(a);
        }
        float* wrt = (float*)(ws + WS_WRT);
        for (int i = gt; i < 4 * 36 * 1024; i += NT) {
            const int l = i / (36 * 1024), o = (i / 1024) % 36, k = i & 1023;
            wrt[i] = o < 4 ? p->in[25][((size_t)l * 1024 + k) * 4 + o] : p->in[27][((size_t)l * 1024 + k) * 32 + (o - 4)];
        }
        unsigned* wpad = (unsigned*)(ws + WS_WIN);
        for (int i = gt; i < 2 * 96 * 512; i += NT) { const int li = i / (96 * 512), r = i % (96 * 512); wpad[((size_t)li * NINP + NIN) * 512 + r] = 0u; }
    }
    __syncthreads();
    {
        float* scr = (float*)smem + wave * (64 * 33);
        constexpr int I_IN = 16 * 113, I_SQ = 16 * 32, I_QKV = 16 * 96, I_E = 256;
        constexpr int R0 = 2 * I_IN, R1 = R0 + 2 * I_SQ, R2 = R1 + 2 * I_QKV, R3 = R2 + 2 * I_SQ, R4 = R3 + 128 * I_E, R5 = R4 + 128 * I_E, R6 = R5 + 128 * I_E;
        for (int it = BIDX() * 4 + wave; it < R6; it += gridDim.x * 4) {
            if (it < R0) { const int i = it / I_IN, r = it % I_IN; tr_item<0>(p->in[10] + (size_t)i * 1024 * NIN, 1024, NIN, (bf16_t*)(ws + WS_WIN) + (size_t)i * NINP * 1024, scr, r, lane); }
            else if (it < R1) { const int q = it - R0, i = q / I_SQ, r = q % I_SQ; tr_item<0>(p->in[17] + (size_t)i * 1024 * 1024, 1024, 1024, (bf16_t*)(ws + WS_WABO) + (size_t)i * 1024 * 1024, scr, r, lane); }
            else if (it < R2) { const int q = it - R1, i = q / I_QKV, r = q % I_QKV; tr_item<0>(p->in[18] + (size_t)i * 1024 * 3072, 1024, 3072, (bf16_t*)(ws + WS_WQKV) + (size_t)i * 3072 * 1024, scr, r, lane); }
            else if (it < R3) { const int q = it - R2, i = q / I_SQ, r = q % I_SQ; tr_item<0>(p->in[24] + (size_t)i * 1024 * 1024, 1024, 1024, (bf16_t*)(ws + WS_WCO) + (size_t)i * 1024 * 1024, scr, r, lane); }
            else if (it < R4) { const int q = it - R3, le = q / I_E, r = q % I_E; tr_item<1>(p->in[29] + (size_t)le * 1024 * 512, 1024, 512, (bf16_t*)(ws + WS_WGU) + (size_t)le * 1024 * 1024, scr, r, lane); }
            else if (it < R5) { const int q = it - R4, le = q / I_E, r = q % I_E; tr_item<2>(p->in[30] + (size_t)le * 1024 * 512, 1024, 512, (bf16_t*)(ws + WS_WGU) + (size_t)le * 1024 * 1024, scr, r, lane); }
            else { const int q = it - R5, le = q / I_E, r = q % I_E; tr_item<0>(p->in[31] + (size_t)le * 512 * 1024, 512, 1024, (bf16_t*)(ws + WS_WD) + (size_t)le * 1024 * 512, scr, r, lane); }
        }
    }
}

DI void phase_pre1(KP p) {
    const int tid = TIDX(), wave = tid >> 6, lane = tid & 63;
    xres_t* X = (xres_t*)(p->ws + WS_X); bf16_t* U = (bf16_t*)(p->ws + WS_U); const float* MOD = (const float*)(p->ws + WS_MOD);
    for (int row = BIDX() * 4 + wave; row < MT; row += gridDim.x * 4) {
        const float* src = row < ML ? p->in[0] + (size_t)row * 1024 : p->in[2] + (size_t)(row - ML) * 1024;
        const int r = row < ML ? (row >> 11) : 8;
        const float* mod = MOD + (size_t)r * 6144;
#pragma unroll
        for (int j = 0; j < 4; ++j) {
            const int k = 256 * j + 4 * lane;
            const f32x4 v = *(const f32x4*)(src + k), sh = *(const f32x4*)(mod + k), sc = *(const f32x4*)(mod + 1024 + k);
            const f32x4 u = v * (1.0f + sc) + sh;
            u32x2 w; w.x = pk2(u[0], u[1]); w.y = pk2(u[2], u[3]);
            *(u32x2*)(U + (size_t)row * 1024 + k) = w;
        }
    }
}

DI void phase_g1e(KP p, int l, unsigned char* smem) {
    const int tid = TIDX(), wid = tid >> 6, lane = tid & 63, wr = wid >> 1, wc = wid & 1, fr = lane & 15, fq = lane >> 4;
    const int li = l >> 1;
    const bf16_t* U = (const bf16_t*)(p->ws + WS_U); const bf16_t* W = (const bf16_t*)(p->ws + WS_WIN) + (size_t)li * NINP * 1024;
    bf16_t* Z = (bf16_t*)(p->ws + WS_Z); float* LR = (float*)(p->ws + WS_LR);
    const float* ca = (const float*)(p->ws + WS_ROPEA); const float* sa = ca + 2048 * 64;
    constexpr int NTN = NINP / 128;
    auto decode = [&](int i, int& brow, int& bcol) -> bool {
        const int q = xcd_seq(i, (MT / 128) * NTN); if (q < 0) return false;
        int rt, nt; tile_seq(q, MT / 128, NTN, rt, nt); brow = rt * 128; bcol = nt * 128; return true; };
    auto epi = [&](int brow, int bcol, f32x4 (&acc)[4][4]) {
        const int colw = bcol + wc * 64;
        if (colw >= NIN) return;
        if (colw >= 3584) {
#pragma unroll
            for (int m = 0; m < 4; ++m) { const int row = brow + wr * 64 + m * 16 + fr;
#pragma unroll
                for (int n = 0; n < 2; ++n) *(f32x4*)(LR + (size_t)row * 32 + n * 16 + fq * 4) = acc[m][n]; }
            return;
        }
        const bool ropeR = colw < 1024; const int half = (colw >> 6) & 1;
        const float scale = colw < 512 ? 0.08838834764831845f : ((colw >= 2048 && colw < 2304) ? 0.125f : 1.0f);
#pragma unroll
        for (int m = 0; m < 4; ++m) {
            const int row = brow + wr * 64 + m * 16 + fr;
            if (ropeR && row < ML) {
                const int t = row & 2047;
#pragma unroll
                for (int n = 0; n < 2; ++n) {
                    const f32x4 c4 = *(const f32x4*)(ca + t * 64 + half * 32 + n * 16 + fq * 4), s4 = *(const f32x4*)(sa + t * 64 + half * 32 + n * 16 + fq * 4);
                    const f32x4 a = acc[m][n], b = acc[m][n + 2];
                    acc[m][n] = a * c4 - b * s4; acc[m][n + 2] = b * c4 + a * s4;
                }
            }
#pragma unroll
            for (int n = 0; n < 4; ++n) {
                const f32x4 v = acc[m][n] * scale; u32x2 w; w.x = pk2(v[0], v[1]); w.y = pk2(v[2], v[3]);
                *(u32x2*)(Z + (size_t)row * ZS + colw + n * 16 + fq * 4) = w;
            }
        }
    };
    int brow, bcol;
    if (!decode(0, brow, bcol)) return;
    const bf16_t* ap[4]; const bf16_t* bp[4]; const bf16_t* apn[4]; const bf16_t* bpn[4];
    gemm_rows(U, brow, 1024, tid, ap); gemm_rows(W, bcol, 1024, tid, bp);
    bool first = true;
    for (int i = 0;; ++i) {
        int nbrow = brow, nbcol = bcol; const bool hn = decode(i + 1, nbrow, nbcol);
        gemm_rows(U, nbrow, 1024, tid, apn); gemm_rows(W, nbcol, 1024, tid, bpn);
        f32x4 acc[4][4];
        gemm_tile<true>(smem, ap, bp, 1024, acc, first, hn, apn, bpn);
        epi(brow, bcol, acc);
        if (!hn) break;
        brow = nbrow; bcol = nbcol; GEMM_ADVANCE(); first = false;
    }
}

DI void phase_g1o(KP p, int l, unsigned char* smem) {
    const int tid = TIDX(), wid = tid >> 6, lane = tid & 63, wr = wid >> 1, wc = wid & 1, fr = lane & 15, fq = lane >> 4;
    const int li = l >> 1;
    const bf16_t* U = (const bf16_t*)(p->ws + WS_U); const bf16_t* W = (const bf16_t*)(p->ws + WS_WQKV) + (size_t)li * 3072 * 1024;
    bf16_t* Qc = (bf16_t*)(p->ws + WS_QC); bf16_t* Kc = (bf16_t*)(p->ws + WS_KC); bf16_t* Vt = (bf16_t*)(p->ws + WS_VT);
    const float* cc = (const float*)(p->ws + WS_ROPEC); const float* sc = cc + 2048 * 32;
    auto decode = [&](int i, int& brow, int& bcol) -> bool {
        const int q = xcd_seq(i, (MT / 128) * 24); if (q < 0) return false;
        int rt, nt; tile_seq(q, MT / 128, 24, rt, nt); brow = rt * 128; bcol = nt * 128; return true; };
    int brow, bcol;
    if (!decode(0, brow, bcol)) return;
    const bf16_t* ap[4]; const bf16_t* bp[4]; const bf16_t* apn[4]; const bf16_t* bpn[4];
    gemm_rows(U, brow, 1024, tid, ap); gemm_rows(W, bcol, 1024, tid, bp);
    bool first = true;
    for (int i = 0;; ++i) {
        int nbrow = brow, nbcol = bcol; const bool hn = decode(i + 1, nbrow, nbcol);
        gemm_rows(U, nbrow, 1024, tid, apn); gemm_rows(W, nbcol, 1024, tid, bpn);
        f32x4 acc[4][4];
        if (bcol < 2048) {
            gemm_tile<true>(smem, ap, bp, 1024, acc, first, hn, apn, bpn);
            const int colw = bcol + wc * 64; const bool isk = colw >= 1024; const int hc = (colw & 1023) >> 6;
            bf16_t* dst = isk ? Kc : Qc; const float scale = isk ? 1.0f : 0.125f;
#pragma unroll
            for (int m = 0; m < 4; ++m) {
                const int row = brow + wr * 64 + m * 16 + fr;
                int b, pidx;
                if (row < ML) {
                    b = row >> 11; const int t = row & 2047; pidx = 256 + t;
#pragma unroll
                    for (int n = 0; n < 4; n += 2) {
                        const f32x4 c4 = *(const f32x4*)(cc + t * 32 + (n >> 1) * 16 + fq * 4), s4 = *(const f32x4*)(sc + t * 32 + (n >> 1) * 16 + fq * 4);
                        const f32x4 a = acc[m][n], bb = acc[m][n + 1];
                        acc[m][n] = a * c4 - bb * s4; acc[m][n + 1] = bb * c4 + a * s4;
                    }
                } else { b = (row - ML) >> 8; pidx = (row - ML) & 255; }
                bf16_t* o = dst + ((size_t)(b * 16 + hc) * TA + pidx) * 64;
#pragma unroll
                for (int n = 0; n < 4; ++n) { const f32x4 v = acc[m][n] * scale; u32x2 w; w.x = pk2(v[0], v[1]); w.y = pk2(v[2], v[3]); *(u32x2*)(o + n * 16 + fq * 4) = w; }
            }
        } else {
            gemm_tile<false>(smem, ap, bp, 1024, acc, first, hn, apn, bpn);
#pragma unroll
            for (int m = 0; m < 4; ++m) {
                const int row = brow + wr * 64 + m * 16 + fq * 4;
                int b, pidx;
                if (row < ML) { b = row >> 11; pidx = 256 + (row & 2047); } else { b = (row - ML) >> 8; pidx = (row - ML) & 255; }
                const int ppos = (pidx & ~12) | ((pidx & 8) >> 1) | ((pidx & 4) << 1);
#pragma unroll
                for (int n = 0; n < 4; ++n) {
                    const int col = bcol - 2048 + wc * 64 + n * 16 + fr; const int h = col >> 7, d = col & 127;
                    const f32x4 v = acc[m][n]; u32x2 w; w.x = pk2(v[0], v[1]); w.y = pk2(v[2], v[3]);
                    *(u32x2*)(Vt + ((size_t)(b * 8 + h) * 128 + d) * TA + ppos) = w;
                }
            }
        }
        if (!hn) break;
        brow = nbrow; bcol = nbcol; GEMM_ADVANCE(); first = false;
    }
}

DI void phase_g2(KP p, int l, unsigned char* smem) {
    const int tid = TIDX(), wid = tid >> 6, lane = tid & 63, wr = wid >> 1, wc = wid & 1, fr = lane & 15, fq = lane >> 4;
    const int li = l >> 1;
    const bf16_t* Y = (const bf16_t*)(p->ws + WS_Y);
    const bf16_t* W = (const bf16_t*)(p->ws + ((l & 1) ? WS_WCO : WS_WABO)) + (size_t)li * 1024 * 1024;
    bf16_t* P = (bf16_t*)(p->ws + WS_P);
    const int nrt = (l == 3 ? ML : MT) / 128;
    auto decode = [&](int i, int& brow, int& bcol) -> bool {
        const int q = xcd_seq(i, nrt * 8); if (q < 0) return false;
        int rt, nt; tile_seq(q, nrt, 8, rt, nt); brow = rt * 128; bcol = nt * 128; return true; };
    int brow, bcol;
    if (!decode(0, brow, bcol)) return;
    const bf16_t* ap[4]; const bf16_t* bp[4]; const bf16_t* apn[4]; const bf16_t* bpn[4];
    gemm_rows(Y, brow, 1024, tid, ap); gemm_rows(W, bcol, 1024, tid, bp);
    bool first = true;
    for (int i = 0;; ++i) {
        int nbrow = brow, nbcol = bcol; const bool hn = decode(i + 1, nbrow, nbcol);
        gemm_rows(Y, nbrow, 1024, tid, apn); gemm_rows(W, nbcol, 1024, tid, bpn);
        f32x4 acc[4][4];
        gemm_tile<true>(smem, ap, bp, 1024, acc, first, hn, apn, bpn);
#pragma unroll
        for (int m = 0; m < 4; ++m) { const int row = brow + wr * 64 + m * 16 + fr;
#pragma unroll
            for (int n = 0; n < 4; ++n) { const f32x4 v = acc[m][n]; u32x2 w; w.x = pk2(v[0], v[1]); w.y = pk2(v[2], v[3]); *(u32x2*)(P + (size_t)row * 1024 + bcol + wc * 64 + n * 16 + fq * 4) = w; } }
        if (!hn) break;
        brow = nbrow; bcol = nbcol; GEMM_ADVANCE(); first = false;
    }
}

template <bool DRY>
DI void phase_ln1r(KP p, int l, unsigned char* smem) {
    constexpr int US = 1028;
    constexpr int RB = 12;
    float* Us = (float*)smem;
    float* Ps = Us + RB * US;
    const int tid = TIDX(), wave = tid >> 6, lane = tid & 63;
    const xres_t* X = (const xres_t*)(p->ws + WS_X); xres_t* Xo = (xres_t*)(p->ws + (DRY ? WS_OB : WS_X)); const bf16_t* P = (const bf16_t*)(p->ws + WS_P); bf16_t* U = (bf16_t*)(p->ws + (DRY ? WS_Y : WS_U));
    const float* MOD = (const float*)(p->ws + WS_MOD); const float* WrT = (const float*)(p->ws + WS_WRT) + (size_t)l * 36 * 1024;
    const float* lng = p->in[6] + l * 1024; const float* lnb = p->in[7] + l * 1024;
    const float* bgrp = p->in[26] + l * 4; const float* brex = p->in[28] + l * 32;
    unsigned* cnt = (unsigned*)(p->ws + WS_CTL) + l * 32 + (DRY ? 256 : 0); int* list = (int*)(p->ws + WS_LIST); float* slotw = (float*)(p->ws + WS_SLOTW);
    const int rows_total = (l == 3) ? ML : MT;
    const int mi = lane & 15, mq = lane >> 4;
    int pend_slot = -1, pend_e = 0; unsigned pend_pos = 0u;
    for (int it = BIDX(); it * RB < rows_total; it += gridDim.x) {
        const int row0 = it * RB + wave * 3;
#pragma unroll
        for (int rr = 0; rr < 3; ++rr) {
            const int rowr = row0 + rr; const bool rvalid = rowr < rows_total; const int row = rvalid ? rowr : rows_total - 1;
            const int r = row < ML ? (row >> 11) : 8;
            const float* mod = MOD + (size_t)(l * 9 + r) * 6144;
            f32x4 v[4]; float s = 0.f;
#pragma unroll
            for (int j = 0; j < 4; ++j) {
                const int k = 256 * j + 4 * lane;
                const f32x4 xv = (l == 0) ? *(const f32x4*)((row < ML ? p->in[0] + (size_t)row * 1024 : p->in[2] + (size_t)(row - ML) * 1024) + k) : xload(X + (size_t)row * 1024 + k);
                const f32x4 g1 = *(const f32x4*)(mod + 2048 + k);
                const u32x2 pw_ = *(const u32x2*)(P + (size_t)row * 1024 + k); const f32x4 pv = (f32x4){bflo(pw_.x), bfhi(pw_.x), bflo(pw_.y), bfhi(pw_.y)};
                v[j] = xv * ALPHA + g1 * pv; s += (v[j][0] + v[j][1]) + (v[j][2] + v[j][3]);
            }
            const float mean = wave_sum(s) * (1.0f / 1024.0f); float s2 = 0.f;
#pragma unroll
            for (int j = 0; j < 4; ++j) { v[j] = v[j] - mean; s2 += (v[j][0] * v[j][0] + v[j][1] * v[j][1]) + (v[j][2] * v[j][2] + v[j][3] * v[j][3]); }
            const float rstd = 1.0f / sqrtf(wave_sum(s2) * (1.0f / 1024.0f) + LN_EPS);
#pragma unroll
            for (int j = 0; j < 4; ++j) {
                const int k = 256 * j + 4 * lane;
                const f32x4 xn = v[j] * rstd * *(const f32x4*)(lng + k) + *(const f32x4*)(lnb + k);
                const f32x4 uu = xn * (1.0f + *(const f32x4*)(mod + 4096 + k)) + *(const f32x4*)(mod + 3072 + k);
                *(f32x4*)(Us + (wave * 3 + rr) * US + k) = uu;
                if (rvalid) {
                    xstore(Xo + (size_t)row * 1024 + k, xn);
                    u32x2 w; w.x = pk2(uu[0], uu[1]); w.y = pk2(uu[2], uu[3]);
                    *(u32x2*)(U + (size_t)row * 1024 + k) = w;
                }
            }
        }
        __syncthreads();
        {
            f32x4 acc[3] = {(f32x4){0.f, 0.f, 0.f, 0.f}, (f32x4){0.f, 0.f, 0.f, 0.f}, (f32x4){0.f, 0.f, 0.f, 0.f}};
            const float* ap = Us + (mi < RB ? mi : mi - RB) * US + 256 * wave + 4 * mq;
            const float* bp0 = WrT + (size_t)mi * 1024 + 256 * wave + 4 * mq;
            const float* bp1 = WrT + (size_t)(16 + mi) * 1024 + 256 * wave + 4 * mq;
            const float* bp2 = WrT + (size_t)(32 + (mi & 3)) * 1024 + 256 * wave + 4 * mq;
#pragma unroll 1
            for (int sb0 = 0; sb0 < 16; sb0 += 8) {
                f32x4 bv[8][3];
#pragma unroll
                for (int q = 0; q < 8; ++q) { bv[q][0] = *(const f32x4*)(bp0 + 16 * (sb0 + q)); bv[q][1] = *(const f32x4*)(bp1 + 16 * (sb0 + q)); bv[q][2] = *(const f32x4*)(bp2 + 16 * (sb0 + q)); }
                __builtin_amdgcn_sched_barrier(0);
#pragma unroll
                for (int q = 0; q < 8; ++q) {
                    const f32x4 a = *(const f32x4*)(ap + 16 * (sb0 + q));
#pragma unroll
                    for (int e = 0; e < 4; ++e) {
                        acc[0] = __builtin_amdgcn_mfma_f32_16x16x4f32(a[e], bv[q][0][e], acc[0], 0, 0, 0);
                        acc[1] = __builtin_amdgcn_mfma_f32_16x16x4f32(a[e], bv[q][1][e], acc[1], 0, 0, 0);
                        acc[2] = __builtin_amdgcn_mfma_f32_16x16x4f32(a[e], bv[q][2][e], acc[2], 0, 0, 0);
                    }
                }
            }
            if (mq < 3) {
#pragma unroll
                for (int nt = 0; nt < 3; ++nt)
#pragma unroll
                    for (int rg = 0; rg < 4; ++rg) Ps[(wave * RB + mq * 4 + rg) * 48 + nt * 16 + mi] = acc[nt][rg];
            }
        }
        __syncthreads();
        if (wave < 2) {
            const int r = wave * 8 + (lane >> 3), c = lane & 7;
            const int rq = r < RB ? r : RB - 1;
            const int row = it * RB + rq;
            float lgv[5];
#pragma unroll
            for (int k = 0; k < 5; ++k) {
                const int o = c + 8 * k; const int oo = o < 36 ? o : 35;
                lgv[k] = (Ps[(0 * RB + rq) * 48 + oo] + Ps[(1 * RB + rq) * 48 + oo]) + (Ps[(2 * RB + rq) * 48 + oo] + Ps[(3 * RB + rq) * 48 + oo]);
            }
            float gv = c < 4 ? lgv[0] + bgrp[c & 3] : -3.0e38f; int gi = c;
#pragma unroll
            for (int off = 1; off < 4; off <<= 1) {
                const float ov = __shfl_xor(gv, off); const int oi = __shfl_xor(gi, off);
                if (ov > gv || (ov == gv && oi < gi)) { gv = ov; gi = oi; }
            }
            const int src0 = lane & ~7;
            const float gmax = __shfl(gv, src0); const int grp = __shfl(gi, src0);
            float ge = c < 4 ? expf(lgv[0] + bgrp[c & 3] - gmax) : 0.f;
            ge += __shfl_xor(ge, 1); ge += __shfl_xor(ge, 2);
            const float gw = 1.0f / __shfl(ge, src0);
            const int j = (c + 4) & 7; const int kk = c >= 4 ? grp : grp + 1;
            float ev = lgv[0];
#pragma unroll
            for (int k = 1; k < 5; ++k) ev = (kk == k) ? lgv[k] : ev;
            ev += brex[grp * 8 + j];
            float v1 = ev; int i1 = j;
#pragma unroll
            for (int off = 1; off < 8; off <<= 1) {
                const float ov = __shfl_xor(v1, off); const int oi = __shfl_xor(i1, off);
                if (ov > v1 || (ov == v1 && oi < i1)) { v1 = ov; i1 = oi; }
            }
            float v2 = (j == i1) ? -3.0e38f : ev; int i2 = (j == i1) ? 99 : j;
#pragma unroll
            for (int off = 1; off < 8; off <<= 1) {
                const float ov = __shfl_xor(v2, off); const int oi = __shfl_xor(i2, off);
                if (ov > v2 || (ov == v2 && oi < i2)) { v2 = ov; i2 = oi; }
            }
            const float e2 = expf(v2 - v1);
            const float w1 = 1.0f / (1.0f + e2), w2 = e2 / (1.0f + e2);
            if (c < 2 && r < RB && row < rows_total) {
                if (pend_slot >= 0) list[(size_t)pend_e * NSLOT + pend_pos] = pend_slot;
                const int e = grp * 8 + (c ? i2 : i1); const float w = gw * (c ? w2 : w1);
                const int slot = row * 2 + c;
                slotw[slot] = w;
                pend_pos = atomicAdd(&cnt[e], 1u); pend_e = e; pend_slot = slot;
            }
        }
        __syncthreads();
    }
    if (pend_slot >= 0) list[(size_t)pend_e * NSLOT + pend_pos] = pend_slot;
}

DI void moe_prefix(KP p, int l, int* s_cnt, int* s_tb, int* s_rb) {
    const int tid = TIDX();
    const unsigned* cnt = (const unsigned*)(p->ws + WS_CTL) + l * 32;
    __syncthreads();
    if (tid < 32) s_cnt[tid] = (int)__hip_atomic_load(cnt + tid, __ATOMIC_RELAXED, __HIP_MEMORY_SCOPE_AGENT);
    __syncthreads();
    if (tid == 0) { int tb = 0; for (int e = 0; e < 32; ++e) { s_tb[e] = tb; s_rb[e] = tb * 128; tb += (s_cnt[e] + 127) >> 7; } s_tb[32] = tb; s_rb[32] = tb * 128; }
    __syncthreads();
}
DI void phase_mg1(KP p, int l, unsigned char* smem) {
    const int tid = TIDX(), wid = tid >> 6, lane = tid & 63, wr = wid >> 1, wc = wid & 1, fr = lane & 15, fq = lane >> 4;
    int* s_cnt = (int*)(smem + 65536 + 64); int* s_tb = s_cnt + 32; int* s_rb = s_tb + 33;
    moe_prefix(p, l, s_cnt, s_tb, s_rb);
    const bf16_t* U = (const bf16_t*)(p->ws + WS_U); const int* list = (const int*)(p->ws + WS_LIST);
    bf16_t* H = (bf16_t*)(p->ws + WS_H);
    const int ntiles = s_tb[32] * 8;
    struct TI { int e, rt, nt, cnt_e; };
    auto decode = [&](int i, TI& t) -> bool {
        const int tile = xcd_seq(i, ntiles); if (tile < 0) return false;
        const int rtg = tile >> 3; t.nt = tile & 7;
        int e = 0;
        for (int q = 1; q < 32; ++q) if (rtg >= s_tb[q]) e = q;
        t.e = e; t.rt = rtg - s_tb[e]; t.cnt_e = s_cnt[e]; return true; };
    auto rows = [&](const TI& t, const bf16_t* (&a)[4], const bf16_t* (&b)[4]) {
#pragma unroll
        for (int i_ = 0; i_ < 4; ++i_) {
            const int pos = t.rt * 128 + (tid >> 3) + 32 * i_;
            const int tok = pos < t.cnt_e ? (list[(size_t)t.e * NSLOT + pos] >> 1) : 0;
            a[i_] = U + (size_t)tok * 1024 + gemm_chunk(tid) * 8;
        }
        gemm_rows((const bf16_t*)(p->ws + WS_WGU) + (size_t)(l * 32 + t.e) * 1024 * 1024, t.nt * 128, 1024, tid, b); };
    TI cur, nxt;
    if (!decode(0, cur)) return;
    const bf16_t* ap[4]; const bf16_t* bp[4]; const bf16_t* apn[4]; const bf16_t* bpn[4];
    rows(cur, ap, bp);
    bool first = true;
    for (int i = 0;; ++i) {
        nxt = cur; const bool hn = decode(i + 1, nxt);
        rows(nxt, apn, bpn);
        f32x4 acc[4][4];
        gemm_tile<true>(smem, ap, bp, 1024, acc, first, hn, apn, bpn);
        const int hrow0 = s_rb[cur.e] + cur.rt * 128 + wr * 64;
#pragma unroll
        for (int m = 0; m < 4; ++m) {
            bf16_t* o = H + (size_t)(hrow0 + m * 16 + fr) * 512 + cur.nt * 64 + wc * 32 + fq * 4;
#pragma unroll
            for (int n = 0; n < 4; n += 2) {
                const f32x4 g = acc[m][n], uu = acc[m][n + 1]; f32x4 h;
#pragma unroll
                for (int j = 0; j < 4; ++j) h[j] = siluf(g[j]) * uu[j];
                u32x2 w; w.x = pk2(h[0], h[1]); w.y = pk2(h[2], h[3]);
                *(u32x2*)(o + (n >> 1) * 16) = w;
            }
        }
        if (!hn) break;
        cur = nxt; GEMM_ADVANCE(); first = false;
    }
}
DI void phase_mg2(KP p, int l, unsigned char* smem) {
    const int tid = TIDX(), wid = tid >> 6, lane = tid & 63, wr = wid >> 1, wc = wid & 1, fr = lane & 15, fq = lane >> 4;
    int* s_cnt = (int*)(smem + 65536 + 64); int* s_tb = s_cnt + 32; int* s_rb = s_tb + 33;
    moe_prefix(p, l, s_cnt, s_tb, s_rb);
    const bf16_t* H = (const bf16_t*)(p->ws + WS_H); const int* list = (const int*)(p->ws + WS_LIST); const float* slotw = (const float*)(p->ws + WS_SLOTW);
    bf16_t* YS = (bf16_t*)(p->ws + WS_YS);
    const int ntiles = s_tb[32] * 8;
    struct TI { int e, rt, nt, cnt_e; };
    auto decode = [&](int i, TI& t) -> bool {
        const int tile = xcd_seq(i, ntiles); if (tile < 0) return false;
        const int rtg = tile >> 3; t.nt = tile & 7;
        int e = 0;
        for (int q = 1; q < 32; ++q) if (rtg >= s_tb[q]) e = q;
        t.e = e; t.rt = rtg - s_tb[e]; t.cnt_e = s_cnt[e]; return true; };
    auto rows = [&](const TI& t, const bf16_t* (&a)[4], const bf16_t* (&b)[4]) {
        gemm_rows(H, s_rb[t.e] + t.rt * 128, 512, tid, a);
        gemm_rows((const bf16_t*)(p->ws + WS_WD) + (size_t)(l * 32 + t.e) * 1024 * 512, t.nt * 128, 512, tid, b); };
    TI cur, nxt;
    if (!decode(0, cur)) return;
    const bf16_t* ap[4]; const bf16_t* bp[4]; const bf16_t* apn[4]; const bf16_t* bpn[4];
    rows(cur, ap, bp);
    bool first = true;
    for (int i = 0;; ++i) {
        nxt = cur; const bool hn = decode(i + 1, nxt);
        rows(nxt, apn, bpn);
        f32x4 acc[4][4];
        gemm_tile<true>(smem, ap, bp, 512, acc, first, hn, apn, bpn);
#pragma unroll
        for (int m = 0; m < 4; ++m) {
            const int pos = cur.rt * 128 + wr * 64 + m * 16 + fr;
            if (pos < cur.cnt_e) {
                const int slot = list[(size_t)cur.e * NSLOT + pos]; const float w = slotw[slot];
                bf16_t* o = YS + (size_t)slot * 1024 + cur.nt * 128 + wc * 64 + fq * 4;
#pragma unroll
                for (int n = 0; n < 4; ++n) { const f32x4 v = acc[m][n] * w; u32x2 ww; ww.x = pk2(v[0], v[1]); ww.y = pk2(v[2], v[3]); *(u32x2*)(o + n * 16) = ww; }
            }
        }
        if (!hn) break;
        cur = nxt; GEMM_ADVANCE(); first = false;
    }
}

template <bool DRY>
DI void phase_ln2(KP p, int l) {
    const int tid = TIDX(), wave = tid >> 6, lane = tid & 63;
    const xres_t* X = (const xres_t*)(p->ws + WS_X); xres_t* Xo = (xres_t*)(p->ws + (DRY ? WS_OB : WS_X)); const bf16_t* YS = (const bf16_t*)(p->ws + WS_YS); bf16_t* U = (bf16_t*)(p->ws + (DRY ? WS_Y : WS_U));
    const float* MOD = (const float*)(p->ws + WS_MOD);
    const float* lng = p->in[8] + l * 1024; const float* lnb = p->in[9] + l * 1024;
    const int rows_total = (l == 3) ? ML : MT;
    for (int row0 = (BIDX() * 4 + wave) * 2; row0 < rows_total; row0 += gridDim.x * 8) {
        f32x4 v[2][4]; float s[2] = {0.f, 0.f};
        const float* mod[2];
#pragma unroll
        for (int q = 0; q < 2; ++q) {
            const int row = row0 + q; const int r = row < ML ? (row >> 11) : 8;
            mod[q] = MOD + (size_t)(l * 9 + r) * 6144;
#pragma unroll
            for (int j = 0; j < 4; ++j) {
                const int k = 256 * j + 4 * lane;
                const u32x2 y0 = *(const u32x2*)(YS + (size_t)(2 * row) * 1024 + k), y1 = *(const u32x2*)(YS + (size_t)(2 * row + 1) * 1024 + k);
                f32x4 y; y[0] = bflo(y0.x) + bflo(y1.x); y[1] = bfhi(y0.x) + bfhi(y1.x); y[2] = bflo(y0.y) + bflo(y1.y); y[3] = bfhi(y0.y) + bfhi(y1.y);
                const f32x4 xv = xload(X + (size_t)row * 1024 + k), g2 = *(const f32x4*)(mod[q] + 5120 + k);
                v[q][j] = xv * ALPHA + g2 * y; s[q] += (v[q][j][0] + v[q][j][1]) + (v[q][j][2] + v[q][j][3]);
            }
        }
        float mean[2], rstd[2];
#pragma unroll
        for (int q = 0; q < 2; ++q) mean[q] = wave_sum(s[q]) * (1.0f / 1024.0f);
#pragma unroll
        for (int q = 0; q < 2; ++q) {
            float s2 = 0.f;
#pragma unroll
            for (int j = 0; j < 4; ++j) { v[q][j] = v[q][j] - mean[q]; s2 += (v[q][j][0] * v[q][j][0] + v[q][j][1] * v[q][j][1]) + (v[q][j][2] * v[q][j][2] + v[q][j][3] * v[q][j][3]); }
            s[q] = s2;
        }
#pragma unroll
        for (int q = 0; q < 2; ++q) rstd[q] = 1.0f / sqrtf(wave_sum(s[q]) * (1.0f / 1024.0f) + LN_EPS);
#pragma unroll
        for (int q = 0; q < 2; ++q) {
            const int row = row0 + q;
            const float* modn = mod[q] + (l + 1 < 4 ? 9 * 6144 : 0);
#pragma unroll
            for (int j = 0; j < 4; ++j) {
                const int k = 256 * j + 4 * lane;
                const f32x4 xn = v[q][j] * rstd[q] * *(const f32x4*)(lng + k) + *(const f32x4*)(lnb + k);
                if (l < 3) {
                    xstore(Xo + (size_t)row * 1024 + k, xn);
                    const f32x4 uu = xn * (1.0f + *(const f32x4*)(modn + 1024 + k)) + *(const f32x4*)(modn + k);
                    u32x2 w; w.x = pk2(uu[0], uu[1]); w.y = pk2(uu[2], uu[3]);
                    *(u32x2*)(U + (size_t)row * 1024 + k) = w;
                } else {
                    *(f32x4*)(p->out + (size_t)row * 1024 + k) = xn;
                }
            }
        }
    }
}

DI s16x4 tr_read(const unsigned char* ptr) {
    typedef short v4i16_t __attribute__((ext_vector_type(4)));
    return __builtin_bit_cast(s16x4, __builtin_amdgcn_ds_read_tr16_b64_v4i16((LAS v4i16_t*)ptr));
}
DI bf16x8 cat8(s16x4 a, s16x4 b) { return __builtin_shufflevector(a, b, 0, 1, 2, 3, 4, 5, 6, 7); }

DI void phase_decay(KP p, int l, unsigned char* smem) {
    const int tid = TIDX();
    const int li = l >> 1;
    const float* LR = (const float*)(p->ws + WS_LR);
    float* PF = (float*)(p->ws + WS_PF); float* SQ = (float*)(p->ws + WS_SQ); float* SK = (float*)(p->ws + WS_SK); float* TOT = (float*)(p->ws + WS_TOT);
    float* lrs = (float*)smem;
    float wf[16], wb[16];
#pragma unroll
    for (int r = 0; r < 16; ++r) { wf[r] = p->in[11][(size_t)li * 16 * 256 + r * 256 + tid]; wb[r] = p->in[13][(size_t)li * 16 * 256 + r * 256 + tid]; }
    const float bf = p->in[12][li * 256 + tid], bb = p->in[14][li * 256 + tid];
    for (int it = BIDX(); it < 2 * (MT / 64); it += gridDim.x) {
        const int ch = it >> 1, dr = it & 1;
        const int row0 = ch * 64;
        __syncthreads();
        { const int tok = tid >> 2, q4 = tid & 3; *(f32x4*)(lrs + tok * 16 + q4 * 4) = *(const f32x4*)(LR + (size_t)(row0 + tok) * 32 + dr * 16 + q4 * 4); }
        __syncthreads();
        float run = 0.f;
        if (dr == 0) {
            for (int t = 0; t < 64; ++t) {
                float g = bf;
#pragma unroll
                for (int r = 0; r < 16; ++r) g += lrs[t * 16 + r] * wf[r];
                run += (fminf(g, 0.f) - __logf(1.0f + __expf(-fabsf(g)))) * (1.0f / 16.0f);
                PF[(size_t)(row0 + t) * 256 + tid] = run;
            }
        } else {
            for (int t = 63; t >= 0; --t) {
                float g = bb;
#pragma unroll
                for (int r = 0; r < 16; ++r) g += lrs[t * 16 + r] * wb[r];
                SQ[(size_t)(row0 + t) * 256 + tid] = run;
                run += (fminf(g, 0.f) - __logf(1.0f + __expf(-fabsf(g)))) * (1.0f / 16.0f);
                SK[(size_t)(row0 + t) * 256 + tid] = run;
            }
        }
        TOT[(size_t)(ch * 2 + dr) * 256 + tid] = run;
    }
}

template <int DK>
DI void scan_item(KP p, int l, int item, unsigned char* smem) {
    constexpr bool ISA = (DK == 128);
    constexpr int QS = DK * 2 + 16, KS = DK * 2 + 32, VS = 96, AS_ = 144, SS = DK * 2 + 16, NKS = DK / 32, NMT = DK / 64;
    constexpr int O_QD = 0, O_KD = O_QD + 64 * QS, O_V = O_KD + 64 * KS, O_ATT = O_V + 64 * VS, O_ST = O_ATT + 64 * AS_, O_END = O_ST + 32 * SS;
    static_assert(O_END <= 65536, "scan LDS");
    constexpr int NP = DK / 64 * 2;
    constexpr int CPR = DK / 8;
    const int tid = TIDX(), wid = tid >> 6, lane = tid & 63, fr = lane & 15, fq = lane >> 4;
    const int b = item >> 5, h = (item >> 3) & 3, dir = (item >> 2) & 1, dvq = item & 3;
    const bf16_t* Z = (const bf16_t*)(p->ws + WS_Z);
    const float* EQ = (const float*)(p->ws + (dir ? WS_SQ : WS_PF)); const float* EK = (const float*)(p->ws + (dir ? WS_SK : WS_PF)); const float* TOT = (const float*)(p->ws + WS_TOT);
    bf16_t* OUT = (bf16_t*)(p->ws + (dir ? WS_OB : WS_OF));
    const int qcol = ISA ? h * 128 : 2048 + h * 64, kcol = ISA ? 512 + h * 128 : 2304 + h * 64, vcol = (ISA ? 1024 : 2560) + h * 128 + dvq * 32;
    const int ocol = (ISA ? 0 : 512) + h * 128 + dvq * 32;
    float lam = 0.f;
    if (ISA) lam = log1pf(-exp2f(-((dir ? 5.5f : 5.0f) + (float)h)));
    f32x4 S[NMT][2];
#pragma unroll
    for (int a = 0; a < NMT; ++a) { S[a][0] = (f32x4){0.f, 0.f, 0.f, 0.f}; S[a][1] = (f32x4){0.f, 0.f, 0.f, 0.f}; }
    __syncthreads();
    for (int i = tid; i < 32 * SS / 4; i += 256) ((unsigned*)(smem + O_ST))[i] = 0u;
    auto chunk_row0 = [&](int cc) -> int {
        const int ci = dir ? 35 - cc : cc; const int pp = ci * 64;
        if (!dir) return pp < 256 ? ML + b * 256 + pp : b * 2048 + (pp - 256);
        return pp < 2048 ? b * 2048 + pp : ML + b * 256 + (pp - 2048);
    };
    u32x4 rq[NP], rk[NP], rv; f32x4 eq[ISA ? 1 : NP][2], ek[ISA ? 1 : NP][2]; f32x4 tv[NMT];
    auto fetch = [&](int cc) {
        const int row0 = chunk_row0(cc);
        if (!ISA) {
#pragma unroll
            for (int a = 0; a < NMT; ++a) tv[a] = *(const f32x4*)(TOT + (size_t)((row0 >> 6) * 2 + dir) * 256 + h * 64 + (wid * NMT + a) * 16 + fq * 4);
        }
#pragma unroll
        for (int i = 0; i < NP; ++i) {
            const int id = tid + 256 * i, tok = id / CPR, cg_ = id % CPR;
            const size_t ro = (size_t)(row0 + tok) * ZS;
            rq[i] = *(const u32x4*)(Z + ro + qcol + cg_ * 8); rk[i] = *(const u32x4*)(Z + ro + kcol + cg_ * 8);
            if (!ISA) {
                const size_t eo = (size_t)(row0 + tok) * 256 + h * 64 + cg_ * 8;
                eq[i][0] = *(const f32x4*)(EQ + eo); eq[i][1] = *(const f32x4*)(EQ + eo + 4);
                ek[i][0] = *(const f32x4*)(EK + eo); ek[i][1] = *(const f32x4*)(EK + eo + 4);
            }
        }
        { const int tok = tid >> 2, cg_ = tid & 3; rv = *(const u32x4*)(Z + (size_t)(row0 + tok) * ZS + vcol + cg_ * 8); }
    };
    float ra[NP], rc[NP];
#pragma unroll
    for (int i = 0; i < NP; ++i) {
        const int tok = (tid + 256 * i) / CPR;
        ra[i] = dir ? __expf(lam * (float)(63 - tok)) : __expf(lam * (float)(tok + 1));
        rc[i] = dir ? __expf(-lam * (float)(64 - tok)) : __expf(-lam * (float)(tok + 1));
    }
    const float decA = __expf(lam * 64.0f);
    fetch(0);
    for (int cc = 0; cc < 36; ++cc) {
        const int row0 = chunk_row0(cc);
#pragma unroll
        for (int i = 0; i < NP; ++i) {
            const int id = tid + 256 * i, tok = id / CPR, cg_ = id % CPR;
            float fqv[8], fkv[8];
            if (ISA) {
#pragma unroll
                for (int e = 0; e < 8; ++e) { fqv[e] = ra[i]; fkv[e] = rc[i]; }
            } else {
#pragma unroll
                for (int e = 0; e < 8; ++e) { fqv[e] = __expf(eq[i][e >> 2][e & 3]); fkv[e] = __expf(-ek[i][e >> 2][e & 3]); }
            }
            const u32x4 q = rq[i], k = rk[i]; u32x4 qo, ko;
            qo.x = pk2(bflo(q.x) * fqv[0], bfhi(q.x) * fqv[1]); qo.y = pk2(bflo(q.y) * fqv[2], bfhi(q.y) * fqv[3]); qo.z = pk2(bflo(q.z) * fqv[4], bfhi(q.z) * fqv[5]); qo.w = pk2(bflo(q.w) * fqv[6], bfhi(q.w) * fqv[7]);
            ko.x = pk2(bflo(k.x) * fkv[0], bfhi(k.x) * fkv[1]); ko.y = pk2(bflo(k.y) * fkv[2], bfhi(k.y) * fkv[3]); ko.z = pk2(bflo(k.z) * fkv[4], bfhi(k.z) * fkv[5]); ko.w = pk2(bflo(k.w) * fkv[6], bfhi(k.w) * fkv[7]);
            *(u32x4*)(smem + O_QD + tok * QS + cg_ * 16) = qo;
            *(u32x4*)(smem + O_KD + tok * KS + cg_ * 16) = ko;
        }
        { const int tok = tid >> 2, cg_ = tid & 3; *(u32x4*)(smem + O_V + tok * VS + cg_ * 16) = rv; }
        f32x4 dec[NMT];
#pragma unroll
        for (int a = 0; a < NMT; ++a) {
            if (ISA) dec[a] = (f32x4){decA, decA, decA, decA};
            else dec[a] = (f32x4){__expf(tv[a][0]), __expf(tv[a][1]), __expf(tv[a][2]), __expf(tv[a][3])};
        }
        if (cc + 1 < 36) fetch(cc + 1);
        __syncthreads();
        bf16x8 afr[2];
        {
            f32x4 at[4];
#pragma unroll
            for (int n = 0; n < 4; ++n) at[n] = (f32x4){0.f, 0.f, 0.f, 0.f};
#pragma unroll
            for (int ks = 0; ks < NKS; ++ks) {
                const bf16x8 qf = *(const bf16x8*)(smem + O_QD + (16 * wid + fr) * QS + (32 * ks + 8 * fq) * 2);
#pragma unroll
                for (int n = 0; n < 4; ++n) {
                    const bf16x8 kf = *(const bf16x8*)(smem + O_KD + (16 * n + fr) * KS + (32 * ks + 8 * fq) * 2);
                    at[n] = __builtin_amdgcn_mfma_f32_16x16x32_bf16(kf, qf, at[n], 0, 0, 0);
                }
            }
            const int i = 16 * wid + fr;
#pragma unroll
            for (int n = 0; n < 4; ++n)
#pragma unroll
                for (int jj = 0; jj < 4; ++jj) { const int j = n * 16 + fq * 4 + jj; const bool keep = dir ? (j > i) : (j <= i); at[n][jj] = keep ? at[n][jj] : 0.f; }
#pragma unroll
            for (int ks = 0; ks < 2; ++ks) {
                u32x4 w; w.x = pk2(at[2 * ks][0], at[2 * ks][1]); w.y = pk2(at[2 * ks][2], at[2 * ks][3]); w.z = pk2(at[2 * ks + 1][0], at[2 * ks + 1][1]); w.w = pk2(at[2 * ks + 1][2], at[2 * ks + 1][3]);
                afr[ks] = __builtin_bit_cast(bf16x8, w);
            }
        }
        bf16x8 vf[2][2];
        {
            const int g = lane >> 4, i16 = lane & 15, q = i16 >> 2, pq = i16 & 3;
#pragma unroll
            for (int ks = 0; ks < 2; ++ks)
#pragma unroll
                for (int n = 0; n < 2; ++n) {
                    const unsigned char* a = smem + O_V + (32 * ks + 4 * g + q) * VS + (n * 16 + 4 * pq) * 2;
                    vf[ks][n] = cat8(tr_read(a), tr_read(a + 16 * VS));
                }
        }
        {
            f32x4 oa[2] = {(f32x4){0.f, 0.f, 0.f, 0.f}, (f32x4){0.f, 0.f, 0.f, 0.f}};
#pragma unroll
            for (int ks = 0; ks < 2; ++ks)
#pragma unroll
                for (int n = 0; n < 2; ++n) oa[n] = __builtin_amdgcn_mfma_f32_16x16x32_bf16(vf[ks][n], afr[ks], oa[n], 0, 0, 0);
#pragma unroll
            for (int ks = 0; ks < NKS; ++ks) {
                const bf16x8 qf = *(const bf16x8*)(smem + O_QD + (16 * wid + fr) * QS + (32 * ks + 8 * fq) * 2);
#pragma unroll
                for (int n = 0; n < 2; ++n) {
                    const bf16x8 sf = *(const bf16x8*)(smem + O_ST + (16 * n + fr) * SS + (32 * ks + 8 * fq) * 2);
                    oa[n] = __builtin_amdgcn_mfma_f32_16x16x32_bf16(sf, qf, oa[n], 0, 0, 0);
                }
            }
            bf16_t* o = OUT + (size_t)(row0 + 16 * wid + fr) * 1024 + ocol + fq * 4;
            u32x2 w0, w1; w0.x = pk2(oa[0][0], oa[0][1]); w0.y = pk2(oa[0][2], oa[0][3]); w1.x = pk2(oa[1][0], oa[1][1]); w1.y = pk2(oa[1][2], oa[1][3]);
            *(u32x2*)(o) = w0; *(u32x2*)(o + 16) = w1;
        }
        {
            const int g = lane >> 4, i16 = lane & 15, q = i16 >> 2, pq = i16 & 3;
#pragma unroll
            for (int a = 0; a < NMT; ++a) {
                const int mt = wid * NMT + a;
#pragma unroll
                for (int ks = 0; ks < 2; ++ks) {
                    const unsigned char* ka = smem + O_KD + (32 * ks + 4 * g + q) * KS + (mt * 16 + 4 * pq) * 2;
                    const bf16x8 kf = cat8(tr_read(ka), tr_read(ka + 16 * KS));
#pragma unroll
                    for (int n = 0; n < 2; ++n) S[a][n] = __builtin_amdgcn_mfma_f32_16x16x32_bf16(kf, vf[ks][n], S[a][n], 0, 0, 0);
                }
                S[a][0] *= dec[a]; S[a][1] *= dec[a];
            }
        }
        __syncthreads();
#pragma unroll
        for (int a = 0; a < NMT; ++a) {
            const int mt = wid * NMT + a;
#pragma unroll
            for (int n = 0; n < 2; ++n) { u32x2 w; w.x = pk2(S[a][n][0], S[a][n][1]); w.y = pk2(S[a][n][2], S[a][n][3]); *(u32x2*)(smem + O_ST + (n * 16 + fr) * SS + (mt * 16 + fq * 4) * 2) = w; }
        }
    }
    __syncthreads();
}
DI void phase_scan(KP p, int l, unsigned char* smem) {
    for (int it = BIDX(); it < 512; it += gridDim.x) {
        if (it < 256) scan_item<128>(p, l, it, smem); else scan_item<64>(p, l, it - 256, smem);
    }
}

DI void phase_merge(KP p, int l) {
    const int tid = TIDX(), wave = tid >> 6, lane = tid & 63;
    const int li = l >> 1;
    const bf16_t* OF = (const bf16_t*)(p->ws + WS_OF); const bf16_t* OB = (const bf16_t*)(p->ws + WS_OB);
    const bf16_t* Z = (const bf16_t*)(p->ws + WS_Z); bf16_t* Y = (bf16_t*)(p->ws + WS_Y);
    const bool isA = lane < 32;
    const float* gn = isA ? p->in[15] + li * 512 + lane * 16 : p->in[16] + li * 512 + (lane - 32) * 16;
    const int gcol = isA ? 1536 + lane * 16 : 3072 + (lane - 32) * 16;
    for (int row = BIDX() * 4 + wave; row < MT; row += gridDim.x * 4) {
        float o[16]; float s = 0.f;
#pragma unroll
        for (int j = 0; j < 2; ++j) {
            const u32x4 a = *(const u32x4*)(OF + (size_t)row * 1024 + lane * 16 + j * 8), bb = *(const u32x4*)(OB + (size_t)row * 1024 + lane * 16 + j * 8);
            o[j * 8 + 0] = bflo(a.x) + bflo(bb.x); o[j * 8 + 1] = bfhi(a.x) + bfhi(bb.x); o[j * 8 + 2] = bflo(a.y) + bflo(bb.y); o[j * 8 + 3] = bfhi(a.y) + bfhi(bb.y);
            o[j * 8 + 4] = bflo(a.z) + bflo(bb.z); o[j * 8 + 5] = bfhi(a.z) + bfhi(bb.z); o[j * 8 + 6] = bflo(a.w) + bflo(bb.w); o[j * 8 + 7] = bfhi(a.w) + bfhi(bb.w);
        }
#pragma unroll
        for (int e = 0; e < 16; ++e) s += o[e];
        s += __shfl_xor(s, 1); s += __shfl_xor(s, 2); s += __shfl_xor(s, 4);
        const float mean = isA ? s * (1.0f / 128.0f) : 0.f;
        float s2 = 0.f;
#pragma unroll
        for (int e = 0; e < 16; ++e) { o[e] -= mean; s2 += o[e] * o[e]; }
        s2 += __shfl_xor(s2, 1); s2 += __shfl_xor(s2, 2); s2 += __shfl_xor(s2, 4);
        const float rs = 1.0f / sqrtf(s2 * (1.0f / 128.0f) + LN_EPS);
        const u32x4 g0 = *(const u32x4*)(Z + (size_t)row * ZS + gcol), g1 = *(const u32x4*)(Z + (size_t)row * ZS + gcol + 8);
        float gt[16];
        gt[0] = bflo(g0.x); gt[1] = bfhi(g0.x); gt[2] = bflo(g0.y); gt[3] = bfhi(g0.y); gt[4] = bflo(g0.z); gt[5] = bfhi(g0.z); gt[6] = bflo(g0.w); gt[7] = bfhi(g0.w);
        gt[8] = bflo(g1.x); gt[9] = bfhi(g1.x); gt[10] = bflo(g1.y); gt[11] = bfhi(g1.y); gt[12] = bflo(g1.z); gt[13] = bfhi(g1.z); gt[14] = bflo(g1.w); gt[15] = bfhi(g1.w);
        float y[16];
#pragma unroll
        for (int e = 0; e < 16; ++e) y[e] = siluf(gt[e]) * (o[e] * rs * gn[e]);
        u32x4 w0, w1;
        w0.x = pk2(y[0], y[1]); w0.y = pk2(y[2], y[3]); w0.z = pk2(y[4], y[5]); w0.w = pk2(y[6], y[7]);
        w1.x = pk2(y[8], y[9]); w1.y = pk2(y[10], y[11]); w1.z = pk2(y[12], y[13]); w1.w = pk2(y[14], y[15]);
        *(u32x4*)(Y + (size_t)row * 1024 + lane * 16) = w0; *(u32x4*)(Y + (size_t)row * 1024 + lane * 16 + 8) = w1;
    }
}

DI int crow(int r, int hi) { return (r & 3) + 8 * (r >> 2) + 4 * hi; }
constexpr int ATT_BUF = 24576;
DI void att_component(const bf16_t* Qc, const bf16_t* Kc, const bf16_t* Vt, unsigned char* smem, float* wsf, int b, int h, int comp, int p0, int nkv, f32x16 (&O)[4]) {
    const int tid = TIDX(), wid = tid >> 6, lane = tid & 63, r32 = lane & 31, hi = lane >> 5;
    const int hc = h * 2 + comp;
    const bf16_t* Qb = Qc + ((size_t)(b * 16 + hc) * TA + p0 + wid * 32 + r32) * 64;
    const int gch = gemm_chunk(tid);
    const bf16_t* Kg = Kc + (size_t)(b * 16 + hc) * TA * 64 + (size_t)(tid >> 3) * 64 + gch * 8;
    const bf16_t* Vg = Vt + (size_t)(b * 8 + h) * 128 * TA + (size_t)(tid >> 3) * TA + gch * 8;
#define ATT_STAGE(buf, kt) do { \
        _Pragma("unroll") for (int i_ = 0; i_ < 2; ++i_) __builtin_amdgcn_global_load_lds((const unsigned*)(Kg + (size_t)((kt) + 32 * i_) * 64), (LAS unsigned*)(smem + (buf) * ATT_BUF + i_ * 4096 + tid * 16), 16, 0, 0); \
        _Pragma("unroll") for (int i_ = 0; i_ < 4; ++i_) __builtin_amdgcn_global_load_lds((const unsigned*)(Vg + (size_t)(32 * i_) * TA + (kt)), (LAS unsigned*)(smem + (buf) * ATT_BUF + 8192 + i_ * 4096 + tid * 16), 16, 0, 0); } while (0)
    ATT_STAGE(0, 0);
    bf16x8 qf[4];
#pragma unroll
    for (int ks = 0; ks < 4; ++ks) qf[ks] = *(const bf16x8*)(Qb + ks * 16 + hi * 8);
#pragma unroll
    for (int d0 = 0; d0 < 4; ++d0)
#pragma unroll
        for (int r = 0; r < 16; ++r) O[d0][r] = 0.f;
    float m_run = -1.0e30f, l_run = 0.f;
    const int sw = (r32 >> 1) & 7;
    const int nt = nkv >> 6;
    for (int t = 0; t < nt; ++t) {
        asm volatile("s_waitcnt vmcnt(0)" ::: "memory");
        __syncthreads();
        if (t + 1 < nt) ATT_STAGE((t + 1) & 1, (t + 1) * 64);
        const unsigned char* Kt = smem + (t & 1) * ATT_BUF; const unsigned char* Vtl = Kt + 8192;
        bf16x8 kf0[4], kf1[4];
#pragma unroll
        for (int ks = 0; ks < 4; ++ks) {
            const unsigned co = (unsigned)(((ks * 2 + hi) ^ sw) << 4);
            kf0[ks] = *(const bf16x8*)(Kt + r32 * 128 + co);
            kf1[ks] = *(const bf16x8*)(Kt + (32 + r32) * 128 + co);
        }
        const unsigned char* vr = Vtl + r32 * 128;
#define ATT_VLOAD(dst, st_) do { const unsigned o1_ = (unsigned)((((st_) * 2 + hi) ^ sw) << 4); \
        _Pragma("unroll") for (int d0_ = 0; d0_ < 4; ++d0_) dst[d0_] = *(const bf16x8*)(vr + d0_ * 4096 + o1_); } while (0)
        bf16x8 va[4], vb[4];
        ATT_VLOAD(va, 0);
        f32x16 s0, s1;
#pragma unroll
        for (int r = 0; r < 16; ++r) { s0[r] = 0.f; s1[r] = 0.f; }
#pragma unroll
        for (int ks = 0; ks < 4; ++ks) {
            s0 = __builtin_amdgcn_mfma_f32_32x32x16_bf16(kf0[ks], qf[ks], s0, 0, 0, 0);
            s1 = __builtin_amdgcn_mfma_f32_32x32x16_bf16(kf1[ks], qf[ks], s1, 0, 0, 0);
        }
        float mxa[8];
#pragma unroll
        for (int i_ = 0; i_ < 8; ++i_) mxa[i_] = fmaxf(fmaxf(s0[2 * i_], s0[2 * i_ + 1]), fmaxf(s1[2 * i_], s1[2 * i_ + 1]));
        float mx = fmaxf(fmaxf(fmaxf(mxa[0], mxa[1]), fmaxf(mxa[2], mxa[3])), fmaxf(fmaxf(mxa[4], mxa[5]), fmaxf(mxa[6], mxa[7])));
        { const auto rr = __builtin_amdgcn_permlane32_swap(__float_as_uint(mx), __float_as_uint(mx), false, false); mx = fmaxf(__uint_as_float(rr[0]), __uint_as_float(rr[1])); }
        if (__any(mx > m_run + 8.0f)) {
            const float m_new = fmaxf(m_run, mx);
            const float alpha = __builtin_amdgcn_exp2f((m_run - m_new) * L2E);
            l_run *= alpha; m_run = m_new;
            if (hi == 0) wsf[r32] = alpha;
            asm volatile("s_waitcnt lgkmcnt(0)" ::: "memory");
            float ar[16];
#pragma unroll
            for (int r = 0; r < 16; ++r) ar[r] = wsf[crow(r, hi)];
#pragma unroll
            for (int d0 = 0; d0 < 4; ++d0)
#pragma unroll
                for (int r = 0; r < 16; ++r) O[d0][r] *= ar[r];
            asm volatile("s_waitcnt lgkmcnt(0)" ::: "memory");
        }
        const float mb = m_run * L2E;
        float ps = 0.f;
#pragma unroll
        for (int r = 0; r < 16; ++r) { s0[r] = __builtin_amdgcn_exp2f(s0[r] * L2E - mb); s1[r] = __builtin_amdgcn_exp2f(s1[r] * L2E - mb); ps += s0[r] + s1[r]; }
        l_run += ps;
        u32x4 pw[4];
#pragma unroll
        for (int s = 0; s < 2; ++s) {
            pw[s].x = pk2(s0[8 * s + 0], s0[8 * s + 1]); pw[s].y = pk2(s0[8 * s + 2], s0[8 * s + 3]); pw[s].z = pk2(s0[8 * s + 4], s0[8 * s + 5]); pw[s].w = pk2(s0[8 * s + 6], s0[8 * s + 7]);
            pw[2 + s].x = pk2(s1[8 * s + 0], s1[8 * s + 1]); pw[2 + s].y = pk2(s1[8 * s + 2], s1[8 * s + 3]); pw[2 + s].z = pk2(s1[8 * s + 4], s1[8 * s + 5]); pw[2 + s].w = pk2(s1[8 * s + 6], s1[8 * s + 7]);
        }
#pragma unroll
        ATT_VLOAD(vb, 1);
#pragma unroll
        for (int d0 = 0; d0 < 4; ++d0) O[d0] = __builtin_amdgcn_mfma_f32_32x32x16_bf16(__builtin_bit_cast(bf16x8, pw[0]), va[d0], O[d0], 0, 0, 0);
        ATT_VLOAD(va, 2);
#pragma unroll
        for (int d0 = 0; d0 < 4; ++d0) O[d0] = __builtin_amdgcn_mfma_f32_32x32x16_bf16(__builtin_bit_cast(bf16x8, pw[1]), vb[d0], O[d0], 0, 0, 0);
        ATT_VLOAD(vb, 3);
#pragma unroll
        for (int d0 = 0; d0 < 4; ++d0) O[d0] = __builtin_amdgcn_mfma_f32_32x32x16_bf16(__builtin_bit_cast(bf16x8, pw[2]), va[d0], O[d0], 0, 0, 0);
#pragma unroll
        for (int d0 = 0; d0 < 4; ++d0) O[d0] = __builtin_amdgcn_mfma_f32_32x32x16_bf16(__builtin_bit_cast(bf16x8, pw[3]), vb[d0], O[d0], 0, 0, 0);
#undef ATT_VLOAD
    }
#undef ATT_STAGE
    l_run += __shfl_xor(l_run, 32);
    asm volatile("s_waitcnt lgkmcnt(0)" ::: "memory");
    if (hi == 0) wsf[r32] = 1.0f / l_run;
    asm volatile("s_waitcnt lgkmcnt(0)" ::: "memory");
    float ar[16];
#pragma unroll
    for (int r = 0; r < 16; ++r) ar[r] = wsf[crow(r, hi)];
    asm volatile("s_waitcnt lgkmcnt(0)" ::: "memory");
#pragma unroll
    for (int d0 = 0; d0 < 4; ++d0)
#pragma unroll
        for (int r = 0; r < 16; ++r) O[d0][r] *= ar[r];
}

DI void phase_att(KP p, int l, unsigned char* smem) {
    constexpr int O_WS = 2 * ATT_BUF;
    const int tid = TIDX(), wid = tid >> 6, lane = tid & 63, r32 = lane & 31, hi = lane >> 5;
    const int li = l >> 1;
    const bf16_t* Qc = (const bf16_t*)(p->ws + WS_QC); const bf16_t* Kc = (const bf16_t*)(p->ws + WS_KC); const bf16_t* Vt = (const bf16_t*)(p->ws + WS_VT);
    bf16_t* Y = (bf16_t*)(p->ws + WS_Y);
    float* stash = (float*)(p->ws + WS_P) + ((size_t)BIDX() * 256 + tid) * 32;
    const float lam_init = 0.8f - 0.6f * expf(-0.3f * (float)l);
    float* wsf = (float*)(smem + O_WS) + wid * 32;
    const int per_x = (l == 3) ? 128 : 144;
    for (int i = 0;; ++i) {
        int b, h, p0, nkv;
        {
            const int G = gridDim.x, bid = BIDX();
            int item;
            if ((G & 7) == 0) { const int x = bid & 7, q = i * (G >> 3) + (bid >> 3); if (q >= per_x) break; item = q < 128 ? x * 128 + q : 1024 + x * 16 + (q - 128); }
            else { item = i * G + bid; if (item >= 8 * per_x) break; }
            if (item < 1024) { b = item >> 7; h = (item >> 4) & 7; p0 = 256 + (item & 15) * 128; nkv = TA; }
            else { const int q = item - 1024; b = q >> 4; h = (q >> 1) & 7; p0 = (q & 1) * 128; nkv = TC; }
        }
        float d1 = 0.f, d2 = 0.f;
        { const float* lq1 = p->in[19] + (li * 8 + h) * 64, *lk1 = p->in[20] + (li * 8 + h) * 64, *lq2 = p->in[21] + (li * 8 + h) * 64, *lk2 = p->in[22] + (li * 8 + h) * 64;
          d1 = wave_sum(lq1[lane] * lk1[lane]); d2 = wave_sum(lq2[lane] * lk2[lane]); }
        const float lamv = expf(d1) - expf(d2) + lam_init;
        f32x16 On[4];
        __syncthreads();
        att_component(Qc, Kc, Vt, smem, wsf, b, h, 0, p0, nkv, On);
#pragma unroll
        for (int d0 = 0; d0 < 4; ++d0)
#pragma unroll
            for (int r = 0; r < 16; r += 8) {
                u32x4 w; w.x = pk2(On[d0][r], On[d0][r + 1]); w.y = pk2(On[d0][r + 2], On[d0][r + 3]); w.z = pk2(On[d0][r + 4], On[d0][r + 5]); w.w = pk2(On[d0][r + 6], On[d0][r + 7]);
                *(u32x4*)(stash + (d0 * 16 + r) / 2) = w;
            }
        __syncthreads();
        att_component(Qc, Kc, Vt, smem, wsf, b, h, 1, p0, nkv, On);
#pragma unroll
        for (int d0 = 0; d0 < 4; ++d0)
#pragma unroll
            for (int r = 0; r < 16; r += 8) {
                const u32x4 w = *(const u32x4*)(stash + (d0 * 16 + r) / 2);
                On[d0][r] = bflo(w.x) - lamv * On[d0][r]; On[d0][r + 1] = bfhi(w.x) - lamv * On[d0][r + 1]; On[d0][r + 2] = bflo(w.y) - lamv * On[d0][r + 2]; On[d0][r + 3] = bfhi(w.y) - lamv * On[d0][r + 3];
                On[d0][r + 4] = bflo(w.z) - lamv * On[d0][r + 4]; On[d0][r + 5] = bfhi(w.z) - lamv * On[d0][r + 5]; On[d0][r + 6] = bflo(w.w) - lamv * On[d0][r + 6]; On[d0][r + 7] = bfhi(w.w) - lamv * On[d0][r + 7];
            }
        float ms[16];
#pragma unroll
        for (int r = 0; r < 16; ++r) {
            float s = (On[0][r] * On[0][r] + On[1][r] * On[1][r]) + (On[2][r] * On[2][r] + On[3][r] * On[3][r]);
            s += __shfl_xor(s, 1); s += __shfl_xor(s, 2); s += __shfl_xor(s, 4); s += __shfl_xor(s, 8); s += __shfl_xor(s, 16);
            ms[r] = __builtin_amdgcn_rsqf(s * (1.0f / 128.0f) + LN_EPS);
        }
        const float* sg = p->in[23] + li * 1024 + h * 128;
        const float post = 1.0f - lam_init;
        float gsc[4];
#pragma unroll
        for (int d0 = 0; d0 < 4; ++d0) gsc[d0] = sg[d0 * 32 + r32] * post;
        __syncthreads();
        unsigned char* stg = smem + wid * 8192;
#pragma unroll
        for (int r = 0; r < 16; ++r) {
            unsigned char* sp = stg + crow(r, hi) * 256 + r32 * 2;
#pragma unroll
            for (int d0 = 0; d0 < 4; ++d0) *(unsigned short*)(sp + d0 * 64) = (unsigned short)f2bf(On[d0][r] * ms[r] * gsc[d0]);
        }
        asm volatile("s_waitcnt lgkmcnt(0)" ::: "memory");
#pragma unroll
        for (int i2 = 0; i2 < 8; ++i2) {
            const int id = lane + 64 * i2, qr = id >> 4, ch = id & 15;
            const int pq = p0 + wid * 32 + qr;
            const int row = pq < 256 ? ML + b * 256 + pq : b * 2048 + (pq - 256);
            *(u32x4*)(Y + (size_t)row * 1024 + h * 128 + ch * 8) = *(const u32x4*)(stg + qr * 256 + ch * 16);
        }
        asm volatile("s_waitcnt lgkmcnt(0)" ::: "memory");
    }
}

#define XB_TMO      128
#define XB_XCNT(j)  (256  + 64 * (j))
#define XB_XSUB(j)  (1280 + 64 * (j))
#define XB_XGEN(j)  (2304 + 64 * (j))
#define XB_TOP      3328
#define XB_TOPGEN   3392
#define XCD_BAR_WORDS 3456
#define XB_SPIN_CAP (1u << 22)
DI unsigned xb_ld(unsigned* p)              { return __hip_atomic_load(p, __ATOMIC_RELAXED, __HIP_MEMORY_SCOPE_AGENT); }
DI unsigned xb_add(unsigned* p, unsigned v) { return __hip_atomic_fetch_add(p, v, __ATOMIC_RELAXED, __HIP_MEMORY_SCOPE_AGENT); }
DI unsigned xb_xcc_id() { return (unsigned)__builtin_amdgcn_s_getreg((3 << 11) | 20) & 0xFu; }
#define XB_SPIN(cond, bar) do { unsigned _sp = 0; while (cond) { __builtin_amdgcn_s_sleep(1); \
    if ((++_sp & 255u) == 0u) { if (xb_ld(&(bar)[XB_TMO])) break; if (_sp > XB_SPIN_CAP) { atomicAdd(&(bar)[XB_TMO], 1u); break; } } } } while (0)
struct XcdBarrier { unsigned* bar; unsigned x; volatile LAS unsigned* st; };
DI XcdBarrier xcd_barrier_post(unsigned* bar, volatile LAS unsigned* st) {
    XcdBarrier b; b.bar = bar; b.x = xb_xcc_id(); b.st = st;
    if (threadIdx.x == 0) (void)xb_add(&bar[XB_XCNT(b.x)], 1u);
    return b;
}
DI void xcd_barrier_complete(unsigned* bar, unsigned x, unsigned& nloc, unsigned& nx) {
    const unsigned G = gridDim.x * gridDim.y * gridDim.z;
    unsigned sum, cnt, mine, sp = 0u;
    for (;;) {
        sum = 0u; cnt = 0u; mine = 0u;
#pragma unroll
        for (unsigned j = 0; j < 16; ++j) { const unsigned c = xb_ld(&bar[XB_XCNT(j)]); sum += c; cnt += (c > 0u) ? 1u : 0u; mine = (j == x) ? c : mine; }
        if (sum == G) break;
        __builtin_amdgcn_s_sleep(1);
        if ((++sp & 255u) == 0u) { if (xb_ld(&bar[XB_TMO])) break; if (sp > XB_SPIN_CAP) { atomicAdd(&bar[XB_TMO], 1u); break; } }
    }
    nloc = mine > 0u ? mine : 1u; nx = cnt > 0u ? cnt : 1u;
}
DI void xcd_barrier(const XcdBarrier& b) {
    asm volatile("s_waitcnt vmcnt(0)" ::: "memory");
    __syncthreads();
    if (threadIdx.x == 0) {
        unsigned* bar = b.bar;
        __builtin_amdgcn_s_waitcnt(0);
        unsigned nloc = b.st[0], nx = b.st[1];
        if (nloc == 0u) { xcd_barrier_complete(bar, b.x, nloc, nx); b.st[0] = nloc; b.st[1] = nx; }
        const unsigned old = xb_add(&bar[XB_XSUB(b.x)], 1u);
        const unsigned gen = old / nloc;
        if (old + 1u == (gen + 1u) * nloc) {
            __builtin_amdgcn_fence(__ATOMIC_RELEASE, "agent");
            asm volatile("s_waitcnt vmcnt(0)" ::: "memory");
            const unsigned og = xb_add(&bar[XB_TOP], 1u);
            const unsigned tg = og / nx;
            if (og + 1u == (tg + 1u) * nx) xb_add(&bar[XB_TOPGEN], 1u);
            else XB_SPIN(xb_ld(&bar[XB_TOPGEN]) == tg, bar);
            __builtin_amdgcn_fence(__ATOMIC_ACQUIRE, "agent");
            xb_add(&bar[XB_XGEN(b.x)], 1u);
            asm volatile("s_waitcnt vmcnt(0)" ::: "memory");
        } else {
            XB_SPIN(xb_ld(&bar[XB_XGEN(b.x)]) == gen, bar);
            __builtin_amdgcn_fence(__ATOMIC_ACQUIRE, "agent");
            asm volatile("s_waitcnt vmcnt(0)" ::: "memory");
        }
    }
    __syncthreads();
}

#ifdef DOUBLE_MASK
#define DRYCOND (rep_ == 0 && nrep_ == 2)
#else
#define DRYCOND false
#endif
constexpr int NPHASE = 34;
constexpr int LDS_BYTES = 65536 + 1024;
__global__ void __launch_bounds__(256, 2) mega(Params pv) {
    extern __shared__ __attribute__((aligned(16))) unsigned char smem[];
    const int ph_lo = pv.ph_lo, ph_hi = pv.ph_hi;
    volatile LAS unsigned* bar_st = (volatile LAS unsigned*)(LAS unsigned char*)(smem + 65536);
    if (threadIdx.x == 0) { bar_st[0] = 0u; bar_st[1] = 0u; }
    __syncthreads();
    XcdBarrier xbar = xcd_barrier_post((unsigned*)(pv.ws + WS_CTL) + 4096, bar_st);
    for (int ph = ph_lo; ph < ph_hi; ++ph) {
        KP p = (KP)__builtin_amdgcn_kernarg_segment_ptr();
        asm volatile("" : "+s"(p) :: "memory");
#ifdef DOUBLE_MASK
        int kind_;
        if (ph == 0) kind_ = 0; else if (ph == 1) kind_ = 1;
        else { const int rem_ = (ph - 2) % 16; kind_ = rem_ == 0 ? 2 : (rem_ == 1 ? 12 : (rem_ < 9 ? rem_ + 1 : (rem_ == 9 ? 10 : (rem_ == 10 ? 11 : (rem_ - 11 + 5))))); }
        const int nrep_ = ((DOUBLE_MASK >> kind_) & 1) ? 2 : 1;
        for (int rep_ = 0; rep_ < nrep_; ++rep_) {
        if (rep_) xcd_barrier(xbar);
#endif
        if (ph == 0) phase_pre0(p, smem);
        else if (ph == 1) phase_pre1(p);
        else {
            const int q = ph - 2, lp = q / 16, rem = q % 16;
            if (rem < 9) {
                const int l = 2 * lp;
                switch (rem) {
                    case 0: phase_g1e(p, l, smem); break;
                    case 1: phase_decay(p, l, smem); break;
                    case 2: phase_scan(p, l, smem); break;
                    case 3: phase_merge(p, l); break;
                    case 4: phase_g2(p, l, smem); break;
                    case 5: if (DRYCOND) phase_ln1r<true>(p, l, smem); else phase_ln1r<false>(p, l, smem); break;
                    case 6: phase_mg1(p, l, smem); break;
                    case 7: phase_mg2(p, l, smem); break;
                    default: if (DRYCOND) phase_ln2<true>(p, l); else phase_ln2<false>(p, l); break;
                }
            } else {
                const int l = 2 * lp + 1;
                switch (rem - 9) {
                    case 0: phase_g1o(p, l, smem); break;
                    case 1: phase_att(p, l, smem); break;
                    case 2: phase_g2(p, l, smem); break;
                    case 3: if (DRYCOND) phase_ln1r<true>(p, l, smem); else phase_ln1r<false>(p, l, smem); break;
                    case 4: phase_mg1(p, l, smem); break;
                    case 5: phase_mg2(p, l, smem); break;
                    default: if (DRYCOND) phase_ln2<true>(p, l); else phase_ln2<false>(p, l); break;
                }
            }
        }
#ifdef DOUBLE_MASK
        }
#endif
        if (ph + 1 < ph_hi) xcd_barrier(xbar);
    }
}

extern "C" void kernel_launch(void* const* d_in, const int* in_sizes, int n_in, void* d_out, int out_size, void* d_ws, size_t ws_size, hipStream_t stream) {
    static int grid_blocks = 0;
    if (grid_blocks == 0) {
        if (n_in != 32 || ws_size < WS_END) { fprintf(stderr, "kernel_launch: unexpected n_in %d or ws_size %zu\n", n_in, ws_size); grid_blocks = -1; return; }
        int dev = 0, cus = 0, per_cu = 0;
        hipGetDevice(&dev);
        hipDeviceGetAttribute(&cus, hipDeviceAttributeMultiprocessorCount, dev);
        hipFuncSetAttribute((const void*)mega, hipFuncAttributeMaxDynamicSharedMemorySize, LDS_BYTES);
        hipOccupancyMaxActiveBlocksPerMultiprocessor(&per_cu, mega, 256, LDS_BYTES);
        if (per_cu > 2) per_cu = 2;
        if (per_cu < 1) per_cu = 1;
        grid_blocks = cus * per_cu;
    }
    if (grid_blocks < 0) return;
    hipMemsetAsync((char*)d_ws + WS_CTL, 0, 32768, stream);
    Params p{};
    for (int i = 0; i < 32; ++i) p.in[i] = (const float*)d_in[i];
    p.out = (float*)d_out; p.ws = (unsigned char*)d_ws;
#if N_LAUNCH_MODE == 1
    p.ph_lo = 0; p.ph_hi = NPHASE;
    void* args[] = {&p};
    hipError_t e = hipLaunchCooperativeKernel((void*)mega, dim3(grid_blocks), dim3(256), args, LDS_BYTES, stream);
    if (e != hipSuccess) fprintf(stderr, "cooperative launch failed: %s (grid %d)\n", hipGetErrorString(e), grid_blocks);
#else
    for (int ph = 0; ph < NPHASE; ++ph) {
        p.ph_lo = ph; p.ph_hi = ph + 1;
        hipLaunchKernelGGL(mega, dim3(grid_blocks), dim3(256), LDS_BYTES, stream, p);
    }
#endif
}
```

```cpp
#include <hip/hip_runtime.h>
#include <hip/hip_cooperative_groups.h>
#include <cstdio>
#include <cstdint>
namespace cg = cooperative_groups;

#ifndef N_LAUNCH_MODE
#define N_LAUNCH_MODE 1
#endif

#define DI __device__ __forceinline__
#define LAS __attribute__((address_space(3)))
typedef unsigned short bf16_t;
typedef short bf16x8 __attribute__((ext_vector_type(8)));
typedef short s16x4 __attribute__((ext_vector_type(4)));
typedef float f32x4 __attribute__((ext_vector_type(4)));
typedef float f32x16 __attribute__((ext_vector_type(16)));
typedef unsigned u32x4 __attribute__((ext_vector_type(4)));
typedef unsigned u32x2 __attribute__((ext_vector_type(2)));

constexpr int D = 1024, NB = 8, T = 2048, TC = 256, TA = T + TC;
constexpr int ML = NB * T, MC = NB * TC, MT = ML + MC;
constexpr int NIN = 3616, NINP = 3712, ZS = 3712;
constexpr int NSLOT = 2 * MT;
constexpr float LN_EPS = 1e-5f;
constexpr float ALPHA = 1.6817928305074290f;
constexpr float L2E = 1.4426950408889634f;

constexpr size_t MiB = 1ull << 20;
constexpr size_t WS_CTL = 0;
constexpr size_t WS_MOD = 1 * MiB;
constexpr size_t WS_ROPEA = 2 * MiB;
constexpr size_t WS_ROPEC = 3 * MiB;
constexpr size_t WS_LR = 4 * MiB;
constexpr size_t WS_SLOTW = 7 * MiB;
constexpr size_t WS_LIST = 8 * MiB;
constexpr size_t WS_WRT = 13 * MiB;
constexpr size_t WS_WIN = 16 * MiB;
constexpr size_t WS_WABO = 32 * MiB;
constexpr size_t WS_WQKV = 36 * MiB;
constexpr size_t WS_WCO = 48 * MiB;
constexpr size_t WS_WGU = 64 * MiB;
constexpr size_t WS_WD = 320 * MiB;
constexpr size_t WS_X = 448 * MiB;
constexpr size_t WS_U = 520 * MiB;
constexpr size_t WS_Y = 556 * MiB;
constexpr size_t WS_Z = 592 * MiB;
constexpr size_t WS_O = 724 * MiB;
constexpr size_t WS_PF = 868 * MiB, WS_SQ = 886 * MiB, WS_SK = 904 * MiB, WS_TOT = 922 * MiB;
constexpr size_t WS_END = 923 * MiB;
constexpr size_t WS_QC = WS_Z, WS_KC = WS_Z + 36 * MiB, WS_VT = WS_Z + 72 * MiB;
constexpr size_t WS_YS = WS_Z;
constexpr size_t WS_OF = WS_O, WS_OB = WS_O + 72 * MiB, WS_P = WS_O, WS_H = WS_O + 72 * MiB;

#ifndef XBF16
#define XBF16 0
#endif
#if XBF16
typedef bf16_t xres_t;
#else
typedef float xres_t;
#endif
struct Params { const float* in[32]; float* out; unsigned char* ws; int ph_lo, ph_hi; };
typedef const __attribute__((address_space(4))) Params* KP;

DI int TIDX() { int t = threadIdx.x; asm volatile("" : "+v"(t)); return t; }
DI int BIDX() { int b = blockIdx.x; asm volatile("" : "+s"(b)); return b; }
DI unsigned pk2(float lo, float hi);
DI unsigned f2bf(float f) { return pk2(f, 0.f) & 0xffffu; }
typedef float f32x2_t __attribute__((ext_vector_type(2))); typedef __bf16 bf16x2_t __attribute__((ext_vector_type(2)));
DI unsigned pk2(float lo, float hi) { f32x2_t v = {lo, hi}; bf16x2_t b = __builtin_convertvector(v, bf16x2_t); return __builtin_bit_cast(unsigned, b); }
DI float bflo(unsigned w) { return __uint_as_float(w << 16); }
DI float bfhi(unsigned w) { return __uint_as_float(w & 0xffff0000u); }
DI f32x4 xload(const xres_t* p) {
#if XBF16
    const u32x2 w = *(const u32x2*)p; return (f32x4){bflo(w.x), bfhi(w.x), bflo(w.y), bfhi(w.y)};
#else
    return *(const f32x4*)p;
#endif
}
DI void xstore(xres_t* p, f32x4 v) {
#if XBF16
    u32x2 w; w.x = pk2(v[0], v[1]); w.y = pk2(v[2], v[3]); *(u32x2*)p = w;
#else
    *(f32x4*)p = v;
#endif
}
DI float wave_sum(float v) {
#pragma unroll
    for (int o = 1; o < 64; o <<= 1) v += __shfl_xor(v, o);
    return v;
}
DI float siluf(float v) { return v * __builtin_amdgcn_rcpf(1.0f + __expf(-v)); }

DI int gemm_chunk(int tid) { return (tid & 7) ^ ((tid >> 4) & 7); }
template <bool TRN>
DI void gemm_tile(unsigned char* shm, const bf16_t* const (&ap)[4], const bf16_t* const (&bp)[4], int K, f32x4 (&acc)[4][4],
                  bool first, bool has_next, const bf16_t* const (&apn)[4], const bf16_t* const (&bpn)[4]) {
    const int tid = TIDX(), wid = tid >> 6, lane = tid & 63, wr = wid >> 1, wc = wid & 1, fr = lane & 15, fq = lane >> 4;
#pragma unroll
    for (int m = 0; m < 4; ++m)
#pragma unroll
        for (int n = 0; n < 4; ++n) acc[m][n] = (f32x4){0.f, 0.f, 0.f, 0.f};
    const int nt = K >> 6;
    const int sw = fr >> 1;
    const unsigned aoff = (unsigned)((wr * 64 + fr) * 128), boff = (unsigned)(16384 + (wc * 64 + fr) * 128);
#define GEMM_STAGE(buf, A_, B_, t) do { _Pragma("unroll") for (int i_ = 0; i_ < 4; ++i_) { \
        __builtin_amdgcn_global_load_lds((const unsigned*)(A_[i_] + (t) * 64), (LAS unsigned*)(shm + (buf) * 32768 + i_ * 4096 + tid * 16), 16, 0, 0); \
        __builtin_amdgcn_global_load_lds((const unsigned*)(B_[i_] + (t) * 64), (LAS unsigned*)(shm + (buf) * 32768 + 16384 + i_ * 4096 + tid * 16), 16, 0, 0); } } while (0)
    if (first) {
        GEMM_STAGE(0, ap, bp, 0);
        asm volatile("s_waitcnt vmcnt(0)" ::: "memory");
        __syncthreads();
    }
    for (int t = 0; t < nt; ++t) {
        const int cur = t & 1;
        if (t + 1 < nt) GEMM_STAGE(cur ^ 1, ap, bp, t + 1);
        else if (has_next) GEMM_STAGE(cur ^ 1, apn, bpn, 0);
        const unsigned char* base = shm + cur * 32768;
        bf16x8 At[2][4], Bt[2][4];
#pragma unroll
        for (int ks = 0; ks < 2; ++ks) {
            const unsigned co = (unsigned)(((ks * 4 + fq) ^ sw) << 4);
#pragma unroll
            for (int m = 0; m < 4; ++m) At[ks][m] = *(const bf16x8*)(base + aoff + m * 2048 + co);
#pragma unroll
            for (int n = 0; n < 4; ++n) Bt[ks][n] = *(const bf16x8*)(base + boff + n * 2048 + co);
        }
        __builtin_amdgcn_s_setprio(1);
#pragma unroll
        for (int ks = 0; ks < 2; ++ks)
#pragma unroll
            for (int m = 0; m < 4; ++m)
#pragma unroll
                for (int n = 0; n < 4; ++n)
                    acc[m][n] = TRN ? __builtin_amdgcn_mfma_f32_16x16x32_bf16(Bt[ks][n], At[ks][m], acc[m][n], 0, 0, 0)
                                    : __builtin_amdgcn_mfma_f32_16x16x32_bf16(At[ks][m], Bt[ks][n], acc[m][n], 0, 0, 0);
        __builtin_amdgcn_s_setprio(0);
        asm volatile("s_waitcnt vmcnt(0)" ::: "memory");
        __syncthreads();
    }
#undef GEMM_STAGE
}
#define GEMM_ADVANCE() do { _Pragma("unroll") for (int k_ = 0; k_ < 4; ++k_) { ap[k_] = apn[k_]; bp[k_] = bpn[k_]; } } while (0)
DI void gemm_rows(const bf16_t* base, int r0, int ld, int tid, const bf16_t* (&pp)[4]) {
    const bf16_t* q = base + (size_t)(r0 + (tid >> 3)) * ld + gemm_chunk(tid) * 8;
#pragma unroll
    for (int i = 0; i < 4; ++i) pp[i] = q + (size_t)(32 * i) * ld;
}
DI bool tile_seq(int q, int nrt, int nct, int& rt, int& ct) {
    if (q >= nrt * nct) return false;
    const int band = q / (8 * nct), rem = q - band * 8 * nct;
    const int rows = (nrt - band * 8) < 8 ? (nrt - band * 8) : 8;
    ct = rem / rows; rt = band * 8 + rem % rows;
    return true;
}
DI int xcd_seq(int i, int total) {
    const int G = gridDim.x, bid = BIDX();
    if ((G & 7) != 0) { const int q = i * G + bid; return q < total ? q : -1; }
    const int x = bid & 7, j = bid >> 3, per = (total + 7) >> 3, gx = G >> 3;
    const int q = i * gx + j;
    if (q >= per) return -1;
    const int g = x * per + q;
    return g < total ? g : -1;
}

template <int MODE>
DI void tr_item(const float* W, int K, int N, bf16_t* WT, float* scr, int item, int lane) {
    const int nblk = N / 32, kb = item / nblk, nb = item % nblk, k0 = 64 * kb, n0 = 32 * nb;
    float wv[32];
#pragma unroll
    for (int i = 0; i < 32; ++i) wv[i] = W[(size_t)(k0 + 2 * i + (lane >> 5)) * N + n0 + (lane & 31)];
#pragma unroll
    for (int i = 0; i < 32; ++i) scr[(2 * i + (lane >> 5)) * 33 + (lane & 31)] = wv[i];
    asm volatile("s_waitcnt lgkmcnt(0)" ::: "memory");
    const int c = lane & 7;
#pragma unroll
    for (int j = 0; j < 4; ++j) {
        const int n = (lane >> 3) + 8 * j; const float* s = scr + (8 * c) * 33 + n;
        u32x4 o; o.x = pk2(s[0 * 33], s[1 * 33]); o.y = pk2(s[2 * 33], s[3 * 33]); o.z = pk2(s[4 * 33], s[5 * 33]); o.w = pk2(s[6 * 33], s[7 * 33]);
        const int nn = n0 + n;
        const int drow = (MODE == 0) ? nn : ((nn >> 4) * 32 + (nn & 15) + (MODE == 2 ? 16 : 0));
        *(u32x4*)(WT + (size_t)drow * K + k0 + 8 * c) = o;
    }
    asm volatile("s_waitcnt lgkmcnt(0)" ::: "memory");
}

DI void phase_pre0(KP p, unsigned char* smem) {
    const int tid = TIDX(), wave = tid >> 6, lane = tid & 63;
    unsigned char* ws = p->ws;
    {
        float* s_sc = (float*)smem;
        float* s_red = s_sc + 9 * 1024;
        const float* c = p->in[1]; const float* cc = p->in[3];
        for (int i = tid; i < 9 * 1024; i += 256) { const int r = i >> 10, k = i & 1023; const float v = r < 8 ? c[r * 1024 + k] : cc[k]; s_sc[i] = v / (1.0f + expf(-v)); }
        __syncthreads();
        float* MOD = (float*)(ws + WS_MOD);
        for (int item = BIDX(); item < 384; item += gridDim.x) {
            const int l = item / 96, n0 = (item % 96) * 64;
            const float* W = p->in[4] + (size_t)l * 1024 * 6144 + n0 + lane;
            float acc[9];
#pragma unroll
            for (int r = 0; r < 9; ++r) acc[r] = 0.f;
#pragma unroll 16
            for (int k = wave * 256; k < wave * 256 + 256; ++k) {
                const float w = W[(size_t)k * 6144];
#pragma unroll
                for (int r = 0; r < 9; ++r) acc[r] += s_sc[r * 1024 + k] * w;
            }
#pragma unroll
            for (int r = 0; r < 9; ++r) s_red[(wave * 9 + r) * 64 + lane] = acc[r];
            __syncthreads();
            for (int i = tid; i < 9 * 64; i += 256) {
                const int r = i >> 6, ln = i & 63;
                const float v = s_red[(0 * 9 + r) * 64 + ln] + s_red[(1 * 9 + r) * 64 + ln] + s_red[(2 * 9 + r) * 64 + ln] + s_red[(3 * 9 + r) * 64 + ln];
                MOD[(size_t)(l * 9 + r) * 6144 + n0 + ln] = v + p->in[5][l * 6144 + n0 + ln];
            }
            __syncthreads();
        }
    }
    {
        const int gt = BIDX() * 256 + tid, NT = gridDim.x * 256;
        float* ca = (float*)(ws + WS_ROPEA); float* sa = ca + 2048 * 64;
        for (int i = gt; i < 2048 * 64; i += NT) {
            const int t = i >> 6, f = i & 63; const int pos = f < 32 ? (t >> 6) : (t & 63); const int ff = f & 31;
            const float inv = powf(10000.0f, -(float)ff / 32.0f); const float a = (float)pos * inv;
            ca[i] = cosf(a); sa[i] = sinf(a);
        }
        float* cc_ = (float*)(ws + WS_ROPEC); float* sc_ = cc_ + 2048 * 32;
        for (int i = gt; i < 2048 * 32; i += NT) {
            const int t = i >> 5, f = i & 31; const int pos = f < 16 ? (t >> 6) : (t & 63); const int ff = f & 15;
            const float inv = powf(10000.0f, -(float)ff / 16.0f); const float a = (float)pos * inv;
            cc_[i] = cosf(a); sc_[i] = sinf(a);
        }
        float* wrt = (float*)(ws + WS_WRT);
        for (int i = gt; i < 4 * 36 * 1024; i += NT) {
            const int l = i / (36 * 1024), o = (i / 1024) % 36, k = i & 1023;
            wrt[i] = o < 4 ? p->in[25][((size_t)l * 1024 + k) * 4 + o] : p->in[27][((size_t)l * 1024 + k) * 32 + (o - 4)];
        }
        unsigned* wpad = (unsigned*)(ws + WS_WIN);
        for (int i = gt; i < 2 * 96 * 512; i += NT) { const int li = i / (96 * 512), r = i % (96 * 512); wpad[((size_t)li * NINP + NIN) * 512 + r] = 0u; }
    }
    __syncthreads();
    {
        float* scr = (float*)smem + wave * (64 * 33);
        constexpr int I_IN = 16 * 113, I_SQ = 16 * 32, I_QKV = 16 * 96, I_E = 256;
        constexpr int R0 = 2 * I_IN, R1 = R0 + 2 * I_SQ, R2 = R1 + 2 * I_QKV, R3 = R2 + 2 * I_SQ, R4 = R3 + 128 * I_E, R5 = R4 + 128 * I_E, R6 = R5 + 128 * I_E;
        for (int it = BIDX() * 4 + wave; it < R6; it += gridDim.x * 4) {
            if (it < R0) { const int i = it / I_IN, r = it % I_IN; tr_item<0>(p->in[10] + (size_t)i * 1024 * NIN, 1024, NIN, (bf16_t*)(ws + WS_WIN) + (size_t)i * NINP * 1024, scr, r, lane); }
            else if (it < R1) { const int q = it - R0, i = q / I_SQ, r = q % I_SQ; tr_item<0>(p->in[17] + (size_t)i * 1024 * 1024, 1024, 1024, (bf16_t*)(ws + WS_WABO) + (size_t)i * 1024 * 1024, scr, r, lane); }
            else if (it < R2) { const int q = it - R1, i = q / I_QKV, r = q % I_QKV; tr_item<0>(p->in[18] + (size_t)i * 1024 * 3072, 1024, 3072, (bf16_t*)(ws + WS_WQKV) + (size_t)i * 3072 * 1024, scr, r, lane); }
            else if (it < R3) { const int q = it - R2, i = q / I_SQ, r = q % I_SQ; tr_item<0>(p->in[24] + (size_t)i * 1024 * 1024, 1024, 1024, (bf16_t*)(ws + WS_WCO) + (size_t)i * 1024 * 1024, scr, r, lane); }
            else if (it < R4) { const int q = it - R3, le = q / I_E, r = q % I_E; tr_item<1>(p->in[29] + (size_t)le * 1024 * 512, 1024, 512, (bf16_t*)(ws + WS_WGU) + (size_t)le * 1024 * 1024, scr, r, lane); }
            else if (it < R5) { const int q = it - R4, le = q / I_E, r = q % I_E; tr_item<2>(p->in[30] + (size_t)le * 1024 * 512, 1024, 512, (bf16_t*)(ws + WS_WGU) + (size_t)le * 1024 * 1024, scr, r, lane); }
            else { const int q = it - R5, le = q / I_E, r = q % I_E; tr_item<0>(p->in[31] + (size_t)le * 512 * 1024, 512, 1024, (bf16_t*)(ws + WS_WD) + (size_t)le * 1024 * 512, scr, r, lane); }
        }
    }
}

DI void phase_pre1(KP p) {
    const int tid = TIDX(), wave = tid >> 6, lane = tid & 63;
    xres_t* X = (xres_t*)(p->ws + WS_X); bf16_t* U = (bf16_t*)(p->ws + WS_U); const float* MOD = (const float*)(p->ws + WS_MOD);
    for (int row = BIDX() * 4 + wave; row < MT; row += gridDim.x * 4) {
        const float* src = row < ML ? p->in[0] + (size_t)row * 1024 : p->in[2] + (size_t)(row - ML) * 1024;
        const int r = row < ML ? (row >> 11) : 8;
        const float* mod = MOD + (size_t)r * 6144;
#pragma unroll
        for (int j = 0; j < 4; ++j) {
            const int k = 256 * j + 4 * lane;
            const f32x4 v = *(const f32x4*)(src + k), sh = *(const f32x4*)(mod + k), sc = *(const f32x4*)(mod + 1024 + k);
            const f32x4 u = v * (1.0f + sc) + sh;
            u32x2 w; w.x = pk2(u[0], u[1]); w.y = pk2(u[2], u[3]);
            *(u32x2*)(U + (size_t)row * 1024 + k) = w;
        }
    }
}

DI void phase_g1e(KP p, int l, unsigned char* smem) {
    const int tid = TIDX(), wid = tid >> 6, lane = tid & 63, wr = wid >> 1, wc = wid & 1, fr = lane & 15, fq = lane >> 4;
    const int li = l >> 1;
    const bf16_t* U = (const bf16_t*)(p->ws + WS_U); const bf16_t* W = (const bf16_t*)(p->ws + WS_WIN) + (size_t)li * NINP * 1024;
    bf16_t* Z = (bf16_t*)(p->ws + WS_Z); float* LR = (float*)(p->ws + WS_LR);
    const float* ca = (const float*)(p->ws + WS_ROPEA); const float* sa = ca + 2048 * 64;
    constexpr int NTN = NINP / 128;
    auto decode = [&](int i, int& brow, int& bcol) -> bool {
        const int q = xcd_seq(i, (MT / 128) * NTN); if (q < 0) return false;
        int rt, nt; tile_seq(q, MT / 128, NTN, rt, nt); brow = rt * 128; bcol = nt * 128; return true; };
    auto epi = [&](int brow, int bcol, f32x4 (&acc)[4][4]) {
        const int colw = bcol + wc * 64;
        if (colw >= NIN) return;
        if (colw >= 3584) {
#pragma unroll
            for (int m = 0; m < 4; ++m) { const int row = brow + wr * 64 + m * 16 + fr;
#pragma unroll
                for (int n = 0; n < 2; ++n) *(f32x4*)(LR + (size_t)row * 32 + n * 16 + fq * 4) = acc[m][n]; }
            return;
        }
        const bool ropeR = colw < 1024; const int half = (colw >> 6) & 1;
        const float scale = colw < 512 ? 0.08838834764831845f : ((colw >= 2048 && colw < 2304) ? 0.125f : 1.0f);
#pragma unroll
        for (int m = 0; m < 4; ++m) {
            const int row = brow + wr * 64 + m * 16 + fr;
            if (ropeR && row < ML) {
                const int t = row & 2047;
#pragma unroll
                for (int n = 0; n < 2; ++n) {
                    const f32x4 c4 = *(const f32x4*)(ca + t * 64 + half * 32 + n * 16 + fq * 4), s4 = *(const f32x4*)(sa + t * 64 + half * 32 + n * 16 + fq * 4);
                    const f32x4 a = acc[m][n], b = acc[m][n + 2];
                    acc[m][n] = a * c4 - b * s4; acc[m][n + 2] = b * c4 + a * s4;
                }
            }
#pragma unroll
            for (int n = 0; n < 4; ++n) {
                const f32x4 v = acc[m][n] * scale; u32x2 w; w.x = pk2(v[0], v[1]); w.y = pk2(v[2], v[3]);
                *(u32x2*)(Z + (size_t)row * ZS + colw + n * 16 + fq * 4) = w;
            }
        }
    };
    int brow, bcol;
    if (!decode(0, brow, bcol)) return;
    const bf16_t* ap[4]; const bf16_t* bp[4]; const bf16_t* apn[4]; const bf16_t* bpn[4];
    gemm_rows(U, brow, 1024, tid, ap); gemm_rows(W, bcol, 1024, tid, bp);
    bool first = true;
    for (int i = 0;; ++i) {
        int nbrow = brow, nbcol = bcol; const bool hn = decode(i + 1, nbrow, nbcol);
        gemm_rows(U, nbrow, 1024, tid, apn); gemm_rows(W, nbcol, 1024, tid, bpn);
        f32x4 acc[4][4];
        gemm_tile<true>(smem, ap, bp, 1024, acc, first, hn, apn, bpn);
        epi(brow, bcol, acc);
        if (!hn) break;
        brow = nbrow; bcol = nbcol; GEMM_ADVANCE(); first = false;
    }
}

DI void phase_g1o(KP p, int l, unsigned char* smem) {
    const int tid = TIDX(), wid = tid >> 6, lane = tid & 63, wr = wid >> 1, wc = wid & 1, fr = lane & 15, fq = lane >> 4;
    const int li = l >> 1;
    const bf16_t* U = (const bf16_t*)(p->ws + WS_U); const bf16_t* W = (const bf16_t*)(p->ws + WS_WQKV) + (size_t)li * 3072 * 1024;
    bf16_t* Qc = (bf16_t*)(p->ws + WS_QC); bf16_t* Kc = (bf16_t*)(p->ws + WS_KC); bf16_t* Vt = (bf16_t*)(p->ws + WS_VT);
    const float* cc = (const float*)(p->ws + WS_ROPEC); const float* sc = cc + 2048 * 32;
    auto decode = [&](int i, int& brow, int& bcol) -> bool {
        const int q = xcd_seq(i, (MT / 128) * 24); if (q < 0) return false;
        int rt, nt; tile_seq(q, MT / 128, 24, rt, nt); brow = rt * 128; bcol = nt * 128; return true; };
    int brow, bcol;
    if (!decode(0, brow, bcol)) return;
    const bf16_t* ap[4]; const bf16_t* bp[4]; const bf16_t* apn[4]; const bf16_t* bpn[4];
    gemm_rows(U, brow, 1024, tid, ap); gemm_rows(W, bcol, 1024, tid, bp);
    bool first = true;
    for (int i = 0;; ++i) {
        int nbrow = brow, nbcol = bcol; const bool hn = decode(i + 1, nbrow, nbcol);
        gemm_rows(U, nbrow, 1024, tid, apn); gemm_rows(W, nbcol, 1024, tid, bpn);
        f32x4 acc[4][4];
        if (bcol < 2048) {
            gemm_tile<true>(smem, ap, bp, 1024, acc, first, hn, apn, bpn);
            const int colw = bcol + wc * 64; const bool isk = colw >= 1024; const int hc = (colw & 1023) >> 6;
            bf16_t* dst = isk ? Kc : Qc; const float scale = isk ? 1.0f : 0.125f;
#pragma unroll
            for (int m = 0; m < 4; ++m) {
                const int row = brow + wr * 64 + m * 16 + fr;
                int b, pidx;
                if (row < ML) {
                    b = row >> 11; const int t = row & 2047; pidx = 256 + t;
#pragma unroll
                    for (int n = 0; n < 4; n += 2) {
                        const f32x4 c4 = *(const f32x4*)(cc + t * 32 + (n >> 1) * 16 + fq * 4), s4 = *(const f32x4*)(sc + t * 32 + (n >> 1) * 16 + fq * 4);
                        const f32x4 a = acc[m][n], bb = acc[m][n + 1];
                        acc[m][n] = a * c4 - bb * s4; acc[m][n + 1] = bb * c4 + a * s4;
                    }
                } else { b = (row - ML) >> 8; pidx = (row - ML) & 255; }
                bf16_t* o = dst + ((size_t)(b * 16 + hc) * TA + pidx) * 64;
#pragma unroll
                for (int n = 0; n < 4; ++n) { const f32x4 v = acc[m][n] * scale; u32x2 w; w.x = pk2(v[0], v[1]); w.y = pk2(v[2], v[3]); *(u32x2*)(o + n * 16 + fq * 4) = w; }
            }
        } else {
            gemm_tile<false>(smem, ap, bp, 1024, acc, first, hn, apn, bpn);
#pragma unroll
            for (int m = 0; m < 4; ++m) {
                const int row = brow + wr * 64 + m * 16 + fq * 4;
                int b, pidx;
                if (row < ML) { b = row >> 11; pidx = 256 + (row & 2047); } else { b = (row - ML) >> 8; pidx = (row - ML) & 255; }
                const int ppos = (pidx & ~12) | ((pidx & 8) >> 1) | ((pidx & 4) << 1);
#pragma unroll
                for (int n = 0; n < 4; ++n) {
                    const int col = bcol - 2048 + wc * 64 + n * 16 + fr; const int h = col >> 7, d = col & 127;
                    const f32x4 v = acc[m][n]; u32x2 w; w.x = pk2(v[0], v[1]); w.y = pk2(v[2], v[3]);
                    *(u32x2*)(Vt + ((size_t)(b * 8 + h) * 128 + d) * TA + ppos) = w;
                }
            }
        }
        if (!hn) break;
        brow = nbrow; bcol = nbcol; GEMM_ADVANCE(); first = false;
    }
}

DI void phase_g2(KP p, int l, unsigned char* smem) {
    const int tid = TIDX(), wid = tid >> 6, lane = tid & 63, wr = wid >> 1, wc = wid & 1, fr = lane & 15, fq = lane >> 4;
    const int li = l >> 1;
    const bf16_t* Y = (const bf16_t*)(p->ws + WS_Y);
    const bf16_t* W = (const bf16_t*)(p->ws + ((l & 1) ? WS_WCO : WS_WABO)) + (size_t)li * 1024 * 1024;
    bf16_t* P = (bf16_t*)(p->ws + WS_P);
    const int nrt = (l == 3 ? ML : MT) / 128;
    auto decode = [&](int i, int& brow, int& bcol) -> bool {
        const int q = xcd_seq(i, nrt * 8); if (q < 0) return false;
        int rt, nt; tile_seq(q, nrt, 8, rt, nt); brow = rt * 128; bcol = nt * 128; return true; };
    int brow, bcol;
    if (!decode(0, brow, bcol)) return;
    const bf16_t* ap[4]; const bf16_t* bp[4]; const bf16_t* apn[4]; const bf16_t* bpn[4];
    gemm_rows(Y, brow, 1024, tid, ap); gemm_rows(W, bcol, 1024, tid, bp);
    bool first = true;
    for (int i = 0;; ++i) {
        int nbrow = brow, nbcol = bcol; const bool hn = decode(i + 1, nbrow, nbcol);
        gemm_rows(Y, nbrow, 1024, tid, apn); gemm_rows(W, nbcol, 1024, tid, bpn);
        f32x4 acc[4][4];
        gemm_tile<true>(smem, ap, bp, 1024, acc, first, hn, apn, bpn);
#pragma unroll
        for (int m = 0; m < 4; ++m) { const int row = brow + wr * 64 + m * 16 + fr;
#pragma unroll
            for (int n = 0; n < 4; ++n) { const f32x4 v = acc[m][n]; u32x2 w; w.x = pk2(v[0], v[1]); w.y = pk2(v[2], v[3]); *(u32x2*)(P + (size_t)row * 1024 + bcol + wc * 64 + n * 16 + fq * 4) = w; } }
        if (!hn) break;
        brow = nbrow; bcol = nbcol; GEMM_ADVANCE(); first = false;
    }
}

template <bool DRY>
DI void phase_ln1r(KP p, int l, unsigned char* smem) {
    constexpr int US = 1028;
    constexpr int RB = 12;
    float* Us = (float*)smem;
    float* Ps = Us + RB * US;
    const int tid = TIDX(), wave = tid >> 6, lane = tid & 63;
    const xres_t* X = (const xres_t*)(p->ws + WS_X); xres_t* Xo = (xres_t*)(p->ws + (DRY ? WS_OB : WS_X)); const bf16_t* P = (const bf16_t*)(p->ws + WS_P); bf16_t* U = (bf16_t*)(p->ws + (DRY ? WS_Y : WS_U));
    const float* MOD = (const float*)(p->ws + WS_MOD); const float* WrT = (const float*)(p->ws + WS_WRT) + (size_t)l * 36 * 1024;
    const float* lng = p->in[6] + l * 1024; const float* lnb = p->in[7] + l * 1024;
    const float* bgrp = p->in[26] + l * 4; const float* brex = p->in[28] + l * 32;
    unsigned* cnt = (unsigned*)(p->ws + WS_CTL) + l * 32 + (DRY ? 256 : 0); int* list = (int*)(p->ws + WS_LIST); float* slotw = (float*)(p->ws + WS_SLOTW);
    const int rows_total = (l == 3) ? ML : MT;
    const int mi = lane & 15, mq = lane >> 4;
    int pend_slot = -1, pend_e = 0; unsigned pend_pos = 0u;
    for (int it = BIDX(); it * RB < rows_total; it += gridDim.x) {
        const int row0 = it * RB + wave * 3;
#pragma unroll
        for (int rr = 0; rr < 3; ++rr) {
            const int rowr = row0 + rr; const bool rvalid = rowr < rows_total; const int row = rvalid ? rowr : rows_total - 1;
            const int r = row < ML ? (row >> 11) : 8;
            const float* mod = MOD + (size_t)(l * 9 + r) * 6144;
            f32x4 v[4]; float s = 0.f;
#pragma unroll
            for (int j = 0; j < 4; ++j) {
                const int k = 256 * j + 4 * lane;
                const f32x4 xv = (l == 0) ? *(const f32x4*)((row < ML ? p->in[0] + (size_t)row * 1024 : p->in[2] + (size_t)(row - ML) * 1024) + k) : xload(X + (size_t)row * 1024 + k);
                const f32x4 g1 = *(const f32x4*)(mod + 2048 + k);
                const u32x2 pw_ = *(const u32x2*)(P + (size_t)row * 1024 + k); const f32x4 pv = (f32x4){bflo(pw_.x), bfhi(pw_.x), bflo(pw_.y), bfhi(pw_.y)};
                v[j] = xv * ALPHA + g1 * pv; s += (v[j][0] + v[j][1]) + (v[j][2] + v[j][3]);
            }
            const float mean = wave_sum(s) * (1.0f / 1024.0f); float s2 = 0.f;
#pragma unroll
            for (int j = 0; j < 4; ++j) { v[j] = v[j] - mean; s2 += (v[j][0] * v[j][0] + v[j][1] * v[j][1]) + (v[j][2] * v[j][2] + v[j][3] * v[j][3]); }
            const float rstd = 1.0f / sqrtf(wave_sum(s2) * (1.0f / 1024.0f) + LN_EPS);
#pragma unroll
            for (int j = 0; j < 4; ++j) {
                const int k = 256 * j + 4 * lane;
                const f32x4 xn = v[j] * rstd * *(const f32x4*)(lng + k) + *(const f32x4*)(lnb + k);
                const f32x4 uu = xn * (1.0f + *(const f32x4*)(mod + 4096 + k)) + *(const f32x4*)(mod + 3072 + k);
                *(f32x4*)(Us + (wave * 3 + rr) * US + k) = uu;
                if (rvalid) {
                    xstore(Xo + (size_t)row * 1024 + k, xn);
                    u32x2 w; w.x = pk2(uu[0], uu[1]); w.y = pk2(uu[2], uu[3]);
                    *(u32x2*)(U + (size_t)row * 1024 + k) = w;
                }
            }
        }
        __syncthreads();
        {
            f32x4 acc[3] = {(f32x4){0.f, 0.f, 0.f, 0.f}, (f32x4){0.f, 0.f, 0.f, 0.f}, (f32x4){0.f, 0.f, 0.f, 0.f}};
            const float* ap = Us + (mi < RB ? mi : mi - RB) * US + 256 * wave + 4 * mq;
            const float* bp0 = WrT + (size_t)mi * 1024 + 256 * wave + 4 * mq;
            const float* bp1 = WrT + (size_t)(16 + mi) * 1024 + 256 * wave + 4 * mq;
            const float* bp2 = WrT + (size_t)(32 + (mi & 3)) * 1024 + 256 * wave + 4 * mq;
#pragma unroll 1
            for (int sb0 = 0; sb0 < 16; sb0 += 8) {
                f32x4 bv[8][3];
#pragma unroll
                for (int q = 0; q < 8; ++q) { bv[q][0] = *(const f32x4*)(bp0 + 16 * (sb0 + q)); bv[q][1] = *(const f32x4*)(bp1 + 16 * (sb0 + q)); bv[q][2] = *(const f32x4*)(bp2 + 16 * (sb0 + q)); }
                __builtin_amdgcn_sched_barrier(0);
#pragma unroll
                for (int q = 0; q < 8; ++q) {
                    const f32x4 a = *(const f32x4*)(ap + 16 * (sb0 + q));
#pragma unroll
                    for (int e = 0; e < 4; ++e) {
                        acc[0] = __builtin_amdgcn_mfma_f32_16x16x4f32(a[e], bv[q][0][e], acc[0], 0, 0, 0);
                        acc[1] = __builtin_amdgcn_mfma_f32_16x16x4f32(a[e], bv[q][1][e], acc[1], 0, 0, 0);
                        acc[2] = __builtin_amdgcn_mfma_f32_16x16x4f32(a[e], bv[q][2][e], acc[2], 0, 0, 0);
                    }
                }
            }
            if (mq < 3) {
#pragma unroll
                for (int nt = 0; nt < 3; ++nt)
#pragma unroll
                    for (int rg = 0; rg < 4; ++rg) Ps[(wave * RB + mq * 4 + rg) * 48 + nt * 16 + mi] = acc[nt][rg];
            }
        }
        __syncthreads();
        if (wave < 2) {
            const int r = wave * 8 + (lane >> 3), c = lane & 7;
            const int rq = r < RB ? r : RB - 1;
            const int row = it * RB + rq;
            float lgv[5];
#pragma unroll
            for (int k = 0; k < 5; ++k) {
                const int o = c + 8 * k; const int oo = o < 36 ? o : 35;
                lgv[k] = (Ps[(0 * RB + rq) * 48 + oo] + Ps[(1 * RB + rq) * 48 + oo]) + (Ps[(2 * RB + rq) * 48 + oo] + Ps[(3 * RB + rq) * 48 + oo]);
            }
            float gv = c < 4 ? lgv[0] + bgrp[c & 3] : -3.0e38f; int gi = c;
#pragma unroll
            for (int off = 1; off < 4; off <<= 1) {
                const float ov = __shfl_xor(gv, off); const int oi = __shfl_xor(gi, off);
                if (ov > gv || (ov == gv && oi < gi)) { gv = ov; gi = oi; }
            }
            const int src0 = lane & ~7;
            const float gmax = __shfl(gv, src0); const int grp = __shfl(gi, src0);
            float ge = c < 4 ? expf(lgv[0] + bgrp[c & 3] - gmax) : 0.f;
            ge += __shfl_xor(ge, 1); ge += __shfl_xor(ge, 2);
            const float gw = 1.0f / __shfl(ge, src0);
            const int j = (c + 4) & 7; const int kk = c >= 4 ? grp : grp + 1;
            float ev = lgv[0];
#pragma unroll
            for (int k = 1; k < 5; ++k) ev = (kk == k) ? lgv[k] : ev;
            ev += brex[grp * 8 + j];
            float v1 = ev; int i1 = j;
#pragma unroll
            for (int off = 1; off < 8; off <<= 1) {
                const float ov = __shfl_xor(v1, off); const int oi = __shfl_xor(i1, off);
                if (ov > v1 || (ov == v1 && oi < i1)) { v1 = ov; i1 = oi; }
            }
            float v2 = (j == i1) ? -3.0e38f : ev; int i2 = (j == i1) ? 99 : j;
#pragma unroll
            for (int off = 1; off < 8; off <<= 1) {
                const float ov = __shfl_xor(v2, off); const int oi = __shfl_xor(i2, off);
                if (ov > v2 || (ov == v2 && oi < i2)) { v2 = ov; i2 = oi; }
            }
            const float e2 = expf(v2 - v1);
            const float w1 = 1.0f / (1.0f + e2), w2 = e2 / (1.0f + e2);
            if (c < 2 && r < RB && row < rows_total) {
                if (pend_slot >= 0) list[(size_t)pend_e * NSLOT + pend_pos] = pend_slot;
                const int e = grp * 8 + (c ? i2 : i1); const float w = gw * (c ? w2 : w1);
                const int slot = row * 2 + c;
                slotw[slot] = w;
                pend_pos = atomicAdd(&cnt[e], 1u); pend_e = e; pend_slot = slot;
            }
        }
        __syncthreads();
    }
    if (pend_slot >= 0) list[(size_t)pend_e * NSLOT + pend_pos] = pend_slot;
}

DI void moe_prefix(KP p, int l, int* s_cnt, int* s_tb, int* s_rb) {
    const int tid = TIDX();
    const unsigned* cnt = (const unsigned*)(p->ws + WS_CTL) + l * 32;
    __syncthreads();
    if (tid < 32) s_cnt[tid] = (int)__hip_atomic_load(cnt + tid, __ATOMIC_RELAXED, __HIP_MEMORY_SCOPE_AGENT);
    __syncthreads();
    if (tid == 0) { int tb = 0; for (int e = 0; e < 32; ++e) { s_tb[e] = tb; s_rb[e] = tb * 128; tb += (s_cnt[e] + 127) >> 7; } s_tb[32] = tb; s_rb[32] = tb * 128; }
    __syncthreads();
}
DI void phase_mg1(KP p, int l, unsigned char* smem) {
    const int tid = TIDX(), wid = tid >> 6, lane = tid & 63, wr = wid >> 1, wc = wid & 1, fr = lane & 15, fq = lane >> 4;
    int* s_cnt = (int*)(smem + 65536 + 64); int* s_tb = s_cnt + 32; int* s_rb = s_tb + 33;
    moe_prefix(p, l, s_cnt, s_tb, s_rb);
    const bf16_t* U = (const bf16_t*)(p->ws + WS_U); const int* list = (const int*)(p->ws + WS_LIST);
    bf16_t* H = (bf16_t*)(p->ws + WS_H);
    const int ntiles = s_tb[32] * 8;
    struct TI { int e, rt, nt, cnt_e; };
    auto decode = [&](int i, TI& t) -> bool {
        const int tile = xcd_seq(i, ntiles); if (tile < 0) return false;
        const int rtg = tile >> 3; t.nt = tile & 7;
        int e = 0;
        for (int q = 1; q < 32; ++q) if (rtg >= s_tb[q]) e = q;
        t.e = e; t.rt = rtg - s_tb[e]; t.cnt_e = s_cnt[e]; return true; };
    auto rows = [&](const TI& t, const bf16_t* (&a)[4], const bf16_t* (&b)[4]) {
#pragma unroll
        for (int i_ = 0; i_ < 4; ++i_) {
            const int pos = t.rt * 128 + (tid >> 3) + 32 * i_;
            const int tok = pos < t.cnt_e ? (list[(size_t)t.e * NSLOT + pos] >> 1) : 0;
            a[i_] = U + (size_t)tok * 1024 + gemm_chunk(tid) * 8;
        }
        gemm_rows((const bf16_t*)(p->ws + WS_WGU) + (size_t)(l * 32 + t.e) * 1024 * 1024, t.nt * 128, 1024, tid, b); };
    TI cur, nxt;
    if (!decode(0, cur)) return;
    const bf16_t* ap[4]; const bf16_t* bp[4]; const bf16_t* apn[4]; const bf16_t* bpn[4];
    rows(cur, ap, bp);
    bool first = true;
    for (int i = 0;; ++i) {
        nxt = cur; const bool hn = decode(i + 1, nxt);
        rows(nxt, apn, bpn);
        f32x4 acc[4][4];
        gemm_tile<true>(smem, ap, bp, 1024, acc, first, hn, apn, bpn);
        const int hrow0 = s_rb[cur.e] + cur.rt * 128 + wr * 64;
#pragma unroll
        for (int m = 0; m < 4; ++m) {
            bf16_t* o = H + (size_t)(hrow0 + m * 16 + fr) * 512 + cur.nt * 64 + wc * 32 + fq * 4;
#pragma unroll
            for (int n = 0; n < 4; n += 2) {
                const f32x4 g = acc[m][n], uu = acc[m][n + 1]; f32x4 h;
#pragma unroll
                for (int j = 0; j < 4; ++j) h[j] = siluf(g[j]) * uu[j];
                u32x2 w; w.x = pk2(h[0], h[1]); w.y = pk2(h[2], h[3]);
                *(u32x2*)(o + (n >> 1) * 16) = w;
            }
        }
        if (!hn) break;
        cur = nxt; GEMM_ADVANCE(); first = false;
    }
}
DI void phase_mg2(KP p, int l, unsigned char* smem) {
    const int tid = TIDX(), wid = tid >> 6, lane = tid & 63, wr = wid >> 1, wc = wid & 1, fr = lane & 15, fq = lane >> 4;
    int* s_cnt = (int*)(smem + 65536 + 64); int* s_tb = s_cnt + 32; int* s_rb = s_tb + 33;
    moe_prefix(p, l, s_cnt, s_tb, s_rb);
    const bf16_t* H = (const bf16_t*)(p->ws + WS_H); const int* list = (const int*)(p->ws + WS_LIST); const float* slotw = (const float*)(p->ws + WS_SLOTW);
    bf16_t* YS = (bf16_t*)(p->ws + WS_YS);
    const int ntiles = s_tb[32] * 8;
    struct TI { int e, rt, nt, cnt_e; };
    auto decode = [&](int i, TI& t) -> bool {
        const int tile = xcd_seq(i, ntiles); if (tile < 0) return false;
        const int rtg = tile >> 3; t.nt = tile & 7;
        int e = 0;
        for (int q = 1; q < 32; ++q) if (rtg >= s_tb[q]) e = q;
        t.e = e; t.rt = rtg - s_tb[e]; t.cnt_e = s_cnt[e]; return true; };
    auto rows = [&](const TI& t, const bf16_t* (&a)[4], const bf16_t* (&b)[4]) {
        gemm_rows(H, s_rb[t.e] + t.rt * 128, 512, tid, a);
        gemm_rows((const bf16_t*)(p->ws + WS_WD) + (size_t)(l * 32 + t.e) * 1024 * 512, t.nt * 128, 512, tid, b); };
    TI cur, nxt;
    if (!decode(0, cur)) return;
    const bf16_t* ap[4]; const bf16_t* bp[4]; const bf16_t* apn[4]; const bf16_t* bpn[4];
    rows(cur, ap, bp);
    bool first = true;
    for (int i = 0;; ++i) {
        nxt = cur; const bool hn = decode(i + 1, nxt);
        rows(nxt, apn, bpn);
        int eslot[4]; float ew[4];
#pragma unroll
        for (int m = 0; m < 4; ++m) {
            const int pos = cur.rt * 128 + wr * 64 + m * 16 + fr;
            eslot[m] = pos < cur.cnt_e ? list[(size_t)cur.e * NSLOT + pos] : -1;
        }
#pragma unroll
        for (int m = 0; m < 4; ++m) ew[m] = eslot[m] >= 0 ? slotw[eslot[m]] : 0.f;
        f32x4 acc[4][4];
        gemm_tile<true>(smem, ap, bp, 512, acc, first, hn, apn, bpn);
#pragma unroll
        for (int m = 0; m < 4; ++m) {
            if (eslot[m] >= 0) {
                const int slot = eslot[m]; const float w = ew[m];
                bf16_t* o = YS + (size_t)slot * 1024 + cur.nt * 128 + wc * 64 + fq * 4;
#pragma unroll
                for (int n = 0; n < 4; ++n) { const f32x4 v = acc[m][n] * w; u32x2 ww; ww.x = pk2(v[0], v[1]); ww.y = pk2(v[2], v[3]); *(u32x2*)(o + n * 16) = ww; }
            }
        }
        if (!hn) break;
        cur = nxt; GEMM_ADVANCE(); first = false;
    }
}

template <bool DRY>
DI void phase_ln2(KP p, int l) {
    const int tid = TIDX(), wave = tid >> 6, lane = tid & 63;
    const xres_t* X = (const xres_t*)(p->ws + WS_X); xres_t* Xo = (xres_t*)(p->ws + (DRY ? WS_OB : WS_X)); const bf16_t* YS = (const bf16_t*)(p->ws + WS_YS); bf16_t* U = (bf16_t*)(p->ws + (DRY ? WS_Y : WS_U));
    const float* MOD = (const float*)(p->ws + WS_MOD);
    const float* lng = p->in[8] + l * 1024; const float* lnb = p->in[9] + l * 1024;
    const int rows_total = (l == 3) ? ML : MT;
    for (int row0 = (BIDX() * 4 + wave) * 2; row0 < rows_total; row0 += gridDim.x * 8) {
        f32x4 v[2][4]; float s[2] = {0.f, 0.f};
        const float* mod[2];
#pragma unroll
        for (int q = 0; q < 2; ++q) {
            const int row = row0 + q; const int r = row < ML ? (row >> 11) : 8;
            mod[q] = MOD + (size_t)(l * 9 + r) * 6144;
#pragma unroll
            for (int j = 0; j < 4; ++j) {
                const int k = 256 * j + 4 * lane;
                const u32x2 y0 = *(const u32x2*)(YS + (size_t)(2 * row) * 1024 + k), y1 = *(const u32x2*)(YS + (size_t)(2 * row + 1) * 1024 + k);
                f32x4 y; y[0] = bflo(y0.x) + bflo(y1.x); y[1] = bfhi(y0.x) + bfhi(y1.x); y[2] = bflo(y0.y) + bflo(y1.y); y[3] = bfhi(y0.y) + bfhi(y1.y);
                const f32x4 xv = xload(X + (size_t)row * 1024 + k), g2 = *(const f32x4*)(mod[q] + 5120 + k);
                v[q][j] = xv * ALPHA + g2 * y; s[q] += (v[q][j][0] + v[q][j][1]) + (v[q][j][2] + v[q][j][3]);
            }
        }
        float mean[2], rstd[2];
#pragma unroll
        for (int q = 0; q < 2; ++q) mean[q] = wave_sum(s[q]) * (1.0f / 1024.0f);
#pragma unroll
        for (int q = 0; q < 2; ++q) {
            float s2 = 0.f;
#pragma unroll
            for (int j = 0; j < 4; ++j) { v[q][j] = v[q][j] - mean[q]; s2 += (v[q][j][0] * v[q][j][0] + v[q][j][1] * v[q][j][1]) + (v[q][j][2] * v[q][j][2] + v[q][j][3] * v[q][j][3]); }
            s[q] = s2;
        }
#pragma unroll
        for (int q = 0; q < 2; ++q) rstd[q] = 1.0f / sqrtf(wave_sum(s[q]) * (1.0f / 1024.0f) + LN_EPS);
#pragma unroll
        for (int q = 0; q < 2; ++q) {
            const int row = row0 + q;
            const float* modn = mod[q] + (l + 1 < 4 ? 9 * 6144 : 0);
#pragma unroll
            for (int j = 0; j < 4; ++j) {
                const int k = 256 * j + 4 * lane;
                const f32x4 xn = v[q][j] * rstd[q] * *(const f32x4*)(lng + k) + *(const f32x4*)(lnb + k);
                if (l < 3) {
                    xstore(Xo + (size_t)row * 1024 + k, xn);
                    const f32x4 uu = xn * (1.0f + *(const f32x4*)(modn + 1024 + k)) + *(const f32x4*)(modn + k);
                    u32x2 w; w.x = pk2(uu[0], uu[1]); w.y = pk2(uu[2], uu[3]);
                    *(u32x2*)(U + (size_t)row * 1024 + k) = w;
                } else {
                    *(f32x4*)(p->out + (size_t)row * 1024 + k) = xn;
                }
            }
        }
    }
}

DI s16x4 tr_read(const unsigned char* ptr) {
    typedef short v4i16_t __attribute__((ext_vector_type(4)));
    return __builtin_bit_cast(s16x4, __builtin_amdgcn_ds_read_tr16_b64_v4i16((LAS v4i16_t*)ptr));
}
DI bf16x8 cat8(s16x4 a, s16x4 b) { return __builtin_shufflevector(a, b, 0, 1, 2, 3, 4, 5, 6, 7); }

DI void phase_decay(KP p, int l, unsigned char* smem) {
    const int tid = TIDX();
    const int li = l >> 1;
    const float* LR = (const float*)(p->ws + WS_LR);
    float* PF = (float*)(p->ws + WS_PF); float* SQ = (float*)(p->ws + WS_SQ); float* SK = (float*)(p->ws + WS_SK); float* TOT = (float*)(p->ws + WS_TOT);
    float* lrs = (float*)smem;
    float wf[16], wb[16];
#pragma unroll
    for (int r = 0; r < 16; ++r) { wf[r] = p->in[11][(size_t)li * 16 * 256 + r * 256 + tid]; wb[r] = p->in[13][(size_t)li * 16 * 256 + r * 256 + tid]; }
    const float bf = p->in[12][li * 256 + tid], bb = p->in[14][li * 256 + tid];
    for (int it = BIDX(); it < 2 * (MT / 64); it += gridDim.x) {
        const int ch = it >> 1, dr = it & 1;
        const int row0 = ch * 64;
        __syncthreads();
        { const int tok = tid >> 2, q4 = tid & 3; *(f32x4*)(lrs + tok * 16 + q4 * 4) = *(const f32x4*)(LR + (size_t)(row0 + tok) * 32 + dr * 16 + q4 * 4); }
        __syncthreads();
        float run = 0.f;
        if (dr == 0) {
            for (int t = 0; t < 64; ++t) {
                float g = bf;
#pragma unroll
                for (int r = 0; r < 16; ++r) g += lrs[t * 16 + r] * wf[r];
                run += (fminf(g, 0.f) - __logf(1.0f + __expf(-fabsf(g)))) * (1.0f / 16.0f);
                PF[(size_t)(row0 + t) * 256 + tid] = run;
            }
        } else {
            for (int t = 63; t >= 0; --t) {
                float g = bb;
#pragma unroll
                for (int r = 0; r < 16; ++r) g += lrs[t * 16 + r] * wb[r];
                SQ[(size_t)(row0 + t) * 256 + tid] = run;
                run += (fminf(g, 0.f) - __logf(1.0f + __expf(-fabsf(g)))) * (1.0f / 16.0f);
                SK[(size_t)(row0 + t) * 256 + tid] = run;
            }
        }
        TOT[(size_t)(ch * 2 + dr) * 256 + tid] = run;
    }
}

template <int DK>
DI void scan_item(KP p, int l, int item, unsigned char* smem) {
    constexpr bool ISA = (DK == 128);
    constexpr int QS = DK * 2 + 16, KS = DK * 2 + 32, VS = 96, AS_ = 144, SS = DK * 2 + 16, NKS = DK / 32, NMT = DK / 64;
    constexpr int O_QD = 0, O_KD = O_QD + 64 * QS, O_V = O_KD + 64 * KS, O_ATT = O_V + 64 * VS, O_ST = O_ATT + 64 * AS_, O_END = O_ST + 32 * SS;
    static_assert(O_END <= 65536, "scan LDS");
    constexpr int NP = DK / 64 * 2;
    constexpr int CPR = DK / 8;
    const int tid = TIDX(), wid = tid >> 6, lane = tid & 63, fr = lane & 15, fq = lane >> 4;
    const int b = item >> 5, h = (item >> 3) & 3, dir = (item >> 2) & 1, dvq = item & 3;
    const bf16_t* Z = (const bf16_t*)(p->ws + WS_Z);
    const float* EQ = (const float*)(p->ws + (dir ? WS_SQ : WS_PF)); const float* EK = (const float*)(p->ws + (dir ? WS_SK : WS_PF)); const float* TOT = (const float*)(p->ws + WS_TOT);
    bf16_t* OUT = (bf16_t*)(p->ws + (dir ? WS_OB : WS_OF));
    const int qcol = ISA ? h * 128 : 2048 + h * 64, kcol = ISA ? 512 + h * 128 : 2304 + h * 64, vcol = (ISA ? 1024 : 2560) + h * 128 + dvq * 32;
    const int ocol = (ISA ? 0 : 512) + h * 128 + dvq * 32;
    float lam = 0.f;
    if (ISA) lam = log1pf(-exp2f(-((dir ? 5.5f : 5.0f) + (float)h)));
    f32x4 S[NMT][2];
#pragma unroll
    for (int a = 0; a < NMT; ++a) { S[a][0] = (f32x4){0.f, 0.f, 0.f, 0.f}; S[a][1] = (f32x4){0.f, 0.f, 0.f, 0.f}; }
    __syncthreads();
    for (int i = tid; i < 32 * SS / 4; i += 256) ((unsigned*)(smem + O_ST))[i] = 0u;
    auto chunk_row0 = [&](int cc) -> int {
        const int ci = dir ? 35 - cc : cc; const int pp = ci * 64;
        if (!dir) return pp < 256 ? ML + b * 256 + pp : b * 2048 + (pp - 256);
        return pp < 2048 ? b * 2048 + pp : ML + b * 256 + (pp - 2048);
    };
    u32x4 rq[NP], rk[NP], rv; f32x4 eq[ISA ? 1 : NP][2], ek[ISA ? 1 : NP][2]; f32x4 tv[NMT];
    auto fetch = [&](int cc) {
        const int row0 = chunk_row0(cc);
        if (!ISA) {
#pragma unroll
            for (int a = 0; a < NMT; ++a) tv[a] = *(const f32x4*)(TOT + (size_t)((row0 >> 6) * 2 + dir) * 256 + h * 64 + (wid * NMT + a) * 16 + fq * 4);
        }
#pragma unroll
        for (int i = 0; i < NP; ++i) {
            const int id = tid + 256 * i, tok = id / CPR, cg_ = id % CPR;
            const size_t ro = (size_t)(row0 + tok) * ZS;
            rq[i] = *(const u32x4*)(Z + ro + qcol + cg_ * 8); rk[i] = *(const u32x4*)(Z + ro + kcol + cg_ * 8);
            if (!ISA) {
                const size_t eo = (size_t)(row0 + tok) * 256 + h * 64 + cg_ * 8;
                eq[i][0] = *(const f32x4*)(EQ + eo); eq[i][1] = *(const f32x4*)(EQ + eo + 4);
                ek[i][0] = *(const f32x4*)(EK + eo); ek[i][1] = *(const f32x4*)(EK + eo + 4);
            }
        }
        { const int tok = tid >> 2, cg_ = tid & 3; rv = *(const u32x4*)(Z + (size_t)(row0 + tok) * ZS + vcol + cg_ * 8); }
    };
    float ra[NP], rc[NP];
#pragma unroll
    for (int i = 0; i < NP; ++i) {
        const int tok = (tid + 256 * i) / CPR;
        ra[i] = dir ? __expf(lam * (float)(63 - tok)) : __expf(lam * (float)(tok + 1));
        rc[i] = dir ? __expf(-lam * (float)(64 - tok)) : __expf(-lam * (float)(tok + 1));
    }
    const float decA = __expf(lam * 64.0f);
    fetch(0);
    for (int cc = 0; cc < 36; ++cc) {
        const int row0 = chunk_row0(cc);
#pragma unroll
        for (int i = 0; i < NP; ++i) {
            const int id = tid + 256 * i, tok = id / CPR, cg_ = id % CPR;
            float fqv[8], fkv[8];
            if (ISA) {
#pragma unroll
                for (int e = 0; e < 8; ++e) { fqv[e] = ra[i]; fkv[e] = rc[i]; }
            } else {
#pragma unroll
                for (int e = 0; e < 8; ++e) { fqv[e] = __expf(eq[i][e >> 2][e & 3]); fkv[e] = __expf(-ek[i][e >> 2][e & 3]); }
            }
            const u32x4 q = rq[i], k = rk[i]; u32x4 qo, ko;
            qo.x = pk2(bflo(q.x) * fqv[0], bfhi(q.x) * fqv[1]); qo.y = pk2(bflo(q.y) * fqv[2], bfhi(q.y) * fqv[3]); qo.z = pk2(bflo(q.z) * fqv[4], bfhi(q.z) * fqv[5]); qo.w = pk2(bflo(q.w) * fqv[6], bfhi(q.w) * fqv[7]);
            ko.x = pk2(bflo(k.x) * fkv[0], bfhi(k.x) * fkv[1]); ko.y = pk2(bflo(k.y) * fkv[2], bfhi(k.y) * fkv[3]); ko.z = pk2(bflo(k.z) * fkv[4], bfhi(k.z) * fkv[5]); ko.w = pk2(bflo(k.w) * fkv[6], bfhi(k.w) * fkv[7]);
            *(u32x4*)(smem + O_QD + tok * QS + cg_ * 16) = qo;
            *(u32x4*)(smem + O_KD + tok * KS + cg_ * 16) = ko;
        }
        { const int tok = tid >> 2, cg_ = tid & 3; *(u32x4*)(smem + O_V + tok * VS + cg_ * 16) = rv; }
        f32x4 dec[NMT];
#pragma unroll
        for (int a = 0; a < NMT; ++a) {
            if (ISA) dec[a] = (f32x4){decA, decA, decA, decA};
            else dec[a] = (f32x4){__expf(tv[a][0]), __expf(tv[a][1]), __expf(tv[a][2]), __expf(tv[a][3])};
        }
        if (cc + 1 < 36) fetch(cc + 1);
        __syncthreads();
        bf16x8 afr[2];
        {
            f32x4 at[4];
#pragma unroll
            for (int n = 0; n < 4; ++n) at[n] = (f32x4){0.f, 0.f, 0.f, 0.f};
#pragma unroll
            for (int ks = 0; ks < NKS; ++ks) {
                const bf16x8 qf = *(const bf16x8*)(smem + O_QD + (16 * wid + fr) * QS + (32 * ks + 8 * fq) * 2);
#pragma unroll
                for (int n = 0; n < 4; ++n) {
                    const bf16x8 kf = *(const bf16x8*)(smem + O_KD + (16 * n + fr) * KS + (32 * ks + 8 * fq) * 2);
                    at[n] = __builtin_amdgcn_mfma_f32_16x16x32_bf16(kf, qf, at[n], 0, 0, 0);
                }
            }
            const int i = 16 * wid + fr;
#pragma unroll
            for (int n = 0; n < 4; ++n)
#pragma unroll
                for (int jj = 0; jj < 4; ++jj) { const int j = n * 16 + fq * 4 + jj; const bool keep = dir ? (j > i) : (j <= i); at[n][jj] = keep ? at[n][jj] : 0.f; }
#pragma unroll
            for (int ks = 0; ks < 2; ++ks) {
                u32x4 w; w.x = pk2(at[2 * ks][0], at[2 * ks][1]); w.y = pk2(at[2 * ks][2], at[2 * ks][3]); w.z = pk2(at[2 * ks + 1][0], at[2 * ks + 1][1]); w.w = pk2(at[2 * ks + 1][2], at[2 * ks + 1][3]);
                afr[ks] = __builtin_bit_cast(bf16x8, w);
            }
        }
        bf16x8 vf[2][2];
        {
            const int g = lane >> 4, i16 = lane & 15, q = i16 >> 2, pq = i16 & 3;
#pragma unroll
            for (int ks = 0; ks < 2; ++ks)
#pragma unroll
                for (int n = 0; n < 2; ++n) {
                    const unsigned char* a = smem + O_V + (32 * ks + 4 * g + q) * VS + (n * 16 + 4 * pq) * 2;
                    vf[ks][n] = cat8(tr_read(a), tr_read(a + 16 * VS));
                }
        }
        {
            f32x4 oa[2] = {(f32x4){0.f, 0.f, 0.f, 0.f}, (f32x4){0.f, 0.f, 0.f, 0.f}};
#pragma unroll
            for (int ks = 0; ks < 2; ++ks)
#pragma unroll
                for (int n = 0; n < 2; ++n) oa[n] = __builtin_amdgcn_mfma_f32_16x16x32_bf16(vf[ks][n], afr[ks], oa[n], 0, 0, 0);
#pragma unroll
            for (int ks = 0; ks < NKS; ++ks) {
                const bf16x8 qf = *(const bf16x8*)(smem + O_QD + (16 * wid + fr) * QS + (32 * ks + 8 * fq) * 2);
#pragma unroll
                for (int n = 0; n < 2; ++n) {
                    const bf16x8 sf = *(const bf16x8*)(smem + O_ST + (16 * n + fr) * SS + (32 * ks + 8 * fq) * 2);
                    oa[n] = __builtin_amdgcn_mfma_f32_16x16x32_bf16(sf, qf, oa[n], 0, 0, 0);
                }
            }
            bf16_t* o = OUT + (size_t)(row0 + 16 * wid + fr) * 1024 + ocol + fq * 4;
            u32x2 w0, w1; w0.x = pk2(oa[0][0], oa[0][1]); w0.y = pk2(oa[0][2], oa[0][3]); w1.x = pk2(oa[1][0], oa[1][1]); w1.y = pk2(oa[1][2], oa[1][3]);
            *(u32x2*)(o) = w0; *(u32x2*)(o + 16) = w1;
        }
        {
            const int g = lane >> 4, i16 = lane & 15, q = i16 >> 2, pq = i16 & 3;
#pragma unroll
            for (int a = 0; a < NMT; ++a) {
                const int mt = wid * NMT + a;
#pragma unroll
                for (int ks = 0; ks < 2; ++ks) {
                    const unsigned char* ka = smem + O_KD + (32 * ks + 4 * g + q) * KS + (mt * 16 + 4 * pq) * 2;
                    const bf16x8 kf = cat8(tr_read(ka), tr_read(ka + 16 * KS));
#pragma unroll
                    for (int n = 0; n < 2; ++n) S[a][n] = __builtin_amdgcn_mfma_f32_16x16x32_bf16(kf, vf[ks][n], S[a][n], 0, 0, 0);
                }
                S[a][0] *= dec[a]; S[a][1] *= dec[a];
            }
        }
        __syncthreads();
#pragma unroll
        for (int a = 0; a < NMT; ++a) {
            const int mt = wid * NMT + a;
#pragma unroll
            for (int n = 0; n < 2; ++n) { u32x2 w; w.x = pk2(S[a][n][0], S[a][n][1]); w.y = pk2(S[a][n][2], S[a][n][3]); *(u32x2*)(smem + O_ST + (n * 16 + fr) * SS + (mt * 16 + fq * 4) * 2) = w; }
        }
    }
    __syncthreads();
}
DI void phase_scan(KP p, int l, unsigned char* smem) {
    for (int it = BIDX(); it < 512; it += gridDim.x) {
        if (it < 256) scan_item<128>(p, l, it, smem); else scan_item<64>(p, l, it - 256, smem);
    }
}

DI void phase_merge(KP p, int l) {
    const int tid = TIDX(), wave = tid >> 6, lane = tid & 63;
    const int li = l >> 1;
    const bf16_t* OF = (const bf16_t*)(p->ws + WS_OF); const bf16_t* OB = (const bf16_t*)(p->ws + WS_OB);
    const bf16_t* Z = (const bf16_t*)(p->ws + WS_Z); bf16_t* Y = (bf16_t*)(p->ws + WS_Y);
    const bool isA = lane < 32;
    const float* gn = isA ? p->in[15] + li * 512 + lane * 16 : p->in[16] + li * 512 + (lane - 32) * 16;
    const int gcol = isA ? 1536 + lane * 16 : 3072 + (lane - 32) * 16;
    for (int row = BIDX() * 4 + wave; row < MT; row += gridDim.x * 4) {
        float o[16]; float s = 0.f;
#pragma unroll
        for (int j = 0; j < 2; ++j) {
            const u32x4 a = *(const u32x4*)(OF + (size_t)row * 1024 + lane * 16 + j * 8), bb = *(const u32x4*)(OB + (size_t)row * 1024 + lane * 16 + j * 8);
            o[j * 8 + 0] = bflo(a.x) + bflo(bb.x); o[j * 8 + 1] = bfhi(a.x) + bfhi(bb.x); o[j * 8 + 2] = bflo(a.y) + bflo(bb.y); o[j * 8 + 3] = bfhi(a.y) + bfhi(bb.y);
            o[j * 8 + 4] = bflo(a.z) + bflo(bb.z); o[j * 8 + 5] = bfhi(a.z) + bfhi(bb.z); o[j * 8 + 6] = bflo(a.w) + bflo(bb.w); o[j * 8 + 7] = bfhi(a.w) + bfhi(bb.w);
        }
#pragma unroll
        for (int e = 0; e < 16; ++e) s += o[e];
        s += __shfl_xor(s, 1); s += __shfl_xor(s, 2); s += __shfl_xor(s, 4);
        const float mean = isA ? s * (1.0f / 128.0f) : 0.f;
        float s2 = 0.f;
#pragma unroll
        for (int e = 0; e < 16; ++e) { o[e] -= mean; s2 += o[e] * o[e]; }
        s2 += __shfl_xor(s2, 1); s2 += __shfl_xor(s2, 2); s2 += __shfl_xor(s2, 4);
        const float rs = 1.0f / sqrtf(s2 * (1.0f / 128.0f) + LN_EPS);
        const u32x4 g0 = *(const u32x4*)(Z + (size_t)row * ZS + gcol), g1 = *(const u32x4*)(Z + (size_t)row * ZS + gcol + 8);
        float gt[16];
        gt[0] = bflo(g0.x); gt[1] = bfhi(g0.x); gt[2] = bflo(g0.y); gt[3] = bfhi(g0.y); gt[4] = bflo(g0.z); gt[5] = bfhi(g0.z); gt[6] = bflo(g0.w); gt[7] = bfhi(g0.w);
        gt[8] = bflo(g1.x); gt[9] = bfhi(g1.x); gt[10] = bflo(g1.y); gt[11] = bfhi(g1.y); gt[12] = bflo(g1.z); gt[13] = bfhi(g1.z); gt[14] = bflo(g1.w); gt[15] = bfhi(g1.w);
        float y[16];
#pragma unroll
        for (int e = 0; e < 16; ++e) y[e] = siluf(gt[e]) * (o[e] * rs * gn[e]);
        u32x4 w0, w1;
        w0.x = pk2(y[0], y[1]); w0.y = pk2(y[2], y[3]); w0.z = pk2(y[4], y[5]); w0.w = pk2(y[6], y[7]);
        w1.x = pk2(y[8], y[9]); w1.y = pk2(y[10], y[11]); w1.z = pk2(y[12], y[13]); w1.w = pk2(y[14], y[15]);
        *(u32x4*)(Y + (size_t)row * 1024 + lane * 16) = w0; *(u32x4*)(Y + (size_t)row * 1024 + lane * 16 + 8) = w1;
    }
}

DI int crow(int r, int hi) { return (r & 3) + 8 * (r >> 2) + 4 * hi; }
constexpr int ATT_BUF = 24576;
DI void att_component(const bf16_t* Qc, const bf16_t* Kc, const bf16_t* Vt, unsigned char* smem, float* wsf, int b, int h, int comp, int p0, int nkv, f32x16 (&O)[4]) {
    const int tid = TIDX(), wid = tid >> 6, lane = tid & 63, r32 = lane & 31, hi = lane >> 5;
    const int hc = h * 2 + comp;
    const bf16_t* Qb = Qc + ((size_t)(b * 16 + hc) * TA + p0 + wid * 32 + r32) * 64;
    const int gch = gemm_chunk(tid);
    const bf16_t* Kg = Kc + (size_t)(b * 16 + hc) * TA * 64 + (size_t)(tid >> 3) * 64 + gch * 8;
    const bf16_t* Vg = Vt + (size_t)(b * 8 + h) * 128 * TA + (size_t)(tid >> 3) * TA + gch * 8;
#define ATT_STAGE(buf, kt) do { \
        _Pragma("unroll") for (int i_ = 0; i_ < 2; ++i_) __builtin_amdgcn_global_load_lds((const unsigned*)(Kg + (size_t)((kt) + 32 * i_) * 64), (LAS unsigned*)(smem + (buf) * ATT_BUF + i_ * 4096 + tid * 16), 16, 0, 0); \
        _Pragma("unroll") for (int i_ = 0; i_ < 4; ++i_) __builtin_amdgcn_global_load_lds((const unsigned*)(Vg + (size_t)(32 * i_) * TA + (kt)), (LAS unsigned*)(smem + (buf) * ATT_BUF + 8192 + i_ * 4096 + tid * 16), 16, 0, 0); } while (0)
    ATT_STAGE(0, 0);
    bf16x8 qf[4];
#pragma unroll
    for (int ks = 0; ks < 4; ++ks) qf[ks] = *(const bf16x8*)(Qb + ks * 16 + hi * 8);
#pragma unroll
    for (int d0 = 0; d0 < 4; ++d0)
#pragma unroll
        for (int r = 0; r < 16; ++r) O[d0][r] = 0.f;
    float m_run = -1.0e30f, l_run = 0.f;
    const int sw = (r32 >> 1) & 7;
    const int nt = nkv >> 6;
    for (int t = 0; t < nt; ++t) {
        asm volatile("s_waitcnt vmcnt(0)" ::: "memory");
        __syncthreads();
        if (t + 1 < nt) ATT_STAGE((t + 1) & 1, (t + 1) * 64);
        const unsigned char* Kt = smem + (t & 1) * ATT_BUF; const unsigned char* Vtl = Kt + 8192;
        bf16x8 kf0[4], kf1[4];
#pragma unroll
        for (int ks = 0; ks < 4; ++ks) {
            const unsigned co = (unsigned)(((ks * 2 + hi) ^ sw) << 4);
            kf0[ks] = *(const bf16x8*)(Kt + r32 * 128 + co);
            kf1[ks] = *(const bf16x8*)(Kt + (32 + r32) * 128 + co);
        }
        const unsigned char* vr = Vtl + r32 * 128;
#define ATT_VLOAD(dst, st_) do { const unsigned o1_ = (unsigned)((((st_) * 2 + hi) ^ sw) << 4); \
        _Pragma("unroll") for (int d0_ = 0; d0_ < 4; ++d0_) dst[d0_] = *(const bf16x8*)(vr + d0_ * 4096 + o1_); } while (0)
        bf16x8 va[4], vb[4];
        ATT_VLOAD(va, 0);
        f32x16 s0, s1;
#pragma unroll
        for (int r = 0; r < 16; ++r) { s0[r] = 0.f; s1[r] = 0.f; }
#pragma unroll
        for (int ks = 0; ks < 4; ++ks) {
            s0 = __builtin_amdgcn_mfma_f32_32x32x16_bf16(kf0[ks], qf[ks], s0, 0, 0, 0);
            s1 = __builtin_amdgcn_mfma_f32_32x32x16_bf16(kf1[ks], qf[ks], s1, 0, 0, 0);
        }
        float mxa[8];
#pragma unroll
        for (int i_ = 0; i_ < 8; ++i_) mxa[i_] = fmaxf(fmaxf(s0[2 * i_], s0[2 * i_ + 1]), fmaxf(s1[2 * i_], s1[2 * i_ + 1]));
        float mx = fmaxf(fmaxf(fmaxf(mxa[0], mxa[1]), fmaxf(mxa[2], mxa[3])), fmaxf(fmaxf(mxa[4], mxa[5]), fmaxf(mxa[6], mxa[7])));
        { const auto rr = __builtin_amdgcn_permlane32_swap(__float_as_uint(mx), __float_as_uint(mx), false, false); mx = fmaxf(__uint_as_float(rr[0]), __uint_as_float(rr[1])); }
        if (__any(mx > m_run + 8.0f)) {
            const float m_new = fmaxf(m_run, mx);
            const float alpha = __builtin_amdgcn_exp2f((m_run - m_new) * L2E);
            l_run *= alpha; m_run = m_new;
            if (hi == 0) wsf[r32] = alpha;
            asm volatile("s_waitcnt lgkmcnt(0)" ::: "memory");
            float ar[16];
#pragma unroll
            for (int r = 0; r < 16; ++r) ar[r] = wsf[crow(r, hi)];
#pragma unroll
            for (int d0 = 0; d0 < 4; ++d0)
#pragma unroll
                for (int r = 0; r < 16; ++r) O[d0][r] *= ar[r];
            asm volatile("s_waitcnt lgkmcnt(0)" ::: "memory");
        }
        const float mb = m_run * L2E;
        float ps = 0.f;
#pragma unroll
        for (int r = 0; r < 16; ++r) { s0[r] = __builtin_amdgcn_exp2f(s0[r] * L2E - mb); s1[r] = __builtin_amdgcn_exp2f(s1[r] * L2E - mb); ps += s0[r] + s1[r]; }
        l_run += ps;
        u32x4 pw[4];
#pragma unroll
        for (int s = 0; s < 2; ++s) {
            pw[s].x = pk2(s0[8 * s + 0], s0[8 * s + 1]); pw[s].y = pk2(s0[8 * s + 2], s0[8 * s + 3]); pw[s].z = pk2(s0[8 * s + 4], s0[8 * s + 5]); pw[s].w = pk2(s0[8 * s + 6], s0[8 * s + 7]);
            pw[2 + s].x = pk2(s1[8 * s + 0], s1[8 * s + 1]); pw[2 + s].y = pk2(s1[8 * s + 2], s1[8 * s + 3]); pw[2 + s].z = pk2(s1[8 * s + 4], s1[8 * s + 5]); pw[2 + s].w = pk2(s1[8 * s + 6], s1[8 * s + 7]);
        }
#pragma unroll
        ATT_VLOAD(vb, 1);
#pragma unroll
        for (int d0 = 0; d0 < 4; ++d0) O[d0] = __builtin_amdgcn_mfma_f32_32x32x16_bf16(__builtin_bit_cast(bf16x8, pw[0]), va[d0], O[d0], 0, 0, 0);
        ATT_VLOAD(va, 2);
#pragma unroll
        for (int d0 = 0; d0 < 4; ++d0) O[d0] = __builtin_amdgcn_mfma_f32_32x32x16_bf16(__builtin_bit_cast(bf16x8, pw[1]), vb[d0], O[d0], 0, 0, 0);
        ATT_VLOAD(vb, 3);
#pragma unroll
        for (int d0 = 0; d0 < 4; ++d0) O[d0] = __builtin_amdgcn_mfma_f32_32x32x16_bf16(__builtin_bit_cast(bf16x8, pw[2]), va[d0], O[d0], 0, 0, 0);
#pragma unroll
        for (int d0 = 0; d0 < 4; ++d0) O[d0] = __builtin_amdgcn_mfma_f32_32x32x16_bf16(__builtin_bit_cast(bf16x8, pw[3]), vb[d0], O[d0], 0, 0, 0);
#undef ATT_VLOAD
    }
#undef ATT_STAGE
    l_run += __shfl_xor(l_run, 32);
    asm volatile("s_waitcnt lgkmcnt(0)" ::: "memory");
    if (hi == 0) wsf[r32] = 1.0f / l_run;
    asm volatile("s_waitcnt lgkmcnt(0)" ::: "memory");
    float ar[16];
#pragma unroll
    for (int r = 0; r < 16; ++r) ar[r] = wsf[crow(r, hi)];
    asm volatile("s_waitcnt lgkmcnt(0)" ::: "memory");
#pragma unroll
    for (int d0 = 0; d0 < 4; ++d0)
#pragma unroll
        for (int r = 0; r < 16; ++r) O[d0][r] *= ar[r];
}

DI void phase_att(KP p, int l, unsigned char* smem) {
    constexpr int O_WS = 2 * ATT_BUF;
    const int tid = TIDX(), wid = tid >> 6, lane = tid & 63, r32 = lane & 31, hi = lane >> 5;
    const int li = l >> 1;
    const bf16_t* Qc = (const bf16_t*)(p->ws + WS_QC); const bf16_t* Kc = (const bf16_t*)(p->ws + WS_KC); const bf16_t* Vt = (const bf16_t*)(p->ws + WS_VT);
    bf16_t* Y = (bf16_t*)(p->ws + WS_Y);
    float* stash = (float*)(p->ws + WS_P) + ((size_t)BIDX() * 256 + tid) * 32;
    const float lam_init = 0.8f - 0.6f * expf(-0.3f * (float)l);
    float* wsf = (float*)(smem + O_WS) + wid * 32;
    const int per_x = (l == 3) ? 128 : 144;
    for (int i = 0;; ++i) {
        int b, h, p0, nkv;
        {
            const int G = gridDim.x, bid = BIDX();
            int item;
            if ((G & 7) == 0) { const int x = bid & 7, q = i * (G >> 3) + (bid >> 3); if (q >= per_x) break; item = q < 128 ? x * 128 + q : 1024 + x * 16 + (q - 128); }
            else { item = i * G + bid; if (item >= 8 * per_x) break; }
            if (item < 1024) { b = item >> 7; h = (item >> 4) & 7; p0 = 256 + (item & 15) * 128; nkv = TA; }
            else { const int q = item - 1024; b = q >> 4; h = (q >> 1) & 7; p0 = (q & 1) * 128; nkv = TC; }
        }
        float d1 = 0.f, d2 = 0.f;
        { const float* lq1 = p->in[19] + (li * 8 + h) * 64, *lk1 = p->in[20] + (li * 8 + h) * 64, *lq2 = p->in[21] + (li * 8 + h) * 64, *lk2 = p->in[22] + (li * 8 + h) * 64;
          d1 = wave_sum(lq1[lane] * lk1[lane]); d2 = wave_sum(lq2[lane] * lk2[lane]); }
        const float lamv = expf(d1) - expf(d2) + lam_init;
        f32x16 On[4];
        __syncthreads();
        att_component(Qc, Kc, Vt, smem, wsf, b, h, 0, p0, nkv, On);
#pragma unroll
        for (int d0 = 0; d0 < 4; ++d0)
#pragma unroll
            for (int r = 0; r < 16; r += 8) {
                u32x4 w; w.x = pk2(On[d0][r], On[d0][r + 1]); w.y = pk2(On[d0][r + 2], On[d0][r + 3]); w.z = pk2(On[d0][r + 4], On[d0][r + 5]); w.w = pk2(On[d0][r + 6], On[d0][r + 7]);
                *(u32x4*)(stash + (d0 * 16 + r) / 2) = w;
            }
        __syncthreads();
        att_component(Qc, Kc, Vt, smem, wsf, b, h, 1, p0, nkv, On);
#pragma unroll
        for (int d0 = 0; d0 < 4; ++d0)
#pragma unroll
            for (int r = 0; r < 16; r += 8) {
                const u32x4 w = *(const u32x4*)(stash + (d0 * 16 + r) / 2);
                On[d0][r] = bflo(w.x) - lamv * On[d0][r]; On[d0][r + 1] = bfhi(w.x) - lamv * On[d0][r + 1]; On[d0][r + 2] = bflo(w.y) - lamv * On[d0][r + 2]; On[d0][r + 3] = bfhi(w.y) - lamv * On[d0][r + 3];
                On[d0][r + 4] = bflo(w.z) - lamv * On[d0][r + 4]; On[d0][r + 5] = bfhi(w.z) - lamv * On[d0][r + 5]; On[d0][r + 6] = bflo(w.w) - lamv * On[d0][r + 6]; On[d0][r + 7] = bfhi(w.w) - lamv * On[d0][r + 7];
            }
        float ms[16];
#pragma unroll
        for (int r = 0; r < 16; ++r) {
            float s = (On[0][r] * On[0][r] + On[1][r] * On[1][r]) + (On[2][r] * On[2][r] + On[3][r] * On[3][r]);
            s += __shfl_xor(s, 1); s += __shfl_xor(s, 2); s += __shfl_xor(s, 4); s += __shfl_xor(s, 8); s += __shfl_xor(s, 16);
            ms[r] = __builtin_amdgcn_rsqf(s * (1.0f / 128.0f) + LN_EPS);
        }
        const float* sg = p->in[23] + li * 1024 + h * 128;
        const float post = 1.0f - lam_init;
        float gsc[4];
#pragma unroll
        for (int d0 = 0; d0 < 4; ++d0) gsc[d0] = sg[d0 * 32 + r32] * post;
        __syncthreads();
        unsigned char* stg = smem + wid * 8192;
#pragma unroll
        for (int r = 0; r < 16; ++r) {
            unsigned char* sp = stg + crow(r, hi) * 256 + r32 * 2;
#pragma unroll
            for (int d0 = 0; d0 < 4; ++d0) *(unsigned short*)(sp + d0 * 64) = (unsigned short)f2bf(On[d0][r] * ms[r] * gsc[d0]);
        }
        asm volatile("s_waitcnt lgkmcnt(0)" ::: "memory");
#pragma unroll
        for (int i2 = 0; i2 < 8; ++i2) {
            const int id = lane + 64 * i2, qr = id >> 4, ch = id & 15;
            const int pq = p0 + wid * 32 + qr;
            const int row = pq < 256 ? ML + b * 256 + pq : b * 2048 + (pq - 256);
            *(u32x4*)(Y + (size_t)row * 1024 + h * 128 + ch * 8) = *(const u32x4*)(stg + qr * 256 + ch * 16);
        }
        asm volatile("s_waitcnt lgkmcnt(0)" ::: "memory");
    }
}

#define XB_TMO      128
#define XB_XCNT(j)  (256  + 64 * (j))
#define XB_XSUB(j)  (1280 + 64 * (j))
#define XB_XGEN(j)  (2304 + 64 * (j))
#define XB_TOP      3328
#define XB_TOPGEN   3392
#define XCD_BAR_WORDS 3456
#define XB_SPIN_CAP (1u << 22)
DI unsigned xb_ld(unsigned* p)              { return __hip_atomic_load(p, __ATOMIC_RELAXED, __HIP_MEMORY_SCOPE_AGENT); }
DI unsigned xb_add(unsigned* p, unsigned v) { return __hip_atomic_fetch_add(p, v, __ATOMIC_RELAXED, __HIP_MEMORY_SCOPE_AGENT); }
DI unsigned xb_xcc_id() { return (unsigned)__builtin_amdgcn_s_getreg((3 << 11) | 20) & 0xFu; }
#define XB_SPIN(cond, bar) do { unsigned _sp = 0; while (cond) { __builtin_amdgcn_s_sleep(1); \
    if ((++_sp & 255u) == 0u) { if (xb_ld(&(bar)[XB_TMO])) break; if (_sp > XB_SPIN_CAP) { atomicAdd(&(bar)[XB_TMO], 1u); break; } } } } while (0)
struct XcdBarrier { unsigned* bar; unsigned x; volatile LAS unsigned* st; };
DI XcdBarrier xcd_barrier_post(unsigned* bar, volatile LAS unsigned* st) {
    XcdBarrier b; b.bar = bar; b.x = xb_xcc_id(); b.st = st;
    if (threadIdx.x == 0) (void)xb_add(&bar[XB_XCNT(b.x)], 1u);
    return b;
}
DI void xcd_barrier_complete(unsigned* bar, unsigned x, unsigned& nloc, unsigned& nx) {
    const unsigned G = gridDim.x * gridDim.y * gridDim.z;
    unsigned sum, cnt, mine, sp = 0u;
    for (;;) {
        sum = 0u; cnt = 0u; mine = 0u;
#pragma unroll
        for (unsigned j = 0; j < 16; ++j) { const unsigned c = xb_ld(&bar[XB_XCNT(j)]); sum += c; cnt += (c > 0u) ? 1u : 0u; mine = (j == x) ? c : mine; }
        if (sum == G) break;
        __builtin_amdgcn_s_sleep(1);
        if ((++sp & 255u) == 0u) { if (xb_ld(&bar[XB_TMO])) break; if (sp > XB_SPIN_CAP) { atomicAdd(&bar[XB_TMO], 1u); break; } }
    }
    nloc = mine > 0u ? mine : 1u; nx = cnt > 0u ? cnt : 1u;
}
DI void xcd_barrier(const XcdBarrier& b) {
    asm volatile("s_waitcnt vmcnt(0)" ::: "memory");
    __syncthreads();
    if (threadIdx.x == 0) {
        unsigned* bar = b.bar;
        __builtin_amdgcn_s_waitcnt(0);
        unsigned nloc = b.st[0], nx = b.st[1];
        if (nloc == 0u) { xcd_barrier_complete(bar, b.x, nloc, nx); b.st[0] = nloc; b.st[1] = nx; }
        const unsigned old = xb_add(&bar[XB_XSUB(b.x)], 1u);
        const unsigned gen = old / nloc;
        if (old + 1u == (gen + 1u) * nloc) {
            __builtin_amdgcn_fence(__ATOMIC_RELEASE, "agent");
            asm volatile("s_waitcnt vmcnt(0)" ::: "memory");
            const unsigned og = xb_add(&bar[XB_TOP], 1u);
            const unsigned tg = og / nx;
            if (og + 1u == (tg + 1u) * nx) xb_add(&bar[XB_TOPGEN], 1u);
            else XB_SPIN(xb_ld(&bar[XB_TOPGEN]) == tg, bar);
            __builtin_amdgcn_fence(__ATOMIC_ACQUIRE, "agent");
            xb_add(&bar[XB_XGEN(b.x)], 1u);
            asm volatile("s_waitcnt vmcnt(0)" ::: "memory");
        } else {
            XB_SPIN(xb_ld(&bar[XB_XGEN(b.x)]) == gen, bar);
            __builtin_amdgcn_fence(__ATOMIC_ACQUIRE, "agent");
            asm volatile("s_waitcnt vmcnt(0)" ::: "memory");
        }
    }
    __syncthreads();
}

#ifdef DOUBLE_MASK
#define DRYCOND (rep_ == 0 && nrep_ == 2)
#else
#define DRYCOND false
#endif
constexpr int NPHASE = 34;
constexpr int LDS_BYTES = 65536 + 1024;
__global__ void __launch_bounds__(256, 2) mega(Params pv) {
    extern __shared__ __attribute__((aligned(16))) unsigned char smem[];
    const int ph_lo = pv.ph_lo, ph_hi = pv.ph_hi;
    volatile LAS unsigned* bar_st = (volatile LAS unsigned*)(LAS unsigned char*)(smem + 65536);
    if (threadIdx.x == 0) { bar_st[0] = 0u; bar_st[1] = 0u; }
    __syncthreads();
    XcdBarrier xbar = xcd_barrier_post((unsigned*)(pv.ws + WS_CTL) + 4096, bar_st);
    for (int ph = ph_lo; ph < ph_hi; ++ph) {
        KP p = (KP)__builtin_amdgcn_kernarg_segment_ptr();
        asm volatile("" : "+s"(p) :: "memory");
#ifdef DOUBLE_MASK
        int kind_;
        if (ph == 0) kind_ = 0; else if (ph == 1) kind_ = 1;
        else { const int rem_ = (ph - 2) % 16; kind_ = rem_ == 0 ? 2 : (rem_ == 1 ? 12 : (rem_ < 9 ? rem_ + 1 : (rem_ == 9 ? 10 : (rem_ == 10 ? 11 : (rem_ - 11 + 5))))); }
        const int nrep_ = ((DOUBLE_MASK >> kind_) & 1) ? 2 : 1;
        for (int rep_ = 0; rep_ < nrep_; ++rep_) {
        if (rep_) xcd_barrier(xbar);
#endif
        if (ph == 0) phase_pre0(p, smem);
        else if (ph == 1) phase_pre1(p);
        else {
            const int q = ph - 2, lp = q / 16, rem = q % 16;
            if (rem < 9) {
                const int l = 2 * lp;
                switch (rem) {
                    case 0: phase_g1e(p, l, smem); break;
                    case 1: phase_decay(p, l, smem); break;
                    case 2: phase_scan(p, l, smem); break;
                    case 3: phase_merge(p, l); break;
                    case 4: phase_g2(p, l, smem); break;
                    case 5: if (DRYCOND) phase_ln1r<true>(p, l, smem); else phase_ln1r<false>(p, l, smem); break;
                    case 6: phase_mg1(p, l, smem); break;
                    case 7: phase_mg2(p, l, smem); break;
                    default: if (DRYCOND) phase_ln2<true>(p, l); else phase_ln2<false>(p, l); break;
                }
            } else {
                const int l = 2 * lp + 1;
                switch (rem - 9) {
                    case 0: phase_g1o(p, l, smem); break;
                    case 1: phase_att(p, l, smem); break;
                    case 2: phase_g2(p, l, smem); break;
                    case 3: if (DRYCOND) phase_ln1r<true>(p, l, smem); else phase_ln1r<false>(p, l, smem); break;
                    case 4: phase_mg1(p, l, smem); break;
                    case 5: phase_mg2(p, l, smem); break;
                    default: if (DRYCOND) phase_ln2<true>(p, l); else phase_ln2<false>(p, l); break;
                }
            }
        }
#ifdef DOUBLE_MASK
        }
#endif
        if (ph + 1 < ph_hi) xcd_barrier(xbar);
    }
}

extern "C" void kernel_launch(void* const* d_in, const int* in_sizes, int n_in, void* d_out, int out_size, void* d_ws, size_t ws_size, hipStream_t stream) {
    static int grid_blocks = 0;
    if (grid_blocks == 0) {
        if (n_in != 32 || ws_size < WS_END) { fprintf(stderr, "kernel_launch: unexpected n_in %d or ws_size %zu\n", n_in, ws_size); grid_blocks = -1; return; }
        int dev = 0, cus = 0, per_cu = 0;
        hipGetDevice(&dev);
        hipDeviceGetAttribute(&cus, hipDeviceAttributeMultiprocessorCount, dev);
        hipFuncSetAttribute((const void*)mega, hipFuncAttributeMaxDynamicSharedMemorySize, LDS_BYTES);
        hipOccupancyMaxActiveBlocksPerMultiprocessor(&per_cu, mega, 256, LDS_BYTES);
        if (per_cu > 2) per_cu = 2;
        if (per_cu < 1) per_cu = 1;
        grid_blocks = cus * per_cu;
    }
    if (grid_blocks < 0) return;
    hipMemsetAsync((char*)d_ws + WS_CTL, 0, 32768, stream);
    Params p{};
    for (int i = 0; i < 32; ++i) p.in[i] = (const float*)d_in[i];
    p.out = (float*)d_out; p.ws = (unsigned char*)d_ws;
#if N_LAUNCH_MODE == 1
    p.ph_lo = 0; p.ph_hi = NPHASE;
    void* args[] = {&p};
    hipError_t e = hipLaunchCooperativeKernel((void*)mega, dim3(grid_blocks), dim3(256), args, LDS_BYTES, stream);
    if (e != hipSuccess) fprintf(stderr, "cooperative launch failed: %s (grid %d)\n", hipGetErrorString(e), grid_blocks);
#else
    for (int ph = 0; ph < NPHASE; ++ph) {
        p.ph_lo = ph; p.ph_hi = ph + 1;
        hipLaunchKernelGGL(mega, dim3(grid_blocks), dim3(256), LDS_BYTES, stream, p);
    }
#endif
}
```

```cpp
#include <hip/hip_runtime.h>
#include <hip/hip_cooperative_groups.h>
#include <cstdio>
#include <cstdint>
namespace cg = cooperative_groups;

#ifndef N_LAUNCH_MODE
#define N_LAUNCH_MODE 1
#endif

#define DI __device__ __forceinline__
#define LAS __attribute__((address_space(3)))
typedef unsigned short bf16_t;
typedef short bf16x8 __attribute__((ext_vector_type(8)));
typedef short s16x4 __attribute__((ext_vector_type(4)));
typedef float f32x4 __attribute__((ext_vector_type(4)));
typedef float f32x16 __attribute__((ext_vector_type(16)));
typedef unsigned u32x4 __attribute__((ext_vector_type(4)));
typedef unsigned u32x2 __attribute__((ext_vector_type(2)));

constexpr int D = 1024, NB = 8, T = 2048, TC = 256, TA = T + TC;
constexpr int ML = NB * T, MC = NB * TC, MT = ML + MC;
constexpr int NIN = 3616, NINP = 3712, ZS = 3712;
constexpr int NSLOT = 2 * MT;
constexpr float LN_EPS = 1e-5f;
constexpr float ALPHA = 1.6817928305074290f;
constexpr float L2E = 1.4426950408889634f;

constexpr size_t MiB = 1ull << 20;
constexpr size_t WS_CTL = 0;
constexpr size_t WS_MOD = 1 * MiB;
constexpr size_t WS_ROPEA = 2 * MiB;
constexpr size_t WS_ROPEC = 3 * MiB;
constexpr size_t WS_LR = 4 * MiB;
constexpr size_t WS_SLOTW = 7 * MiB;
constexpr size_t WS_LIST = 8 * MiB;
constexpr size_t WS_WRT = 13 * MiB;
constexpr size_t WS_WIN = 16 * MiB;
constexpr size_t WS_WABO = 32 * MiB;
constexpr size_t WS_WQKV = 36 * MiB;
constexpr size_t WS_WCO = 48 * MiB;
constexpr size_t WS_WGU = 64 * MiB;
constexpr size_t WS_WD = 320 * MiB;
constexpr size_t WS_X = 448 * MiB;
constexpr size_t WS_U = 520 * MiB;
constexpr size_t WS_Y = 556 * MiB;
constexpr size_t WS_Z = 592 * MiB;
constexpr size_t WS_O = 724 * MiB;
constexpr size_t WS_PF = 868 * MiB, WS_SQ = 886 * MiB, WS_SK = 904 * MiB, WS_TOT = 922 * MiB;
constexpr size_t WS_END = 923 * MiB;
constexpr size_t WS_QC = WS_Z, WS_KC = WS_Z + 36 * MiB, WS_VT = WS_Z + 72 * MiB;
constexpr size_t WS_YS = WS_Z;
constexpr size_t WS_OF = WS_O, WS_OB = WS_O + 72 * MiB, WS_P = WS_O, WS_H = WS_O + 72 * MiB;

#ifndef XBF16
#define XBF16 0
#endif
#if XBF16
typedef bf16_t xres_t;
#else
typedef float xres_t;
#endif
struct Params { const float* in[32]; float* out; unsigned char* ws; int ph_lo, ph_hi; };
typedef const __attribute__((address_space(4))) Params* KP;

DI int TIDX() { int t = threadIdx.x; asm volatile("" : "+v"(t)); return t; }
DI int BIDX() { int b = blockIdx.x; asm volatile("" : "+s"(b)); return b; }
DI unsigned pk2(float lo, float hi);
DI unsigned f2bf(float f) { return pk2(f, 0.f) & 0xffffu; }
typedef float f32x2_t __attribute__((ext_vector_type(2))); typedef __bf16 bf16x2_t __attribute__((ext_vector_type(2)));
DI unsigned pk2(float lo, float hi) { f32x2_t v = {lo, hi}; bf16x2_t b = __builtin_convertvector(v, bf16x2_t); return __builtin_bit_cast(unsigned, b); }
DI float bflo(unsigned w) { return __uint_as_float(w << 16); }
DI float bfhi(unsigned w) { return __uint_as_float(w & 0xffff0000u); }
DI f32x4 xload(const xres_t* p) {
#if XBF16
    const u32x2 w = *(const u32x2*)p; return (f32x4){bflo(w.x), bfhi(w.x), bflo(w.y), bfhi(w.y)};
#else
    return *(const f32x4*)p;
#endif
}
DI void xstore(xres_t* p, f32x4 v) {
#if XBF16
    u32x2 w; w.x = pk2(v[0], v[1]); w.y = pk2(v[2], v[3]); *(u32x2*)p = w;
#else
    *(f32x4*)p = v;
#endif
}
DI float wave_sum(float v) {
    int x = __float_as_int(v);
    v += __int_as_float(__builtin_amdgcn_update_dpp(x, x, 0xB1, 0xF, 0xF, false)); x = __float_as_int(v);
    v += __int_as_float(__builtin_amdgcn_update_dpp(x, x, 0x4E, 0xF, 0xF, false)); x = __float_as_int(v);
    v += __int_as_float(__builtin_amdgcn_update_dpp(x, x, 0x141, 0xF, 0xF, false)); x = __float_as_int(v);
    v += __int_as_float(__builtin_amdgcn_update_dpp(x, x, 0x140, 0xF, 0xF, false));
    { const auto r = __builtin_amdgcn_permlane16_swap(__float_as_uint(v), __float_as_uint(v), false, false); v = __uint_as_float(r[0]) + __uint_as_float(r[1]); }
    { const auto r = __builtin_amdgcn_permlane32_swap(__float_as_uint(v), __float_as_uint(v), false, false); v = __uint_as_float(r[0]) + __uint_as_float(r[1]); }
    return v;
}
DI float siluf(float v) { return v * __builtin_amdgcn_rcpf(1.0f + __expf(-v)); }

DI int gemm_chunk(int tid) { return (tid & 7) ^ ((tid >> 4) & 7); }
template <bool TRN>
DI void gemm_tile(unsigned char* shm, const bf16_t* const (&ap)[4], const bf16_t* const (&bp)[4], int K, f32x4 (&acc)[4][4],
                  bool first, bool has_next, const bf16_t* const (&apn)[4], const bf16_t* const (&bpn)[4]) {
    const int tid = TIDX(), wid = tid >> 6, lane = tid & 63, wr = wid >> 1, wc = wid & 1, fr = lane & 15, fq = lane >> 4;
#pragma unroll
    for (int m = 0; m < 4; ++m)
#pragma unroll
        for (int n = 0; n < 4; ++n) acc[m][n] = (f32x4){0.f, 0.f, 0.f, 0.f};
    const int nt = K >> 6;
    const int sw = fr >> 1;
    const unsigned aoff = (unsigned)((wr * 64 + fr) * 128), boff = (unsigned)(16384 + (wc * 64 + fr) * 128);
#define GEMM_STAGE(buf, A_, B_, t) do { _Pragma("unroll") for (int i_ = 0; i_ < 4; ++i_) { \
        __builtin_amdgcn_global_load_lds((const unsigned*)(A_[i_] + (t) * 64), (LAS unsigned*)(shm + (buf) * 32768 + i_ * 4096 + tid * 16), 16, 0, 0); \
        __builtin_amdgcn_global_load_lds((const unsigned*)(B_[i_] + (t) * 64), (LAS unsigned*)(shm + (buf) * 32768 + 16384 + i_ * 4096 + tid * 16), 16, 0, 0); } } while (0)
    if (first) {
        GEMM_STAGE(0, ap, bp, 0);
        asm volatile("s_waitcnt vmcnt(0)" ::: "memory");
        __syncthreads();
    }
    for (int t = 0; t < nt; ++t) {
        const int cur = t & 1;
        if (t + 1 < nt) GEMM_STAGE(cur ^ 1, ap, bp, t + 1);
        else if (has_next) GEMM_STAGE(cur ^ 1, apn, bpn, 0);
        const unsigned char* base = shm + cur * 32768;
        bf16x8 At[2][4], Bt[2][4];
#pragma unroll
        for (int ks = 0; ks < 2; ++ks) {
            const unsigned co = (unsigned)(((ks * 4 + fq) ^ sw) << 4);
#pragma unroll
            for (int m = 0; m < 4; ++m) At[ks][m] = *(const bf16x8*)(base + aoff + m * 2048 + co);
#pragma unroll
            for (int n = 0; n < 4; ++n) Bt[ks][n] = *(const bf16x8*)(base + boff + n * 2048 + co);
        }
        __builtin_amdgcn_s_setprio(1);
#pragma unroll
        for (int ks = 0; ks < 2; ++ks)
#pragma unroll
            for (int m = 0; m < 4; ++m)
#pragma unroll
                for (int n = 0; n < 4; ++n)
                    acc[m][n] = TRN ? __builtin_amdgcn_mfma_f32_16x16x32_bf16(Bt[ks][n], At[ks][m], acc[m][n], 0, 0, 0)
                                    : __builtin_amdgcn_mfma_f32_16x16x32_bf16(At[ks][m], Bt[ks][n], acc[m][n], 0, 0, 0);
        __builtin_amdgcn_s_setprio(0);
        asm volatile("s_waitcnt vmcnt(0)" ::: "memory");
        __syncthreads();
    }
#undef GEMM_STAGE
}
#define GEMM_ADVANCE() do { _Pragma("unroll") for (int k_ = 0; k_ < 4; ++k_) { ap[k_] = apn[k_]; bp[k_] = bpn[k_]; } } while (0)
DI void gemm_rows(const bf16_t* base, int r0, int ld, int tid, const bf16_t* (&pp)[4]) {
    const bf16_t* q = base + (size_t)(r0 + (tid >> 3)) * ld + gemm_chunk(tid) * 8;
#pragma unroll
    for (int i = 0; i < 4; ++i) pp[i] = q + (size_t)(32 * i) * ld;
}
DI bool tile_seq(int q, int nrt, int nct, int& rt, int& ct) {
    if (q >= nrt * nct) return false;
    const int band = q / (8 * nct), rem = q - band * 8 * nct;
    const int rows = (nrt - band * 8) < 8 ? (nrt - band * 8) : 8;
    ct = rem / rows; rt = band * 8 + rem % rows;
    return true;
}
DI int xcd_seq(int i, int total) {
    const int G = gridDim.x, bid = BIDX();
    if ((G & 7) != 0) { const int q = i * G + bid; return q < total ? q : -1; }
    const int x = bid & 7, j = bid >> 3, per = (total + 7) >> 3, gx = G >> 3;
    const int q = i * gx + j;
    if (q >= per) return -1;
    const int g = x * per + q;
    return g < total ? g : -1;
}

template <int MODE>
DI void tr_item(const float* W, int K, int N, bf16_t* WT, float* scr, int item, int lane) {
    const int nblk = N / 32, kb = item / nblk, nb = item % nblk, k0 = 64 * kb, n0 = 32 * nb;
    float wv[32];
#pragma unroll
    for (int i = 0; i < 32; ++i) wv[i] = W[(size_t)(k0 + 2 * i + (lane >> 5)) * N + n0 + (lane & 31)];
#pragma unroll
    for (int i = 0; i < 32; ++i) scr[(2 * i + (lane >> 5)) * 33 + (lane & 31)] = wv[i];
    asm volatile("s_waitcnt lgkmcnt(0)" ::: "memory");
    const int c = lane & 7;
#pragma unroll
    for (int j = 0; j < 4; ++j) {
        const int n = (lane >> 3) + 8 * j; const float* s = scr + (8 * c) * 33 + n;
        u32x4 o; o.x = pk2(s[0 * 33], s[1 * 33]); o.y = pk2(s[2 * 33], s[3 * 33]); o.z = pk2(s[4 * 33], s[5 * 33]); o.w = pk2(s[6 * 33], s[7 * 33]);
        const int nn = n0 + n;
        const int drow = (MODE == 0) ? nn : ((nn >> 4) * 32 + (nn & 15) + (MODE == 2 ? 16 : 0));
        *(u32x4*)(WT + (size_t)drow * K + k0 + 8 * c) = o;
    }
    asm volatile("s_waitcnt lgkmcnt(0)" ::: "memory");
}

DI void phase_pre0(KP p, unsigned char* smem) {
    const int tid = TIDX(), wave = tid >> 6, lane = tid & 63;
    unsigned char* ws = p->ws;
    {
        float* s_sc = (float*)smem;
        float* s_red = s_sc + 9 * 1024;
        const float* c = p->in[1]; const float* cc = p->in[3];
        for (int i = tid; i < 9 * 1024; i += 256) { const int r = i >> 10, k = i & 1023; const float v = r < 8 ? c[r * 1024 + k] : cc[k]; s_sc[i] = v / (1.0f + expf(-v)); }
        __syncthreads();
        float* MOD = (float*)(ws + WS_MOD);
        for (int item = BIDX(); item < 384; item += gridDim.x) {
            const int l = item / 96, n0 = (item % 96) * 64;
            const float* W = p->in[4] + (size_t)l * 1024 * 6144 + n0 + lane;
            float acc[9];
#pragma unroll
            for (int r = 0; r < 9; ++r) acc[r] = 0.f;
#pragma unroll 16
            for (int k = wave * 256; k < wave * 256 + 256; ++k) {
                const float w = W[(size_t)k * 6144];
#pragma unroll
                for (int r = 0; r < 9; ++r) acc[r] += s_sc[r * 1024 + k] * w;
            }
#pragma unroll
            for (int r = 0; r < 9; ++r) s_red[(wave * 9 + r) * 64 + lane] = acc[r];
            __syncthreads();
            for (int i = tid; i < 9 * 64; i += 256) {
                const int r = i >> 6, ln = i & 63;
                const float v = s_red[(0 * 9 + r) * 64 + ln] + s_red[(1 * 9 + r) * 64 + ln] + s_red[(2 * 9 + r) * 64 + ln] + s_red[(3 * 9 + r) * 64 + ln];
                MOD[(size_t)(l * 9 + r) * 6144 + n0 + ln] = v + p->in[5][l * 6144 + n0 + ln];
            }
            __syncthreads();
        }
    }
    {
        const int gt = BIDX() * 256 + tid, NT = gridDim.x * 256;
        float* ca = (float*)(ws + WS_ROPEA); float* sa = ca + 2048 * 64;
        for (int i = gt; i < 2048 * 64; i += NT) {
            const int t = i >> 6, f = i & 63; const int pos = f < 32 ? (t >> 6) : (t & 63); const int ff = f & 31;
            const float inv = powf(10000.0f, -(float)ff / 32.0f); const float a = (float)pos * inv;
            ca[i] = cosf(a); sa[i] = sinf(a);
        }
        float* cc_ = (float*)(ws + WS_ROPEC); float* sc_ = cc_ + 2048 * 32;
        for (int i = gt; i < 2048 * 32; i += NT) {
            const int t = i >> 5, f = i & 31; const int pos = f < 16 ? (t >> 6) : (t & 63); const int ff = f & 15;
            const float inv = powf(10000.0f, -(float)ff / 16.0f); const float a = (float)pos * inv;
            cc_[i] = cosf(a); sc_[i] = sinf(a);
        }
        float* wrt = (float*)(ws + WS_WRT);
        for (int i = gt; i < 4 * 36 * 1024; i += NT) {
            const int l = i / (36 * 1024), o = (i / 1024) % 36, k = i & 1023;
            wrt[i] = o < 4 ? p->in[25][((size_t)l * 1024 + k) * 4 + o] : p->in[27][((size_t)l * 1024 + k) * 32 + (o - 4)];
        }
        unsigned* wpad = (unsigned*)(ws + WS_WIN);
        for (int i = gt; i < 2 * 96 * 512; i += NT) { const int li = i / (96 * 512), r = i % (96 * 512); wpad[((size_t)li * NINP + NIN) * 512 + r] = 0u; }
    }
    __syncthreads();
    {
        float* scr = (float*)smem + wave * (64 * 33);
        constexpr int I_IN = 16 * 113, I_SQ = 16 * 32, I_QKV = 16 * 96, I_E = 256;
        constexpr int R0 = 2 * I_IN, R1 = R0 + 2 * I_SQ, R2 = R1 + 2 * I_QKV, R3 = R2 + 2 * I_SQ, R4 = R3 + 128 * I_E, R5 = R4 + 128 * I_E, R6 = R5 + 128 * I_E;
        for (int it = BIDX() * 4 + wave; it < R6; it += gridDim.x * 4) {
            if (it < R0) { const int i = it / I_IN, r = it % I_IN; tr_item<0>(p->in[10] + (size_t)i * 1024 * NIN, 1024, NIN, (bf16_t*)(ws + WS_WIN) + (size_t)i * NINP * 1024, scr, r, lane); }
            else if (it < R1) { const int q = it - R0, i = q / I_SQ, r = q % I_SQ; tr_item<0>(p->in[17] + (size_t)i * 1024 * 1024, 1024, 1024, (bf16_t*)(ws + WS_WABO) + (size_t)i * 1024 * 1024, scr, r, lane); }
            else if (it < R2) { const int q = it - R1, i = q / I_QKV, r = q % I_QKV; tr_item<0>(p->in[18] + (size_t)i * 1024 * 3072, 1024, 3072, (bf16_t*)(ws + WS_WQKV) + (size_t)i * 3072 * 1024, scr, r, lane); }
            else if (it < R3) { const int q = it - R2, i = q / I_SQ, r = q % I_SQ; tr_item<0>(p->in[24] + (size_t)i * 1024 * 1024, 1024, 1024, (bf16_t*)(ws + WS_WCO) + (size_t)i * 1024 * 1024, scr, r, lane); }
            else if (it < R4) { const int q = it - R3, le = q / I_E, r = q % I_E; tr_item<1>(p->in[29] + (size_t)le * 1024 * 512, 1024, 512, (bf16_t*)(ws + WS_WGU) + (size_t)le * 1024 * 1024, scr, r, lane); }
            else if (it < R5) { const int q = it - R4, le = q / I_E, r = q % I_E; tr_item<2>(p->in[30] + (size_t)le * 1024 * 512, 1024, 512, (bf16_t*)(ws + WS_WGU) + (size_t)le * 1024 * 1024, scr, r, lane); }
            else { const int q = it - R5, le = q / I_E, r = q % I_E; tr_item<0>(p->in[31] + (size_t)le * 512 * 1024, 512, 1024, (bf16_t*)(ws + WS_WD) + (size_t)le * 1024 * 512, scr, r, lane); }
        }
    }
}

DI void phase_pre1(KP p) {
    const int tid = TIDX(), wave = tid >> 6, lane = tid & 63;
    xres_t* X = (xres_t*)(p->ws + WS_X); bf16_t* U = (bf16_t*)(p->ws + WS_U); const float* MOD = (const float*)(p->ws + WS_MOD);
    for (int row = BIDX() * 4 + wave; row < MT; row += gridDim.x * 4) {
        const float* src = row < ML ? p->in[0] + (size_t)row * 1024 : p->in[2] + (size_t)(row - ML) * 1024;
        const int r = row < ML ? (row >> 11) : 8;
        const float* mod = MOD + (size_t)r * 6144;
#pragma unroll
        for (int j = 0; j < 4; ++j) {
            const int k = 256 * j + 4 * lane;
            const f32x4 v = *(const f32x4*)(src + k), sh = *(const f32x4*)(mod + k), sc = *(const f32x4*)(mod + 1024 + k);
            const f32x4 u = v * (1.0f + sc) + sh;
            u32x2 w; w.x = pk2(u[0], u[1]); w.y = pk2(u[2], u[3]);
            *(u32x2*)(U + (size_t)row * 1024 + k) = w;
        }
    }
}

DI void phase_g1e(KP p, int l, unsigned char* smem) {
    const int tid = TIDX(), wid = tid >> 6, lane = tid & 63, wr = wid >> 1, wc = wid & 1, fr = lane & 15, fq = lane >> 4;
    const int li = l >> 1;
    const bf16_t* U = (const bf16_t*)(p->ws + WS_U); const bf16_t* W = (const bf16_t*)(p->ws + WS_WIN) + (size_t)li * NINP * 1024;
    bf16_t* Z = (bf16_t*)(p->ws + WS_Z); float* LR = (float*)(p->ws + WS_LR);
    const float* ca = (const float*)(p->ws + WS_ROPEA); const float* sa = ca + 2048 * 64;
    constexpr int NTN = NINP / 128;
    auto decode = [&](int i, int& brow, int& bcol) -> bool {
        const int q = xcd_seq(i, (MT / 128) * NTN); if (q < 0) return false;
        int rt, nt; tile_seq(q, MT / 128, NTN, rt, nt); brow = rt * 128; bcol = nt * 128; return true; };
    auto epi = [&](int brow, int bcol, f32x4 (&acc)[4][4]) {
        const int colw = bcol + wc * 64;
        if (colw >= NIN) return;
        if (colw >= 3584) {
#pragma unroll
            for (int m = 0; m < 4; ++m) { const int row = brow + wr * 64 + m * 16 + fr;
#pragma unroll
                for (int n = 0; n < 2; ++n) *(f32x4*)(LR + (size_t)row * 32 + n * 16 + fq * 4) = acc[m][n]; }
            return;
        }
        const bool ropeR = colw < 1024; const int half = (colw >> 6) & 1;
        const float scale = colw < 512 ? 0.08838834764831845f : ((colw >= 2048 && colw < 2304) ? 0.125f : 1.0f);
#pragma unroll
        for (int m = 0; m < 4; ++m) {
            const int row = brow + wr * 64 + m * 16 + fr;
            if (ropeR && row < ML) {
                const int t = row & 2047;
#pragma unroll
                for (int n = 0; n < 2; ++n) {
                    const f32x4 c4 = *(const f32x4*)(ca + t * 64 + half * 32 + n * 16 + fq * 4), s4 = *(const f32x4*)(sa + t * 64 + half * 32 + n * 16 + fq * 4);
                    const f32x4 a = acc[m][n], b = acc[m][n + 2];
                    acc[m][n] = a * c4 - b * s4; acc[m][n + 2] = b * c4 + a * s4;
                }
            }
#pragma unroll
            for (int n = 0; n < 4; ++n) {
                const f32x4 v = acc[m][n] * scale; u32x2 w; w.x = pk2(v[0], v[1]); w.y = pk2(v[2], v[3]);
                *(u32x2*)(Z + (size_t)row * ZS + colw + n * 16 + fq * 4) = w;
            }
        }
    };
    int brow, bcol;
    if (!decode(0, brow, bcol)) return;
    const bf16_t* ap[4]; const bf16_t* bp[4]; const bf16_t* apn[4]; const bf16_t* bpn[4];
    gemm_rows(U, brow, 1024, tid, ap); gemm_rows(W, bcol, 1024, tid, bp);
    bool first = true;
    for (int i = 0;; ++i) {
        int nbrow = brow, nbcol = bcol; const bool hn = decode(i + 1, nbrow, nbcol);
        gemm_rows(U, nbrow, 1024, tid, apn); gemm_rows(W, nbcol, 1024, tid, bpn);
        f32x4 acc[4][4];
        gemm_tile<true>(smem, ap, bp, 1024, acc, first, hn, apn, bpn);
        epi(brow, bcol, acc);
        if (!hn) break;
        brow = nbrow; bcol = nbcol; GEMM_ADVANCE(); first = false;
    }
}

DI void phase_g1o(KP p, int l, unsigned char* smem) {
    const int tid = TIDX(), wid = tid >> 6, lane = tid & 63, wr = wid >> 1, wc = wid & 1, fr = lane & 15, fq = lane >> 4;
    const int li = l >> 1;
    const bf16_t* U = (const bf16_t*)(p->ws + WS_U); const bf16_t* W = (const bf16_t*)(p->ws + WS_WQKV) + (size_t)li * 3072 * 1024;
    bf16_t* Qc = (bf16_t*)(p->ws + WS_QC); bf16_t* Kc = (bf16_t*)(p->ws + WS_KC); bf16_t* Vt = (bf16_t*)(p->ws + WS_VT);
    const float* cc = (const float*)(p->ws + WS_ROPEC); const float* sc = cc + 2048 * 32;
    auto decode = [&](int i, int& brow, int& bcol) -> bool {
        const int q = xcd_seq(i, (MT / 128) * 24); if (q < 0) return false;
        int rt, nt; tile_seq(q, MT / 128, 24, rt, nt); brow = rt * 128; bcol = nt * 128; return true; };
    int brow, bcol;
    if (!decode(0, brow, bcol)) return;
    const bf16_t* ap[4]; const bf16_t* bp[4]; const bf16_t* apn[4]; const bf16_t* bpn[4];
    gemm_rows(U, brow, 1024, tid, ap); gemm_rows(W, bcol, 1024, tid, bp);
    bool first = true;
    for (int i = 0;; ++i) {
        int nbrow = brow, nbcol = bcol; const bool hn = decode(i + 1, nbrow, nbcol);
        gemm_rows(U, nbrow, 1024, tid, apn); gemm_rows(W, nbcol, 1024, tid, bpn);
        f32x4 acc[4][4];
        if (bcol < 2048) {
            gemm_tile<true>(smem, ap, bp, 1024, acc, first, hn, apn, bpn);
            const int colw = bcol + wc * 64; const bool isk = colw >= 1024; const int hc = (colw & 1023) >> 6;
            bf16_t* dst = isk ? Kc : Qc; const float scale = isk ? 1.0f : 0.125f;
#pragma unroll
            for (int m = 0; m < 4; ++m) {
                const int row = brow + wr * 64 + m * 16 + fr;
                int b, pidx;
                if (row < ML) {
                    b = row >> 11; const int t = row & 2047; pidx = 256 + t;
#pragma unroll
                    for (int n = 0; n < 4; n += 2) {
                        const f32x4 c4 = *(const f32x4*)(cc + t * 32 + (n >> 1) * 16 + fq * 4), s4 = *(const f32x4*)(sc + t * 32 + (n >> 1) * 16 + fq * 4);
                        const f32x4 a = acc[m][n], bb = acc[m][n + 1];
                        acc[m][n] = a * c4 - bb * s4; acc[m][n + 1] = bb * c4 + a * s4;
                    }
                } else { b = (row - ML) >> 8; pidx = (row - ML) & 255; }
                bf16_t* o = dst + ((size_t)(b * 16 + hc) * TA + pidx) * 64;
#pragma unroll
                for (int n = 0; n < 4; ++n) { const f32x4 v = acc[m][n] * scale; u32x2 w; w.x = pk2(v[0], v[1]); w.y = pk2(v[2], v[3]); *(u32x2*)(o + n * 16 + fq * 4) = w; }
            }
        } else {
            gemm_tile<false>(smem, ap, bp, 1024, acc, first, hn, apn, bpn);
#pragma unroll
            for (int m = 0; m < 4; ++m) {
                const int row = brow + wr * 64 + m * 16 + fq * 4;
                int b, pidx;
                if (row < ML) { b = row >> 11; pidx = 256 + (row & 2047); } else { b = (row - ML) >> 8; pidx = (row - ML) & 255; }
                const int ppos = (pidx & ~12) | ((pidx & 8) >> 1) | ((pidx & 4) << 1);
#pragma unroll
                for (int n = 0; n < 4; ++n) {
                    const int col = bcol - 2048 + wc * 64 + n * 16 + fr; const int h = col >> 7, d = col & 127;
                    const f32x4 v = acc[m][n]; u32x2 w; w.x = pk2(v[0], v[1]); w.y = pk2(v[2], v[3]);
                    *(u32x2*)(Vt + ((size_t)(b * 8 + h) * 128 + d) * TA + ppos) = w;
                }
            }
        }
        if (!hn) break;
        brow = nbrow; bcol = nbcol; GEMM_ADVANCE(); first = false;
    }
}

DI void phase_g2(KP p, int l, unsigned char* smem) {
    const int tid = TIDX(), wid = tid >> 6, lane = tid & 63, wr = wid >> 1, wc = wid & 1, fr = lane & 15, fq = lane >> 4;
    const int li = l >> 1;
    const bf16_t* Y = (const bf16_t*)(p->ws + WS_Y);
    const bf16_t* W = (const bf16_t*)(p->ws + ((l & 1) ? WS_WCO : WS_WABO)) + (size_t)li * 1024 * 1024;
    bf16_t* P = (bf16_t*)(p->ws + WS_P);
    const int nrt = (l == 3 ? ML : MT) / 128;
    auto decode = [&](int i, int& brow, int& bcol) -> bool {
        const int q = xcd_seq(i, nrt * 8); if (q < 0) return false;
        int rt, nt; tile_seq(q, nrt, 8, rt, nt); brow = rt * 128; bcol = nt * 128; return true; };
    int brow, bcol;
    if (!decode(0, brow, bcol)) return;
    const bf16_t* ap[4]; const bf16_t* bp[4]; const bf16_t* apn[4]; const bf16_t* bpn[4];
    gemm_rows(Y, brow, 1024, tid, ap); gemm_rows(W, bcol, 1024, tid, bp);
    bool first = true;
    for (int i = 0;; ++i) {
        int nbrow = brow, nbcol = bcol; const bool hn = decode(i + 1, nbrow, nbcol);
        gemm_rows(Y, nbrow, 1024, tid, apn); gemm_rows(W, nbcol, 1024, tid, bpn);
        f32x4 acc[4][4];
        gemm_tile<true>(smem, ap, bp, 1024, acc, first, hn, apn, bpn);
#pragma unroll
        for (int m = 0; m < 4; ++m) { const int row = brow + wr * 64 + m * 16 + fr;
#pragma unroll
            for (int n = 0; n < 4; ++n) { const f32x4 v = acc[m][n]; u32x2 w; w.x = pk2(v[0], v[1]); w.y = pk2(v[2], v[3]); *(u32x2*)(P + (size_t)row * 1024 + bcol + wc * 64 + n * 16 + fq * 4) = w; } }
        if (!hn) break;
        brow = nbrow; bcol = nbcol; GEMM_ADVANCE(); first = false;
    }
}

template <bool DRY>
DI void phase_ln1r(KP p, int l, unsigned char* smem) {
    constexpr int US = 1028;
    constexpr int RB = 12;
    float* Us = (float*)smem;
    float* Ps = Us + RB * US;
    const int tid = TIDX(), wave = tid >> 6, lane = tid & 63;
    const xres_t* X = (const xres_t*)(p->ws + WS_X); xres_t* Xo = (xres_t*)(p->ws + (DRY ? WS_OB : WS_X)); const bf16_t* P = (const bf16_t*)(p->ws + WS_P); bf16_t* U = (bf16_t*)(p->ws + (DRY ? WS_Y : WS_U));
    const float* MOD = (const float*)(p->ws + WS_MOD); const float* WrT = (const float*)(p->ws + WS_WRT) + (size_t)l * 36 * 1024;
    const float* lng = p->in[6] + l * 1024; const float* lnb = p->in[7] + l * 1024;
    const float* bgrp = p->in[26] + l * 4; const float* brex = p->in[28] + l * 32;
    unsigned* cnt = (unsigned*)(p->ws + WS_CTL) + l * 32 + (DRY ? 256 : 0); int* list = (int*)(p->ws + WS_LIST); float* slotw = (float*)(p->ws + WS_SLOTW);
    const int rows_total = (l == 3) ? ML : MT;
    const int mi = lane & 15, mq = lane >> 4;
    int pend_slot = -1, pend_e = 0; unsigned pend_pos = 0u;
    for (int it = BIDX(); it * RB < rows_total; it += gridDim.x) {
        const int row0 = it * RB + wave * 3;
#pragma unroll
        for (int rr = 0; rr < 3; ++rr) {
            const int rowr = row0 + rr; const bool rvalid = rowr < rows_total; const int row = rvalid ? rowr : rows_total - 1;
            const int r = row < ML ? (row >> 11) : 8;
            const float* mod = MOD + (size_t)(l * 9 + r) * 6144;
            f32x4 v[4]; float s = 0.f;
#pragma unroll
            for (int j = 0; j < 4; ++j) {
                const int k = 256 * j + 4 * lane;
                const f32x4 xv = (l == 0) ? *(const f32x4*)((row < ML ? p->in[0] + (size_t)row * 1024 : p->in[2] + (size_t)(row - ML) * 1024) + k) : xload(X + (size_t)row * 1024 + k);
                const f32x4 g1 = *(const f32x4*)(mod + 2048 + k);
                const u32x2 pw_ = *(const u32x2*)(P + (size_t)row * 1024 + k); const f32x4 pv = (f32x4){bflo(pw_.x), bfhi(pw_.x), bflo(pw_.y), bfhi(pw_.y)};
                v[j] = xv * ALPHA + g1 * pv; s += (v[j][0] + v[j][1]) + (v[j][2] + v[j][3]);
            }
            const float mean = wave_sum(s) * (1.0f / 1024.0f); float s2 = 0.f;
#pragma unroll
            for (int j = 0; j < 4; ++j) { v[j] = v[j] - mean; s2 += (v[j][0] * v[j][0] + v[j][1] * v[j][1]) + (v[j][2] * v[j][2] + v[j][3] * v[j][3]); }
            const float rstd = 1.0f / sqrtf(wave_sum(s2) * (1.0f / 1024.0f) + LN_EPS);
#pragma unroll
            for (int j = 0; j < 4; ++j) {
                const int k = 256 * j + 4 * lane;
                const f32x4 xn = v[j] * rstd * *(const f32x4*)(lng + k) + *(const f32x4*)(lnb + k);
                const f32x4 uu = xn * (1.0f + *(const f32x4*)(mod + 4096 + k)) + *(const f32x4*)(mod + 3072 + k);
                *(f32x4*)(Us + (wave * 3 + rr) * US + k) = uu;
                if (rvalid) {
                    xstore(Xo + (size_t)row * 1024 + k, xn);
                    u32x2 w; w.x = pk2(uu[0], uu[1]); w.y = pk2(uu[2], uu[3]);
                    *(u32x2*)(U + (size_t)row * 1024 + k) = w;
                }
            }
        }
        __syncthreads();
        {
            f32x4 acc[3] = {(f32x4){0.f, 0.f, 0.f, 0.f}, (f32x4){0.f, 0.f, 0.f, 0.f}, (f32x4){0.f, 0.f, 0.f, 0.f}};
            const float* ap = Us + (mi < RB ? mi : mi - RB) * US + 256 * wave + 4 * mq;
            const float* bp0 = WrT + (size_t)mi * 1024 + 256 * wave + 4 * mq;
            const float* bp1 = WrT + (size_t)(16 + mi) * 1024 + 256 * wave + 4 * mq;
            const float* bp2 = WrT + (size_t)(32 + (mi & 3)) * 1024 + 256 * wave + 4 * mq;
#pragma unroll 1
            for (int sb0 = 0; sb0 < 16; sb0 += 8) {
                f32x4 bv[8][3];
#pragma unroll
                for (int q = 0; q < 8; ++q) { bv[q][0] = *(const f32x4*)(bp0 + 16 * (sb0 + q)); bv[q][1] = *(const f32x4*)(bp1 + 16 * (sb0 + q)); bv[q][2] = *(const f32x4*)(bp2 + 16 * (sb0 + q)); }
                __builtin_amdgcn_sched_barrier(0);
#pragma unroll
                for (int q = 0; q < 8; ++q) {
                    const f32x4 a = *(const f32x4*)(ap + 16 * (sb0 + q));
#pragma unroll
                    for (int e = 0; e < 4; ++e) {
                        acc[0] = __builtin_amdgcn_mfma_f32_16x16x4f32(a[e], bv[q][0][e], acc[0], 0, 0, 0);
                        acc[1] = __builtin_amdgcn_mfma_f32_16x16x4f32(a[e], bv[q][1][e], acc[1], 0, 0, 0);
                        acc[2] = __builtin_amdgcn_mfma_f32_16x16x4f32(a[e], bv[q][2][e], acc[2], 0, 0, 0);
                    }
                }
            }
            if (mq < 3) {
#pragma unroll
                for (int nt = 0; nt < 3; ++nt)
#pragma unroll
                    for (int rg = 0; rg < 4; ++rg) Ps[(wave * RB + mq * 4 + rg) * 48 + nt * 16 + mi] = acc[nt][rg];
            }
        }
        __syncthreads();
        if (wave < 2) {
            const int r = wave * 8 + (lane >> 3), c = lane & 7;
            const int rq = r < RB ? r : RB - 1;
            const int row = it * RB + rq;
            float lgv[5];
#pragma unroll
            for (int k = 0; k < 5; ++k) {
                const int o = c + 8 * k; const int oo = o < 36 ? o : 35;
                lgv[k] = (Ps[(0 * RB + rq) * 48 + oo] + Ps[(1 * RB + rq) * 48 + oo]) + (Ps[(2 * RB + rq) * 48 + oo] + Ps[(3 * RB + rq) * 48 + oo]);
            }
            float gv = c < 4 ? lgv[0] + bgrp[c & 3] : -3.0e38f; int gi = c;
#pragma unroll
            for (int off = 1; off < 4; off <<= 1) {
                const float ov = __shfl_xor(gv, off); const int oi = __shfl_xor(gi, off);
                if (ov > gv || (ov == gv && oi < gi)) { gv = ov; gi = oi; }
            }
            const int src0 = lane & ~7;
            const float gmax = __shfl(gv, src0); const int grp = __shfl(gi, src0);
            float ge = c < 4 ? expf(lgv[0] + bgrp[c & 3] - gmax) : 0.f;
            ge += __shfl_xor(ge, 1); ge += __shfl_xor(ge, 2);
            const float gw = 1.0f / __shfl(ge, src0);
            const int j = (c + 4) & 7; const int kk = c >= 4 ? grp : grp + 1;
            float ev = lgv[0];
#pragma unroll
            for (int k = 1; k < 5; ++k) ev = (kk == k) ? lgv[k] : ev;
            ev += brex[grp * 8 + j];
            float v1 = ev; int i1 = j;
#pragma unroll
            for (int off = 1; off < 8; off <<= 1) {
                const float ov = __shfl_xor(v1, off); const int oi = __shfl_xor(i1, off);
                if (ov > v1 || (ov == v1 && oi < i1)) { v1 = ov; i1 = oi; }
            }
            float v2 = (j == i1) ? -3.0e38f : ev; int i2 = (j == i1) ? 99 : j;
#pragma unroll
            for (int off = 1; off < 8; off <<= 1) {
                const float ov = __shfl_xor(v2, off); const int oi = __shfl_xor(i2, off);
                if (ov > v2 || (ov == v2 && oi < i2)) { v2 = ov; i2 = oi; }
            }
            const float e2 = expf(v2 - v1);
            const float w1 = 1.0f / (1.0f + e2), w2 = e2 / (1.0f + e2);
            if (c < 2 && r < RB && row < rows_total) {
                if (pend_slot >= 0) list[(size_t)pend_e * NSLOT + pend_pos] = pend_slot;
                const int e = grp * 8 + (c ? i2 : i1); const float w = gw * (c ? w2 : w1);
                const int slot = row * 2 + c;
                slotw[slot] = w;
                pend_pos = atomicAdd(&cnt[e], 1u); pend_e = e; pend_slot = slot;
            }
        }
        __syncthreads();
    }
    if (pend_slot >= 0) list[(size_t)pend_e * NSLOT + pend_pos] = pend_slot;
}

DI void moe_prefix(KP p, int l, int* s_cnt, int* s_tb, int* s_rb) {
    const int tid = TIDX();
    const unsigned* cnt = (const unsigned*)(p->ws + WS_CTL) + l * 32;
    __syncthreads();
    if (tid < 32) s_cnt[tid] = (int)__hip_atomic_load(cnt + tid, __ATOMIC_RELAXED, __HIP_MEMORY_SCOPE_AGENT);
    __syncthreads();
    if (tid == 0) { int tb = 0; for (int e = 0; e < 32; ++e) { s_tb[e] = tb; s_rb[e] = tb * 128; tb += (s_cnt[e] + 127) >> 7; } s_tb[32] = tb; s_rb[32] = tb * 128; }
    __syncthreads();
}
DI void phase_mg1(KP p, int l, unsigned char* smem) {
    const int tid = TIDX(), wid = tid >> 6, lane = tid & 63, wr = wid >> 1, wc = wid & 1, fr = lane & 15, fq = lane >> 4;
    int* s_cnt = (int*)(smem + 65536 + 64); int* s_tb = s_cnt + 32; int* s_rb = s_tb + 33;
    moe_prefix(p, l, s_cnt, s_tb, s_rb);
    const bf16_t* U = (const bf16_t*)(p->ws + WS_U); const int* list = (const int*)(p->ws + WS_LIST);
    bf16_t* H = (bf16_t*)(p->ws + WS_H);
    const int ntiles = s_tb[32] * 8;
    struct TI { int e, rt, nt, cnt_e; };
    auto decode = [&](int i, TI& t) -> bool {
        const int tile = xcd_seq(i, ntiles); if (tile < 0) return false;
        const int rtg = tile >> 3; t.nt = tile & 7;
        int e = 0;
        for (int q = 1; q < 32; ++q) if (rtg >= s_tb[q]) e = q;
        t.e = e; t.rt = rtg - s_tb[e]; t.cnt_e = s_cnt[e]; return true; };
    auto rows = [&](const TI& t, const bf16_t* (&a)[4], const bf16_t* (&b)[4]) {
#pragma unroll
        for (int i_ = 0; i_ < 4; ++i_) {
            const int pos = t.rt * 128 + (tid >> 3) + 32 * i_;
            const int tok = pos < t.cnt_e ? (list[(size_t)t.e * NSLOT + pos] >> 1) : 0;
            a[i_] = U + (size_t)tok * 1024 + gemm_chunk(tid) * 8;
        }
        gemm_rows((const bf16_t*)(p->ws + WS_WGU) + (size_t)(l * 32 + t.e) * 1024 * 1024, t.nt * 128, 1024, tid, b); };
    TI cur, nxt;
    if (!decode(0, cur)) return;
    const bf16_t* ap[4]; const bf16_t* bp[4]; const bf16_t* apn[4]; const bf16_t* bpn[4];
    rows(cur, ap, bp);
    bool first = true;
    for (int i = 0;; ++i) {
        nxt = cur; const bool hn = decode(i + 1, nxt);
        rows(nxt, apn, bpn);
        f32x4 acc[4][4];
        gemm_tile<true>(smem, ap, bp, 1024, acc, first, hn, apn, bpn);
        const int hrow0 = s_rb[cur.e] + cur.rt * 128 + wr * 64;
#pragma unroll
        for (int m = 0; m < 4; ++m) {
            bf16_t* o = H + (size_t)(hrow0 + m * 16 + fr) * 512 + cur.nt * 64 + wc * 32 + fq * 4;
#pragma unroll
            for (int n = 0; n < 4; n += 2) {
                const f32x4 g = acc[m][n], uu = acc[m][n + 1]; f32x4 h;
#pragma unroll
                for (int j = 0; j < 4; ++j) h[j] = siluf(g[j]) * uu[j];
                u32x2 w; w.x = pk2(h[0], h[1]); w.y = pk2(h[2], h[3]);
                *(u32x2*)(o + (n >> 1) * 16) = w;
            }
        }
        if (!hn) break;
        cur = nxt; GEMM_ADVANCE(); first = false;
    }
}
DI void phase_mg2(KP p, int l, unsigned char* smem) {
    const int tid = TIDX(), wid = tid >> 6, lane = tid & 63, wr = wid >> 1, wc = wid & 1, fr = lane & 15, fq = lane >> 4;
    int* s_cnt = (int*)(smem + 65536 + 64); int* s_tb = s_cnt + 32; int* s_rb = s_tb + 33;
    moe_prefix(p, l, s_cnt, s_tb, s_rb);
    const bf16_t* H = (const bf16_t*)(p->ws + WS_H); const int* list = (const int*)(p->ws + WS_LIST); const float* slotw = (const float*)(p->ws + WS_SLOTW);
    bf16_t* YS = (bf16_t*)(p->ws + WS_YS);
    const int ntiles = s_tb[32] * 8;
    struct TI { int e, rt, nt, cnt_e; };
    auto decode = [&](int i, TI& t) -> bool {
        const int tile = xcd_seq(i, ntiles); if (tile < 0) return false;
        const int rtg = tile >> 3; t.nt = tile & 7;
        int e = 0;
        for (int q = 1; q < 32; ++q) if (rtg >= s_tb[q]) e = q;
        t.e = e; t.rt = rtg - s_tb[e]; t.cnt_e = s_cnt[e]; return true; };
    auto rows = [&](const TI& t, const bf16_t* (&a)[4], const bf16_t* (&b)[4]) {
        gemm_rows(H, s_rb[t.e] + t.rt * 128, 512, tid, a);
        gemm_rows((const bf16_t*)(p->ws + WS_WD) + (size_t)(l * 32 + t.e) * 1024 * 512, t.nt * 128, 512, tid, b); };
    TI cur, nxt;
    if (!decode(0, cur)) return;
    const bf16_t* ap[4]; const bf16_t* bp[4]; const bf16_t* apn[4]; const bf16_t* bpn[4];
    rows(cur, ap, bp);
    bool first = true;
    for (int i = 0;; ++i) {
        nxt = cur; const bool hn = decode(i + 1, nxt);
        rows(nxt, apn, bpn);
        int eslot[4]; float ew[4];
#pragma unroll
        for (int m = 0; m < 4; ++m) {
            const int pos = cur.rt * 128 + wr * 64 + m * 16 + fr;
            eslot[m] = pos < cur.cnt_e ? list[(size_t)cur.e * NSLOT + pos] : -1;
        }
#pragma unroll
        for (int m = 0; m < 4; ++m) ew[m] = eslot[m] >= 0 ? slotw[eslot[m]] : 0.f;
        f32x4 acc[4][4];
        gemm_tile<true>(smem, ap, bp, 512, acc, first, hn, apn, bpn);
#pragma unroll
        for (int m = 0; m < 4; ++m) {
            if (eslot[m] >= 0) {
                const int slot = eslot[m]; const float w = ew[m];
                bf16_t* o = YS + (size_t)slot * 1024 + cur.nt * 128 + wc * 64 + fq * 4;
#pragma unroll
                for (int n = 0; n < 4; ++n) { const f32x4 v = acc[m][n] * w; u32x2 ww; ww.x = pk2(v[0], v[1]); ww.y = pk2(v[2], v[3]); *(u32x2*)(o + n * 16) = ww; }
            }
        }
        if (!hn) break;
        cur = nxt; GEMM_ADVANCE(); first = false;
    }
}

template <bool DRY>
DI void phase_ln2(KP p, int l) {
    const int tid = TIDX(), wave = tid >> 6, lane = tid & 63;
    const xres_t* X = (const xres_t*)(p->ws + WS_X); xres_t* Xo = (xres_t*)(p->ws + (DRY ? WS_OB : WS_X)); const bf16_t* YS = (const bf16_t*)(p->ws + WS_YS); bf16_t* U = (bf16_t*)(p->ws + (DRY ? WS_Y : WS_U));
    const float* MOD = (const float*)(p->ws + WS_MOD);
    const float* lng = p->in[8] + l * 1024; const float* lnb = p->in[9] + l * 1024;
    const int rows_total = (l == 3) ? ML : MT;
    u32x2 ry0[2][4], ry1[2][4]; f32x4 rx[2][4];
    const int rstride = gridDim.x * 8;
    int row0 = (BIDX() * 4 + wave) * 2;
#define LN2_FETCH(R0) { _Pragma("unroll") for (int q = 0; q < 2; ++q) { const int row = (R0) + q; _Pragma("unroll") for (int j = 0; j < 4; ++j) { const int k = 256 * j + 4 * lane; \
        ry0[q][j] = *(const u32x2*)(YS + (size_t)(2 * row) * 1024 + k); ry1[q][j] = *(const u32x2*)(YS + (size_t)(2 * row + 1) * 1024 + k); rx[q][j] = xload(X + (size_t)row * 1024 + k); } } }
    if (row0 < rows_total) LN2_FETCH(row0)
#pragma unroll 1
    for (; row0 < rows_total; row0 += rstride) {
        f32x4 v[2][4]; float s[2] = {0.f, 0.f};
        const float* mod[2];
#pragma unroll
        for (int q = 0; q < 2; ++q) {
            const int row = row0 + q; const int r = row < ML ? (row >> 11) : 8;
            mod[q] = MOD + (size_t)(l * 9 + r) * 6144;
#pragma unroll
            for (int j = 0; j < 4; ++j) {
                const int k = 256 * j + 4 * lane;
                const u32x2 y0 = ry0[q][j], y1 = ry1[q][j];
                f32x4 y; y[0] = bflo(y0.x) + bflo(y1.x); y[1] = bfhi(y0.x) + bfhi(y1.x); y[2] = bflo(y0.y) + bflo(y1.y); y[3] = bfhi(y0.y) + bfhi(y1.y);
                const f32x4 xv = rx[q][j], g2 = *(const f32x4*)(mod[q] + 5120 + k);
                v[q][j] = xv * ALPHA + g2 * y; s[q] += (v[q][j][0] + v[q][j][1]) + (v[q][j][2] + v[q][j][3]);
            }
        }
        if (row0 + rstride < rows_total) LN2_FETCH(row0 + rstride)
        float mean[2], rstd[2];
#pragma unroll
        for (int q = 0; q < 2; ++q) mean[q] = wave_sum(s[q]) * (1.0f / 1024.0f);
#pragma unroll
        for (int q = 0; q < 2; ++q) {
            float s2 = 0.f;
#pragma unroll
            for (int j = 0; j < 4; ++j) { v[q][j] = v[q][j] - mean[q]; s2 += (v[q][j][0] * v[q][j][0] + v[q][j][1] * v[q][j][1]) + (v[q][j][2] * v[q][j][2] + v[q][j][3] * v[q][j][3]); }
            s[q] = s2;
        }
#pragma unroll
        for (int q = 0; q < 2; ++q) rstd[q] = 1.0f / sqrtf(wave_sum(s[q]) * (1.0f / 1024.0f) + LN_EPS);
#pragma unroll
        for (int q = 0; q < 2; ++q) {
            const int row = row0 + q;
            const float* modn = mod[q] + (l + 1 < 4 ? 9 * 6144 : 0);
#pragma unroll
            for (int j = 0; j < 4; ++j) {
                const int k = 256 * j + 4 * lane;
                const f32x4 xn = v[q][j] * rstd[q] * *(const f32x4*)(lng + k) + *(const f32x4*)(lnb + k);
                if (l < 3) {
                    xstore(Xo + (size_t)row * 1024 + k, xn);
                    const f32x4 uu = xn * (1.0f + *(const f32x4*)(modn + 1024 + k)) + *(const f32x4*)(modn + k);
                    u32x2 w; w.x = pk2(uu[0], uu[1]); w.y = pk2(uu[2], uu[3]);
                    *(u32x2*)(U + (size_t)row * 1024 + k) = w;
                } else {
                    *(f32x4*)(p->out + (size_t)row * 1024 + k) = xn;
                }
            }
        }
    }
}

DI s16x4 tr_read(const unsigned char* ptr) {
    typedef short v4i16_t __attribute__((ext_vector_type(4)));
    return __builtin_bit_cast(s16x4, __builtin_amdgcn_ds_read_tr16_b64_v4i16((LAS v4i16_t*)ptr));
}
DI bf16x8 cat8(s16x4 a, s16x4 b) { return __builtin_shufflevector(a, b, 0, 1, 2, 3, 4, 5, 6, 7); }

DI void phase_decay(KP p, int l, unsigned char* smem) {
    const int tid = TIDX();
    const int li = l >> 1;
    const float* LR = (const float*)(p->ws + WS_LR);
    float* PF = (float*)(p->ws + WS_PF); float* SQ = (float*)(p->ws + WS_SQ); float* SK = (float*)(p->ws + WS_SK); float* TOT = (float*)(p->ws + WS_TOT);
    float* lrs = (float*)smem;
    float wf[16], wb[16];
#pragma unroll
    for (int r = 0; r < 16; ++r) { wf[r] = p->in[11][(size_t)li * 16 * 256 + r * 256 + tid]; wb[r] = p->in[13][(size_t)li * 16 * 256 + r * 256 + tid]; }
    const float bf = p->in[12][li * 256 + tid], bb = p->in[14][li * 256 + tid];
    for (int it = BIDX(); it < 2 * (MT / 64); it += gridDim.x) {
        const int ch = it >> 1, dr = it & 1;
        const int row0 = ch * 64;
        __syncthreads();
        { const int tok = tid >> 2, q4 = tid & 3; *(f32x4*)(lrs + tok * 16 + q4 * 4) = *(const f32x4*)(LR + (size_t)(row0 + tok) * 32 + dr * 16 + q4 * 4); }
        __syncthreads();
        float run = 0.f;
        if (dr == 0) {
            for (int t = 0; t < 64; ++t) {
                float g = bf;
#pragma unroll
                for (int r = 0; r < 16; ++r) g += lrs[t * 16 + r] * wf[r];
                run += (fminf(g, 0.f) - __logf(1.0f + __expf(-fabsf(g)))) * (1.0f / 16.0f);
                PF[(size_t)(row0 + t) * 256 + tid] = run;
            }
        } else {
            for (int t = 63; t >= 0; --t) {
                float g = bb;
#pragma unroll
                for (int r = 0; r < 16; ++r) g += lrs[t * 16 + r] * wb[r];
                SQ[(size_t)(row0 + t) * 256 + tid] = run;
                run += (fminf(g, 0.f) - __logf(1.0f + __expf(-fabsf(g)))) * (1.0f / 16.0f);
                SK[(size_t)(row0 + t) * 256 + tid] = run;
            }
        }
        TOT[(size_t)(ch * 2 + dr) * 256 + tid] = run;
    }
}

template <int DK>
DI void scan_item(KP p, int l, int item, unsigned char* smem) {
    constexpr bool ISA = (DK == 128);
    constexpr int QS = DK * 2 + 16, KS = DK * 2 + 32, VS = 96, AS_ = 144, SS = DK * 2 + 16, NKS = DK / 32, NMT = DK / 64;
    constexpr int O_QD = 0, O_KD = O_QD + 64 * QS, O_V = O_KD + 64 * KS, O_ATT = O_V + 64 * VS, O_ST = O_ATT + 64 * AS_, O_END = O_ST + 32 * SS;
    static_assert(O_END <= 65536, "scan LDS");
    constexpr int NP = DK / 64 * 2;
    constexpr int CPR = DK / 8;
    const int tid = TIDX(), wid = tid >> 6, lane = tid & 63, fr = lane & 15, fq = lane >> 4;
    const int b = item >> 5, h = (item >> 3) & 3, dir = (item >> 2) & 1, dvq = item & 3;
    const bf16_t* Z = (const bf16_t*)(p->ws + WS_Z);
    const float* EQ = (const float*)(p->ws + (dir ? WS_SQ : WS_PF)); const float* EK = (const float*)(p->ws + (dir ? WS_SK : WS_PF)); const float* TOT = (const float*)(p->ws + WS_TOT);
    bf16_t* OUT = (bf16_t*)(p->ws + (dir ? WS_OB : WS_OF));
    const int qcol = ISA ? h * 128 : 2048 + h * 64, kcol = ISA ? 512 + h * 128 : 2304 + h * 64, vcol = (ISA ? 1024 : 2560) + h * 128 + dvq * 32;
    const int ocol = (ISA ? 0 : 512) + h * 128 + dvq * 32;
    float lam = 0.f;
    if (ISA) lam = log1pf(-exp2f(-((dir ? 5.5f : 5.0f) + (float)h)));
    f32x4 S[NMT][2];
#pragma unroll
    for (int a = 0; a < NMT; ++a) { S[a][0] = (f32x4){0.f, 0.f, 0.f, 0.f}; S[a][1] = (f32x4){0.f, 0.f, 0.f, 0.f}; }
    __syncthreads();
    for (int i = tid; i < 32 * SS / 4; i += 256) ((unsigned*)(smem + O_ST))[i] = 0u;
    auto chunk_row0 = [&](int cc) -> int {
        const int ci = dir ? 35 - cc : cc; const int pp = ci * 64;
        if (!dir) return pp < 256 ? ML + b * 256 + pp : b * 2048 + (pp - 256);
        return pp < 2048 ? b * 2048 + pp : ML + b * 256 + (pp - 2048);
    };
    u32x4 rq[NP], rk[NP], rv; f32x4 eq[ISA ? 1 : NP][2], ek[ISA ? 1 : NP][2]; f32x4 tv[NMT];
    auto fetch = [&](int cc) {
        const int row0 = chunk_row0(cc);
        if (!ISA) {
#pragma unroll
            for (int a = 0; a < NMT; ++a) tv[a] = *(const f32x4*)(TOT + (size_t)((row0 >> 6) * 2 + dir) * 256 + h * 64 + (wid * NMT + a) * 16 + fq * 4);
        }
#pragma unroll
        for (int i = 0; i < NP; ++i) {
            const int id = tid + 256 * i, tok = id / CPR, cg_ = id % CPR;
            const size_t ro = (size_t)(row0 + tok) * ZS;
            rq[i] = *(const u32x4*)(Z + ro + qcol + cg_ * 8); rk[i] = *(const u32x4*)(Z + ro + kcol + cg_ * 8);
            if (!ISA) {
                const size_t eo = (size_t)(row0 + tok) * 256 + h * 64 + cg_ * 8;
                eq[i][0] = *(const f32x4*)(EQ + eo); eq[i][1] = *(const f32x4*)(EQ + eo + 4);
                ek[i][0] = *(const f32x4*)(EK + eo); ek[i][1] = *(const f32x4*)(EK + eo + 4);
            }
        }
        { const int tok = tid >> 2, cg_ = tid & 3; rv = *(const u32x4*)(Z + (size_t)(row0 + tok) * ZS + vcol + cg_ * 8); }
    };
    float ra[NP], rc[NP];
#pragma unroll
    for (int i = 0; i < NP; ++i) {
        const int tok = (tid + 256 * i) / CPR;
        ra[i] = dir ? __expf(lam * (float)(63 - tok)) : __expf(lam * (float)(tok + 1));
        rc[i] = dir ? __expf(-lam * (float)(64 - tok)) : __expf(-lam * (float)(tok + 1));
    }
    const float decA = __expf(lam * 64.0f);
    fetch(0);
    for (int cc = 0; cc < 36; ++cc) {
        const int row0 = chunk_row0(cc);
#pragma unroll
        for (int i = 0; i < NP; ++i) {
            const int id = tid + 256 * i, tok = id / CPR, cg_ = id % CPR;
            float fqv[8], fkv[8];
            if (ISA) {
#pragma unroll
                for (int e = 0; e < 8; ++e) { fqv[e] = ra[i]; fkv[e] = rc[i]; }
            } else {
#pragma unroll
                for (int e = 0; e < 8; ++e) { fqv[e] = __expf(eq[i][e >> 2][e & 3]); fkv[e] = __expf(-ek[i][e >> 2][e & 3]); }
            }
            const u32x4 q = rq[i], k = rk[i]; u32x4 qo, ko;
            qo.x = pk2(bflo(q.x) * fqv[0], bfhi(q.x) * fqv[1]); qo.y = pk2(bflo(q.y) * fqv[2], bfhi(q.y) * fqv[3]); qo.z = pk2(bflo(q.z) * fqv[4], bfhi(q.z) * fqv[5]); qo.w = pk2(bflo(q.w) * fqv[6], bfhi(q.w) * fqv[7]);
            ko.x = pk2(bflo(k.x) * fkv[0], bfhi(k.x) * fkv[1]); ko.y = pk2(bflo(k.y) * fkv[2], bfhi(k.y) * fkv[3]); ko.z = pk2(bflo(k.z) * fkv[4], bfhi(k.z) * fkv[5]); ko.w = pk2(bflo(k.w) * fkv[6], bfhi(k.w) * fkv[7]);
            *(u32x4*)(smem + O_QD + tok * QS + cg_ * 16) = qo;
            *(u32x4*)(smem + O_KD + tok * KS + cg_ * 16) = ko;
        }
        { const int tok = tid >> 2, cg_ = tid & 3; *(u32x4*)(smem + O_V + tok * VS + cg_ * 16) = rv; }
        f32x4 dec[NMT];
#pragma unroll
        for (int a = 0; a < NMT; ++a) {
            if (ISA) dec[a] = (f32x4){decA, decA, decA, decA};
            else dec[a] = (f32x4){__expf(tv[a][0]), __expf(tv[a][1]), __expf(tv[a][2]), __expf(tv[a][3])};
        }
        if (cc + 1 < 36) fetch(cc + 1);
        __syncthreads();
        bf16x8 afr[2];
        {
            f32x4 at[4];
#pragma unroll
            for (int n = 0; n < 4; ++n) at[n] = (f32x4){0.f, 0.f, 0.f, 0.f};
#pragma unroll
            for (int ks = 0; ks < NKS; ++ks) {
                const bf16x8 qf = *(const bf16x8*)(smem + O_QD + (16 * wid + fr) * QS + (32 * ks + 8 * fq) * 2);
#pragma unroll
                for (int n = 0; n < 4; ++n) {
                    const bf16x8 kf = *(const bf16x8*)(smem + O_KD + (16 * n + fr) * KS + (32 * ks + 8 * fq) * 2);
                    at[n] = __builtin_amdgcn_mfma_f32_16x16x32_bf16(kf, qf, at[n], 0, 0, 0);
                }
            }
            const int i = 16 * wid + fr;
#pragma unroll
            for (int n = 0; n < 4; ++n)
#pragma unroll
                for (int jj = 0; jj < 4; ++jj) { const int j = n * 16 + fq * 4 + jj; const bool keep = dir ? (j > i) : (j <= i); at[n][jj] = keep ? at[n][jj] : 0.f; }
#pragma unroll
            for (int ks = 0; ks < 2; ++ks) {
                u32x4 w; w.x = pk2(at[2 * ks][0], at[2 * ks][1]); w.y = pk2(at[2 * ks][2], at[2 * ks][3]); w.z = pk2(at[2 * ks + 1][0], at[2 * ks + 1][1]); w.w = pk2(at[2 * ks + 1][2], at[2 * ks + 1][3]);
                afr[ks] = __builtin_bit_cast(bf16x8, w);
            }
        }
        bf16x8 vf[2][2];
        {
            const int g = lane >> 4, i16 = lane & 15, q = i16 >> 2, pq = i16 & 3;
#pragma unroll
            for (int ks = 0; ks < 2; ++ks)
#pragma unroll
                for (int n = 0; n < 2; ++n) {
                    const unsigned char* a = smem + O_V + (32 * ks + 4 * g + q) * VS + (n * 16 + 4 * pq) * 2;
                    vf[ks][n] = cat8(tr_read(a), tr_read(a + 16 * VS));
                }
        }
        {
            f32x4 oa[2] = {(f32x4){0.f, 0.f, 0.f, 0.f}, (f32x4){0.f, 0.f, 0.f, 0.f}};
#pragma unroll
            for (int ks = 0; ks < 2; ++ks)
#pragma unroll
                for (int n = 0; n < 2; ++n) oa[n] = __builtin_amdgcn_mfma_f32_16x16x32_bf16(vf[ks][n], afr[ks], oa[n], 0, 0, 0);
#pragma unroll
            for (int ks = 0; ks < NKS; ++ks) {
                const bf16x8 qf = *(const bf16x8*)(smem + O_QD + (16 * wid + fr) * QS + (32 * ks + 8 * fq) * 2);
#pragma unroll
                for (int n = 0; n < 2; ++n) {
                    const bf16x8 sf = *(const bf16x8*)(smem + O_ST + (16 * n + fr) * SS + (32 * ks + 8 * fq) * 2);
                    oa[n] = __builtin_amdgcn_mfma_f32_16x16x32_bf16(sf, qf, oa[n], 0, 0, 0);
                }
            }
            bf16_t* o = OUT + (size_t)(row0 + 16 * wid + fr) * 1024 + ocol + fq * 4;
            u32x2 w0, w1; w0.x = pk2(oa[0][0], oa[0][1]); w0.y = pk2(oa[0][2], oa[0][3]); w1.x = pk2(oa[1][0], oa[1][1]); w1.y = pk2(oa[1][2], oa[1][3]);
            *(u32x2*)(o) = w0; *(u32x2*)(o + 16) = w1;
        }
        {
            const int g = lane >> 4, i16 = lane & 15, q = i16 >> 2, pq = i16 & 3;
#pragma unroll
            for (int a = 0; a < NMT; ++a) {
                const int mt = wid * NMT + a;
#pragma unroll
                for (int ks = 0; ks < 2; ++ks) {
                    const unsigned char* ka = smem + O_KD + (32 * ks + 4 * g + q) * KS + (mt * 16 + 4 * pq) * 2;
                    const bf16x8 kf = cat8(tr_read(ka), tr_read(ka + 16 * KS));
#pragma unroll
                    for (int n = 0; n < 2; ++n) S[a][n] = __builtin_amdgcn_mfma_f32_16x16x32_bf16(kf, vf[ks][n], S[a][n], 0, 0, 0);
                }
                S[a][0] *= dec[a]; S[a][1] *= dec[a];
            }
        }
        __syncthreads();
#pragma unroll
        for (int a = 0; a < NMT; ++a) {
            const int mt = wid * NMT + a;
#pragma unroll
            for (int n = 0; n < 2; ++n) { u32x2 w; w.x = pk2(S[a][n][0], S[a][n][1]); w.y = pk2(S[a][n][2], S[a][n][3]); *(u32x2*)(smem + O_ST + (n * 16 + fr) * SS + (mt * 16 + fq * 4) * 2) = w; }
        }
    }
    __syncthreads();
}
DI void phase_scan(KP p, int l, unsigned char* smem) {
    for (int it = BIDX(); it < 512; it += gridDim.x) {
        if (it < 256) scan_item<128>(p, l, it, smem); else scan_item<64>(p, l, it - 256, smem);
    }
}

DI void phase_merge(KP p, int l) {
    const int tid = TIDX(), wave = tid >> 6, lane = tid & 63;
    const int li = l >> 1;
    const bf16_t* OF = (const bf16_t*)(p->ws + WS_OF); const bf16_t* OB = (const bf16_t*)(p->ws + WS_OB);
    const bf16_t* Z = (const bf16_t*)(p->ws + WS_Z); bf16_t* Y = (bf16_t*)(p->ws + WS_Y);
    const bool isA = lane < 32;
    const float* gn = isA ? p->in[15] + li * 512 + lane * 16 : p->in[16] + li * 512 + (lane - 32) * 16;
    const int gcol = isA ? 1536 + lane * 16 : 3072 + (lane - 32) * 16;
    for (int row = BIDX() * 4 + wave; row < MT; row += gridDim.x * 4) {
        float o[16]; float s = 0.f;
#pragma unroll
        for (int j = 0; j < 2; ++j) {
            const u32x4 a = *(const u32x4*)(OF + (size_t)row * 1024 + lane * 16 + j * 8), bb = *(const u32x4*)(OB + (size_t)row * 1024 + lane * 16 + j * 8);
            o[j * 8 + 0] = bflo(a.x) + bflo(bb.x); o[j * 8 + 1] = bfhi(a.x) + bfhi(bb.x); o[j * 8 + 2] = bflo(a.y) + bflo(bb.y); o[j * 8 + 3] = bfhi(a.y) + bfhi(bb.y);
            o[j * 8 + 4] = bflo(a.z) + bflo(bb.z); o[j * 8 + 5] = bfhi(a.z) + bfhi(bb.z); o[j * 8 + 6] = bflo(a.w) + bflo(bb.w); o[j * 8 + 7] = bfhi(a.w) + bfhi(bb.w);
        }
#pragma unroll
        for (int e = 0; e < 16; ++e) s += o[e];
        s += __shfl_xor(s, 1); s += __shfl_xor(s, 2); s += __shfl_xor(s, 4);
        const float mean = isA ? s * (1.0f / 128.0f) : 0.f;
        float s2 = 0.f;
#pragma unroll
        for (int e = 0; e < 16; ++e) { o[e] -= mean; s2 += o[e] * o[e]; }
        s2 += __shfl_xor(s2, 1); s2 += __shfl_xor(s2, 2); s2 += __shfl_xor(s2, 4);
        const float rs = 1.0f / sqrtf(s2 * (1.0f / 128.0f) + LN_EPS);
        const u32x4 g0 = *(const u32x4*)(Z + (size_t)row * ZS + gcol), g1 = *(const u32x4*)(Z + (size_t)row * ZS + gcol + 8);
        float gt[16];
        gt[0] = bflo(g0.x); gt[1] = bfhi(g0.x); gt[2] = bflo(g0.y); gt[3] = bfhi(g0.y); gt[4] = bflo(g0.z); gt[5] = bfhi(g0.z); gt[6] = bflo(g0.w); gt[7] = bfhi(g0.w);
        gt[8] = bflo(g1.x); gt[9] = bfhi(g1.x); gt[10] = bflo(g1.y); gt[11] = bfhi(g1.y); gt[12] = bflo(g1.z); gt[13] = bfhi(g1.z); gt[14] = bflo(g1.w); gt[15] = bfhi(g1.w);
        float y[16];
#pragma unroll
        for (int e = 0; e < 16; ++e) y[e] = siluf(gt[e]) * (o[e] * rs * gn[e]);
        u32x4 w0, w1;
        w0.x = pk2(y[0], y[1]); w0.y = pk2(y[2], y[3]); w0.z = pk2(y[4], y[5]); w0.w = pk2(y[6], y[7]);
        w1.x = pk2(y[8], y[9]); w1.y = pk2(y[10], y[11]); w1.z = pk2(y[12], y[13]); w1.w = pk2(y[14], y[15]);
        *(u32x4*)(Y + (size_t)row * 1024 + lane * 16) = w0; *(u32x4*)(Y + (size_t)row * 1024 + lane * 16 + 8) = w1;
    }
}

DI int crow(int r, int hi) { return (r & 3) + 8 * (r >> 2) + 4 * hi; }
constexpr int ATT_BUF = 24576;
DI void att_component(const bf16_t* Qc, const bf16_t* Kc, const bf16_t* Vt, unsigned char* smem, float* wsf, int b, int h, int comp, int p0, int nkv, f32x16 (&O)[4]) {
    const int tid = TIDX(), wid = tid >> 6, lane = tid & 63, r32 = lane & 31, hi = lane >> 5;
    const int hc = h * 2 + comp;
    const bf16_t* Qb = Qc + ((size_t)(b * 16 + hc) * TA + p0 + wid * 32 + r32) * 64;
    const int gch = gemm_chunk(tid);
    const bf16_t* Kg = Kc + (size_t)(b * 16 + hc) * TA * 64 + (size_t)(tid >> 3) * 64 + gch * 8;
    const bf16_t* Vg = Vt + (size_t)(b * 8 + h) * 128 * TA + (size_t)(tid >> 3) * TA + gch * 8;
#define ATT_STAGE(buf, kt) do { \
        _Pragma("unroll") for (int i_ = 0; i_ < 2; ++i_) __builtin_amdgcn_global_load_lds((const unsigned*)(Kg + (size_t)((kt) + 32 * i_) * 64), (LAS unsigned*)(smem + (buf) * ATT_BUF + i_ * 4096 + tid * 16), 16, 0, 0); \
        _Pragma("unroll") for (int i_ = 0; i_ < 4; ++i_) __builtin_amdgcn_global_load_lds((const unsigned*)(Vg + (size_t)(32 * i_) * TA + (kt)), (LAS unsigned*)(smem + (buf) * ATT_BUF + 8192 + i_ * 4096 + tid * 16), 16, 0, 0); } while (0)
    ATT_STAGE(0, 0);
    bf16x8 qf[4];
#pragma unroll
    for (int ks = 0; ks < 4; ++ks) qf[ks] = *(const bf16x8*)(Qb + ks * 16 + hi * 8);
#pragma unroll
    for (int d0 = 0; d0 < 4; ++d0)
#pragma unroll
        for (int r = 0; r < 16; ++r) O[d0][r] = 0.f;
    float m_run = -1.0e30f, l_run = 0.f;
    const int sw = (r32 >> 1) & 7;
    const int nt = nkv >> 6;
    for (int t = 0; t < nt; ++t) {
        asm volatile("s_waitcnt vmcnt(0)" ::: "memory");
        __syncthreads();
        if (t + 1 < nt) ATT_STAGE((t + 1) & 1, (t + 1) * 64);
        const unsigned char* Kt = smem + (t & 1) * ATT_BUF; const unsigned char* Vtl = Kt + 8192;
        bf16x8 kf0[4], kf1[4];
#pragma unroll
        for (int ks = 0; ks < 4; ++ks) {
            const unsigned co = (unsigned)(((ks * 2 + hi) ^ sw) << 4);
            kf0[ks] = *(const bf16x8*)(Kt + r32 * 128 + co);
            kf1[ks] = *(const bf16x8*)(Kt + (32 + r32) * 128 + co);
        }
        const unsigned char* vr = Vtl + r32 * 128;
#define ATT_VLOAD(dst, st_) do { const unsigned o1_ = (unsigned)((((st_) * 2 + hi) ^ sw) << 4); \
        _Pragma("unroll") for (int d0_ = 0; d0_ < 4; ++d0_) dst[d0_] = *(const bf16x8*)(vr + d0_ * 4096 + o1_); } while (0)
        bf16x8 va[4], vb[4];
        ATT_VLOAD(va, 0);
        f32x16 s0, s1;
#pragma unroll
        for (int r = 0; r < 16; ++r) { s0[r] = 0.f; s1[r] = 0.f; }
#pragma unroll
        for (int ks = 0; ks < 4; ++ks) {
            s0 = __builtin_amdgcn_mfma_f32_32x32x16_bf16(kf0[ks], qf[ks], s0, 0, 0, 0);
            s1 = __builtin_amdgcn_mfma_f32_32x32x16_bf16(kf1[ks], qf[ks], s1, 0, 0, 0);
        }
        float mxa[8];
#pragma unroll
        for (int i_ = 0; i_ < 8; ++i_) mxa[i_] = fmaxf(fmaxf(s0[2 * i_], s0[2 * i_ + 1]), fmaxf(s1[2 * i_], s1[2 * i_ + 1]));
        float mx = fmaxf(fmaxf(fmaxf(mxa[0], mxa[1]), fmaxf(mxa[2], mxa[3])), fmaxf(fmaxf(mxa[4], mxa[5]), fmaxf(mxa[6], mxa[7])));
        { const auto rr = __builtin_amdgcn_permlane32_swap(__float_as_uint(mx), __float_as_uint(mx), false, false); mx = fmaxf(__uint_as_float(rr[0]), __uint_as_float(rr[1])); }
        if (__any(mx > m_run + 8.0f)) {
            const float m_new = fmaxf(m_run, mx);
            const float alpha = __builtin_amdgcn_exp2f((m_run - m_new) * L2E);
            l_run *= alpha; m_run = m_new;
            if (hi == 0) wsf[r32] = alpha;
            asm volatile("s_waitcnt lgkmcnt(0)" ::: "memory");
            float ar[16];
#pragma unroll
            for (int r = 0; r < 16; ++r) ar[r] = wsf[crow(r, hi)];
#pragma unroll
            for (int d0 = 0; d0 < 4; ++d0)
#pragma unroll
                for (int r = 0; r < 16; ++r) O[d0][r] *= ar[r];
            asm volatile("s_waitcnt lgkmcnt(0)" ::: "memory");
        }
        const float mb = m_run * L2E;
        float ps = 0.f;
#pragma unroll
        for (int r = 0; r < 16; ++r) { s0[r] = __builtin_amdgcn_exp2f(s0[r] * L2E - mb); s1[r] = __builtin_amdgcn_exp2f(s1[r] * L2E - mb); ps += s0[r] + s1[r]; }
        l_run += ps;
        u32x4 pw[4];
#pragma unroll
        for (int s = 0; s < 2; ++s) {
            pw[s].x = pk2(s0[8 * s + 0], s0[8 * s + 1]); pw[s].y = pk2(s0[8 * s + 2], s0[8 * s + 3]); pw[s].z = pk2(s0[8 * s + 4], s0[8 * s + 5]); pw[s].w = pk2(s0[8 * s + 6], s0[8 * s + 7]);
            pw[2 + s].x = pk2(s1[8 * s + 0], s1[8 * s + 1]); pw[2 + s].y = pk2(s1[8 * s + 2], s1[8 * s + 3]); pw[2 + s].z = pk2(s1[8 * s + 4], s1[8 * s + 5]); pw[2 + s].w = pk2(s1[8 * s + 6], s1[8 * s + 7]);
        }
#pragma unroll
        ATT_VLOAD(vb, 1);
#pragma unroll
        for (int d0 = 0; d0 < 4; ++d0) O[d0] = __builtin_amdgcn_mfma_f32_32x32x16_bf16(__builtin_bit_cast(bf16x8, pw[0]), va[d0], O[d0], 0, 0, 0);
        ATT_VLOAD(va, 2);
#pragma unroll
        for (int d0 = 0; d0 < 4; ++d0) O[d0] = __builtin_amdgcn_mfma_f32_32x32x16_bf16(__builtin_bit_cast(bf16x8, pw[1]), vb[d0], O[d0], 0, 0, 0);
        ATT_VLOAD(vb, 3);
#pragma unroll
        for (int d0 = 0; d0 < 4; ++d0) O[d0] = __builtin_amdgcn_mfma_f32_32x32x16_bf16(__builtin_bit_cast(bf16x8, pw[2]), va[d0], O[d0], 0, 0, 0);
#pragma unroll
        for (int d0 = 0; d0 < 4; ++d0) O[d0] = __builtin_amdgcn_mfma_f32_32x32x16_bf16(__builtin_bit_cast(bf16x8, pw[3]), vb[d0], O[d0], 0, 0, 0);
#undef ATT_VLOAD
    }
#undef ATT_STAGE
    l_run += __shfl_xor(l_run, 32);
    asm volatile("s_waitcnt lgkmcnt(0)" ::: "memory");
    if (hi == 0) wsf[r32] = 1.0f / l_run;
    asm volatile("s_waitcnt lgkmcnt(0)" ::: "memory");
    float ar[16];
#pragma unroll
    for (int r = 0; r < 16; ++r) ar[r] = wsf[crow(r, hi)];
    asm volatile("s_waitcnt lgkmcnt(0)" ::: "memory");
#pragma unroll
    for (int d0 = 0; d0 < 4; ++d0)
#pragma unroll
        for (int r = 0; r < 16; ++r) O[d0][r] *= ar[r];
}

DI void phase_att(KP p, int l, unsigned char* smem) {
    constexpr int O_WS = 2 * ATT_BUF;
    const int tid = TIDX(), wid = tid >> 6, lane = tid & 63, r32 = lane & 31, hi = lane >> 5;
    const int li = l >> 1;
    const bf16_t* Qc = (const bf16_t*)(p->ws + WS_QC); const bf16_t* Kc = (const bf16_t*)(p->ws + WS_KC); const bf16_t* Vt = (const bf16_t*)(p->ws + WS_VT);
    bf16_t* Y = (bf16_t*)(p->ws + WS_Y);
    float* stash = (float*)(p->ws + WS_P) + ((size_t)BIDX() * 256 + tid) * 32;
    const float lam_init = 0.8f - 0.6f * expf(-0.3f * (float)l);
    float* wsf = (float*)(smem + O_WS) + wid * 32;
    const int per_x = (l == 3) ? 128 : 144;
    for (int i = 0;; ++i) {
        int b, h, p0, nkv;
        {
            const int G = gridDim.x, bid = BIDX();
            int item;
            if ((G & 7) == 0) { const int x = bid & 7, q = i * (G >> 3) + (bid >> 3); if (q >= per_x) break; item = q < 128 ? x * 128 + q : 1024 + x * 16 + (q - 128); }
            else { item = i * G + bid; if (item >= 8 * per_x) break; }
            if (item < 1024) { b = item >> 7; h = (item >> 4) & 7; p0 = 256 + (item & 15) * 128; nkv = TA; }
            else { const int q = item - 1024; b = q >> 4; h = (q >> 1) & 7; p0 = (q & 1) * 128; nkv = TC; }
        }
        float d1 = 0.f, d2 = 0.f;
        { const float* lq1 = p->in[19] + (li * 8 + h) * 64, *lk1 = p->in[20] + (li * 8 + h) * 64, *lq2 = p->in[21] + (li * 8 + h) * 64, *lk2 = p->in[22] + (li * 8 + h) * 64;
          d1 = wave_sum(lq1[lane] * lk1[lane]); d2 = wave_sum(lq2[lane] * lk2[lane]); }
        const float lamv = expf(d1) - expf(d2) + lam_init;
        f32x16 On[4];
        __syncthreads();
        att_component(Qc, Kc, Vt, smem, wsf, b, h, 0, p0, nkv, On);
#pragma unroll
        for (int d0 = 0; d0 < 4; ++d0)
#pragma unroll
            for (int r = 0; r < 16; r += 8) {
                u32x4 w; w.x = pk2(On[d0][r], On[d0][r + 1]); w.y = pk2(On[d0][r + 2], On[d0][r + 3]); w.z = pk2(On[d0][r + 4], On[d0][r + 5]); w.w = pk2(On[d0][r + 6], On[d0][r + 7]);
                *(u32x4*)(stash + (d0 * 16 + r) / 2) = w;
            }
        __syncthreads();
        att_component(Qc, Kc, Vt, smem, wsf, b, h, 1, p0, nkv, On);
#pragma unroll
        for (int d0 = 0; d0 < 4; ++d0)
#pragma unroll
            for (int r = 0; r < 16; r += 8) {
                const u32x4 w = *(const u32x4*)(stash + (d0 * 16 + r) / 2);
                On[d0][r] = bflo(w.x) - lamv * On[d0][r]; On[d0][r + 1] = bfhi(w.x) - lamv * On[d0][r + 1]; On[d0][r + 2] = bflo(w.y) - lamv * On[d0][r + 2]; On[d0][r + 3] = bfhi(w.y) - lamv * On[d0][r + 3];
                On[d0][r + 4] = bflo(w.z) - lamv * On[d0][r + 4]; On[d0][r + 5] = bfhi(w.z) - lamv * On[d0][r + 5]; On[d0][r + 6] = bflo(w.w) - lamv * On[d0][r + 6]; On[d0][r + 7] = bfhi(w.w) - lamv * On[d0][r + 7];
            }
        float ms[16];
#pragma unroll
        for (int r = 0; r < 16; ++r) {
            float s = (On[0][r] * On[0][r] + On[1][r] * On[1][r]) + (On[2][r] * On[2][r] + On[3][r] * On[3][r]);
            s += __shfl_xor(s, 1); s += __shfl_xor(s, 2); s += __shfl_xor(s, 4); s += __shfl_xor(s, 8); s += __shfl_xor(s, 16);
            ms[r] = __builtin_amdgcn_rsqf(s * (1.0f / 128.0f) + LN_EPS);
        }
        const float* sg = p->in[23] + li * 1024 + h * 128;
        const float post = 1.0f - lam_init;
        float gsc[4];
#pragma unroll
        for (int d0 = 0; d0 < 4; ++d0) gsc[d0] = sg[d0 * 32 + r32] * post;
        __syncthreads();
        unsigned char* stg = smem + wid * 8192;
#pragma unroll
        for (int r = 0; r < 16; ++r) {
            unsigned char* sp = stg + crow(r, hi) * 256 + r32 * 2;
#pragma unroll
            for (int d0 = 0; d0 < 4; ++d0) *(unsigned short*)(sp + d0 * 64) = (unsigned short)f2bf(On[d0][r] * ms[r] * gsc[d0]);
        }
        asm volatile("s_waitcnt lgkmcnt(0)" ::: "memory");
#pragma unroll
        for (int i2 = 0; i2 < 8; ++i2) {
            const int id = lane + 64 * i2, qr = id >> 4, ch = id & 15;
            const int pq = p0 + wid * 32 + qr;
            const int row = pq < 256 ? ML + b * 256 + pq : b * 2048 + (pq - 256);
            *(u32x4*)(Y + (size_t)row * 1024 + h * 128 + ch * 8) = *(const u32x4*)(stg + qr * 256 + ch * 16);
        }
        asm volatile("s_waitcnt lgkmcnt(0)" ::: "memory");
    }
}

#define XB_TMO      128
#define XB_XCNT(j)  (256  + 64 * (j))
#define XB_XSUB(j)  (1280 + 64 * (j))
#define XB_XGEN(j)  (2304 + 64 * (j))
#define XB_TOP      3328
#define XB_TOPGEN   3392
#define XCD_BAR_WORDS 3456
#define XB_SPIN_CAP (1u << 22)
DI unsigned xb_ld(unsigned* p)              { return __hip_atomic_load(p, __ATOMIC_RELAXED, __HIP_MEMORY_SCOPE_AGENT); }
DI unsigned xb_add(unsigned* p, unsigned v) { return __hip_atomic_fetch_add(p, v, __ATOMIC_RELAXED, __HIP_MEMORY_SCOPE_AGENT); }
DI unsigned xb_xcc_id() { return (unsigned)__builtin_amdgcn_s_getreg((3 << 11) | 20) & 0xFu; }
#define XB_SPIN(cond, bar) do { unsigned _sp = 0; while (cond) { __builtin_amdgcn_s_sleep(1); \
    if ((++_sp & 255u) == 0u) { if (xb_ld(&(bar)[XB_TMO])) break; if (_sp > XB_SPIN_CAP) { atomicAdd(&(bar)[XB_TMO], 1u); break; } } } } while (0)
struct XcdBarrier { unsigned* bar; unsigned x; volatile LAS unsigned* st; };
DI XcdBarrier xcd_barrier_post(unsigned* bar, volatile LAS unsigned* st) {
    XcdBarrier b; b.bar = bar; b.x = xb_xcc_id(); b.st = st;
    if (threadIdx.x == 0) (void)xb_add(&bar[XB_XCNT(b.x)], 1u);
    return b;
}
DI void xcd_barrier_complete(unsigned* bar, unsigned x, unsigned& nloc, unsigned& nx) {
    const unsigned G = gridDim.x * gridDim.y * gridDim.z;
    unsigned sum, cnt, mine, sp = 0u;
    for (;;) {
        sum = 0u; cnt = 0u; mine = 0u;
#pragma unroll
        for (unsigned j = 0; j < 16; ++j) { const unsigned c = xb_ld(&bar[XB_XCNT(j)]); sum += c; cnt += (c > 0u) ? 1u : 0u; mine = (j == x) ? c : mine; }
        if (sum == G) break;
        __builtin_amdgcn_s_sleep(1);
        if ((++sp & 255u) == 0u) { if (xb_ld(&bar[XB_TMO])) break; if (sp > XB_SPIN_CAP) { atomicAdd(&bar[XB_TMO], 1u); break; } }
    }
    nloc = mine > 0u ? mine : 1u; nx = cnt > 0u ? cnt : 1u;
}
DI void xcd_barrier(const XcdBarrier& b) {
    asm volatile("s_waitcnt vmcnt(0)" ::: "memory");
    __syncthreads();
    if (threadIdx.x == 0) {
        unsigned* bar = b.bar;
        __builtin_amdgcn_s_waitcnt(0);
        unsigned nloc = b.st[0], nx = b.st[1];
        if (nloc == 0u) { xcd_barrier_complete(bar, b.x, nloc, nx); b.st[0] = nloc; b.st[1] = nx; }
        const unsigned old = xb_add(&bar[XB_XSUB(b.x)], 1u);
        const unsigned gen = old / nloc;
        if (old + 1u == (gen + 1u) * nloc) {
            __builtin_amdgcn_fence(__ATOMIC_RELEASE, "agent");
            asm volatile("s_waitcnt vmcnt(0)" ::: "memory");
            const unsigned og = xb_add(&bar[XB_TOP], 1u);
            const unsigned tg = og / nx;
            if (og + 1u == (tg + 1u) * nx) xb_add(&bar[XB_TOPGEN], 1u);
            else XB_SPIN(xb_ld(&bar[XB_TOPGEN]) == tg, bar);
            __builtin_amdgcn_fence(__ATOMIC_ACQUIRE, "agent");
            xb_add(&bar[XB_XGEN(b.x)], 1u);
            asm volatile("s_waitcnt vmcnt(0)" ::: "memory");
        } else {
            XB_SPIN(xb_ld(&bar[XB_XGEN(b.x)]) == gen, bar);
            __builtin_amdgcn_fence(__ATOMIC_ACQUIRE, "agent");
            asm volatile("s_waitcnt vmcnt(0)" ::: "memory");
        }
    }
    __syncthreads();
}

#ifdef DOUBLE_MASK
#define DRYCOND (rep_ == 0 && nrep_ == 2)
#else
#define DRYCOND false
#endif
constexpr int NPHASE = 34;
constexpr int LDS_BYTES = 65536 + 1024;
__global__ void __launch_bounds__(256, 2) mega(Params pv) {
    extern __shared__ __attribute__((aligned(16))) unsigned char smem[];
    const int ph_lo = pv.ph_lo, ph_hi = pv.ph_hi;
    volatile LAS unsigned* bar_st = (volatile LAS unsigned*)(LAS unsigned char*)(smem + 65536);
    if (threadIdx.x == 0) { bar_st[0] = 0u; bar_st[1] = 0u; }
    __syncthreads();
    XcdBarrier xbar = xcd_barrier_post((unsigned*)(pv.ws + WS_CTL) + 4096, bar_st);
    for (int ph = ph_lo; ph < ph_hi; ++ph) {
        KP p = (KP)__builtin_amdgcn_kernarg_segment_ptr();
        asm volatile("" : "+s"(p) :: "memory");
#ifdef DOUBLE_MASK
        int kind_;
        if (ph == 0) kind_ = 0; else if (ph == 1) kind_ = 1;
        else { const int rem_ = (ph - 2) % 16; kind_ = rem_ == 0 ? 2 : (rem_ == 1 ? 12 : (rem_ < 9 ? rem_ + 1 : (rem_ == 9 ? 10 : (rem_ == 10 ? 11 : (rem_ - 11 + 5))))); }
        const int nrep_ = ((DOUBLE_MASK >> kind_) & 1) ? 2 : 1;
        for (int rep_ = 0; rep_ < nrep_; ++rep_) {
        if (rep_) xcd_barrier(xbar);
#endif
        if (ph == 0) phase_pre0(p, smem);
        else if (ph == 1) phase_pre1(p);
        else {
            const int q = ph - 2, lp = q / 16, rem = q % 16;
            if (rem < 9) {
                const int l = 2 * lp;
                switch (rem) {
                    case 0: phase_g1e(p, l, smem); break;
                    case 1: phase_decay(p, l, smem); break;
                    case 2: phase_scan(p, l, smem); break;
                    case 3: phase_merge(p, l); break;
                    case 4: phase_g2(p, l, smem); break;
                    case 5: if (DRYCOND) phase_ln1r<true>(p, l, smem); else phase_ln1r<false>(p, l, smem); break;
                    case 6: phase_mg1(p, l, smem); break;
                    case 7: phase_mg2(p, l, smem); break;
                    default: if (DRYCOND) phase_ln2<true>(p, l); else phase_ln2<false>(p, l); break;
                }
            } else {
                const int l = 2 * lp + 1;
                switch (rem - 9) {
                    case 0: phase_g1o(p, l, smem); break;
                    case 1: phase_att(p, l, smem); break;
                    case 2: phase_g2(p, l, smem); break;
                    case 3: if (DRYCOND) phase_ln1r<true>(p, l, smem); else phase_ln1r<false>(p, l, smem); break;
                    case 4: phase_mg1(p, l, smem); break;
                    case 5: phase_mg2(p, l, smem); break;
                    default: if (DRYCOND) phase_ln2<true>(p, l); else phase_ln2<false>(p, l); break;
                }
            }
        }
#ifdef DOUBLE_MASK
        }
#endif
        if (ph + 1 < ph_hi) xcd_barrier(xbar);
    }
}

extern "C" void kernel_launch(void* const* d_in, const int* in_sizes, int n_in, void* d_out, int out_size, void* d_ws, size_t ws_size, hipStream_t stream) {
    static int grid_blocks = 0;
    if (grid_blocks == 0) {
        if (n_in != 32 || ws_size < WS_END) { fprintf(stderr, "kernel_launch: unexpected n_in %d or ws_size %zu\n", n_in, ws_size); grid_blocks = -1; return; }
        int dev = 0, cus = 0, per_cu = 0;
        hipGetDevice(&dev);
        hipDeviceGetAttribute(&cus, hipDeviceAttributeMultiprocessorCount, dev);
        hipFuncSetAttribute((const void*)mega, hipFuncAttributeMaxDynamicSharedMemorySize, LDS_BYTES);
        hipOccupancyMaxActiveBlocksPerMultiprocessor(&per_cu, mega, 256, LDS_BYTES);
        if (per_cu > 2) per_cu = 2;
        if (per_cu < 1) per_cu = 1;
        grid_blocks = cus * per_cu;
    }
    if (grid_blocks < 0) return;
    hipMemsetAsync((char*)d_ws + WS_CTL, 0, 32768, stream);
    Params p{};
    for (int i = 0; i < 32; ++i) p.in[i] = (const float*)d_in[i];
    p.out = (float*)d_out; p.ws = (unsigned char*)d_ws;
#if N_LAUNCH_MODE == 1
    p.ph_lo = 0; p.ph_hi = NPHASE;
    void* args[] = {&p};
    hipError_t e = hipLaunchCooperativeKernel((void*)mega, dim3(grid_blocks), dim3(256), args, LDS_BYTES, stream);
    if (e != hipSuccess) fprintf(stderr, "cooperative launch failed: %s (grid %d)\n", hipGetErrorString(e), grid_blocks);
#else
    for (int ph = 0; ph < NPHASE; ++ph) {
        p.ph_lo = ph; p.ph_hi = ph + 1;
        hipLaunchKernelGGL(mega, dim3(grid_blocks), dim3(256), LDS_BYTES, stream, p);
    }
#endif
}
```

```cpp
#include <hip/hip_runtime.h>
#include <hip/hip_cooperative_groups.h>
#include <cstdio>
#include <cstdint>
namespace cg = cooperative_groups;

#ifndef N_LAUNCH_MODE
#define N_LAUNCH_MODE 1
#endif

#define DI __device__ __forceinline__
#define LAS __attribute__((address_space(3)))
typedef unsigned short bf16_t;
typedef short bf16x8 __attribute__((ext_vector_type(8)));
typedef short s16x4 __attribute__((ext_vector_type(4)));
typedef float f32x4 __attribute__((ext_vector_type(4)));
typedef float f32x16 __attribute__((ext_vector_type(16)));
typedef unsigned u32x4 __attribute__((ext_vector_type(4)));
typedef unsigned u32x2 __attribute__((ext_vector_type(2)));

constexpr int D = 1024, NB = 8, T = 2048, TC = 256, TA = T + TC;
constexpr int ML = NB * T, MC = NB * TC, MT = ML + MC;
constexpr int NIN = 3616, NINP = 3712, ZS = 3712;
constexpr int NSLOT = 2 * MT;
constexpr float LN_EPS = 1e-5f;
constexpr float ALPHA = 1.6817928305074290f;
constexpr float L2E = 1.4426950408889634f;

constexpr size_t MiB = 1ull << 20;
constexpr size_t WS_CTL = 0;
constexpr int CNT_WORD0 = 32768;
constexpr int CNT_STRIDE = 1088;
constexpr size_t WS_MOD = 1 * MiB;
constexpr size_t WS_ROPEA = 2 * MiB;
constexpr size_t WS_ROPEC = 3 * MiB;
constexpr size_t WS_LR = 4 * MiB;
constexpr size_t WS_SLOTW = 7 * MiB;
constexpr size_t WS_LIST = 8 * MiB;
constexpr size_t WS_WRT = 13 * MiB;
constexpr size_t WS_WIN = 16 * MiB;
constexpr size_t WS_WABO = 32 * MiB;
constexpr size_t WS_WQKV = 36 * MiB;
constexpr size_t WS_WCO = 48 * MiB;
constexpr size_t WS_WGU = 64 * MiB;
constexpr size_t WS_WD = 320 * MiB;
constexpr size_t WS_X = 448 * MiB;
constexpr size_t WS_U = 520 * MiB;
constexpr size_t WS_Y = 556 * MiB;
constexpr size_t WS_Z = 592 * MiB;
constexpr size_t WS_O = 724 * MiB;
constexpr size_t WS_PF = 868 * MiB, WS_SQ = 886 * MiB, WS_SK = 904 * MiB, WS_TOT = 922 * MiB;
constexpr size_t WS_END = 923 * MiB;
constexpr size_t WS_QC = WS_Z, WS_KC = WS_Z + 36 * MiB, WS_VT = WS_Z + 72 * MiB;
constexpr size_t WS_YS = WS_Z;
constexpr size_t WS_OF = WS_O, WS_OB = WS_O + 72 * MiB, WS_P = WS_O, WS_H = WS_O + 72 * MiB;

#ifndef XBF16
#define XBF16 0
#endif
#if XBF16
typedef bf16_t xres_t;
#else
typedef float xres_t;
#endif
struct Params { const float* in[32]; float* out; unsigned char* ws; int ph_lo, ph_hi; };
typedef const __attribute__((address_space(4))) Params* KP;

DI int TIDX() { int t = threadIdx.x; asm volatile("" : "+v"(t)); return t; }
DI int BIDX() { int b = blockIdx.x; asm volatile("" : "+s"(b)); return b; }
DI unsigned pk2(float lo, float hi);
DI unsigned f2bf(float f) { return pk2(f, 0.f) & 0xffffu; }
typedef float f32x2_t __attribute__((ext_vector_type(2))); typedef __bf16 bf16x2_t __attribute__((ext_vector_type(2)));
DI unsigned pk2(float lo, float hi) { f32x2_t v = {lo, hi}; bf16x2_t b = __builtin_convertvector(v, bf16x2_t); return __builtin_bit_cast(unsigned, b); }
DI float bflo(unsigned w) { return __uint_as_float(w << 16); }
DI float bfhi(unsigned w) { return __uint_as_float(w & 0xffff0000u); }
DI f32x4 xload(const xres_t* p) {
#if XBF16
    const u32x2 w = *(const u32x2*)p; return (f32x4){bflo(w.x), bfhi(w.x), bflo(w.y), bfhi(w.y)};
#else
    return *(const f32x4*)p;
#endif
}
DI void xstore(xres_t* p, f32x4 v) {
#if XBF16
    u32x2 w; w.x = pk2(v[0], v[1]); w.y = pk2(v[2], v[3]); *(u32x2*)p = w;
#else
    *(f32x4*)p = v;
#endif
}
DI float wave_sum(float v) {
    int x = __float_as_int(v);
    v += __int_as_float(__builtin_amdgcn_update_dpp(x, x, 0xB1, 0xF, 0xF, false)); x = __float_as_int(v);
    v += __int_as_float(__builtin_amdgcn_update_dpp(x, x, 0x4E, 0xF, 0xF, false)); x = __float_as_int(v);
    v += __int_as_float(__builtin_amdgcn_update_dpp(x, x, 0x141, 0xF, 0xF, false)); x = __float_as_int(v);
    v += __int_as_float(__builtin_amdgcn_update_dpp(x, x, 0x140, 0xF, 0xF, false));
    { const auto r = __builtin_amdgcn_permlane16_swap(__float_as_uint(v), __float_as_uint(v), false, false); v = __uint_as_float(r[0]) + __uint_as_float(r[1]); }
    { const auto r = __builtin_amdgcn_permlane32_swap(__float_as_uint(v), __float_as_uint(v), false, false); v = __uint_as_float(r[0]) + __uint_as_float(r[1]); }
    return v;
}
DI float siluf(float v) { return v * __builtin_amdgcn_rcpf(1.0f + __expf(-v)); }

DI int gemm_chunk(int tid) { return (tid & 7) ^ ((tid >> 4) & 7); }
template <bool TRN>
DI void gemm_tile(unsigned char* shm, const bf16_t* const (&ap)[4], const bf16_t* const (&bp)[4], int K, f32x4 (&acc)[4][4],
                  bool first, bool has_next, const bf16_t* const (&apn)[4], const bf16_t* const (&bpn)[4]) {
    const int tid = TIDX(), wid = tid >> 6, lane = tid & 63, wr = wid >> 1, wc = wid & 1, fr = lane & 15, fq = lane >> 4;
#pragma unroll
    for (int m = 0; m < 4; ++m)
#pragma unroll
        for (int n = 0; n < 4; ++n) acc[m][n] = (f32x4){0.f, 0.f, 0.f, 0.f};
    const int nt = K >> 6;
    const int sw = fr >> 1;
    const unsigned aoff = (unsigned)((wr * 64 + fr) * 128), boff = (unsigned)(16384 + (wc * 64 + fr) * 128);
#define GEMM_STAGE(buf, A_, B_, t) do { _Pragma("unroll") for (int i_ = 0; i_ < 4; ++i_) { \
        __builtin_amdgcn_global_load_lds((const unsigned*)(A_[i_] + (t) * 64), (LAS unsigned*)(shm + (buf) * 32768 + i_ * 4096 + tid * 16), 16, 0, 0); \
        __builtin_amdgcn_global_load_lds((const unsigned*)(B_[i_] + (t) * 64), (LAS unsigned*)(shm + (buf) * 32768 + 16384 + i_ * 4096 + tid * 16), 16, 0, 0); } } while (0)
    if (first) {
        GEMM_STAGE(0, ap, bp, 0);
        asm volatile("s_waitcnt vmcnt(0)" ::: "memory");
        __syncthreads();
    }
    for (int t = 0; t < nt; ++t) {
        const int cur = t & 1;
        if (t + 1 < nt) GEMM_STAGE(cur ^ 1, ap, bp, t + 1);
        else if (has_next) GEMM_STAGE(cur ^ 1, apn, bpn, 0);
        const unsigned char* base = shm + cur * 32768;
        bf16x8 At[2][4], Bt[2][4];
#pragma unroll
        for (int ks = 0; ks < 2; ++ks) {
            const unsigned co = (unsigned)(((ks * 4 + fq) ^ sw) << 4);
#pragma unroll
            for (int m = 0; m < 4; ++m) At[ks][m] = *(const bf16x8*)(base + aoff + m * 2048 + co);
#pragma unroll
            for (int n = 0; n < 4; ++n) Bt[ks][n] = *(const bf16x8*)(base + boff + n * 2048 + co);
        }
        __builtin_amdgcn_s_setprio(1);
#pragma unroll
        for (int ks = 0; ks < 2; ++ks)
#pragma unroll
            for (int m = 0; m < 4; ++m)
#pragma unroll
                for (int n = 0; n < 4; ++n)
                    acc[m][n] = TRN ? __builtin_amdgcn_mfma_f32_16x16x32_bf16(Bt[ks][n], At[ks][m], acc[m][n], 0, 0, 0)
                                    : __builtin_amdgcn_mfma_f32_16x16x32_bf16(At[ks][m], Bt[ks][n], acc[m][n], 0, 0, 0);
        __builtin_amdgcn_s_setprio(0);
        asm volatile("s_waitcnt vmcnt(0)" ::: "memory");
        __syncthreads();
    }
#undef GEMM_STAGE
}
#define GEMM_ADVANCE() do { _Pragma("unroll") for (int k_ = 0; k_ < 4; ++k_) { ap[k_] = apn[k_]; bp[k_] = bpn[k_]; } } while (0)
DI void gemm_rows(const bf16_t* base, int r0, int ld, int tid, const bf16_t* (&pp)[4]) {
    const bf16_t* q = base + (size_t)(r0 + (tid >> 3)) * ld + gemm_chunk(tid) * 8;
#pragma unroll
    for (int i = 0; i < 4; ++i) pp[i] = q + (size_t)(32 * i) * ld;
}
DI bool tile_seq(int q, int nrt, int nct, int& rt, int& ct) {
    if (q >= nrt * nct) return false;
    const int band = q / (8 * nct), rem = q - band * 8 * nct;
    const int rows = (nrt - band * 8) < 8 ? (nrt - band * 8) : 8;
    ct = rem / rows; rt = band * 8 + rem % rows;
    return true;
}
DI int xcd_seq(int i, int total) {
    const int G = gridDim.x, bid = BIDX();
    if ((G & 7) != 0) { const int q = i * G + bid; return q < total ? q : -1; }
    const int x = bid & 7, j = bid >> 3, per = (total + 7) >> 3, gx = G >> 3;
    const int q = i * gx + j;
    if (q >= per) return -1;
    const int g = x * per + q;
    return g < total ? g : -1;
}

template <int MODE>
DI void tr_item(const float* W, int K, int N, bf16_t* WT, float* scr, int item, int lane) {
    const int nblk = N / 32, kb = item / nblk, nb = item % nblk, k0 = 64 * kb, n0 = 32 * nb;
    float wv[32];
#pragma unroll
    for (int i = 0; i < 32; ++i) wv[i] = W[(size_t)(k0 + 2 * i + (lane >> 5)) * N + n0 + (lane & 31)];
#pragma unroll
    for (int i = 0; i < 32; ++i) scr[(2 * i + (lane >> 5)) * 33 + (lane & 31)] = wv[i];
    asm volatile("s_waitcnt lgkmcnt(0)" ::: "memory");
    const int c = lane & 7;
#pragma unroll
    for (int j = 0; j < 4; ++j) {
        const int n = (lane >> 3) + 8 * j; const float* s = scr + (8 * c) * 33 + n;
        u32x4 o; o.x = pk2(s[0 * 33], s[1 * 33]); o.y = pk2(s[2 * 33], s[3 * 33]); o.z = pk2(s[4 * 33], s[5 * 33]); o.w = pk2(s[6 * 33], s[7 * 33]);
        const int nn = n0 + n;
        const int drow = (MODE == 0) ? nn : ((nn >> 4) * 32 + (nn & 15) + (MODE == 2 ? 16 : 0));
        *(u32x4*)(WT + (size_t)drow * K + k0 + 8 * c) = o;
    }
    asm volatile("s_waitcnt lgkmcnt(0)" ::: "memory");
}

DI void phase_pre0(KP p, unsigned char* smem) {
    const int tid = TIDX(), wave = tid >> 6, lane = tid & 63;
    unsigned char* ws = p->ws;
    if (BIDX() == 0 && tid < 128) {
        unsigned* c0 = (unsigned*)(ws + WS_CTL) + CNT_WORD0 + tid * CNT_STRIDE;
        __hip_atomic_store(c0, 0u, __ATOMIC_RELAXED, __HIP_MEMORY_SCOPE_AGENT); __hip_atomic_store(c0 + 64, 0u, __ATOMIC_RELAXED, __HIP_MEMORY_SCOPE_AGENT);
    }
    {
        float* s_sc = (float*)smem;
        float* s_red = s_sc + 9 * 1024;
        const float* c = p->in[1]; const float* cc = p->in[3];
        for (int i = tid; i < 9 * 1024; i += 256) { const int r = i >> 10, k = i & 1023; const float v = r < 8 ? c[r * 1024 + k] : cc[k]; s_sc[i] = v / (1.0f + expf(-v)); }
        __syncthreads();
        float* MOD = (float*)(ws + WS_MOD);
        for (int item = BIDX(); item < 384; item += gridDim.x) {
            const int l = item / 96, n0 = (item % 96) * 64;
            const float* W = p->in[4] + (size_t)l * 1024 * 6144 + n0 + lane;
            float acc[9];
#pragma unroll
            for (int r = 0; r < 9; ++r) acc[r] = 0.f;
#pragma unroll 16
            for (int k = wave * 256; k < wave * 256 + 256; ++k) {
                const float w = W[(size_t)k * 6144];
#pragma unroll
                for (int r = 0; r < 9; ++r) acc[r] += s_sc[r * 1024 + k] * w;
            }
#pragma unroll
            for (int r = 0; r < 9; ++r) s_red[(wave * 9 + r) * 64 + lane] = acc[r];
            __syncthreads();
            for (int i = tid; i < 9 * 64; i += 256) {
                const int r = i >> 6, ln = i & 63;
                const float v = s_red[(0 * 9 + r) * 64 + ln] + s_red[(1 * 9 + r) * 64 + ln] + s_red[(2 * 9 + r) * 64 + ln] + s_red[(3 * 9 + r) * 64 + ln];
                MOD[(size_t)(l * 9 + r) * 6144 + n0 + ln] = v + p->in[5][l * 6144 + n0 + ln];
            }
            __syncthreads();
        }
    }
    {
        const int gt = BIDX() * 256 + tid, NT = gridDim.x * 256;
        float* ca = (float*)(ws + WS_ROPEA); float* sa = ca + 2048 * 64;
        for (int i = gt; i < 2048 * 64; i += NT) {
            const int t = i >> 6, f = i & 63; const int pos = f < 32 ? (t >> 6) : (t & 63); const int ff = f & 31;
            const float inv = powf(10000.0f, -(float)ff / 32.0f); const float a = (float)pos * inv;
            ca[i] = cosf(a); sa[i] = sinf(a);
        }
        float* cc_ = (float*)(ws + WS_ROPEC); float* sc_ = cc_ + 2048 * 32;
        for (int i = gt; i < 2048 * 32; i += NT) {
            const int t = i >> 5, f = i & 31; const int pos = f < 16 ? (t >> 6) : (t & 63); const int ff = f & 15;
            const float inv = powf(10000.0f, -(float)ff / 16.0f); const float a = (float)pos * inv;
            cc_[i] = cosf(a); sc_[i] = sinf(a);
        }
        float* wrt = (float*)(ws + WS_WRT);
        for (int i = gt; i < 4 * 36 * 1024; i += NT) {
            const int l = i / (36 * 1024), o = (i / 1024) % 36, k = i & 1023;
            wrt[i] = o < 4 ? p->in[25][((size_t)l * 1024 + k) * 4 + o] : p->in[27][((size_t)l * 1024 + k) * 32 + (o - 4)];
        }
        unsigned* wpad = (unsigned*)(ws + WS_WIN);
        for (int i = gt; i < 2 * 96 * 512; i += NT) { const int li = i / (96 * 512), r = i % (96 * 512); wpad[((size_t)li * NINP + NIN) * 512 + r] = 0u; }
    }
    __syncthreads();
    {
        float* scr = (float*)smem + wave * (64 * 33);
        constexpr int I_IN = 16 * 113, I_SQ = 16 * 32, I_QKV = 16 * 96, I_E = 256;
        constexpr int R0 = 2 * I_IN, R1 = R0 + 2 * I_SQ, R2 = R1 + 2 * I_QKV, R3 = R2 + 2 * I_SQ, R4 = R3 + 128 * I_E, R5 = R4 + 128 * I_E, R6 = R5 + 128 * I_E;
        for (int it = BIDX() * 4 + wave; it < R6; it += gridDim.x * 4) {
            if (it < R0) { const int i = it / I_IN, r = it % I_IN; tr_item<0>(p->in[10] + (size_t)i * 1024 * NIN, 1024, NIN, (bf16_t*)(ws + WS_WIN) + (size_t)i * NINP * 1024, scr, r, lane); }
            else if (it < R1) { const int q = it - R0, i = q / I_SQ, r = q % I_SQ; tr_item<0>(p->in[17] + (size_t)i * 1024 * 1024, 1024, 1024, (bf16_t*)(ws + WS_WABO) + (size_t)i * 1024 * 1024, scr, r, lane); }
            else if (it < R2) { const int q = it - R1, i = q / I_QKV, r = q % I_QKV; tr_item<0>(p->in[18] + (size_t)i * 1024 * 3072, 1024, 3072, (bf16_t*)(ws + WS_WQKV) + (size_t)i * 3072 * 1024, scr, r, lane); }
            else if (it < R3) { const int q = it - R2, i = q / I_SQ, r = q % I_SQ; tr_item<0>(p->in[24] + (size_t)i * 1024 * 1024, 1024, 1024, (bf16_t*)(ws + WS_WCO) + (size_t)i * 1024 * 1024, scr, r, lane); }
            else if (it < R4) { const int q = it - R3, le = q / I_E, r = q % I_E; tr_item<1>(p->in[29] + (size_t)le * 1024 * 512, 1024, 512, (bf16_t*)(ws + WS_WGU) + (size_t)le * 1024 * 1024, scr, r, lane); }
            else if (it < R5) { const int q = it - R4, le = q / I_E, r = q % I_E; tr_item<2>(p->in[30] + (size_t)le * 1024 * 512, 1024, 512, (bf16_t*)(ws + WS_WGU) + (size_t)le * 1024 * 1024, scr, r, lane); }
            else { const int q = it - R5, le = q / I_E, r = q % I_E; tr_item<0>(p->in[31] + (size_t)le * 512 * 1024, 512, 1024, (bf16_t*)(ws + WS_WD) + (size_t)le * 1024 * 512, scr, r, lane); }
        }
    }
}

DI void phase_pre1(KP p) {
    const int tid = TIDX(), wave = tid >> 6, lane = tid & 63;
    xres_t* X = (xres_t*)(p->ws + WS_X); bf16_t* U = (bf16_t*)(p->ws + WS_U); const float* MOD = (const float*)(p->ws + WS_MOD);
    for (int row = BIDX() * 4 + wave; row < MT; row += gridDim.x * 4) {
        const float* src = row < ML ? p->in[0] + (size_t)row * 1024 : p->in[2] + (size_t)(row - ML) * 1024;
        const int r = row < ML ? (row >> 11) : 8;
        const float* mod = MOD + (size_t)r * 6144;
#pragma unroll
        for (int j = 0; j < 4; ++j) {
            const int k = 256 * j + 4 * lane;
            const f32x4 v = *(const f32x4*)(src + k), sh = *(const f32x4*)(mod + k), sc = *(const f32x4*)(mod + 1024 + k);
            const f32x4 u = v * (1.0f + sc) + sh;
            u32x2 w; w.x = pk2(u[0], u[1]); w.y = pk2(u[2], u[3]);
            *(u32x2*)(U + (size_t)row * 1024 + k) = w;
        }
    }
}

DI void phase_g1e(KP p, int l, unsigned char* smem) {
    const int tid = TIDX(), wid = tid >> 6, lane = tid & 63, wr = wid >> 1, wc = wid & 1, fr = lane & 15, fq = lane >> 4;
    const int li = l >> 1;
    const bf16_t* U = (const bf16_t*)(p->ws + WS_U); const bf16_t* W = (const bf16_t*)(p->ws + WS_WIN) + (size_t)li * NINP * 1024;
    bf16_t* Z = (bf16_t*)(p->ws + WS_Z); float* LR = (float*)(p->ws + WS_LR);
    const float* ca = (const float*)(p->ws + WS_ROPEA); const float* sa = ca + 2048 * 64;
    constexpr int NTN = NINP / 128;
    auto decode = [&](int i, int& brow, int& bcol) -> bool {
        const int q = xcd_seq(i, (MT / 128) * NTN); if (q < 0) return false;
        int rt, nt; tile_seq(q, MT / 128, NTN, rt, nt); brow = rt * 128; bcol = nt * 128; return true; };
    auto epi = [&](int brow, int bcol, f32x4 (&acc)[4][4]) {
        const int colw = bcol + wc * 64;
        if (colw >= NIN) return;
        if (colw >= 3584) {
#pragma unroll
            for (int m = 0; m < 4; ++m) { const int row = brow + wr * 64 + m * 16 + fr;
#pragma unroll
                for (int n = 0; n < 2; ++n) *(f32x4*)(LR + (size_t)row * 32 + n * 16 + fq * 4) = acc[m][n]; }
            return;
        }
        const bool ropeR = colw < 1024; const int half = (colw >> 6) & 1;
        const float scale = colw < 512 ? 0.08838834764831845f : ((colw >= 2048 && colw < 2304) ? 0.125f : 1.0f);
#pragma unroll
        for (int m = 0; m < 4; ++m) {
            const int row = brow + wr * 64 + m * 16 + fr;
            if (ropeR && row < ML) {
                const int t = row & 2047;
#pragma unroll
                for (int n = 0; n < 2; ++n) {
                    const f32x4 c4 = *(const f32x4*)(ca + t * 64 + half * 32 + n * 16 + fq * 4), s4 = *(const f32x4*)(sa + t * 64 + half * 32 + n * 16 + fq * 4);
                    const f32x4 a = acc[m][n], b = acc[m][n + 2];
                    acc[m][n] = a * c4 - b * s4; acc[m][n + 2] = b * c4 + a * s4;
                }
            }
#pragma unroll
            for (int n = 0; n < 4; ++n) {
                const f32x4 v = acc[m][n] * scale; u32x2 w; w.x = pk2(v[0], v[1]); w.y = pk2(v[2], v[3]);
                *(u32x2*)(Z + (size_t)row * ZS + colw + n * 16 + fq * 4) = w;
            }
        }
    };
    int brow, bcol;
    if (!decode(0, brow, bcol)) return;
    const bf16_t* ap[4]; const bf16_t* bp[4]; const bf16_t* apn[4]; const bf16_t* bpn[4];
    gemm_rows(U, brow, 1024, tid, ap); gemm_rows(W, bcol, 1024, tid, bp);
    bool first = true;
    for (int i = 0;; ++i) {
        int nbrow = brow, nbcol = bcol; const bool hn = decode(i + 1, nbrow, nbcol);
        gemm_rows(U, nbrow, 1024, tid, apn); gemm_rows(W, nbcol, 1024, tid, bpn);
        f32x4 acc[4][4];
        gemm_tile<true>(smem, ap, bp, 1024, acc, first, hn, apn, bpn);
        epi(brow, bcol, acc);
        if (!hn) break;
        brow = nbrow; bcol = nbcol; GEMM_ADVANCE(); first = false;
    }
}

DI void phase_g1o(KP p, int l, unsigned char* smem) {
    const int tid = TIDX(), wid = tid >> 6, lane = tid & 63, wr = wid >> 1, wc = wid & 1, fr = lane & 15, fq = lane >> 4;
    const int li = l >> 1;
    const bf16_t* U = (const bf16_t*)(p->ws + WS_U); const bf16_t* W = (const bf16_t*)(p->ws + WS_WQKV) + (size_t)li * 3072 * 1024;
    bf16_t* Qc = (bf16_t*)(p->ws + WS_QC); bf16_t* Kc = (bf16_t*)(p->ws + WS_KC); bf16_t* Vt = (bf16_t*)(p->ws + WS_VT);
    const float* cc = (const float*)(p->ws + WS_ROPEC); const float* sc = cc + 2048 * 32;
    auto decode = [&](int i, int& brow, int& bcol) -> bool {
        const int q = xcd_seq(i, (MT / 128) * 24); if (q < 0) return false;
        int rt, nt; tile_seq(q, MT / 128, 24, rt, nt); brow = rt * 128; bcol = nt * 128; return true; };
    int brow, bcol;
    if (!decode(0, brow, bcol)) return;
    const bf16_t* ap[4]; const bf16_t* bp[4]; const bf16_t* apn[4]; const bf16_t* bpn[4];
    gemm_rows(U, brow, 1024, tid, ap); gemm_rows(W, bcol, 1024, tid, bp);
    bool first = true;
    for (int i = 0;; ++i) {
        int nbrow = brow, nbcol = bcol; const bool hn = decode(i + 1, nbrow, nbcol);
        gemm_rows(U, nbrow, 1024, tid, apn); gemm_rows(W, nbcol, 1024, tid, bpn);
        f32x4 acc[4][4];
        if (bcol < 2048) {
            gemm_tile<true>(smem, ap, bp, 1024, acc, first, hn, apn, bpn);
            const int colw = bcol + wc * 64; const bool isk = colw >= 1024; const int hc = (colw & 1023) >> 6;
            bf16_t* dst = isk ? Kc : Qc; const float scale = isk ? 1.0f : 0.125f;
#pragma unroll
            for (int m = 0; m < 4; ++m) {
                const int row = brow + wr * 64 + m * 16 + fr;
                int b, pidx;
                if (row < ML) {
                    b = row >> 11; const int t = row & 2047; pidx = 256 + t;
#pragma unroll
                    for (int n = 0; n < 4; n += 2) {
                        const f32x4 c4 = *(const f32x4*)(cc + t * 32 + (n >> 1) * 16 + fq * 4), s4 = *(const f32x4*)(sc + t * 32 + (n >> 1) * 16 + fq * 4);
                        const f32x4 a = acc[m][n], bb = acc[m][n + 1];
                        acc[m][n] = a * c4 - bb * s4; acc[m][n + 1] = bb * c4 + a * s4;
                    }
                } else { b = (row - ML) >> 8; pidx = (row - ML) & 255; }
                bf16_t* o = dst + ((size_t)(b * 16 + hc) * TA + pidx) * 64;
#pragma unroll
                for (int n = 0; n < 4; ++n) { const f32x4 v = acc[m][n] * scale; u32x2 w; w.x = pk2(v[0], v[1]); w.y = pk2(v[2], v[3]); *(u32x2*)(o + n * 16 + fq * 4) = w; }
            }
        } else {
            gemm_tile<false>(smem, ap, bp, 1024, acc, first, hn, apn, bpn);
#pragma unroll
            for (int m = 0; m < 4; ++m) {
                const int row = brow + wr * 64 + m * 16 + fq * 4;
                int b, pidx;
                if (row < ML) { b = row >> 11; pidx = 256 + (row & 2047); } else { b = (row - ML) >> 8; pidx = (row - ML) & 255; }
                const int ppos = (pidx & ~12) | ((pidx & 8) >> 1) | ((pidx & 4) << 1);
#pragma unroll
                for (int n = 0; n < 4; ++n) {
                    const int col = bcol - 2048 + wc * 64 + n * 16 + fr; const int h = col >> 7, d = col & 127;
                    const f32x4 v = acc[m][n]; u32x2 w; w.x = pk2(v[0], v[1]); w.y = pk2(v[2], v[3]);
                    *(u32x2*)(Vt + ((size_t)(b * 8 + h) * 128 + d) * TA + ppos) = w;
                }
            }
        }
        if (!hn) break;
        brow = nbrow; bcol = nbcol; GEMM_ADVANCE(); first = false;
    }
}

DI void phase_g2(KP p, int l, unsigned char* smem) {
    const int tid = TIDX(), wid = tid >> 6, lane = tid & 63, wr = wid >> 1, wc = wid & 1, fr = lane & 15, fq = lane >> 4;
    const int li = l >> 1;
    const bf16_t* Y = (const bf16_t*)(p->ws + WS_Y);
    const bf16_t* W = (const bf16_t*)(p->ws + ((l & 1) ? WS_WCO : WS_WABO)) + (size_t)li * 1024 * 1024;
    bf16_t* P = (bf16_t*)(p->ws + WS_P);
    const int nrt = (l == 3 ? ML : MT) / 128;
    auto decode = [&](int i, int& brow, int& bcol) -> bool {
        const int q = xcd_seq(i, nrt * 8); if (q < 0) return false;
        int rt, nt; tile_seq(q, nrt, 8, rt, nt); brow = rt * 128; bcol = nt * 128; return true; };
    int brow, bcol;
    if (!decode(0, brow, bcol)) return;
    const bf16_t* ap[4]; const bf16_t* bp[4]; const bf16_t* apn[4]; const bf16_t* bpn[4];
    gemm_rows(Y, brow, 1024, tid, ap); gemm_rows(W, bcol, 1024, tid, bp);
    bool first = true;
    for (int i = 0;; ++i) {
        int nbrow = brow, nbcol = bcol; const bool hn = decode(i + 1, nbrow, nbcol);
        gemm_rows(Y, nbrow, 1024, tid, apn); gemm_rows(W, nbcol, 1024, tid, bpn);
        f32x4 acc[4][4];
        gemm_tile<true>(smem, ap, bp, 1024, acc, first, hn, apn, bpn);
#pragma unroll
        for (int m = 0; m < 4; ++m) { const int row = brow + wr * 64 + m * 16 + fr;
#pragma unroll
            for (int n = 0; n < 4; ++n) { const f32x4 v = acc[m][n]; u32x2 w; w.x = pk2(v[0], v[1]); w.y = pk2(v[2], v[3]); *(u32x2*)(P + (size_t)row * 1024 + bcol + wc * 64 + n * 16 + fq * 4) = w; } }
        if (!hn) break;
        brow = nbrow; bcol = nbcol; GEMM_ADVANCE(); first = false;
    }
}

template <bool DRY>
DI void phase_ln1r(KP p, int l, unsigned char* smem) {
    constexpr int US = 1028;
    constexpr int RB = 12;
    float* Us = (float*)smem;
    float* Ps = Us + RB * US;
    const int tid = TIDX(), wave = tid >> 6, lane = tid & 63;
    const xres_t* X = (const xres_t*)(p->ws + WS_X); xres_t* Xo = (xres_t*)(p->ws + (DRY ? WS_OB : WS_X)); const bf16_t* P = (const bf16_t*)(p->ws + WS_P); bf16_t* U = (bf16_t*)(p->ws + (DRY ? WS_Y : WS_U));
    const float* MOD = (const float*)(p->ws + WS_MOD); const float* WrT = (const float*)(p->ws + WS_WRT) + (size_t)l * 36 * 1024;
    const float* lng = p->in[6] + l * 1024; const float* lnb = p->in[7] + l * 1024;
    const float* bgrp = p->in[26] + l * 4; const float* brex = p->in[28] + l * 32;
    unsigned* cnt = (unsigned*)(p->ws + WS_CTL) + CNT_WORD0 + l * 32 * CNT_STRIDE + (DRY ? 64 : 0); int* list = (int*)(p->ws + WS_LIST); float* slotw = (float*)(p->ws + WS_SLOTW);
    const int rows_total = (l == 3) ? ML : MT;
    const int mi = lane & 15, mq = lane >> 4;
    int pend_slot = -1, pend_e = 0; unsigned pend_pos = 0u;
    f32x4 rx[3][4]; u32x2 rp[3][4];
#define LN1_FETCH(IT, RR) { const int frow_ = (IT) * RB + wave * 3 + (RR); const int frow = frow_ < rows_total ? frow_ : rows_total - 1; \
        const float* xsrc = (l == 0) ? (frow < ML ? p->in[0] + (size_t)frow * 1024 : p->in[2] + (size_t)(frow - ML) * 1024) : nullptr; \
        _Pragma("unroll") for (int j = 0; j < 4; ++j) { const int k = 256 * j + 4 * lane; \
            rx[RR][j] = (l == 0) ? *(const f32x4*)(xsrc + k) : xload(X + (size_t)frow * 1024 + k); rp[RR][j] = *(const u32x2*)(P + (size_t)frow * 1024 + k); } }
    int it = BIDX();
    if (it * RB < rows_total) { LN1_FETCH(it, 0) LN1_FETCH(it, 1) LN1_FETCH(it, 2) }
#pragma unroll 1
    for (; it * RB < rows_total; it += gridDim.x) {
        const int row0 = it * RB + wave * 3;
        const bool has_next = (it + (int)gridDim.x) * RB < rows_total;
#pragma unroll
        for (int rr = 0; rr < 3; ++rr) {
            const int rowr = row0 + rr; const bool rvalid = rowr < rows_total; const int row = rvalid ? rowr : rows_total - 1;
            const int r = row < ML ? (row >> 11) : 8;
            const float* mod = MOD + (size_t)(l * 9 + r) * 6144;
            f32x4 v[4]; float s = 0.f;
#pragma unroll
            for (int j = 0; j < 4; ++j) {
                const int k = 256 * j + 4 * lane;
                const f32x4 xv = rx[rr][j];
                const f32x4 g1 = *(const f32x4*)(mod + 2048 + k);
                const u32x2 pw_ = rp[rr][j]; const f32x4 pv = (f32x4){bflo(pw_.x), bfhi(pw_.x), bflo(pw_.y), bfhi(pw_.y)};
                v[j] = xv * ALPHA + g1 * pv; s += (v[j][0] + v[j][1]) + (v[j][2] + v[j][3]);
            }
            if (has_next) { if (rr == 0) LN1_FETCH(it + gridDim.x, 0) else if (rr == 1) LN1_FETCH(it + gridDim.x, 1) else LN1_FETCH(it + gridDim.x, 2) }
            const float mean = wave_sum(s) * (1.0f / 1024.0f); float s2 = 0.f;
#pragma unroll
            for (int j = 0; j < 4; ++j) { v[j] = v[j] - mean; s2 += (v[j][0] * v[j][0] + v[j][1] * v[j][1]) + (v[j][2] * v[j][2] + v[j][3] * v[j][3]); }
            const float rstd = 1.0f / sqrtf(wave_sum(s2) * (1.0f / 1024.0f) + LN_EPS);
#pragma unroll
            for (int j = 0; j < 4; ++j) {
                const int k = 256 * j + 4 * lane;
                const f32x4 xn = v[j] * rstd * *(const f32x4*)(lng + k) + *(const f32x4*)(lnb + k);
                const f32x4 uu = xn * (1.0f + *(const f32x4*)(mod + 4096 + k)) + *(const f32x4*)(mod + 3072 + k);
                *(f32x4*)(Us + (wave * 3 + rr) * US + k) = uu;
                if (rvalid) {
                    xstore(Xo + (size_t)row * 1024 + k, xn);
                    u32x2 w; w.x = pk2(uu[0], uu[1]); w.y = pk2(uu[2], uu[3]);
                    *(u32x2*)(U + (size_t)row * 1024 + k) = w;
                }
            }
        }
        __syncthreads();
        {
            f32x4 acc[3] = {(f32x4){0.f, 0.f, 0.f, 0.f}, (f32x4){0.f, 0.f, 0.f, 0.f}, (f32x4){0.f, 0.f, 0.f, 0.f}};
            const float* ap = Us + (mi < RB ? mi : mi - RB) * US + 256 * wave + 4 * mq;
            const float* bp0 = WrT + (size_t)mi * 1024 + 256 * wave + 4 * mq;
            const float* bp1 = WrT + (size_t)(16 + mi) * 1024 + 256 * wave + 4 * mq;
            const float* bp2 = WrT + (size_t)(32 + (mi & 3)) * 1024 + 256 * wave + 4 * mq;
#pragma unroll 1
            for (int sb0 = 0; sb0 < 16; sb0 += 8) {
                f32x4 bv[8][3];
#pragma unroll
                for (int q = 0; q < 8; ++q) { bv[q][0] = *(const f32x4*)(bp0 + 16 * (sb0 + q)); bv[q][1] = *(const f32x4*)(bp1 + 16 * (sb0 + q)); bv[q][2] = *(const f32x4*)(bp2 + 16 * (sb0 + q)); }
                __builtin_amdgcn_sched_barrier(0);
#pragma unroll
                for (int q = 0; q < 8; ++q) {
                    const f32x4 a = *(const f32x4*)(ap + 16 * (sb0 + q));
#pragma unroll
                    for (int e = 0; e < 4; ++e) {
                        acc[0] = __builtin_amdgcn_mfma_f32_16x16x4f32(a[e], bv[q][0][e], acc[0], 0, 0, 0);
                        acc[1] = __builtin_amdgcn_mfma_f32_16x16x4f32(a[e], bv[q][1][e], acc[1], 0, 0, 0);
                        acc[2] = __builtin_amdgcn_mfma_f32_16x16x4f32(a[e], bv[q][2][e], acc[2], 0, 0, 0);
                    }
                }
            }
            if (mq < 3) {
#pragma unroll
                for (int nt = 0; nt < 3; ++nt)
#pragma unroll
                    for (int rg = 0; rg < 4; ++rg) Ps[(wave * RB + mq * 4 + rg) * 48 + nt * 16 + mi] = acc[nt][rg];
            }
        }
        __syncthreads();
        if (wave < 2) {
            const int r = wave * 8 + (lane >> 3), c = lane & 7;
            const int rq = r < RB ? r : RB - 1;
            const int row = it * RB + rq;
            float lgv[5];
#pragma unroll
            for (int k = 0; k < 5; ++k) {
                const int o = c + 8 * k; const int oo = o < 36 ? o : 35;
                lgv[k] = (Ps[(0 * RB + rq) * 48 + oo] + Ps[(1 * RB + rq) * 48 + oo]) + (Ps[(2 * RB + rq) * 48 + oo] + Ps[(3 * RB + rq) * 48 + oo]);
            }
            float gv = c < 4 ? lgv[0] + bgrp[c & 3] : -3.0e38f; int gi = c;
#pragma unroll
            for (int off = 1; off < 4; off <<= 1) {
                const float ov = __shfl_xor(gv, off); const int oi = __shfl_xor(gi, off);
                if (ov > gv || (ov == gv && oi < gi)) { gv = ov; gi = oi; }
            }
            const int src0 = lane & ~7;
            const float gmax = __shfl(gv, src0); const int grp = __shfl(gi, src0);
            float ge = c < 4 ? expf(lgv[0] + bgrp[c & 3] - gmax) : 0.f;
            ge += __shfl_xor(ge, 1); ge += __shfl_xor(ge, 2);
            const float gw = 1.0f / __shfl(ge, src0);
            const int j = (c + 4) & 7; const int kk = c >= 4 ? grp : grp + 1;
            float ev = lgv[0];
#pragma unroll
            for (int k = 1; k < 5; ++k) ev = (kk == k) ? lgv[k] : ev;
            ev += brex[grp * 8 + j];
            float v1 = ev; int i1 = j;
#pragma unroll
            for (int off = 1; off < 8; off <<= 1) {
                const float ov = __shfl_xor(v1, off); const int oi = __shfl_xor(i1, off);
                if (ov > v1 || (ov == v1 && oi < i1)) { v1 = ov; i1 = oi; }
            }
            float v2 = (j == i1) ? -3.0e38f : ev; int i2 = (j == i1) ? 99 : j;
#pragma unroll
            for (int off = 1; off < 8; off <<= 1) {
                const float ov = __shfl_xor(v2, off); const int oi = __shfl_xor(i2, off);
                if (ov > v2 || (ov == v2 && oi < i2)) { v2 = ov; i2 = oi; }
            }
            const float e2 = expf(v2 - v1);
            const float w1 = 1.0f / (1.0f + e2), w2 = e2 / (1.0f + e2);
            if (c < 2 && r < RB && row < rows_total) {
                if (pend_slot >= 0) list[(size_t)pend_e * NSLOT + pend_pos] = pend_slot;
                const int e = grp * 8 + (c ? i2 : i1); const float w = gw * (c ? w2 : w1);
                const int slot = row * 2 + c;
                slotw[slot] = w;
#ifdef DRY_NOATOM
                pend_pos = DRY ? (unsigned)slot : atomicAdd(&cnt[e * CNT_STRIDE], 1u); pend_e = e; pend_slot = slot;
#else
                pend_pos = atomicAdd(&cnt[e * CNT_STRIDE], 1u); pend_e = e; pend_slot = slot;
#endif
            }
        }
        __syncthreads();
    }
    if (pend_slot >= 0) list[(size_t)pend_e * NSLOT + pend_pos] = pend_slot;
}

DI void moe_prefix(KP p, int l, int* s_cnt, int* s_tb, int* s_rb) {
    const int tid = TIDX();
    const unsigned* cnt = (const unsigned*)(p->ws + WS_CTL) + CNT_WORD0 + l * 32 * CNT_STRIDE;
    __syncthreads();
    if (tid < 32) s_cnt[tid] = (int)__hip_atomic_load(cnt + tid * CNT_STRIDE, __ATOMIC_RELAXED, __HIP_MEMORY_SCOPE_AGENT);
    __syncthreads();
    if (tid == 0) { int tb = 0; for (int e = 0; e < 32; ++e) { s_tb[e] = tb; s_rb[e] = tb * 128; tb += (s_cnt[e] + 127) >> 7; } s_tb[32] = tb; s_rb[32] = tb * 128; }
    __syncthreads();
}
DI void phase_mg1(KP p, int l, unsigned char* smem) {
    const int tid = TIDX(), wid = tid >> 6, lane = tid & 63, wr = wid >> 1, wc = wid & 1, fr = lane & 15, fq = lane >> 4;
    int* s_cnt = (int*)(smem + 65536 + 64); int* s_tb = s_cnt + 32; int* s_rb = s_tb + 33;
    moe_prefix(p, l, s_cnt, s_tb, s_rb);
    const bf16_t* U = (const bf16_t*)(p->ws + WS_U); const int* list = (const int*)(p->ws + WS_LIST);
    bf16_t* H = (bf16_t*)(p->ws + WS_H);
    const int ntiles = s_tb[32] * 8;
    struct TI { int e, rt, nt, cnt_e; };
    auto decode = [&](int i, TI& t) -> bool {
        const int tile = xcd_seq(i, ntiles); if (tile < 0) return false;
        const int rtg = tile >> 3; t.nt = tile & 7;
        int e = 0;
        for (int q = 1; q < 32; ++q) if (rtg >= s_tb[q]) e = q;
        t.e = e; t.rt = rtg - s_tb[e]; t.cnt_e = s_cnt[e]; return true; };
    auto rows = [&](const TI& t, const bf16_t* (&a)[4], const bf16_t* (&b)[4]) {
#pragma unroll
        for (int i_ = 0; i_ < 4; ++i_) {
            const int pos = t.rt * 128 + (tid >> 3) + 32 * i_;
            const int tok = pos < t.cnt_e ? (list[(size_t)t.e * NSLOT + pos] >> 1) : 0;
            a[i_] = U + (size_t)tok * 1024 + gemm_chunk(tid) * 8;
        }
        gemm_rows((const bf16_t*)(p->ws + WS_WGU) + (size_t)(l * 32 + t.e) * 1024 * 1024, t.nt * 128, 1024, tid, b); };
    TI cur, nxt;
    if (!decode(0, cur)) return;
    const bf16_t* ap[4]; const bf16_t* bp[4]; const bf16_t* apn[4]; const bf16_t* bpn[4];
    rows(cur, ap, bp);
    bool first = true;
    for (int i = 0;; ++i) {
        nxt = cur; const bool hn = decode(i + 1, nxt);
        rows(nxt, apn, bpn);
        f32x4 acc[4][4];
        gemm_tile<true>(smem, ap, bp, 1024, acc, first, hn, apn, bpn);
        const int hrow0 = s_rb[cur.e] + cur.rt * 128 + wr * 64;
#pragma unroll
        for (int m = 0; m < 4; ++m) {
            bf16_t* o = H + (size_t)(hrow0 + m * 16 + fr) * 512 + cur.nt * 64 + wc * 32 + fq * 4;
#pragma unroll
            for (int n = 0; n < 4; n += 2) {
                const f32x4 g = acc[m][n], uu = acc[m][n + 1]; f32x4 h;
#pragma unroll
                for (int j = 0; j < 4; ++j) h[j] = siluf(g[j]) * uu[j];
                u32x2 w; w.x = pk2(h[0], h[1]); w.y = pk2(h[2], h[3]);
                *(u32x2*)(o + (n >> 1) * 16) = w;
            }
        }
        if (!hn) break;
        cur = nxt; GEMM_ADVANCE(); first = false;
    }
}
DI void phase_mg2(KP p, int l, unsigned char* smem) {
    const int tid = TIDX(), wid = tid >> 6, lane = tid & 63, wr = wid >> 1, wc = wid & 1, fr = lane & 15, fq = lane >> 4;
    int* s_cnt = (int*)(smem + 65536 + 64); int* s_tb = s_cnt + 32; int* s_rb = s_tb + 33;
    moe_prefix(p, l, s_cnt, s_tb, s_rb);
    const bf16_t* H = (const bf16_t*)(p->ws + WS_H); const int* list = (const int*)(p->ws + WS_LIST); const float* slotw = (const float*)(p->ws + WS_SLOTW);
    bf16_t* YS = (bf16_t*)(p->ws + WS_YS);
    const int ntiles = s_tb[32] * 8;
    struct TI { int e, rt, nt, cnt_e; };
    auto decode = [&](int i, TI& t) -> bool {
        const int tile = xcd_seq(i, ntiles); if (tile < 0) return false;
        const int rtg = tile >> 3; t.nt = tile & 7;
        int e = 0;
        for (int q = 1; q < 32; ++q) if (rtg >= s_tb[q]) e = q;
        t.e = e; t.rt = rtg - s_tb[e]; t.cnt_e = s_cnt[e]; return true; };
    auto rows = [&](const TI& t, const bf16_t* (&a)[4], const bf16_t* (&b)[4]) {
        gemm_rows(H, s_rb[t.e] + t.rt * 128, 512, tid, a);
        gemm_rows((const bf16_t*)(p->ws + WS_WD) + (size_t)(l * 32 + t.e) * 1024 * 512, t.nt * 128, 512, tid, b); };
    TI cur, nxt;
    if (!decode(0, cur)) return;
    const bf16_t* ap[4]; const bf16_t* bp[4]; const bf16_t* apn[4]; const bf16_t* bpn[4];
    rows(cur, ap, bp);
    bool first = true;
    for (int i = 0;; ++i) {
        nxt = cur; const bool hn = decode(i + 1, nxt);
        rows(nxt, apn, bpn);
        int eslot[4]; float ew[4];
#pragma unroll
        for (int m = 0; m < 4; ++m) {
            const int pos = cur.rt * 128 + wr * 64 + m * 16 + fr;
            eslot[m] = pos < cur.cnt_e ? list[(size_t)cur.e * NSLOT + pos] : -1;
        }
#pragma unroll
        for (int m = 0; m < 4; ++m) ew[m] = eslot[m] >= 0 ? slotw[eslot[m]] : 0.f;
        f32x4 acc[4][4];
        gemm_tile<true>(smem, ap, bp, 512, acc, first, hn, apn, bpn);
#pragma unroll
        for (int m = 0; m < 4; ++m) {
            if (eslot[m] >= 0) {
                const int slot = eslot[m]; const float w = ew[m];
                bf16_t* o = YS + (size_t)slot * 1024 + cur.nt * 128 + wc * 64 + fq * 4;
#pragma unroll
                for (int n = 0; n < 4; ++n) { const f32x4 v = acc[m][n] * w; u32x2 ww; ww.x = pk2(v[0], v[1]); ww.y = pk2(v[2], v[3]); *(u32x2*)(o + n * 16) = ww; }
            }
        }
        if (!hn) break;
        cur = nxt; GEMM_ADVANCE(); first = false;
    }
}

template <bool DRY>
DI void phase_ln2(KP p, int l) {
    const int tid = TIDX(), wave = tid >> 6, lane = tid & 63;
    const xres_t* X = (const xres_t*)(p->ws + WS_X); xres_t* Xo = (xres_t*)(p->ws + (DRY ? WS_OB : WS_X)); const bf16_t* YS = (const bf16_t*)(p->ws + WS_YS); bf16_t* U = (bf16_t*)(p->ws + (DRY ? WS_Y : WS_U));
    const float* MOD = (const float*)(p->ws + WS_MOD);
    const float* lng = p->in[8] + l * 1024; const float* lnb = p->in[9] + l * 1024;
    const int rows_total = (l == 3) ? ML : MT;
    u32x2 ry0[2][4], ry1[2][4]; f32x4 rx[2][4];
    const int rstride = gridDim.x * 8;
    int row0 = (BIDX() * 4 + wave) * 2;
#define LN2_FETCH(R0) { _Pragma("unroll") for (int q = 0; q < 2; ++q) { const int row = (R0) + q; _Pragma("unroll") for (int j = 0; j < 4; ++j) { const int k = 256 * j + 4 * lane; \
        ry0[q][j] = *(const u32x2*)(YS + (size_t)(2 * row) * 1024 + k); ry1[q][j] = *(const u32x2*)(YS + (size_t)(2 * row + 1) * 1024 + k); rx[q][j] = xload(X + (size_t)row * 1024 + k); } } }
    if (row0 < rows_total) LN2_FETCH(row0)
#pragma unroll 1
    for (; row0 < rows_total; row0 += rstride) {
        f32x4 v[2][4]; float s[2] = {0.f, 0.f};
        const float* mod[2];
#pragma unroll
        for (int q = 0; q < 2; ++q) {
            const int row = row0 + q; const int r = row < ML ? (row >> 11) : 8;
            mod[q] = MOD + (size_t)(l * 9 + r) * 6144;
#pragma unroll
            for (int j = 0; j < 4; ++j) {
                const int k = 256 * j + 4 * lane;
                const u32x2 y0 = ry0[q][j], y1 = ry1[q][j];
                f32x4 y; y[0] = bflo(y0.x) + bflo(y1.x); y[1] = bfhi(y0.x) + bfhi(y1.x); y[2] = bflo(y0.y) + bflo(y1.y); y[3] = bfhi(y0.y) + bfhi(y1.y);
                const f32x4 xv = rx[q][j], g2 = *(const f32x4*)(mod[q] + 5120 + k);
                v[q][j] = xv * ALPHA + g2 * y; s[q] += (v[q][j][0] + v[q][j][1]) + (v[q][j][2] + v[q][j][3]);
            }
        }
        if (row0 + rstride < rows_total) LN2_FETCH(row0 + rstride)
        float mean[2], rstd[2];
#pragma unroll
        for (int q = 0; q < 2; ++q) mean[q] = wave_sum(s[q]) * (1.0f / 1024.0f);
#pragma unroll
        for (int q = 0; q < 2; ++q) {
            float s2 = 0.f;
#pragma unroll
            for (int j = 0; j < 4; ++j) { v[q][j] = v[q][j] - mean[q]; s2 += (v[q][j][0] * v[q][j][0] + v[q][j][1] * v[q][j][1]) + (v[q][j][2] * v[q][j][2] + v[q][j][3] * v[q][j][3]); }
            s[q] = s2;
        }
#pragma unroll
        for (int q = 0; q < 2; ++q) rstd[q] = 1.0f / sqrtf(wave_sum(s[q]) * (1.0f / 1024.0f) + LN_EPS);
#pragma unroll
        for (int q = 0; q < 2; ++q) {
            const int row = row0 + q;
            const float* modn = mod[q] + (l + 1 < 4 ? 9 * 6144 : 0);
#pragma unroll
            for (int j = 0; j < 4; ++j) {
                const int k = 256 * j + 4 * lane;
                const f32x4 xn = v[q][j] * rstd[q] * *(const f32x4*)(lng + k) + *(const f32x4*)(lnb + k);
                if (l < 3) {
                    xstore(Xo + (size_t)row * 1024 + k, xn);
                    const f32x4 uu = xn * (1.0f + *(const f32x4*)(modn + 1024 + k)) + *(const f32x4*)(modn + k);
                    u32x2 w; w.x = pk2(uu[0], uu[1]); w.y = pk2(uu[2], uu[3]);
                    *(u32x2*)(U + (size_t)row * 1024 + k) = w;
                } else {
                    *(f32x4*)(p->out + (size_t)row * 1024 + k) = xn;
                }
            }
        }
    }
}

DI s16x4 tr_read(const unsigned char* ptr) {
    typedef short v4i16_t __attribute__((ext_vector_type(4)));
    return __builtin_bit_cast(s16x4, __builtin_amdgcn_ds_read_tr16_b64_v4i16((LAS v4i16_t*)ptr));
}
DI bf16x8 cat8(s16x4 a, s16x4 b) { return __builtin_shufflevector(a, b, 0, 1, 2, 3, 4, 5, 6, 7); }

DI void phase_decay(KP p, int l, unsigned char* smem) {
    const int tid = TIDX();
    const int li = l >> 1;
    const float* LR = (const float*)(p->ws + WS_LR);
    float* PF = (float*)(p->ws + WS_PF); float* SQ = (float*)(p->ws + WS_SQ); float* SK = (float*)(p->ws + WS_SK); float* TOT = (float*)(p->ws + WS_TOT);
    float* lrs = (float*)smem;
    float wf[16], wb[16];
#pragma unroll
    for (int r = 0; r < 16; ++r) { wf[r] = p->in[11][(size_t)li * 16 * 256 + r * 256 + tid]; wb[r] = p->in[13][(size_t)li * 16 * 256 + r * 256 + tid]; }
    const float bf = p->in[12][li * 256 + tid], bb = p->in[14][li * 256 + tid];
    for (int it = BIDX(); it < 2 * (MT / 64); it += gridDim.x) {
        const int ch = it >> 1, dr = it & 1;
        const int row0 = ch * 64;
        __syncthreads();
        { const int tok = tid >> 2, q4 = tid & 3; *(f32x4*)(lrs + tok * 16 + q4 * 4) = *(const f32x4*)(LR + (size_t)(row0 + tok) * 32 + dr * 16 + q4 * 4); }
        __syncthreads();
        float run = 0.f;
        if (dr == 0) {
            for (int t = 0; t < 64; ++t) {
                float g = bf;
#pragma unroll
                for (int r = 0; r < 16; ++r) g += lrs[t * 16 + r] * wf[r];
                run += (fminf(g, 0.f) - __logf(1.0f + __expf(-fabsf(g)))) * (1.0f / 16.0f);
                PF[(size_t)(row0 + t) * 256 + tid] = run;
            }
        } else {
            for (int t = 63; t >= 0; --t) {
                float g = bb;
#pragma unroll
                for (int r = 0; r < 16; ++r) g += lrs[t * 16 + r] * wb[r];
                SQ[(size_t)(row0 + t) * 256 + tid] = run;
                run += (fminf(g, 0.f) - __logf(1.0f + __expf(-fabsf(g)))) * (1.0f / 16.0f);
                SK[(size_t)(row0 + t) * 256 + tid] = run;
            }
        }
        TOT[(size_t)(ch * 2 + dr) * 256 + tid] = run;
    }
}

template <int DK>
DI void scan_item(KP p, int l, int item, unsigned char* smem) {
    constexpr bool ISA = (DK == 128);
    constexpr int QS = DK * 2 + 16, KS = DK * 2 + 32, VS = 96, AS_ = 144, SS = DK * 2 + 16, NKS = DK / 32, NMT = DK / 64;
    constexpr int O_QD = 0, O_KD = O_QD + 64 * QS, O_V = O_KD + 64 * KS, O_ATT = O_V + 64 * VS, O_ST = O_ATT + 64 * AS_, O_END = O_ST + 32 * SS;
    static_assert(O_END <= 65536, "scan LDS");
    constexpr int NP = DK / 64 * 2;
    constexpr int CPR = DK / 8;
    const int tid = TIDX(), wid = tid >> 6, lane = tid & 63, fr = lane & 15, fq = lane >> 4;
    const int b = item >> 5, h = (item >> 3) & 3, dir = (item >> 2) & 1, dvq = item & 3;
    const bf16_t* Z = (const bf16_t*)(p->ws + WS_Z);
    const float* EQ = (const float*)(p->ws + (dir ? WS_SQ : WS_PF)); const float* EK = (const float*)(p->ws + (dir ? WS_SK : WS_PF)); const float* TOT = (const float*)(p->ws + WS_TOT);
    bf16_t* OUT = (bf16_t*)(p->ws + (dir ? WS_OB : WS_OF));
    const int qcol = ISA ? h * 128 : 2048 + h * 64, kcol = ISA ? 512 + h * 128 : 2304 + h * 64, vcol = (ISA ? 1024 : 2560) + h * 128 + dvq * 32;
    const int ocol = (ISA ? 0 : 512) + h * 128 + dvq * 32;
    float lam = 0.f;
    if (ISA) lam = log1pf(-exp2f(-((dir ? 5.5f : 5.0f) + (float)h)));
    f32x4 S[NMT][2];
#pragma unroll
    for (int a = 0; a < NMT; ++a) { S[a][0] = (f32x4){0.f, 0.f, 0.f, 0.f}; S[a][1] = (f32x4){0.f, 0.f, 0.f, 0.f}; }
    __syncthreads();
    for (int i = tid; i < 32 * SS / 4; i += 256) ((unsigned*)(smem + O_ST))[i] = 0u;
    auto chunk_row0 = [&](int cc) -> int {
        const int ci = dir ? 35 - cc : cc; const int pp = ci * 64;
        if (!dir) return pp < 256 ? ML + b * 256 + pp : b * 2048 + (pp - 256);
        return pp < 2048 ? b * 2048 + pp : ML + b * 256 + (pp - 2048);
    };
    u32x4 rq[NP], rk[NP], rv; f32x4 eq[ISA ? 1 : NP][2], ek[ISA ? 1 : NP][2]; f32x4 tv[NMT];
    auto fetch = [&](int cc) {
        const int row0 = chunk_row0(cc);
        if (!ISA) {
#pragma unroll
            for (int a = 0; a < NMT; ++a) tv[a] = *(const f32x4*)(TOT + (size_t)((row0 >> 6) * 2 + dir) * 256 + h * 64 + (wid * NMT + a) * 16 + fq * 4);
        }
#pragma unroll
        for (int i = 0; i < NP; ++i) {
            const int id = tid + 256 * i, tok = id / CPR, cg_ = id % CPR;
            const size_t ro = (size_t)(row0 + tok) * ZS;
            rq[i] = *(const u32x4*)(Z + ro + qcol + cg_ * 8); rk[i] = *(const u32x4*)(Z + ro + kcol + cg_ * 8);
            if (!ISA) {
                const size_t eo = (size_t)(row0 + tok) * 256 + h * 64 + cg_ * 8;
                eq[i][0] = *(const f32x4*)(EQ + eo); eq[i][1] = *(const f32x4*)(EQ + eo + 4);
                ek[i][0] = *(const f32x4*)(EK + eo); ek[i][1] = *(const f32x4*)(EK + eo + 4);
            }
        }
        { const int tok = tid >> 2, cg_ = tid & 3; rv = *(const u32x4*)(Z + (size_t)(row0 + tok) * ZS + vcol + cg_ * 8); }
    };
    float ra[NP], rc[NP];
#pragma unroll
    for (int i = 0; i < NP; ++i) {
        const int tok = (tid + 256 * i) / CPR;
        ra[i] = dir ? __expf(lam * (float)(63 - tok)) : __expf(lam * (float)(tok + 1));
        rc[i] = dir ? __expf(-lam * (float)(64 - tok)) : __expf(-lam * (float)(tok + 1));
    }
    const float decA = __expf(lam * 64.0f);
    fetch(0);
    for (int cc = 0; cc < 36; ++cc) {
        const int row0 = chunk_row0(cc);
#pragma unroll
        for (int i = 0; i < NP; ++i) {
            const int id = tid + 256 * i, tok = id / CPR, cg_ = id % CPR;
            float fqv[8], fkv[8];
            if (ISA) {
#pragma unroll
                for (int e = 0; e < 8; ++e) { fqv[e] = ra[i]; fkv[e] = rc[i]; }
            } else {
#pragma unroll
                for (int e = 0; e < 8; ++e) { fqv[e] = __expf(eq[i][e >> 2][e & 3]); fkv[e] = __expf(-ek[i][e >> 2][e & 3]); }
            }
            const u32x4 q = rq[i], k = rk[i]; u32x4 qo, ko;
            qo.x = pk2(bflo(q.x) * fqv[0], bfhi(q.x) * fqv[1]); qo.y = pk2(bflo(q.y) * fqv[2], bfhi(q.y) * fqv[3]); qo.z = pk2(bflo(q.z) * fqv[4], bfhi(q.z) * fqv[5]); qo.w = pk2(bflo(q.w) * fqv[6], bfhi(q.w) * fqv[7]);
            ko.x = pk2(bflo(k.x) * fkv[0], bfhi(k.x) * fkv[1]); ko.y = pk2(bflo(k.y) * fkv[2], bfhi(k.y) * fkv[3]); ko.z = pk2(bflo(k.z) * fkv[4], bfhi(k.z) * fkv[5]); ko.w = pk2(bflo(k.w) * fkv[6], bfhi(k.w) * fkv[7]);
            *(u32x4*)(smem + O_QD + tok * QS + cg_ * 16) = qo;
            *(u32x4*)(smem + O_KD + tok * KS + cg_ * 16) = ko;
        }
        { const int tok = tid >> 2, cg_ = tid & 3; *(u32x4*)(smem + O_V + tok * VS + cg_ * 16) = rv; }
        f32x4 dec[NMT];
#pragma unroll
        for (int a = 0; a < NMT; ++a) {
            if (ISA) dec[a] = (f32x4){decA, decA, decA, decA};
            else dec[a] = (f32x4){__expf(tv[a][0]), __expf(tv[a][1]), __expf(tv[a][2]), __expf(tv[a][3])};
        }
        if (cc + 1 < 36) fetch(cc + 1);
        __syncthreads();
        bf16x8 afr[2];
        {
            f32x4 at[4];
#pragma unroll
            for (int n = 0; n < 4; ++n) at[n] = (f32x4){0.f, 0.f, 0.f, 0.f};
#pragma unroll
            for (int ks = 0; ks < NKS; ++ks) {
                const bf16x8 qf = *(const bf16x8*)(smem + O_QD + (16 * wid + fr) * QS + (32 * ks + 8 * fq) * 2);
#pragma unroll
                for (int n = 0; n < 4; ++n) {
                    const bf16x8 kf = *(const bf16x8*)(smem + O_KD + (16 * n + fr) * KS + (32 * ks + 8 * fq) * 2);
                    at[n] = __builtin_amdgcn_mfma_f32_16x16x32_bf16(kf, qf, at[n], 0, 0, 0);
                }
            }
            const int i = 16 * wid + fr;
#pragma unroll
            for (int n = 0; n < 4; ++n)
#pragma unroll
                for (int jj = 0; jj < 4; ++jj) { const int j = n * 16 + fq * 4 + jj; const bool keep = dir ? (j > i) : (j <= i); at[n][jj] = keep ? at[n][jj] : 0.f; }
#pragma unroll
            for (int ks = 0; ks < 2; ++ks) {
                u32x4 w; w.x = pk2(at[2 * ks][0], at[2 * ks][1]); w.y = pk2(at[2 * ks][2], at[2 * ks][3]); w.z = pk2(at[2 * ks + 1][0], at[2 * ks + 1][1]); w.w = pk2(at[2 * ks + 1][2], at[2 * ks + 1][3]);
                afr[ks] = __builtin_bit_cast(bf16x8, w);
            }
        }
        bf16x8 vf[2][2];
        {
            const int g = lane >> 4, i16 = lane & 15, q = i16 >> 2, pq = i16 & 3;
#pragma unroll
            for (int ks = 0; ks < 2; ++ks)
#pragma unroll
                for (int n = 0; n < 2; ++n) {
                    const unsigned char* a = smem + O_V + (32 * ks + 4 * g + q) * VS + (n * 16 + 4 * pq) * 2;
                    vf[ks][n] = cat8(tr_read(a), tr_read(a + 16 * VS));
                }
        }
        {
            f32x4 oa[2] = {(f32x4){0.f, 0.f, 0.f, 0.f}, (f32x4){0.f, 0.f, 0.f, 0.f}};
#pragma unroll
            for (int ks = 0; ks < 2; ++ks)
#pragma unroll
                for (int n = 0; n < 2; ++n) oa[n] = __builtin_amdgcn_mfma_f32_16x16x32_bf16(vf[ks][n], afr[ks], oa[n], 0, 0, 0);
#pragma unroll
            for (int ks = 0; ks < NKS; ++ks) {
                const bf16x8 qf = *(const bf16x8*)(smem + O_QD + (16 * wid + fr) * QS + (32 * ks + 8 * fq) * 2);
#pragma unroll
                for (int n = 0; n < 2; ++n) {
                    const bf16x8 sf = *(const bf16x8*)(smem + O_ST + (16 * n + fr) * SS + (32 * ks + 8 * fq) * 2);
                    oa[n] = __builtin_amdgcn_mfma_f32_16x16x32_bf16(sf, qf, oa[n], 0, 0, 0);
                }
            }
            bf16_t* o = OUT + (size_t)(row0 + 16 * wid + fr) * 1024 + ocol + fq * 4;
            u32x2 w0, w1; w0.x = pk2(oa[0][0], oa[0][1]); w0.y = pk2(oa[0][2], oa[0][3]); w1.x = pk2(oa[1][0], oa[1][1]); w1.y = pk2(oa[1][2], oa[1][3]);
            *(u32x2*)(o) = w0; *(u32x2*)(o + 16) = w1;
        }
        {
            const int g = lane >> 4, i16 = lane & 15, q = i16 >> 2, pq = i16 & 3;
#pragma unroll
            for (int a = 0; a < NMT; ++a) {
                const int mt = wid * NMT + a;
#pragma unroll
                for (int ks = 0; ks < 2; ++ks) {
                    const unsigned char* ka = smem + O_KD + (32 * ks + 4 * g + q) * KS + (mt * 16 + 4 * pq) * 2;
                    const bf16x8 kf = cat8(tr_read(ka), tr_read(ka + 16 * KS));
#pragma unroll
                    for (int n = 0; n < 2; ++n) S[a][n] = __builtin_amdgcn_mfma_f32_16x16x32_bf16(kf, vf[ks][n], S[a][n], 0, 0, 0);
                }
                S[a][0] *= dec[a]; S[a][1] *= dec[a];
            }
        }
        __syncthreads();
#pragma unroll
        for (int a = 0; a < NMT; ++a) {
            const int mt = wid * NMT + a;
#pragma unroll
            for (int n = 0; n < 2; ++n) { u32x2 w; w.x = pk2(S[a][n][0], S[a][n][1]); w.y = pk2(S[a][n][2], S[a][n][3]); *(u32x2*)(smem + O_ST + (n * 16 + fr) * SS + (mt * 16 + fq * 4) * 2) = w; }
        }
    }
    __syncthreads();
}
DI void phase_scan(KP p, int l, unsigned char* smem) {
    for (int it = BIDX(); it < 512; it += gridDim.x) {
        if (it < 256) scan_item<128>(p, l, it, smem); else scan_item<64>(p, l, it - 256, smem);
    }
}

DI void phase_merge(KP p, int l) {
    const int tid = TIDX(), wave = tid >> 6, lane = tid & 63;
    const int li = l >> 1;
    const bf16_t* OF = (const bf16_t*)(p->ws + WS_OF); const bf16_t* OB = (const bf16_t*)(p->ws + WS_OB);
    const bf16_t* Z = (const bf16_t*)(p->ws + WS_Z); bf16_t* Y = (bf16_t*)(p->ws + WS_Y);
    const bool isA = lane < 32;
    const float* gn = isA ? p->in[15] + li * 512 + lane * 16 : p->in[16] + li * 512 + (lane - 32) * 16;
    const int gcol = isA ? 1536 + lane * 16 : 3072 + (lane - 32) * 16;
    for (int row = BIDX() * 4 + wave; row < MT; row += gridDim.x * 4) {
        float o[16]; float s = 0.f;
#pragma unroll
        for (int j = 0; j < 2; ++j) {
            const u32x4 a = *(const u32x4*)(OF + (size_t)row * 1024 + lane * 16 + j * 8), bb = *(const u32x4*)(OB + (size_t)row * 1024 + lane * 16 + j * 8);
            o[j * 8 + 0] = bflo(a.x) + bflo(bb.x); o[j * 8 + 1] = bfhi(a.x) + bfhi(bb.x); o[j * 8 + 2] = bflo(a.y) + bflo(bb.y); o[j * 8 + 3] = bfhi(a.y) + bfhi(bb.y);
            o[j * 8 + 4] = bflo(a.z) + bflo(bb.z); o[j * 8 + 5] = bfhi(a.z) + bfhi(bb.z); o[j * 8 + 6] = bflo(a.w) + bflo(bb.w); o[j * 8 + 7] = bfhi(a.w) + bfhi(bb.w);
        }
#pragma unroll
        for (int e = 0; e < 16; ++e) s += o[e];
        s += __shfl_xor(s, 1); s += __shfl_xor(s, 2); s += __shfl_xor(s, 4);
        const float mean = isA ? s * (1.0f / 128.0f) : 0.f;
        float s2 = 0.f;
#pragma unroll
        for (int e = 0; e < 16; ++e) { o[e] -= mean; s2 += o[e] * o[e]; }
        s2 += __shfl_xor(s2, 1); s2 += __shfl_xor(s2, 2); s2 += __shfl_xor(s2, 4);
        const float rs = 1.0f / sqrtf(s2 * (1.0f / 128.0f) + LN_EPS);
        const u32x4 g0 = *(const u32x4*)(Z + (size_t)row * ZS + gcol), g1 = *(const u32x4*)(Z + (size_t)row * ZS + gcol + 8);
        float gt[16];
        gt[0] = bflo(g0.x); gt[1] = bfhi(g0.x); gt[2] = bflo(g0.y); gt[3] = bfhi(g0.y); gt[4] = bflo(g0.z); gt[5] = bfhi(g0.z); gt[6] = bflo(g0.w); gt[7] = bfhi(g0.w);
        gt[8] = bflo(g1.x); gt[9] = bfhi(g1.x); gt[10] = bflo(g1.y); gt[11] = bfhi(g1.y); gt[12] = bflo(g1.z); gt[13] = bfhi(g1.z); gt[14] = bflo(g1.w); gt[15] = bfhi(g1.w);
        float y[16];
#pragma unroll
        for (int e = 0; e < 16; ++e) y[e] = siluf(gt[e]) * (o[e] * rs * gn[e]);
        u32x4 w0, w1;
        w0.x = pk2(y[0], y[1]); w0.y = pk2(y[2], y[3]); w0.z = pk2(y[4], y[5]); w0.w = pk2(y[6], y[7]);
        w1.x = pk2(y[8], y[9]); w1.y = pk2(y[10], y[11]); w1.z = pk2(y[12], y[13]); w1.w = pk2(y[14], y[15]);
        *(u32x4*)(Y + (size_t)row * 1024 + lane * 16) = w0; *(u32x4*)(Y + (size_t)row * 1024 + lane * 16 + 8) = w1;
    }
}

DI int crow(int r, int hi) { return (r & 3) + 8 * (r >> 2) + 4 * hi; }
constexpr int ATT_BUF = 24576;
DI void att_component(const bf16_t* Qc, const bf16_t* Kc, const bf16_t* Vt, unsigned char* smem, float* wsf, int b, int h, int comp, int p0, int nkv, f32x16 (&O)[4]) {
    const int tid = TIDX(), wid = tid >> 6, lane = tid & 63, r32 = lane & 31, hi = lane >> 5;
    const int hc = h * 2 + comp;
    const bf16_t* Qb = Qc + ((size_t)(b * 16 + hc) * TA + p0 + wid * 32 + r32) * 64;
    const int gch = gemm_chunk(tid);
    const bf16_t* Kg = Kc + (size_t)(b * 16 + hc) * TA * 64 + (size_t)(tid >> 3) * 64 + gch * 8;
    const bf16_t* Vg = Vt + (size_t)(b * 8 + h) * 128 * TA + (size_t)(tid >> 3) * TA + gch * 8;
#define ATT_STAGE(buf, kt) do { \
        _Pragma("unroll") for (int i_ = 0; i_ < 2; ++i_) __builtin_amdgcn_global_load_lds((const unsigned*)(Kg + (size_t)((kt) + 32 * i_) * 64), (LAS unsigned*)(smem + (buf) * ATT_BUF + i_ * 4096 + tid * 16), 16, 0, 0); \
        _Pragma("unroll") for (int i_ = 0; i_ < 4; ++i_) __builtin_amdgcn_global_load_lds((const unsigned*)(Vg + (size_t)(32 * i_) * TA + (kt)), (LAS unsigned*)(smem + (buf) * ATT_BUF + 8192 + i_ * 4096 + tid * 16), 16, 0, 0); } while (0)
    ATT_STAGE(0, 0);
    bf16x8 qf[4];
#pragma unroll
    for (int ks = 0; ks < 4; ++ks) qf[ks] = *(const bf16x8*)(Qb + ks * 16 + hi * 8);
#pragma unroll
    for (int d0 = 0; d0 < 4; ++d0)
#pragma unroll
        for (int r = 0; r < 16; ++r) O[d0][r] = 0.f;
    float m_run = -1.0e30f, l_run = 0.f;
    const int sw = (r32 >> 1) & 7;
    const int nt = nkv >> 6;
    for (int t = 0; t < nt; ++t) {
        asm volatile("s_waitcnt vmcnt(0)" ::: "memory");
        __syncthreads();
        if (t + 1 < nt) ATT_STAGE((t + 1) & 1, (t + 1) * 64);
        const unsigned char* Kt = smem + (t & 1) * ATT_BUF; const unsigned char* Vtl = Kt + 8192;
        bf16x8 kf0[4], kf1[4];
#pragma unroll
        for (int ks = 0; ks < 4; ++ks) {
            const unsigned co = (unsigned)(((ks * 2 + hi) ^ sw) << 4);
            kf0[ks] = *(const bf16x8*)(Kt + r32 * 128 + co);
            kf1[ks] = *(const bf16x8*)(Kt + (32 + r32) * 128 + co);
        }
        const unsigned char* vr = Vtl + r32 * 128;
#define ATT_VLOAD(dst, st_) do { const unsigned o1_ = (unsigned)((((st_) * 2 + hi) ^ sw) << 4); \
        _Pragma("unroll") for (int d0_ = 0; d0_ < 4; ++d0_) dst[d0_] = *(const bf16x8*)(vr + d0_ * 4096 + o1_); } while (0)
        bf16x8 va[4], vb[4];
        ATT_VLOAD(va, 0);
        f32x16 s0, s1;
#pragma unroll
        for (int r = 0; r < 16; ++r) { s0[r] = 0.f; s1[r] = 0.f; }
#pragma unroll
        for (int ks = 0; ks < 4; ++ks) {
            s0 = __builtin_amdgcn_mfma_f32_32x32x16_bf16(kf0[ks], qf[ks], s0, 0, 0, 0);
            s1 = __builtin_amdgcn_mfma_f32_32x32x16_bf16(kf1[ks], qf[ks], s1, 0, 0, 0);
        }
        float mxa[8];
#pragma unroll
        for (int i_ = 0; i_ < 8; ++i_) mxa[i_] = fmaxf(fmaxf(s0[2 * i_], s0[2 * i_ + 1]), fmaxf(s1[2 * i_], s1[2 * i_ + 1]));
        float mx = fmaxf(fmaxf(fmaxf(mxa[0], mxa[1]), fmaxf(mxa[2], mxa[3])), fmaxf(fmaxf(mxa[4], mxa[5]), fmaxf(mxa[6], mxa[7])));
        { const auto rr = __builtin_amdgcn_permlane32_swap(__float_as_uint(mx), __float_as_uint(mx), false, false); mx = fmaxf(__uint_as_float(rr[0]), __uint_as_float(rr[1])); }
        if (__any(mx > m_run + 8.0f)) {
            const float m_new = fmaxf(m_run, mx);
            const float alpha = __builtin_amdgcn_exp2f((m_run - m_new) * L2E);
            l_run *= alpha; m_run = m_new;
            if (hi == 0) wsf[r32] = alpha;
            asm volatile("s_waitcnt lgkmcnt(0)" ::: "memory");
            float ar[16];
#pragma unroll
            for (int r = 0; r < 16; ++r) ar[r] = wsf[crow(r, hi)];
#pragma unroll
            for (int d0 = 0; d0 < 4; ++d0)
#pragma unroll
                for (int r = 0; r < 16; ++r) O[d0][r] *= ar[r];
            asm volatile("s_waitcnt lgkmcnt(0)" ::: "memory");
        }
        const float mb = m_run * L2E;
        float ps = 0.f;
#pragma unroll
        for (int r = 0; r < 16; ++r) { s0[r] = __builtin_amdgcn_exp2f(s0[r] * L2E - mb); s1[r] = __builtin_amdgcn_exp2f(s1[r] * L2E - mb); ps += s0[r] + s1[r]; }
        l_run += ps;
        u32x4 pw[4];
#pragma unroll
        for (int s = 0; s < 2; ++s) {
            pw[s].x = pk2(s0[8 * s + 0], s0[8 * s + 1]); pw[s].y = pk2(s0[8 * s + 2], s0[8 * s + 3]); pw[s].z = pk2(s0[8 * s + 4], s0[8 * s + 5]); pw[s].w = pk2(s0[8 * s + 6], s0[8 * s + 7]);
            pw[2 + s].x = pk2(s1[8 * s + 0], s1[8 * s + 1]); pw[2 + s].y = pk2(s1[8 * s + 2], s1[8 * s + 3]); pw[2 + s].z = pk2(s1[8 * s + 4], s1[8 * s + 5]); pw[2 + s].w = pk2(s1[8 * s + 6], s1[8 * s + 7]);
        }
#pragma unroll
        ATT_VLOAD(vb, 1);
#pragma unroll
        for (int d0 = 0; d0 < 4; ++d0) O[d0] = __builtin_amdgcn_mfma_f32_32x32x16_bf16(__builtin_bit_cast(bf16x8, pw[0]), va[d0], O[d0], 0, 0, 0);
        ATT_VLOAD(va, 2);
#pragma unroll
        for (int d0 = 0; d0 < 4; ++d0) O[d0] = __builtin_amdgcn_mfma_f32_32x32x16_bf16(__builtin_bit_cast(bf16x8, pw[1]), vb[d0], O[d0], 0, 0, 0);
        ATT_VLOAD(vb, 3);
#pragma unroll
        for (int d0 = 0; d0 < 4; ++d0) O[d0] = __builtin_amdgcn_mfma_f32_32x32x16_bf16(__builtin_bit_cast(bf16x8, pw[2]), va[d0], O[d0], 0, 0, 0);
#pragma unroll
        for (int d0 = 0; d0 < 4; ++d0) O[d0] = __builtin_amdgcn_mfma_f32_32x32x16_bf16(__builtin_bit_cast(bf16x8, pw[3]), vb[d0], O[d0], 0, 0, 0);
#undef ATT_VLOAD
    }
#undef ATT_STAGE
    l_run += __shfl_xor(l_run, 32);
    asm volatile("s_waitcnt lgkmcnt(0)" ::: "memory");
    if (hi == 0) wsf[r32] = 1.0f / l_run;
    asm volatile("s_waitcnt lgkmcnt(0)" ::: "memory");
    float ar[16];
#pragma unroll
    for (int r = 0; r < 16; ++r) ar[r] = wsf[crow(r, hi)];
    asm volatile("s_waitcnt lgkmcnt(0)" ::: "memory");
#pragma unroll
    for (int d0 = 0; d0 < 4; ++d0)
#pragma unroll
        for (int r = 0; r < 16; ++r) O[d0][r] *= ar[r];
}

DI void phase_att(KP p, int l, unsigned char* smem) {
    constexpr int O_WS = 2 * ATT_BUF;
    const int tid = TIDX(), wid = tid >> 6, lane = tid & 63, r32 = lane & 31, hi = lane >> 5;
    const int li = l >> 1;
    const bf16_t* Qc = (const bf16_t*)(p->ws + WS_QC); const bf16_t* Kc = (const bf16_t*)(p->ws + WS_KC); const bf16_t* Vt = (const bf16_t*)(p->ws + WS_VT);
    bf16_t* Y = (bf16_t*)(p->ws + WS_Y);
    float* stash = (float*)(p->ws + WS_P) + ((size_t)BIDX() * 256 + tid) * 32;
    const float lam_init = 0.8f - 0.6f * expf(-0.3f * (float)l);
    float* wsf = (float*)(smem + O_WS) + wid * 32;
    const int per_x = (l == 3) ? 128 : 144;
    for (int i = 0;; ++i) {
        int b, h, p0, nkv;
        {
            const int G = gridDim.x, bid = BIDX();
            int item;
            if ((G & 7) == 0) { const int x = bid & 7, q = i * (G >> 3) + (bid >> 3); if (q >= per_x) break; item = q < 128 ? x * 128 + q : 1024 + x * 16 + (q - 128); }
            else { item = i * G + bid; if (item >= 8 * per_x) break; }
            if (item < 1024) { b = item >> 7; h = (item >> 4) & 7; p0 = 256 + (item & 15) * 128; nkv = TA; }
            else { const int q = item - 1024; b = q >> 4; h = (q >> 1) & 7; p0 = (q & 1) * 128; nkv = TC; }
        }
        float d1 = 0.f, d2 = 0.f;
        { const float* lq1 = p->in[19] + (li * 8 + h) * 64, *lk1 = p->in[20] + (li * 8 + h) * 64, *lq2 = p->in[21] + (li * 8 + h) * 64, *lk2 = p->in[22] + (li * 8 + h) * 64;
          d1 = wave_sum(lq1[lane] * lk1[lane]); d2 = wave_sum(lq2[lane] * lk2[lane]); }
        const float lamv = expf(d1) - expf(d2) + lam_init;
        f32x16 On[4];
        __syncthreads();
        att_component(Qc, Kc, Vt, smem, wsf, b, h, 0, p0, nkv, On);
#pragma unroll
        for (int d0 = 0; d0 < 4; ++d0)
#pragma unroll
            for (int r = 0; r < 16; r += 8) {
                u32x4 w; w.x = pk2(On[d0][r], On[d0][r + 1]); w.y = pk2(On[d0][r + 2], On[d0][r + 3]); w.z = pk2(On[d0][r + 4], On[d0][r + 5]); w.w = pk2(On[d0][r + 6], On[d0][r + 7]);
                *(u32x4*)(stash + (d0 * 16 + r) / 2) = w;
            }
        __syncthreads();
        att_component(Qc, Kc, Vt, smem, wsf, b, h, 1, p0, nkv, On);
#pragma unroll
        for (int d0 = 0; d0 < 4; ++d0)
#pragma unroll
            for (int r = 0; r < 16; r += 8) {
                const u32x4 w = *(const u32x4*)(stash + (d0 * 16 + r) / 2);
                On[d0][r] = bflo(w.x) - lamv * On[d0][r]; On[d0][r + 1] = bfhi(w.x) - lamv * On[d0][r + 1]; On[d0][r + 2] = bflo(w.y) - lamv * On[d0][r + 2]; On[d0][r + 3] = bfhi(w.y) - lamv * On[d0][r + 3];
                On[d0][r + 4] = bflo(w.z) - lamv * On[d0][r + 4]; On[d0][r + 5] = bfhi(w.z) - lamv * On[d0][r + 5]; On[d0][r + 6] = bflo(w.w) - lamv * On[d0][r + 6]; On[d0][r + 7] = bfhi(w.w) - lamv * On[d0][r + 7];
            }
        float ms[16];
#pragma unroll
        for (int r = 0; r < 16; ++r) {
            float s = (On[0][r] * On[0][r] + On[1][r] * On[1][r]) + (On[2][r] * On[2][r] + On[3][r] * On[3][r]);
            s += __shfl_xor(s, 1); s += __shfl_xor(s, 2); s += __shfl_xor(s, 4); s += __shfl_xor(s, 8); s += __shfl_xor(s, 16);
            ms[r] = __builtin_amdgcn_rsqf(s * (1.0f / 128.0f) + LN_EPS);
        }
        const float* sg = p->in[23] + li * 1024 + h * 128;
        const float post = 1.0f - lam_init;
        float gsc[4];
#pragma unroll
        for (int d0 = 0; d0 < 4; ++d0) gsc[d0] = sg[d0 * 32 + r32] * post;
        __syncthreads();
        unsigned char* stg = smem + wid * 8192;
#pragma unroll
        for (int r = 0; r < 16; ++r) {
            unsigned char* sp = stg + crow(r, hi) * 256 + r32 * 2;
#pragma unroll
            for (int d0 = 0; d0 < 4; ++d0) *(unsigned short*)(sp + d0 * 64) = (unsigned short)f2bf(On[d0][r] * ms[r] * gsc[d0]);
        }
        asm volatile("s_waitcnt lgkmcnt(0)" ::: "memory");
#pragma unroll
        for (int i2 = 0; i2 < 8; ++i2) {
            const int id = lane + 64 * i2, qr = id >> 4, ch = id & 15;
            const int pq = p0 + wid * 32 + qr;
            const int row = pq < 256 ? ML + b * 256 + pq : b * 2048 + (pq - 256);
            *(u32x4*)(Y + (size_t)row * 1024 + h * 128 + ch * 8) = *(const u32x4*)(stg + qr * 256 + ch * 16);
        }
        asm volatile("s_waitcnt lgkmcnt(0)" ::: "memory");
    }
}

#define XB_TMO      128
#define XB_XCNT(j)  (256  + 64 * (j))
#define XB_XSUB(j)  (1280 + 64 * (j))
#define XB_XGEN(j)  (2304 + 64 * (j))
#define XB_TOP      3328
#define XB_TOPGEN   3392
#define XCD_BAR_WORDS 3456
#define XB_SPIN_CAP (1u << 22)
DI unsigned xb_ld(unsigned* p)              { return __hip_atomic_load(p, __ATOMIC_RELAXED, __HIP_MEMORY_SCOPE_AGENT); }
DI unsigned xb_add(unsigned* p, unsigned v) { return __hip_atomic_fetch_add(p, v, __ATOMIC_RELAXED, __HIP_MEMORY_SCOPE_AGENT); }
DI unsigned xb_xcc_id() { return (unsigned)__builtin_amdgcn_s_getreg((3 << 11) | 20) & 0xFu; }
#define XB_SPIN(cond, bar) do { unsigned _sp = 0; while (cond) { __builtin_amdgcn_s_sleep(1); \
    if ((++_sp & 255u) == 0u) { if (xb_ld(&(bar)[XB_TMO])) break; if (_sp > XB_SPIN_CAP) { atomicAdd(&(bar)[XB_TMO], 1u); break; } } } } while (0)
struct XcdBarrier { unsigned* bar; unsigned x; volatile LAS unsigned* st; };
DI XcdBarrier xcd_barrier_post(unsigned* bar, volatile LAS unsigned* st) {
    XcdBarrier b; b.bar = bar; b.x = xb_xcc_id(); b.st = st;
    if (threadIdx.x == 0) (void)xb_add(&bar[XB_XCNT(b.x)], 1u);
    return b;
}
DI void xcd_barrier_complete(unsigned* bar, unsigned x, unsigned& nloc, unsigned& nx) {
    const unsigned G = gridDim.x * gridDim.y * gridDim.z;
    unsigned sum, cnt, mine, sp = 0u;
    for (;;) {
        sum = 0u; cnt = 0u; mine = 0u;
#pragma unroll
        for (unsigned j = 0; j < 16; ++j) { const unsigned c = xb_ld(&bar[XB_XCNT(j)]); sum += c; cnt += (c > 0u) ? 1u : 0u; mine = (j == x) ? c : mine; }
        if (sum == G) break;
        __builtin_amdgcn_s_sleep(1);
        if ((++sp & 255u) == 0u) { if (xb_ld(&bar[XB_TMO])) break; if (sp > XB_SPIN_CAP) { atomicAdd(&bar[XB_TMO], 1u); break; } }
    }
    nloc = mine > 0u ? mine : 1u; nx = cnt > 0u ? cnt : 1u;
}
DI void xcd_barrier(const XcdBarrier& b) {
    asm volatile("s_waitcnt vmcnt(0)" ::: "memory");
    __syncthreads();
    if (threadIdx.x == 0) {
        unsigned* bar = b.bar;
        __builtin_amdgcn_s_waitcnt(0);
        unsigned nloc = b.st[0], nx = b.st[1];
        if (nloc == 0u) { xcd_barrier_complete(bar, b.x, nloc, nx); b.st[0] = nloc; b.st[1] = nx; }
        const unsigned old = xb_add(&bar[XB_XSUB(b.x)], 1u);
        const unsigned gen = old / nloc;
        if (old + 1u == (gen + 1u) * nloc) {
            __builtin_amdgcn_fence(__ATOMIC_RELEASE, "agent");
            asm volatile("s_waitcnt vmcnt(0)" ::: "memory");
            const unsigned og = xb_add(&bar[XB_TOP], 1u);
            const unsigned tg = og / nx;
            if (og + 1u == (tg + 1u) * nx) xb_add(&bar[XB_TOPGEN], 1u);
            else XB_SPIN(xb_ld(&bar[XB_TOPGEN]) == tg, bar);
            __builtin_amdgcn_fence(__ATOMIC_ACQUIRE, "agent");
            xb_add(&bar[XB_XGEN(b.x)], 1u);
            asm volatile("s_waitcnt vmcnt(0)" ::: "memory");
        } else {
            XB_SPIN(xb_ld(&bar[XB_XGEN(b.x)]) == gen, bar);
            __builtin_amdgcn_fence(__ATOMIC_ACQUIRE, "agent");
            asm volatile("s_waitcnt vmcnt(0)" ::: "memory");
        }
    }
    __syncthreads();
}

#ifdef DOUBLE_MASK
#define DRYCOND (rep_ == 0 && nrep_ == 2)
#else
#define DRYCOND false
#endif
constexpr int NPHASE = 34;
constexpr int LDS_BYTES = 65536 + 1024;
__global__ void __launch_bounds__(256, 2) mega(Params pv) {
    extern __shared__ __attribute__((aligned(16))) unsigned char smem[];
    const int ph_lo = pv.ph_lo, ph_hi = pv.ph_hi;
    volatile LAS unsigned* bar_st = (volatile LAS unsigned*)(LAS unsigned char*)(smem + 65536);
    if (threadIdx.x == 0) { bar_st[0] = 0u; bar_st[1] = 0u; }
    __syncthreads();
    XcdBarrier xbar = xcd_barrier_post((unsigned*)(pv.ws + WS_CTL) + 4096, bar_st);
    for (int ph = ph_lo; ph < ph_hi; ++ph) {
        KP p = (KP)__builtin_amdgcn_kernarg_segment_ptr();
        asm volatile("" : "+s"(p) :: "memory");
#ifdef DOUBLE_MASK
        int kind_;
        if (ph == 0) kind_ = 0; else if (ph == 1) kind_ = 1;
        else { const int rem_ = (ph - 2) % 16; kind_ = rem_ == 0 ? 2 : (rem_ == 1 ? 12 : (rem_ < 9 ? rem_ + 1 : (rem_ == 9 ? 10 : (rem_ == 10 ? 11 : (rem_ - 11 + 5))))); }
        const int nrep_ = ((DOUBLE_MASK >> kind_) & 1) ? 2 : 1;
        for (int rep_ = 0; rep_ < nrep_; ++rep_) {
        if (rep_) xcd_barrier(xbar);
#endif
        if (ph == 0) phase_pre0(p, smem);
        else if (ph == 1) phase_pre1(p);
        else {
            const int q = ph - 2, lp = q / 16, rem = q % 16;
            if (rem < 9) {
                const int l = 2 * lp;
                switch (rem) {
                    case 0: phase_g1e(p, l, smem); break;
                    case 1: phase_decay(p, l, smem); break;
                    case 2: phase_scan(p, l, smem); break;
                    case 3: phase_merge(p, l); break;
                    case 4: phase_g2(p, l, smem); break;
                    case 5: if (DRYCOND) phase_ln1r<true>(p, l, smem); else phase_ln1r<false>(p, l, smem); break;
                    case 6: phase_mg1(p, l, smem); break;
                    case 7: phase_mg2(p, l, smem); break;
                    default: if (DRYCOND) phase_ln2<true>(p, l); else phase_ln2<false>(p, l); break;
                }
            } else {
                const int l = 2 * lp + 1;
                switch (rem - 9) {
                    case 0: phase_g1o(p, l, smem); break;
                    case 1: phase_att(p, l, smem); break;
                    case 2: phase_g2(p, l, smem); break;
                    case 3: if (DRYCOND) phase_ln1r<true>(p, l, smem); else phase_ln1r<false>(p, l, smem); break;
                    case 4: phase_mg1(p, l, smem); break;
                    case 5: phase_mg2(p, l, smem); break;
                    default: if (DRYCOND) phase_ln2<true>(p, l); else phase_ln2<false>(p, l); break;
                }
            }
        }
#ifdef DOUBLE_MASK
        }
#endif
        if (ph + 1 < ph_hi) xcd_barrier(xbar);
    }
}

extern "C" void kernel_launch(void* const* d_in, const int* in_sizes, int n_in, void* d_out, int out_size, void* d_ws, size_t ws_size, hipStream_t stream) {
    static int grid_blocks = 0;
    if (grid_blocks == 0) {
        if (n_in != 32 || ws_size < WS_END) { fprintf(stderr, "kernel_launch: unexpected n_in %d or ws_size %zu\n", n_in, ws_size); grid_blocks = -1; return; }
        int dev = 0, cus = 0, per_cu = 0;
        hipGetDevice(&dev);
        hipDeviceGetAttribute(&cus, hipDeviceAttributeMultiprocessorCount, dev);
        hipFuncSetAttribute((const void*)mega, hipFuncAttributeMaxDynamicSharedMemorySize, LDS_BYTES);
        hipOccupancyMaxActiveBlocksPerMultiprocessor(&per_cu, mega, 256, LDS_BYTES);
        if (per_cu > 2) per_cu = 2;
        if (per_cu < 1) per_cu = 1;
        grid_blocks = cus * per_cu;
    }
    if (grid_blocks < 0) return;
    hipMemsetAsync((char*)d_ws + WS_CTL, 0, 32768, stream);
    Params p{};
    for (int i = 0; i < 32; ++i) p.in[i] = (const float*)d_in[i];
    p.out = (float*)d_out; p.ws = (unsigned char*)d_ws;
#if N_LAUNCH_MODE == 1
    p.ph_lo = 0; p.ph_hi = NPHASE;
    void* args[] = {&p};
    hipError_t e = hipLaunchCooperativeKernel((void*)mega, dim3(grid_blocks), dim3(256), args, LDS_BYTES, stream);
    if (e != hipSuccess) fprintf(stderr, "cooperative launch failed: %s (grid %d)\n", hipGetErrorString(e), grid_blocks);
#else
    for (int ph = 0; ph < NPHASE; ++ph) {
        p.ph_lo = ph; p.ph_hi = ph + 1;
        hipLaunchKernelGGL(mega, dim3(grid_blocks), dim3(256), LDS_BYTES, stream, p);
    }
#endif
}
```

```cpp
#include <hip/hip_runtime.h>
#include <hip/hip_cooperative_groups.h>
#include <cstdio>
#include <cstdint>
namespace cg = cooperative_groups;

#ifndef N_LAUNCH_MODE
#define N_LAUNCH_MODE 1
#endif

#define DI __device__ __forceinline__
#define LAS __attribute__((address_space(3)))
typedef unsigned short bf16_t;
typedef short bf16x8 __attribute__((ext_vector_type(8)));
typedef short s16x4 __attribute__((ext_vector_type(4)));
typedef float f32x4 __attribute__((ext_vector_type(4)));
typedef float f32x16 __attribute__((ext_vector_type(16)));
typedef unsigned u32x4 __attribute__((ext_vector_type(4)));
typedef unsigned u32x2 __attribute__((ext_vector_type(2)));

constexpr int D = 1024, NB = 8, T = 2048, TC = 256, TA = T + TC;
constexpr int ML = NB * T, MC = NB * TC, MT = ML + MC;
constexpr int NIN = 3616, NINP = 3712, ZS = 3712;
constexpr int NSLOT = 2 * MT;
constexpr float LN_EPS = 1e-5f;
constexpr float ALPHA = 1.6817928305074290f;
constexpr float L2E = 1.4426950408889634f;

constexpr size_t MiB = 1ull << 20;
constexpr size_t WS_CTL = 0;
constexpr int CNT_WORD0 = 32768;
constexpr int CNT_STRIDE = 1088;
constexpr size_t WS_MOD = 1 * MiB;
constexpr size_t WS_ROPEA = 2 * MiB;
constexpr size_t WS_ROPEC = 3 * MiB;
constexpr size_t WS_LR = 4 * MiB;
constexpr size_t WS_SLOTW = 7 * MiB;
constexpr size_t WS_LIST = 8 * MiB;
constexpr size_t WS_WRT = 13 * MiB;
constexpr size_t WS_WIN = 16 * MiB;
constexpr size_t WS_WABO = 32 * MiB;
constexpr size_t WS_WQKV = 36 * MiB;
constexpr size_t WS_WCO = 48 * MiB;
constexpr size_t WS_WGU = 64 * MiB;
constexpr size_t WS_WD = 320 * MiB;
constexpr size_t WS_X = 448 * MiB;
constexpr size_t WS_U = 520 * MiB;
constexpr size_t WS_Y = 556 * MiB;
constexpr size_t WS_Z = 592 * MiB;
constexpr size_t WS_O = 724 * MiB;
constexpr size_t WS_PF = 868 * MiB, WS_SQ = 886 * MiB, WS_SK = 904 * MiB, WS_TOT = 922 * MiB;
constexpr size_t WS_END = 923 * MiB;
constexpr size_t WS_QC = WS_Z, WS_KC = WS_Z + 36 * MiB, WS_VT = WS_Z + 72 * MiB;
constexpr size_t WS_YS = WS_Z;
constexpr size_t WS_OF = WS_O, WS_OB = WS_O + 72 * MiB, WS_P = WS_O, WS_H = WS_O + 72 * MiB;

#ifndef XBF16
#define XBF16 0
#endif
#if XBF16
typedef bf16_t xres_t;
#else
typedef float xres_t;
#endif
struct Params { const float* in[32]; float* out; unsigned char* ws; int ph_lo, ph_hi; };
typedef const __attribute__((address_space(4))) Params* KP;

DI int TIDX() { int t = threadIdx.x; asm volatile("" : "+v"(t)); return t; }
DI int BIDX() { int b = blockIdx.x; asm volatile("" : "+s"(b)); return b; }
DI unsigned pk2(float lo, float hi);
DI unsigned f2bf(float f) { return pk2(f, 0.f) & 0xffffu; }
typedef float f32x2_t __attribute__((ext_vector_type(2))); typedef __bf16 bf16x2_t __attribute__((ext_vector_type(2)));
DI unsigned pk2(float lo, float hi) { f32x2_t v = {lo, hi}; bf16x2_t b = __builtin_convertvector(v, bf16x2_t); return __builtin_bit_cast(unsigned, b); }
DI float bflo(unsigned w) { return __uint_as_float(w << 16); }
DI float bfhi(unsigned w) { return __uint_as_float(w & 0xffff0000u); }
DI f32x4 xload(const xres_t* p) {
#if XBF16
    const u32x2 w = *(const u32x2*)p; return (f32x4){bflo(w.x), bfhi(w.x), bflo(w.y), bfhi(w.y)};
#else
    return *(const f32x4*)p;
#endif
}
DI void xstore(xres_t* p, f32x4 v) {
#if XBF16
    u32x2 w; w.x = pk2(v[0], v[1]); w.y = pk2(v[2], v[3]); *(u32x2*)p = w;
#else
    *(f32x4*)p = v;
#endif
}
DI float wave_sum(float v) {
    int x = __float_as_int(v);
    v += __int_as_float(__builtin_amdgcn_update_dpp(x, x, 0xB1, 0xF, 0xF, false)); x = __float_as_int(v);
    v += __int_as_float(__builtin_amdgcn_update_dpp(x, x, 0x4E, 0xF, 0xF, false)); x = __float_as_int(v);
    v += __int_as_float(__builtin_amdgcn_update_dpp(x, x, 0x141, 0xF, 0xF, false)); x = __float_as_int(v);
    v += __int_as_float(__builtin_amdgcn_update_dpp(x, x, 0x140, 0xF, 0xF, false));
    { const auto r = __builtin_amdgcn_permlane16_swap(__float_as_uint(v), __float_as_uint(v), false, false); v = __uint_as_float(r[0]) + __uint_as_float(r[1]); }
    { const auto r = __builtin_amdgcn_permlane32_swap(__float_as_uint(v), __float_as_uint(v), false, false); v = __uint_as_float(r[0]) + __uint_as_float(r[1]); }
    return v;
}
DI float siluf(float v) { return v * __builtin_amdgcn_rcpf(1.0f + __expf(-v)); }

DI int gemm_chunk(int tid) { return (tid & 7) ^ ((tid >> 4) & 7); }
template <bool TRN>
DI void gemm_tile(unsigned char* shm, const bf16_t* const (&ap)[4], const bf16_t* const (&bp)[4], int K, f32x4 (&acc)[4][4],
                  bool first, bool has_next, const bf16_t* const (&apn)[4], const bf16_t* const (&bpn)[4]) {
    const int tid = TIDX(), wid = tid >> 6, lane = tid & 63, wr = wid >> 1, wc = wid & 1, fr = lane & 15, fq = lane >> 4;
#pragma unroll
    for (int m = 0; m < 4; ++m)
#pragma unroll
        for (int n = 0; n < 4; ++n) acc[m][n] = (f32x4){0.f, 0.f, 0.f, 0.f};
    const int nt = K >> 6;
    const int sw = fr >> 1;
    const unsigned aoff = (unsigned)((wr * 64 + fr) * 128), boff = (unsigned)(16384 + (wc * 64 + fr) * 128);
#define GEMM_STAGE(buf, A_, B_, t) do { _Pragma("unroll") for (int i_ = 0; i_ < 4; ++i_) { \
        __builtin_amdgcn_global_load_lds((const unsigned*)(A_[i_] + (t) * 64), (LAS unsigned*)(shm + (buf) * 32768 + i_ * 4096 + tid * 16), 16, 0, 0); \
        __builtin_amdgcn_global_load_lds((const unsigned*)(B_[i_] + (t) * 64), (LAS unsigned*)(shm + (buf) * 32768 + 16384 + i_ * 4096 + tid * 16), 16, 0, 0); } } while (0)
    if (first) {
        GEMM_STAGE(0, ap, bp, 0);
        asm volatile("s_waitcnt vmcnt(0)" ::: "memory");
        __syncthreads();
    }
    for (int t = 0; t < nt; ++t) {
        const int cur = t & 1;
        if (t + 1 < nt) GEMM_STAGE(cur ^ 1, ap, bp, t + 1);
        else if (has_next) GEMM_STAGE(cur ^ 1, apn, bpn, 0);
        const unsigned char* base = shm + cur * 32768;
        bf16x8 At[2][4], Bt[2][4];
#pragma unroll
        for (int ks = 0; ks < 2; ++ks) {
            const unsigned co = (unsigned)(((ks * 4 + fq) ^ sw) << 4);
#pragma unroll
            for (int m = 0; m < 4; ++m) At[ks][m] = *(const bf16x8*)(base + aoff + m * 2048 + co);
#pragma unroll
            for (int n = 0; n < 4; ++n) Bt[ks][n] = *(const bf16x8*)(base + boff + n * 2048 + co);
        }
        __builtin_amdgcn_s_setprio(1);
#pragma unroll
        for (int ks = 0; ks < 2; ++ks)
#pragma unroll
            for (int m = 0; m < 4; ++m)
#pragma unroll
                for (int n = 0; n < 4; ++n)
                    acc[m][n] = TRN ? __builtin_amdgcn_mfma_f32_16x16x32_bf16(Bt[ks][n], At[ks][m], acc[m][n], 0, 0, 0)
                                    : __builtin_amdgcn_mfma_f32_16x16x32_bf16(At[ks][m], Bt[ks][n], acc[m][n], 0, 0, 0);
        __builtin_amdgcn_s_setprio(0);
        asm volatile("s_waitcnt vmcnt(0)" ::: "memory");
        __syncthreads();
    }
#undef GEMM_STAGE
}
#define GEMM_ADVANCE() do { _Pragma("unroll") for (int k_ = 0; k_ < 4; ++k_) { ap[k_] = apn[k_]; bp[k_] = bpn[k_]; } } while (0)
DI void gemm_rows(const bf16_t* base, int r0, int ld, int tid, const bf16_t* (&pp)[4]) {
    const bf16_t* q = base + (size_t)(r0 + (tid >> 3)) * ld + gemm_chunk(tid) * 8;
#pragma unroll
    for (int i = 0; i < 4; ++i) pp[i] = q + (size_t)(32 * i) * ld;
}
DI bool tile_seq(int q, int nrt, int nct, int& rt, int& ct) {
    if (q >= nrt * nct) return false;
    const int band = q / (8 * nct), rem = q - band * 8 * nct;
    const int rows = (nrt - band * 8) < 8 ? (nrt - band * 8) : 8;
    ct = rem / rows; rt = band * 8 + rem % rows;
    return true;
}
DI int xcd_seq(int i, int total) {
    const int G = gridDim.x, bid = BIDX();
    if ((G & 7) != 0) { const int q = i * G + bid; return q < total ? q : -1; }
    const int x = bid & 7, j = bid >> 3, per = (total + 7) >> 3, gx = G >> 3;
    const int q = i * gx + j;
    if (q >= per) return -1;
    const int g = x * per + q;
    return g < total ? g : -1;
}

struct TrDesc { const float* W; bf16_t* WT; int K, N, mode, item; };
DI void tr_load(const TrDesc& d, int lane, float (&wv)[32]) {
    const int nblk = d.N / 32, kb = d.item / nblk, nb = d.item % nblk, k0 = 64 * kb, n0 = 32 * nb;
    const float* src = d.W + (size_t)(k0 + (lane >> 5)) * d.N + n0 + (lane & 31);
#pragma unroll
    for (int i = 0; i < 32; ++i) wv[i] = src[(size_t)(2 * i) * d.N];
}
DI void tr_store(const TrDesc& d, int lane, float* scr, const float (&wv)[32]) {
    const int nblk = d.N / 32, kb = d.item / nblk, nb = d.item % nblk, k0 = 64 * kb, n0 = 32 * nb;
#pragma unroll
    for (int i = 0; i < 32; ++i) scr[(2 * i + (lane >> 5)) * 33 + (lane & 31)] = wv[i];
    asm volatile("s_waitcnt lgkmcnt(0)" ::: "memory");
    const int c = lane & 7;
#pragma unroll
    for (int j = 0; j < 4; ++j) {
        const int n = (lane >> 3) + 8 * j; const float* s = scr + (8 * c) * 33 + n;
        u32x4 o; o.x = pk2(s[0 * 33], s[1 * 33]); o.y = pk2(s[2 * 33], s[3 * 33]); o.z = pk2(s[4 * 33], s[5 * 33]); o.w = pk2(s[6 * 33], s[7 * 33]);
        const int nn = n0 + n;
        const int drow = (d.mode == 0) ? nn : ((nn >> 4) * 32 + (nn & 15) + (d.mode == 2 ? 16 : 0));
        *(u32x4*)(d.WT + (size_t)drow * d.K + k0 + 8 * c) = o;
    }
    asm volatile("s_waitcnt lgkmcnt(0)" ::: "memory");
}

DI void phase_pre0(KP p, unsigned char* smem) {
    const int tid = TIDX(), wave = tid >> 6, lane = tid & 63;
    unsigned char* ws = p->ws;
    if (BIDX() == 0 && tid < 128) {
        unsigned* c0 = (unsigned*)(ws + WS_CTL) + CNT_WORD0 + tid * CNT_STRIDE;
        __hip_atomic_store(c0, 0u, __ATOMIC_RELAXED, __HIP_MEMORY_SCOPE_AGENT); __hip_atomic_store(c0 + 64, 0u, __ATOMIC_RELAXED, __HIP_MEMORY_SCOPE_AGENT);
    }
    {
        float* s_sc = (float*)smem;
        float* s_red = s_sc + 9 * 1024;
        const float* c = p->in[1]; const float* cc = p->in[3];
        for (int i = tid; i < 9 * 1024; i += 256) { const int r = i >> 10, k = i & 1023; const float v = r < 8 ? c[r * 1024 + k] : cc[k]; s_sc[i] = v / (1.0f + expf(-v)); }
        __syncthreads();
        float* MOD = (float*)(ws + WS_MOD);
        for (int item = BIDX(); item < 384; item += gridDim.x) {
            const int l = item / 96, n0 = (item % 96) * 64;
            const float* W = p->in[4] + (size_t)l * 1024 * 6144 + n0 + lane;
            float acc[9];
#pragma unroll
            for (int r = 0; r < 9; ++r) acc[r] = 0.f;
#pragma unroll 16
            for (int k = wave * 256; k < wave * 256 + 256; ++k) {
                const float w = W[(size_t)k * 6144];
#pragma unroll
                for (int r = 0; r < 9; ++r) acc[r] += s_sc[r * 1024 + k] * w;
            }
#pragma unroll
            for (int r = 0; r < 9; ++r) s_red[(wave * 9 + r) * 64 + lane] = acc[r];
            __syncthreads();
            for (int i = tid; i < 9 * 64; i += 256) {
                const int r = i >> 6, ln = i & 63;
                const float v = s_red[(0 * 9 + r) * 64 + ln] + s_red[(1 * 9 + r) * 64 + ln] + s_red[(2 * 9 + r) * 64 + ln] + s_red[(3 * 9 + r) * 64 + ln];
                MOD[(size_t)(l * 9 + r) * 6144 + n0 + ln] = v + p->in[5][l * 6144 + n0 + ln];
            }
            __syncthreads();
        }
    }
    {
        const int gt = BIDX() * 256 + tid, NT = gridDim.x * 256;
        float* ca = (float*)(ws + WS_ROPEA); float* sa = ca + 2048 * 64;
        for (int i = gt; i < 2048 * 64; i += NT) {
            const int t = i >> 6, f = i & 63; const int pos = f < 32 ? (t >> 6) : (t & 63); const int ff = f & 31;
            const float inv = powf(10000.0f, -(float)ff / 32.0f); const float a = (float)pos * inv;
            ca[i] = cosf(a); sa[i] = sinf(a);
        }
        float* cc_ = (float*)(ws + WS_ROPEC); float* sc_ = cc_ + 2048 * 32;
        for (int i = gt; i < 2048 * 32; i += NT) {
            const int t = i >> 5, f = i & 31; const int pos = f < 16 ? (t >> 6) : (t & 63); const int ff = f & 15;
            const float inv = powf(10000.0f, -(float)ff / 16.0f); const float a = (float)pos * inv;
            cc_[i] = cosf(a); sc_[i] = sinf(a);
        }
        float* wrt = (float*)(ws + WS_WRT);
        for (int i = gt; i < 4 * 36 * 1024; i += NT) {
            const int l = i / (36 * 1024), o = (i / 1024) % 36, k = i & 1023;
            wrt[i] = o < 4 ? p->in[25][((size_t)l * 1024 + k) * 4 + o] : p->in[27][((size_t)l * 1024 + k) * 32 + (o - 4)];
        }
        unsigned* wpad = (unsigned*)(ws + WS_WIN);
        for (int i = gt; i < 2 * 96 * 512; i += NT) { const int li = i / (96 * 512), r = i % (96 * 512); wpad[((size_t)li * NINP + NIN) * 512 + r] = 0u; }
    }
    __syncthreads();
    {
        float* scr = (float*)smem + wave * (64 * 33);
        constexpr int I_IN = 16 * 113, I_SQ = 16 * 32, I_QKV = 16 * 96, I_E = 256;
        constexpr int R0 = 2 * I_IN, R1 = R0 + 2 * I_SQ, R2 = R1 + 2 * I_QKV, R3 = R2 + 2 * I_SQ, R4 = R3 + 128 * I_E, R5 = R4 + 128 * I_E, R6 = R5 + 128 * I_E;
        auto decode = [&](int it) -> TrDesc {
            TrDesc d;
            if (it < R0) { const int i = it / I_IN; d.item = it % I_IN; d.W = p->in[10] + (size_t)i * 1024 * NIN; d.K = 1024; d.N = NIN; d.WT = (bf16_t*)(ws + WS_WIN) + (size_t)i * NINP * 1024; d.mode = 0; }
            else if (it < R1) { const int q = it - R0, i = q / I_SQ; d.item = q % I_SQ; d.W = p->in[17] + (size_t)i * 1024 * 1024; d.K = 1024; d.N = 1024; d.WT = (bf16_t*)(ws + WS_WABO) + (size_t)i * 1024 * 1024; d.mode = 0; }
            else if (it < R2) { const int q = it - R1, i = q / I_QKV; d.item = q % I_QKV; d.W = p->in[18] + (size_t)i * 1024 * 3072; d.K = 1024; d.N = 3072; d.WT = (bf16_t*)(ws + WS_WQKV) + (size_t)i * 3072 * 1024; d.mode = 0; }
            else if (it < R3) { const int q = it - R2, i = q / I_SQ; d.item = q % I_SQ; d.W = p->in[24] + (size_t)i * 1024 * 1024; d.K = 1024; d.N = 1024; d.WT = (bf16_t*)(ws + WS_WCO) + (size_t)i * 1024 * 1024; d.mode = 0; }
            else if (it < R4) { const int q = it - R3, le = q / I_E; d.item = q % I_E; d.W = p->in[29] + (size_t)le * 1024 * 512; d.K = 1024; d.N = 512; d.WT = (bf16_t*)(ws + WS_WGU) + (size_t)le * 1024 * 1024; d.mode = 1; }
            else if (it < R5) { const int q = it - R4, le = q / I_E; d.item = q % I_E; d.W = p->in[30] + (size_t)le * 1024 * 512; d.K = 1024; d.N = 512; d.WT = (bf16_t*)(ws + WS_WGU) + (size_t)le * 1024 * 1024; d.mode = 2; }
            else { const int q = it - R5, le = q / I_E; d.item = q % I_E; d.W = p->in[31] + (size_t)le * 512 * 1024; d.K = 512; d.N = 1024; d.WT = (bf16_t*)(ws + WS_WD) + (size_t)le * 1024 * 512; d.mode = 0; }
            return d;
        };
        const int istride = gridDim.x * 4;
        int it = BIDX() * 4 + wave;
        float wa[32], wb[32];
        TrDesc dc = decode(it < R6 ? it : 0);
        if (it < R6) tr_load(dc, lane, wa);
#pragma unroll 1
        for (; it < R6; it += istride) {
            const bool hn = it + istride < R6;
            const TrDesc dn = decode(hn ? it + istride : 0);
            if (hn) tr_load(dn, lane, wb);
            tr_store(dc, lane, scr, wa);
            dc = dn;
#pragma unroll
            for (int i = 0; i < 32; ++i) wa[i] = wb[i];
        }
    }
}

DI void phase_pre1(KP p) {
    const int tid = TIDX(), wave = tid >> 6, lane = tid & 63;
    xres_t* X = (xres_t*)(p->ws + WS_X); bf16_t* U = (bf16_t*)(p->ws + WS_U); const float* MOD = (const float*)(p->ws + WS_MOD);
    for (int row = BIDX() * 4 + wave; row < MT; row += gridDim.x * 4) {
        const float* src = row < ML ? p->in[0] + (size_t)row * 1024 : p->in[2] + (size_t)(row - ML) * 1024;
        const int r = row < ML ? (row >> 11) : 8;
        const float* mod = MOD + (size_t)r * 6144;
#pragma unroll
        for (int j = 0; j < 4; ++j) {
            const int k = 256 * j + 4 * lane;
            const f32x4 v = *(const f32x4*)(src + k), sh = *(const f32x4*)(mod + k), sc = *(const f32x4*)(mod + 1024 + k);
            const f32x4 u = v * (1.0f + sc) + sh;
            u32x2 w; w.x = pk2(u[0], u[1]); w.y = pk2(u[2], u[3]);
            *(u32x2*)(U + (size_t)row * 1024 + k) = w;
        }
    }
}

DI void phase_g1e(KP p, int l, unsigned char* smem) {
    const int tid = TIDX(), wid = tid >> 6, lane = tid & 63, wr = wid >> 1, wc = wid & 1, fr = lane & 15, fq = lane >> 4;
    const int li = l >> 1;
    const bf16_t* U = (const bf16_t*)(p->ws + WS_U); const bf16_t* W = (const bf16_t*)(p->ws + WS_WIN) + (size_t)li * NINP * 1024;
    bf16_t* Z = (bf16_t*)(p->ws + WS_Z); float* LR = (float*)(p->ws + WS_LR);
    const float* ca = (const float*)(p->ws + WS_ROPEA); const float* sa = ca + 2048 * 64;
    constexpr int NTN = NINP / 128;
    auto decode = [&](int i, int& brow, int& bcol) -> bool {
        const int q = xcd_seq(i, (MT / 128) * NTN); if (q < 0) return false;
        int rt, nt; tile_seq(q, MT / 128, NTN, rt, nt); brow = rt * 128; bcol = nt * 128; return true; };
    auto epi = [&](int brow, int bcol, f32x4 (&acc)[4][4]) {
        const int colw = bcol + wc * 64;
        if (colw >= NIN) return;
        if (colw >= 3584) {
#pragma unroll
            for (int m = 0; m < 4; ++m) { const int row = brow + wr * 64 + m * 16 + fr;
#pragma unroll
                for (int n = 0; n < 2; ++n) *(f32x4*)(LR + (size_t)row * 32 + n * 16 + fq * 4) = acc[m][n]; }
            return;
        }
        const bool ropeR = colw < 1024; const int half = (colw >> 6) & 1;
        const float scale = colw < 512 ? 0.08838834764831845f : ((colw >= 2048 && colw < 2304) ? 0.125f : 1.0f);
#pragma unroll
        for (int m = 0; m < 4; ++m) {
            const int row = brow + wr * 64 + m * 16 + fr;
            if (ropeR && row < ML) {
                const int t = row & 2047;
#pragma unroll
                for (int n = 0; n < 2; ++n) {
                    const f32x4 c4 = *(const f32x4*)(ca + t * 64 + half * 32 + n * 16 + fq * 4), s4 = *(const f32x4*)(sa + t * 64 + half * 32 + n * 16 + fq * 4);
                    const f32x4 a = acc[m][n], b = acc[m][n + 2];
                    acc[m][n] = a * c4 - b * s4; acc[m][n + 2] = b * c4 + a * s4;
                }
            }
#pragma unroll
            for (int n = 0; n < 4; ++n) {
                const f32x4 v = acc[m][n] * scale; u32x2 w; w.x = pk2(v[0], v[1]); w.y = pk2(v[2], v[3]);
                *(u32x2*)(Z + (size_t)row * ZS + colw + n * 16 + fq * 4) = w;
            }
        }
    };
    int brow, bcol;
    if (!decode(0, brow, bcol)) return;
    const bf16_t* ap[4]; const bf16_t* bp[4]; const bf16_t* apn[4]; const bf16_t* bpn[4];
    gemm_rows(U, brow, 1024, tid, ap); gemm_rows(W, bcol, 1024, tid, bp);
    bool first = true;
    for (int i = 0;; ++i) {
        int nbrow = brow, nbcol = bcol; const bool hn = decode(i + 1, nbrow, nbcol);
        gemm_rows(U, nbrow, 1024, tid, apn); gemm_rows(W, nbcol, 1024, tid, bpn);
        f32x4 acc[4][4];
        gemm_tile<true>(smem, ap, bp, 1024, acc, first, hn, apn, bpn);
        epi(brow, bcol, acc);
        if (!hn) break;
        brow = nbrow; bcol = nbcol; GEMM_ADVANCE(); first = false;
    }
}

DI void phase_g1o(KP p, int l, unsigned char* smem) {
    const int tid = TIDX(), wid = tid >> 6, lane = tid & 63, wr = wid >> 1, wc = wid & 1, fr = lane & 15, fq = lane >> 4;
    const int li = l >> 1;
    const bf16_t* U = (const bf16_t*)(p->ws + WS_U); const bf16_t* W = (const bf16_t*)(p->ws + WS_WQKV) + (size_t)li * 3072 * 1024;
    bf16_t* Qc = (bf16_t*)(p->ws + WS_QC); bf16_t* Kc = (bf16_t*)(p->ws + WS_KC); bf16_t* Vt = (bf16_t*)(p->ws + WS_VT);
    const float* cc = (const float*)(p->ws + WS_ROPEC); const float* sc = cc + 2048 * 32;
    auto decode = [&](int i, int& brow, int& bcol) -> bool {
        const int q = xcd_seq(i, (MT / 128) * 24); if (q < 0) return false;
        int rt, nt; tile_seq(q, MT / 128, 24, rt, nt); brow = rt * 128; bcol = nt * 128; return true; };
    int brow, bcol;
    if (!decode(0, brow, bcol)) return;
    const bf16_t* ap[4]; const bf16_t* bp[4]; const bf16_t* apn[4]; const bf16_t* bpn[4];
    gemm_rows(U, brow, 1024, tid, ap); gemm_rows(W, bcol, 1024, tid, bp);
    bool first = true;
    for (int i = 0;; ++i) {
        int nbrow = brow, nbcol = bcol; const bool hn = decode(i + 1, nbrow, nbcol);
        gemm_rows(U, nbrow, 1024, tid, apn); gemm_rows(W, nbcol, 1024, tid, bpn);
        f32x4 acc[4][4];
        if (bcol < 2048) {
            gemm_tile<true>(smem, ap, bp, 1024, acc, first, hn, apn, bpn);
            const int colw = bcol + wc * 64; const bool isk = colw >= 1024; const int hc = (colw & 1023) >> 6;
            bf16_t* dst = isk ? Kc : Qc; const float scale = isk ? 1.0f : 0.125f;
#pragma unroll
            for (int m = 0; m < 4; ++m) {
                const int row = brow + wr * 64 + m * 16 + fr;
                int b, pidx;
                if (row < ML) {
                    b = row >> 11; const int t = row & 2047; pidx = 256 + t;
#pragma unroll
                    for (int n = 0; n < 4; n += 2) {
                        const f32x4 c4 = *(const f32x4*)(cc + t * 32 + (n >> 1) * 16 + fq * 4), s4 = *(const f32x4*)(sc + t * 32 + (n >> 1) * 16 + fq * 4);
                        const f32x4 a = acc[m][n], bb = acc[m][n + 1];
                        acc[m][n] = a * c4 - bb * s4; acc[m][n + 1] = bb * c4 + a * s4;
                    }
                } else { b = (row - ML) >> 8; pidx = (row - ML) & 255; }
                bf16_t* o = dst + ((size_t)(b * 16 + hc) * TA + pidx) * 64;
#pragma unroll
                for (int n = 0; n < 4; ++n) { const f32x4 v = acc[m][n] * scale; u32x2 w; w.x = pk2(v[0], v[1]); w.y = pk2(v[2], v[3]); *(u32x2*)(o + n * 16 + fq * 4) = w; }
            }
        } else {
            gemm_tile<false>(smem, ap, bp, 1024, acc, first, hn, apn, bpn);
#pragma unroll
            for (int m = 0; m < 4; ++m) {
                const int row = brow + wr * 64 + m * 16 + fq * 4;
                int b, pidx;
                if (row < ML) { b = row >> 11; pidx = 256 + (row & 2047); } else { b = (row - ML) >> 8; pidx = (row - ML) & 255; }
                const int ppos = (pidx & ~12) | ((pidx & 8) >> 1) | ((pidx & 4) << 1);
#pragma unroll
                for (int n = 0; n < 4; ++n) {
                    const int col = bcol - 2048 + wc * 64 + n * 16 + fr; const int h = col >> 7, d = col & 127;
                    const f32x4 v = acc[m][n]; u32x2 w; w.x = pk2(v[0], v[1]); w.y = pk2(v[2], v[3]);
                    *(u32x2*)(Vt + ((size_t)(b * 8 + h) * 128 + d) * TA + ppos) = w;
                }
            }
        }
        if (!hn) break;
        brow = nbrow; bcol = nbcol; GEMM_ADVANCE(); first = false;
    }
}

DI void phase_g2(KP p, int l, unsigned char* smem) {
    const int tid = TIDX(), wid = tid >> 6, lane = tid & 63, wr = wid >> 1, wc = wid & 1, fr = lane & 15, fq = lane >> 4;
    const int li = l >> 1;
    const bf16_t* Y = (const bf16_t*)(p->ws + WS_Y);
    const bf16_t* W = (const bf16_t*)(p->ws + ((l & 1) ? WS_WCO : WS_WABO)) + (size_t)li * 1024 * 1024;
    bf16_t* P = (bf16_t*)(p->ws + WS_P);
    const int nrt = (l == 3 ? ML : MT) / 128;
    auto decode = [&](int i, int& brow, int& bcol) -> bool {
        const int q = xcd_seq(i, nrt * 8); if (q < 0) return false;
        int rt, nt; tile_seq(q, nrt, 8, rt, nt); brow = rt * 128; bcol = nt * 128; return true; };
    int brow, bcol;
    if (!decode(0, brow, bcol)) return;
    const bf16_t* ap[4]; const bf16_t* bp[4]; const bf16_t* apn[4]; const bf16_t* bpn[4];
    gemm_rows(Y, brow, 1024, tid, ap); gemm_rows(W, bcol, 1024, tid, bp);
    bool first = true;
    for (int i = 0;; ++i) {
        int nbrow = brow, nbcol = bcol; const bool hn = decode(i + 1, nbrow, nbcol);
        gemm_rows(Y, nbrow, 1024, tid, apn); gemm_rows(W, nbcol, 1024, tid, bpn);
        f32x4 acc[4][4];
        gemm_tile<true>(smem, ap, bp, 1024, acc, first, hn, apn, bpn);
#pragma unroll
        for (int m = 0; m < 4; ++m) { const int row = brow + wr * 64 + m * 16 + fr;
#pragma unroll
            for (int n = 0; n < 4; ++n) { const f32x4 v = acc[m][n]; u32x2 w; w.x = pk2(v[0], v[1]); w.y = pk2(v[2], v[3]); *(u32x2*)(P + (size_t)row * 1024 + bcol + wc * 64 + n * 16 + fq * 4) = w; } }
        if (!hn) break;
        brow = nbrow; bcol = nbcol; GEMM_ADVANCE(); first = false;
    }
}

template <bool DRY>
DI void phase_ln1r(KP p, int l, unsigned char* smem) {
    constexpr int US = 1028;
    constexpr int RB = 12;
    float* Us = (float*)smem;
    float* Ps = Us + RB * US;
    const int tid = TIDX(), wave = tid >> 6, lane = tid & 63;
    const xres_t* X = (const xres_t*)(p->ws + WS_X); xres_t* Xo = (xres_t*)(p->ws + (DRY ? WS_OB : WS_X)); const bf16_t* P = (const bf16_t*)(p->ws + WS_P); bf16_t* U = (bf16_t*)(p->ws + (DRY ? WS_Y : WS_U));
    const float* MOD = (const float*)(p->ws + WS_MOD); const float* WrT = (const float*)(p->ws + WS_WRT) + (size_t)l * 36 * 1024;
    const float* lng = p->in[6] + l * 1024; const float* lnb = p->in[7] + l * 1024;
    const float* bgrp = p->in[26] + l * 4; const float* brex = p->in[28] + l * 32;
    unsigned* cnt = (unsigned*)(p->ws + WS_CTL) + CNT_WORD0 + l * 32 * CNT_STRIDE + (DRY ? 64 : 0); int* list = (int*)(p->ws + WS_LIST); float* slotw = (float*)(p->ws + WS_SLOTW);
    const int rows_total = (l == 3) ? ML : MT;
    const int mi = lane & 15, mq = lane >> 4;
    int pend_slot = -1, pend_e = 0; unsigned pend_pos = 0u;
    f32x4 rx[3][4]; u32x2 rp[3][4];
#define LN1_FETCH(IT, RR) { const int frow_ = (IT) * RB + wave * 3 + (RR); const int frow = frow_ < rows_total ? frow_ : rows_total - 1; \
        const float* xsrc = (l == 0) ? (frow < ML ? p->in[0] + (size_t)frow * 1024 : p->in[2] + (size_t)(frow - ML) * 1024) : nullptr; \
        _Pragma("unroll") for (int j = 0; j < 4; ++j) { const int k = 256 * j + 4 * lane; \
            rx[RR][j] = (l == 0) ? *(const f32x4*)(xsrc + k) : xload(X + (size_t)frow * 1024 + k); rp[RR][j] = *(const u32x2*)(P + (size_t)frow * 1024 + k); } }
    int it = BIDX();
    if (it * RB < rows_total) { LN1_FETCH(it, 0) LN1_FETCH(it, 1) LN1_FETCH(it, 2) }
#pragma unroll 1
    for (; it * RB < rows_total; it += gridDim.x) {
        const int row0 = it * RB + wave * 3;
        const bool has_next = (it + (int)gridDim.x) * RB < rows_total;
#pragma unroll
        for (int rr = 0; rr < 3; ++rr) {
            const int rowr = row0 + rr; const bool rvalid = rowr < rows_total; const int row = rvalid ? rowr : rows_total - 1;
            const int r = row < ML ? (row >> 11) : 8;
            const float* mod = MOD + (size_t)(l * 9 + r) * 6144;
            f32x4 v[4]; float s = 0.f;
#pragma unroll
            for (int j = 0; j < 4; ++j) {
                const int k = 256 * j + 4 * lane;
                const f32x4 xv = rx[rr][j];
                const f32x4 g1 = *(const f32x4*)(mod + 2048 + k);
                const u32x2 pw_ = rp[rr][j]; const f32x4 pv = (f32x4){bflo(pw_.x), bfhi(pw_.x), bflo(pw_.y), bfhi(pw_.y)};
                v[j] = xv * ALPHA + g1 * pv; s += (v[j][0] + v[j][1]) + (v[j][2] + v[j][3]);
            }
            if (has_next) { if (rr == 0) LN1_FETCH(it + gridDim.x, 0) else if (rr == 1) LN1_FETCH(it + gridDim.x, 1) else LN1_FETCH(it + gridDim.x, 2) }
            const float mean = wave_sum(s) * (1.0f / 1024.0f); float s2 = 0.f;
#pragma unroll
            for (int j = 0; j < 4; ++j) { v[j] = v[j] - mean; s2 += (v[j][0] * v[j][0] + v[j][1] * v[j][1]) + (v[j][2] * v[j][2] + v[j][3] * v[j][3]); }
            const float rstd = 1.0f / sqrtf(wave_sum(s2) * (1.0f / 1024.0f) + LN_EPS);
#pragma unroll
            for (int j = 0; j < 4; ++j) {
                const int k = 256 * j + 4 * lane;
                const f32x4 xn = v[j] * rstd * *(const f32x4*)(lng + k) + *(const f32x4*)(lnb + k);
                const f32x4 uu = xn * (1.0f + *(const f32x4*)(mod + 4096 + k)) + *(const f32x4*)(mod + 3072 + k);
                *(f32x4*)(Us + (wave * 3 + rr) * US + k) = uu;
                if (rvalid) {
                    xstore(Xo + (size_t)row * 1024 + k, xn);
                    u32x2 w; w.x = pk2(uu[0], uu[1]); w.y = pk2(uu[2], uu[3]);
                    *(u32x2*)(U + (size_t)row * 1024 + k) = w;
                }
            }
        }
        __syncthreads();
        {
            f32x4 acc[3] = {(f32x4){0.f, 0.f, 0.f, 0.f}, (f32x4){0.f, 0.f, 0.f, 0.f}, (f32x4){0.f, 0.f, 0.f, 0.f}};
            const float* ap = Us + (mi < RB ? mi : mi - RB) * US + 256 * wave + 4 * mq;
            const float* bp0 = WrT + (size_t)mi * 1024 + 256 * wave + 4 * mq;
            const float* bp1 = WrT + (size_t)(16 + mi) * 1024 + 256 * wave + 4 * mq;
            const float* bp2 = WrT + (size_t)(32 + (mi & 3)) * 1024 + 256 * wave + 4 * mq;
#pragma unroll 1
            for (int sb0 = 0; sb0 < 16; sb0 += 8) {
                f32x4 bv[8][3];
#pragma unroll
                for (int q = 0; q < 8; ++q) { bv[q][0] = *(const f32x4*)(bp0 + 16 * (sb0 + q)); bv[q][1] = *(const f32x4*)(bp1 + 16 * (sb0 + q)); bv[q][2] = *(const f32x4*)(bp2 + 16 * (sb0 + q)); }
                __builtin_amdgcn_sched_barrier(0);
#pragma unroll
                for (int q = 0; q < 8; ++q) {
                    const f32x4 a = *(const f32x4*)(ap + 16 * (sb0 + q));
#pragma unroll
                    for (int e = 0; e < 4; ++e) {
                        acc[0] = __builtin_amdgcn_mfma_f32_16x16x4f32(a[e], bv[q][0][e], acc[0], 0, 0, 0);
                        acc[1] = __builtin_amdgcn_mfma_f32_16x16x4f32(a[e], bv[q][1][e], acc[1], 0, 0, 0);
                        acc[2] = __builtin_amdgcn_mfma_f32_16x16x4f32(a[e], bv[q][2][e], acc[2], 0, 0, 0);
                    }
                }
            }
            if (mq < 3) {
#pragma unroll
                for (int nt = 0; nt < 3; ++nt)
#pragma unroll
                    for (int rg = 0; rg < 4; ++rg) Ps[(wave * RB + mq * 4 + rg) * 48 + nt * 16 + mi] = acc[nt][rg];
            }
        }
        __syncthreads();
        if (wave < 2) {
            const int r = wave * 8 + (lane >> 3), c = lane & 7;
            const int rq = r < RB ? r : RB - 1;
            const int row = it * RB + rq;
            float lgv[5];
#pragma unroll
            for (int k = 0; k < 5; ++k) {
                const int o = c + 8 * k; const int oo = o < 36 ? o : 35;
                lgv[k] = (Ps[(0 * RB + rq) * 48 + oo] + Ps[(1 * RB + rq) * 48 + oo]) + (Ps[(2 * RB + rq) * 48 + oo] + Ps[(3 * RB + rq) * 48 + oo]);
            }
            float gv = c < 4 ? lgv[0] + bgrp[c & 3] : -3.0e38f; int gi = c;
#pragma unroll
            for (int off = 1; off < 4; off <<= 1) {
                const float ov = __shfl_xor(gv, off); const int oi = __shfl_xor(gi, off);
                if (ov > gv || (ov == gv && oi < gi)) { gv = ov; gi = oi; }
            }
            const int src0 = lane & ~7;
            const float gmax = __shfl(gv, src0); const int grp = __shfl(gi, src0);
            float ge = c < 4 ? expf(lgv[0] + bgrp[c & 3] - gmax) : 0.f;
            ge += __shfl_xor(ge, 1); ge += __shfl_xor(ge, 2);
            const float gw = 1.0f / __shfl(ge, src0);
            const int j = (c + 4) & 7; const int kk = c >= 4 ? grp : grp + 1;
            float ev = lgv[0];
#pragma unroll
            for (int k = 1; k < 5; ++k) ev = (kk == k) ? lgv[k] : ev;
            ev += brex[grp * 8 + j];
            float v1 = ev; int i1 = j;
#pragma unroll
            for (int off = 1; off < 8; off <<= 1) {
                const float ov = __shfl_xor(v1, off); const int oi = __shfl_xor(i1, off);
                if (ov > v1 || (ov == v1 && oi < i1)) { v1 = ov; i1 = oi; }
            }
            float v2 = (j == i1) ? -3.0e38f : ev; int i2 = (j == i1) ? 99 : j;
#pragma unroll
            for (int off = 1; off < 8; off <<= 1) {
                const float ov = __shfl_xor(v2, off); const int oi = __shfl_xor(i2, off);
                if (ov > v2 || (ov == v2 && oi < i2)) { v2 = ov; i2 = oi; }
            }
            const float e2 = expf(v2 - v1);
            const float w1 = 1.0f / (1.0f + e2), w2 = e2 / (1.0f + e2);
            if (c < 2 && r < RB && row < rows_total) {
                if (pend_slot >= 0) list[(size_t)pend_e * NSLOT + pend_pos] = pend_slot;
                const int e = grp * 8 + (c ? i2 : i1); const float w = gw * (c ? w2 : w1);
                const int slot = row * 2 + c;
                slotw[slot] = w;
#ifdef DRY_NOATOM
                pend_pos = DRY ? (unsigned)slot : atomicAdd(&cnt[e * CNT_STRIDE], 1u); pend_e = e; pend_slot = slot;
#else
                pend_pos = atomicAdd(&cnt[e * CNT_STRIDE], 1u); pend_e = e; pend_slot = slot;
#endif
            }
        }
        __syncthreads();
    }
    if (pend_slot >= 0) list[(size_t)pend_e * NSLOT + pend_pos] = pend_slot;
}

DI void moe_prefix(KP p, int l, int* s_cnt, int* s_tb, int* s_rb) {
    const int tid = TIDX();
    const unsigned* cnt = (const unsigned*)(p->ws + WS_CTL) + CNT_WORD0 + l * 32 * CNT_STRIDE;
    __syncthreads();
    if (tid < 32) s_cnt[tid] = (int)__hip_atomic_load(cnt + tid * CNT_STRIDE, __ATOMIC_RELAXED, __HIP_MEMORY_SCOPE_AGENT);
    __syncthreads();
    if (tid == 0) { int tb = 0; for (int e = 0; e < 32; ++e) { s_tb[e] = tb; s_rb[e] = tb * 128; tb += (s_cnt[e] + 127) >> 7; } s_tb[32] = tb; s_rb[32] = tb * 128; }
    __syncthreads();
}
DI void phase_mg1(KP p, int l, unsigned char* smem) {
    const int tid = TIDX(), wid = tid >> 6, lane = tid & 63, wr = wid >> 1, wc = wid & 1, fr = lane & 15, fq = lane >> 4;
    int* s_cnt = (int*)(smem + 65536 + 64); int* s_tb = s_cnt + 32; int* s_rb = s_tb + 33;
    moe_prefix(p, l, s_cnt, s_tb, s_rb);
    const bf16_t* U = (const bf16_t*)(p->ws + WS_U); const int* list = (const int*)(p->ws + WS_LIST);
    bf16_t* H = (bf16_t*)(p->ws + WS_H);
    const int ntiles = s_tb[32] * 8;
    struct TI { int e, rt, nt, cnt_e; };
    auto decode = [&](int i, TI& t) -> bool {
        const int tile = xcd_seq(i, ntiles); if (tile < 0) return false;
        const int rtg = tile >> 3; t.nt = tile & 7;
        int e = 0;
        for (int q = 1; q < 32; ++q) if (rtg >= s_tb[q]) e = q;
        t.e = e; t.rt = rtg - s_tb[e]; t.cnt_e = s_cnt[e]; return true; };
    auto rows = [&](const TI& t, const bf16_t* (&a)[4], const bf16_t* (&b)[4]) {
#pragma unroll
        for (int i_ = 0; i_ < 4; ++i_) {
            const int pos = t.rt * 128 + (tid >> 3) + 32 * i_;
            const int tok = pos < t.cnt_e ? (list[(size_t)t.e * NSLOT + pos] >> 1) : 0;
            a[i_] = U + (size_t)tok * 1024 + gemm_chunk(tid) * 8;
        }
        gemm_rows((const bf16_t*)(p->ws + WS_WGU) + (size_t)(l * 32 + t.e) * 1024 * 1024, t.nt * 128, 1024, tid, b); };
    TI cur, nxt;
    if (!decode(0, cur)) return;
    const bf16_t* ap[4]; const bf16_t* bp[4]; const bf16_t* apn[4]; const bf16_t* bpn[4];
    rows(cur, ap, bp);
    bool first = true;
    for (int i = 0;; ++i) {
        nxt = cur; const bool hn = decode(i + 1, nxt);
        rows(nxt, apn, bpn);
        f32x4 acc[4][4];
        gemm_tile<true>(smem, ap, bp, 1024, acc, first, hn, apn, bpn);
        const int hrow0 = s_rb[cur.e] + cur.rt * 128 + wr * 64;
#pragma unroll
        for (int m = 0; m < 4; ++m) {
            bf16_t* o = H + (size_t)(hrow0 + m * 16 + fr) * 512 + cur.nt * 64 + wc * 32 + fq * 4;
#pragma unroll
            for (int n = 0; n < 4; n += 2) {
                const f32x4 g = acc[m][n], uu = acc[m][n + 1]; f32x4 h;
#pragma unroll
                for (int j = 0; j < 4; ++j) h[j] = siluf(g[j]) * uu[j];
                u32x2 w; w.x = pk2(h[0], h[1]); w.y = pk2(h[2], h[3]);
                *(u32x2*)(o + (n >> 1) * 16) = w;
            }
        }
        if (!hn) break;
        cur = nxt; GEMM_ADVANCE(); first = false;
    }
}
DI void phase_mg2(KP p, int l, unsigned char* smem) {
    const int tid = TIDX(), wid = tid >> 6, lane = tid & 63, wr = wid >> 1, wc = wid & 1, fr = lane & 15, fq = lane >> 4;
    int* s_cnt = (int*)(smem + 65536 + 64); int* s_tb = s_cnt + 32; int* s_rb = s_tb + 33;
    moe_prefix(p, l, s_cnt, s_tb, s_rb);
    const bf16_t* H = (const bf16_t*)(p->ws + WS_H); const int* list = (const int*)(p->ws + WS_LIST); const float* slotw = (const float*)(p->ws + WS_SLOTW);
    bf16_t* YS = (bf16_t*)(p->ws + WS_YS);
    const int ntiles = s_tb[32] * 8;
    struct TI { int e, rt, nt, cnt_e; };
    auto decode = [&](int i, TI& t) -> bool {
        const int tile = xcd_seq(i, ntiles); if (tile < 0) return false;
        const int rtg = tile >> 3; t.nt = tile & 7;
        int e = 0;
        for (int q = 1; q < 32; ++q) if (rtg >= s_tb[q]) e = q;
        t.e = e; t.rt = rtg - s_tb[e]; t.cnt_e = s_cnt[e]; return true; };
    auto rows = [&](const TI& t, const bf16_t* (&a)[4], const bf16_t* (&b)[4]) {
        gemm_rows(H, s_rb[t.e] + t.rt * 128, 512, tid, a);
        gemm_rows((const bf16_t*)(p->ws + WS_WD) + (size_t)(l * 32 + t.e) * 1024 * 512, t.nt * 128, 512, tid, b); };
    TI cur, nxt;
    if (!decode(0, cur)) return;
    const bf16_t* ap[4]; const bf16_t* bp[4]; const bf16_t* apn[4]; const bf16_t* bpn[4];
    rows(cur, ap, bp);
    bool first = true;
    for (int i = 0;; ++i) {
        nxt = cur; const bool hn = decode(i + 1, nxt);
        rows(nxt, apn, bpn);
        int eslot[4]; float ew[4];
#pragma unroll
        for (int m = 0; m < 4; ++m) {
            const int pos = cur.rt * 128 + wr * 64 + m * 16 + fr;
            eslot[m] = pos < cur.cnt_e ? list[(size_t)cur.e * NSLOT + pos] : -1;
        }
#pragma unroll
        for (int m = 0; m < 4; ++m) ew[m] = eslot[m] >= 0 ? slotw[eslot[m]] : 0.f;
        f32x4 acc[4][4];
        gemm_tile<true>(smem, ap, bp, 512, acc, first, hn, apn, bpn);
#pragma unroll
        for (int m = 0; m < 4; ++m) {
            if (eslot[m] >= 0) {
                const int slot = eslot[m]; const float w = ew[m];
                bf16_t* o = YS + (size_t)slot * 1024 + cur.nt * 128 + wc * 64 + fq * 4;
#pragma unroll
                for (int n = 0; n < 4; ++n) { const f32x4 v = acc[m][n] * w; u32x2 ww; ww.x = pk2(v[0], v[1]); ww.y = pk2(v[2], v[3]); *(u32x2*)(o + n * 16) = ww; }
            }
        }
        if (!hn) break;
        cur = nxt; GEMM_ADVANCE(); first = false;
    }
}

template <bool DRY>
DI void phase_ln2(KP p, int l) {
    const int tid = TIDX(), wave = tid >> 6, lane = tid & 63;
    const xres_t* X = (const xres_t*)(p->ws + WS_X); xres_t* Xo = (xres_t*)(p->ws + (DRY ? WS_OB : WS_X)); const bf16_t* YS = (const bf16_t*)(p->ws + WS_YS); bf16_t* U = (bf16_t*)(p->ws + (DRY ? WS_Y : WS_U));
    const float* MOD = (const float*)(p->ws + WS_MOD);
    const float* lng = p->in[8] + l * 1024; const float* lnb = p->in[9] + l * 1024;
    const int rows_total = (l == 3) ? ML : MT;
    u32x2 ry0[2][4], ry1[2][4]; f32x4 rx[2][4];
    const int rstride = gridDim.x * 8;
    int row0 = (BIDX() * 4 + wave) * 2;
#define LN2_FETCH(R0) { _Pragma("unroll") for (int q = 0; q < 2; ++q) { const int row = (R0) + q; _Pragma("unroll") for (int j = 0; j < 4; ++j) { const int k = 256 * j + 4 * lane; \
        ry0[q][j] = *(const u32x2*)(YS + (size_t)(2 * row) * 1024 + k); ry1[q][j] = *(const u32x2*)(YS + (size_t)(2 * row + 1) * 1024 + k); rx[q][j] = xload(X + (size_t)row * 1024 + k); } } }
    if (row0 < rows_total) LN2_FETCH(row0)
#pragma unroll 1
    for (; row0 < rows_total; row0 += rstride) {
        f32x4 v[2][4]; float s[2] = {0.f, 0.f};
        const float* mod[2];
#pragma unroll
        for (int q = 0; q < 2; ++q) {
            const int row = row0 + q; const int r = row < ML ? (row >> 11) : 8;
            mod[q] = MOD + (size_t)(l * 9 + r) * 6144;
#pragma unroll
            for (int j = 0; j < 4; ++j) {
                const int k = 256 * j + 4 * lane;
                const u32x2 y0 = ry0[q][j], y1 = ry1[q][j];
                f32x4 y; y[0] = bflo(y0.x) + bflo(y1.x); y[1] = bfhi(y0.x) + bfhi(y1.x); y[2] = bflo(y0.y) + bflo(y1.y); y[3] = bfhi(y0.y) + bfhi(y1.y);
                const f32x4 xv = rx[q][j], g2 = *(const f32x4*)(mod[q] + 5120 + k);
                v[q][j] = xv * ALPHA + g2 * y; s[q] += (v[q][j][0] + v[q][j][1]) + (v[q][j][2] + v[q][j][3]);
            }
        }
        if (row0 + rstride < rows_total) LN2_FETCH(row0 + rstride)
        float mean[2], rstd[2];
#pragma unroll
        for (int q = 0; q < 2; ++q) mean[q] = wave_sum(s[q]) * (1.0f / 1024.0f);
#pragma unroll
        for (int q = 0; q < 2; ++q) {
            float s2 = 0.f;
#pragma unroll
            for (int j = 0; j < 4; ++j) { v[q][j] = v[q][j] - mean[q]; s2 += (v[q][j][0] * v[q][j][0] + v[q][j][1] * v[q][j][1]) + (v[q][j][2] * v[q][j][2] + v[q][j][3] * v[q][j][3]); }
            s[q] = s2;
        }
#pragma unroll
        for (int q = 0; q < 2; ++q) rstd[q] = 1.0f / sqrtf(wave_sum(s[q]) * (1.0f / 1024.0f) + LN_EPS);
#pragma unroll
        for (int q = 0; q < 2; ++q) {
            const int row = row0 + q;
            const float* modn = mod[q] + (l + 1 < 4 ? 9 * 6144 : 0);
#pragma unroll
            for (int j = 0; j < 4; ++j) {
                const int k = 256 * j + 4 * lane;
                const f32x4 xn = v[q][j] * rstd[q] * *(const f32x4*)(lng + k) + *(const f32x4*)(lnb + k);
                if (l < 3) {
                    xstore(Xo + (size_t)row * 1024 + k, xn);
                    const f32x4 uu = xn * (1.0f + *(const f32x4*)(modn + 1024 + k)) + *(const f32x4*)(modn + k);
                    u32x2 w; w.x = pk2(uu[0], uu[1]); w.y = pk2(uu[2], uu[3]);
                    *(u32x2*)(U + (size_t)row * 1024 + k) = w;
                } else {
                    *(f32x4*)(p->out + (size_t)row * 1024 + k) = xn;
                }
            }
        }
    }
}

DI s16x4 tr_read(const unsigned char* ptr) {
    typedef short v4i16_t __attribute__((ext_vector_type(4)));
    return __builtin_bit_cast(s16x4, __builtin_amdgcn_ds_read_tr16_b64_v4i16((LAS v4i16_t*)ptr));
}
DI bf16x8 cat8(s16x4 a, s16x4 b) { return __builtin_shufflevector(a, b, 0, 1, 2, 3, 4, 5, 6, 7); }

DI void phase_decay(KP p, int l, unsigned char* smem) {
    const int tid = TIDX();
    const int li = l >> 1;
    const float* LR = (const float*)(p->ws + WS_LR);
    float* PF = (float*)(p->ws + WS_PF); float* SQ = (float*)(p->ws + WS_SQ); float* SK = (float*)(p->ws + WS_SK); float* TOT = (float*)(p->ws + WS_TOT);
    float* lrs = (float*)smem;
    float wf[16], wb[16];
#pragma unroll
    for (int r = 0; r < 16; ++r) { wf[r] = p->in[11][(size_t)li * 16 * 256 + r * 256 + tid]; wb[r] = p->in[13][(size_t)li * 16 * 256 + r * 256 + tid]; }
    const float bf = p->in[12][li * 256 + tid], bb = p->in[14][li * 256 + tid];
    for (int it = BIDX(); it < 2 * (MT / 64); it += gridDim.x) {
        const int ch = it >> 1, dr = it & 1;
        const int row0 = ch * 64;
        __syncthreads();
        { const int tok = tid >> 2, q4 = tid & 3; *(f32x4*)(lrs + tok * 16 + q4 * 4) = *(const f32x4*)(LR + (size_t)(row0 + tok) * 32 + dr * 16 + q4 * 4); }
        __syncthreads();
        float run = 0.f;
        if (dr == 0) {
            for (int t = 0; t < 64; ++t) {
                float g = bf;
#pragma unroll
                for (int r = 0; r < 16; ++r) g += lrs[t * 16 + r] * wf[r];
                run += (fminf(g, 0.f) - __logf(1.0f + __expf(-fabsf(g)))) * (1.0f / 16.0f);
                PF[(size_t)(row0 + t) * 256 + tid] = run;
            }
        } else {
            for (int t = 63; t >= 0; --t) {
                float g = bb;
#pragma unroll
                for (int r = 0; r < 16; ++r) g += lrs[t * 16 + r] * wb[r];
                SQ[(size_t)(row0 + t) * 256 + tid] = run;
                run += (fminf(g, 0.f) - __logf(1.0f + __expf(-fabsf(g)))) * (1.0f / 16.0f);
                SK[(size_t)(row0 + t) * 256 + tid] = run;
            }
        }
        TOT[(size_t)(ch * 2 + dr) * 256 + tid] = run;
    }
}

template <int DK>
DI void scan_item(KP p, int l, int item, unsigned char* smem) {
    constexpr bool ISA = (DK == 128);
    constexpr int QS = DK * 2 + 16, KS = DK * 2 + 32, VS = 96, AS_ = 144, SS = DK * 2 + 16, NKS = DK / 32, NMT = DK / 64;
    constexpr int O_QD = 0, O_KD = O_QD + 64 * QS, O_V = O_KD + 64 * KS, O_ATT = O_V + 64 * VS, O_ST = O_ATT + 64 * AS_, O_END = O_ST + 32 * SS;
    static_assert(O_END <= 65536, "scan LDS");
    constexpr int NP = DK / 64 * 2;
    constexpr int CPR = DK / 8;
    const int tid = TIDX(), wid = tid >> 6, lane = tid & 63, fr = lane & 15, fq = lane >> 4;
    const int b = item >> 5, h = (item >> 3) & 3, dir = (item >> 2) & 1, dvq = item & 3;
    const bf16_t* Z = (const bf16_t*)(p->ws + WS_Z);
    const float* EQ = (const float*)(p->ws + (dir ? WS_SQ : WS_PF)); const float* EK = (const float*)(p->ws + (dir ? WS_SK : WS_PF)); const float* TOT = (const float*)(p->ws + WS_TOT);
    bf16_t* OUT = (bf16_t*)(p->ws + (dir ? WS_OB : WS_OF));
    const int qcol = ISA ? h * 128 : 2048 + h * 64, kcol = ISA ? 512 + h * 128 : 2304 + h * 64, vcol = (ISA ? 1024 : 2560) + h * 128 + dvq * 32;
    const int ocol = (ISA ? 0 : 512) + h * 128 + dvq * 32;
    float lam = 0.f;
    if (ISA) lam = log1pf(-exp2f(-((dir ? 5.5f : 5.0f) + (float)h)));
    f32x4 S[NMT][2];
#pragma unroll
    for (int a = 0; a < NMT; ++a) { S[a][0] = (f32x4){0.f, 0.f, 0.f, 0.f}; S[a][1] = (f32x4){0.f, 0.f, 0.f, 0.f}; }
    __syncthreads();
    for (int i = tid; i < 32 * SS / 4; i += 256) ((unsigned*)(smem + O_ST))[i] = 0u;
    auto chunk_row0 = [&](int cc) -> int {
        const int ci = dir ? 35 - cc : cc; const int pp = ci * 64;
        if (!dir) return pp < 256 ? ML + b * 256 + pp : b * 2048 + (pp - 256);
        return pp < 2048 ? b * 2048 + pp : ML + b * 256 + (pp - 2048);
    };
    u32x4 rq[NP], rk[NP], rv; f32x4 eq[ISA ? 1 : NP][2], ek[ISA ? 1 : NP][2]; f32x4 tv[NMT];
    auto fetch = [&](int cc) {
        const int row0 = chunk_row0(cc);
        if (!ISA) {
#pragma unroll
            for (int a = 0; a < NMT; ++a) tv[a] = *(const f32x4*)(TOT + (size_t)((row0 >> 6) * 2 + dir) * 256 + h * 64 + (wid * NMT + a) * 16 + fq * 4);
        }
#pragma unroll
        for (int i = 0; i < NP; ++i) {
            const int id = tid + 256 * i, tok = id / CPR, cg_ = id % CPR;
            const size_t ro = (size_t)(row0 + tok) * ZS;
            rq[i] = *(const u32x4*)(Z + ro + qcol + cg_ * 8); rk[i] = *(const u32x4*)(Z + ro + kcol + cg_ * 8);
            if (!ISA) {
                const size_t eo = (size_t)(row0 + tok) * 256 + h * 64 + cg_ * 8;
                eq[i][0] = *(const f32x4*)(EQ + eo); eq[i][1] = *(const f32x4*)(EQ + eo + 4);
                ek[i][0] = *(const f32x4*)(EK + eo); ek[i][1] = *(const f32x4*)(EK + eo + 4);
            }
        }
        { const int tok = tid >> 2, cg_ = tid & 3; rv = *(const u32x4*)(Z + (size_t)(row0 + tok) * ZS + vcol + cg_ * 8); }
    };
    float ra[NP], rc[NP];
#pragma unroll
    for (int i = 0; i < NP; ++i) {
        const int tok = (tid + 256 * i) / CPR;
        ra[i] = dir ? __expf(lam * (float)(63 - tok)) : __expf(lam * (float)(tok + 1));
        rc[i] = dir ? __expf(-lam * (float)(64 - tok)) : __expf(-lam * (float)(tok + 1));
    }
    const float decA = __expf(lam * 64.0f);
    fetch(0);
    for (int cc = 0; cc < 36; ++cc) {
        const int row0 = chunk_row0(cc);
#pragma unroll
        for (int i = 0; i < NP; ++i) {
            const int id = tid + 256 * i, tok = id / CPR, cg_ = id % CPR;
            float fqv[8], fkv[8];
            if (ISA) {
#pragma unroll
                for (int e = 0; e < 8; ++e) { fqv[e] = ra[i]; fkv[e] = rc[i]; }
            } else {
#pragma unroll
                for (int e = 0; e < 8; ++e) { fqv[e] = __expf(eq[i][e >> 2][e & 3]); fkv[e] = __expf(-ek[i][e >> 2][e & 3]); }
            }
            const u32x4 q = rq[i], k = rk[i]; u32x4 qo, ko;
            qo.x = pk2(bflo(q.x) * fqv[0], bfhi(q.x) * fqv[1]); qo.y = pk2(bflo(q.y) * fqv[2], bfhi(q.y) * fqv[3]); qo.z = pk2(bflo(q.z) * fqv[4], bfhi(q.z) * fqv[5]); qo.w = pk2(bflo(q.w) * fqv[6], bfhi(q.w) * fqv[7]);
            ko.x = pk2(bflo(k.x) * fkv[0], bfhi(k.x) * fkv[1]); ko.y = pk2(bflo(k.y) * fkv[2], bfhi(k.y) * fkv[3]); ko.z = pk2(bflo(k.z) * fkv[4], bfhi(k.z) * fkv[5]); ko.w = pk2(bflo(k.w) * fkv[6], bfhi(k.w) * fkv[7]);
            *(u32x4*)(smem + O_QD + tok * QS + cg_ * 16) = qo;
            *(u32x4*)(smem + O_KD + tok * KS + cg_ * 16) = ko;
        }
        { const int tok = tid >> 2, cg_ = tid & 3; *(u32x4*)(smem + O_V + tok * VS + cg_ * 16) = rv; }
        f32x4 dec[NMT];
#pragma unroll
        for (int a = 0; a < NMT; ++a) {
            if (ISA) dec[a] = (f32x4){decA, decA, decA, decA};
            else dec[a] = (f32x4){__expf(tv[a][0]), __expf(tv[a][1]), __expf(tv[a][2]), __expf(tv[a][3])};
        }
        if (cc + 1 < 36) fetch(cc + 1);
        __syncthreads();
        bf16x8 afr[2];
        {
            f32x4 at[4];
#pragma unroll
            for (int n = 0; n < 4; ++n) at[n] = (f32x4){0.f, 0.f, 0.f, 0.f};
#pragma unroll
            for (int ks = 0; ks < NKS; ++ks) {
                const bf16x8 qf = *(const bf16x8*)(smem + O_QD + (16 * wid + fr) * QS + (32 * ks + 8 * fq) * 2);
#pragma unroll
                for (int n = 0; n < 4; ++n) {
                    const bf16x8 kf = *(const bf16x8*)(smem + O_KD + (16 * n + fr) * KS + (32 * ks + 8 * fq) * 2);
                    at[n] = __builtin_amdgcn_mfma_f32_16x16x32_bf16(kf, qf, at[n], 0, 0, 0);
                }
            }
            const int i = 16 * wid + fr;
#pragma unroll
            for (int n = 0; n < 4; ++n)
#pragma unroll
                for (int jj = 0; jj < 4; ++jj) { const int j = n * 16 + fq * 4 + jj; const bool keep = dir ? (j > i) : (j <= i); at[n][jj] = keep ? at[n][jj] : 0.f; }
#pragma unroll
            for (int ks = 0; ks < 2; ++ks) {
                u32x4 w; w.x = pk2(at[2 * ks][0], at[2 * ks][1]); w.y = pk2(at[2 * ks][2], at[2 * ks][3]); w.z = pk2(at[2 * ks + 1][0], at[2 * ks + 1][1]); w.w = pk2(at[2 * ks + 1][2], at[2 * ks + 1][3]);
                afr[ks] = __builtin_bit_cast(bf16x8, w);
            }
        }
        bf16x8 vf[2][2];
        {
            const int g = lane >> 4, i16 = lane & 15, q = i16 >> 2, pq = i16 & 3;
#pragma unroll
            for (int ks = 0; ks < 2; ++ks)
#pragma unroll
                for (int n = 0; n < 2; ++n) {
                    const unsigned char* a = smem + O_V + (32 * ks + 4 * g + q) * VS + (n * 16 + 4 * pq) * 2;
                    vf[ks][n] = cat8(tr_read(a), tr_read(a + 16 * VS));
                }
        }
        {
            f32x4 oa[2] = {(f32x4){0.f, 0.f, 0.f, 0.f}, (f32x4){0.f, 0.f, 0.f, 0.f}};
#pragma unroll
            for (int ks = 0; ks < 2; ++ks)
#pragma unroll
                for (int n = 0; n < 2; ++n) oa[n] = __builtin_amdgcn_mfma_f32_16x16x32_bf16(vf[ks][n], afr[ks], oa[n], 0, 0, 0);
#pragma unroll
            for (int ks = 0; ks < NKS; ++ks) {
                const bf16x8 qf = *(const bf16x8*)(smem + O_QD + (16 * wid + fr) * QS + (32 * ks + 8 * fq) * 2);
#pragma unroll
                for (int n = 0; n < 2; ++n) {
                    const bf16x8 sf = *(const bf16x8*)(smem + O_ST + (16 * n + fr) * SS + (32 * ks + 8 * fq) * 2);
                    oa[n] = __builtin_amdgcn_mfma_f32_16x16x32_bf16(sf, qf, oa[n], 0, 0, 0);
                }
            }
            bf16_t* o = OUT + (size_t)(row0 + 16 * wid + fr) * 1024 + ocol + fq * 4;
            u32x2 w0, w1; w0.x = pk2(oa[0][0], oa[0][1]); w0.y = pk2(oa[0][2], oa[0][3]); w1.x = pk2(oa[1][0], oa[1][1]); w1.y = pk2(oa[1][2], oa[1][3]);
            *(u32x2*)(o) = w0; *(u32x2*)(o + 16) = w1;
        }
        {
            const int g = lane >> 4, i16 = lane & 15, q = i16 >> 2, pq = i16 & 3;
#pragma unroll
            for (int a = 0; a < NMT; ++a) {
                const int mt = wid * NMT + a;
#pragma unroll
                for (int ks = 0; ks < 2; ++ks) {
                    const unsigned char* ka = smem + O_KD + (32 * ks + 4 * g + q) * KS + (mt * 16 + 4 * pq) * 2;
                    const bf16x8 kf = cat8(tr_read(ka), tr_read(ka + 16 * KS));
#pragma unroll
                    for (int n = 0; n < 2; ++n) S[a][n] = __builtin_amdgcn_mfma_f32_16x16x32_bf16(kf, vf[ks][n], S[a][n], 0, 0, 0);
                }
                S[a][0] *= dec[a]; S[a][1] *= dec[a];
            }
        }
        __syncthreads();
#pragma unroll
        for (int a = 0; a < NMT; ++a) {
            const int mt = wid * NMT + a;
#pragma unroll
            for (int n = 0; n < 2; ++n) { u32x2 w; w.x = pk2(S[a][n][0], S[a][n][1]); w.y = pk2(S[a][n][2], S[a][n][3]); *(u32x2*)(smem + O_ST + (n * 16 + fr) * SS + (mt * 16 + fq * 4) * 2) = w; }
        }
    }
    __syncthreads();
}
DI void phase_scan(KP p, int l, unsigned char* smem) {
    for (int it = BIDX(); it < 512; it += gridDim.x) {
        if (it < 256) scan_item<128>(p, l, it, smem); else scan_item<64>(p, l, it - 256, smem);
    }
}

DI void phase_merge(KP p, int l) {
    const int tid = TIDX(), wave = tid >> 6, lane = tid & 63;
    const int li = l >> 1;
    const bf16_t* OF = (const bf16_t*)(p->ws + WS_OF); const bf16_t* OB = (const bf16_t*)(p->ws + WS_OB);
    const bf16_t* Z = (const bf16_t*)(p->ws + WS_Z); bf16_t* Y = (bf16_t*)(p->ws + WS_Y);
    const bool isA = lane < 32;
    const float* gn = isA ? p->in[15] + li * 512 + lane * 16 : p->in[16] + li * 512 + (lane - 32) * 16;
    const int gcol = isA ? 1536 + lane * 16 : 3072 + (lane - 32) * 16;
    for (int row = BIDX() * 4 + wave; row < MT; row += gridDim.x * 4) {
        float o[16]; float s = 0.f;
#pragma unroll
        for (int j = 0; j < 2; ++j) {
            const u32x4 a = *(const u32x4*)(OF + (size_t)row * 1024 + lane * 16 + j * 8), bb = *(const u32x4*)(OB + (size_t)row * 1024 + lane * 16 + j * 8);
            o[j * 8 + 0] = bflo(a.x) + bflo(bb.x); o[j * 8 + 1] = bfhi(a.x) + bfhi(bb.x); o[j * 8 + 2] = bflo(a.y) + bflo(bb.y); o[j * 8 + 3] = bfhi(a.y) + bfhi(bb.y);
            o[j * 8 + 4] = bflo(a.z) + bflo(bb.z); o[j * 8 + 5] = bfhi(a.z) + bfhi(bb.z); o[j * 8 + 6] = bflo(a.w) + bflo(bb.w); o[j * 8 + 7] = bfhi(a.w) + bfhi(bb.w);
        }
#pragma unroll
        for (int e = 0; e < 16; ++e) s += o[e];
        s += __shfl_xor(s, 1); s += __shfl_xor(s, 2); s += __shfl_xor(s, 4);
        const float mean = isA ? s * (1.0f / 128.0f) : 0.f;
        float s2 = 0.f;
#pragma unroll
        for (int e = 0; e < 16; ++e) { o[e] -= mean; s2 += o[e] * o[e]; }
        s2 += __shfl_xor(s2, 1); s2 += __shfl_xor(s2, 2); s2 += __shfl_xor(s2, 4);
        const float rs = 1.0f / sqrtf(s2 * (1.0f / 128.0f) + LN_EPS);
        const u32x4 g0 = *(const u32x4*)(Z + (size_t)row * ZS + gcol), g1 = *(const u32x4*)(Z + (size_t)row * ZS + gcol + 8);
        float gt[16];
        gt[0] = bflo(g0.x); gt[1] = bfhi(g0.x); gt[2] = bflo(g0.y); gt[3] = bfhi(g0.y); gt[4] = bflo(g0.z); gt[5] = bfhi(g0.z); gt[6] = bflo(g0.w); gt[7] = bfhi(g0.w);
        gt[8] = bflo(g1.x); gt[9] = bfhi(g1.x); gt[10] = bflo(g1.y); gt[11] = bfhi(g1.y); gt[12] = bflo(g1.z); gt[13] = bfhi(g1.z); gt[14] = bflo(g1.w); gt[15] = bfhi(g1.w);
        float y[16];
#pragma unroll
        for (int e = 0; e < 16; ++e) y[e] = siluf(gt[e]) * (o[e] * rs * gn[e]);
        u32x4 w0, w1;
        w0.x = pk2(y[0], y[1]); w0.y = pk2(y[2], y[3]); w0.z = pk2(y[4], y[5]); w0.w = pk2(y[6], y[7]);
        w1.x = pk2(y[8], y[9]); w1.y = pk2(y[10], y[11]); w1.z = pk2(y[12], y[13]); w1.w = pk2(y[14], y[15]);
        *(u32x4*)(Y + (size_t)row * 1024 + lane * 16) = w0; *(u32x4*)(Y + (size_t)row * 1024 + lane * 16 + 8) = w1;
    }
}

DI int crow(int r, int hi) { return (r & 3) + 8 * (r >> 2) + 4 * hi; }
constexpr int ATT_BUF = 24576;
DI void att_component(const bf16_t* Qc, const bf16_t* Kc, const bf16_t* Vt, unsigned char* smem, float* wsf, int b, int h, int comp, int p0, int nkv, f32x16 (&O)[4]) {
    const int tid = TIDX(), wid = tid >> 6, lane = tid & 63, r32 = lane & 31, hi = lane >> 5;
    const int hc = h * 2 + comp;
    const bf16_t* Qb = Qc + ((size_t)(b * 16 + hc) * TA + p0 + wid * 32 + r32) * 64;
    const int gch = gemm_chunk(tid);
    const bf16_t* Kg = Kc + (size_t)(b * 16 + hc) * TA * 64 + (size_t)(tid >> 3) * 64 + gch * 8;
    const bf16_t* Vg = Vt + (size_t)(b * 8 + h) * 128 * TA + (size_t)(tid >> 3) * TA + gch * 8;
#define ATT_STAGE(buf, kt) do { \
        _Pragma("unroll") for (int i_ = 0; i_ < 2; ++i_) __builtin_amdgcn_global_load_lds((const unsigned*)(Kg + (size_t)((kt) + 32 * i_) * 64), (LAS unsigned*)(smem + (buf) * ATT_BUF + i_ * 4096 + tid * 16), 16, 0, 0); \
        _Pragma("unroll") for (int i_ = 0; i_ < 4; ++i_) __builtin_amdgcn_global_load_lds((const unsigned*)(Vg + (size_t)(32 * i_) * TA + (kt)), (LAS unsigned*)(smem + (buf) * ATT_BUF + 8192 + i_ * 4096 + tid * 16), 16, 0, 0); } while (0)
    ATT_STAGE(0, 0);
    bf16x8 qf[4];
#pragma unroll
    for (int ks = 0; ks < 4; ++ks) qf[ks] = *(const bf16x8*)(Qb + ks * 16 + hi * 8);
#pragma unroll
    for (int d0 = 0; d0 < 4; ++d0)
#pragma unroll
        for (int r = 0; r < 16; ++r) O[d0][r] = 0.f;
    float m_run = -1.0e30f, l_run = 0.f;
    const int sw = (r32 >> 1) & 7;
    const int nt = nkv >> 6;
    for (int t = 0; t < nt; ++t) {
        asm volatile("s_waitcnt vmcnt(0)" ::: "memory");
        __syncthreads();
        if (t + 1 < nt) ATT_STAGE((t + 1) & 1, (t + 1) * 64);
        const unsigned char* Kt = smem + (t & 1) * ATT_BUF; const unsigned char* Vtl = Kt + 8192;
        bf16x8 kf0[4], kf1[4];
#pragma unroll
        for (int ks = 0; ks < 4; ++ks) {
            const unsigned co = (unsigned)(((ks * 2 + hi) ^ sw) << 4);
            kf0[ks] = *(const bf16x8*)(Kt + r32 * 128 + co);
            kf1[ks] = *(const bf16x8*)(Kt + (32 + r32) * 128 + co);
        }
        const unsigned char* vr = Vtl + r32 * 128;
#define ATT_VLOAD(dst, st_) do { const unsigned o1_ = (unsigned)((((st_) * 2 + hi) ^ sw) << 4); \
        _Pragma("unroll") for (int d0_ = 0; d0_ < 4; ++d0_) dst[d0_] = *(const bf16x8*)(vr + d0_ * 4096 + o1_); } while (0)
        bf16x8 va[4], vb[4];
        ATT_VLOAD(va, 0);
        f32x16 s0, s1;
#pragma unroll
        for (int r = 0; r < 16; ++r) { s0[r] = 0.f; s1[r] = 0.f; }
#pragma unroll
        for (int ks = 0; ks < 4; ++ks) {
            s0 = __builtin_amdgcn_mfma_f32_32x32x16_bf16(kf0[ks], qf[ks], s0, 0, 0, 0);
            s1 = __builtin_amdgcn_mfma_f32_32x32x16_bf16(kf1[ks], qf[ks], s1, 0, 0, 0);
        }
        float mxa[8];
#pragma unroll
        for (int i_ = 0; i_ < 8; ++i_) mxa[i_] = fmaxf(fmaxf(s0[2 * i_], s0[2 * i_ + 1]), fmaxf(s1[2 * i_], s1[2 * i_ + 1]));
        float mx = fmaxf(fmaxf(fmaxf(mxa[0], mxa[1]), fmaxf(mxa[2], mxa[3])), fmaxf(fmaxf(mxa[4], mxa[5]), fmaxf(mxa[6], mxa[7])));
        { const auto rr = __builtin_amdgcn_permlane32_swap(__float_as_uint(mx), __float_as_uint(mx), false, false); mx = fmaxf(__uint_as_float(rr[0]), __uint_as_float(rr[1])); }
        if (__any(mx > m_run + 8.0f)) {
            const float m_new = fmaxf(m_run, mx);
            const float alpha = __builtin_amdgcn_exp2f((m_run - m_new) * L2E);
            l_run *= alpha; m_run = m_new;
            if (hi == 0) wsf[r32] = alpha;
            asm volatile("s_waitcnt lgkmcnt(0)" ::: "memory");
            float ar[16];
#pragma unroll
            for (int r = 0; r < 16; ++r) ar[r] = wsf[crow(r, hi)];
#pragma unroll
            for (int d0 = 0; d0 < 4; ++d0)
#pragma unroll
                for (int r = 0; r < 16; ++r) O[d0][r] *= ar[r];
            asm volatile("s_waitcnt lgkmcnt(0)" ::: "memory");
        }
        const float mb = m_run * L2E;
        float ps = 0.f;
#pragma unroll
        for (int r = 0; r < 16; ++r) { s0[r] = __builtin_amdgcn_exp2f(s0[r] * L2E - mb); s1[r] = __builtin_amdgcn_exp2f(s1[r] * L2E - mb); ps += s0[r] + s1[r]; }
        l_run += ps;
        u32x4 pw[4];
#pragma unroll
        for (int s = 0; s < 2; ++s) {
            pw[s].x = pk2(s0[8 * s + 0], s0[8 * s + 1]); pw[s].y = pk2(s0[8 * s + 2], s0[8 * s + 3]); pw[s].z = pk2(s0[8 * s + 4], s0[8 * s + 5]); pw[s].w = pk2(s0[8 * s + 6], s0[8 * s + 7]);
            pw[2 + s].x = pk2(s1[8 * s + 0], s1[8 * s + 1]); pw[2 + s].y = pk2(s1[8 * s + 2], s1[8 * s + 3]); pw[2 + s].z = pk2(s1[8 * s + 4], s1[8 * s + 5]); pw[2 + s].w = pk2(s1[8 * s + 6], s1[8 * s + 7]);
        }
#pragma unroll
        ATT_VLOAD(vb, 1);
#pragma unroll
        for (int d0 = 0; d0 < 4; ++d0) O[d0] = __builtin_amdgcn_mfma_f32_32x32x16_bf16(__builtin_bit_cast(bf16x8, pw[0]), va[d0], O[d0], 0, 0, 0);
        ATT_VLOAD(va, 2);
#pragma unroll
        for (int d0 = 0; d0 < 4; ++d0) O[d0] = __builtin_amdgcn_mfma_f32_32x32x16_bf16(__builtin_bit_cast(bf16x8, pw[1]), vb[d0], O[d0], 0, 0, 0);
        ATT_VLOAD(vb, 3);
#pragma unroll
        for (int d0 = 0; d0 < 4; ++d0) O[d0] = __builtin_amdgcn_mfma_f32_32x32x16_bf16(__builtin_bit_cast(bf16x8, pw[2]), va[d0], O[d0], 0, 0, 0);
#pragma unroll
        for (int d0 = 0; d0 < 4; ++d0) O[d0] = __builtin_amdgcn_mfma_f32_32x32x16_bf16(__builtin_bit_cast(bf16x8, pw[3]), vb[d0], O[d0], 0, 0, 0);
#undef ATT_VLOAD
    }
#undef ATT_STAGE
    l_run += __shfl_xor(l_run, 32);
    asm volatile("s_waitcnt lgkmcnt(0)" ::: "memory");
    if (hi == 0) wsf[r32] = 1.0f / l_run;
    asm volatile("s_waitcnt lgkmcnt(0)" ::: "memory");
    float ar[16];
#pragma unroll
    for (int r = 0; r < 16; ++r) ar[r] = wsf[crow(r, hi)];
    asm volatile("s_waitcnt lgkmcnt(0)" ::: "memory");
#pragma unroll
    for (int d0 = 0; d0 < 4; ++d0)
#pragma unroll
        for (int r = 0; r < 16; ++r) O[d0][r] *= ar[r];
}

DI void phase_att(KP p, int l, unsigned char* smem) {
    constexpr int O_WS = 2 * ATT_BUF;
    const int tid = TIDX(), wid = tid >> 6, lane = tid & 63, r32 = lane & 31, hi = lane >> 5;
    const int li = l >> 1;
    const bf16_t* Qc = (const bf16_t*)(p->ws + WS_QC); const bf16_t* Kc = (const bf16_t*)(p->ws + WS_KC); const bf16_t* Vt = (const bf16_t*)(p->ws + WS_VT);
    bf16_t* Y = (bf16_t*)(p->ws + WS_Y);
    float* stash = (float*)(p->ws + WS_P) + ((size_t)BIDX() * 256 + tid) * 32;
    const float lam_init = 0.8f - 0.6f * expf(-0.3f * (float)l);
    float* wsf = (float*)(smem + O_WS) + wid * 32;
    const int per_x = (l == 3) ? 128 : 144;
    for (int i = 0;; ++i) {
        int b, h, p0, nkv;
        {
            const int G = gridDim.x, bid = BIDX();
            int item;
            if ((G & 7) == 0) { const int x = bid & 7, q = i * (G >> 3) + (bid >> 3); if (q >= per_x) break; item = q < 128 ? x * 128 + q : 1024 + x * 16 + (q - 128); }
            else { item = i * G + bid; if (item >= 8 * per_x) break; }
            if (item < 1024) { b = item >> 7; h = (item >> 4) & 7; p0 = 256 + (item & 15) * 128; nkv = TA; }
            else { const int q = item - 1024; b = q >> 4; h = (q >> 1) & 7; p0 = (q & 1) * 128; nkv = TC; }
        }
        float d1 = 0.f, d2 = 0.f;
        { const float* lq1 = p->in[19] + (li * 8 + h) * 64, *lk1 = p->in[20] + (li * 8 + h) * 64, *lq2 = p->in[21] + (li * 8 + h) * 64, *lk2 = p->in[22] + (li * 8 + h) * 64;
          d1 = wave_sum(lq1[lane] * lk1[lane]); d2 = wave_sum(lq2[lane] * lk2[lane]); }
        const float lamv = expf(d1) - expf(d2) + lam_init;
        f32x16 On[4];
        __syncthreads();
        att_component(Qc, Kc, Vt, smem, wsf, b, h, 0, p0, nkv, On);
#pragma unroll
        for (int d0 = 0; d0 < 4; ++d0)
#pragma unroll
            for (int r = 0; r < 16; r += 8) {
                u32x4 w; w.x = pk2(On[d0][r], On[d0][r + 1]); w.y = pk2(On[d0][r + 2], On[d0][r + 3]); w.z = pk2(On[d0][r + 4], On[d0][r + 5]); w.w = pk2(On[d0][r + 6], On[d0][r + 7]);
                *(u32x4*)(stash + (d0 * 16 + r) / 2) = w;
            }
        __syncthreads();
        att_component(Qc, Kc, Vt, smem, wsf, b, h, 1, p0, nkv, On);
#pragma unroll
        for (int d0 = 0; d0 < 4; ++d0)
#pragma unroll
            for (int r = 0; r < 16; r += 8) {
                const u32x4 w = *(const u32x4*)(stash + (d0 * 16 + r) / 2);
                On[d0][r] = bflo(w.x) - lamv * On[d0][r]; On[d0][r + 1] = bfhi(w.x) - lamv * On[d0][r + 1]; On[d0][r + 2] = bflo(w.y) - lamv * On[d0][r + 2]; On[d0][r + 3] = bfhi(w.y) - lamv * On[d0][r + 3];
                On[d0][r + 4] = bflo(w.z) - lamv * On[d0][r + 4]; On[d0][r + 5] = bfhi(w.z) - lamv * On[d0][r + 5]; On[d0][r + 6] = bflo(w.w) - lamv * On[d0][r + 6]; On[d0][r + 7] = bfhi(w.w) - lamv * On[d0][r + 7];
            }
        float ms[16];
#pragma unroll
        for (int r = 0; r < 16; ++r) {
            float s = (On[0][r] * On[0][r] + On[1][r] * On[1][r]) + (On[2][r] * On[2][r] + On[3][r] * On[3][r]);
            s += __shfl_xor(s, 1); s += __shfl_xor(s, 2); s += __shfl_xor(s, 4); s += __shfl_xor(s, 8); s += __shfl_xor(s, 16);
            ms[r] = __builtin_amdgcn_rsqf(s * (1.0f / 128.0f) + LN_EPS);
        }
        const float* sg = p->in[23] + li * 1024 + h * 128;
        const float post = 1.0f - lam_init;
        float gsc[4];
#pragma unroll
        for (int d0 = 0; d0 < 4; ++d0) gsc[d0] = sg[d0 * 32 + r32] * post;
        __syncthreads();
        unsigned char* stg = smem + wid * 8192;
#pragma unroll
        for (int r = 0; r < 16; ++r) {
            unsigned char* sp = stg + crow(r, hi) * 256 + r32 * 2;
#pragma unroll
            for (int d0 = 0; d0 < 4; ++d0) *(unsigned short*)(sp + d0 * 64) = (unsigned short)f2bf(On[d0][r] * ms[r] * gsc[d0]);
        }
        asm volatile("s_waitcnt lgkmcnt(0)" ::: "memory");
#pragma unroll
        for (int i2 = 0; i2 < 8; ++i2) {
            const int id = lane + 64 * i2, qr = id >> 4, ch = id & 15;
            const int pq = p0 + wid * 32 + qr;
            const int row = pq < 256 ? ML + b * 256 + pq : b * 2048 + (pq - 256);
            *(u32x4*)(Y + (size_t)row * 1024 + h * 128 + ch * 8) = *(const u32x4*)(stg + qr * 256 + ch * 16);
        }
        asm volatile("s_waitcnt lgkmcnt(0)" ::: "memory");
    }
}

#define XB_TMO      128
#define XB_XCNT(j)  (256  + 64 * (j))
#define XB_XSUB(j)  (1280 + 64 * (j))
#define XB_XGEN(j)  (2304 + 64 * (j))
#define XB_TOP      3328
#define XB_TOPGEN   3392
#define XCD_BAR_WORDS 3456
#define XB_SPIN_CAP (1u << 22)
DI unsigned xb_ld(unsigned* p)              { return __hip_atomic_load(p, __ATOMIC_RELAXED, __HIP_MEMORY_SCOPE_AGENT); }
DI unsigned xb_add(unsigned* p, unsigned v) { return __hip_atomic_fetch_add(p, v, __ATOMIC_RELAXED, __HIP_MEMORY_SCOPE_AGENT); }
DI unsigned xb_xcc_id() { return (unsigned)__builtin_amdgcn_s_getreg((3 << 11) | 20) & 0xFu; }
#define XB_SPIN(cond, bar) do { unsigned _sp = 0; while (cond) { __builtin_amdgcn_s_sleep(1); \
    if ((++_sp & 255u) == 0u) { if (xb_ld(&(bar)[XB_TMO])) break; if (_sp > XB_SPIN_CAP) { atomicAdd(&(bar)[XB_TMO], 1u); break; } } } } while (0)
struct XcdBarrier { unsigned* bar; unsigned x; volatile LAS unsigned* st; };
DI XcdBarrier xcd_barrier_post(unsigned* bar, volatile LAS unsigned* st) {
    XcdBarrier b; b.bar = bar; b.x = xb_xcc_id(); b.st = st;
    if (threadIdx.x == 0) (void)xb_add(&bar[XB_XCNT(b.x)], 1u);
    return b;
}
DI void xcd_barrier_complete(unsigned* bar, unsigned x, unsigned& nloc, unsigned& nx) {
    const unsigned G = gridDim.x * gridDim.y * gridDim.z;
    unsigned sum, cnt, mine, sp = 0u;
    for (;;) {
        sum = 0u; cnt = 0u; mine = 0u;
#pragma unroll
        for (unsigned j = 0; j < 16; ++j) { const unsigned c = xb_ld(&bar[XB_XCNT(j)]); sum += c; cnt += (c > 0u) ? 1u : 0u; mine = (j == x) ? c : mine; }
        if (sum == G) break;
        __builtin_amdgcn_s_sleep(1);
        if ((++sp & 255u) == 0u) { if (xb_ld(&bar[XB_TMO])) break; if (sp > XB_SPIN_CAP) { atomicAdd(&bar[XB_TMO], 1u); break; } }
    }
    nloc = mine > 0u ? mine : 1u; nx = cnt > 0u ? cnt : 1u;
}
DI void xcd_barrier(const XcdBarrier& b) {
    asm volatile("s_waitcnt vmcnt(0)" ::: "memory");
    __syncthreads();
    if (threadIdx.x == 0) {
        unsigned* bar = b.bar;
        __builtin_amdgcn_s_waitcnt(0);
        unsigned nloc = b.st[0], nx = b.st[1];
        if (nloc == 0u) { xcd_barrier_complete(bar, b.x, nloc, nx); b.st[0] = nloc; b.st[1] = nx; }
        const unsigned old = xb_add(&bar[XB_XSUB(b.x)], 1u);
        const unsigned gen = old / nloc;
        if (old + 1u == (gen + 1u) * nloc) {
            __builtin_amdgcn_fence(__ATOMIC_RELEASE, "agent");
            asm volatile("s_waitcnt vmcnt(0)" ::: "memory");
            const unsigned og = xb_add(&bar[XB_TOP], 1u);
            const unsigned tg = og / nx;
            if (og + 1u == (tg + 1u) * nx) xb_add(&bar[XB_TOPGEN], 1u);
            else XB_SPIN(xb_ld(&bar[XB_TOPGEN]) == tg, bar);
            __builtin_amdgcn_fence(__ATOMIC_ACQUIRE, "agent");
            xb_add(&bar[XB_XGEN(b.x)], 1u);
            asm volatile("s_waitcnt vmcnt(0)" ::: "memory");
        } else {
            XB_SPIN(xb_ld(&bar[XB_XGEN(b.x)]) == gen, bar);
            __builtin_amdgcn_fence(__ATOMIC_ACQUIRE, "agent");
            asm volatile("s_waitcnt vmcnt(0)" ::: "memory");
        }
    }
    __syncthreads();
}

#ifdef DOUBLE_MASK
#define DRYCOND (rep_ == 0 && nrep_ == 2)
#else
#define DRYCOND false
#endif
constexpr int NPHASE = 34;
constexpr int LDS_BYTES = 65536 + 1024;
__global__ void __launch_bounds__(256, 2) mega(Params pv) {
    extern __shared__ __attribute__((aligned(16))) unsigned char smem[];
    const int ph_lo = pv.ph_lo, ph_hi = pv.ph_hi;
    volatile LAS unsigned* bar_st = (volatile LAS unsigned*)(LAS unsigned char*)(smem + 65536);
    if (threadIdx.x == 0) { bar_st[0] = 0u; bar_st[1] = 0u; }
    __syncthreads();
    XcdBarrier xbar = xcd_barrier_post((unsigned*)(pv.ws + WS_CTL) + 4096, bar_st);
    for (int ph = ph_lo; ph < ph_hi; ++ph) {
        KP p = (KP)__builtin_amdgcn_kernarg_segment_ptr();
        asm volatile("" : "+s"(p) :: "memory");
#ifdef DOUBLE_MASK
        int kind_;
        if (ph == 0) kind_ = 0; else if (ph == 1) kind_ = 1;
        else { const int rem_ = (ph - 2) % 16; kind_ = rem_ == 0 ? 2 : (rem_ == 1 ? 12 : (rem_ < 9 ? rem_ + 1 : (rem_ == 9 ? 10 : (rem_ == 10 ? 11 : (rem_ - 11 + 5))))); }
        const int nrep_ = ((DOUBLE_MASK >> kind_) & 1) ? 2 : 1;
        for (int rep_ = 0; rep_ < nrep_; ++rep_) {
        if (rep_) xcd_barrier(xbar);
#endif
        if (ph == 0) phase_pre0(p, smem);
        else if (ph == 1) phase_pre1(p);
        else {
            const int q = ph - 2, lp = q / 16, rem = q % 16;
            if (rem < 9) {
                const int l = 2 * lp;
                switch (rem) {
                    case 0: phase_g1e(p, l, smem); break;
                    case 1: phase_decay(p, l, smem); break;
                    case 2: phase_scan(p, l, smem); break;
                    case 3: phase_merge(p, l); break;
                    case 4: phase_g2(p, l, smem); break;
                    case 5: if (DRYCOND) phase_ln1r<true>(p, l, smem); else phase_ln1r<false>(p, l, smem); break;
                    case 6: phase_mg1(p, l, smem); break;
                    case 7: phase_mg2(p, l, smem); break;
                    default: if (DRYCOND) phase_ln2<true>(p, l); else phase_ln2<false>(p, l); break;
                }
            } else {
                const int l = 2 * lp + 1;
                switch (rem - 9) {
                    case 0: phase_g1o(p, l, smem); break;
                    case 1: phase_att(p, l, smem); break;
                    case 2: phase_g2(p, l, smem); break;
                    case 3: if (DRYCOND) phase_ln1r<true>(p, l, smem); else phase_ln1r<false>(p, l, smem); break;
                    case 4: phase_mg1(p, l, smem); break;
                    case 5: phase_mg2(p, l, smem); break;
                    default: if (DRYCOND) phase_ln2<true>(p, l); else phase_ln2<false>(p, l); break;
                }
            }
        }
#ifdef DOUBLE_MASK
        }
#endif
        if (ph + 1 < ph_hi) xcd_barrier(xbar);
    }
}

extern "C" void kernel_launch(void* const* d_in, const int* in_sizes, int n_in, void* d_out, int out_size, void* d_ws, size_t ws_size, hipStream_t stream) {
    static int grid_blocks = 0;
    if (grid_blocks == 0) {
        if (n_in != 32 || ws_size < WS_END) { fprintf(stderr, "kernel_launch: unexpected n_in %d or ws_size %zu\n", n_in, ws_size); grid_blocks = -1; return; }
        int dev = 0, cus = 0, per_cu = 0;
        hipGetDevice(&dev);
        hipDeviceGetAttribute(&cus, hipDeviceAttributeMultiprocessorCount, dev);
        hipFuncSetAttribute((const void*)mega, hipFuncAttributeMaxDynamicSharedMemorySize, LDS_BYTES);
        hipOccupancyMaxActiveBlocksPerMultiprocessor(&per_cu, mega, 256, LDS_BYTES);
        if (per_cu > 2) per_cu = 2;
        if (per_cu < 1) per_cu = 1;
        grid_blocks = cus * per_cu;
    }
    if (grid_blocks < 0) return;
    hipMemsetAsync((char*)d_ws + WS_CTL, 0, 32768, stream);
    Params p{};
    for (int i = 0; i < 32; ++i) p.in[i] = (const float*)d_in[i];
    p.out = (float*)d_out; p.ws = (unsigned char*)d_ws;
#if N_LAUNCH_MODE == 1
    p.ph_lo = 0; p.ph_hi = NPHASE;
    void* args[] = {&p};
    hipError_t e = hipLaunchCooperativeKernel((void*)mega, dim3(grid_blocks), dim3(256), args, LDS_BYTES, stream);
    if (e != hipSuccess) fprintf(stderr, "cooperative launch failed: %s (grid %d)\n", hipGetErrorString(e), grid_blocks);
#else
    for (int ph = 0; ph < NPHASE; ++ph) {
        p.ph_lo = ph; p.ph_hi = ph + 1;
        hipLaunchKernelGGL(mega, dim3(grid_blocks), dim3(256), LDS_BYTES, stream, p);
    }
#endif
}
```

```cpp
#include <hip/hip_runtime.h>
#include <hip/hip_cooperative_groups.h>
#include <cstdio>
#include <cstdint>
namespace cg = cooperative_groups;

#ifndef N_LAUNCH_MODE
#define N_LAUNCH_MODE 1
#endif

#define DI __device__ __forceinline__
#define LAS __attribute__((address_space(3)))
typedef unsigned short bf16_t;
typedef short bf16x8 __attribute__((ext_vector_type(8)));
typedef short s16x4 __attribute__((ext_vector_type(4)));
typedef float f32x4 __attribute__((ext_vector_type(4)));
typedef float f32x16 __attribute__((ext_vector_type(16)));
typedef unsigned u32x4 __attribute__((ext_vector_type(4)));
typedef unsigned u32x2 __attribute__((ext_vector_type(2)));

constexpr int D = 1024, NB = 8, T = 2048, TC = 256, TA = T + TC;
constexpr int ML = NB * T, MC = NB * TC, MT = ML + MC;
constexpr int NIN = 3616, NINP = 3712, ZS = 3712;
constexpr int NSLOT = 2 * MT;
constexpr float LN_EPS = 1e-5f;
constexpr float ALPHA = 1.6817928305074290f;
constexpr float L2E = 1.4426950408889634f;

constexpr size_t MiB = 1ull << 20;
constexpr size_t WS_CTL = 0;
constexpr int CNT_WORD0 = 32768;
constexpr int CNT_STRIDE = 1088;
constexpr size_t WS_MOD = 1 * MiB;
constexpr size_t WS_ROPEA = 2 * MiB;
constexpr size_t WS_ROPEC = 3 * MiB;
constexpr size_t WS_LR = 4 * MiB;
constexpr size_t WS_SLOTW = 7 * MiB;
constexpr size_t WS_LIST = 8 * MiB;
constexpr size_t WS_WRT = 13 * MiB;
constexpr size_t WS_WIN = 16 * MiB;
constexpr size_t WS_WABO = 32 * MiB;
constexpr size_t WS_WQKV = 36 * MiB;
constexpr size_t WS_WCO = 48 * MiB;
constexpr size_t WS_WGU = 64 * MiB;
constexpr size_t WS_WD = 320 * MiB;
constexpr size_t WS_X = 448 * MiB;
constexpr size_t WS_U = 520 * MiB;
constexpr size_t WS_Y = 556 * MiB;
constexpr size_t WS_Z = 592 * MiB;
constexpr size_t WS_O = 724 * MiB;
constexpr size_t WS_QDF = 868 * MiB, WS_QDB = 886 * MiB, WS_TOT = 922 * MiB;
constexpr size_t WS_END = 923 * MiB;
constexpr size_t WS_QC = WS_Z, WS_KC = WS_Z + 36 * MiB, WS_VT = WS_Z + 72 * MiB;
constexpr size_t WS_YS = WS_Z;
constexpr size_t WS_OF = WS_O, WS_OB = WS_O + 72 * MiB, WS_P = WS_O, WS_H = WS_O + 72 * MiB;

#ifndef XBF16
#define XBF16 0
#endif
#if XBF16
typedef bf16_t xres_t;
#else
typedef float xres_t;
#endif
struct Params { const float* in[32]; float* out; unsigned char* ws; int ph_lo, ph_hi; };
typedef const __attribute__((address_space(4))) Params* KP;

DI int TIDX() { int t = threadIdx.x; asm volatile("" : "+v"(t)); return t; }
DI int BIDX() { int b = blockIdx.x; asm volatile("" : "+s"(b)); return b; }
DI unsigned pk2(float lo, float hi);
DI unsigned f2bf(float f) { return pk2(f, 0.f) & 0xffffu; }
typedef float f32x2_t __attribute__((ext_vector_type(2))); typedef __bf16 bf16x2_t __attribute__((ext_vector_type(2)));
DI unsigned pk2(float lo, float hi) { f32x2_t v = {lo, hi}; bf16x2_t b = __builtin_convertvector(v, bf16x2_t); return __builtin_bit_cast(unsigned, b); }
DI float bflo(unsigned w) { return __uint_as_float(w << 16); }
DI float bfhi(unsigned w) { return __uint_as_float(w & 0xffff0000u); }
DI f32x4 xload(const xres_t* p) {
#if XBF16
    const u32x2 w = *(const u32x2*)p; return (f32x4){bflo(w.x), bfhi(w.x), bflo(w.y), bfhi(w.y)};
#else
    return *(const f32x4*)p;
#endif
}
DI void xstore(xres_t* p, f32x4 v) {
#if XBF16
    u32x2 w; w.x = pk2(v[0], v[1]); w.y = pk2(v[2], v[3]); *(u32x2*)p = w;
#else
    *(f32x4*)p = v;
#endif
}
DI float wave_sum(float v) {
    int x = __float_as_int(v);
    v += __int_as_float(__builtin_amdgcn_update_dpp(x, x, 0xB1, 0xF, 0xF, false)); x = __float_as_int(v);
    v += __int_as_float(__builtin_amdgcn_update_dpp(x, x, 0x4E, 0xF, 0xF, false)); x = __float_as_int(v);
    v += __int_as_float(__builtin_amdgcn_update_dpp(x, x, 0x141, 0xF, 0xF, false)); x = __float_as_int(v);
    v += __int_as_float(__builtin_amdgcn_update_dpp(x, x, 0x140, 0xF, 0xF, false));
    { const auto r = __builtin_amdgcn_permlane16_swap(__float_as_uint(v), __float_as_uint(v), false, false); v = __uint_as_float(r[0]) + __uint_as_float(r[1]); }
    { const auto r = __builtin_amdgcn_permlane32_swap(__float_as_uint(v), __float_as_uint(v), false, false); v = __uint_as_float(r[0]) + __uint_as_float(r[1]); }
    return v;
}
DI float siluf(float v) { return v * __builtin_amdgcn_rcpf(1.0f + __expf(-v)); }

DI int gemm_chunk(int tid) { return (tid & 7) ^ ((tid >> 4) & 7); }
template <bool TRN>
DI void gemm_tile(unsigned char* shm, const bf16_t* const (&ap)[4], const bf16_t* const (&bp)[4], int K, f32x4 (&acc)[4][4],
                  bool first, bool has_next, const bf16_t* const (&apn)[4], const bf16_t* const (&bpn)[4]) {
    const int tid = TIDX(), wid = tid >> 6, lane = tid & 63, wr = wid >> 1, wc = wid & 1, fr = lane & 15, fq = lane >> 4;
#pragma unroll
    for (int m = 0; m < 4; ++m)
#pragma unroll
        for (int n = 0; n < 4; ++n) acc[m][n] = (f32x4){0.f, 0.f, 0.f, 0.f};
    const int nt = K >> 6;
    const int sw = fr >> 1;
    const unsigned aoff = (unsigned)((wr * 64 + fr) * 128), boff = (unsigned)(16384 + (wc * 64 + fr) * 128);
#define GEMM_STAGE(buf, A_, B_, t) do { _Pragma("unroll") for (int i_ = 0; i_ < 4; ++i_) { \
        __builtin_amdgcn_global_load_lds((const unsigned*)(A_[i_] + (t) * 64), (LAS unsigned*)(shm + (buf) * 32768 + i_ * 4096 + tid * 16), 16, 0, 0); \
        __builtin_amdgcn_global_load_lds((const unsigned*)(B_[i_] + (t) * 64), (LAS unsigned*)(shm + (buf) * 32768 + 16384 + i_ * 4096 + tid * 16), 16, 0, 0); } } while (0)
    if (first) {
        GEMM_STAGE(0, ap, bp, 0);
        asm volatile("s_waitcnt vmcnt(0)" ::: "memory");
        __syncthreads();
    }
    for (int t = 0; t < nt; ++t) {
        const int cur = t & 1;
        if (t + 1 < nt) GEMM_STAGE(cur ^ 1, ap, bp, t + 1);
        else if (has_next) GEMM_STAGE(cur ^ 1, apn, bpn, 0);
        const unsigned char* base = shm + cur * 32768;
        bf16x8 At[2][4], Bt[2][4];
#pragma unroll
        for (int ks = 0; ks < 2; ++ks) {
            const unsigned co = (unsigned)(((ks * 4 + fq) ^ sw) << 4);
#pragma unroll
            for (int m = 0; m < 4; ++m) At[ks][m] = *(const bf16x8*)(base + aoff + m * 2048 + co);
#pragma unroll
            for (int n = 0; n < 4; ++n) Bt[ks][n] = *(const bf16x8*)(base + boff + n * 2048 + co);
        }
        __builtin_amdgcn_s_setprio(1);
#pragma unroll
        for (int ks = 0; ks < 2; ++ks)
#pragma unroll
            for (int m = 0; m < 4; ++m)
#pragma unroll
                for (int n = 0; n < 4; ++n)
                    acc[m][n] = TRN ? __builtin_amdgcn_mfma_f32_16x16x32_bf16(Bt[ks][n], At[ks][m], acc[m][n], 0, 0, 0)
                                    : __builtin_amdgcn_mfma_f32_16x16x32_bf16(At[ks][m], Bt[ks][n], acc[m][n], 0, 0, 0);
        __builtin_amdgcn_s_setprio(0);
        asm volatile("s_waitcnt vmcnt(0)" ::: "memory");
        __syncthreads();
    }
#undef GEMM_STAGE
}
#define GEMM_ADVANCE() do { _Pragma("unroll") for (int k_ = 0; k_ < 4; ++k_) { ap[k_] = apn[k_]; bp[k_] = bpn[k_]; } } while (0)
DI void gemm_rows(const bf16_t* base, int r0, int ld, int tid, const bf16_t* (&pp)[4]) {
    const bf16_t* q = base + (size_t)(r0 + (tid >> 3)) * ld + gemm_chunk(tid) * 8;
#pragma unroll
    for (int i = 0; i < 4; ++i) pp[i] = q + (size_t)(32 * i) * ld;
}
DI bool tile_seq(int q, int nrt, int nct, int& rt, int& ct) {
    if (q >= nrt * nct) return false;
    const int band = q / (8 * nct), rem = q - band * 8 * nct;
    const int rows = (nrt - band * 8) < 8 ? (nrt - band * 8) : 8;
    ct = rem / rows; rt = band * 8 + rem % rows;
    return true;
}
DI int xcd_seq(int i, int total) {
    const int G = gridDim.x, bid = BIDX();
    if ((G & 7) != 0) { const int q = i * G + bid; return q < total ? q : -1; }
    const int x = bid & 7, j = bid >> 3, per = (total + 7) >> 3, gx = G >> 3;
    const int q = i * gx + j;
    if (q >= per) return -1;
    const int g = x * per + q;
    return g < total ? g : -1;
}

struct TrDesc { const float* W; bf16_t* WT; int K, N, mode, item; };
DI void tr_load(const TrDesc& d, int lane, float (&wv)[32]) {
    const int nblk = d.N / 32, kb = d.item / nblk, nb = d.item % nblk, k0 = 64 * kb, n0 = 32 * nb;
    const float* src = d.W + (size_t)(k0 + (lane >> 5)) * d.N + n0 + (lane & 31);
#pragma unroll
    for (int i = 0; i < 32; ++i) wv[i] = src[(size_t)(2 * i) * d.N];
}
DI void tr_store(const TrDesc& d, int lane, float* scr, const float (&wv)[32]) {
    const int nblk = d.N / 32, kb = d.item / nblk, nb = d.item % nblk, k0 = 64 * kb, n0 = 32 * nb;
#pragma unroll
    for (int i = 0; i < 32; ++i) scr[(2 * i + (lane >> 5)) * 33 + (lane & 31)] = wv[i];
    asm volatile("s_waitcnt lgkmcnt(0)" ::: "memory");
    const int c = lane & 7;
#pragma unroll
    for (int j = 0; j < 4; ++j) {
        const int n = (lane >> 3) + 8 * j; const float* s = scr + (8 * c) * 33 + n;
        u32x4 o; o.x = pk2(s[0 * 33], s[1 * 33]); o.y = pk2(s[2 * 33], s[3 * 33]); o.z = pk2(s[4 * 33], s[5 * 33]); o.w = pk2(s[6 * 33], s[7 * 33]);
        const int nn = n0 + n;
        const int drow = (d.mode == 0) ? nn : ((nn >> 4) * 32 + (nn & 15) + (d.mode == 2 ? 16 : 0));
        *(u32x4*)(d.WT + (size_t)drow * d.K + k0 + 8 * c) = o;
    }
    asm volatile("s_waitcnt lgkmcnt(0)" ::: "memory");
}

DI void phase_pre0(KP p, unsigned char* smem) {
    const int tid = TIDX(), wave = tid >> 6, lane = tid & 63;
    unsigned char* ws = p->ws;
    if (BIDX() == 0 && tid < 128) {
        unsigned* c0 = (unsigned*)(ws + WS_CTL) + CNT_WORD0 + tid * CNT_STRIDE;
        __hip_atomic_store(c0, 0u, __ATOMIC_RELAXED, __HIP_MEMORY_SCOPE_AGENT); __hip_atomic_store(c0 + 64, 0u, __ATOMIC_RELAXED, __HIP_MEMORY_SCOPE_AGENT);
    }
    {
        float* s_sc = (float*)smem;
        float* s_red = s_sc + 9 * 1024;
        const float* c = p->in[1]; const float* cc = p->in[3];
        for (int i = tid; i < 9 * 1024; i += 256) { const int r = i >> 10, k = i & 1023; const float v = r < 8 ? c[r * 1024 + k] : cc[k]; s_sc[i] = v / (1.0f + expf(-v)); }
        __syncthreads();
        float* MOD = (float*)(ws + WS_MOD);
        for (int item = BIDX(); item < 384; item += gridDim.x) {
            const int l = item / 96, n0 = (item % 96) * 64;
            const float* W = p->in[4] + (size_t)l * 1024 * 6144 + n0 + lane;
            float acc[9];
#pragma unroll
            for (int r = 0; r < 9; ++r) acc[r] = 0.f;
#pragma unroll 16
            for (int k = wave * 256; k < wave * 256 + 256; ++k) {
                const float w = W[(size_t)k * 6144];
#pragma unroll
                for (int r = 0; r < 9; ++r) acc[r] += s_sc[r * 1024 + k] * w;
            }
#pragma unroll
            for (int r = 0; r < 9; ++r) s_red[(wave * 9 + r) * 64 + lane] = acc[r];
            __syncthreads();
            for (int i = tid; i < 9 * 64; i += 256) {
                const int r = i >> 6, ln = i & 63;
                const float v = s_red[(0 * 9 + r) * 64 + ln] + s_red[(1 * 9 + r) * 64 + ln] + s_red[(2 * 9 + r) * 64 + ln] + s_red[(3 * 9 + r) * 64 + ln];
                MOD[(size_t)(l * 9 + r) * 6144 + n0 + ln] = v + p->in[5][l * 6144 + n0 + ln];
            }
            __syncthreads();
        }
    }
    {
        const int gt = BIDX() * 256 + tid, NT = gridDim.x * 256;
        float* ca = (float*)(ws + WS_ROPEA); float* sa = ca + 2048 * 64;
        for (int i = gt; i < 2048 * 64; i += NT) {
            const int t = i >> 6, f = i & 63; const int pos = f < 32 ? (t >> 6) : (t & 63); const int ff = f & 31;
            const float inv = powf(10000.0f, -(float)ff / 32.0f); const float a = (float)pos * inv;
            ca[i] = cosf(a); sa[i] = sinf(a);
        }
        float* cc_ = (float*)(ws + WS_ROPEC); float* sc_ = cc_ + 2048 * 32;
        for (int i = gt; i < 2048 * 32; i += NT) {
            const int t = i >> 5, f = i & 31; const int pos = f < 16 ? (t >> 6) : (t & 63); const int ff = f & 15;
            const float inv = powf(10000.0f, -(float)ff / 16.0f); const float a = (float)pos * inv;
            cc_[i] = cosf(a); sc_[i] = sinf(a);
        }
        float* wrt = (float*)(ws + WS_WRT);
        for (int i = gt; i < 4 * 36 * 1024; i += NT) {
            const int l = i / (36 * 1024), o = (i / 1024) % 36, k = i & 1023;
            wrt[i] = o < 4 ? p->in[25][((size_t)l * 1024 + k) * 4 + o] : p->in[27][((size_t)l * 1024 + k) * 32 + (o - 4)];
        }
        unsigned* wpad = (unsigned*)(ws + WS_WIN);
        for (int i = gt; i < 2 * 96 * 512; i += NT) { const int li = i / (96 * 512), r = i % (96 * 512); wpad[((size_t)li * NINP + NIN) * 512 + r] = 0u; }
    }
    __syncthreads();
    {
        float* scr = (float*)smem + wave * (64 * 33);
        constexpr int I_IN = 16 * 113, I_SQ = 16 * 32, I_QKV = 16 * 96, I_E = 256;
        constexpr int R0 = 2 * I_IN, R1 = R0 + 2 * I_SQ, R2 = R1 + 2 * I_QKV, R3 = R2 + 2 * I_SQ, R4 = R3 + 128 * I_E, R5 = R4 + 128 * I_E, R6 = R5 + 128 * I_E;
        auto decode = [&](int it) -> TrDesc {
            TrDesc d;
            if (it < R0) { const int i = it / I_IN; d.item = it % I_IN; d.W = p->in[10] + (size_t)i * 1024 * NIN; d.K = 1024; d.N = NIN; d.WT = (bf16_t*)(ws + WS_WIN) + (size_t)i * NINP * 1024; d.mode = 0; }
            else if (it < R1) { const int q = it - R0, i = q / I_SQ; d.item = q % I_SQ; d.W = p->in[17] + (size_t)i * 1024 * 1024; d.K = 1024; d.N = 1024; d.WT = (bf16_t*)(ws + WS_WABO) + (size_t)i * 1024 * 1024; d.mode = 0; }
            else if (it < R2) { const int q = it - R1, i = q / I_QKV; d.item = q % I_QKV; d.W = p->in[18] + (size_t)i * 1024 * 3072; d.K = 1024; d.N = 3072; d.WT = (bf16_t*)(ws + WS_WQKV) + (size_t)i * 3072 * 1024; d.mode = 0; }
            else if (it < R3) { const int q = it - R2, i = q / I_SQ; d.item = q % I_SQ; d.W = p->in[24] + (size_t)i * 1024 * 1024; d.K = 1024; d.N = 1024; d.WT = (bf16_t*)(ws + WS_WCO) + (size_t)i * 1024 * 1024; d.mode = 0; }
            else if (it < R4) { const int q = it - R3, le = q / I_E; d.item = q % I_E; d.W = p->in[29] + (size_t)le * 1024 * 512; d.K = 1024; d.N = 512; d.WT = (bf16_t*)(ws + WS_WGU) + (size_t)le * 1024 * 1024; d.mode = 1; }
            else if (it < R5) { const int q = it - R4, le = q / I_E; d.item = q % I_E; d.W = p->in[30] + (size_t)le * 1024 * 512; d.K = 1024; d.N = 512; d.WT = (bf16_t*)(ws + WS_WGU) + (size_t)le * 1024 * 1024; d.mode = 2; }
            else { const int q = it - R5, le = q / I_E; d.item = q % I_E; d.W = p->in[31] + (size_t)le * 512 * 1024; d.K = 512; d.N = 1024; d.WT = (bf16_t*)(ws + WS_WD) + (size_t)le * 1024 * 512; d.mode = 0; }
            return d;
        };
        const int istride = gridDim.x * 4;
        int it = BIDX() * 4 + wave;
        float wa[32], wb[32];
        TrDesc dc = decode(it < R6 ? it : 0);
        if (it < R6) tr_load(dc, lane, wa);
#pragma unroll 1
        for (; it < R6; it += istride) {
            const bool hn = it + istride < R6;
            const TrDesc dn = decode(hn ? it + istride : 0);
            if (hn) tr_load(dn, lane, wb);
            tr_store(dc, lane, scr, wa);
            dc = dn;
#pragma unroll
            for (int i = 0; i < 32; ++i) wa[i] = wb[i];
        }
    }
}

DI void phase_pre1(KP p) {
    const int tid = TIDX(), wave = tid >> 6, lane = tid & 63;
    xres_t* X = (xres_t*)(p->ws + WS_X); bf16_t* U = (bf16_t*)(p->ws + WS_U); const float* MOD = (const float*)(p->ws + WS_MOD);
    const int rstride = gridDim.x * 4;
    f32x4 rv[3][4];
#define PRE1_FETCH(R0) { _Pragma("unroll") for (int q = 0; q < 3; ++q) { const int row_ = (R0) + q * rstride; const int row = row_ < MT ? row_ : MT - 1; \
        const float* src = row < ML ? p->in[0] + (size_t)row * 1024 : p->in[2] + (size_t)(row - ML) * 1024; \
        _Pragma("unroll") for (int j = 0; j < 4; ++j) rv[q][j] = *(const f32x4*)(src + 256 * j + 4 * lane); } }
    int row0 = BIDX() * 4 + wave;
    if (row0 < MT) PRE1_FETCH(row0)
#pragma unroll 1
    for (; row0 < MT; row0 += 3 * rstride) {
        f32x4 u[3][4];
#pragma unroll
        for (int q = 0; q < 3; ++q) {
            const int row_ = row0 + q * rstride; const int row = row_ < MT ? row_ : MT - 1;
            const int r = row < ML ? (row >> 11) : 8;
            const float* mod = MOD + (size_t)r * 6144;
#pragma unroll
            for (int j = 0; j < 4; ++j) {
                const int k = 256 * j + 4 * lane;
                const f32x4 sh = *(const f32x4*)(mod + k), sc = *(const f32x4*)(mod + 1024 + k);
                u[q][j] = rv[q][j] * (1.0f + sc) + sh;
            }
        }
        if (row0 + 3 * rstride < MT) PRE1_FETCH(row0 + 3 * rstride)
#pragma unroll
        for (int q = 0; q < 3; ++q) {
            const int row = row0 + q * rstride;
            if (row < MT) {
#pragma unroll
                for (int j = 0; j < 4; ++j) {
                    const int k = 256 * j + 4 * lane;
                    u32x2 w; w.x = pk2(u[q][j][0], u[q][j][1]); w.y = pk2(u[q][j][2], u[q][j][3]);
                    *(u32x2*)(U + (size_t)row * 1024 + k) = w;
                }
            }
        }
    }
}

DI void phase_g1e(KP p, int l, unsigned char* smem) {
    const int tid = TIDX(), wid = tid >> 6, lane = tid & 63, wr = wid >> 1, wc = wid & 1, fr = lane & 15, fq = lane >> 4;
    const int li = l >> 1;
    const bf16_t* U = (const bf16_t*)(p->ws + WS_U); const bf16_t* W = (const bf16_t*)(p->ws + WS_WIN) + (size_t)li * NINP * 1024;
    bf16_t* Z = (bf16_t*)(p->ws + WS_Z); float* LR = (float*)(p->ws + WS_LR);
    const float* ca = (const float*)(p->ws + WS_ROPEA); const float* sa = ca + 2048 * 64;
    constexpr int NTN = NINP / 128;
    auto decode = [&](int i, int& brow, int& bcol) -> bool {
        const int q = xcd_seq(i, (MT / 128) * NTN); if (q < 0) return false;
        int rt, nt; tile_seq(q, MT / 128, NTN, rt, nt); brow = rt * 128; bcol = nt * 128; return true; };
    auto epi = [&](int brow, int bcol, f32x4 (&acc)[4][4]) {
        const int colw = bcol + wc * 64;
        if (colw >= NIN) return;
        if (colw >= 3584) {
#pragma unroll
            for (int m = 0; m < 4; ++m) { const int row = brow + wr * 64 + m * 16 + fr;
#pragma unroll
                for (int n = 0; n < 2; ++n) *(f32x4*)(LR + (size_t)row * 32 + n * 16 + fq * 4) = acc[m][n]; }
            return;
        }
        const bool ropeR = colw < 1024; const int half = (colw >> 6) & 1;
        const float scale = colw < 512 ? 0.08838834764831845f : ((colw >= 2048 && colw < 2304) ? 0.125f : 1.0f);
#pragma unroll
        for (int m = 0; m < 4; ++m) {
            const int row = brow + wr * 64 + m * 16 + fr;
            if (ropeR && row < ML) {
                const int t = row & 2047;
#pragma unroll
                for (int n = 0; n < 2; ++n) {
                    const f32x4 c4 = *(const f32x4*)(ca + t * 64 + half * 32 + n * 16 + fq * 4), s4 = *(const f32x4*)(sa + t * 64 + half * 32 + n * 16 + fq * 4);
                    const f32x4 a = acc[m][n], b = acc[m][n + 2];
                    acc[m][n] = a * c4 - b * s4; acc[m][n + 2] = b * c4 + a * s4;
                }
            }
#pragma unroll
            for (int n = 0; n < 4; ++n) {
                const f32x4 v = acc[m][n] * scale; u32x2 w; w.x = pk2(v[0], v[1]); w.y = pk2(v[2], v[3]);
                *(u32x2*)(Z + (size_t)row * ZS + colw + n * 16 + fq * 4) = w;
            }
        }
    };
    int brow, bcol;
    if (!decode(0, brow, bcol)) return;
    const bf16_t* ap[4]; const bf16_t* bp[4]; const bf16_t* apn[4]; const bf16_t* bpn[4];
    gemm_rows(U, brow, 1024, tid, ap); gemm_rows(W, bcol, 1024, tid, bp);
    bool first = true;
    for (int i = 0;; ++i) {
        int nbrow = brow, nbcol = bcol; const bool hn = decode(i + 1, nbrow, nbcol);
        gemm_rows(U, nbrow, 1024, tid, apn); gemm_rows(W, nbcol, 1024, tid, bpn);
        f32x4 acc[4][4];
        gemm_tile<true>(smem, ap, bp, 1024, acc, first, hn, apn, bpn);
        epi(brow, bcol, acc);
        if (!hn) break;
        brow = nbrow; bcol = nbcol; GEMM_ADVANCE(); first = false;
    }
}

DI void phase_g1o(KP p, int l, unsigned char* smem) {
    const int tid = TIDX(), wid = tid >> 6, lane = tid & 63, wr = wid >> 1, wc = wid & 1, fr = lane & 15, fq = lane >> 4;
    const int li = l >> 1;
    const bf16_t* U = (const bf16_t*)(p->ws + WS_U); const bf16_t* W = (const bf16_t*)(p->ws + WS_WQKV) + (size_t)li * 3072 * 1024;
    bf16_t* Qc = (bf16_t*)(p->ws + WS_QC); bf16_t* Kc = (bf16_t*)(p->ws + WS_KC); bf16_t* Vt = (bf16_t*)(p->ws + WS_VT);
    const float* cc = (const float*)(p->ws + WS_ROPEC); const float* sc = cc + 2048 * 32;
    auto decode = [&](int i, int& brow, int& bcol) -> bool {
        const int q = xcd_seq(i, (MT / 128) * 24); if (q < 0) return false;
        int rt, nt; tile_seq(q, MT / 128, 24, rt, nt); brow = rt * 128; bcol = nt * 128; return true; };
    int brow, bcol;
    if (!decode(0, brow, bcol)) return;
    const bf16_t* ap[4]; const bf16_t* bp[4]; const bf16_t* apn[4]; const bf16_t* bpn[4];
    gemm_rows(U, brow, 1024, tid, ap); gemm_rows(W, bcol, 1024, tid, bp);
    bool first = true;
    for (int i = 0;; ++i) {
        int nbrow = brow, nbcol = bcol; const bool hn = decode(i + 1, nbrow, nbcol);
        gemm_rows(U, nbrow, 1024, tid, apn); gemm_rows(W, nbcol, 1024, tid, bpn);
        f32x4 acc[4][4];
        if (bcol < 2048) {
            gemm_tile<true>(smem, ap, bp, 1024, acc, first, hn, apn, bpn);
            const int colw = bcol + wc * 64; const bool isk = colw >= 1024; const int hc = (colw & 1023) >> 6;
            bf16_t* dst = isk ? Kc : Qc; const float scale = isk ? 1.0f : 0.125f;
#pragma unroll
            for (int m = 0; m < 4; ++m) {
                const int row = brow + wr * 64 + m * 16 + fr;
                int b, pidx;
                if (row < ML) {
                    b = row >> 11; const int t = row & 2047; pidx = 256 + t;
#pragma unroll
                    for (int n = 0; n < 4; n += 2) {
                        const f32x4 c4 = *(const f32x4*)(cc + t * 32 + (n >> 1) * 16 + fq * 4), s4 = *(const f32x4*)(sc + t * 32 + (n >> 1) * 16 + fq * 4);
                        const f32x4 a = acc[m][n], bb = acc[m][n + 1];
                        acc[m][n] = a * c4 - bb * s4; acc[m][n + 1] = bb * c4 + a * s4;
                    }
                } else { b = (row - ML) >> 8; pidx = (row - ML) & 255; }
                bf16_t* o = dst + ((size_t)(b * 16 + hc) * TA + pidx) * 64;
#pragma unroll
                for (int n = 0; n < 4; ++n) { const f32x4 v = acc[m][n] * scale; u32x2 w; w.x = pk2(v[0], v[1]); w.y = pk2(v[2], v[3]); *(u32x2*)(o + n * 16 + fq * 4) = w; }
            }
        } else {
            gemm_tile<false>(smem, ap, bp, 1024, acc, first, hn, apn, bpn);
#pragma unroll
            for (int m = 0; m < 4; ++m) {
                const int row = brow + wr * 64 + m * 16 + fq * 4;
                int b, pidx;
                if (row < ML) { b = row >> 11; pidx = 256 + (row & 2047); } else { b = (row - ML) >> 8; pidx = (row - ML) & 255; }
                const int ppos = (pidx & ~12) | ((pidx & 8) >> 1) | ((pidx & 4) << 1);
#pragma unroll
                for (int n = 0; n < 4; ++n) {
                    const int col = bcol - 2048 + wc * 64 + n * 16 + fr; const int h = col >> 7, d = col & 127;
                    const f32x4 v = acc[m][n]; u32x2 w; w.x = pk2(v[0], v[1]); w.y = pk2(v[2], v[3]);
                    *(u32x2*)(Vt + ((size_t)(b * 8 + h) * 128 + d) * TA + ppos) = w;
                }
            }
        }
        if (!hn) break;
        brow = nbrow; bcol = nbcol; GEMM_ADVANCE(); first = false;
    }
}

DI void phase_g2(KP p, int l, unsigned char* smem) {
    const int tid = TIDX(), wid = tid >> 6, lane = tid & 63, wr = wid >> 1, wc = wid & 1, fr = lane & 15, fq = lane >> 4;
    const int li = l >> 1;
    const bf16_t* Y = (const bf16_t*)(p->ws + WS_Y);
    const bf16_t* W = (const bf16_t*)(p->ws + ((l & 1) ? WS_WCO : WS_WABO)) + (size_t)li * 1024 * 1024;
    bf16_t* P = (bf16_t*)(p->ws + WS_P);
    const int nrt = (l == 3 ? ML : MT) / 128;
    auto decode = [&](int i, int& brow, int& bcol) -> bool {
        const int q = xcd_seq(i, nrt * 8); if (q < 0) return false;
        int rt, nt; tile_seq(q, nrt, 8, rt, nt); brow = rt * 128; bcol = nt * 128; return true; };
    int brow, bcol;
    if (!decode(0, brow, bcol)) return;
    const bf16_t* ap[4]; const bf16_t* bp[4]; const bf16_t* apn[4]; const bf16_t* bpn[4];
    gemm_rows(Y, brow, 1024, tid, ap); gemm_rows(W, bcol, 1024, tid, bp);
    bool first = true;
    for (int i = 0;; ++i) {
        int nbrow = brow, nbcol = bcol; const bool hn = decode(i + 1, nbrow, nbcol);
        gemm_rows(Y, nbrow, 1024, tid, apn); gemm_rows(W, nbcol, 1024, tid, bpn);
        f32x4 acc[4][4];
        gemm_tile<true>(smem, ap, bp, 1024, acc, first, hn, apn, bpn);
#pragma unroll
        for (int m = 0; m < 4; ++m) { const int row = brow + wr * 64 + m * 16 + fr;
#pragma unroll
            for (int n = 0; n < 4; ++n) { const f32x4 v = acc[m][n]; u32x2 w; w.x = pk2(v[0], v[1]); w.y = pk2(v[2], v[3]); *(u32x2*)(P + (size_t)row * 1024 + bcol + wc * 64 + n * 16 + fq * 4) = w; } }
        if (!hn) break;
        brow = nbrow; bcol = nbcol; GEMM_ADVANCE(); first = false;
    }
}

template <bool DRY>
DI void phase_ln1r(KP p, int l, unsigned char* smem) {
    constexpr int US = 1028;
    constexpr int RB = 12;
    float* Us = (float*)smem;
    float* Ps = Us + RB * US;
    const int tid = TIDX(), wave = tid >> 6, lane = tid & 63;
    const xres_t* X = (const xres_t*)(p->ws + WS_X); xres_t* Xo = (xres_t*)(p->ws + (DRY ? WS_OB : WS_X)); const bf16_t* P = (const bf16_t*)(p->ws + WS_P); bf16_t* U = (bf16_t*)(p->ws + (DRY ? WS_Y : WS_U));
    const float* MOD = (const float*)(p->ws + WS_MOD); const float* WrT = (const float*)(p->ws + WS_WRT) + (size_t)l * 36 * 1024;
    const float* lng = p->in[6] + l * 1024; const float* lnb = p->in[7] + l * 1024;
    const float* bgrp = p->in[26] + l * 4; const float* brex = p->in[28] + l * 32;
    unsigned* cnt = (unsigned*)(p->ws + WS_CTL) + CNT_WORD0 + l * 32 * CNT_STRIDE + (DRY ? 64 : 0); int* list = (int*)(p->ws + WS_LIST); float* slotw = (float*)(p->ws + WS_SLOTW);
    const int rows_total = (l == 3) ? ML : MT;
    const int mi = lane & 15, mq = lane >> 4;
    int pend_slot = -1, pend_e = 0; unsigned pend_pos = 0u;
    f32x4 rx[3][4]; u32x2 rp[3][4];
#define LN1_FETCH(IT, RR) { const int frow_ = (IT) * RB + wave * 3 + (RR); const int frow = frow_ < rows_total ? frow_ : rows_total - 1; \
        const float* xsrc = (l == 0) ? (frow < ML ? p->in[0] + (size_t)frow * 1024 : p->in[2] + (size_t)(frow - ML) * 1024) : nullptr; \
        _Pragma("unroll") for (int j = 0; j < 4; ++j) { const int k = 256 * j + 4 * lane; \
            rx[RR][j] = (l == 0) ? *(const f32x4*)(xsrc + k) : xload(X + (size_t)frow * 1024 + k); rp[RR][j] = *(const u32x2*)(P + (size_t)frow * 1024 + k); } }
    int it = BIDX();
    if (it * RB < rows_total) { LN1_FETCH(it, 0) LN1_FETCH(it, 1) LN1_FETCH(it, 2) }
#pragma unroll 1
    for (; it * RB < rows_total; it += gridDim.x) {
        const int row0 = it * RB + wave * 3;
        const bool has_next = (it + (int)gridDim.x) * RB < rows_total;
#pragma unroll
        for (int rr = 0; rr < 3; ++rr) {
            const int rowr = row0 + rr; const bool rvalid = rowr < rows_total; const int row = rvalid ? rowr : rows_total - 1;
            const int r = row < ML ? (row >> 11) : 8;
            const float* mod = MOD + (size_t)(l * 9 + r) * 6144;
            f32x4 v[4]; float s = 0.f;
#pragma unroll
            for (int j = 0; j < 4; ++j) {
                const int k = 256 * j + 4 * lane;
                const f32x4 xv = rx[rr][j];
                const f32x4 g1 = *(const f32x4*)(mod + 2048 + k);
                const u32x2 pw_ = rp[rr][j]; const f32x4 pv = (f32x4){bflo(pw_.x), bfhi(pw_.x), bflo(pw_.y), bfhi(pw_.y)};
                v[j] = xv * ALPHA + g1 * pv; s += (v[j][0] + v[j][1]) + (v[j][2] + v[j][3]);
            }
            if (has_next) { if (rr == 0) LN1_FETCH(it + gridDim.x, 0) else if (rr == 1) LN1_FETCH(it + gridDim.x, 1) else LN1_FETCH(it + gridDim.x, 2) }
            const float mean = wave_sum(s) * (1.0f / 1024.0f); float s2 = 0.f;
#pragma unroll
            for (int j = 0; j < 4; ++j) { v[j] = v[j] - mean; s2 += (v[j][0] * v[j][0] + v[j][1] * v[j][1]) + (v[j][2] * v[j][2] + v[j][3] * v[j][3]); }
            const float rstd = 1.0f / sqrtf(wave_sum(s2) * (1.0f / 1024.0f) + LN_EPS);
#pragma unroll
            for (int j = 0; j < 4; ++j) {
                const int k = 256 * j + 4 * lane;
                const f32x4 xn = v[j] * rstd * *(const f32x4*)(lng + k) + *(const f32x4*)(lnb + k);
                const f32x4 uu = xn * (1.0f + *(const f32x4*)(mod + 4096 + k)) + *(const f32x4*)(mod + 3072 + k);
                *(f32x4*)(Us + (wave * 3 + rr) * US + k) = uu;
                if (rvalid) {
                    xstore(Xo + (size_t)row * 1024 + k, xn);
                    u32x2 w; w.x = pk2(uu[0], uu[1]); w.y = pk2(uu[2], uu[3]);
                    *(u32x2*)(U + (size_t)row * 1024 + k) = w;
                }
            }
        }
        __syncthreads();
        {
            f32x4 acc[3] = {(f32x4){0.f, 0.f, 0.f, 0.f}, (f32x4){0.f, 0.f, 0.f, 0.f}, (f32x4){0.f, 0.f, 0.f, 0.f}};
            const float* ap = Us + (mi < RB ? mi : mi - RB) * US + 256 * wave + 4 * mq;
            const float* bp0 = WrT + (size_t)mi * 1024 + 256 * wave + 4 * mq;
            const float* bp1 = WrT + (size_t)(16 + mi) * 1024 + 256 * wave + 4 * mq;
            const float* bp2 = WrT + (size_t)(32 + (mi & 3)) * 1024 + 256 * wave + 4 * mq;
#pragma unroll 1
            for (int sb0 = 0; sb0 < 16; sb0 += 8) {
                f32x4 bv[8][3];
#pragma unroll
                for (int q = 0; q < 8; ++q) { bv[q][0] = *(const f32x4*)(bp0 + 16 * (sb0 + q)); bv[q][1] = *(const f32x4*)(bp1 + 16 * (sb0 + q)); bv[q][2] = *(const f32x4*)(bp2 + 16 * (sb0 + q)); }
                __builtin_amdgcn_sched_barrier(0);
#pragma unroll
                for (int q = 0; q < 8; ++q) {
                    const f32x4 a = *(const f32x4*)(ap + 16 * (sb0 + q));
#pragma unroll
                    for (int e = 0; e < 4; ++e) {
                        acc[0] = __builtin_amdgcn_mfma_f32_16x16x4f32(a[e], bv[q][0][e], acc[0], 0, 0, 0);
                        acc[1] = __builtin_amdgcn_mfma_f32_16x16x4f32(a[e], bv[q][1][e], acc[1], 0, 0, 0);
                        acc[2] = __builtin_amdgcn_mfma_f32_16x16x4f32(a[e], bv[q][2][e], acc[2], 0, 0, 0);
                    }
                }
            }
            if (mq < 3) {
#pragma unroll
                for (int nt = 0; nt < 3; ++nt)
#pragma unroll
                    for (int rg = 0; rg < 4; ++rg) Ps[(wave * RB + mq * 4 + rg) * 48 + nt * 16 + mi] = acc[nt][rg];
            }
        }
        __syncthreads();
        if (wave < 2) {
            const int r = wave * 8 + (lane >> 3), c = lane & 7;
            const int rq = r < RB ? r : RB - 1;
            const int row = it * RB + rq;
            float lgv[5];
#pragma unroll
            for (int k = 0; k < 5; ++k) {
                const int o = c + 8 * k; const int oo = o < 36 ? o : 35;
                lgv[k] = (Ps[(0 * RB + rq) * 48 + oo] + Ps[(1 * RB + rq) * 48 + oo]) + (Ps[(2 * RB + rq) * 48 + oo] + Ps[(3 * RB + rq) * 48 + oo]);
            }
            float gv = c < 4 ? lgv[0] + bgrp[c & 3] : -3.0e38f; int gi = c;
#pragma unroll
            for (int off = 1; off < 4; off <<= 1) {
                const float ov = __shfl_xor(gv, off); const int oi = __shfl_xor(gi, off);
                if (ov > gv || (ov == gv && oi < gi)) { gv = ov; gi = oi; }
            }
            const int src0 = lane & ~7;
            const float gmax = __shfl(gv, src0); const int grp = __shfl(gi, src0);
            float ge = c < 4 ? expf(lgv[0] + bgrp[c & 3] - gmax) : 0.f;
            ge += __shfl_xor(ge, 1); ge += __shfl_xor(ge, 2);
            const float gw = 1.0f / __shfl(ge, src0);
            const int j = (c + 4) & 7; const int kk = c >= 4 ? grp : grp + 1;
            float ev = lgv[0];
#pragma unroll
            for (int k = 1; k < 5; ++k) ev = (kk == k) ? lgv[k] : ev;
            ev += brex[grp * 8 + j];
            float v1 = ev; int i1 = j;
#pragma unroll
            for (int off = 1; off < 8; off <<= 1) {
                const float ov = __shfl_xor(v1, off); const int oi = __shfl_xor(i1, off);
                if (ov > v1 || (ov == v1 && oi < i1)) { v1 = ov; i1 = oi; }
            }
            float v2 = (j == i1) ? -3.0e38f : ev; int i2 = (j == i1) ? 99 : j;
#pragma unroll
            for (int off = 1; off < 8; off <<= 1) {
                const float ov = __shfl_xor(v2, off); const int oi = __shfl_xor(i2, off);
                if (ov > v2 || (ov == v2 && oi < i2)) { v2 = ov; i2 = oi; }
            }
            const float e2 = expf(v2 - v1);
            const float w1 = 1.0f / (1.0f + e2), w2 = e2 / (1.0f + e2);
            if (c < 2 && r < RB && row < rows_total) {
                if (pend_slot >= 0) list[(size_t)pend_e * NSLOT + pend_pos] = pend_slot;
                const int e = grp * 8 + (c ? i2 : i1); const float w = gw * (c ? w2 : w1);
                const int slot = row * 2 + c;
                slotw[slot] = w;
#ifdef DRY_NOATOM
                pend_pos = DRY ? (unsigned)slot : atomicAdd(&cnt[e * CNT_STRIDE], 1u); pend_e = e; pend_slot = slot;
#else
                pend_pos = atomicAdd(&cnt[e * CNT_STRIDE], 1u); pend_e = e; pend_slot = slot;
#endif
            }
        }
        __syncthreads();
    }
    if (pend_slot >= 0) list[(size_t)pend_e * NSLOT + pend_pos] = pend_slot;
}

DI void moe_prefix(KP p, int l, int* s_cnt, int* s_tb, int* s_rb) {
    const int tid = TIDX();
    const unsigned* cnt = (const unsigned*)(p->ws + WS_CTL) + CNT_WORD0 + l * 32 * CNT_STRIDE;
    __syncthreads();
    if (tid < 32) s_cnt[tid] = (int)__hip_atomic_load(cnt + tid * CNT_STRIDE, __ATOMIC_RELAXED, __HIP_MEMORY_SCOPE_AGENT);
    __syncthreads();
    if (tid == 0) { int tb = 0; for (int e = 0; e < 32; ++e) { s_tb[e] = tb; s_rb[e] = tb * 128; tb += (s_cnt[e] + 127) >> 7; } s_tb[32] = tb; s_rb[32] = tb * 128; }
    __syncthreads();
}
DI void phase_mg1(KP p, int l, unsigned char* smem) {
    const int tid = TIDX(), wid = tid >> 6, lane = tid & 63, wr = wid >> 1, wc = wid & 1, fr = lane & 15, fq = lane >> 4;
    int* s_cnt = (int*)(smem + 65536 + 64); int* s_tb = s_cnt + 32; int* s_rb = s_tb + 33;
    moe_prefix(p, l, s_cnt, s_tb, s_rb);
    const bf16_t* U = (const bf16_t*)(p->ws + WS_U); const int* list = (const int*)(p->ws + WS_LIST);
    bf16_t* H = (bf16_t*)(p->ws + WS_H);
    const int ntiles = s_tb[32] * 8;
    struct TI { int e, rt, nt, cnt_e; };
    auto decode = [&](int i, TI& t) -> bool {
        const int tile = xcd_seq(i, ntiles); if (tile < 0) return false;
        const int rtg = tile >> 3; t.nt = tile & 7;
        int e = 0;
        for (int q = 1; q < 32; ++q) if (rtg >= s_tb[q]) e = q;
        t.e = e; t.rt = rtg - s_tb[e]; t.cnt_e = s_cnt[e]; return true; };
    auto rows = [&](const TI& t, const bf16_t* (&a)[4], const bf16_t* (&b)[4]) {
#pragma unroll
        for (int i_ = 0; i_ < 4; ++i_) {
            const int pos = t.rt * 128 + (tid >> 3) + 32 * i_;
            const int tok = pos < t.cnt_e ? (list[(size_t)t.e * NSLOT + pos] >> 1) : 0;
            a[i_] = U + (size_t)tok * 1024 + gemm_chunk(tid) * 8;
        }
        gemm_rows((const bf16_t*)(p->ws + WS_WGU) + (size_t)(l * 32 + t.e) * 1024 * 1024, t.nt * 128, 1024, tid, b); };
    TI cur, nxt;
    if (!decode(0, cur)) return;
    const bf16_t* ap[4]; const bf16_t* bp[4]; const bf16_t* apn[4]; const bf16_t* bpn[4];
    rows(cur, ap, bp);
    bool first = true;
    for (int i = 0;; ++i) {
        nxt = cur; const bool hn = decode(i + 1, nxt);
        rows(nxt, apn, bpn);
        f32x4 acc[4][4];
        gemm_tile<true>(smem, ap, bp, 1024, acc, first, hn, apn, bpn);
        const int hrow0 = s_rb[cur.e] + cur.rt * 128 + wr * 64;
#pragma unroll
        for (int m = 0; m < 4; ++m) {
            bf16_t* o = H + (size_t)(hrow0 + m * 16 + fr) * 512 + cur.nt * 64 + wc * 32 + fq * 4;
#pragma unroll
            for (int n = 0; n < 4; n += 2) {
                const f32x4 g = acc[m][n], uu = acc[m][n + 1]; f32x4 h;
#pragma unroll
                for (int j = 0; j < 4; ++j) h[j] = siluf(g[j]) * uu[j];
                u32x2 w; w.x = pk2(h[0], h[1]); w.y = pk2(h[2], h[3]);
                *(u32x2*)(o + (n >> 1) * 16) = w;
            }
        }
        if (!hn) break;
        cur = nxt; GEMM_ADVANCE(); first = false;
    }
}
DI void phase_mg2(KP p, int l, unsigned char* smem) {
    const int tid = TIDX(), wid = tid >> 6, lane = tid & 63, wr = wid >> 1, wc = wid & 1, fr = lane & 15, fq = lane >> 4;
    int* s_cnt = (int*)(smem + 65536 + 64); int* s_tb = s_cnt + 32; int* s_rb = s_tb + 33;
    moe_prefix(p, l, s_cnt, s_tb, s_rb);
    const bf16_t* H = (const bf16_t*)(p->ws + WS_H); const int* list = (const int*)(p->ws + WS_LIST); const float* slotw = (const float*)(p->ws + WS_SLOTW);
    bf16_t* YS = (bf16_t*)(p->ws + WS_YS);
    const int ntiles = s_tb[32] * 8;
    struct TI { int e, rt, nt, cnt_e; };
    auto decode = [&](int i, TI& t) -> bool {
        const int tile = xcd_seq(i, ntiles); if (tile < 0) return false;
        const int rtg = tile >> 3; t.nt = tile & 7;
        int e = 0;
        for (int q = 1; q < 32; ++q) if (rtg >= s_tb[q]) e = q;
        t.e = e; t.rt = rtg - s_tb[e]; t.cnt_e = s_cnt[e]; return true; };
    auto rows = [&](const TI& t, const bf16_t* (&a)[4], const bf16_t* (&b)[4]) {
        gemm_rows(H, s_rb[t.e] + t.rt * 128, 512, tid, a);
        gemm_rows((const bf16_t*)(p->ws + WS_WD) + (size_t)(l * 32 + t.e) * 1024 * 512, t.nt * 128, 512, tid, b); };
    TI cur, nxt;
    if (!decode(0, cur)) return;
    const bf16_t* ap[4]; const bf16_t* bp[4]; const bf16_t* apn[4]; const bf16_t* bpn[4];
    rows(cur, ap, bp);
    bool first = true;
    for (int i = 0;; ++i) {
        nxt = cur; const bool hn = decode(i + 1, nxt);
        rows(nxt, apn, bpn);
        int eslot[4]; float ew[4];
#pragma unroll
        for (int m = 0; m < 4; ++m) {
            const int pos = cur.rt * 128 + wr * 64 + m * 16 + fr;
            eslot[m] = pos < cur.cnt_e ? list[(size_t)cur.e * NSLOT + pos] : -1;
        }
#pragma unroll
        for (int m = 0; m < 4; ++m) ew[m] = eslot[m] >= 0 ? slotw[eslot[m]] : 0.f;
        f32x4 acc[4][4];
        gemm_tile<true>(smem, ap, bp, 512, acc, first, hn, apn, bpn);
#pragma unroll
        for (int m = 0; m < 4; ++m) {
            if (eslot[m] >= 0) {
                const int slot = eslot[m]; const float w = ew[m];
                bf16_t* o = YS + (size_t)slot * 1024 + cur.nt * 128 + wc * 64 + fq * 4;
#pragma unroll
                for (int n = 0; n < 4; ++n) { const f32x4 v = acc[m][n] * w; u32x2 ww; ww.x = pk2(v[0], v[1]); ww.y = pk2(v[2], v[3]); *(u32x2*)(o + n * 16) = ww; }
            }
        }
        if (!hn) break;
        cur = nxt; GEMM_ADVANCE(); first = false;
    }
}

template <bool DRY>
DI void phase_ln2(KP p, int l) {
    const int tid = TIDX(), wave = tid >> 6, lane = tid & 63;
    const xres_t* X = (const xres_t*)(p->ws + WS_X); xres_t* Xo = (xres_t*)(p->ws + (DRY ? WS_OB : WS_X)); const bf16_t* YS = (const bf16_t*)(p->ws + WS_YS); bf16_t* U = (bf16_t*)(p->ws + (DRY ? WS_Y : WS_U));
    const float* MOD = (const float*)(p->ws + WS_MOD);
    const float* lng = p->in[8] + l * 1024; const float* lnb = p->in[9] + l * 1024;
    const int rows_total = (l == 3) ? ML : MT;
    u32x2 ry0[2][4], ry1[2][4]; f32x4 rx[2][4];
    const int rstride = gridDim.x * 8;
    int row0 = (BIDX() * 4 + wave) * 2;
#define LN2_FETCH(R0) { _Pragma("unroll") for (int q = 0; q < 2; ++q) { const int row = (R0) + q; _Pragma("unroll") for (int j = 0; j < 4; ++j) { const int k = 256 * j + 4 * lane; \
        ry0[q][j] = *(const u32x2*)(YS + (size_t)(2 * row) * 1024 + k); ry1[q][j] = *(const u32x2*)(YS + (size_t)(2 * row + 1) * 1024 + k); rx[q][j] = xload(X + (size_t)row * 1024 + k); } } }
    if (row0 < rows_total) LN2_FETCH(row0)
#pragma unroll 1
    for (; row0 < rows_total; row0 += rstride) {
        f32x4 v[2][4]; float s[2] = {0.f, 0.f};
        const float* mod[2];
#pragma unroll
        for (int q = 0; q < 2; ++q) {
            const int row = row0 + q; const int r = row < ML ? (row >> 11) : 8;
            mod[q] = MOD + (size_t)(l * 9 + r) * 6144;
#pragma unroll
            for (int j = 0; j < 4; ++j) {
                const int k = 256 * j + 4 * lane;
                const u32x2 y0 = ry0[q][j], y1 = ry1[q][j];
                f32x4 y; y[0] = bflo(y0.x) + bflo(y1.x); y[1] = bfhi(y0.x) + bfhi(y1.x); y[2] = bflo(y0.y) + bflo(y1.y); y[3] = bfhi(y0.y) + bfhi(y1.y);
                const f32x4 xv = rx[q][j], g2 = *(const f32x4*)(mod[q] + 5120 + k);
                v[q][j] = xv * ALPHA + g2 * y; s[q] += (v[q][j][0] + v[q][j][1]) + (v[q][j][2] + v[q][j][3]);
            }
        }
        if (row0 + rstride < rows_total) LN2_FETCH(row0 + rstride)
        float mean[2], rstd[2];
#pragma unroll
        for (int q = 0; q < 2; ++q) mean[q] = wave_sum(s[q]) * (1.0f / 1024.0f);
#pragma unroll
        for (int q = 0; q < 2; ++q) {
            float s2 = 0.f;
#pragma unroll
            for (int j = 0; j < 4; ++j) { v[q][j] = v[q][j] - mean[q]; s2 += (v[q][j][0] * v[q][j][0] + v[q][j][1] * v[q][j][1]) + (v[q][j][2] * v[q][j][2] + v[q][j][3] * v[q][j][3]); }
            s[q] = s2;
        }
#pragma unroll
        for (int q = 0; q < 2; ++q) rstd[q] = 1.0f / sqrtf(wave_sum(s[q]) * (1.0f / 1024.0f) + LN_EPS);
#pragma unroll
        for (int q = 0; q < 2; ++q) {
            const int row = row0 + q;
            const float* modn = mod[q] + (l + 1 < 4 ? 9 * 6144 : 0);
#pragma unroll
            for (int j = 0; j < 4; ++j) {
                const int k = 256 * j + 4 * lane;
                const f32x4 xn = v[q][j] * rstd[q] * *(const f32x4*)(lng + k) + *(const f32x4*)(lnb + k);
                if (l < 3) {
                    xstore(Xo + (size_t)row * 1024 + k, xn);
                    const f32x4 uu = xn * (1.0f + *(const f32x4*)(modn + 1024 + k)) + *(const f32x4*)(modn + k);
                    u32x2 w; w.x = pk2(uu[0], uu[1]); w.y = pk2(uu[2], uu[3]);
                    *(u32x2*)(U + (size_t)row * 1024 + k) = w;
                } else {
                    *(f32x4*)(p->out + (size_t)row * 1024 + k) = xn;
                }
            }
        }
    }
}

DI s16x4 tr_read(const unsigned char* ptr) {
    typedef short v4i16_t __attribute__((ext_vector_type(4)));
    return __builtin_bit_cast(s16x4, __builtin_amdgcn_ds_read_tr16_b64_v4i16((LAS v4i16_t*)ptr));
}
DI bf16x8 cat8(s16x4 a, s16x4 b) { return __builtin_shufflevector(a, b, 0, 1, 2, 3, 4, 5, 6, 7); }

DI void phase_decay(KP p, int l, unsigned char* smem) {
    const int tid = TIDX();
    const int li = l >> 1;
    const float* LR = (const float*)(p->ws + WS_LR); float* TOT = (float*)(p->ws + WS_TOT);
    const bf16_t* Z = (const bf16_t*)(p->ws + WS_Z);
    float* lrs = (float*)smem;
    float* cum = lrs + 64 * 16;
    float wf[16], wb[16];
#pragma unroll
    for (int r = 0; r < 16; ++r) { wf[r] = p->in[11][(size_t)li * 16 * 256 + r * 256 + tid]; wb[r] = p->in[13][(size_t)li * 16 * 256 + r * 256 + tid]; }
    const float bf = p->in[12][li * 256 + tid], bb = p->in[14][li * 256 + tid];
    for (int it = BIDX(); it < 2 * (MT / 64); it += gridDim.x) {
        const int ch = it >> 1, dr = it & 1;
        const int row0 = ch * 64;
        bf16_t* QD = (bf16_t*)(p->ws + (dr ? WS_QDB : WS_QDF)); bf16_t* KD = QD + (size_t)MT * 256;
        __syncthreads();
        { const int tok = tid >> 2, q4 = tid & 3; *(f32x4*)(lrs + tok * 16 + q4 * 4) = *(const f32x4*)(LR + (size_t)(row0 + tok) * 32 + dr * 16 + q4 * 4); }
        __syncthreads();
        float run = 0.f;
#pragma unroll 1
        for (int half = 0; half < 2; ++half) {
            const int base = dr ? 32 - 32 * half : 32 * half;
            u32x4 qv[4], kv[4];
#pragma unroll
            for (int i = 0; i < 4; ++i) {
                const int id = tid + 256 * i, tokl = id >> 5, cg = id & 31;
                const size_t zr = (size_t)(row0 + base + tokl) * ZS;
                qv[i] = *(const u32x4*)(Z + zr + 2048 + cg * 8); kv[i] = *(const u32x4*)(Z + zr + 2304 + cg * 8);
            }
            if (dr == 0) {
                for (int t = base; t < base + 32; ++t) {
                    float g = bf;
#pragma unroll
                    for (int r = 0; r < 16; ++r) g += lrs[t * 16 + r] * wf[r];
                    run += (fminf(g, 0.f) - __logf(1.0f + __expf(-fabsf(g)))) * (1.0f / 16.0f);
                    cum[(t - base) * 256 + tid] = run;
                }
            } else {
                cum[32 * 256 + tid] = run;
                for (int t = base + 31; t >= base; --t) {
                    float g = bb;
#pragma unroll
                    for (int r = 0; r < 16; ++r) g += lrs[t * 16 + r] * wb[r];
                    run += (fminf(g, 0.f) - __logf(1.0f + __expf(-fabsf(g)))) * (1.0f / 16.0f);
                    cum[(t - base) * 256 + tid] = run;
                }
            }
            __syncthreads();
#pragma unroll
            for (int i = 0; i < 4; ++i) {
                const int id = tid + 256 * i, tokl = id >> 5, cg = id & 31;
                const float* ce = cum + tokl * 256 + cg * 8;
                const float* cq = dr ? ce + 256 : ce;
                const f32x4 a0 = *(const f32x4*)cq, a1 = *(const f32x4*)(cq + 4), b0 = *(const f32x4*)ce, b1 = *(const f32x4*)(ce + 4);
                float fqv[8], fkv[8];
#pragma unroll
                for (int e = 0; e < 4; ++e) { fqv[e] = __expf(a0[e]); fqv[4 + e] = __expf(a1[e]); fkv[e] = __expf(-b0[e]); fkv[4 + e] = __expf(-b1[e]); }
                const u32x4 q = qv[i], k = kv[i]; u32x4 qo, ko;
                qo.x = pk2(bflo(q.x) * fqv[0], bfhi(q.x) * fqv[1]); qo.y = pk2(bflo(q.y) * fqv[2], bfhi(q.y) * fqv[3]); qo.z = pk2(bflo(q.z) * fqv[4], bfhi(q.z) * fqv[5]); qo.w = pk2(bflo(q.w) * fqv[6], bfhi(q.w) * fqv[7]);
                ko.x = pk2(bflo(k.x) * fkv[0], bfhi(k.x) * fkv[1]); ko.y = pk2(bflo(k.y) * fkv[2], bfhi(k.y) * fkv[3]); ko.z = pk2(bflo(k.z) * fkv[4], bfhi(k.z) * fkv[5]); ko.w = pk2(bflo(k.w) * fkv[6], bfhi(k.w) * fkv[7]);
                const size_t orow = (size_t)(row0 + base + tokl) * 256 + cg * 8;
                *(u32x4*)(QD + orow) = qo; *(u32x4*)(KD + orow) = ko;
            }
            __syncthreads();
        }
        TOT[(size_t)(ch * 2 + dr) * 256 + tid] = run;
    }
}

template <int DK>
DI void scan_item(KP p, int l, int item, unsigned char* smem) {
    constexpr bool ISA = (DK == 128);
    constexpr int QS = DK * 2 + 16, KS = DK * 2 + 32, VS = 96, AS_ = 144, SS = DK * 2 + 16, NKS = DK / 32, NMT = DK / 64;
    constexpr int O_QD = 0, O_KD = O_QD + 64 * QS, O_V = O_KD + 64 * KS, O_ATT = O_V + 64 * VS, O_ST = O_ATT + 64 * AS_, O_END = O_ST + 32 * SS;
    static_assert(O_END <= 65536, "scan LDS");
    constexpr int NP = DK / 64 * 2;
    constexpr int CPR = DK / 8;
    const int tid = TIDX(), wid = tid >> 6, lane = tid & 63, fr = lane & 15, fq = lane >> 4;
    const int b = item >> 5, h = (item >> 3) & 3, dir = (item >> 2) & 1, dvq = item & 3;
    const bf16_t* Z = (const bf16_t*)(p->ws + WS_Z);
    const bf16_t* QDg = (const bf16_t*)(p->ws + (dir ? WS_QDB : WS_QDF)); const bf16_t* KDg = QDg + (size_t)MT * 256; const float* TOT = (const float*)(p->ws + WS_TOT);
    bf16_t* OUT = (bf16_t*)(p->ws + (dir ? WS_OB : WS_OF));
    const int qcol = ISA ? h * 128 : 2048 + h * 64, kcol = ISA ? 512 + h * 128 : 2304 + h * 64, vcol = (ISA ? 1024 : 2560) + h * 128 + dvq * 32;
    const int ocol = (ISA ? 0 : 512) + h * 128 + dvq * 32;
    float lam = 0.f;
    if (ISA) lam = log1pf(-exp2f(-((dir ? 5.5f : 5.0f) + (float)h)));
    f32x4 S[NMT][2];
#pragma unroll
    for (int a = 0; a < NMT; ++a) { S[a][0] = (f32x4){0.f, 0.f, 0.f, 0.f}; S[a][1] = (f32x4){0.f, 0.f, 0.f, 0.f}; }
    __syncthreads();
    for (int i = tid; i < 32 * SS / 4; i += 256) ((unsigned*)(smem + O_ST))[i] = 0u;
    auto chunk_row0 = [&](int cc) -> int {
        const int ci = dir ? 35 - cc : cc; const int pp = ci * 64;
        if (!dir) return pp < 256 ? ML + b * 256 + pp : b * 2048 + (pp - 256);
        return pp < 2048 ? b * 2048 + pp : ML + b * 256 + (pp - 2048);
    };
    u32x4 rq[NP], rk[NP], rv; f32x4 tv[NMT];
    auto fetch = [&](int cc) {
        const int row0 = chunk_row0(cc);
        if (!ISA) {
#pragma unroll
            for (int a = 0; a < NMT; ++a) tv[a] = *(const f32x4*)(TOT + (size_t)((row0 >> 6) * 2 + dir) * 256 + h * 64 + (wid * NMT + a) * 16 + fq * 4);
        }
#pragma unroll
        for (int i = 0; i < NP; ++i) {
            const int id = tid + 256 * i, tok = id / CPR, cg_ = id % CPR;
            if (ISA) {
                const size_t ro = (size_t)(row0 + tok) * ZS;
                rq[i] = *(const u32x4*)(Z + ro + qcol + cg_ * 8); rk[i] = *(const u32x4*)(Z + ro + kcol + cg_ * 8);
            } else {
                const size_t eo = (size_t)(row0 + tok) * 256 + h * 64 + cg_ * 8;
                rq[i] = *(const u32x4*)(QDg + eo); rk[i] = *(const u32x4*)(KDg + eo);
            }
        }
        { const int tok = tid >> 2, cg_ = tid & 3; rv = *(const u32x4*)(Z + (size_t)(row0 + tok) * ZS + vcol + cg_ * 8); }
    };
    float ra[NP], rc[NP];
#pragma unroll
    for (int i = 0; i < NP; ++i) {
        const int tok = (tid + 256 * i) / CPR;
        ra[i] = dir ? __expf(lam * (float)(63 - tok)) : __expf(lam * (float)(tok + 1));
        rc[i] = dir ? __expf(-lam * (float)(64 - tok)) : __expf(-lam * (float)(tok + 1));
    }
    const float decA = __expf(lam * 64.0f);
    fetch(0);
    for (int cc = 0; cc < 36; ++cc) {
        const int row0 = chunk_row0(cc);
#pragma unroll
        for (int i = 0; i < NP; ++i) {
            const int id = tid + 256 * i, tok = id / CPR, cg_ = id % CPR;
            const u32x4 q = rq[i], k = rk[i]; u32x4 qo = q, ko = k;
            if (ISA) {
                const float fqv = ra[i], fkv = rc[i];
                qo.x = pk2(bflo(q.x) * fqv, bfhi(q.x) * fqv); qo.y = pk2(bflo(q.y) * fqv, bfhi(q.y) * fqv); qo.z = pk2(bflo(q.z) * fqv, bfhi(q.z) * fqv); qo.w = pk2(bflo(q.w) * fqv, bfhi(q.w) * fqv);
                ko.x = pk2(bflo(k.x) * fkv, bfhi(k.x) * fkv); ko.y = pk2(bflo(k.y) * fkv, bfhi(k.y) * fkv); ko.z = pk2(bflo(k.z) * fkv, bfhi(k.z) * fkv); ko.w = pk2(bflo(k.w) * fkv, bfhi(k.w) * fkv);
            }
            *(u32x4*)(smem + O_QD + tok * QS + cg_ * 16) = qo;
            *(u32x4*)(smem + O_KD + tok * KS + cg_ * 16) = ko;
        }
        { const int tok = tid >> 2, cg_ = tid & 3; *(u32x4*)(smem + O_V + tok * VS + cg_ * 16) = rv; }
        f32x4 dec[NMT];
#pragma unroll
        for (int a = 0; a < NMT; ++a) {
            if (ISA) dec[a] = (f32x4){decA, decA, decA, decA};
            else dec[a] = (f32x4){__expf(tv[a][0]), __expf(tv[a][1]), __expf(tv[a][2]), __expf(tv[a][3])};
        }
        if (cc + 1 < 36) fetch(cc + 1);
        __syncthreads();
        bf16x8 afr[2];
        {
            f32x4 at[4];
#pragma unroll
            for (int n = 0; n < 4; ++n) at[n] = (f32x4){0.f, 0.f, 0.f, 0.f};
#pragma unroll
            for (int ks = 0; ks < NKS; ++ks) {
                const bf16x8 qf = *(const bf16x8*)(smem + O_QD + (16 * wid + fr) * QS + (32 * ks + 8 * fq) * 2);
#pragma unroll
                for (int n = 0; n < 4; ++n) {
                    const bf16x8 kf = *(const bf16x8*)(smem + O_KD + (16 * n + fr) * KS + (32 * ks + 8 * fq) * 2);
                    at[n] = __builtin_amdgcn_mfma_f32_16x16x32_bf16(kf, qf, at[n], 0, 0, 0);
                }
            }
            const int i = 16 * wid + fr;
#pragma unroll
            for (int n = 0; n < 4; ++n)
#pragma unroll
                for (int jj = 0; jj < 4; ++jj) { const int j = n * 16 + fq * 4 + jj; const bool keep = dir ? (j > i) : (j <= i); at[n][jj] = keep ? at[n][jj] : 0.f; }
#pragma unroll
            for (int ks = 0; ks < 2; ++ks) {
                u32x4 w; w.x = pk2(at[2 * ks][0], at[2 * ks][1]); w.y = pk2(at[2 * ks][2], at[2 * ks][3]); w.z = pk2(at[2 * ks + 1][0], at[2 * ks + 1][1]); w.w = pk2(at[2 * ks + 1][2], at[2 * ks + 1][3]);
                afr[ks] = __builtin_bit_cast(bf16x8, w);
            }
        }
        bf16x8 vf[2][2];
        {
            const int g = lane >> 4, i16 = lane & 15, q = i16 >> 2, pq = i16 & 3;
#pragma unroll
            for (int ks = 0; ks < 2; ++ks)
#pragma unroll
                for (int n = 0; n < 2; ++n) {
                    const unsigned char* a = smem + O_V + (32 * ks + 4 * g + q) * VS + (n * 16 + 4 * pq) * 2;
                    vf[ks][n] = cat8(tr_read(a), tr_read(a + 16 * VS));
                }
        }
        {
            f32x4 oa[2] = {(f32x4){0.f, 0.f, 0.f, 0.f}, (f32x4){0.f, 0.f, 0.f, 0.f}};
#pragma unroll
            for (int ks = 0; ks < 2; ++ks)
#pragma unroll
                for (int n = 0; n < 2; ++n) oa[n] = __builtin_amdgcn_mfma_f32_16x16x32_bf16(vf[ks][n], afr[ks], oa[n], 0, 0, 0);
#pragma unroll
            for (int ks = 0; ks < NKS; ++ks) {
                const bf16x8 qf = *(const bf16x8*)(smem + O_QD + (16 * wid + fr) * QS + (32 * ks + 8 * fq) * 2);
#pragma unroll
                for (int n = 0; n < 2; ++n) {
                    const bf16x8 sf = *(const bf16x8*)(smem + O_ST + (16 * n + fr) * SS + (32 * ks + 8 * fq) * 2);
                    oa[n] = __builtin_amdgcn_mfma_f32_16x16x32_bf16(sf, qf, oa[n], 0, 0, 0);
                }
            }
            bf16_t* o = OUT + (size_t)(row0 + 16 * wid + fr) * 1024 + ocol + fq * 4;
            u32x2 w0, w1; w0.x = pk2(oa[0][0], oa[0][1]); w0.y = pk2(oa[0][2], oa[0][3]); w1.x = pk2(oa[1][0], oa[1][1]); w1.y = pk2(oa[1][2], oa[1][3]);
            *(u32x2*)(o) = w0; *(u32x2*)(o + 16) = w1;
        }
        {
            const int g = lane >> 4, i16 = lane & 15, q = i16 >> 2, pq = i16 & 3;
#pragma unroll
            for (int a = 0; a < NMT; ++a) {
                const int mt = wid * NMT + a;
#pragma unroll
                for (int ks = 0; ks < 2; ++ks) {
                    const unsigned char* ka = smem + O_KD + (32 * ks + 4 * g + q) * KS + (mt * 16 + 4 * pq) * 2;
                    const bf16x8 kf = cat8(tr_read(ka), tr_read(ka + 16 * KS));
#pragma unroll
                    for (int n = 0; n < 2; ++n) S[a][n] = __builtin_amdgcn_mfma_f32_16x16x32_bf16(kf, vf[ks][n], S[a][n], 0, 0, 0);
                }
                S[a][0] *= dec[a]; S[a][1] *= dec[a];
            }
        }
        __syncthreads();
#pragma unroll
        for (int a = 0; a < NMT; ++a) {
            const int mt = wid * NMT + a;
#pragma unroll
            for (int n = 0; n < 2; ++n) { u32x2 w; w.x = pk2(S[a][n][0], S[a][n][1]); w.y = pk2(S[a][n][2], S[a][n][3]); *(u32x2*)(smem + O_ST + (n * 16 + fr) * SS + (mt * 16 + fq * 4) * 2) = w; }
        }
    }
    __syncthreads();
}
DI void phase_scan(KP p, int l, unsigned char* smem) {
    for (int it = BIDX(); it < 512; it += gridDim.x) {
        if (it < 256) scan_item<128>(p, l, it, smem); else scan_item<64>(p, l, it - 256, smem);
    }
}

DI void phase_merge(KP p, int l) {
    const int tid = TIDX(), wave = tid >> 6, lane = tid & 63;
    const int li = l >> 1;
    const bf16_t* OF = (const bf16_t*)(p->ws + WS_OF); const bf16_t* OB = (const bf16_t*)(p->ws + WS_OB);
    const bf16_t* Z = (const bf16_t*)(p->ws + WS_Z); bf16_t* Y = (bf16_t*)(p->ws + WS_Y);
    const bool isA = lane < 32;
    const float* gn = isA ? p->in[15] + li * 512 + lane * 16 : p->in[16] + li * 512 + (lane - 32) * 16;
    const int gcol = isA ? 1536 + lane * 16 : 3072 + (lane - 32) * 16;
    for (int row = BIDX() * 4 + wave; row < MT; row += gridDim.x * 4) {
        float o[16]; float s = 0.f;
#pragma unroll
        for (int j = 0; j < 2; ++j) {
            const u32x4 a = *(const u32x4*)(OF + (size_t)row * 1024 + lane * 16 + j * 8), bb = *(const u32x4*)(OB + (size_t)row * 1024 + lane * 16 + j * 8);
            o[j * 8 + 0] = bflo(a.x) + bflo(bb.x); o[j * 8 + 1] = bfhi(a.x) + bfhi(bb.x); o[j * 8 + 2] = bflo(a.y) + bflo(bb.y); o[j * 8 + 3] = bfhi(a.y) + bfhi(bb.y);
            o[j * 8 + 4] = bflo(a.z) + bflo(bb.z); o[j * 8 + 5] = bfhi(a.z) + bfhi(bb.z); o[j * 8 + 6] = bflo(a.w) + bflo(bb.w); o[j * 8 + 7] = bfhi(a.w) + bfhi(bb.w);
        }
#pragma unroll
        for (int e = 0; e < 16; ++e) s += o[e];
        s += __shfl_xor(s, 1); s += __shfl_xor(s, 2); s += __shfl_xor(s, 4);
        const float mean = isA ? s * (1.0f / 128.0f) : 0.f;
        float s2 = 0.f;
#pragma unroll
        for (int e = 0; e < 16; ++e) { o[e] -= mean; s2 += o[e] * o[e]; }
        s2 += __shfl_xor(s2, 1); s2 += __shfl_xor(s2, 2); s2 += __shfl_xor(s2, 4);
        const float rs = 1.0f / sqrtf(s2 * (1.0f / 128.0f) + LN_EPS);
        const u32x4 g0 = *(const u32x4*)(Z + (size_t)row * ZS + gcol), g1 = *(const u32x4*)(Z + (size_t)row * ZS + gcol + 8);
        float gt[16];
        gt[0] = bflo(g0.x); gt[1] = bfhi(g0.x); gt[2] = bflo(g0.y); gt[3] = bfhi(g0.y); gt[4] = bflo(g0.z); gt[5] = bfhi(g0.z); gt[6] = bflo(g0.w); gt[7] = bfhi(g0.w);
        gt[8] = bflo(g1.x); gt[9] = bfhi(g1.x); gt[10] = bflo(g1.y); gt[11] = bfhi(g1.y); gt[12] = bflo(g1.z); gt[13] = bfhi(g1.z); gt[14] = bflo(g1.w); gt[15] = bfhi(g1.w);
        float y[16];
#pragma unroll
        for (int e = 0; e < 16; ++e) y[e] = siluf(gt[e]) * (o[e] * rs * gn[e]);
        u32x4 w0, w1;
        w0.x = pk2(y[0], y[1]); w0.y = pk2(y[2], y[3]); w0.z = pk2(y[4], y[5]); w0.w = pk2(y[6], y[7]);
        w1.x = pk2(y[8], y[9]); w1.y = pk2(y[10], y[11]); w1.z = pk2(y[12], y[13]); w1.w = pk2(y[14], y[15]);
        *(u32x4*)(Y + (size_t)row * 1024 + lane * 16) = w0; *(u32x4*)(Y + (size_t)row * 1024 + lane * 16 + 8) = w1;
    }
}

DI int crow(int r, int hi) { return (r & 3) + 8 * (r >> 2) + 4 * hi; }
constexpr int ATT_BUF = 24576;
DI void att_component(const bf16_t* Qc, const bf16_t* Kc, const bf16_t* Vt, unsigned char* smem, float* wsf, int b, int h, int comp, int p0, int nkv, f32x16 (&O)[4]) {
    const int tid = TIDX(), wid = tid >> 6, lane = tid & 63, r32 = lane & 31, hi = lane >> 5;
    const int hc = h * 2 + comp;
    const bf16_t* Qb = Qc + ((size_t)(b * 16 + hc) * TA + p0 + wid * 32 + r32) * 64;
    const int gch = gemm_chunk(tid);
    const bf16_t* Kg = Kc + (size_t)(b * 16 + hc) * TA * 64 + (size_t)(tid >> 3) * 64 + gch * 8;
    const bf16_t* Vg = Vt + (size_t)(b * 8 + h) * 128 * TA + (size_t)(tid >> 3) * TA + gch * 8;
#define ATT_STAGE(buf, kt) do { \
        _Pragma("unroll") for (int i_ = 0; i_ < 2; ++i_) __builtin_amdgcn_global_load_lds((const unsigned*)(Kg + (size_t)((kt) + 32 * i_) * 64), (LAS unsigned*)(smem + (buf) * ATT_BUF + i_ * 4096 + tid * 16), 16, 0, 0); \
        _Pragma("unroll") for (int i_ = 0; i_ < 4; ++i_) __builtin_amdgcn_global_load_lds((const unsigned*)(Vg + (size_t)(32 * i_) * TA + (kt)), (LAS unsigned*)(smem + (buf) * ATT_BUF + 8192 + i_ * 4096 + tid * 16), 16, 0, 0); } while (0)
    ATT_STAGE(0, 0);
    bf16x8 qf[4];
#pragma unroll
    for (int ks = 0; ks < 4; ++ks) qf[ks] = *(const bf16x8*)(Qb + ks * 16 + hi * 8);
#pragma unroll
    for (int d0 = 0; d0 < 4; ++d0)
#pragma unroll
        for (int r = 0; r < 16; ++r) O[d0][r] = 0.f;
    float m_run = -1.0e30f, l_run = 0.f;
    const int sw = (r32 >> 1) & 7;
    const int nt = nkv >> 6;
    for (int t = 0; t < nt; ++t) {
        asm volatile("s_waitcnt vmcnt(0)" ::: "memory");
        __syncthreads();
        if (t + 1 < nt) ATT_STAGE((t + 1) & 1, (t + 1) * 64);
        const unsigned char* Kt = smem + (t & 1) * ATT_BUF; const unsigned char* Vtl = Kt + 8192;
        bf16x8 kf0[4], kf1[4];
#pragma unroll
        for (int ks = 0; ks < 4; ++ks) {
            const unsigned co = (unsigned)(((ks * 2 + hi) ^ sw) << 4);
            kf0[ks] = *(const bf16x8*)(Kt + r32 * 128 + co);
            kf1[ks] = *(const bf16x8*)(Kt + (32 + r32) * 128 + co);
        }
        const unsigned char* vr = Vtl + r32 * 128;
#define ATT_VLOAD(dst, st_) do { const unsigned o1_ = (unsigned)((((st_) * 2 + hi) ^ sw) << 4); \
        _Pragma("unroll") for (int d0_ = 0; d0_ < 4; ++d0_) dst[d0_] = *(const bf16x8*)(vr + d0_ * 4096 + o1_); } while (0)
        bf16x8 va[4], vb[4];
        ATT_VLOAD(va, 0);
        f32x16 s0, s1;
#pragma unroll
        for (int r = 0; r < 16; ++r) { s0[r] = 0.f; s1[r] = 0.f; }
#pragma unroll
        for (int ks = 0; ks < 4; ++ks) {
            s0 = __builtin_amdgcn_mfma_f32_32x32x16_bf16(kf0[ks], qf[ks], s0, 0, 0, 0);
            s1 = __builtin_amdgcn_mfma_f32_32x32x16_bf16(kf1[ks], qf[ks], s1, 0, 0, 0);
        }
        float mxa[8];
#pragma unroll
        for (int i_ = 0; i_ < 8; ++i_) mxa[i_] = fmaxf(fmaxf(s0[2 * i_], s0[2 * i_ + 1]), fmaxf(s1[2 * i_], s1[2 * i_ + 1]));
        float mx = fmaxf(fmaxf(fmaxf(mxa[0], mxa[1]), fmaxf(mxa[2], mxa[3])), fmaxf(fmaxf(mxa[4], mxa[5]), fmaxf(mxa[6], mxa[7])));
        { const auto rr = __builtin_amdgcn_permlane32_swap(__float_as_uint(mx), __float_as_uint(mx), false, false); mx = fmaxf(__uint_as_float(rr[0]), __uint_as_float(rr[1])); }
        if (__any(mx > m_run + 8.0f)) {
            const float m_new = fmaxf(m_run, mx);
            const float alpha = __builtin_amdgcn_exp2f((m_run - m_new) * L2E);
            l_run *= alpha; m_run = m_new;
            if (hi == 0) wsf[r32] = alpha;
            asm volatile("s_waitcnt lgkmcnt(0)" ::: "memory");
            float ar[16];
#pragma unroll
            for (int r = 0; r < 16; ++r) ar[r] = wsf[crow(r, hi)];
#pragma unroll
            for (int d0 = 0; d0 < 4; ++d0)
#pragma unroll
                for (int r = 0; r < 16; ++r) O[d0][r] *= ar[r];
            asm volatile("s_waitcnt lgkmcnt(0)" ::: "memory");
        }
        const float mb = m_run * L2E;
        float ps = 0.f;
#pragma unroll
        for (int r = 0; r < 16; ++r) { s0[r] = __builtin_amdgcn_exp2f(s0[r] * L2E - mb); s1[r] = __builtin_amdgcn_exp2f(s1[r] * L2E - mb); ps += s0[r] + s1[r]; }
        l_run += ps;
        u32x4 pw[4];
#pragma unroll
        for (int s = 0; s < 2; ++s) {
            pw[s].x = pk2(s0[8 * s + 0], s0[8 * s + 1]); pw[s].y = pk2(s0[8 * s + 2], s0[8 * s + 3]); pw[s].z = pk2(s0[8 * s + 4], s0[8 * s + 5]); pw[s].w = pk2(s0[8 * s + 6], s0[8 * s + 7]);
            pw[2 + s].x = pk2(s1[8 * s + 0], s1[8 * s + 1]); pw[2 + s].y = pk2(s1[8 * s + 2], s1[8 * s + 3]); pw[2 + s].z = pk2(s1[8 * s + 4], s1[8 * s + 5]); pw[2 + s].w = pk2(s1[8 * s + 6], s1[8 * s + 7]);
        }
#pragma unroll
        ATT_VLOAD(vb, 1);
#pragma unroll
        for (int d0 = 0; d0 < 4; ++d0) O[d0] = __builtin_amdgcn_mfma_f32_32x32x16_bf16(__builtin_bit_cast(bf16x8, pw[0]), va[d0], O[d0], 0, 0, 0);
        ATT_VLOAD(va, 2);
#pragma unroll
        for (int d0 = 0; d0 < 4; ++d0) O[d0] = __builtin_amdgcn_mfma_f32_32x32x16_bf16(__builtin_bit_cast(bf16x8, pw[1]), vb[d0], O[d0], 0, 0, 0);
        ATT_VLOAD(vb, 3);
#pragma unroll
        for (int d0 = 0; d0 < 4; ++d0) O[d0] = __builtin_amdgcn_mfma_f32_32x32x16_bf16(__builtin_bit_cast(bf16x8, pw[2]), va[d0], O[d0], 0, 0, 0);
#pragma unroll
        for (int d0 = 0; d0 < 4; ++d0) O[d0] = __builtin_amdgcn_mfma_f32_32x32x16_bf16(__builtin_bit_cast(bf16x8, pw[3]), vb[d0], O[d0], 0, 0, 0);
#undef ATT_VLOAD
    }
#undef ATT_STAGE
    l_run += __shfl_xor(l_run, 32);
    asm volatile("s_waitcnt lgkmcnt(0)" ::: "memory");
    if (hi == 0) wsf[r32] = 1.0f / l_run;
    asm volatile("s_waitcnt lgkmcnt(0)" ::: "memory");
    float ar[16];
#pragma unroll
    for (int r = 0; r < 16; ++r) ar[r] = wsf[crow(r, hi)];
    asm volatile("s_waitcnt lgkmcnt(0)" ::: "memory");
#pragma unroll
    for (int d0 = 0; d0 < 4; ++d0)
#pragma unroll
        for (int r = 0; r < 16; ++r) O[d0][r] *= ar[r];
}

DI void phase_att(KP p, int l, unsigned char* smem) {
    constexpr int O_WS = 2 * ATT_BUF;
    const int tid = TIDX(), wid = tid >> 6, lane = tid & 63, r32 = lane & 31, hi = lane >> 5;
    const int li = l >> 1;
    const bf16_t* Qc = (const bf16_t*)(p->ws + WS_QC); const bf16_t* Kc = (const bf16_t*)(p->ws + WS_KC); const bf16_t* Vt = (const bf16_t*)(p->ws + WS_VT);
    bf16_t* Y = (bf16_t*)(p->ws + WS_Y);
    float* stash = (float*)(p->ws + WS_P) + ((size_t)BIDX() * 256 + tid) * 32;
    const float lam_init = 0.8f - 0.6f * expf(-0.3f * (float)l);
    float* wsf = (float*)(smem + O_WS) + wid * 32;
    const int per_x = (l == 3) ? 128 : 144;
    for (int i = 0;; ++i) {
        int b, h, p0, nkv;
        {
            const int G = gridDim.x, bid = BIDX();
            int item;
            if ((G & 7) == 0) { const int x = bid & 7, q = i * (G >> 3) + (bid >> 3); if (q >= per_x) break; item = q < 128 ? x * 128 + q : 1024 + x * 16 + (q - 128); }
            else { item = i * G + bid; if (item >= 8 * per_x) break; }
            if (item < 1024) { b = item >> 7; h = (item >> 4) & 7; p0 = 256 + (item & 15) * 128; nkv = TA; }
            else { const int q = item - 1024; b = q >> 4; h = (q >> 1) & 7; p0 = (q & 1) * 128; nkv = TC; }
        }
        float d1 = 0.f, d2 = 0.f;
        { const float* lq1 = p->in[19] + (li * 8 + h) * 64, *lk1 = p->in[20] + (li * 8 + h) * 64, *lq2 = p->in[21] + (li * 8 + h) * 64, *lk2 = p->in[22] + (li * 8 + h) * 64;
          d1 = wave_sum(lq1[lane] * lk1[lane]); d2 = wave_sum(lq2[lane] * lk2[lane]); }
        const float lamv = expf(d1) - expf(d2) + lam_init;
        f32x16 On[4];
        __syncthreads();
        att_component(Qc, Kc, Vt, smem, wsf, b, h, 0, p0, nkv, On);
#pragma unroll
        for (int d0 = 0; d0 < 4; ++d0)
#pragma unroll
            for (int r = 0; r < 16; r += 8) {
                u32x4 w; w.x = pk2(On[d0][r], On[d0][r + 1]); w.y = pk2(On[d0][r + 2], On[d0][r + 3]); w.z = pk2(On[d0][r + 4], On[d0][r + 5]); w.w = pk2(On[d0][r + 6], On[d0][r + 7]);
                *(u32x4*)(stash + (d0 * 16 + r) / 2) = w;
            }
        __syncthreads();
        att_component(Qc, Kc, Vt, smem, wsf, b, h, 1, p0, nkv, On);
#pragma unroll
        for (int d0 = 0; d0 < 4; ++d0)
#pragma unroll
            for (int r = 0; r < 16; r += 8) {
                const u32x4 w = *(const u32x4*)(stash + (d0 * 16 + r) / 2);
                On[d0][r] = bflo(w.x) - lamv * On[d0][r]; On[d0][r + 1] = bfhi(w.x) - lamv * On[d0][r + 1]; On[d0][r + 2] = bflo(w.y) - lamv * On[d0][r + 2]; On[d0][r + 3] = bfhi(w.y) - lamv * On[d0][r + 3];
                On[d0][r + 4] = bflo(w.z) - lamv * On[d0][r + 4]; On[d0][r + 5] = bfhi(w.z) - lamv * On[d0][r + 5]; On[d0][r + 6] = bflo(w.w) - lamv * On[d0][r + 6]; On[d0][r + 7] = bfhi(w.w) - lamv * On[d0][r + 7];
            }
        float ms[16];
#pragma unroll
        for (int r = 0; r < 16; ++r) {
            float s = (On[0][r] * On[0][r] + On[1][r] * On[1][r]) + (On[2][r] * On[2][r] + On[3][r] * On[3][r]);
            s += __shfl_xor(s, 1); s += __shfl_xor(s, 2); s += __shfl_xor(s, 4); s += __shfl_xor(s, 8); s += __shfl_xor(s, 16);
            ms[r] = __builtin_amdgcn_rsqf(s * (1.0f / 128.0f) + LN_EPS);
        }
        const float* sg = p->in[23] + li * 1024 + h * 128;
        const float post = 1.0f - lam_init;
        float gsc[4];
#pragma unroll
        for (int d0 = 0; d0 < 4; ++d0) gsc[d0] = sg[d0 * 32 + r32] * post;
        __syncthreads();
        unsigned char* stg = smem + wid * 8192;
#pragma unroll
        for (int r = 0; r < 16; ++r) {
            unsigned char* sp = stg + crow(r, hi) * 256 + r32 * 2;
#pragma unroll
            for (int d0 = 0; d0 < 4; ++d0) *(unsigned short*)(sp + d0 * 64) = (unsigned short)f2bf(On[d0][r] * ms[r] * gsc[d0]);
        }
        asm volatile("s_waitcnt lgkmcnt(0)" ::: "memory");
#pragma unroll
        for (int i2 = 0; i2 < 8; ++i2) {
            const int id = lane + 64 * i2, qr = id >> 4, ch = id & 15;
            const int pq = p0 + wid * 32 + qr;
            const int row = pq < 256 ? ML + b * 256 + pq : b * 2048 + (pq - 256);
            *(u32x4*)(Y + (size_t)row * 1024 + h * 128 + ch * 8) = *(const u32x4*)(stg + qr * 256 + ch * 16);
        }
        asm volatile("s_waitcnt lgkmcnt(0)" ::: "memory");
    }
}

#define XB_TMO      128
#define XB_XCNT(j)  (256  + 64 * (j))
#define XB_XSUB(j)  (1280 + 64 * (j))
#define XB_XGEN(j)  (2304 + 64 * (j))
#define XB_TOP      3328
#define XB_TOPGEN   3392
#define XCD_BAR_WORDS 3456
#define XB_SPIN_CAP (1u << 22)
DI unsigned xb_ld(unsigned* p)              { return __hip_atomic_load(p, __ATOMIC_RELAXED, __HIP_MEMORY_SCOPE_AGENT); }
DI unsigned xb_add(unsigned* p, unsigned v) { return __hip_atomic_fetch_add(p, v, __ATOMIC_RELAXED, __HIP_MEMORY_SCOPE_AGENT); }
DI unsigned xb_xcc_id() { return (unsigned)__builtin_amdgcn_s_getreg((3 << 11) | 20) & 0xFu; }
#define XB_SPIN(cond, bar) do { unsigned _sp = 0; while (cond) { __builtin_amdgcn_s_sleep(1); \
    if ((++_sp & 255u) == 0u) { if (xb_ld(&(bar)[XB_TMO])) break; if (_sp > XB_SPIN_CAP) { atomicAdd(&(bar)[XB_TMO], 1u); break; } } } } while (0)
struct XcdBarrier { unsigned* bar; unsigned x; volatile LAS unsigned* st; };
DI XcdBarrier xcd_barrier_post(unsigned* bar, volatile LAS unsigned* st) {
    XcdBarrier b; b.bar = bar; b.x = xb_xcc_id(); b.st = st;
    if (threadIdx.x == 0) (void)xb_add(&bar[XB_XCNT(b.x)], 1u);
    return b;
}
DI void xcd_barrier_complete(unsigned* bar, unsigned x, unsigned& nloc, unsigned& nx) {
    const unsigned G = gridDim.x * gridDim.y * gridDim.z;
    unsigned sum, cnt, mine, sp = 0u;
    for (;;) {
        sum = 0u; cnt = 0u; mine = 0u;
#pragma unroll
        for (unsigned j = 0; j < 16; ++j) { const unsigned c = xb_ld(&bar[XB_XCNT(j)]); sum += c; cnt += (c > 0u) ? 1u : 0u; mine = (j == x) ? c : mine; }
        if (sum == G) break;
        __builtin_amdgcn_s_sleep(1);
        if ((++sp & 255u) == 0u) { if (xb_ld(&bar[XB_TMO])) break; if (sp > XB_SPIN_CAP) { atomicAdd(&bar[XB_TMO], 1u); break; } }
    }
    nloc = mine > 0u ? mine : 1u; nx = cnt > 0u ? cnt : 1u;
}
DI void xcd_barrier(const XcdBarrier& b) {
    asm volatile("s_waitcnt vmcnt(0)" ::: "memory");
    __syncthreads();
    if (threadIdx.x == 0) {
        unsigned* bar = b.bar;
        __builtin_amdgcn_s_waitcnt(0);
        unsigned nloc = b.st[0], nx = b.st[1];
        if (nloc == 0u) { xcd_barrier_complete(bar, b.x, nloc, nx); b.st[0] = nloc; b.st[1] = nx; }
        const unsigned old = xb_add(&bar[XB_XSUB(b.x)], 1u);
        const unsigned gen = old / nloc;
        if (old + 1u == (gen + 1u) * nloc) {
            __builtin_amdgcn_fence(__ATOMIC_RELEASE, "agent");
            asm volatile("s_waitcnt vmcnt(0)" ::: "memory");
            const unsigned og = xb_add(&bar[XB_TOP], 1u);
            const unsigned tg = og / nx;
            if (og + 1u == (tg + 1u) * nx) xb_add(&bar[XB_TOPGEN], 1u);
            else XB_SPIN(xb_ld(&bar[XB_TOPGEN]) == tg, bar);
            __builtin_amdgcn_fence(__ATOMIC_ACQUIRE, "agent");
            xb_add(&bar[XB_XGEN(b.x)], 1u);
            asm volatile("s_waitcnt vmcnt(0)" ::: "memory");
        } else {
            XB_SPIN(xb_ld(&bar[XB_XGEN(b.x)]) == gen, bar);
            __builtin_amdgcn_fence(__ATOMIC_ACQUIRE, "agent");
            asm volatile("s_waitcnt vmcnt(0)" ::: "memory");
        }
    }
    __syncthreads();
}

#ifdef DOUBLE_MASK
#define DRYCOND (rep_ == 0 && nrep_ == 2)
#else
#define DRYCOND false
#endif
constexpr int NPHASE = 34;
constexpr int LDS_BYTES = 65536 + 1024;
__global__ void __launch_bounds__(256, 2) mega(Params pv) {
    extern __shared__ __attribute__((aligned(16))) unsigned char smem[];
    const int ph_lo = pv.ph_lo, ph_hi = pv.ph_hi;
    volatile LAS unsigned* bar_st = (volatile LAS unsigned*)(LAS unsigned char*)(smem + 65536);
    if (threadIdx.x == 0) { bar_st[0] = 0u; bar_st[1] = 0u; }
    __syncthreads();
    XcdBarrier xbar = xcd_barrier_post((unsigned*)(pv.ws + WS_CTL) + 4096, bar_st);
    for (int ph = ph_lo; ph < ph_hi; ++ph) {
        KP p = (KP)__builtin_amdgcn_kernarg_segment_ptr();
        asm volatile("" : "+s"(p) :: "memory");
#ifdef DOUBLE_MASK
        int kind_;
        if (ph == 0) kind_ = 0; else if (ph == 1) kind_ = 1;
        else { const int rem_ = (ph - 2) % 16; kind_ = rem_ == 0 ? 2 : (rem_ == 1 ? 12 : (rem_ < 9 ? rem_ + 1 : (rem_ == 9 ? 10 : (rem_ == 10 ? 11 : (rem_ - 11 + 5))))); }
        const int nrep_ = ((DOUBLE_MASK >> kind_) & 1) ? 2 : 1;
        for (int rep_ = 0; rep_ < nrep_; ++rep_) {
        if (rep_) xcd_barrier(xbar);
#endif
        if (ph == 0) phase_pre0(p, smem);
        else if (ph == 1) phase_pre1(p);
        else {
            const int q = ph - 2, lp = q / 16, rem = q % 16;
            if (rem < 9) {
                const int l = 2 * lp;
                switch (rem) {
                    case 0: phase_g1e(p, l, smem); break;
                    case 1: phase_decay(p, l, smem); break;
                    case 2: phase_scan(p, l, smem); break;
                    case 3: phase_merge(p, l); break;
                    case 4: phase_g2(p, l, smem); break;
                    case 5: if (DRYCOND) phase_ln1r<true>(p, l, smem); else phase_ln1r<false>(p, l, smem); break;
                    case 6: phase_mg1(p, l, smem); break;
                    case 7: phase_mg2(p, l, smem); break;
                    default: if (DRYCOND) phase_ln2<true>(p, l); else phase_ln2<false>(p, l); break;
                }
            } else {
                const int l = 2 * lp + 1;
                switch (rem - 9) {
                    case 0: phase_g1o(p, l, smem); break;
                    case 1: phase_att(p, l, smem); break;
                    case 2: phase_g2(p, l, smem); break;
                    case 3: if (DRYCOND) phase_ln1r<true>(p, l, smem); else phase_ln1r<false>(p, l, smem); break;
                    case 4: phase_mg1(p, l, smem); break;
                    case 5: phase_mg2(p, l, smem); break;
                    default: if (DRYCOND) phase_ln2<true>(p, l); else phase_ln2<false>(p, l); break;
                }
            }
        }
#ifdef DOUBLE_MASK
        }
#endif
        if (ph + 1 < ph_hi) xcd_barrier(xbar);
    }
}

extern "C" void kernel_launch(void* const* d_in, const int* in_sizes, int n_in, void* d_out, int out_size, void* d_ws, size_t ws_size, hipStream_t stream) {
    static int grid_blocks = 0;
    if (grid_blocks == 0) {
        if (n_in != 32 || ws_size < WS_END) { fprintf(stderr, "kernel_launch: unexpected n_in %d or ws_size %zu\n", n_in, ws_size); grid_blocks = -1; return; }
        int dev = 0, cus = 0, per_cu = 0;
        hipGetDevice(&dev);
        hipDeviceGetAttribute(&cus, hipDeviceAttributeMultiprocessorCount, dev);
        hipFuncSetAttribute((const void*)mega, hipFuncAttributeMaxDynamicSharedMemorySize, LDS_BYTES);
        hipOccupancyMaxActiveBlocksPerMultiprocessor(&per_cu, mega, 256, LDS_BYTES);
        if (per_cu > 2) per_cu = 2;
        if (per_cu < 1) per_cu = 1;
        grid_blocks = cus * per_cu;
    }
    if (grid_blocks < 0) return;
    hipMemsetAsync((char*)d_ws + WS_CTL, 0, 32768, stream);
    Params p{};
    for (int i = 0; i < 32; ++i) p.in[i] = (const float*)d_in[i];
    p.out = (float*)d_out; p.ws = (unsigned char*)d_ws;
#if N_LAUNCH_MODE == 1
    p.ph_lo = 0; p.ph_hi = NPHASE;
    void* args[] = {&p};
    hipError_t e = hipLaunchCooperativeKernel((void*)mega, dim3(grid_blocks), dim3(256), args, LDS_BYTES, stream);
    if (e != hipSuccess) fprintf(stderr, "cooperative launch failed: %s (grid %d)\n", hipGetErrorString(e), grid_blocks);
#else
    for (int ph = 0; ph < NPHASE; ++ph) {
        p.ph_lo = ph; p.ph_hi = ph + 1;
        hipLaunchKernelGGL(mega, dim3(grid_blocks), dim3(256), LDS_BYTES, stream, p);
    }
#endif
}
```

```cpp
#include <hip/hip_runtime.h>
#include <hip/hip_cooperative_groups.h>
#include <cstdio>
#include <cstdint>
namespace cg = cooperative_groups;

#ifndef N_LAUNCH_MODE
#define N_LAUNCH_MODE 1
#endif

#define DI __device__ __forceinline__
#define LAS __attribute__((address_space(3)))
typedef unsigned short bf16_t;
typedef short bf16x8 __attribute__((ext_vector_type(8)));
typedef short s16x4 __attribute__((ext_vector_type(4)));
typedef float f32x4 __attribute__((ext_vector_type(4)));
typedef float f32x16 __attribute__((ext_vector_type(16)));
typedef unsigned u32x4 __attribute__((ext_vector_type(4)));
typedef unsigned u32x2 __attribute__((ext_vector_type(2)));

constexpr int D = 1024, NB = 8, T = 2048, TC = 256, TA = T + TC;
constexpr int ML = NB * T, MC = NB * TC, MT = ML + MC;
constexpr int NIN = 3616, NINP = 3712, ZS = 3712;
constexpr int NSLOT = 2 * MT;
constexpr float LN_EPS = 1e-5f;
constexpr float ALPHA = 1.6817928305074290f;
constexpr float L2E = 1.4426950408889634f;

constexpr size_t MiB = 1ull << 20;
constexpr size_t WS_CTL = 0;
constexpr int CNT_WORD0 = 32768;
constexpr int CNT_STRIDE = 1088;
constexpr size_t WS_MOD = 1 * MiB;
constexpr size_t WS_ROPEA = 2 * MiB;
constexpr size_t WS_ROPEC = 3 * MiB;
constexpr size_t WS_LR = 4 * MiB;
constexpr size_t WS_SLOTW = 7 * MiB;
constexpr size_t WS_LIST = 8 * MiB;
constexpr size_t WS_WRT = 13 * MiB;
constexpr size_t WS_WIN = 16 * MiB;
constexpr size_t WS_WABO = 32 * MiB;
constexpr size_t WS_WQKV = 36 * MiB;
constexpr size_t WS_WCO = 48 * MiB;
constexpr size_t WS_WGU = 64 * MiB;
constexpr size_t WS_WD = 320 * MiB;
constexpr size_t WS_X = 448 * MiB;
constexpr size_t WS_U = 520 * MiB;
constexpr size_t WS_Y = 556 * MiB;
constexpr size_t WS_Z = 592 * MiB;
constexpr size_t WS_O = 724 * MiB;
constexpr size_t WS_QDF = 868 * MiB, WS_QDB = 886 * MiB, WS_TOT = 922 * MiB;
constexpr size_t WS_END = 923 * MiB;
constexpr size_t WS_QC = WS_Z, WS_KC = WS_Z + 36 * MiB, WS_VT = WS_Z + 72 * MiB;
constexpr size_t WS_YS = WS_Z;
constexpr size_t WS_OF = WS_O, WS_OB = WS_O + 72 * MiB, WS_P = WS_O, WS_H = WS_O + 72 * MiB;

#ifndef XBF16
#define XBF16 0
#endif
#if XBF16
typedef bf16_t xres_t;
#else
typedef float xres_t;
#endif
struct Params { const float* in[32]; float* out; unsigned char* ws; int ph_lo, ph_hi; };
typedef const __attribute__((address_space(4))) Params* KP;

DI int TIDX() { int t = threadIdx.x; asm volatile("" : "+v"(t)); return t; }
DI int BIDX() { int b = blockIdx.x; asm volatile("" : "+s"(b)); return b; }
DI unsigned pk2(float lo, float hi);
DI unsigned f2bf(float f) { return pk2(f, 0.f) & 0xffffu; }
typedef float f32x2_t __attribute__((ext_vector_type(2))); typedef __bf16 bf16x2_t __attribute__((ext_vector_type(2)));
DI unsigned pk2(float lo, float hi) { f32x2_t v = {lo, hi}; bf16x2_t b = __builtin_convertvector(v, bf16x2_t); return __builtin_bit_cast(unsigned, b); }
DI float bflo(unsigned w) { return __uint_as_float(w << 16); }
DI float bfhi(unsigned w) { return __uint_as_float(w & 0xffff0000u); }
DI f32x4 xload(const xres_t* p) {
#if XBF16
    const u32x2 w = *(const u32x2*)p; return (f32x4){bflo(w.x), bfhi(w.x), bflo(w.y), bfhi(w.y)};
#else
    return *(const f32x4*)p;
#endif
}
DI void xstore(xres_t* p, f32x4 v) {
#if XBF16
    u32x2 w; w.x = pk2(v[0], v[1]); w.y = pk2(v[2], v[3]); *(u32x2*)p = w;
#else
    *(f32x4*)p = v;
#endif
}
DI float wave_sum(float v) {
    int x = __float_as_int(v);
    v += __int_as_float(__builtin_amdgcn_update_dpp(x, x, 0xB1, 0xF, 0xF, false)); x = __float_as_int(v);
    v += __int_as_float(__builtin_amdgcn_update_dpp(x, x, 0x4E, 0xF, 0xF, false)); x = __float_as_int(v);
    v += __int_as_float(__builtin_amdgcn_update_dpp(x, x, 0x141, 0xF, 0xF, false)); x = __float_as_int(v);
    v += __int_as_float(__builtin_amdgcn_update_dpp(x, x, 0x140, 0xF, 0xF, false));
    { const auto r = __builtin_amdgcn_permlane16_swap(__float_as_uint(v), __float_as_uint(v), false, false); v = __uint_as_float(r[0]) + __uint_as_float(r[1]); }
    { const auto r = __builtin_amdgcn_permlane32_swap(__float_as_uint(v), __float_as_uint(v), false, false); v = __uint_as_float(r[0]) + __uint_as_float(r[1]); }
    return v;
}
DI float siluf(float v) { return v * __builtin_amdgcn_rcpf(1.0f + __expf(-v)); }

DI int gemm_chunk(int tid) { return (tid & 7) ^ ((tid >> 4) & 7); }
template <bool TRN>
DI void gemm_tile(unsigned char* shm, const bf16_t* const (&ap)[4], const bf16_t* const (&bp)[4], int K, f32x4 (&acc)[4][4],
                  bool first, bool has_next, const bf16_t* const (&apn)[4], const bf16_t* const (&bpn)[4]) {
    const int tid = TIDX(), wid = tid >> 6, lane = tid & 63, wr = wid >> 1, wc = wid & 1, fr = lane & 15, fq = lane >> 4;
#pragma unroll
    for (int m = 0; m < 4; ++m)
#pragma unroll
        for (int n = 0; n < 4; ++n) acc[m][n] = (f32x4){0.f, 0.f, 0.f, 0.f};
    const int nt = K >> 6;
    const int sw = fr >> 1;
    const unsigned aoff = (unsigned)((wr * 64 + fr) * 128), boff = (unsigned)(16384 + (wc * 64 + fr) * 128);
#define GEMM_STAGE(buf, A_, B_, t) do { _Pragma("unroll") for (int i_ = 0; i_ < 4; ++i_) { \
        __builtin_amdgcn_global_load_lds((const unsigned*)(A_[i_] + (t) * 64), (LAS unsigned*)(shm + (buf) * 32768 + i_ * 4096 + tid * 16), 16, 0, 0); \
        __builtin_amdgcn_global_load_lds((const unsigned*)(B_[i_] + (t) * 64), (LAS unsigned*)(shm + (buf) * 32768 + 16384 + i_ * 4096 + tid * 16), 16, 0, 0); } } while (0)
    if (first) {
        GEMM_STAGE(0, ap, bp, 0);
        asm volatile("s_waitcnt vmcnt(0)" ::: "memory");
        __syncthreads();
    }
    for (int t = 0; t < nt; ++t) {
        const int cur = t & 1;
        if (t + 1 < nt) GEMM_STAGE(cur ^ 1, ap, bp, t + 1);
        else if (has_next) GEMM_STAGE(cur ^ 1, apn, bpn, 0);
        const unsigned char* base = shm + cur * 32768;
        bf16x8 At[2][4], Bt[2][4];
#pragma unroll
        for (int ks = 0; ks < 2; ++ks) {
            const unsigned co = (unsigned)(((ks * 4 + fq) ^ sw) << 4);
#pragma unroll
            for (int m = 0; m < 4; ++m) At[ks][m] = *(const bf16x8*)(base + aoff + m * 2048 + co);
#pragma unroll
            for (int n = 0; n < 4; ++n) Bt[ks][n] = *(const bf16x8*)(base + boff + n * 2048 + co);
        }
        __builtin_amdgcn_s_setprio(1);
#pragma unroll
        for (int ks = 0; ks < 2; ++ks)
#pragma unroll
            for (int m = 0; m < 4; ++m)
#pragma unroll
                for (int n = 0; n < 4; ++n)
                    acc[m][n] = TRN ? __builtin_amdgcn_mfma_f32_16x16x32_bf16(Bt[ks][n], At[ks][m], acc[m][n], 0, 0, 0)
                                    : __builtin_amdgcn_mfma_f32_16x16x32_bf16(At[ks][m], Bt[ks][n], acc[m][n], 0, 0, 0);
        __builtin_amdgcn_s_setprio(0);
        asm volatile("s_waitcnt vmcnt(0)" ::: "memory");
        __syncthreads();
    }
#undef GEMM_STAGE
}
#define GEMM_ADVANCE() do { _Pragma("unroll") for (int k_ = 0; k_ < 4; ++k_) { ap[k_] = apn[k_]; bp[k_] = bpn[k_]; } } while (0)
DI void gemm_rows(const bf16_t* base, int r0, int ld, int tid, const bf16_t* (&pp)[4]) {
    const bf16_t* q = base + (size_t)(r0 + (tid >> 3)) * ld + gemm_chunk(tid) * 8;
#pragma unroll
    for (int i = 0; i < 4; ++i) pp[i] = q + (size_t)(32 * i) * ld;
}
DI bool tile_seq(int q, int nrt, int nct, int& rt, int& ct) {
    if (q >= nrt * nct) return false;
    const int band = q / (8 * nct), rem = q - band * 8 * nct;
    const int rows = (nrt - band * 8) < 8 ? (nrt - band * 8) : 8;
    ct = rem / rows; rt = band * 8 + rem % rows;
    return true;
}
DI int xcd_seq(int i, int total) {
    const int G = gridDim.x, bid = BIDX();
    if ((G & 7) != 0) { const int q = i * G + bid; return q < total ? q : -1; }
    const int x = bid & 7, j = bid >> 3, per = (total + 7) >> 3, gx = G >> 3;
    const int q = i * gx + j;
    if (q >= per) return -1;
    const int g = x * per + q;
    return g < total ? g : -1;
}

struct TrDesc { const float* W; bf16_t* WT; int K, N, mode, item; };
DI void tr_load(const TrDesc& d, int lane, float (&wv)[32]) {
    const int nblk = d.N / 32, kb = d.item / nblk, nb = d.item % nblk, k0 = 64 * kb, n0 = 32 * nb;
    const float* src = d.W + (size_t)(k0 + (lane >> 5)) * d.N + n0 + (lane & 31);
#pragma unroll
    for (int i = 0; i < 32; ++i) wv[i] = src[(size_t)(2 * i) * d.N];
}
DI void tr_store(const TrDesc& d, int lane, float* scr, const float (&wv)[32]) {
    const int nblk = d.N / 32, kb = d.item / nblk, nb = d.item % nblk, k0 = 64 * kb, n0 = 32 * nb;
#pragma unroll
    for (int i = 0; i < 32; ++i) scr[(2 * i + (lane >> 5)) * 33 + (lane & 31)] = wv[i];
    asm volatile("s_waitcnt lgkmcnt(0)" ::: "memory");
    const int c = lane & 7;
#pragma unroll
    for (int j = 0; j < 4; ++j) {
        const int n = (lane >> 3) + 8 * j; const float* s = scr + (8 * c) * 33 + n;
        u32x4 o; o.x = pk2(s[0 * 33], s[1 * 33]); o.y = pk2(s[2 * 33], s[3 * 33]); o.z = pk2(s[4 * 33], s[5 * 33]); o.w = pk2(s[6 * 33], s[7 * 33]);
        const int nn = n0 + n;
        const int drow = (d.mode == 0) ? nn : ((nn >> 4) * 32 + (nn & 15) + (d.mode == 2 ? 16 : 0));
        *(u32x4*)(d.WT + (size_t)drow * d.K + k0 + 8 * c) = o;
    }
    asm volatile("s_waitcnt lgkmcnt(0)" ::: "memory");
}

DI void phase_pre0(KP p, unsigned char* smem) {
    const int tid = TIDX(), wave = tid >> 6, lane = tid & 63;
    unsigned char* ws = p->ws;
    if (BIDX() == 0 && tid < 128) {
        unsigned* c0 = (unsigned*)(ws + WS_CTL) + CNT_WORD0 + tid * CNT_STRIDE;
        __hip_atomic_store(c0, 0u, __ATOMIC_RELAXED, __HIP_MEMORY_SCOPE_AGENT); __hip_atomic_store(c0 + 64, 0u, __ATOMIC_RELAXED, __HIP_MEMORY_SCOPE_AGENT);
    }
    {
        float* s_sc = (float*)smem;
        float* s_red = s_sc + 9 * 1024;
        const float* c = p->in[1]; const float* cc = p->in[3];
        for (int i = tid; i < 9 * 1024; i += 256) { const int r = i >> 10, k = i & 1023; const float v = r < 8 ? c[r * 1024 + k] : cc[k]; s_sc[i] = v / (1.0f + expf(-v)); }
        __syncthreads();
        float* MOD = (float*)(ws + WS_MOD);
        for (int item = BIDX(); item < 384; item += gridDim.x) {
            const int l = item / 96, n0 = (item % 96) * 64;
            const float* W = p->in[4] + (size_t)l * 1024 * 6144 + n0 + lane;
            float acc[9];
#pragma unroll
            for (int r = 0; r < 9; ++r) acc[r] = 0.f;
#pragma unroll 16
            for (int k = wave * 256; k < wave * 256 + 256; ++k) {
                const float w = W[(size_t)k * 6144];
#pragma unroll
                for (int r = 0; r < 9; ++r) acc[r] += s_sc[r * 1024 + k] * w;
            }
#pragma unroll
            for (int r = 0; r < 9; ++r) s_red[(wave * 9 + r) * 64 + lane] = acc[r];
            __syncthreads();
            for (int i = tid; i < 9 * 64; i += 256) {
                const int r = i >> 6, ln = i & 63;
                const float v = s_red[(0 * 9 + r) * 64 + ln] + s_red[(1 * 9 + r) * 64 + ln] + s_red[(2 * 9 + r) * 64 + ln] + s_red[(3 * 9 + r) * 64 + ln];
                MOD[(size_t)(l * 9 + r) * 6144 + n0 + ln] = v + p->in[5][l * 6144 + n0 + ln];
            }
            __syncthreads();
        }
    }
    {
        const int gt = BIDX() * 256 + tid, NT = gridDim.x * 256;
        float* ca = (float*)(ws + WS_ROPEA); float* sa = ca + 2048 * 64;
        for (int i = gt; i < 2048 * 64; i += NT) {
            const int t = i >> 6, f = i & 63; const int pos = f < 32 ? (t >> 6) : (t & 63); const int ff = f & 31;
            const float inv = powf(10000.0f, -(float)ff / 32.0f); const float a = (float)pos * inv;
            ca[i] = cosf(a); sa[i] = sinf(a);
        }
        float* cc_ = (float*)(ws + WS_ROPEC); float* sc_ = cc_ + 2048 * 32;
        for (int i = gt; i < 2048 * 32; i += NT) {
            const int t = i >> 5, f = i & 31; const int pos = f < 16 ? (t >> 6) : (t & 63); const int ff = f & 15;
            const float inv = powf(10000.0f, -(float)ff / 16.0f); const float a = (float)pos * inv;
            cc_[i] = cosf(a); sc_[i] = sinf(a);
        }
        float* wrt = (float*)(ws + WS_WRT);
        for (int i = gt; i < 4 * 36 * 1024; i += NT) {
            const int l = i / (36 * 1024), o = (i / 1024) % 36, k = i & 1023;
            wrt[i] = o < 4 ? p->in[25][((size_t)l * 1024 + k) * 4 + o] : p->in[27][((size_t)l * 1024 + k) * 32 + (o - 4)];
        }
        unsigned* wpad = (unsigned*)(ws + WS_WIN);
        for (int i = gt; i < 2 * 96 * 512; i += NT) { const int li = i / (96 * 512), r = i % (96 * 512); wpad[((size_t)li * NINP + NIN) * 512 + r] = 0u; }
    }
    __syncthreads();
    {
        float* scr = (float*)smem + wave * (64 * 33);
        constexpr int I_IN = 16 * 113, I_SQ = 16 * 32, I_QKV = 16 * 96, I_E = 256;
        constexpr int R0 = 2 * I_IN, R1 = R0 + 2 * I_SQ, R2 = R1 + 2 * I_QKV, R3 = R2 + 2 * I_SQ, R4 = R3 + 128 * I_E, R5 = R4 + 128 * I_E, R6 = R5 + 128 * I_E;
        auto decode = [&](int it) -> TrDesc {
            TrDesc d;
            if (it < R0) { const int i = it / I_IN; d.item = it % I_IN; d.W = p->in[10] + (size_t)i * 1024 * NIN; d.K = 1024; d.N = NIN; d.WT = (bf16_t*)(ws + WS_WIN) + (size_t)i * NINP * 1024; d.mode = 0; }
            else if (it < R1) { const int q = it - R0, i = q / I_SQ; d.item = q % I_SQ; d.W = p->in[17] + (size_t)i * 1024 * 1024; d.K = 1024; d.N = 1024; d.WT = (bf16_t*)(ws + WS_WABO) + (size_t)i * 1024 * 1024; d.mode = 0; }
            else if (it < R2) { const int q = it - R1, i = q / I_QKV; d.item = q % I_QKV; d.W = p->in[18] + (size_t)i * 1024 * 3072; d.K = 1024; d.N = 3072; d.WT = (bf16_t*)(ws + WS_WQKV) + (size_t)i * 3072 * 1024; d.mode = 0; }
            else if (it < R3) { const int q = it - R2, i = q / I_SQ; d.item = q % I_SQ; d.W = p->in[24] + (size_t)i * 1024 * 1024; d.K = 1024; d.N = 1024; d.WT = (bf16_t*)(ws + WS_WCO) + (size_t)i * 1024 * 1024; d.mode = 0; }
            else if (it < R4) { const int q = it - R3, le = q / I_E; d.item = q % I_E; d.W = p->in[29] + (size_t)le * 1024 * 512; d.K = 1024; d.N = 512; d.WT = (bf16_t*)(ws + WS_WGU) + (size_t)le * 1024 * 1024; d.mode = 1; }
            else if (it < R5) { const int q = it - R4, le = q / I_E; d.item = q % I_E; d.W = p->in[30] + (size_t)le * 1024 * 512; d.K = 1024; d.N = 512; d.WT = (bf16_t*)(ws + WS_WGU) + (size_t)le * 1024 * 1024; d.mode = 2; }
            else { const int q = it - R5, le = q / I_E; d.item = q % I_E; d.W = p->in[31] + (size_t)le * 512 * 1024; d.K = 512; d.N = 1024; d.WT = (bf16_t*)(ws + WS_WD) + (size_t)le * 1024 * 512; d.mode = 0; }
            return d;
        };
        const int istride = gridDim.x * 4;
        int it = BIDX() * 4 + wave;
        float wa[32], wb[32];
        TrDesc dc = decode(it < R6 ? it : 0);
        if (it < R6) tr_load(dc, lane, wa);
#pragma unroll 1
        for (; it < R6; it += istride) {
            const bool hn = it + istride < R6;
            const TrDesc dn = decode(hn ? it + istride : 0);
            if (hn) tr_load(dn, lane, wb);
            tr_store(dc, lane, scr, wa);
            dc = dn;
#pragma unroll
            for (int i = 0; i < 32; ++i) wa[i] = wb[i];
        }
    }
}

DI void phase_pre1(KP p) {
    const int tid = TIDX(), wave = tid >> 6, lane = tid & 63;
    xres_t* X = (xres_t*)(p->ws + WS_X); bf16_t* U = (bf16_t*)(p->ws + WS_U); const float* MOD = (const float*)(p->ws + WS_MOD);
    const int rstride = gridDim.x * 4;
    f32x4 rv[3][4];
#define PRE1_FETCH(R0) { _Pragma("unroll") for (int q = 0; q < 3; ++q) { const int row_ = (R0) + q * rstride; const int row = row_ < MT ? row_ : MT - 1; \
        const float* src = row < ML ? p->in[0] + (size_t)row * 1024 : p->in[2] + (size_t)(row - ML) * 1024; \
        _Pragma("unroll") for (int j = 0; j < 4; ++j) rv[q][j] = *(const f32x4*)(src + 256 * j + 4 * lane); } }
    int row0 = BIDX() * 4 + wave;
    if (row0 < MT) PRE1_FETCH(row0)
#pragma unroll 1
    for (; row0 < MT; row0 += 3 * rstride) {
        f32x4 u[3][4];
#pragma unroll
        for (int q = 0; q < 3; ++q) {
            const int row_ = row0 + q * rstride; const int row = row_ < MT ? row_ : MT - 1;
            const int r = row < ML ? (row >> 11) : 8;
            const float* mod = MOD + (size_t)r * 6144;
#pragma unroll
            for (int j = 0; j < 4; ++j) {
                const int k = 256 * j + 4 * lane;
                const f32x4 sh = *(const f32x4*)(mod + k), sc = *(const f32x4*)(mod + 1024 + k);
                u[q][j] = rv[q][j] * (1.0f + sc) + sh;
            }
        }
        if (row0 + 3 * rstride < MT) PRE1_FETCH(row0 + 3 * rstride)
#pragma unroll
        for (int q = 0; q < 3; ++q) {
            const int row = row0 + q * rstride;
            if (row < MT) {
#pragma unroll
                for (int j = 0; j < 4; ++j) {
                    const int k = 256 * j + 4 * lane;
                    u32x2 w; w.x = pk2(u[q][j][0], u[q][j][1]); w.y = pk2(u[q][j][2], u[q][j][3]);
                    *(u32x2*)(U + (size_t)row * 1024 + k) = w;
                }
            }
        }
    }
}

DI void phase_g1e(KP p, int l, unsigned char* smem) {
    const int tid = TIDX(), wid = tid >> 6, lane = tid & 63, wr = wid >> 1, wc = wid & 1, fr = lane & 15, fq = lane >> 4;
    const int li = l >> 1;
    const bf16_t* U = (const bf16_t*)(p->ws + WS_U); const bf16_t* W = (const bf16_t*)(p->ws + WS_WIN) + (size_t)li * NINP * 1024;
    bf16_t* Z = (bf16_t*)(p->ws + WS_Z); float* LR = (float*)(p->ws + WS_LR);
    const float* ca = (const float*)(p->ws + WS_ROPEA); const float* sa = ca + 2048 * 64;
    constexpr int NTN = NINP / 128;
    auto decode = [&](int i, int& brow, int& bcol) -> bool {
        const int q = xcd_seq(i, (MT / 128) * NTN); if (q < 0) return false;
        int rt, nt; tile_seq(q, MT / 128, NTN, rt, nt); brow = rt * 128; bcol = nt * 128; return true; };
    auto epi = [&](int brow, int bcol, f32x4 (&acc)[4][4]) {
        const int colw = bcol + wc * 64;
        if (colw >= NIN) return;
        if (colw >= 3584) {
#pragma unroll
            for (int m = 0; m < 4; ++m) { const int row = brow + wr * 64 + m * 16 + fr;
#pragma unroll
                for (int n = 0; n < 2; ++n) *(f32x4*)(LR + (size_t)row * 32 + n * 16 + fq * 4) = acc[m][n]; }
            return;
        }
        const bool ropeR = colw < 1024; const int half = (colw >> 6) & 1;
        const float scale = colw < 512 ? 0.08838834764831845f : ((colw >= 2048 && colw < 2304) ? 0.125f : 1.0f);
#pragma unroll
        for (int m = 0; m < 4; ++m) {
            const int row = brow + wr * 64 + m * 16 + fr;
            if (ropeR && row < ML) {
                const int t = row & 2047;
#pragma unroll
                for (int n = 0; n < 2; ++n) {
                    const f32x4 c4 = *(const f32x4*)(ca + t * 64 + half * 32 + n * 16 + fq * 4), s4 = *(const f32x4*)(sa + t * 64 + half * 32 + n * 16 + fq * 4);
                    const f32x4 a = acc[m][n], b = acc[m][n + 2];
                    acc[m][n] = a * c4 - b * s4; acc[m][n + 2] = b * c4 + a * s4;
                }
            }
#pragma unroll
            for (int n = 0; n < 4; ++n) {
                const f32x4 v = acc[m][n] * scale; u32x2 w; w.x = pk2(v[0], v[1]); w.y = pk2(v[2], v[3]);
                *(u32x2*)(Z + (size_t)row * ZS + colw + n * 16 + fq * 4) = w;
            }
        }
    };
    int brow, bcol;
    if (!decode(0, brow, bcol)) return;
    const bf16_t* ap[4]; const bf16_t* bp[4]; const bf16_t* apn[4]; const bf16_t* bpn[4];
    gemm_rows(U, brow, 1024, tid, ap); gemm_rows(W, bcol, 1024, tid, bp);
    bool first = true;
    for (int i = 0;; ++i) {
        int nbrow = brow, nbcol = bcol; const bool hn = decode(i + 1, nbrow, nbcol);
        gemm_rows(U, nbrow, 1024, tid, apn); gemm_rows(W, nbcol, 1024, tid, bpn);
        f32x4 acc[4][4];
        gemm_tile<true>(smem, ap, bp, 1024, acc, first, hn, apn, bpn);
        epi(brow, bcol, acc);
        if (!hn) break;
        brow = nbrow; bcol = nbcol; GEMM_ADVANCE(); first = false;
    }
}

DI void phase_g1o(KP p, int l, unsigned char* smem) {
    const int tid = TIDX(), wid = tid >> 6, lane = tid & 63, wr = wid >> 1, wc = wid & 1, fr = lane & 15, fq = lane >> 4;
    const int li = l >> 1;
    const bf16_t* U = (const bf16_t*)(p->ws + WS_U); const bf16_t* W = (const bf16_t*)(p->ws + WS_WQKV) + (size_t)li * 3072 * 1024;
    bf16_t* Qc = (bf16_t*)(p->ws + WS_QC); bf16_t* Kc = (bf16_t*)(p->ws + WS_KC); bf16_t* Vt = (bf16_t*)(p->ws + WS_VT);
    const float* cc = (const float*)(p->ws + WS_ROPEC); const float* sc = cc + 2048 * 32;
    auto decode = [&](int i, int& brow, int& bcol) -> bool {
        const int q = xcd_seq(i, (MT / 128) * 24); if (q < 0) return false;
        int rt, nt; tile_seq(q, MT / 128, 24, rt, nt); brow = rt * 128; bcol = nt * 128; return true; };
    int brow, bcol;
    if (!decode(0, brow, bcol)) return;
    const bf16_t* ap[4]; const bf16_t* bp[4]; const bf16_t* apn[4]; const bf16_t* bpn[4];
    gemm_rows(U, brow, 1024, tid, ap); gemm_rows(W, bcol, 1024, tid, bp);
    bool first = true;
    for (int i = 0;; ++i) {
        int nbrow = brow, nbcol = bcol; const bool hn = decode(i + 1, nbrow, nbcol);
        gemm_rows(U, nbrow, 1024, tid, apn); gemm_rows(W, nbcol, 1024, tid, bpn);
        f32x4 acc[4][4];
        if (bcol < 2048) {
            gemm_tile<true>(smem, ap, bp, 1024, acc, first, hn, apn, bpn);
            const int colw = bcol + wc * 64; const bool isk = colw >= 1024; const int hc = (colw & 1023) >> 6;
            bf16_t* dst = isk ? Kc : Qc; const float scale = isk ? 1.0f : 0.125f;
#pragma unroll
            for (int m = 0; m < 4; ++m) {
                const int row = brow + wr * 64 + m * 16 + fr;
                int b, pidx;
                if (row < ML) {
                    b = row >> 11; const int t = row & 2047; pidx = 256 + t;
#pragma unroll
                    for (int n = 0; n < 4; n += 2) {
                        const f32x4 c4 = *(const f32x4*)(cc + t * 32 + (n >> 1) * 16 + fq * 4), s4 = *(const f32x4*)(sc + t * 32 + (n >> 1) * 16 + fq * 4);
                        const f32x4 a = acc[m][n], bb = acc[m][n + 1];
                        acc[m][n] = a * c4 - bb * s4; acc[m][n + 1] = bb * c4 + a * s4;
                    }
                } else { b = (row - ML) >> 8; pidx = (row - ML) & 255; }
                bf16_t* o = dst + ((size_t)(b * 16 + hc) * TA + pidx) * 64;
#pragma unroll
                for (int n = 0; n < 4; ++n) { const f32x4 v = acc[m][n] * scale; u32x2 w; w.x = pk2(v[0], v[1]); w.y = pk2(v[2], v[3]); *(u32x2*)(o + n * 16 + fq * 4) = w; }
            }
        } else {
            gemm_tile<false>(smem, ap, bp, 1024, acc, first, hn, apn, bpn);
#pragma unroll
            for (int m = 0; m < 4; ++m) {
                const int row = brow + wr * 64 + m * 16 + fq * 4;
                int b, pidx;
                if (row < ML) { b = row >> 11; pidx = 256 + (row & 2047); } else { b = (row - ML) >> 8; pidx = (row - ML) & 255; }
                const int ppos = (pidx & ~12) | ((pidx & 8) >> 1) | ((pidx & 4) << 1);
#pragma unroll
                for (int n = 0; n < 4; ++n) {
                    const int col = bcol - 2048 + wc * 64 + n * 16 + fr; const int h = col >> 7, d = col & 127;
                    const f32x4 v = acc[m][n]; u32x2 w; w.x = pk2(v[0], v[1]); w.y = pk2(v[2], v[3]);
                    *(u32x2*)(Vt + ((size_t)(b * 8 + h) * 128 + d) * TA + ppos) = w;
                }
            }
        }
        if (!hn) break;
        brow = nbrow; bcol = nbcol; GEMM_ADVANCE(); first = false;
    }
}

DI void phase_g2(KP p, int l, unsigned char* smem) {
    const int tid = TIDX(), wid = tid >> 6, lane = tid & 63, wr = wid >> 1, wc = wid & 1, fr = lane & 15, fq = lane >> 4;
    const int li = l >> 1;
    const bf16_t* Y = (const bf16_t*)(p->ws + WS_Y);
    const bf16_t* W = (const bf16_t*)(p->ws + ((l & 1) ? WS_WCO : WS_WABO)) + (size_t)li * 1024 * 1024;
    bf16_t* P = (bf16_t*)(p->ws + WS_P);
    const int nrt = (l == 3 ? ML : MT) / 128;
    auto decode = [&](int i, int& brow, int& bcol) -> bool {
        const int q = xcd_seq(i, nrt * 8); if (q < 0) return false;
        int rt, nt; tile_seq(q, nrt, 8, rt, nt); brow = rt * 128; bcol = nt * 128; return true; };
    int brow, bcol;
    if (!decode(0, brow, bcol)) return;
    const bf16_t* ap[4]; const bf16_t* bp[4]; const bf16_t* apn[4]; const bf16_t* bpn[4];
    gemm_rows(Y, brow, 1024, tid, ap); gemm_rows(W, bcol, 1024, tid, bp);
    bool first = true;
    for (int i = 0;; ++i) {
        int nbrow = brow, nbcol = bcol; const bool hn = decode(i + 1, nbrow, nbcol);
        gemm_rows(Y, nbrow, 1024, tid, apn); gemm_rows(W, nbcol, 1024, tid, bpn);
        f32x4 acc[4][4];
        gemm_tile<true>(smem, ap, bp, 1024, acc, first, hn, apn, bpn);
#pragma unroll
        for (int m = 0; m < 4; ++m) { const int row = brow + wr * 64 + m * 16 + fr;
#pragma unroll
            for (int n = 0; n < 4; ++n) { const f32x4 v = acc[m][n]; u32x2 w; w.x = pk2(v[0], v[1]); w.y = pk2(v[2], v[3]); *(u32x2*)(P + (size_t)row * 1024 + bcol + wc * 64 + n * 16 + fq * 4) = w; } }
        if (!hn) break;
        brow = nbrow; bcol = nbcol; GEMM_ADVANCE(); first = false;
    }
}

template <bool DRY>
DI void phase_ln1r(KP p, int l, unsigned char* smem) {
    constexpr int US = 1028;
    constexpr int RB = 12;
    float* Us = (float*)smem;
    float* Ps = Us + RB * US;
    const int tid = TIDX(), wave = tid >> 6, lane = tid & 63;
    const xres_t* X = (const xres_t*)(p->ws + WS_X); xres_t* Xo = (xres_t*)(p->ws + (DRY ? WS_OB : WS_X)); const bf16_t* P = (const bf16_t*)(p->ws + WS_P); bf16_t* U = (bf16_t*)(p->ws + (DRY ? WS_Y : WS_U));
    const float* MOD = (const float*)(p->ws + WS_MOD); const float* WrT = (const float*)(p->ws + WS_WRT) + (size_t)l * 36 * 1024;
    const float* lng = p->in[6] + l * 1024; const float* lnb = p->in[7] + l * 1024;
    const float* bgrp = p->in[26] + l * 4; const float* brex = p->in[28] + l * 32;
    unsigned* cnt = (unsigned*)(p->ws + WS_CTL) + CNT_WORD0 + l * 32 * CNT_STRIDE + (DRY ? 64 : 0); int* list = (int*)(p->ws + WS_LIST); float* slotw = (float*)(p->ws + WS_SLOTW);
    const int rows_total = (l == 3) ? ML : MT;
    const int mi = lane & 15, mq = lane >> 4;
    int pend_slot = -1, pend_e = 0; unsigned pend_pos = 0u;
    f32x4 rx[3][4]; u32x2 rp[3][4];
#define LN1_FETCH(IT, RR) { const int frow_ = (IT) * RB + wave * 3 + (RR); const int frow = frow_ < rows_total ? frow_ : rows_total - 1; \
        const float* xsrc = (l == 0) ? (frow < ML ? p->in[0] + (size_t)frow * 1024 : p->in[2] + (size_t)(frow - ML) * 1024) : nullptr; \
        _Pragma("unroll") for (int j = 0; j < 4; ++j) { const int k = 256 * j + 4 * lane; \
            rx[RR][j] = (l == 0) ? *(const f32x4*)(xsrc + k) : xload(X + (size_t)frow * 1024 + k); rp[RR][j] = *(const u32x2*)(P + (size_t)frow * 1024 + k); } }
    int it = BIDX();
    if (it * RB < rows_total) { LN1_FETCH(it, 0) LN1_FETCH(it, 1) LN1_FETCH(it, 2) }
#pragma unroll 1
    for (; it * RB < rows_total; it += gridDim.x) {
        const int row0 = it * RB + wave * 3;
        const bool has_next = (it + (int)gridDim.x) * RB < rows_total;
#pragma unroll
        for (int rr = 0; rr < 3; ++rr) {
            const int rowr = row0 + rr; const bool rvalid = rowr < rows_total; const int row = rvalid ? rowr : rows_total - 1;
            const int r = row < ML ? (row >> 11) : 8;
            const float* mod = MOD + (size_t)(l * 9 + r) * 6144;
            f32x4 v[4]; float s = 0.f;
#pragma unroll
            for (int j = 0; j < 4; ++j) {
                const int k = 256 * j + 4 * lane;
                const f32x4 xv = rx[rr][j];
                const f32x4 g1 = *(const f32x4*)(mod + 2048 + k);
                const u32x2 pw_ = rp[rr][j]; const f32x4 pv = (f32x4){bflo(pw_.x), bfhi(pw_.x), bflo(pw_.y), bfhi(pw_.y)};
                v[j] = xv * ALPHA + g1 * pv; s += (v[j][0] + v[j][1]) + (v[j][2] + v[j][3]);
            }
            if (has_next) { if (rr == 0) LN1_FETCH(it + gridDim.x, 0) else if (rr == 1) LN1_FETCH(it + gridDim.x, 1) else LN1_FETCH(it + gridDim.x, 2) }
            const float mean = wave_sum(s) * (1.0f / 1024.0f); float s2 = 0.f;
#pragma unroll
            for (int j = 0; j < 4; ++j) { v[j] = v[j] - mean; s2 += (v[j][0] * v[j][0] + v[j][1] * v[j][1]) + (v[j][2] * v[j][2] + v[j][3] * v[j][3]); }
            const float rstd = 1.0f / sqrtf(wave_sum(s2) * (1.0f / 1024.0f) + LN_EPS);
#pragma unroll
            for (int j = 0; j < 4; ++j) {
                const int k = 256 * j + 4 * lane;
                const f32x4 xn = v[j] * rstd * *(const f32x4*)(lng + k) + *(const f32x4*)(lnb + k);
                const f32x4 uu = xn * (1.0f + *(const f32x4*)(mod + 4096 + k)) + *(const f32x4*)(mod + 3072 + k);
                *(f32x4*)(Us + (wave * 3 + rr) * US + k) = uu;
                if (rvalid) {
                    xstore(Xo + (size_t)row * 1024 + k, xn);
                    u32x2 w; w.x = pk2(uu[0], uu[1]); w.y = pk2(uu[2], uu[3]);
                    *(u32x2*)(U + (size_t)row * 1024 + k) = w;
                }
            }
        }
        __syncthreads();
        {
            f32x4 acc[3] = {(f32x4){0.f, 0.f, 0.f, 0.f}, (f32x4){0.f, 0.f, 0.f, 0.f}, (f32x4){0.f, 0.f, 0.f, 0.f}};
            const float* ap = Us + (mi < RB ? mi : mi - RB) * US + 256 * wave + 4 * mq;
            const float* bp0 = WrT + (size_t)mi * 1024 + 256 * wave + 4 * mq;
            const float* bp1 = WrT + (size_t)(16 + mi) * 1024 + 256 * wave + 4 * mq;
            const float* bp2 = WrT + (size_t)(32 + (mi & 3)) * 1024 + 256 * wave + 4 * mq;
#pragma unroll 1
            for (int sb0 = 0; sb0 < 16; sb0 += 8) {
                f32x4 bv[8][3];
#pragma unroll
                for (int q = 0; q < 8; ++q) { bv[q][0] = *(const f32x4*)(bp0 + 16 * (sb0 + q)); bv[q][1] = *(const f32x4*)(bp1 + 16 * (sb0 + q)); bv[q][2] = *(const f32x4*)(bp2 + 16 * (sb0 + q)); }
                __builtin_amdgcn_sched_barrier(0);
#pragma unroll
                for (int q = 0; q < 8; ++q) {
                    const f32x4 a = *(const f32x4*)(ap + 16 * (sb0 + q));
#pragma unroll
                    for (int e = 0; e < 4; ++e) {
                        acc[0] = __builtin_amdgcn_mfma_f32_16x16x4f32(a[e], bv[q][0][e], acc[0], 0, 0, 0);
                        acc[1] = __builtin_amdgcn_mfma_f32_16x16x4f32(a[e], bv[q][1][e], acc[1], 0, 0, 0);
                        acc[2] = __builtin_amdgcn_mfma_f32_16x16x4f32(a[e], bv[q][2][e], acc[2], 0, 0, 0);
                    }
                }
            }
            if (mq < 3) {
#pragma unroll
                for (int nt = 0; nt < 3; ++nt)
#pragma unroll
                    for (int rg = 0; rg < 4; ++rg) Ps[(wave * RB + mq * 4 + rg) * 48 + nt * 16 + mi] = acc[nt][rg];
            }
        }
        __syncthreads();
        if (wave < 2) {
            const int r = wave * 8 + (lane >> 3), c = lane & 7;
            const int rq = r < RB ? r : RB - 1;
            const int row = it * RB + rq;
            float lgv[5];
#pragma unroll
            for (int k = 0; k < 5; ++k) {
                const int o = c + 8 * k; const int oo = o < 36 ? o : 35;
                lgv[k] = (Ps[(0 * RB + rq) * 48 + oo] + Ps[(1 * RB + rq) * 48 + oo]) + (Ps[(2 * RB + rq) * 48 + oo] + Ps[(3 * RB + rq) * 48 + oo]);
            }
            float gv = c < 4 ? lgv[0] + bgrp[c & 3] : -3.0e38f; int gi = c;
#pragma unroll
            for (int off = 1; off < 4; off <<= 1) {
                const float ov = __shfl_xor(gv, off); const int oi = __shfl_xor(gi, off);
                if (ov > gv || (ov == gv && oi < gi)) { gv = ov; gi = oi; }
            }
            const int src0 = lane & ~7;
            const float gmax = __shfl(gv, src0); const int grp = __shfl(gi, src0);
            float ge = c < 4 ? expf(lgv[0] + bgrp[c & 3] - gmax) : 0.f;
            ge += __shfl_xor(ge, 1); ge += __shfl_xor(ge, 2);
            const float gw = 1.0f / __shfl(ge, src0);
            const int j = (c + 4) & 7; const int kk = c >= 4 ? grp : grp + 1;
            float ev = lgv[0];
#pragma unroll
            for (int k = 1; k < 5; ++k) ev = (kk == k) ? lgv[k] : ev;
            ev += brex[grp * 8 + j];
            float v1 = ev; int i1 = j;
#pragma unroll
            for (int off = 1; off < 8; off <<= 1) {
                const float ov = __shfl_xor(v1, off); const int oi = __shfl_xor(i1, off);
                if (ov > v1 || (ov == v1 && oi < i1)) { v1 = ov; i1 = oi; }
            }
            float v2 = (j == i1) ? -3.0e38f : ev; int i2 = (j == i1) ? 99 : j;
#pragma unroll
            for (int off = 1; off < 8; off <<= 1) {
                const float ov = __shfl_xor(v2, off); const int oi = __shfl_xor(i2, off);
                if (ov > v2 || (ov == v2 && oi < i2)) { v2 = ov; i2 = oi; }
            }
            const float e2 = expf(v2 - v1);
            const float w1 = 1.0f / (1.0f + e2), w2 = e2 / (1.0f + e2);
            if (c < 2 && r < RB && row < rows_total) {
                if (pend_slot >= 0) list[(size_t)pend_e * NSLOT + pend_pos] = pend_slot;
                const int e = grp * 8 + (c ? i2 : i1); const float w = gw * (c ? w2 : w1);
                const int slot = row * 2 + c;
                slotw[slot] = w;
#ifdef DRY_NOATOM
                pend_pos = DRY ? (unsigned)slot : atomicAdd(&cnt[e * CNT_STRIDE], 1u); pend_e = e; pend_slot = slot;
#else
                pend_pos = atomicAdd(&cnt[e * CNT_STRIDE], 1u); pend_e = e; pend_slot = slot;
#endif
            }
        }
        __syncthreads();
    }
    if (pend_slot >= 0) list[(size_t)pend_e * NSLOT + pend_pos] = pend_slot;
}

DI void moe_prefix(KP p, int l, int* s_cnt, int* s_tb, int* s_rb) {
    const int tid = TIDX();
    const unsigned* cnt = (const unsigned*)(p->ws + WS_CTL) + CNT_WORD0 + l * 32 * CNT_STRIDE;
    __syncthreads();
    if (tid < 32) s_cnt[tid] = (int)__hip_atomic_load(cnt + tid * CNT_STRIDE, __ATOMIC_RELAXED, __HIP_MEMORY_SCOPE_AGENT);
    __syncthreads();
    if (tid == 0) { int tb = 0; for (int e = 0; e < 32; ++e) { s_tb[e] = tb; s_rb[e] = tb * 128; tb += (s_cnt[e] + 127) >> 7; } s_tb[32] = tb; s_rb[32] = tb * 128; }
    __syncthreads();
}
DI void phase_mg1(KP p, int l, unsigned char* smem) {
    const int tid = TIDX(), wid = tid >> 6, lane = tid & 63, wr = wid >> 1, wc = wid & 1, fr = lane & 15, fq = lane >> 4;
    int* s_cnt = (int*)(smem + 65536 + 64); int* s_tb = s_cnt + 32; int* s_rb = s_tb + 33;
    moe_prefix(p, l, s_cnt, s_tb, s_rb);
    const bf16_t* U = (const bf16_t*)(p->ws + WS_U); const int* list = (const int*)(p->ws + WS_LIST);
    bf16_t* H = (bf16_t*)(p->ws + WS_H);
    const int ntiles = s_tb[32] * 8;
    struct TI { int e, rt, nt, cnt_e; };
    auto decode = [&](int i, TI& t) -> bool {
        const int tile = xcd_seq(i, ntiles); if (tile < 0) return false;
        const int rtg = tile >> 3; t.nt = tile & 7;
        int e = 0;
        for (int q = 1; q < 32; ++q) if (rtg >= s_tb[q]) e = q;
        t.e = e; t.rt = rtg - s_tb[e]; t.cnt_e = s_cnt[e]; return true; };
    auto rows = [&](const TI& t, const bf16_t* (&a)[4], const bf16_t* (&b)[4]) {
#pragma unroll
        for (int i_ = 0; i_ < 4; ++i_) {
            const int pos = t.rt * 128 + (tid >> 3) + 32 * i_;
            const int tok = pos < t.cnt_e ? (list[(size_t)t.e * NSLOT + pos] >> 1) : 0;
            a[i_] = U + (size_t)tok * 1024 + gemm_chunk(tid) * 8;
        }
        gemm_rows((const bf16_t*)(p->ws + WS_WGU) + (size_t)(l * 32 + t.e) * 1024 * 1024, t.nt * 128, 1024, tid, b); };
    TI cur, nxt;
    if (!decode(0, cur)) return;
    const bf16_t* ap[4]; const bf16_t* bp[4]; const bf16_t* apn[4]; const bf16_t* bpn[4];
    rows(cur, ap, bp);
    bool first = true;
    for (int i = 0;; ++i) {
        nxt = cur; const bool hn = decode(i + 1, nxt);
        rows(nxt, apn, bpn);
        f32x4 acc[4][4];
        gemm_tile<true>(smem, ap, bp, 1024, acc, first, hn, apn, bpn);
        const int hrow0 = s_rb[cur.e] + cur.rt * 128 + wr * 64;
#pragma unroll
        for (int m = 0; m < 4; ++m) {
            bf16_t* o = H + (size_t)(hrow0 + m * 16 + fr) * 512 + cur.nt * 64 + wc * 32 + fq * 4;
#pragma unroll
            for (int n = 0; n < 4; n += 2) {
                const f32x4 g = acc[m][n], uu = acc[m][n + 1]; f32x4 h;
#pragma unroll
                for (int j = 0; j < 4; ++j) h[j] = siluf(g[j]) * uu[j];
                u32x2 w; w.x = pk2(h[0], h[1]); w.y = pk2(h[2], h[3]);
                *(u32x2*)(o + (n >> 1) * 16) = w;
            }
        }
        if (!hn) break;
        cur = nxt; GEMM_ADVANCE(); first = false;
    }
}
DI void phase_mg2(KP p, int l, unsigned char* smem) {
    const int tid = TIDX(), wid = tid >> 6, lane = tid & 63, wr = wid >> 1, wc = wid & 1, fr = lane & 15, fq = lane >> 4;
    int* s_cnt = (int*)(smem + 65536 + 64); int* s_tb = s_cnt + 32; int* s_rb = s_tb + 33;
    moe_prefix(p, l, s_cnt, s_tb, s_rb);
    const bf16_t* H = (const bf16_t*)(p->ws + WS_H); const int* list = (const int*)(p->ws + WS_LIST); const float* slotw = (const float*)(p->ws + WS_SLOTW);
    bf16_t* YS = (bf16_t*)(p->ws + WS_YS);
    const int ntiles = s_tb[32] * 8;
    struct TI { int e, rt, nt, cnt_e; };
    auto decode = [&](int i, TI& t) -> bool {
        const int tile = xcd_seq(i, ntiles); if (tile < 0) return false;
        const int rtg = tile >> 3; t.nt = tile & 7;
        int e = 0;
        for (int q = 1; q < 32; ++q) if (rtg >= s_tb[q]) e = q;
        t.e = e; t.rt = rtg - s_tb[e]; t.cnt_e = s_cnt[e]; return true; };
    auto rows = [&](const TI& t, const bf16_t* (&a)[4], const bf16_t* (&b)[4]) {
        gemm_rows(H, s_rb[t.e] + t.rt * 128, 512, tid, a);
        gemm_rows((const bf16_t*)(p->ws + WS_WD) + (size_t)(l * 32 + t.e) * 1024 * 512, t.nt * 128, 512, tid, b); };
    TI cur, nxt;
    if (!decode(0, cur)) return;
    const bf16_t* ap[4]; const bf16_t* bp[4]; const bf16_t* apn[4]; const bf16_t* bpn[4];
    rows(cur, ap, bp);
    bool first = true;
    for (int i = 0;; ++i) {
        nxt = cur; const bool hn = decode(i + 1, nxt);
        rows(nxt, apn, bpn);
        int eslot[4]; float ew[4];
#pragma unroll
        for (int m = 0; m < 4; ++m) {
            const int pos = cur.rt * 128 + wr * 64 + m * 16 + fr;
            eslot[m] = pos < cur.cnt_e ? list[(size_t)cur.e * NSLOT + pos] : -1;
        }
#pragma unroll
        for (int m = 0; m < 4; ++m) ew[m] = eslot[m] >= 0 ? slotw[eslot[m]] : 0.f;
        f32x4 acc[4][4];
        gemm_tile<true>(smem, ap, bp, 512, acc, first, hn, apn, bpn);
#pragma unroll
        for (int m = 0; m < 4; ++m) {
            if (eslot[m] >= 0) {
                const int slot = eslot[m]; const float w = ew[m];
                bf16_t* o = YS + (size_t)slot * 1024 + cur.nt * 128 + wc * 64 + fq * 4;
#pragma unroll
                for (int n = 0; n < 4; ++n) { const f32x4 v = acc[m][n] * w; u32x2 ww; ww.x = pk2(v[0], v[1]); ww.y = pk2(v[2], v[3]); *(u32x2*)(o + n * 16) = ww; }
            }
        }
        if (!hn) break;
        cur = nxt; GEMM_ADVANCE(); first = false;
    }
}

template <bool DRY>
DI void phase_ln2(KP p, int l) {
    const int tid = TIDX(), wave = tid >> 6, lane = tid & 63;
    const xres_t* X = (const xres_t*)(p->ws + WS_X); xres_t* Xo = (xres_t*)(p->ws + (DRY ? WS_OB : WS_X)); const bf16_t* YS = (const bf16_t*)(p->ws + WS_YS); bf16_t* U = (bf16_t*)(p->ws + (DRY ? WS_Y : WS_U));
    const float* MOD = (const float*)(p->ws + WS_MOD);
    const float* lng = p->in[8] + l * 1024; const float* lnb = p->in[9] + l * 1024;
    const int rows_total = (l == 3) ? ML : MT;
    u32x2 ry0[2][4], ry1[2][4]; f32x4 rx[2][4];
    const int rstride = gridDim.x * 8;
    int row0 = (BIDX() * 4 + wave) * 2;
#define LN2_FETCH(R0) { _Pragma("unroll") for (int q = 0; q < 2; ++q) { const int row = (R0) + q; _Pragma("unroll") for (int j = 0; j < 4; ++j) { const int k = 256 * j + 4 * lane; \
        ry0[q][j] = *(const u32x2*)(YS + (size_t)(2 * row) * 1024 + k); ry1[q][j] = *(const u32x2*)(YS + (size_t)(2 * row + 1) * 1024 + k); rx[q][j] = xload(X + (size_t)row * 1024 + k); } } }
    if (row0 < rows_total) LN2_FETCH(row0)
#pragma unroll 1
    for (; row0 < rows_total; row0 += rstride) {
        f32x4 v[2][4]; float s[2] = {0.f, 0.f};
        const float* mod[2];
#pragma unroll
        for (int q = 0; q < 2; ++q) {
            const int row = row0 + q; const int r = row < ML ? (row >> 11) : 8;
            mod[q] = MOD + (size_t)(l * 9 + r) * 6144;
#pragma unroll
            for (int j = 0; j < 4; ++j) {
                const int k = 256 * j + 4 * lane;
                const u32x2 y0 = ry0[q][j], y1 = ry1[q][j];
                f32x4 y; y[0] = bflo(y0.x) + bflo(y1.x); y[1] = bfhi(y0.x) + bfhi(y1.x); y[2] = bflo(y0.y) + bflo(y1.y); y[3] = bfhi(y0.y) + bfhi(y1.y);
                const f32x4 xv = rx[q][j], g2 = *(const f32x4*)(mod[q] + 5120 + k);
                v[q][j] = xv * ALPHA + g2 * y; s[q] += (v[q][j][0] + v[q][j][1]) + (v[q][j][2] + v[q][j][3]);
            }
        }
        if (row0 + rstride < rows_total) LN2_FETCH(row0 + rstride)
        float mean[2], rstd[2];
#pragma unroll
        for (int q = 0; q < 2; ++q) mean[q] = wave_sum(s[q]) * (1.0f / 1024.0f);
#pragma unroll
        for (int q = 0; q < 2; ++q) {
            float s2 = 0.f;
#pragma unroll
            for (int j = 0; j < 4; ++j) { v[q][j] = v[q][j] - mean[q]; s2 += (v[q][j][0] * v[q][j][0] + v[q][j][1] * v[q][j][1]) + (v[q][j][2] * v[q][j][2] + v[q][j][3] * v[q][j][3]); }
            s[q] = s2;
        }
#pragma unroll
        for (int q = 0; q < 2; ++q) rstd[q] = 1.0f / sqrtf(wave_sum(s[q]) * (1.0f / 1024.0f) + LN_EPS);
#pragma unroll
        for (int q = 0; q < 2; ++q) {
            const int row = row0 + q;
            const float* modn = mod[q] + (l + 1 < 4 ? 9 * 6144 : 0);
#pragma unroll
            for (int j = 0; j < 4; ++j) {
                const int k = 256 * j + 4 * lane;
                const f32x4 xn = v[q][j] * rstd[q] * *(const f32x4*)(lng + k) + *(const f32x4*)(lnb + k);
                if (l < 3) {
                    xstore(Xo + (size_t)row * 1024 + k, xn);
                    const f32x4 uu = xn * (1.0f + *(const f32x4*)(modn + 1024 + k)) + *(const f32x4*)(modn + k);
                    u32x2 w; w.x = pk2(uu[0], uu[1]); w.y = pk2(uu[2], uu[3]);
                    *(u32x2*)(U + (size_t)row * 1024 + k) = w;
                } else {
                    *(f32x4*)(p->out + (size_t)row * 1024 + k) = xn;
                }
            }
        }
    }
}

DI s16x4 tr_read(const unsigned char* ptr) {
    typedef short v4i16_t __attribute__((ext_vector_type(4)));
    return __builtin_bit_cast(s16x4, __builtin_amdgcn_ds_read_tr16_b64_v4i16((LAS v4i16_t*)ptr));
}
DI bf16x8 cat8(s16x4 a, s16x4 b) { return __builtin_shufflevector(a, b, 0, 1, 2, 3, 4, 5, 6, 7); }

DI void phase_decay(KP p, int l, unsigned char* smem) {
    const int tid = TIDX();
    const int li = l >> 1;
    const float* LR = (const float*)(p->ws + WS_LR); float* TOT = (float*)(p->ws + WS_TOT);
    const bf16_t* Z = (const bf16_t*)(p->ws + WS_Z);
    float* lrs = (float*)smem;
    float* cum = lrs + 64 * 16;
    float wf[16], wb[16];
#pragma unroll
    for (int r = 0; r < 16; ++r) { wf[r] = p->in[11][(size_t)li * 16 * 256 + r * 256 + tid]; wb[r] = p->in[13][(size_t)li * 16 * 256 + r * 256 + tid]; }
    const float bf = p->in[12][li * 256 + tid], bb = p->in[14][li * 256 + tid];
    for (int it = BIDX(); it < 2 * (MT / 64); it += gridDim.x) {
        const int ch = it >> 1, dr = it & 1;
        const int row0 = ch * 64;
        bf16_t* QD = (bf16_t*)(p->ws + (dr ? WS_QDB : WS_QDF)); bf16_t* KD = QD + (size_t)MT * 256;
        __syncthreads();
        { const int tok = tid >> 2, q4 = tid & 3; *(f32x4*)(lrs + tok * 16 + q4 * 4) = *(const f32x4*)(LR + (size_t)(row0 + tok) * 32 + dr * 16 + q4 * 4); }
        __syncthreads();
        float run = 0.f;
#pragma unroll 1
        for (int half = 0; half < 2; ++half) {
            const int base = dr ? 32 - 32 * half : 32 * half;
            u32x4 qv[4], kv[4];
#pragma unroll
            for (int i = 0; i < 4; ++i) {
                const int id = tid + 256 * i, tokl = id >> 5, cg = id & 31;
                const size_t zr = (size_t)(row0 + base + tokl) * ZS;
                qv[i] = *(const u32x4*)(Z + zr + 2048 + cg * 8); kv[i] = *(const u32x4*)(Z + zr + 2304 + cg * 8);
            }
            if (dr == 0) {
                for (int t = base; t < base + 32; ++t) {
                    float g = bf;
#pragma unroll
                    for (int r = 0; r < 16; ++r) g += lrs[t * 16 + r] * wf[r];
                    run += (fminf(g, 0.f) - __logf(1.0f + __expf(-fabsf(g)))) * (1.0f / 16.0f);
                    cum[(t - base) * 256 + tid] = run;
                }
            } else {
                cum[32 * 256 + tid] = run;
                for (int t = base + 31; t >= base; --t) {
                    float g = bb;
#pragma unroll
                    for (int r = 0; r < 16; ++r) g += lrs[t * 16 + r] * wb[r];
                    run += (fminf(g, 0.f) - __logf(1.0f + __expf(-fabsf(g)))) * (1.0f / 16.0f);
                    cum[(t - base) * 256 + tid] = run;
                }
            }
            __syncthreads();
#pragma unroll
            for (int i = 0; i < 4; ++i) {
                const int id = tid + 256 * i, tokl = id >> 5, cg = id & 31;
                const float* ce = cum + tokl * 256 + cg * 8;
                const float* cq = dr ? ce + 256 : ce;
                const f32x4 a0 = *(const f32x4*)cq, a1 = *(const f32x4*)(cq + 4), b0 = *(const f32x4*)ce, b1 = *(const f32x4*)(ce + 4);
                float fqv[8], fkv[8];
#pragma unroll
                for (int e = 0; e < 4; ++e) { fqv[e] = __expf(a0[e]); fqv[4 + e] = __expf(a1[e]); fkv[e] = __expf(-b0[e]); fkv[4 + e] = __expf(-b1[e]); }
                const u32x4 q = qv[i], k = kv[i]; u32x4 qo, ko;
                qo.x = pk2(bflo(q.x) * fqv[0], bfhi(q.x) * fqv[1]); qo.y = pk2(bflo(q.y) * fqv[2], bfhi(q.y) * fqv[3]); qo.z = pk2(bflo(q.z) * fqv[4], bfhi(q.z) * fqv[5]); qo.w = pk2(bflo(q.w) * fqv[6], bfhi(q.w) * fqv[7]);
                ko.x = pk2(bflo(k.x) * fkv[0], bfhi(k.x) * fkv[1]); ko.y = pk2(bflo(k.y) * fkv[2], bfhi(k.y) * fkv[3]); ko.z = pk2(bflo(k.z) * fkv[4], bfhi(k.z) * fkv[5]); ko.w = pk2(bflo(k.w) * fkv[6], bfhi(k.w) * fkv[7]);
                const size_t orow = (size_t)(row0 + base + tokl) * 256 + cg * 8;
                *(u32x4*)(QD + orow) = qo; *(u32x4*)(KD + orow) = ko;
            }
            __syncthreads();
        }
        TOT[(size_t)(ch * 2 + dr) * 256 + tid] = run;
    }
}

template <int DK>
DI void scan_item(KP p, int l, int item, unsigned char* smem) {
    constexpr bool ISA = (DK == 128);
    constexpr int QS = DK * 2 + 16, KS = DK * 2 + 32, VS = 96, AS_ = 144, SS = DK * 2 + 16, NKS = DK / 32, NMT = DK / 64;
    constexpr int O_QD = 0, O_KD = O_QD + 64 * QS, O_V = O_KD + 64 * KS, O_ATT = O_V + 64 * VS, O_ST = O_ATT + 64 * AS_, O_END = O_ST + 32 * SS;
    static_assert(O_END <= 65536, "scan LDS");
    constexpr int NP = DK / 64 * 2;
    constexpr int CPR = DK / 8;
    const int tid = TIDX(), wid = tid >> 6, lane = tid & 63, fr = lane & 15, fq = lane >> 4;
    const int b = item >> 5, h = (item >> 3) & 3, dir = (item >> 2) & 1, dvq = item & 3;
    const bf16_t* Z = (const bf16_t*)(p->ws + WS_Z);
    const bf16_t* QDg = (const bf16_t*)(p->ws + (dir ? WS_QDB : WS_QDF)); const bf16_t* KDg = QDg + (size_t)MT * 256; const float* TOT = (const float*)(p->ws + WS_TOT);
    bf16_t* OUT = (bf16_t*)(p->ws + (dir ? WS_OB : WS_OF));
    const int qcol = ISA ? h * 128 : 2048 + h * 64, kcol = ISA ? 512 + h * 128 : 2304 + h * 64, vcol = (ISA ? 1024 : 2560) + h * 128 + dvq * 32;
    const int ocol = (ISA ? 0 : 512) + h * 128 + dvq * 32;
    float lam = 0.f;
    if (ISA) lam = log1pf(-exp2f(-((dir ? 5.5f : 5.0f) + (float)h)));
    f32x4 S[NMT][2];
#pragma unroll
    for (int a = 0; a < NMT; ++a) { S[a][0] = (f32x4){0.f, 0.f, 0.f, 0.f}; S[a][1] = (f32x4){0.f, 0.f, 0.f, 0.f}; }
    __syncthreads();
    for (int i = tid; i < 32 * SS / 4; i += 256) ((unsigned*)(smem + O_ST))[i] = 0u;
    auto chunk_row0 = [&](int cc) -> int {
        const int ci = dir ? 35 - cc : cc; const int pp = ci * 64;
        if (!dir) return pp < 256 ? ML + b * 256 + pp : b * 2048 + (pp - 256);
        return pp < 2048 ? b * 2048 + pp : ML + b * 256 + (pp - 2048);
    };
    u32x4 rq[NP], rk[NP], rv; f32x4 tv[NMT];
    auto fetch = [&](int cc) {
        const int row0 = chunk_row0(cc);
        if (!ISA) {
#pragma unroll
            for (int a = 0; a < NMT; ++a) tv[a] = *(const f32x4*)(TOT + (size_t)((row0 >> 6) * 2 + dir) * 256 + h * 64 + (wid * NMT + a) * 16 + fq * 4);
        }
#pragma unroll
        for (int i = 0; i < NP; ++i) {
            const int id = tid + 256 * i, tok = id / CPR, cg_ = id % CPR;
            if (ISA) {
                const size_t ro = (size_t)(row0 + tok) * ZS;
                rq[i] = *(const u32x4*)(Z + ro + qcol + cg_ * 8); rk[i] = *(const u32x4*)(Z + ro + kcol + cg_ * 8);
            } else {
                const size_t eo = (size_t)(row0 + tok) * 256 + h * 64 + cg_ * 8;
                rq[i] = *(const u32x4*)(QDg + eo); rk[i] = *(const u32x4*)(KDg + eo);
            }
        }
        { const int tok = tid >> 2, cg_ = tid & 3; rv = *(const u32x4*)(Z + (size_t)(row0 + tok) * ZS + vcol + cg_ * 8); }
    };
    float ra[NP], rc[NP];
#pragma unroll
    for (int i = 0; i < NP; ++i) {
        const int tok = (tid + 256 * i) / CPR;
        ra[i] = dir ? __expf(lam * (float)(63 - tok)) : __expf(lam * (float)(tok + 1));
        rc[i] = dir ? __expf(-lam * (float)(64 - tok)) : __expf(-lam * (float)(tok + 1));
    }
    const float decA = __expf(lam * 64.0f);
    fetch(0);
    for (int cc = 0; cc < 36; ++cc) {
        const int row0 = chunk_row0(cc);
#pragma unroll
        for (int i = 0; i < NP; ++i) {
            const int id = tid + 256 * i, tok = id / CPR, cg_ = id % CPR;
            const u32x4 q = rq[i], k = rk[i]; u32x4 qo = q, ko = k;
            if (ISA) {
                const float fqv = ra[i], fkv = rc[i];
                qo.x = pk2(bflo(q.x) * fqv, bfhi(q.x) * fqv); qo.y = pk2(bflo(q.y) * fqv, bfhi(q.y) * fqv); qo.z = pk2(bflo(q.z) * fqv, bfhi(q.z) * fqv); qo.w = pk2(bflo(q.w) * fqv, bfhi(q.w) * fqv);
                ko.x = pk2(bflo(k.x) * fkv, bfhi(k.x) * fkv); ko.y = pk2(bflo(k.y) * fkv, bfhi(k.y) * fkv); ko.z = pk2(bflo(k.z) * fkv, bfhi(k.z) * fkv); ko.w = pk2(bflo(k.w) * fkv, bfhi(k.w) * fkv);
            }
            *(u32x4*)(smem + O_QD + tok * QS + cg_ * 16) = qo;
            *(u32x4*)(smem + O_KD + tok * KS + cg_ * 16) = ko;
        }
        { const int tok = tid >> 2, cg_ = tid & 3; *(u32x4*)(smem + O_V + tok * VS + cg_ * 16) = rv; }
        f32x4 dec[NMT];
#pragma unroll
        for (int a = 0; a < NMT; ++a) {
            if (ISA) dec[a] = (f32x4){decA, decA, decA, decA};
            else dec[a] = (f32x4){__expf(tv[a][0]), __expf(tv[a][1]), __expf(tv[a][2]), __expf(tv[a][3])};
        }
        if (cc + 1 < 36) fetch(cc + 1);
        __syncthreads();
        bf16x8 afr[2];
        {
            f32x4 at[4];
#pragma unroll
            for (int n = 0; n < 4; ++n) at[n] = (f32x4){0.f, 0.f, 0.f, 0.f};
#pragma unroll
            for (int ks = 0; ks < NKS; ++ks) {
                const bf16x8 qf = *(const bf16x8*)(smem + O_QD + (16 * wid + fr) * QS + (32 * ks + 8 * fq) * 2);
#pragma unroll
                for (int n = 0; n < 4; ++n) {
                    const bf16x8 kf = *(const bf16x8*)(smem + O_KD + (16 * n + fr) * KS + (32 * ks + 8 * fq) * 2);
                    at[n] = __builtin_amdgcn_mfma_f32_16x16x32_bf16(kf, qf, at[n], 0, 0, 0);
                }
            }
            const int i = 16 * wid + fr;
#pragma unroll
            for (int n = 0; n < 4; ++n)
#pragma unroll
                for (int jj = 0; jj < 4; ++jj) { const int j = n * 16 + fq * 4 + jj; const bool keep = dir ? (j > i) : (j <= i); at[n][jj] = keep ? at[n][jj] : 0.f; }
#pragma unroll
            for (int ks = 0; ks < 2; ++ks) {
                u32x4 w; w.x = pk2(at[2 * ks][0], at[2 * ks][1]); w.y = pk2(at[2 * ks][2], at[2 * ks][3]); w.z = pk2(at[2 * ks + 1][0], at[2 * ks + 1][1]); w.w = pk2(at[2 * ks + 1][2], at[2 * ks + 1][3]);
                afr[ks] = __builtin_bit_cast(bf16x8, w);
            }
        }
        bf16x8 vf[2][2];
        {
            const int g = lane >> 4, i16 = lane & 15, q = i16 >> 2, pq = i16 & 3;
#pragma unroll
            for (int ks = 0; ks < 2; ++ks)
#pragma unroll
                for (int n = 0; n < 2; ++n) {
                    const unsigned char* a = smem + O_V + (32 * ks + 4 * g + q) * VS + (n * 16 + 4 * pq) * 2;
                    vf[ks][n] = cat8(tr_read(a), tr_read(a + 16 * VS));
                }
        }
        {
            f32x4 oa[2] = {(f32x4){0.f, 0.f, 0.f, 0.f}, (f32x4){0.f, 0.f, 0.f, 0.f}};
#pragma unroll
            for (int ks = 0; ks < 2; ++ks)
#pragma unroll
                for (int n = 0; n < 2; ++n) oa[n] = __builtin_amdgcn_mfma_f32_16x16x32_bf16(vf[ks][n], afr[ks], oa[n], 0, 0, 0);
#pragma unroll
            for (int ks = 0; ks < NKS; ++ks) {
                const bf16x8 qf = *(const bf16x8*)(smem + O_QD + (16 * wid + fr) * QS + (32 * ks + 8 * fq) * 2);
#pragma unroll
                for (int n = 0; n < 2; ++n) {
                    const bf16x8 sf = *(const bf16x8*)(smem + O_ST + (16 * n + fr) * SS + (32 * ks + 8 * fq) * 2);
                    oa[n] = __builtin_amdgcn_mfma_f32_16x16x32_bf16(sf, qf, oa[n], 0, 0, 0);
                }
            }
            bf16_t* o = OUT + (size_t)(row0 + 16 * wid + fr) * 1024 + ocol + fq * 4;
            u32x2 w0, w1; w0.x = pk2(oa[0][0], oa[0][1]); w0.y = pk2(oa[0][2], oa[0][3]); w1.x = pk2(oa[1][0], oa[1][1]); w1.y = pk2(oa[1][2], oa[1][3]);
            *(u32x2*)(o) = w0; *(u32x2*)(o + 16) = w1;
        }
        {
            const int g = lane >> 4, i16 = lane & 15, q = i16 >> 2, pq = i16 & 3;
#pragma unroll
            for (int a = 0; a < NMT; ++a) {
                const int mt = wid * NMT + a;
#pragma unroll
                for (int ks = 0; ks < 2; ++ks) {
                    const unsigned char* ka = smem + O_KD + (32 * ks + 4 * g + q) * KS + (mt * 16 + 4 * pq) * 2;
                    const bf16x8 kf = cat8(tr_read(ka), tr_read(ka + 16 * KS));
#pragma unroll
                    for (int n = 0; n < 2; ++n) S[a][n] = __builtin_amdgcn_mfma_f32_16x16x32_bf16(kf, vf[ks][n], S[a][n], 0, 0, 0);
                }
                S[a][0] *= dec[a]; S[a][1] *= dec[a];
            }
        }
        __syncthreads();
#pragma unroll
        for (int a = 0; a < NMT; ++a) {
            const int mt = wid * NMT + a;
#pragma unroll
            for (int n = 0; n < 2; ++n) { u32x2 w; w.x = pk2(S[a][n][0], S[a][n][1]); w.y = pk2(S[a][n][2], S[a][n][3]); *(u32x2*)(smem + O_ST + (n * 16 + fr) * SS + (mt * 16 + fq * 4) * 2) = w; }
        }
    }
    __syncthreads();
}
DI void phase_scan(KP p, int l, unsigned char* smem) {
    for (int it = BIDX(); it < 512; it += gridDim.x) {
        const int item = (it & 7) * 32 + ((it >> 3) & 31);
        if (it < 256) scan_item<128>(p, l, item, smem); else scan_item<64>(p, l, item, smem);
    }
}

DI void phase_merge(KP p, int l) {
    const int tid = TIDX(), wave = tid >> 6, lane = tid & 63;
    const int li = l >> 1;
    const bf16_t* OF = (const bf16_t*)(p->ws + WS_OF); const bf16_t* OB = (const bf16_t*)(p->ws + WS_OB);
    const bf16_t* Z = (const bf16_t*)(p->ws + WS_Z); bf16_t* Y = (bf16_t*)(p->ws + WS_Y);
    const bool isA = lane < 32;
    const float* gn = isA ? p->in[15] + li * 512 + lane * 16 : p->in[16] + li * 512 + (lane - 32) * 16;
    const int gcol = isA ? 1536 + lane * 16 : 3072 + (lane - 32) * 16;
    for (int row = BIDX() * 4 + wave; row < MT; row += gridDim.x * 4) {
        float o[16]; float s = 0.f;
#pragma unroll
        for (int j = 0; j < 2; ++j) {
            const u32x4 a = *(const u32x4*)(OF + (size_t)row * 1024 + lane * 16 + j * 8), bb = *(const u32x4*)(OB + (size_t)row * 1024 + lane * 16 + j * 8);
            o[j * 8 + 0] = bflo(a.x) + bflo(bb.x); o[j * 8 + 1] = bfhi(a.x) + bfhi(bb.x); o[j * 8 + 2] = bflo(a.y) + bflo(bb.y); o[j * 8 + 3] = bfhi(a.y) + bfhi(bb.y);
            o[j * 8 + 4] = bflo(a.z) + bflo(bb.z); o[j * 8 + 5] = bfhi(a.z) + bfhi(bb.z); o[j * 8 + 6] = bflo(a.w) + bflo(bb.w); o[j * 8 + 7] = bfhi(a.w) + bfhi(bb.w);
        }
#pragma unroll
        for (int e = 0; e < 16; ++e) s += o[e];
        s += __shfl_xor(s, 1); s += __shfl_xor(s, 2); s += __shfl_xor(s, 4);
        const float mean = isA ? s * (1.0f / 128.0f) : 0.f;
        float s2 = 0.f;
#pragma unroll
        for (int e = 0; e < 16; ++e) { o[e] -= mean; s2 += o[e] * o[e]; }
        s2 += __shfl_xor(s2, 1); s2 += __shfl_xor(s2, 2); s2 += __shfl_xor(s2, 4);
        const float rs = 1.0f / sqrtf(s2 * (1.0f / 128.0f) + LN_EPS);
        const u32x4 g0 = *(const u32x4*)(Z + (size_t)row * ZS + gcol), g1 = *(const u32x4*)(Z + (size_t)row * ZS + gcol + 8);
        float gt[16];
        gt[0] = bflo(g0.x); gt[1] = bfhi(g0.x); gt[2] = bflo(g0.y); gt[3] = bfhi(g0.y); gt[4] = bflo(g0.z); gt[5] = bfhi(g0.z); gt[6] = bflo(g0.w); gt[7] = bfhi(g0.w);
        gt[8] = bflo(g1.x); gt[9] = bfhi(g1.x); gt[10] = bflo(g1.y); gt[11] = bfhi(g1.y); gt[12] = bflo(g1.z); gt[13] = bfhi(g1.z); gt[14] = bflo(g1.w); gt[15] = bfhi(g1.w);
        float y[16];
#pragma unroll
        for (int e = 0; e < 16; ++e) y[e] = siluf(gt[e]) * (o[e] * rs * gn[e]);
        u32x4 w0, w1;
        w0.x = pk2(y[0], y[1]); w0.y = pk2(y[2], y[3]); w0.z = pk2(y[4], y[5]); w0.w = pk2(y[6], y[7]);
        w1.x = pk2(y[8], y[9]); w1.y = pk2(y[10], y[11]); w1.z = pk2(y[12], y[13]); w1.w = pk2(y[14], y[15]);
        *(u32x4*)(Y + (size_t)row * 1024 + lane * 16) = w0; *(u32x4*)(Y + (size_t)row * 1024 + lane * 16 + 8) = w1;
    }
}

DI int crow(int r, int hi) { return (r & 3) + 8 * (r >> 2) + 4 * hi; }
constexpr int ATT_BUF = 24576;
DI void att_component(const bf16_t* Qc, const bf16_t* Kc, const bf16_t* Vt, unsigned char* smem, float* wsf, int b, int h, int comp, int p0, int nkv, f32x16 (&O)[4]) {
    const int tid = TIDX(), wid = tid >> 6, lane = tid & 63, r32 = lane & 31, hi = lane >> 5;
    const int hc = h * 2 + comp;
    const bf16_t* Qb = Qc + ((size_t)(b * 16 + hc) * TA + p0 + wid * 32 + r32) * 64;
    const int gch = gemm_chunk(tid);
    const bf16_t* Kg = Kc + (size_t)(b * 16 + hc) * TA * 64 + (size_t)(tid >> 3) * 64 + gch * 8;
    const bf16_t* Vg = Vt + (size_t)(b * 8 + h) * 128 * TA + (size_t)(tid >> 3) * TA + gch * 8;
#define ATT_STAGE(buf, kt) do { \
        _Pragma("unroll") for (int i_ = 0; i_ < 2; ++i_) __builtin_amdgcn_global_load_lds((const unsigned*)(Kg + (size_t)((kt) + 32 * i_) * 64), (LAS unsigned*)(smem + (buf) * ATT_BUF + i_ * 4096 + tid * 16), 16, 0, 0); \
        _Pragma("unroll") for (int i_ = 0; i_ < 4; ++i_) __builtin_amdgcn_global_load_lds((const unsigned*)(Vg + (size_t)(32 * i_) * TA + (kt)), (LAS unsigned*)(smem + (buf) * ATT_BUF + 8192 + i_ * 4096 + tid * 16), 16, 0, 0); } while (0)
    ATT_STAGE(0, 0);
    bf16x8 qf[4];
#pragma unroll
    for (int ks = 0; ks < 4; ++ks) qf[ks] = *(const bf16x8*)(Qb + ks * 16 + hi * 8);
#pragma unroll
    for (int d0 = 0; d0 < 4; ++d0)
#pragma unroll
        for (int r = 0; r < 16; ++r) O[d0][r] = 0.f;
    float m_run = -1.0e30f, l_run = 0.f;
    const int sw = (r32 >> 1) & 7;
    const int nt = nkv >> 6;
    for (int t = 0; t < nt; ++t) {
        asm volatile("s_waitcnt vmcnt(0)" ::: "memory");
        __syncthreads();
        if (t + 1 < nt) ATT_STAGE((t + 1) & 1, (t + 1) * 64);
        const unsigned char* Kt = smem + (t & 1) * ATT_BUF; const unsigned char* Vtl = Kt + 8192;
        bf16x8 kf0[4], kf1[4];
#pragma unroll
        for (int ks = 0; ks < 4; ++ks) {
            const unsigned co = (unsigned)(((ks * 2 + hi) ^ sw) << 4);
            kf0[ks] = *(const bf16x8*)(Kt + r32 * 128 + co);
            kf1[ks] = *(const bf16x8*)(Kt + (32 + r32) * 128 + co);
        }
        const unsigned char* vr = Vtl + r32 * 128;
#define ATT_VLOAD(dst, st_) do { const unsigned o1_ = (unsigned)((((st_) * 2 + hi) ^ sw) << 4); \
        _Pragma("unroll") for (int d0_ = 0; d0_ < 4; ++d0_) dst[d0_] = *(const bf16x8*)(vr + d0_ * 4096 + o1_); } while (0)
        bf16x8 va[4], vb[4];
        ATT_VLOAD(va, 0);
        f32x16 s0, s1;
#pragma unroll
        for (int r = 0; r < 16; ++r) { s0[r] = 0.f; s1[r] = 0.f; }
#pragma unroll
        for (int ks = 0; ks < 4; ++ks) {
            s0 = __builtin_amdgcn_mfma_f32_32x32x16_bf16(kf0[ks], qf[ks], s0, 0, 0, 0);
            s1 = __builtin_amdgcn_mfma_f32_32x32x16_bf16(kf1[ks], qf[ks], s1, 0, 0, 0);
        }
        float mxa[8];
#pragma unroll
        for (int i_ = 0; i_ < 8; ++i_) mxa[i_] = fmaxf(fmaxf(s0[2 * i_], s0[2 * i_ + 1]), fmaxf(s1[2 * i_], s1[2 * i_ + 1]));
        float mx = fmaxf(fmaxf(fmaxf(mxa[0], mxa[1]), fmaxf(mxa[2], mxa[3])), fmaxf(fmaxf(mxa[4], mxa[5]), fmaxf(mxa[6], mxa[7])));
        { const auto rr = __builtin_amdgcn_permlane32_swap(__float_as_uint(mx), __float_as_uint(mx), false, false); mx = fmaxf(__uint_as_float(rr[0]), __uint_as_float(rr[1])); }
        if (__any(mx > m_run + 8.0f)) {
            const float m_new = fmaxf(m_run, mx);
            const float alpha = __builtin_amdgcn_exp2f((m_run - m_new) * L2E);
            l_run *= alpha; m_run = m_new;
            if (hi == 0) wsf[r32] = alpha;
            asm volatile("s_waitcnt lgkmcnt(0)" ::: "memory");
            float ar[16];
#pragma unroll
            for (int r = 0; r < 16; ++r) ar[r] = wsf[crow(r, hi)];
#pragma unroll
            for (int d0 = 0; d0 < 4; ++d0)
#pragma unroll
                for (int r = 0; r < 16; ++r) O[d0][r] *= ar[r];
            asm volatile("s_waitcnt lgkmcnt(0)" ::: "memory");
        }
        const float mb = m_run * L2E;
        float ps = 0.f;
#pragma unroll
        for (int r = 0; r < 16; ++r) { s0[r] = __builtin_amdgcn_exp2f(s0[r] * L2E - mb); s1[r] = __builtin_amdgcn_exp2f(s1[r] * L2E - mb); ps += s0[r] + s1[r]; }
        l_run += ps;
        u32x4 pw[4];
#pragma unroll
        for (int s = 0; s < 2; ++s) {
            pw[s].x = pk2(s0[8 * s + 0], s0[8 * s + 1]); pw[s].y = pk2(s0[8 * s + 2], s0[8 * s + 3]); pw[s].z = pk2(s0[8 * s + 4], s0[8 * s + 5]); pw[s].w = pk2(s0[8 * s + 6], s0[8 * s + 7]);
            pw[2 + s].x = pk2(s1[8 * s + 0], s1[8 * s + 1]); pw[2 + s].y = pk2(s1[8 * s + 2], s1[8 * s + 3]); pw[2 + s].z = pk2(s1[8 * s + 4], s1[8 * s + 5]); pw[2 + s].w = pk2(s1[8 * s + 6], s1[8 * s + 7]);
        }
#pragma unroll
        ATT_VLOAD(vb, 1);
#pragma unroll
        for (int d0 = 0; d0 < 4; ++d0) O[d0] = __builtin_amdgcn_mfma_f32_32x32x16_bf16(__builtin_bit_cast(bf16x8, pw[0]), va[d0], O[d0], 0, 0, 0);
        ATT_VLOAD(va, 2);
#pragma unroll
        for (int d0 = 0; d0 < 4; ++d0) O[d0] = __builtin_amdgcn_mfma_f32_32x32x16_bf16(__builtin_bit_cast(bf16x8, pw[1]), vb[d0], O[d0], 0, 0, 0);
        ATT_VLOAD(vb, 3);
#pragma unroll
        for (int d0 = 0; d0 < 4; ++d0) O[d0] = __builtin_amdgcn_mfma_f32_32x32x16_bf16(__builtin_bit_cast(bf16x8, pw[2]), va[d0], O[d0], 0, 0, 0);
#pragma unroll
        for (int d0 = 0; d0 < 4; ++d0) O[d0] = __builtin_amdgcn_mfma_f32_32x32x16_bf16(__builtin_bit_cast(bf16x8, pw[3]), vb[d0], O[d0], 0, 0, 0);
#undef ATT_VLOAD
    }
#undef ATT_STAGE
    l_run += __shfl_xor(l_run, 32);
    asm volatile("s_waitcnt lgkmcnt(0)" ::: "memory");
    if (hi == 0) wsf[r32] = 1.0f / l_run;
    asm volatile("s_waitcnt lgkmcnt(0)" ::: "memory");
    float ar[16];
#pragma unroll
    for (int r = 0; r < 16; ++r) ar[r] = wsf[crow(r, hi)];
    asm volatile("s_waitcnt lgkmcnt(0)" ::: "memory");
#pragma unroll
    for (int d0 = 0; d0 < 4; ++d0)
#pragma unroll
        for (int r = 0; r < 16; ++r) O[d0][r] *= ar[r];
}

DI void phase_att(KP p, int l, unsigned char* smem) {
    constexpr int O_WS = 2 * ATT_BUF;
    const int tid = TIDX(), wid = tid >> 6, lane = tid & 63, r32 = lane & 31, hi = lane >> 5;
    const int li = l >> 1;
    const bf16_t* Qc = (const bf16_t*)(p->ws + WS_QC); const bf16_t* Kc = (const bf16_t*)(p->ws + WS_KC); const bf16_t* Vt = (const bf16_t*)(p->ws + WS_VT);
    bf16_t* Y = (bf16_t*)(p->ws + WS_Y);
    float* stash = (float*)(p->ws + WS_P) + ((size_t)BIDX() * 256 + tid) * 32;
    const float lam_init = 0.8f - 0.6f * expf(-0.3f * (float)l);
    float* wsf = (float*)(smem + O_WS) + wid * 32;
    const int per_x = (l == 3) ? 128 : 144;
    for (int i = 0;; ++i) {
        int b, h, p0, nkv;
        {
            const int G = gridDim.x, bid = BIDX();
            int item;
            if ((G & 7) == 0) { const int x = bid & 7, q = i * (G >> 3) + (bid >> 3); if (q >= per_x) break; item = q < 128 ? x * 128 + q : 1024 + x * 16 + (q - 128); }
            else { item = i * G + bid; if (item >= 8 * per_x) break; }
            if (item < 1024) { b = item >> 7; h = (item >> 4) & 7; p0 = 256 + (item & 15) * 128; nkv = TA; }
            else { const int q = item - 1024; b = q >> 4; h = (q >> 1) & 7; p0 = (q & 1) * 128; nkv = TC; }
        }
        float d1 = 0.f, d2 = 0.f;
        { const float* lq1 = p->in[19] + (li * 8 + h) * 64, *lk1 = p->in[20] + (li * 8 + h) * 64, *lq2 = p->in[21] + (li * 8 + h) * 64, *lk2 = p->in[22] + (li * 8 + h) * 64;
          d1 = wave_sum(lq1[lane] * lk1[lane]); d2 = wave_sum(lq2[lane] * lk2[lane]); }
        const float lamv = expf(d1) - expf(d2) + lam_init;
        f32x16 On[4];
        __syncthreads();
        att_component(Qc, Kc, Vt, smem, wsf, b, h, 0, p0, nkv, On);
#pragma unroll
        for (int d0 = 0; d0 < 4; ++d0)
#pragma unroll
            for (int r = 0; r < 16; r += 8) {
                u32x4 w; w.x = pk2(On[d0][r], On[d0][r + 1]); w.y = pk2(On[d0][r + 2], On[d0][r + 3]); w.z = pk2(On[d0][r + 4], On[d0][r + 5]); w.w = pk2(On[d0][r + 6], On[d0][r + 7]);
                *(u32x4*)(stash + (d0 * 16 + r) / 2) = w;
            }
        __syncthreads();
        att_component(Qc, Kc, Vt, smem, wsf, b, h, 1, p0, nkv, On);
#pragma unroll
        for (int d0 = 0; d0 < 4; ++d0)
#pragma unroll
            for (int r = 0; r < 16; r += 8) {
                const u32x4 w = *(const u32x4*)(stash + (d0 * 16 + r) / 2);
                On[d0][r] = bflo(w.x) - lamv * On[d0][r]; On[d0][r + 1] = bfhi(w.x) - lamv * On[d0][r + 1]; On[d0][r + 2] = bflo(w.y) - lamv * On[d0][r + 2]; On[d0][r + 3] = bfhi(w.y) - lamv * On[d0][r + 3];
                On[d0][r + 4] = bflo(w.z) - lamv * On[d0][r + 4]; On[d0][r + 5] = bfhi(w.z) - lamv * On[d0][r + 5]; On[d0][r + 6] = bflo(w.w) - lamv * On[d0][r + 6]; On[d0][r + 7] = bfhi(w.w) - lamv * On[d0][r + 7];
            }
        float ms[16];
#pragma unroll
        for (int r = 0; r < 16; ++r) {
            float s = (On[0][r] * On[0][r] + On[1][r] * On[1][r]) + (On[2][r] * On[2][r] + On[3][r] * On[3][r]);
            s += __shfl_xor(s, 1); s += __shfl_xor(s, 2); s += __shfl_xor(s, 4); s += __shfl_xor(s, 8); s += __shfl_xor(s, 16);
            ms[r] = __builtin_amdgcn_rsqf(s * (1.0f / 128.0f) + LN_EPS);
        }
        const float* sg = p->in[23] + li * 1024 + h * 128;
        const float post = 1.0f - lam_init;
        float gsc[4];
#pragma unroll
        for (int d0 = 0; d0 < 4; ++d0) gsc[d0] = sg[d0 * 32 + r32] * post;
        __syncthreads();
        unsigned char* stg = smem + wid * 8192;
#pragma unroll
        for (int r = 0; r < 16; ++r) {
            unsigned char* sp = stg + crow(r, hi) * 256 + r32 * 2;
#pragma unroll
            for (int d0 = 0; d0 < 4; ++d0) *(unsigned short*)(sp + d0 * 64) = (unsigned short)f2bf(On[d0][r] * ms[r] * gsc[d0]);
        }
        asm volatile("s_waitcnt lgkmcnt(0)" ::: "memory");
#pragma unroll
        for (int i2 = 0; i2 < 8; ++i2) {
            const int id = lane + 64 * i2, qr = id >> 4, ch = id & 15;
            const int pq = p0 + wid * 32 + qr;
            const int row = pq < 256 ? ML + b * 256 + pq : b * 2048 + (pq - 256);
            *(u32x4*)(Y + (size_t)row * 1024 + h * 128 + ch * 8) = *(const u32x4*)(stg + qr * 256 + ch * 16);
        }
        asm volatile("s_waitcnt lgkmcnt(0)" ::: "memory");
    }
}

#define XB_TMO      128
#define XB_XCNT(j)  (256  + 64 * (j))
#define XB_XSUB(j)  (1280 + 64 * (j))
#define XB_XGEN(j)  (2304 + 64 * (j))
#define XB_TOP      3328
#define XB_TOPGEN   3392
#define XCD_BAR_WORDS 3456
#define XB_SPIN_CAP (1u << 22)
DI unsigned xb_ld(unsigned* p)              { return __hip_atomic_load(p, __ATOMIC_RELAXED, __HIP_MEMORY_SCOPE_AGENT); }
DI unsigned xb_add(unsigned* p, unsigned v) { return __hip_atomic_fetch_add(p, v, __ATOMIC_RELAXED, __HIP_MEMORY_SCOPE_AGENT); }
DI unsigned xb_xcc_id() { return (unsigned)__builtin_amdgcn_s_getreg((3 << 11) | 20) & 0xFu; }
#define XB_SPIN(cond, bar) do { unsigned _sp = 0; while (cond) { __builtin_amdgcn_s_sleep(1); \
    if ((++_sp & 255u) == 0u) { if (xb_ld(&(bar)[XB_TMO])) break; if (_sp > XB_SPIN_CAP) { atomicAdd(&(bar)[XB_TMO], 1u); break; } } } } while (0)
struct XcdBarrier { unsigned* bar; unsigned x; volatile LAS unsigned* st; };
DI XcdBarrier xcd_barrier_post(unsigned* bar, volatile LAS unsigned* st) {
    XcdBarrier b; b.bar = bar; b.x = xb_xcc_id(); b.st = st;
    if (threadIdx.x == 0) (void)xb_add(&bar[XB_XCNT(b.x)], 1u);
    return b;
}
DI void xcd_barrier_complete(unsigned* bar, unsigned x, unsigned& nloc, unsigned& nx) {
    const unsigned G = gridDim.x * gridDim.y * gridDim.z;
    unsigned sum, cnt, mine, sp = 0u;
    for (;;) {
        sum = 0u; cnt = 0u; mine = 0u;
#pragma unroll
        for (unsigned j = 0; j < 16; ++j) { const unsigned c = xb_ld(&bar[XB_XCNT(j)]); sum += c; cnt += (c > 0u) ? 1u : 0u; mine = (j == x) ? c : mine; }
        if (sum == G) break;
        __builtin_amdgcn_s_sleep(1);
        if ((++sp & 255u) == 0u) { if (xb_ld(&bar[XB_TMO])) break; if (sp > XB_SPIN_CAP) { atomicAdd(&bar[XB_TMO], 1u); break; } }
    }
    nloc = mine > 0u ? mine : 1u; nx = cnt > 0u ? cnt : 1u;
}
DI void xcd_barrier(const XcdBarrier& b) {
    asm volatile("s_waitcnt vmcnt(0)" ::: "memory");
    __syncthreads();
    if (threadIdx.x == 0) {
        unsigned* bar = b.bar;
        __builtin_amdgcn_s_waitcnt(0);
        unsigned nloc = b.st[0], nx = b.st[1];
        if (nloc == 0u) { xcd_barrier_complete(bar, b.x, nloc, nx); b.st[0] = nloc; b.st[1] = nx; }
        const unsigned old = xb_add(&bar[XB_XSUB(b.x)], 1u);
        const unsigned gen = old / nloc;
        if (old + 1u == (gen + 1u) * nloc) {
            __builtin_amdgcn_fence(__ATOMIC_RELEASE, "agent");
            asm volatile("s_waitcnt vmcnt(0)" ::: "memory");
            const unsigned og = xb_add(&bar[XB_TOP], 1u);
            const unsigned tg = og / nx;
            if (og + 1u == (tg + 1u) * nx) xb_add(&bar[XB_TOPGEN], 1u);
            else XB_SPIN(xb_ld(&bar[XB_TOPGEN]) == tg, bar);
            __builtin_amdgcn_fence(__ATOMIC_ACQUIRE, "agent");
            xb_add(&bar[XB_XGEN(b.x)], 1u);
            asm volatile("s_waitcnt vmcnt(0)" ::: "memory");
        } else {
            XB_SPIN(xb_ld(&bar[XB_XGEN(b.x)]) == gen, bar);
            __builtin_amdgcn_fence(__ATOMIC_ACQUIRE, "agent");
            asm volatile("s_waitcnt vmcnt(0)" ::: "memory");
        }
    }
    __syncthreads();
}

#ifdef DOUBLE_MASK
#define DRYCOND (rep_ == 0 && nrep_ == 2)
#else
#define DRYCOND false
#endif
constexpr int NPHASE = 34;
constexpr int LDS_BYTES = 65536 + 1024;
__global__ void __launch_bounds__(256, 2) mega(Params pv) {
    extern __shared__ __attribute__((aligned(16))) unsigned char smem[];
    const int ph_lo = pv.ph_lo, ph_hi = pv.ph_hi;
    volatile LAS unsigned* bar_st = (volatile LAS unsigned*)(LAS unsigned char*)(smem + 65536);
    if (threadIdx.x == 0) { bar_st[0] = 0u; bar_st[1] = 0u; }
    __syncthreads();
    XcdBarrier xbar = xcd_barrier_post((unsigned*)(pv.ws + WS_CTL) + 4096, bar_st);
    for (int ph = ph_lo; ph < ph_hi; ++ph) {
        KP p = (KP)__builtin_amdgcn_kernarg_segment_ptr();
        asm volatile("" : "+s"(p) :: "memory");
#ifdef DOUBLE_MASK
        int kind_;
        if (ph == 0) kind_ = 0; else if (ph == 1) kind_ = 1;
        else { const int rem_ = (ph - 2) % 16; kind_ = rem_ == 0 ? 2 : (rem_ == 1 ? 12 : (rem_ < 9 ? rem_ + 1 : (rem_ == 9 ? 10 : (rem_ == 10 ? 11 : (rem_ - 11 + 5))))); }
        const int nrep_ = ((DOUBLE_MASK >> kind_) & 1) ? 2 : 1;
        for (int rep_ = 0; rep_ < nrep_; ++rep_) {
        if (rep_) xcd_barrier(xbar);
#endif
        if (ph == 0) phase_pre0(p, smem);
        else if (ph == 1) phase_pre1(p);
        else {
            const int q = ph - 2, lp = q / 16, rem = q % 16;
            if (rem < 9) {
                const int l = 2 * lp;
                switch (rem) {
                    case 0: phase_g1e(p, l, smem); break;
                    case 1: phase_decay(p, l, smem); break;
                    case 2: phase_scan(p, l, smem); break;
                    case 3: phase_merge(p, l); break;
                    case 4: phase_g2(p, l, smem); break;
                    case 5: if (DRYCOND) phase_ln1r<true>(p, l, smem); else phase_ln1r<false>(p, l, smem); break;
                    case 6: phase_mg1(p, l, smem); break;
                    case 7: phase_mg2(p, l, smem); break;
                    default: if (DRYCOND) phase_ln2<true>(p, l); else phase_ln2<false>(p, l); break;
                }
            } else {
                const int l = 2 * lp + 1;
                switch (rem - 9) {
                    case 0: phase_g1o(p, l, smem); break;
                    case 1: phase_att(p, l, smem); break;
                    case 2: phase_g2(p, l, smem); break;
                    case 3: if (DRYCOND) phase_ln1r<true>(p, l, smem); else phase_ln1r<false>(p, l, smem); break;
                    case 4: phase_mg1(p, l, smem); break;
                    case 5: phase_mg2(p, l, smem); break;
                    default: if (DRYCOND) phase_ln2<true>(p, l); else phase_ln2<false>(p, l); break;
                }
            }
        }
#ifdef DOUBLE_MASK
        }
#endif
        if (ph + 1 < ph_hi) xcd_barrier(xbar);
    }
}

extern "C" void kernel_launch(void* const* d_in, const int* in_sizes, int n_in, void* d_out, int out_size, void* d_ws, size_t ws_size, hipStream_t stream) {
    static int grid_blocks = 0;
    if (grid_blocks == 0) {
        if (n_in != 32 || ws_size < WS_END) { fprintf(stderr, "kernel_launch: unexpected n_in %d or ws_size %zu\n", n_in, ws_size); grid_blocks = -1; return; }
        int dev = 0, cus = 0, per_cu = 0;
        hipGetDevice(&dev);
        hipDeviceGetAttribute(&cus, hipDeviceAttributeMultiprocessorCount, dev);
        hipFuncSetAttribute((const void*)mega, hipFuncAttributeMaxDynamicSharedMemorySize, LDS_BYTES);
        hipOccupancyMaxActiveBlocksPerMultiprocessor(&per_cu, mega, 256, LDS_BYTES);
        if (per_cu > 2) per_cu = 2;
        if (per_cu < 1) per_cu = 1;
        grid_blocks = cus * per_cu;
    }
    if (grid_blocks < 0) return;
    hipMemsetAsync((char*)d_ws + WS_CTL, 0, 32768, stream);
    Params p{};
    for (int i = 0; i < 32; ++i) p.in[i] = (const float*)d_in[i];
    p.out = (float*)d_out; p.ws = (unsigned char*)d_ws;
#if N_LAUNCH_MODE == 1
    p.ph_lo = 0; p.ph_hi = NPHASE;
    void* args[] = {&p};
    hipError_t e = hipLaunchCooperativeKernel((void*)mega, dim3(grid_blocks), dim3(256), args, LDS_BYTES, stream);
    if (e != hipSuccess) fprintf(stderr, "cooperative launch failed: %s (grid %d)\n", hipGetErrorString(e), grid_blocks);
#else
    for (int ph = 0; ph < NPHASE; ++ph) {
        p.ph_lo = ph; p.ph_hi = ph + 1;
        hipLaunchKernelGGL(mega, dim3(grid_blocks), dim3(256), LDS_BYTES, stream, p);
    }
#endif
}
```

```cpp
#include <hip/hip_runtime.h>
#include <hip/hip_cooperative_groups.h>
#include <cstdio>
#include <cstdint>
namespace cg = cooperative_groups;

#ifndef N_LAUNCH_MODE
#define N_LAUNCH_MODE 1
#endif

#define DI __device__ __forceinline__
#define LAS __attribute__((address_space(3)))
typedef unsigned short bf16_t;
typedef short bf16x8 __attribute__((ext_vector_type(8)));
typedef short s16x4 __attribute__((ext_vector_type(4)));
typedef float f32x4 __attribute__((ext_vector_type(4)));
typedef float f32x16 __attribute__((ext_vector_type(16)));
typedef unsigned u32x4 __attribute__((ext_vector_type(4)));
typedef unsigned u32x2 __attribute__((ext_vector_type(2)));

constexpr int D = 1024, NB = 8, T = 2048, TC = 256, TA = T + TC;
constexpr int ML = NB * T, MC = NB * TC, MT = ML + MC;
constexpr int NIN = 3616, NINP = 3712, ZS = 3712;
constexpr int NSLOT = 2 * MT;
constexpr float LN_EPS = 1e-5f;
constexpr float ALPHA = 1.6817928305074290f;
constexpr float L2E = 1.4426950408889634f;

constexpr size_t MiB = 1ull << 20;
constexpr size_t WS_CTL = 0;
constexpr int CNT_WORD0 = 32768;
constexpr int CNT_STRIDE = 1088;
constexpr size_t WS_MOD = 1 * MiB;
constexpr size_t WS_ROPEA = 2 * MiB;
constexpr size_t WS_ROPEC = 3 * MiB;
constexpr size_t WS_LR = 4 * MiB;
constexpr size_t WS_SLOTW = 7 * MiB;
constexpr size_t WS_LIST = 8 * MiB;
constexpr size_t WS_WRT = 13 * MiB;
constexpr size_t WS_WIN = 16 * MiB;
constexpr size_t WS_WABO = 32 * MiB;
constexpr size_t WS_WQKV = 36 * MiB;
constexpr size_t WS_WCO = 48 * MiB;
constexpr size_t WS_WGU = 64 * MiB;
constexpr size_t WS_WD = 320 * MiB;
constexpr size_t WS_X = 448 * MiB;
constexpr size_t WS_U = 520 * MiB;
constexpr size_t WS_Y = 556 * MiB;
constexpr size_t WS_Z = 592 * MiB;
constexpr size_t WS_O = 724 * MiB;
constexpr size_t WS_QDF = 868 * MiB, WS_QDB = 886 * MiB, WS_TOT = 922 * MiB;
constexpr size_t WS_END = 923 * MiB;
constexpr size_t WS_QC = WS_Z, WS_KC = WS_Z + 36 * MiB, WS_VT = WS_Z + 72 * MiB;
constexpr size_t WS_YS = WS_Z;
constexpr size_t WS_OF = WS_O, WS_OB = WS_O + 72 * MiB, WS_P = WS_O, WS_H = WS_O + 72 * MiB;

#ifndef XBF16
#define XBF16 0
#endif
#if XBF16
typedef bf16_t xres_t;
#else
typedef float xres_t;
#endif
struct Params { const float* in[32]; float* out; unsigned char* ws; int ph_lo, ph_hi; };
typedef const __attribute__((address_space(4))) Params* KP;

DI int TIDX() { int t = threadIdx.x; asm volatile("" : "+v"(t)); return t; }
DI int BIDX() { int b = blockIdx.x; asm volatile("" : "+s"(b)); return b; }
DI unsigned pk2(float lo, float hi);
DI unsigned f2bf(float f) { return pk2(f, 0.f) & 0xffffu; }
typedef float f32x2_t __attribute__((ext_vector_type(2))); typedef __bf16 bf16x2_t __attribute__((ext_vector_type(2)));
DI unsigned pk2(float lo, float hi) { f32x2_t v = {lo, hi}; bf16x2_t b = __builtin_convertvector(v, bf16x2_t); return __builtin_bit_cast(unsigned, b); }
DI float bflo(unsigned w) { return __uint_as_float(w << 16); }
DI float bfhi(unsigned w) { return __uint_as_float(w & 0xffff0000u); }
DI f32x4 xload(const xres_t* p) {
#if XBF16
    const u32x2 w = *(const u32x2*)p; return (f32x4){bflo(w.x), bfhi(w.x), bflo(w.y), bfhi(w.y)};
#else
    return *(const f32x4*)p;
#endif
}
DI void xstore(xres_t* p, f32x4 v) {
#if XBF16
    u32x2 w; w.x = pk2(v[0], v[1]); w.y = pk2(v[2], v[3]); *(u32x2*)p = w;
#else
    *(f32x4*)p = v;
#endif
}
DI float wave_sum(float v) {
    int x = __float_as_int(v);
    v += __int_as_float(__builtin_amdgcn_update_dpp(x, x, 0xB1, 0xF, 0xF, false)); x = __float_as_int(v);
    v += __int_as_float(__builtin_amdgcn_update_dpp(x, x, 0x4E, 0xF, 0xF, false)); x = __float_as_int(v);
    v += __int_as_float(__builtin_amdgcn_update_dpp(x, x, 0x141, 0xF, 0xF, false)); x = __float_as_int(v);
    v += __int_as_float(__builtin_amdgcn_update_dpp(x, x, 0x140, 0xF, 0xF, false));
    { const auto r = __builtin_amdgcn_permlane16_swap(__float_as_uint(v), __float_as_uint(v), false, false); v = __uint_as_float(r[0]) + __uint_as_float(r[1]); }
    { const auto r = __builtin_amdgcn_permlane32_swap(__float_as_uint(v), __float_as_uint(v), false, false); v = __uint_as_float(r[0]) + __uint_as_float(r[1]); }
    return v;
}
DI float siluf(float v) { return v * __builtin_amdgcn_rcpf(1.0f + __expf(-v)); }

DI int gemm_chunk(int tid) { return (tid & 7) ^ ((tid >> 4) & 7); }
template <bool TRN>
DI void gemm_tile(unsigned char* shm, const bf16_t* const (&ap)[4], const bf16_t* const (&bp)[4], int K, f32x4 (&acc)[4][4],
                  bool first, bool has_next, const bf16_t* const (&apn)[4], const bf16_t* const (&bpn)[4]) {
    const int tid = TIDX(), wid = tid >> 6, lane = tid & 63, wr = wid >> 1, wc = wid & 1, fr = lane & 15, fq = lane >> 4;
#pragma unroll
    for (int m = 0; m < 4; ++m)
#pragma unroll
        for (int n = 0; n < 4; ++n) acc[m][n] = (f32x4){0.f, 0.f, 0.f, 0.f};
    const int nt = K >> 6;
    const int sw = fr >> 1;
    const unsigned aoff = (unsigned)((wr * 64 + fr) * 128), boff = (unsigned)(16384 + (wc * 64 + fr) * 128);
#define GEMM_STAGE(buf, A_, B_, t) do { _Pragma("unroll") for (int i_ = 0; i_ < 4; ++i_) { \
        __builtin_amdgcn_global_load_lds((const unsigned*)(A_[i_] + (t) * 64), (LAS unsigned*)(shm + (buf) * 32768 + i_ * 4096 + tid * 16), 16, 0, 0); \
        __builtin_amdgcn_global_load_lds((const unsigned*)(B_[i_] + (t) * 64), (LAS unsigned*)(shm + (buf) * 32768 + 16384 + i_ * 4096 + tid * 16), 16, 0, 0); } } while (0)
    if (first) {
        GEMM_STAGE(0, ap, bp, 0);
        asm volatile("s_waitcnt vmcnt(0)" ::: "memory");
        __syncthreads();
    }
    for (int t = 0; t < nt; ++t) {
        const int cur = t & 1;
        if (t + 1 < nt) GEMM_STAGE(cur ^ 1, ap, bp, t + 1);
        else if (has_next) GEMM_STAGE(cur ^ 1, apn, bpn, 0);
        const unsigned char* base = shm + cur * 32768;
        bf16x8 At[2][4], Bt[2][4];
#pragma unroll
        for (int ks = 0; ks < 2; ++ks) {
            const unsigned co = (unsigned)(((ks * 4 + fq) ^ sw) << 4);
#pragma unroll
            for (int m = 0; m < 4; ++m) At[ks][m] = *(const bf16x8*)(base + aoff + m * 2048 + co);
#pragma unroll
            for (int n = 0; n < 4; ++n) Bt[ks][n] = *(const bf16x8*)(base + boff + n * 2048 + co);
        }
        __builtin_amdgcn_s_setprio(1);
#pragma unroll
        for (int ks = 0; ks < 2; ++ks)
#pragma unroll
            for (int m = 0; m < 4; ++m)
#pragma unroll
                for (int n = 0; n < 4; ++n)
                    acc[m][n] = TRN ? __builtin_amdgcn_mfma_f32_16x16x32_bf16(Bt[ks][n], At[ks][m], acc[m][n], 0, 0, 0)
                                    : __builtin_amdgcn_mfma_f32_16x16x32_bf16(At[ks][m], Bt[ks][n], acc[m][n], 0, 0, 0);
        __builtin_amdgcn_s_setprio(0);
        asm volatile("s_waitcnt vmcnt(0)" ::: "memory");
        __syncthreads();
    }
#undef GEMM_STAGE
}
#define GEMM_ADVANCE() do { _Pragma("unroll") for (int k_ = 0; k_ < 4; ++k_) { ap[k_] = apn[k_]; bp[k_] = bpn[k_]; } } while (0)
DI void gemm_rows(const bf16_t* base, int r0, int ld, int tid, const bf16_t* (&pp)[4]) {
    const bf16_t* q = base + (size_t)(r0 + (tid >> 3)) * ld + gemm_chunk(tid) * 8;
#pragma unroll
    for (int i = 0; i < 4; ++i) pp[i] = q + (size_t)(32 * i) * ld;
}
DI bool tile_seq(int q, int nrt, int nct, int& rt, int& ct) {
    if (q >= nrt * nct) return false;
    const int band = q / (8 * nct), rem = q - band * 8 * nct;
    const int rows = (nrt - band * 8) < 8 ? (nrt - band * 8) : 8;
    ct = rem / rows; rt = band * 8 + rem % rows;
    return true;
}
DI int xcd_seq(int i, int total) {
    const int G = gridDim.x, bid = BIDX();
    if ((G & 7) != 0) { const int q = i * G + bid; return q < total ? q : -1; }
    const int x = bid & 7, j = bid >> 3, per = (total + 7) >> 3, gx = G >> 3;
    const int q = i * gx + j;
    if (q >= per) return -1;
    const int g = x * per + q;
    return g < total ? g : -1;
}

struct TrDesc { const float* W; bf16_t* WT; int K, N, mode, item; };
DI void tr_load(const TrDesc& d, int lane, float (&wv)[32]) {
    const int nblk = d.N / 32, kb = d.item / nblk, nb = d.item % nblk, k0 = 64 * kb, n0 = 32 * nb;
    const float* src = d.W + (size_t)(k0 + (lane >> 5)) * d.N + n0 + (lane & 31);
#pragma unroll
    for (int i = 0; i < 32; ++i) wv[i] = src[(size_t)(2 * i) * d.N];
}
DI void tr_store(const TrDesc& d, int lane, float* scr, const float (&wv)[32]) {
    const int nblk = d.N / 32, kb = d.item / nblk, nb = d.item % nblk, k0 = 64 * kb, n0 = 32 * nb;
#pragma unroll
    for (int i = 0; i < 32; ++i) scr[(2 * i + (lane >> 5)) * 33 + (lane & 31)] = wv[i];
    asm volatile("s_waitcnt lgkmcnt(0)" ::: "memory");
    const int c = lane & 7;
#pragma unroll
    for (int j = 0; j < 4; ++j) {
        const int n = (lane >> 3) + 8 * j; const float* s = scr + (8 * c) * 33 + n;
        u32x4 o; o.x = pk2(s[0 * 33], s[1 * 33]); o.y = pk2(s[2 * 33], s[3 * 33]); o.z = pk2(s[4 * 33], s[5 * 33]); o.w = pk2(s[6 * 33], s[7 * 33]);
        const int nn = n0 + n;
        const int drow = (d.mode == 0) ? nn : ((nn >> 4) * 32 + (nn & 15) + (d.mode == 2 ? 16 : 0));
        *(u32x4*)(d.WT + (size_t)drow * d.K + k0 + 8 * c) = o;
    }
    asm volatile("s_waitcnt lgkmcnt(0)" ::: "memory");
}

DI void phase_pre0(KP p, unsigned char* smem) {
    const int tid = TIDX(), wave = tid >> 6, lane = tid & 63;
    unsigned char* ws = p->ws;
    if (BIDX() == 0 && tid < 128) {
        unsigned* c0 = (unsigned*)(ws + WS_CTL) + CNT_WORD0 + tid * CNT_STRIDE;
        __hip_atomic_store(c0, 0u, __ATOMIC_RELAXED, __HIP_MEMORY_SCOPE_AGENT); __hip_atomic_store(c0 + 64, 0u, __ATOMIC_RELAXED, __HIP_MEMORY_SCOPE_AGENT);
    }
    {
        float* s_sc = (float*)smem;
        float* s_red = s_sc + 9 * 1024;
        const float* c = p->in[1]; const float* cc = p->in[3];
        for (int i = tid; i < 9 * 1024; i += 256) { const int r = i >> 10, k = i & 1023; const float v = r < 8 ? c[r * 1024 + k] : cc[k]; s_sc[i] = v / (1.0f + expf(-v)); }
        __syncthreads();
        float* MOD = (float*)(ws + WS_MOD);
        for (int item = BIDX(); item < 384; item += gridDim.x) {
            const int l = item / 96, n0 = (item % 96) * 64;
            const float* W = p->in[4] + (size_t)l * 1024 * 6144 + n0 + lane;
            float acc[9];
#pragma unroll
            for (int r = 0; r < 9; ++r) acc[r] = 0.f;
#pragma unroll 16
            for (int k = wave * 256; k < wave * 256 + 256; ++k) {
                const float w = W[(size_t)k * 6144];
#pragma unroll
                for (int r = 0; r < 9; ++r) acc[r] += s_sc[r * 1024 + k] * w;
            }
#pragma unroll
            for (int r = 0; r < 9; ++r) s_red[(wave * 9 + r) * 64 + lane] = acc[r];
            __syncthreads();
            for (int i = tid; i < 9 * 64; i += 256) {
                const int r = i >> 6, ln = i & 63;
                const float v = s_red[(0 * 9 + r) * 64 + ln] + s_red[(1 * 9 + r) * 64 + ln] + s_red[(2 * 9 + r) * 64 + ln] + s_red[(3 * 9 + r) * 64 + ln];
                MOD[(size_t)(l * 9 + r) * 6144 + n0 + ln] = v + p->in[5][l * 6144 + n0 + ln];
            }
            __syncthreads();
        }
    }
    {
        const int gt = BIDX() * 256 + tid, NT = gridDim.x * 256;
        float* ca = (float*)(ws + WS_ROPEA); float* sa = ca + 2048 * 64;
        for (int i = gt; i < 2048 * 64; i += NT) {
            const int t = i >> 6, f = i & 63; const int pos = f < 32 ? (t >> 6) : (t & 63); const int ff = f & 31;
            const float inv = powf(10000.0f, -(float)ff / 32.0f); const float a = (float)pos * inv;
            ca[i] = cosf(a); sa[i] = sinf(a);
        }
        float* cc_ = (float*)(ws + WS_ROPEC); float* sc_ = cc_ + 2048 * 32;
        for (int i = gt; i < 2048 * 32; i += NT) {
            const int t = i >> 5, f = i & 31; const int pos = f < 16 ? (t >> 6) : (t & 63); const int ff = f & 15;
            const float inv = powf(10000.0f, -(float)ff / 16.0f); const float a = (float)pos * inv;
            cc_[i] = cosf(a); sc_[i] = sinf(a);
        }
        float* wrt = (float*)(ws + WS_WRT);
        for (int i = gt; i < 4 * 36 * 1024; i += NT) {
            const int l = i / (36 * 1024), o = (i / 1024) % 36, k = i & 1023;
            wrt[i] = o < 4 ? p->in[25][((size_t)l * 1024 + k) * 4 + o] : p->in[27][((size_t)l * 1024 + k) * 32 + (o - 4)];
        }
        unsigned* wpad = (unsigned*)(ws + WS_WIN);
        for (int i = gt; i < 2 * 96 * 512; i += NT) { const int li = i / (96 * 512), r = i % (96 * 512); wpad[((size_t)li * NINP + NIN) * 512 + r] = 0u; }
    }
    __syncthreads();
    {
        float* scr = (float*)smem + wave * (64 * 33);
        constexpr int I_IN = 16 * 113, I_SQ = 16 * 32, I_QKV = 16 * 96, I_E = 256;
        constexpr int R0 = 2 * I_IN, R1 = R0 + 2 * I_SQ, R2 = R1 + 2 * I_QKV, R3 = R2 + 2 * I_SQ, R4 = R3 + 128 * I_E, R5 = R4 + 128 * I_E, R6 = R5 + 128 * I_E;
        auto decode = [&](int it) -> TrDesc {
            TrDesc d;
            if (it < R0) { const int i = it / I_IN; d.item = it % I_IN; d.W = p->in[10] + (size_t)i * 1024 * NIN; d.K = 1024; d.N = NIN; d.WT = (bf16_t*)(ws + WS_WIN) + (size_t)i * NINP * 1024; d.mode = 0; }
            else if (it < R1) { const int q = it - R0, i = q / I_SQ; d.item = q % I_SQ; d.W = p->in[17] + (size_t)i * 1024 * 1024; d.K = 1024; d.N = 1024; d.WT = (bf16_t*)(ws + WS_WABO) + (size_t)i * 1024 * 1024; d.mode = 0; }
            else if (it < R2) { const int q = it - R1, i = q / I_QKV; d.item = q % I_QKV; d.W = p->in[18] + (size_t)i * 1024 * 3072; d.K = 1024; d.N = 3072; d.WT = (bf16_t*)(ws + WS_WQKV) + (size_t)i * 3072 * 1024; d.mode = 0; }
            else if (it < R3) { const int q = it - R2, i = q / I_SQ; d.item = q % I_SQ; d.W = p->in[24] + (size_t)i * 1024 * 1024; d.K = 1024; d.N = 1024; d.WT = (bf16_t*)(ws + WS_WCO) + (size_t)i * 1024 * 1024; d.mode = 0; }
            else if (it < R4) { const int q = it - R3, le = q / I_E; d.item = q % I_E; d.W = p->in[29] + (size_t)le * 1024 * 512; d.K = 1024; d.N = 512; d.WT = (bf16_t*)(ws + WS_WGU) + (size_t)le * 1024 * 1024; d.mode = 1; }
            else if (it < R5) { const int q = it - R4, le = q / I_E; d.item = q % I_E; d.W = p->in[30] + (size_t)le * 1024 * 512; d.K = 1024; d.N = 512; d.WT = (bf16_t*)(ws + WS_WGU) + (size_t)le * 1024 * 1024; d.mode = 2; }
            else { const int q = it - R5, le = q / I_E; d.item = q % I_E; d.W = p->in[31] + (size_t)le * 512 * 1024; d.K = 512; d.N = 1024; d.WT = (bf16_t*)(ws + WS_WD) + (size_t)le * 1024 * 512; d.mode = 0; }
            return d;
        };
        const int istride = gridDim.x * 4;
        int it = BIDX() * 4 + wave;
        float wa[32], wb[32];
        TrDesc dc = decode(it < R6 ? it : 0);
        if (it < R6) tr_load(dc, lane, wa);
#pragma unroll 1
        for (; it < R6; it += istride) {
            const bool hn = it + istride < R6;
            const TrDesc dn = decode(hn ? it + istride : 0);
            if (hn) tr_load(dn, lane, wb);
            tr_store(dc, lane, scr, wa);
            dc = dn;
#pragma unroll
            for (int i = 0; i < 32; ++i) wa[i] = wb[i];
        }
    }
}

DI void phase_pre1(KP p) {
    const int tid = TIDX(), wave = tid >> 6, lane = tid & 63;
    xres_t* X = (xres_t*)(p->ws + WS_X); bf16_t* U = (bf16_t*)(p->ws + WS_U); const float* MOD = (const float*)(p->ws + WS_MOD);
    const int rstride = gridDim.x * 4;
    f32x4 rv[3][4];
#define PRE1_FETCH(R0) { _Pragma("unroll") for (int q = 0; q < 3; ++q) { const int row_ = (R0) + q * rstride; const int row = row_ < MT ? row_ : MT - 1; \
        const float* src = row < ML ? p->in[0] + (size_t)row * 1024 : p->in[2] + (size_t)(row - ML) * 1024; \
        _Pragma("unroll") for (int j = 0; j < 4; ++j) rv[q][j] = *(const f32x4*)(src + 256 * j + 4 * lane); } }
    int row0 = BIDX() * 4 + wave;
    if (row0 < MT) PRE1_FETCH(row0)
#pragma unroll 1
    for (; row0 < MT; row0 += 3 * rstride) {
        f32x4 u[3][4];
#pragma unroll
        for (int q = 0; q < 3; ++q) {
            const int row_ = row0 + q * rstride; const int row = row_ < MT ? row_ : MT - 1;
            const int r = row < ML ? (row >> 11) : 8;
            const float* mod = MOD + (size_t)r * 6144;
#pragma unroll
            for (int j = 0; j < 4; ++j) {
                const int k = 256 * j + 4 * lane;
                const f32x4 sh = *(const f32x4*)(mod + k), sc = *(const f32x4*)(mod + 1024 + k);
                u[q][j] = rv[q][j] * (1.0f + sc) + sh;
            }
        }
        if (row0 + 3 * rstride < MT) PRE1_FETCH(row0 + 3 * rstride)
#pragma unroll
        for (int q = 0; q < 3; ++q) {
            const int row = row0 + q * rstride;
            if (row < MT) {
#pragma unroll
                for (int j = 0; j < 4; ++j) {
                    const int k = 256 * j + 4 * lane;
                    u32x2 w; w.x = pk2(u[q][j][0], u[q][j][1]); w.y = pk2(u[q][j][2], u[q][j][3]);
                    *(u32x2*)(U + (size_t)row * 1024 + k) = w;
                }
            }
        }
    }
}

DI void phase_g1e(KP p, int l, unsigned char* smem) {
    const int tid = TIDX(), wid = tid >> 6, lane = tid & 63, wr = wid >> 1, wc = wid & 1, fr = lane & 15, fq = lane >> 4;
    const int li = l >> 1;
    const bf16_t* U = (const bf16_t*)(p->ws + WS_U); const bf16_t* W = (const bf16_t*)(p->ws + WS_WIN) + (size_t)li * NINP * 1024;
    bf16_t* Z = (bf16_t*)(p->ws + WS_Z); float* LR = (float*)(p->ws + WS_LR);
    const float* ca = (const float*)(p->ws + WS_ROPEA); const float* sa = ca + 2048 * 64;
    constexpr int NTN = NINP / 128;
    auto decode = [&](int i, int& brow, int& bcol) -> bool {
        const int q = xcd_seq(i, (MT / 128) * NTN); if (q < 0) return false;
        int rt, nt; tile_seq(q, MT / 128, NTN, rt, nt); brow = rt * 128; bcol = nt * 128; return true; };
    auto epi = [&](int brow, int bcol, f32x4 (&acc)[4][4]) {
        const int colw = bcol + wc * 64;
        if (colw >= NIN) return;
        if (colw >= 3584) {
#pragma unroll
            for (int m = 0; m < 4; ++m) { const int row = brow + wr * 64 + m * 16 + fr;
#pragma unroll
                for (int n = 0; n < 2; ++n) *(f32x4*)(LR + (size_t)row * 32 + n * 16 + fq * 4) = acc[m][n]; }
            return;
        }
        const bool ropeR = colw < 1024; const int half = (colw >> 6) & 1;
        const float scale = colw < 512 ? 0.08838834764831845f : ((colw >= 2048 && colw < 2304) ? 0.125f : 1.0f);
#pragma unroll
        for (int m = 0; m < 4; ++m) {
            const int row = brow + wr * 64 + m * 16 + fr;
            if (ropeR && row < ML) {
                const int t = row & 2047;
#pragma unroll
                for (int n = 0; n < 2; ++n) {
                    const f32x4 c4 = *(const f32x4*)(ca + t * 64 + half * 32 + n * 16 + fq * 4), s4 = *(const f32x4*)(sa + t * 64 + half * 32 + n * 16 + fq * 4);
                    const f32x4 a = acc[m][n], b = acc[m][n + 2];
                    acc[m][n] = a * c4 - b * s4; acc[m][n + 2] = b * c4 + a * s4;
                }
            }
#pragma unroll
            for (int n = 0; n < 4; ++n) {
                const f32x4 v = acc[m][n] * scale; u32x2 w; w.x = pk2(v[0], v[1]); w.y = pk2(v[2], v[3]);
                *(u32x2*)(Z + (size_t)row * ZS + colw + n * 16 + fq * 4) = w;
            }
        }
    };
    int brow, bcol;
    if (!decode(0, brow, bcol)) return;
    const bf16_t* ap[4]; const bf16_t* bp[4]; const bf16_t* apn[4]; const bf16_t* bpn[4];
    gemm_rows(U, brow, 1024, tid, ap); gemm_rows(W, bcol, 1024, tid, bp);
    bool first = true;
    for (int i = 0;; ++i) {
        int nbrow = brow, nbcol = bcol; const bool hn = decode(i + 1, nbrow, nbcol);
        gemm_rows(U, nbrow, 1024, tid, apn); gemm_rows(W, nbcol, 1024, tid, bpn);
        f32x4 acc[4][4];
        gemm_tile<true>(smem, ap, bp, 1024, acc, first, hn, apn, bpn);
        epi(brow, bcol, acc);
        if (!hn) break;
        brow = nbrow; bcol = nbcol; GEMM_ADVANCE(); first = false;
    }
}

DI void phase_g1o(KP p, int l, unsigned char* smem) {
    const int tid = TIDX(), wid = tid >> 6, lane = tid & 63, wr = wid >> 1, wc = wid & 1, fr = lane & 15, fq = lane >> 4;
    const int li = l >> 1;
    const bf16_t* U = (const bf16_t*)(p->ws + WS_U); const bf16_t* W = (const bf16_t*)(p->ws + WS_WQKV) + (size_t)li * 3072 * 1024;
    bf16_t* Qc = (bf16_t*)(p->ws + WS_QC); bf16_t* Kc = (bf16_t*)(p->ws + WS_KC); bf16_t* Vt = (bf16_t*)(p->ws + WS_VT);
    const float* cc = (const float*)(p->ws + WS_ROPEC); const float* sc = cc + 2048 * 32;
    auto decode = [&](int i, int& brow, int& bcol) -> bool {
        const int q = xcd_seq(i, (MT / 128) * 24); if (q < 0) return false;
        int rt, nt; tile_seq(q, MT / 128, 24, rt, nt); brow = rt * 128; bcol = nt * 128; return true; };
    int brow, bcol;
    if (!decode(0, brow, bcol)) return;
    const bf16_t* ap[4]; const bf16_t* bp[4]; const bf16_t* apn[4]; const bf16_t* bpn[4];
    gemm_rows(U, brow, 1024, tid, ap); gemm_rows(W, bcol, 1024, tid, bp);
    bool first = true;
    for (int i = 0;; ++i) {
        int nbrow = brow, nbcol = bcol; const bool hn = decode(i + 1, nbrow, nbcol);
        gemm_rows(U, nbrow, 1024, tid, apn); gemm_rows(W, nbcol, 1024, tid, bpn);
        f32x4 acc[4][4];
        if (bcol < 2048) {
            gemm_tile<true>(smem, ap, bp, 1024, acc, first, hn, apn, bpn);
            const int colw = bcol + wc * 64; const bool isk = colw >= 1024; const int hc = (colw & 1023) >> 6;
            bf16_t* dst = isk ? Kc : Qc; const float scale = isk ? 1.0f : 0.125f;
#pragma unroll
            for (int m = 0; m < 4; ++m) {
                const int row = brow + wr * 64 + m * 16 + fr;
                int b, pidx;
                if (row < ML) {
                    b = row >> 11; const int t = row & 2047; pidx = 256 + t;
#pragma unroll
                    for (int n = 0; n < 4; n += 2) {
                        const f32x4 c4 = *(const f32x4*)(cc + t * 32 + (n >> 1) * 16 + fq * 4), s4 = *(const f32x4*)(sc + t * 32 + (n >> 1) * 16 + fq * 4);
                        const f32x4 a = acc[m][n], bb = acc[m][n + 1];
                        acc[m][n] = a * c4 - bb * s4; acc[m][n + 1] = bb * c4 + a * s4;
                    }
                } else { b = (row - ML) >> 8; pidx = (row - ML) & 255; }
                bf16_t* o = dst + ((size_t)(b * 16 + hc) * TA + pidx) * 64;
#pragma unroll
                for (int n = 0; n < 4; ++n) { const f32x4 v = acc[m][n] * scale; u32x2 w; w.x = pk2(v[0], v[1]); w.y = pk2(v[2], v[3]); *(u32x2*)(o + n * 16 + fq * 4) = w; }
            }
        } else {
            gemm_tile<false>(smem, ap, bp, 1024, acc, first, hn, apn, bpn);
#pragma unroll
            for (int m = 0; m < 4; ++m) {
                const int row = brow + wr * 64 + m * 16 + fq * 4;
                int b, pidx;
                if (row < ML) { b = row >> 11; pidx = 256 + (row & 2047); } else { b = (row - ML) >> 8; pidx = (row - ML) & 255; }
                const int ppos = (pidx & ~12) | ((pidx & 8) >> 1) | ((pidx & 4) << 1);
#pragma unroll
                for (int n = 0; n < 4; ++n) {
                    const int col = bcol - 2048 + wc * 64 + n * 16 + fr; const int h = col >> 7, d = col & 127;
                    const f32x4 v = acc[m][n]; u32x2 w; w.x = pk2(v[0], v[1]); w.y = pk2(v[2], v[3]);
                    *(u32x2*)(Vt + ((size_t)(b * 8 + h) * 128 + d) * TA + ppos) = w;
                }
            }
        }
        if (!hn) break;
        brow = nbrow; bcol = nbcol; GEMM_ADVANCE(); first = false;
    }
}

DI void phase_g2(KP p, int l, unsigned char* smem) {
    const int tid = TIDX(), wid = tid >> 6, lane = tid & 63, wr = wid >> 1, wc = wid & 1, fr = lane & 15, fq = lane >> 4;
    const int li = l >> 1;
    const bf16_t* Y = (const bf16_t*)(p->ws + WS_Y);
    const bf16_t* W = (const bf16_t*)(p->ws + ((l & 1) ? WS_WCO : WS_WABO)) + (size_t)li * 1024 * 1024;
    bf16_t* P = (bf16_t*)(p->ws + WS_P);
    const int nrt = (l == 3 ? ML : MT) / 128;
    auto decode = [&](int i, int& brow, int& bcol) -> bool {
        const int q = xcd_seq(i, nrt * 8); if (q < 0) return false;
        int rt, nt; tile_seq(q, nrt, 8, rt, nt); brow = rt * 128; bcol = nt * 128; return true; };
    int brow, bcol;
    if (!decode(0, brow, bcol)) return;
    const bf16_t* ap[4]; const bf16_t* bp[4]; const bf16_t* apn[4]; const bf16_t* bpn[4];
    gemm_rows(Y, brow, 1024, tid, ap); gemm_rows(W, bcol, 1024, tid, bp);
    bool first = true;
    for (int i = 0;; ++i) {
        int nbrow = brow, nbcol = bcol; const bool hn = decode(i + 1, nbrow, nbcol);
        gemm_rows(Y, nbrow, 1024, tid, apn); gemm_rows(W, nbcol, 1024, tid, bpn);
        f32x4 acc[4][4];
        gemm_tile<true>(smem, ap, bp, 1024, acc, first, hn, apn, bpn);
#pragma unroll
        for (int m = 0; m < 4; ++m) { const int row = brow + wr * 64 + m * 16 + fr;
#pragma unroll
            for (int n = 0; n < 4; ++n) { const f32x4 v = acc[m][n]; u32x2 w; w.x = pk2(v[0], v[1]); w.y = pk2(v[2], v[3]); *(u32x2*)(P + (size_t)row * 1024 + bcol + wc * 64 + n * 16 + fq * 4) = w; } }
        if (!hn) break;
        brow = nbrow; bcol = nbcol; GEMM_ADVANCE(); first = false;
    }
}

template <bool DRY>
DI void phase_ln1r(KP p, int l, unsigned char* smem) {
    constexpr int US = 1028;
    constexpr int RB = 12;
    float* Us = (float*)smem;
    float* Ps = Us + RB * US;
    const int tid = TIDX(), wave = tid >> 6, lane = tid & 63;
    const xres_t* X = (const xres_t*)(p->ws + WS_X); xres_t* Xo = (xres_t*)(p->ws + (DRY ? WS_OB : WS_X)); const bf16_t* P = (const bf16_t*)(p->ws + WS_P); bf16_t* U = (bf16_t*)(p->ws + (DRY ? WS_Y : WS_U));
    const float* MOD = (const float*)(p->ws + WS_MOD); const float* WrT = (const float*)(p->ws + WS_WRT) + (size_t)l * 36 * 1024;
    const float* lng = p->in[6] + l * 1024; const float* lnb = p->in[7] + l * 1024;
    const float* bgrp = p->in[26] + l * 4; const float* brex = p->in[28] + l * 32;
    unsigned* cnt = (unsigned*)(p->ws + WS_CTL) + CNT_WORD0 + l * 32 * CNT_STRIDE + (DRY ? 64 : 0); int* list = (int*)(p->ws + WS_LIST); float* slotw = (float*)(p->ws + WS_SLOTW);
    const int rows_total = (l == 3) ? ML : MT;
    const int mi = lane & 15, mq = lane >> 4;
    int pend_slot = -1, pend_e = 0; unsigned pend_pos = 0u;
    f32x4 rx[3][4]; u32x2 rp[3][4];
#define LN1_FETCH(IT, RR) { const int frow_ = (IT) * RB + wave * 3 + (RR); const int frow = frow_ < rows_total ? frow_ : rows_total - 1; \
        const float* xsrc = (l == 0) ? (frow < ML ? p->in[0] + (size_t)frow * 1024 : p->in[2] + (size_t)(frow - ML) * 1024) : nullptr; \
        _Pragma("unroll") for (int j = 0; j < 4; ++j) { const int k = 256 * j + 4 * lane; \
            rx[RR][j] = (l == 0) ? *(const f32x4*)(xsrc + k) : xload(X + (size_t)frow * 1024 + k); rp[RR][j] = *(const u32x2*)(P + (size_t)frow * 1024 + k); } }
    int it = BIDX();
    if (it * RB < rows_total) { LN1_FETCH(it, 0) LN1_FETCH(it, 1) LN1_FETCH(it, 2) }
#pragma unroll 1
    for (; it * RB < rows_total; it += gridDim.x) {
        const int row0 = it * RB + wave * 3;
        const bool has_next = (it + (int)gridDim.x) * RB < rows_total;
#pragma unroll
        for (int rr = 0; rr < 3; ++rr) {
            const int rowr = row0 + rr; const bool rvalid = rowr < rows_total; const int row = rvalid ? rowr : rows_total - 1;
            const int r = row < ML ? (row >> 11) : 8;
            const float* mod = MOD + (size_t)(l * 9 + r) * 6144;
            f32x4 v[4]; float s = 0.f;
#pragma unroll
            for (int j = 0; j < 4; ++j) {
                const int k = 256 * j + 4 * lane;
                const f32x4 xv = rx[rr][j];
                const f32x4 g1 = *(const f32x4*)(mod + 2048 + k);
                const u32x2 pw_ = rp[rr][j]; const f32x4 pv = (f32x4){bflo(pw_.x), bfhi(pw_.x), bflo(pw_.y), bfhi(pw_.y)};
                v[j] = xv * ALPHA + g1 * pv; s += (v[j][0] + v[j][1]) + (v[j][2] + v[j][3]);
            }
            if (has_next) { if (rr == 0) LN1_FETCH(it + gridDim.x, 0) else if (rr == 1) LN1_FETCH(it + gridDim.x, 1) else LN1_FETCH(it + gridDim.x, 2) }
            const float mean = wave_sum(s) * (1.0f / 1024.0f); float s2 = 0.f;
#pragma unroll
            for (int j = 0; j < 4; ++j) { v[j] = v[j] - mean; s2 += (v[j][0] * v[j][0] + v[j][1] * v[j][1]) + (v[j][2] * v[j][2] + v[j][3] * v[j][3]); }
            const float rstd = 1.0f / sqrtf(wave_sum(s2) * (1.0f / 1024.0f) + LN_EPS);
#pragma unroll
            for (int j = 0; j < 4; ++j) {
                const int k = 256 * j + 4 * lane;
                const f32x4 xn = v[j] * rstd * *(const f32x4*)(lng + k) + *(const f32x4*)(lnb + k);
                const f32x4 uu = xn * (1.0f + *(const f32x4*)(mod + 4096 + k)) + *(const f32x4*)(mod + 3072 + k);
                *(f32x4*)(Us + (wave * 3 + rr) * US + k) = uu;
                if (rvalid) {
                    xstore(Xo + (size_t)row * 1024 + k, xn);
                    u32x2 w; w.x = pk2(uu[0], uu[1]); w.y = pk2(uu[2], uu[3]);
                    *(u32x2*)(U + (size_t)row * 1024 + k) = w;
                }
            }
        }
        __syncthreads();
        {
            f32x4 acc[3] = {(f32x4){0.f, 0.f, 0.f, 0.f}, (f32x4){0.f, 0.f, 0.f, 0.f}, (f32x4){0.f, 0.f, 0.f, 0.f}};
            const float* ap = Us + (mi < RB ? mi : mi - RB) * US + 256 * wave + 4 * mq;
            const float* bp0 = WrT + (size_t)mi * 1024 + 256 * wave + 4 * mq;
            const float* bp1 = WrT + (size_t)(16 + mi) * 1024 + 256 * wave + 4 * mq;
            const float* bp2 = WrT + (size_t)(32 + (mi & 3)) * 1024 + 256 * wave + 4 * mq;
#pragma unroll 1
            for (int sb0 = 0; sb0 < 16; sb0 += 8) {
                f32x4 bv[8][3];
#pragma unroll
                for (int q = 0; q < 8; ++q) { bv[q][0] = *(const f32x4*)(bp0 + 16 * (sb0 + q)); bv[q][1] = *(const f32x4*)(bp1 + 16 * (sb0 + q)); bv[q][2] = *(const f32x4*)(bp2 + 16 * (sb0 + q)); }
                __builtin_amdgcn_sched_barrier(0);
#pragma unroll
                for (int q = 0; q < 8; ++q) {
                    const f32x4 a = *(const f32x4*)(ap + 16 * (sb0 + q));
#pragma unroll
                    for (int e = 0; e < 4; ++e) {
                        acc[0] = __builtin_amdgcn_mfma_f32_16x16x4f32(a[e], bv[q][0][e], acc[0], 0, 0, 0);
                        acc[1] = __builtin_amdgcn_mfma_f32_16x16x4f32(a[e], bv[q][1][e], acc[1], 0, 0, 0);
                        acc[2] = __builtin_amdgcn_mfma_f32_16x16x4f32(a[e], bv[q][2][e], acc[2], 0, 0, 0);
                    }
                }
            }
            if (mq < 3) {
#pragma unroll
                for (int nt = 0; nt < 3; ++nt)
#pragma unroll
                    for (int rg = 0; rg < 4; ++rg) Ps[(wave * RB + mq * 4 + rg) * 48 + nt * 16 + mi] = acc[nt][rg];
            }
        }
        __syncthreads();
        if (wave < 2) {
            const int r = wave * 8 + (lane >> 3), c = lane & 7;
            const int rq = r < RB ? r : RB - 1;
            const int row = it * RB + rq;
            float lgv[5];
#pragma unroll
            for (int k = 0; k < 5; ++k) {
                const int o = c + 8 * k; const int oo = o < 36 ? o : 35;
                lgv[k] = (Ps[(0 * RB + rq) * 48 + oo] + Ps[(1 * RB + rq) * 48 + oo]) + (Ps[(2 * RB + rq) * 48 + oo] + Ps[(3 * RB + rq) * 48 + oo]);
            }
            float gv = c < 4 ? lgv[0] + bgrp[c & 3] : -3.0e38f; int gi = c;
#pragma unroll
            for (int off = 1; off < 4; off <<= 1) {
                const float ov = __shfl_xor(gv, off); const int oi = __shfl_xor(gi, off);
                if (ov > gv || (ov == gv && oi < gi)) { gv = ov; gi = oi; }
            }
            const int src0 = lane & ~7;
            const float gmax = __shfl(gv, src0); const int grp = __shfl(gi, src0);
            float ge = c < 4 ? expf(lgv[0] + bgrp[c & 3] - gmax) : 0.f;
            ge += __shfl_xor(ge, 1); ge += __shfl_xor(ge, 2);
            const float gw = 1.0f / __shfl(ge, src0);
            const int j = (c + 4) & 7; const int kk = c >= 4 ? grp : grp + 1;
            float ev = lgv[0];
#pragma unroll
            for (int k = 1; k < 5; ++k) ev = (kk == k) ? lgv[k] : ev;
            ev += brex[grp * 8 + j];
            float v1 = ev; int i1 = j;
#pragma unroll
            for (int off = 1; off < 8; off <<= 1) {
                const float ov = __shfl_xor(v1, off); const int oi = __shfl_xor(i1, off);
                if (ov > v1 || (ov == v1 && oi < i1)) { v1 = ov; i1 = oi; }
            }
            float v2 = (j == i1) ? -3.0e38f : ev; int i2 = (j == i1) ? 99 : j;
#pragma unroll
            for (int off = 1; off < 8; off <<= 1) {
                const float ov = __shfl_xor(v2, off); const int oi = __shfl_xor(i2, off);
                if (ov > v2 || (ov == v2 && oi < i2)) { v2 = ov; i2 = oi; }
            }
            const float e2 = expf(v2 - v1);
            const float w1 = 1.0f / (1.0f + e2), w2 = e2 / (1.0f + e2);
            if (c < 2 && r < RB && row < rows_total) {
                if (pend_slot >= 0) list[(size_t)pend_e * NSLOT + pend_pos] = pend_slot;
                const int e = grp * 8 + (c ? i2 : i1); const float w = gw * (c ? w2 : w1);
                const int slot = row * 2 + c;
                slotw[slot] = w;
#ifdef DRY_NOATOM
                pend_pos = DRY ? (unsigned)slot : atomicAdd(&cnt[e * CNT_STRIDE], 1u); pend_e = e; pend_slot = slot;
#else
                pend_pos = atomicAdd(&cnt[e * CNT_STRIDE], 1u); pend_e = e; pend_slot = slot;
#endif
            }
        }
        __syncthreads();
    }
    if (pend_slot >= 0) list[(size_t)pend_e * NSLOT + pend_pos] = pend_slot;
}

DI void moe_prefix(KP p, int l, int* s_cnt, int* s_tb, int* s_rb) {
    const int tid = TIDX();
    const unsigned* cnt = (const unsigned*)(p->ws + WS_CTL) + CNT_WORD0 + l * 32 * CNT_STRIDE;
    __syncthreads();
    if (tid < 32) s_cnt[tid] = (int)__hip_atomic_load(cnt + tid * CNT_STRIDE, __ATOMIC_RELAXED, __HIP_MEMORY_SCOPE_AGENT);
    __syncthreads();
    if (tid == 0) { int tb = 0; for (int e = 0; e < 32; ++e) { s_tb[e] = tb; s_rb[e] = tb * 128; tb += (s_cnt[e] + 127) >> 7; } s_tb[32] = tb; s_rb[32] = tb * 128; }
    __syncthreads();
}
DI void phase_mg1(KP p, int l, unsigned char* smem) {
    const int tid = TIDX(), wid = tid >> 6, lane = tid & 63, wr = wid >> 1, wc = wid & 1, fr = lane & 15, fq = lane >> 4;
    int* s_cnt = (int*)(smem + 65536 + 64); int* s_tb = s_cnt + 32; int* s_rb = s_tb + 33;
    moe_prefix(p, l, s_cnt, s_tb, s_rb);
    const bf16_t* U = (const bf16_t*)(p->ws + WS_U); const int* list = (const int*)(p->ws + WS_LIST);
    bf16_t* H = (bf16_t*)(p->ws + WS_H);
    const int ntiles = s_tb[32] * 8;
    struct TI { int e, rt, nt, cnt_e; };
    auto decode = [&](int i, TI& t) -> bool {
        const int tile = xcd_seq(i, ntiles); if (tile < 0) return false;
        const int rtg = tile >> 3; t.nt = tile & 7;
        int e = 0;
        for (int q = 1; q < 32; ++q) if (rtg >= s_tb[q]) e = q;
        t.e = e; t.rt = rtg - s_tb[e]; t.cnt_e = s_cnt[e]; return true; };
    auto rows = [&](const TI& t, const bf16_t* (&a)[4], const bf16_t* (&b)[4]) {
#pragma unroll
        for (int i_ = 0; i_ < 4; ++i_) {
            const int pos = t.rt * 128 + (tid >> 3) + 32 * i_;
            const int tok = pos < t.cnt_e ? (list[(size_t)t.e * NSLOT + pos] >> 1) : 0;
            a[i_] = U + (size_t)tok * 1024 + gemm_chunk(tid) * 8;
        }
        gemm_rows((const bf16_t*)(p->ws + WS_WGU) + (size_t)(l * 32 + t.e) * 1024 * 1024, t.nt * 128, 1024, tid, b); };
    TI cur, nxt;
    if (!decode(0, cur)) return;
    const bf16_t* ap[4]; const bf16_t* bp[4]; const bf16_t* apn[4]; const bf16_t* bpn[4];
    rows(cur, ap, bp);
    bool first = true;
    for (int i = 0;; ++i) {
        nxt = cur; const bool hn = decode(i + 1, nxt);
        rows(nxt, apn, bpn);
        f32x4 acc[4][4];
        gemm_tile<true>(smem, ap, bp, 1024, acc, first, hn, apn, bpn);
        const int hrow0 = s_rb[cur.e] + cur.rt * 128 + wr * 64;
#pragma unroll
        for (int m = 0; m < 4; ++m) {
            bf16_t* o = H + (size_t)(hrow0 + m * 16 + fr) * 512 + cur.nt * 64 + wc * 32 + fq * 4;
#pragma unroll
            for (int n = 0; n < 4; n += 2) {
                const f32x4 g = acc[m][n], uu = acc[m][n + 1]; f32x4 h;
#pragma unroll
                for (int j = 0; j < 4; ++j) h[j] = siluf(g[j]) * uu[j];
                u32x2 w; w.x = pk2(h[0], h[1]); w.y = pk2(h[2], h[3]);
                *(u32x2*)(o + (n >> 1) * 16) = w;
            }
        }
        if (!hn) break;
        cur = nxt; GEMM_ADVANCE(); first = false;
    }
}
DI void phase_mg2(KP p, int l, unsigned char* smem) {
    const int tid = TIDX(), wid = tid >> 6, lane = tid & 63, wr = wid >> 1, wc = wid & 1, fr = lane & 15, fq = lane >> 4;
    int* s_cnt = (int*)(smem + 65536 + 64); int* s_tb = s_cnt + 32; int* s_rb = s_tb + 33;
    moe_prefix(p, l, s_cnt, s_tb, s_rb);
    const bf16_t* H = (const bf16_t*)(p->ws + WS_H); const int* list = (const int*)(p->ws + WS_LIST); const float* slotw = (const float*)(p->ws + WS_SLOTW);
    bf16_t* YS = (bf16_t*)(p->ws + WS_YS);
    const int ntiles = s_tb[32] * 8;
    struct TI { int e, rt, nt, cnt_e; };
    auto decode = [&](int i, TI& t) -> bool {
        const int tile = xcd_seq(i, ntiles); if (tile < 0) return false;
        const int rtg = tile >> 3; t.nt = tile & 7;
        int e = 0;
        for (int q = 1; q < 32; ++q) if (rtg >= s_tb[q]) e = q;
        t.e = e; t.rt = rtg - s_tb[e]; t.cnt_e = s_cnt[e]; return true; };
    auto rows = [&](const TI& t, const bf16_t* (&a)[4], const bf16_t* (&b)[4]) {
        gemm_rows(H, s_rb[t.e] + t.rt * 128, 512, tid, a);
        gemm_rows((const bf16_t*)(p->ws + WS_WD) + (size_t)(l * 32 + t.e) * 1024 * 512, t.nt * 128, 512, tid, b); };
    TI cur, nxt;
    if (!decode(0, cur)) return;
    const bf16_t* ap[4]; const bf16_t* bp[4]; const bf16_t* apn[4]; const bf16_t* bpn[4];
    rows(cur, ap, bp);
    bool first = true;
    for (int i = 0;; ++i) {
        nxt = cur; const bool hn = decode(i + 1, nxt);
        rows(nxt, apn, bpn);
        int eslot[4]; float ew[4];
#pragma unroll
        for (int m = 0; m < 4; ++m) {
            const int pos = cur.rt * 128 + wr * 64 + m * 16 + fr;
            eslot[m] = pos < cur.cnt_e ? list[(size_t)cur.e * NSLOT + pos] : -1;
        }
#pragma unroll
        for (int m = 0; m < 4; ++m) ew[m] = eslot[m] >= 0 ? slotw[eslot[m]] : 0.f;
        f32x4 acc[4][4];
        gemm_tile<true>(smem, ap, bp, 512, acc, first, hn, apn, bpn);
#pragma unroll
        for (int m = 0; m < 4; ++m) {
            if (eslot[m] >= 0) {
                const int slot = eslot[m]; const float w = ew[m];
                bf16_t* o = YS + (size_t)slot * 1024 + cur.nt * 128 + wc * 64 + fq * 4;
#pragma unroll
                for (int n = 0; n < 4; ++n) { const f32x4 v = acc[m][n] * w; u32x2 ww; ww.x = pk2(v[0], v[1]); ww.y = pk2(v[2], v[3]); *(u32x2*)(o + n * 16) = ww; }
            }
        }
        if (!hn) break;
        cur = nxt; GEMM_ADVANCE(); first = false;
    }
}

template <bool DRY>
DI void phase_ln2(KP p, int l) {
    const int tid = TIDX(), wave = tid >> 6, lane = tid & 63;
    const xres_t* X = (const xres_t*)(p->ws + WS_X); xres_t* Xo = (xres_t*)(p->ws + (DRY ? WS_OB : WS_X)); const bf16_t* YS = (const bf16_t*)(p->ws + WS_YS); bf16_t* U = (bf16_t*)(p->ws + (DRY ? WS_Y : WS_U));
    const float* MOD = (const float*)(p->ws + WS_MOD);
    const float* lng = p->in[8] + l * 1024; const float* lnb = p->in[9] + l * 1024;
    const int rows_total = (l == 3) ? ML : MT;
    u32x2 ry0[2][4], ry1[2][4]; f32x4 rx[2][4];
    const int rstride = gridDim.x * 8;
    int row0 = (BIDX() * 4 + wave) * 2;
#define LN2_FETCH(R0) { _Pragma("unroll") for (int q = 0; q < 2; ++q) { const int row = (R0) + q; _Pragma("unroll") for (int j = 0; j < 4; ++j) { const int k = 256 * j + 4 * lane; \
        ry0[q][j] = *(const u32x2*)(YS + (size_t)(2 * row) * 1024 + k); ry1[q][j] = *(const u32x2*)(YS + (size_t)(2 * row + 1) * 1024 + k); rx[q][j] = xload(X + (size_t)row * 1024 + k); } } }
    if (row0 < rows_total) LN2_FETCH(row0)
#pragma unroll 1
    for (; row0 < rows_total; row0 += rstride) {
        f32x4 v[2][4]; float s[2] = {0.f, 0.f};
        const float* mod[2];
#pragma unroll
        for (int q = 0; q < 2; ++q) {
            const int row = row0 + q; const int r = row < ML ? (row >> 11) : 8;
            mod[q] = MOD + (size_t)(l * 9 + r) * 6144;
#pragma unroll
            for (int j = 0; j < 4; ++j) {
                const int k = 256 * j + 4 * lane;
                const u32x2 y0 = ry0[q][j], y1 = ry1[q][j];
                f32x4 y; y[0] = bflo(y0.x) + bflo(y1.x); y[1] = bfhi(y0.x) + bfhi(y1.x); y[2] = bflo(y0.y) + bflo(y1.y); y[3] = bfhi(y0.y) + bfhi(y1.y);
                const f32x4 xv = rx[q][j], g2 = *(const f32x4*)(mod[q] + 5120 + k);
                v[q][j] = xv * ALPHA + g2 * y; s[q] += (v[q][j][0] + v[q][j][1]) + (v[q][j][2] + v[q][j][3]);
            }
        }
        if (row0 + rstride < rows_total) LN2_FETCH(row0 + rstride)
        float mean[2], rstd[2];
#pragma unroll
        for (int q = 0; q < 2; ++q) mean[q] = wave_sum(s[q]) * (1.0f / 1024.0f);
#pragma unroll
        for (int q = 0; q < 2; ++q) {
            float s2 = 0.f;
#pragma unroll
            for (int j = 0; j < 4; ++j) { v[q][j] = v[q][j] - mean[q]; s2 += (v[q][j][0] * v[q][j][0] + v[q][j][1] * v[q][j][1]) + (v[q][j][2] * v[q][j][2] + v[q][j][3] * v[q][j][3]); }
            s[q] = s2;
        }
#pragma unroll
        for (int q = 0; q < 2; ++q) rstd[q] = 1.0f / sqrtf(wave_sum(s[q]) * (1.0f / 1024.0f) + LN_EPS);
#pragma unroll
        for (int q = 0; q < 2; ++q) {
            const int row = row0 + q;
            const float* modn = mod[q] + (l + 1 < 4 ? 9 * 6144 : 0);
#pragma unroll
            for (int j = 0; j < 4; ++j) {
                const int k = 256 * j + 4 * lane;
                const f32x4 xn = v[q][j] * rstd[q] * *(const f32x4*)(lng + k) + *(const f32x4*)(lnb + k);
                if (l < 3) {
                    xstore(Xo + (size_t)row * 1024 + k, xn);
                    const f32x4 uu = xn * (1.0f + *(const f32x4*)(modn + 1024 + k)) + *(const f32x4*)(modn + k);
                    u32x2 w; w.x = pk2(uu[0], uu[1]); w.y = pk2(uu[2], uu[3]);
                    *(u32x2*)(U + (size_t)row * 1024 + k) = w;
                } else {
                    *(f32x4*)(p->out + (size_t)row * 1024 + k) = xn;
                }
            }
        }
    }
}

DI s16x4 tr_read(const unsigned char* ptr) {
    typedef short v4i16_t __attribute__((ext_vector_type(4)));
    return __builtin_bit_cast(s16x4, __builtin_amdgcn_ds_read_tr16_b64_v4i16((LAS v4i16_t*)ptr));
}
DI bf16x8 cat8(s16x4 a, s16x4 b) { return __builtin_shufflevector(a, b, 0, 1, 2, 3, 4, 5, 6, 7); }

DI void phase_decay(KP p, int l, unsigned char* smem) {
    const int tid = TIDX();
    const int li = l >> 1;
    const float* LR = (const float*)(p->ws + WS_LR); float* TOT = (float*)(p->ws + WS_TOT);
    const bf16_t* Z = (const bf16_t*)(p->ws + WS_Z);
    float* lrs = (float*)smem;
    float* cum = lrs + 64 * 16;
    float wf[16], wb[16];
#pragma unroll
    for (int r = 0; r < 16; ++r) { wf[r] = p->in[11][(size_t)li * 16 * 256 + r * 256 + tid]; wb[r] = p->in[13][(size_t)li * 16 * 256 + r * 256 + tid]; }
    const float bf = p->in[12][li * 256 + tid], bb = p->in[14][li * 256 + tid];
    for (int it = BIDX(); it < 2 * (MT / 64); it += gridDim.x) {
        const int ch = it >> 1, dr = it & 1;
        const int row0 = ch * 64;
        bf16_t* QD = (bf16_t*)(p->ws + (dr ? WS_QDB : WS_QDF)); bf16_t* KD = QD + (size_t)MT * 256;
        __syncthreads();
        { const int tok = tid >> 2, q4 = tid & 3; *(f32x4*)(lrs + tok * 16 + q4 * 4) = *(const f32x4*)(LR + (size_t)(row0 + tok) * 32 + dr * 16 + q4 * 4); }
        __syncthreads();
        float run = 0.f;
#pragma unroll 1
        for (int half = 0; half < 2; ++half) {
            const int base = dr ? 32 - 32 * half : 32 * half;
            u32x4 qv[4], kv[4];
#pragma unroll
            for (int i = 0; i < 4; ++i) {
                const int id = tid + 256 * i, tokl = id >> 5, cg = id & 31;
                const size_t zr = (size_t)(row0 + base + tokl) * ZS;
                qv[i] = *(const u32x4*)(Z + zr + 2048 + cg * 8); kv[i] = *(const u32x4*)(Z + zr + 2304 + cg * 8);
            }
            if (dr == 0) {
                for (int t = base; t < base + 32; ++t) {
                    float g = bf;
#pragma unroll
                    for (int r = 0; r < 16; ++r) g += lrs[t * 16 + r] * wf[r];
                    run += (fminf(g, 0.f) - __logf(1.0f + __expf(-fabsf(g)))) * (1.0f / 16.0f);
                    cum[(t - base) * 256 + tid] = run;
                }
            } else {
                cum[32 * 256 + tid] = run;
                for (int t = base + 31; t >= base; --t) {
                    float g = bb;
#pragma unroll
                    for (int r = 0; r < 16; ++r) g += lrs[t * 16 + r] * wb[r];
                    run += (fminf(g, 0.f) - __logf(1.0f + __expf(-fabsf(g)))) * (1.0f / 16.0f);
                    cum[(t - base) * 256 + tid] = run;
                }
            }
            __syncthreads();
#pragma unroll
            for (int i = 0; i < 4; ++i) {
                const int id = tid + 256 * i, tokl = id >> 5, cg = id & 31;
                const float* ce = cum + tokl * 256 + cg * 8;
                const float* cq = dr ? ce + 256 : ce;
                const f32x4 a0 = *(const f32x4*)cq, a1 = *(const f32x4*)(cq + 4), b0 = *(const f32x4*)ce, b1 = *(const f32x4*)(ce + 4);
                float fqv[8], fkv[8];
#pragma unroll
                for (int e = 0; e < 4; ++e) { fqv[e] = __expf(a0[e]); fqv[4 + e] = __expf(a1[e]); fkv[e] = __expf(-b0[e]); fkv[4 + e] = __expf(-b1[e]); }
                const u32x4 q = qv[i], k = kv[i]; u32x4 qo, ko;
                qo.x = pk2(bflo(q.x) * fqv[0], bfhi(q.x) * fqv[1]); qo.y = pk2(bflo(q.y) * fqv[2], bfhi(q.y) * fqv[3]); qo.z = pk2(bflo(q.z) * fqv[4], bfhi(q.z) * fqv[5]); qo.w = pk2(bflo(q.w) * fqv[6], bfhi(q.w) * fqv[7]);
                ko.x = pk2(bflo(k.x) * fkv[0], bfhi(k.x) * fkv[1]); ko.y = pk2(bflo(k.y) * fkv[2], bfhi(k.y) * fkv[3]); ko.z = pk2(bflo(k.z) * fkv[4], bfhi(k.z) * fkv[5]); ko.w = pk2(bflo(k.w) * fkv[6], bfhi(k.w) * fkv[7]);
                const size_t orow = (size_t)(row0 + base + tokl) * 256 + cg * 8;
                *(u32x4*)(QD + orow) = qo; *(u32x4*)(KD + orow) = ko;
            }
            __syncthreads();
        }
        TOT[(size_t)(ch * 2 + dr) * 256 + tid] = run;
    }
}

template <int DK>
DI void scan_item(KP p, int l, int item, unsigned char* smem) {
    constexpr bool ISA = (DK == 128);
    constexpr int QS = DK * 2 + 16, KS = DK * 2 + 32, VS = 96, AS_ = 144, SS = DK * 2 + 16, NKS = DK / 32, NMT = DK / 64;
    constexpr int O_QD = 0, O_KD = O_QD + 64 * QS, O_V = O_KD + 64 * KS, O_ATT = O_V + 64 * VS, O_ST = O_ATT + 64 * AS_, O_END = O_ST + 32 * SS;
    static_assert(O_END <= 65536, "scan LDS");
    constexpr int NP = DK / 64 * 2;
    constexpr int CPR = DK / 8;
    const int tid = TIDX(), wid = tid >> 6, lane = tid & 63, fr = lane & 15, fq = lane >> 4;
    const int b = item >> 5, h = (item >> 3) & 3, dir = (item >> 2) & 1, dvq = item & 3;
    const bf16_t* Z = (const bf16_t*)(p->ws + WS_Z);
    const bf16_t* QDg = (const bf16_t*)(p->ws + (dir ? WS_QDB : WS_QDF)); const bf16_t* KDg = QDg + (size_t)MT * 256; const float* TOT = (const float*)(p->ws + WS_TOT);
    bf16_t* OUT = (bf16_t*)(p->ws + (dir ? WS_OB : WS_OF));
    const int qcol = ISA ? h * 128 : 2048 + h * 64, kcol = ISA ? 512 + h * 128 : 2304 + h * 64, vcol = (ISA ? 1024 : 2560) + h * 128 + dvq * 32;
    const int ocol = (ISA ? 0 : 512) + h * 128 + dvq * 32;
    float lam = 0.f;
    if (ISA) lam = log1pf(-exp2f(-((dir ? 5.5f : 5.0f) + (float)h)));
    f32x4 S[NMT][2];
#pragma unroll
    for (int a = 0; a < NMT; ++a) { S[a][0] = (f32x4){0.f, 0.f, 0.f, 0.f}; S[a][1] = (f32x4){0.f, 0.f, 0.f, 0.f}; }
    __syncthreads();
    for (int i = tid; i < 32 * SS / 4; i += 256) ((unsigned*)(smem + O_ST))[i] = 0u;
    auto chunk_row0 = [&](int cc) -> int {
        const int ci = dir ? 35 - cc : cc; const int pp = ci * 64;
        if (!dir) return pp < 256 ? ML + b * 256 + pp : b * 2048 + (pp - 256);
        return pp < 2048 ? b * 2048 + pp : ML + b * 256 + (pp - 2048);
    };
    u32x4 rq[NP], rk[NP], rv; f32x4 tv[NMT];
    auto fetch = [&](int cc) {
        const int row0 = chunk_row0(cc);
        if (!ISA) {
#pragma unroll
            for (int a = 0; a < NMT; ++a) tv[a] = *(const f32x4*)(TOT + (size_t)((row0 >> 6) * 2 + dir) * 256 + h * 64 + (wid * NMT + a) * 16 + fq * 4);
        }
#pragma unroll
        for (int i = 0; i < NP; ++i) {
            const int id = tid + 256 * i, tok = id / CPR, cg_ = id % CPR;
            if (ISA) {
                const size_t ro = (size_t)(row0 + tok) * ZS;
                rq[i] = *(const u32x4*)(Z + ro + qcol + cg_ * 8); rk[i] = *(const u32x4*)(Z + ro + kcol + cg_ * 8);
            } else {
                const size_t eo = (size_t)(row0 + tok) * 256 + h * 64 + cg_ * 8;
                rq[i] = *(const u32x4*)(QDg + eo); rk[i] = *(const u32x4*)(KDg + eo);
            }
        }
        { const int tok = tid >> 2, cg_ = tid & 3; rv = *(const u32x4*)(Z + (size_t)(row0 + tok) * ZS + vcol + cg_ * 8); }
    };
    float ra[NP], rc[NP];
#pragma unroll
    for (int i = 0; i < NP; ++i) {
        const int tok = (tid + 256 * i) / CPR;
        ra[i] = dir ? __expf(lam * (float)(63 - tok)) : __expf(lam * (float)(tok + 1));
        rc[i] = dir ? __expf(-lam * (float)(64 - tok)) : __expf(-lam * (float)(tok + 1));
    }
    const float decA = __expf(lam * 64.0f);
    fetch(0);
    for (int cc = 0; cc < 36; ++cc) {
        const int row0 = chunk_row0(cc);
#pragma unroll
        for (int i = 0; i < NP; ++i) {
            const int id = tid + 256 * i, tok = id / CPR, cg_ = id % CPR;
            const u32x4 q = rq[i], k = rk[i]; u32x4 qo = q, ko = k;
            if (ISA) {
                const float fqv = ra[i], fkv = rc[i];
                qo.x = pk2(bflo(q.x) * fqv, bfhi(q.x) * fqv); qo.y = pk2(bflo(q.y) * fqv, bfhi(q.y) * fqv); qo.z = pk2(bflo(q.z) * fqv, bfhi(q.z) * fqv); qo.w = pk2(bflo(q.w) * fqv, bfhi(q.w) * fqv);
                ko.x = pk2(bflo(k.x) * fkv, bfhi(k.x) * fkv); ko.y = pk2(bflo(k.y) * fkv, bfhi(k.y) * fkv); ko.z = pk2(bflo(k.z) * fkv, bfhi(k.z) * fkv); ko.w = pk2(bflo(k.w) * fkv, bfhi(k.w) * fkv);
            }
            *(u32x4*)(smem + O_QD + tok * QS + cg_ * 16) = qo;
            *(u32x4*)(smem + O_KD + tok * KS + cg_ * 16) = ko;
        }
        { const int tok = tid >> 2, cg_ = tid & 3; *(u32x4*)(smem + O_V + tok * VS + cg_ * 16) = rv; }
        f32x4 dec[NMT];
#pragma unroll
        for (int a = 0; a < NMT; ++a) {
            if (ISA) dec[a] = (f32x4){decA, decA, decA, decA};
            else dec[a] = (f32x4){__expf(tv[a][0]), __expf(tv[a][1]), __expf(tv[a][2]), __expf(tv[a][3])};
        }
        if (cc + 1 < 36) fetch(cc + 1);
        __syncthreads();
        bf16x8 qf[NKS], kf[NKS][4], vf[2][2], sf[NKS][2], ktf[NMT][2];
        {
            const int g = lane >> 4, i16 = lane & 15, q = i16 >> 2, pq = i16 & 3;
#pragma unroll
            for (int ks = 0; ks < NKS; ++ks) {
                qf[ks] = *(const bf16x8*)(smem + O_QD + (16 * wid + fr) * QS + (32 * ks + 8 * fq) * 2);
#pragma unroll
                for (int n = 0; n < 4; ++n) kf[ks][n] = *(const bf16x8*)(smem + O_KD + (16 * n + fr) * KS + (32 * ks + 8 * fq) * 2);
            }
#pragma unroll
            for (int ks = 0; ks < 2; ++ks)
#pragma unroll
                for (int n = 0; n < 2; ++n) {
                    const unsigned char* a = smem + O_V + (32 * ks + 4 * g + q) * VS + (n * 16 + 4 * pq) * 2;
                    vf[ks][n] = cat8(tr_read(a), tr_read(a + 16 * VS));
                }
        }
        __builtin_amdgcn_sched_barrier(0);
        bf16x8 afr[2];
        {
            f32x4 at[4];
#pragma unroll
            for (int n = 0; n < 4; ++n) at[n] = (f32x4){0.f, 0.f, 0.f, 0.f};
#pragma unroll
            for (int ks = 0; ks < NKS; ++ks)
#pragma unroll
                for (int n = 0; n < 4; ++n) at[n] = __builtin_amdgcn_mfma_f32_16x16x32_bf16(kf[ks][n], qf[ks], at[n], 0, 0, 0);
            {
                const int g = lane >> 4, i16 = lane & 15, q = i16 >> 2, pq = i16 & 3;
#pragma unroll
                for (int ks = 0; ks < NKS; ++ks)
#pragma unroll
                    for (int n = 0; n < 2; ++n) sf[ks][n] = *(const bf16x8*)(smem + O_ST + (16 * n + fr) * SS + (32 * ks + 8 * fq) * 2);
#pragma unroll
                for (int a = 0; a < NMT; ++a)
#pragma unroll
                    for (int ks = 0; ks < 2; ++ks) {
                        const unsigned char* ka = smem + O_KD + (32 * ks + 4 * g + q) * KS + ((wid * NMT + a) * 16 + 4 * pq) * 2;
                        ktf[a][ks] = cat8(tr_read(ka), tr_read(ka + 16 * KS));
                    }
            }
            __builtin_amdgcn_sched_barrier(0);
            const int i = 16 * wid + fr;
#pragma unroll
            for (int n = 0; n < 4; ++n)
#pragma unroll
                for (int jj = 0; jj < 4; ++jj) { const int j = n * 16 + fq * 4 + jj; const bool keep = dir ? (j > i) : (j <= i); at[n][jj] = keep ? at[n][jj] : 0.f; }
#pragma unroll
            for (int ks = 0; ks < 2; ++ks) {
                u32x4 w; w.x = pk2(at[2 * ks][0], at[2 * ks][1]); w.y = pk2(at[2 * ks][2], at[2 * ks][3]); w.z = pk2(at[2 * ks + 1][0], at[2 * ks + 1][1]); w.w = pk2(at[2 * ks + 1][2], at[2 * ks + 1][3]);
                afr[ks] = __builtin_bit_cast(bf16x8, w);
            }
        }
        {
            f32x4 oa[2] = {(f32x4){0.f, 0.f, 0.f, 0.f}, (f32x4){0.f, 0.f, 0.f, 0.f}};
#pragma unroll
            for (int ks = 0; ks < NKS; ++ks)
#pragma unroll
                for (int n = 0; n < 2; ++n) oa[n] = __builtin_amdgcn_mfma_f32_16x16x32_bf16(sf[ks][n], qf[ks], oa[n], 0, 0, 0);
#pragma unroll
            for (int ks = 0; ks < 2; ++ks)
#pragma unroll
                for (int n = 0; n < 2; ++n) oa[n] = __builtin_amdgcn_mfma_f32_16x16x32_bf16(vf[ks][n], afr[ks], oa[n], 0, 0, 0);
            bf16_t* o = OUT + (size_t)(row0 + 16 * wid + fr) * 1024 + ocol + fq * 4;
            u32x2 w0, w1; w0.x = pk2(oa[0][0], oa[0][1]); w0.y = pk2(oa[0][2], oa[0][3]); w1.x = pk2(oa[1][0], oa[1][1]); w1.y = pk2(oa[1][2], oa[1][3]);
            *(u32x2*)(o) = w0; *(u32x2*)(o + 16) = w1;
        }
#pragma unroll
        for (int a = 0; a < NMT; ++a) {
#pragma unroll
            for (int ks = 0; ks < 2; ++ks)
#pragma unroll
                for (int n = 0; n < 2; ++n) S[a][n] = __builtin_amdgcn_mfma_f32_16x16x32_bf16(ktf[a][ks], vf[ks][n], S[a][n], 0, 0, 0);
            S[a][0] *= dec[a]; S[a][1] *= dec[a];
        }
        __syncthreads();
#pragma unroll
        for (int a = 0; a < NMT; ++a) {
            const int mt = wid * NMT + a;
#pragma unroll
            for (int n = 0; n < 2; ++n) { u32x2 w; w.x = pk2(S[a][n][0], S[a][n][1]); w.y = pk2(S[a][n][2], S[a][n][3]); *(u32x2*)(smem + O_ST + (n * 16 + fr) * SS + (mt * 16 + fq * 4) * 2) = w; }
        }
    }
    __syncthreads();
}
DI void phase_scan(KP p, int l, unsigned char* smem) {
    for (int it = BIDX(); it < 512; it += gridDim.x) {
        const int item = (it & 7) * 32 + ((it >> 3) & 31);
        if (it < 256) scan_item<128>(p, l, item, smem); else scan_item<64>(p, l, item, smem);
    }
}

DI void phase_merge(KP p, int l) {
    const int tid = TIDX(), wave = tid >> 6, lane = tid & 63;
    const int li = l >> 1;
    const bf16_t* OF = (const bf16_t*)(p->ws + WS_OF); const bf16_t* OB = (const bf16_t*)(p->ws + WS_OB);
    const bf16_t* Z = (const bf16_t*)(p->ws + WS_Z); bf16_t* Y = (bf16_t*)(p->ws + WS_Y);
    const bool isA = lane < 32;
    const float* gn = isA ? p->in[15] + li * 512 + lane * 16 : p->in[16] + li * 512 + (lane - 32) * 16;
    const int gcol = isA ? 1536 + lane * 16 : 3072 + (lane - 32) * 16;
    for (int row = BIDX() * 4 + wave; row < MT; row += gridDim.x * 4) {
        float o[16]; float s = 0.f;
#pragma unroll
        for (int j = 0; j < 2; ++j) {
            const u32x4 a = *(const u32x4*)(OF + (size_t)row * 1024 + lane * 16 + j * 8), bb = *(const u32x4*)(OB + (size_t)row * 1024 + lane * 16 + j * 8);
            o[j * 8 + 0] = bflo(a.x) + bflo(bb.x); o[j * 8 + 1] = bfhi(a.x) + bfhi(bb.x); o[j * 8 + 2] = bflo(a.y) + bflo(bb.y); o[j * 8 + 3] = bfhi(a.y) + bfhi(bb.y);
            o[j * 8 + 4] = bflo(a.z) + bflo(bb.z); o[j * 8 + 5] = bfhi(a.z) + bfhi(bb.z); o[j * 8 + 6] = bflo(a.w) + bflo(bb.w); o[j * 8 + 7] = bfhi(a.w) + bfhi(bb.w);
        }
#pragma unroll
        for (int e = 0; e < 16; ++e) s += o[e];
        s += __shfl_xor(s, 1); s += __shfl_xor(s, 2); s += __shfl_xor(s, 4);
        const float mean = isA ? s * (1.0f / 128.0f) : 0.f;
        float s2 = 0.f;
#pragma unroll
        for (int e = 0; e < 16; ++e) { o[e] -= mean; s2 += o[e] * o[e]; }
        s2 += __shfl_xor(s2, 1); s2 += __shfl_xor(s2, 2); s2 += __shfl_xor(s2, 4);
        const float rs = 1.0f / sqrtf(s2 * (1.0f / 128.0f) + LN_EPS);
        const u32x4 g0 = *(const u32x4*)(Z + (size_t)row * ZS + gcol), g1 = *(const u32x4*)(Z + (size_t)row * ZS + gcol + 8);
        float gt[16];
        gt[0] = bflo(g0.x); gt[1] = bfhi(g0.x); gt[2] = bflo(g0.y); gt[3] = bfhi(g0.y); gt[4] = bflo(g0.z); gt[5] = bfhi(g0.z); gt[6] = bflo(g0.w); gt[7] = bfhi(g0.w);
        gt[8] = bflo(g1.x); gt[9] = bfhi(g1.x); gt[10] = bflo(g1.y); gt[11] = bfhi(g1.y); gt[12] = bflo(g1.z); gt[13] = bfhi(g1.z); gt[14] = bflo(g1.w); gt[15] = bfhi(g1.w);
        float y[16];
#pragma unroll
        for (int e = 0; e < 16; ++e) y[e] = siluf(gt[e]) * (o[e] * rs * gn[e]);
        u32x4 w0, w1;
        w0.x = pk2(y[0], y[1]); w0.y = pk2(y[2], y[3]); w0.z = pk2(y[4], y[5]); w0.w = pk2(y[6], y[7]);
        w1.x = pk2(y[8], y[9]); w1.y = pk2(y[10], y[11]); w1.z = pk2(y[12], y[13]); w1.w = pk2(y[14], y[15]);
        *(u32x4*)(Y + (size_t)row * 1024 + lane * 16) = w0; *(u32x4*)(Y + (size_t)row * 1024 + lane * 16 + 8) = w1;
    }
}

DI int crow(int r, int hi) { return (r & 3) + 8 * (r >> 2) + 4 * hi; }
constexpr int ATT_BUF = 24576;
DI void att_component(const bf16_t* Qc, const bf16_t* Kc, const bf16_t* Vt, unsigned char* smem, float* wsf, int b, int h, int comp, int p0, int nkv, f32x16 (&O)[4]) {
    const int tid = TIDX(), wid = tid >> 6, lane = tid & 63, r32 = lane & 31, hi = lane >> 5;
    const int hc = h * 2 + comp;
    const bf16_t* Qb = Qc + ((size_t)(b * 16 + hc) * TA + p0 + wid * 32 + r32) * 64;
    const int gch = gemm_chunk(tid);
    const bf16_t* Kg = Kc + (size_t)(b * 16 + hc) * TA * 64 + (size_t)(tid >> 3) * 64 + gch * 8;
    const bf16_t* Vg = Vt + (size_t)(b * 8 + h) * 128 * TA + (size_t)(tid >> 3) * TA + gch * 8;
#define ATT_STAGE(buf, kt) do { \
        _Pragma("unroll") for (int i_ = 0; i_ < 2; ++i_) __builtin_amdgcn_global_load_lds((const unsigned*)(Kg + (size_t)((kt) + 32 * i_) * 64), (LAS unsigned*)(smem + (buf) * ATT_BUF + i_ * 4096 + tid * 16), 16, 0, 0); \
        _Pragma("unroll") for (int i_ = 0; i_ < 4; ++i_) __builtin_amdgcn_global_load_lds((const unsigned*)(Vg + (size_t)(32 * i_) * TA + (kt)), (LAS unsigned*)(smem + (buf) * ATT_BUF + 8192 + i_ * 4096 + tid * 16), 16, 0, 0); } while (0)
    ATT_STAGE(0, 0);
    bf16x8 qf[4];
#pragma unroll
    for (int ks = 0; ks < 4; ++ks) qf[ks] = *(const bf16x8*)(Qb + ks * 16 + hi * 8);
#pragma unroll
    for (int d0 = 0; d0 < 4; ++d0)
#pragma unroll
        for (int r = 0; r < 16; ++r) O[d0][r] = 0.f;
    float m_run = -1.0e30f, l_run = 0.f;
    const int sw = (r32 >> 1) & 7;
    const int nt = nkv >> 6;
    for (int t = 0; t < nt; ++t) {
        asm volatile("s_waitcnt vmcnt(0)" ::: "memory");
        __syncthreads();
        if (t + 1 < nt) ATT_STAGE((t + 1) & 1, (t + 1) * 64);
        const unsigned char* Kt = smem + (t & 1) * ATT_BUF; const unsigned char* Vtl = Kt + 8192;
        bf16x8 kf0[4], kf1[4];
#pragma unroll
        for (int ks = 0; ks < 4; ++ks) {
            const unsigned co = (unsigned)(((ks * 2 + hi) ^ sw) << 4);
            kf0[ks] = *(const bf16x8*)(Kt + r32 * 128 + co);
            kf1[ks] = *(const bf16x8*)(Kt + (32 + r32) * 128 + co);
        }
        const unsigned char* vr = Vtl + r32 * 128;
#define ATT_VLOAD(dst, st_) do { const unsigned o1_ = (unsigned)((((st_) * 2 + hi) ^ sw) << 4); \
        _Pragma("unroll") for (int d0_ = 0; d0_ < 4; ++d0_) dst[d0_] = *(const bf16x8*)(vr + d0_ * 4096 + o1_); } while (0)
        bf16x8 va[4], vb[4];
        ATT_VLOAD(va, 0);
        f32x16 s0, s1;
#pragma unroll
        for (int r = 0; r < 16; ++r) { s0[r] = 0.f; s1[r] = 0.f; }
#pragma unroll
        for (int ks = 0; ks < 4; ++ks) {
            s0 = __builtin_amdgcn_mfma_f32_32x32x16_bf16(kf0[ks], qf[ks], s0, 0, 0, 0);
            s1 = __builtin_amdgcn_mfma_f32_32x32x16_bf16(kf1[ks], qf[ks], s1, 0, 0, 0);
        }
        float mxa[8];
#pragma unroll
        for (int i_ = 0; i_ < 8; ++i_) mxa[i_] = fmaxf(fmaxf(s0[2 * i_], s0[2 * i_ + 1]), fmaxf(s1[2 * i_], s1[2 * i_ + 1]));
        float mx = fmaxf(fmaxf(fmaxf(mxa[0], mxa[1]), fmaxf(mxa[2], mxa[3])), fmaxf(fmaxf(mxa[4], mxa[5]), fmaxf(mxa[6], mxa[7])));
        { const auto rr = __builtin_amdgcn_permlane32_swap(__float_as_uint(mx), __float_as_uint(mx), false, false); mx = fmaxf(__uint_as_float(rr[0]), __uint_as_float(rr[1])); }
        if (__any(mx > m_run + 8.0f)) {
            const float m_new = fmaxf(m_run, mx);
            const float alpha = __builtin_amdgcn_exp2f((m_run - m_new) * L2E);
            l_run *= alpha; m_run = m_new;
            if (hi == 0) wsf[r32] = alpha;
            asm volatile("s_waitcnt lgkmcnt(0)" ::: "memory");
            float ar[16];
#pragma unroll
            for (int r = 0; r < 16; ++r) ar[r] = wsf[crow(r, hi)];
#pragma unroll
            for (int d0 = 0; d0 < 4; ++d0)
#pragma unroll
                for (int r = 0; r < 16; ++r) O[d0][r] *= ar[r];
            asm volatile("s_waitcnt lgkmcnt(0)" ::: "memory");
        }
        const float mb = m_run * L2E;
        float ps = 0.f;
#pragma unroll
        for (int r = 0; r < 16; ++r) { s0[r] = __builtin_amdgcn_exp2f(s0[r] * L2E - mb); s1[r] = __builtin_amdgcn_exp2f(s1[r] * L2E - mb); ps += s0[r] + s1[r]; }
        l_run += ps;
        u32x4 pw[4];
#pragma unroll
        for (int s = 0; s < 2; ++s) {
            pw[s].x = pk2(s0[8 * s + 0], s0[8 * s + 1]); pw[s].y = pk2(s0[8 * s + 2], s0[8 * s + 3]); pw[s].z = pk2(s0[8 * s + 4], s0[8 * s + 5]); pw[s].w = pk2(s0[8 * s + 6], s0[8 * s + 7]);
            pw[2 + s].x = pk2(s1[8 * s + 0], s1[8 * s + 1]); pw[2 + s].y = pk2(s1[8 * s + 2], s1[8 * s + 3]); pw[2 + s].z = pk2(s1[8 * s + 4], s1[8 * s + 5]); pw[2 + s].w = pk2(s1[8 * s + 6], s1[8 * s + 7]);
        }
#pragma unroll
        ATT_VLOAD(vb, 1);
#pragma unroll
        for (int d0 = 0; d0 < 4; ++d0) O[d0] = __builtin_amdgcn_mfma_f32_32x32x16_bf16(__builtin_bit_cast(bf16x8, pw[0]), va[d0], O[d0], 0, 0, 0);
        ATT_VLOAD(va, 2);
#pragma unroll
        for (int d0 = 0; d0 < 4; ++d0) O[d0] = __builtin_amdgcn_mfma_f32_32x32x16_bf16(__builtin_bit_cast(bf16x8, pw[1]), vb[d0], O[d0], 0, 0, 0);
        ATT_VLOAD(vb, 3);
#pragma unroll
        for (int d0 = 0; d0 < 4; ++d0) O[d0] = __builtin_amdgcn_mfma_f32_32x32x16_bf16(__builtin_bit_cast(bf16x8, pw[2]), va[d0], O[d0], 0, 0, 0);
#pragma unroll
        for (int d0 = 0; d0 < 4; ++d0) O[d0] = __builtin_amdgcn_mfma_f32_32x32x16_bf16(__builtin_bit_cast(bf16x8, pw[3]), vb[d0], O[d0], 0, 0, 0);
#undef ATT_VLOAD
    }
#undef ATT_STAGE
    l_run += __shfl_xor(l_run, 32);
    asm volatile("s_waitcnt lgkmcnt(0)" ::: "memory");
    if (hi == 0) wsf[r32] = 1.0f / l_run;
    asm volatile("s_waitcnt lgkmcnt(0)" ::: "memory");
    float ar[16];
#pragma unroll
    for (int r = 0; r < 16; ++r) ar[r] = wsf[crow(r, hi)];
    asm volatile("s_waitcnt lgkmcnt(0)" ::: "memory");
#pragma unroll
    for (int d0 = 0; d0 < 4; ++d0)
#pragma unroll
        for (int r = 0; r < 16; ++r) O[d0][r] *= ar[r];
}

DI void phase_att(KP p, int l, unsigned char* smem) {
    constexpr int O_WS = 2 * ATT_BUF;
    const int tid = TIDX(), wid = tid >> 6, lane = tid & 63, r32 = lane & 31, hi = lane >> 5;
    const int li = l >> 1;
    const bf16_t* Qc = (const bf16_t*)(p->ws + WS_QC); const bf16_t* Kc = (const bf16_t*)(p->ws + WS_KC); const bf16_t* Vt = (const bf16_t*)(p->ws + WS_VT);
    bf16_t* Y = (bf16_t*)(p->ws + WS_Y);
    float* stash = (float*)(p->ws + WS_P) + ((size_t)BIDX() * 256 + tid) * 32;
    const float lam_init = 0.8f - 0.6f * expf(-0.3f * (float)l);
    float* wsf = (float*)(smem + O_WS) + wid * 32;
    const int per_x = (l == 3) ? 128 : 144;
    for (int i = 0;; ++i) {
        int b, h, p0, nkv;
        {
            const int G = gridDim.x, bid = BIDX();
            int item;
            if ((G & 7) == 0) { const int x = bid & 7, q = i * (G >> 3) + (bid >> 3); if (q >= per_x) break; item = q < 128 ? x * 128 + q : 1024 + x * 16 + (q - 128); }
            else { item = i * G + bid; if (item >= 8 * per_x) break; }
            if (item < 1024) { b = item >> 7; h = (item >> 4) & 7; p0 = 256 + (item & 15) * 128; nkv = TA; }
            else { const int q = item - 1024; b = q >> 4; h = (q >> 1) & 7; p0 = (q & 1) * 128; nkv = TC; }
        }
        float d1 = 0.f, d2 = 0.f;
        { const float* lq1 = p->in[19] + (li * 8 + h) * 64, *lk1 = p->in[20] + (li * 8 + h) * 64, *lq2 = p->in[21] + (li * 8 + h) * 64, *lk2 = p->in[22] + (li * 8 + h) * 64;
          d1 = wave_sum(lq1[lane] * lk1[lane]); d2 = wave_sum(lq2[lane] * lk2[lane]); }
        const float lamv = expf(d1) - expf(d2) + lam_init;
        f32x16 On[4];
        __syncthreads();
        att_component(Qc, Kc, Vt, smem, wsf, b, h, 0, p0, nkv, On);
#pragma unroll
        for (int d0 = 0; d0 < 4; ++d0)
#pragma unroll
            for (int r = 0; r < 16; r += 8) {
                u32x4 w; w.x = pk2(On[d0][r], On[d0][r + 1]); w.y = pk2(On[d0][r + 2], On[d0][r + 3]); w.z = pk2(On[d0][r + 4], On[d0][r + 5]); w.w = pk2(On[d0][r + 6], On[d0][r + 7]);
                *(u32x4*)(stash + (d0 * 16 + r) / 2) = w;
            }
        __syncthreads();
        att_component(Qc, Kc, Vt, smem, wsf, b, h, 1, p0, nkv, On);
#pragma unroll
        for (int d0 = 0; d0 < 4; ++d0)
#pragma unroll
            for (int r = 0; r < 16; r += 8) {
                const u32x4 w = *(const u32x4*)(stash + (d0 * 16 + r) / 2);
                On[d0][r] = bflo(w.x) - lamv * On[d0][r]; On[d0][r + 1] = bfhi(w.x) - lamv * On[d0][r + 1]; On[d0][r + 2] = bflo(w.y) - lamv * On[d0][r + 2]; On[d0][r + 3] = bfhi(w.y) - lamv * On[d0][r + 3];
                On[d0][r + 4] = bflo(w.z) - lamv * On[d0][r + 4]; On[d0][r + 5] = bfhi(w.z) - lamv * On[d0][r + 5]; On[d0][r + 6] = bflo(w.w) - lamv * On[d0][r + 6]; On[d0][r + 7] = bfhi(w.w) - lamv * On[d0][r + 7];
            }
        float ms[16];
#pragma unroll
        for (int r = 0; r < 16; ++r) {
            float s = (On[0][r] * On[0][r] + On[1][r] * On[1][r]) + (On[2][r] * On[2][r] + On[3][r] * On[3][r]);
            s += __shfl_xor(s, 1); s += __shfl_xor(s, 2); s += __shfl_xor(s, 4); s += __shfl_xor(s, 8); s += __shfl_xor(s, 16);
            ms[r] = __builtin_amdgcn_rsqf(s * (1.0f / 128.0f) + LN_EPS);
        }
        const float* sg = p->in[23] + li * 1024 + h * 128;
        const float post = 1.0f - lam_init;
        float gsc[4];
#pragma unroll
        for (int d0 = 0; d0 < 4; ++d0) gsc[d0] = sg[d0 * 32 + r32] * post;
        __syncthreads();
        unsigned char* stg = smem + wid * 8192;
#pragma unroll
        for (int r = 0; r < 16; ++r) {
            unsigned char* sp = stg + crow(r, hi) * 256 + r32 * 2;
#pragma unroll
            for (int d0 = 0; d0 < 4; ++d0) *(unsigned short*)(sp + d0 * 64) = (unsigned short)f2bf(On[d0][r] * ms[r] * gsc[d0]);
        }
        asm volatile("s_waitcnt lgkmcnt(0)" ::: "memory");
#pragma unroll
        for (int i2 = 0; i2 < 8; ++i2) {
            const int id = lane + 64 * i2, qr = id >> 4, ch = id & 15;
            const int pq = p0 + wid * 32 + qr;
            const int row = pq < 256 ? ML + b * 256 + pq : b * 2048 + (pq - 256);
            *(u32x4*)(Y + (size_t)row * 1024 + h * 128 + ch * 8) = *(const u32x4*)(stg + qr * 256 + ch * 16);
        }
        asm volatile("s_waitcnt lgkmcnt(0)" ::: "memory");
    }
}

#define XB_TMO      128
#define XB_XCNT(j)  (256  + 64 * (j))
#define XB_XSUB(j)  (1280 + 64 * (j))
#define XB_XGEN(j)  (2304 + 64 * (j))
#define XB_TOP      3328
#define XB_TOPGEN   3392
#define XCD_BAR_WORDS 3456
#define XB_SPIN_CAP (1u << 22)
DI unsigned xb_ld(unsigned* p)              { return __hip_atomic_load(p, __ATOMIC_RELAXED, __HIP_MEMORY_SCOPE_AGENT); }
DI unsigned xb_add(unsigned* p, unsigned v) { return __hip_atomic_fetch_add(p, v, __ATOMIC_RELAXED, __HIP_MEMORY_SCOPE_AGENT); }
DI unsigned xb_xcc_id() { return (unsigned)__builtin_amdgcn_s_getreg((3 << 11) | 20) & 0xFu; }
#define XB_SPIN(cond, bar) do { unsigned _sp = 0; while (cond) { __builtin_amdgcn_s_sleep(1); \
    if ((++_sp & 255u) == 0u) { if (xb_ld(&(bar)[XB_TMO])) break; if (_sp > XB_SPIN_CAP) { atomicAdd(&(bar)[XB_TMO], 1u); break; } } } } while (0)
struct XcdBarrier { unsigned* bar; unsigned x; volatile LAS unsigned* st; };
DI XcdBarrier xcd_barrier_post(unsigned* bar, volatile LAS unsigned* st) {
    XcdBarrier b; b.bar = bar; b.x = xb_xcc_id(); b.st = st;
    if (threadIdx.x == 0) (void)xb_add(&bar[XB_XCNT(b.x)], 1u);
    return b;
}
DI void xcd_barrier_complete(unsigned* bar, unsigned x, unsigned& nloc, unsigned& nx) {
    const unsigned G = gridDim.x * gridDim.y * gridDim.z;
    unsigned sum, cnt, mine, sp = 0u;
    for (;;) {
        sum = 0u; cnt = 0u; mine = 0u;
#pragma unroll
        for (unsigned j = 0; j < 16; ++j) { const unsigned c = xb_ld(&bar[XB_XCNT(j)]); sum += c; cnt += (c > 0u) ? 1u : 0u; mine = (j == x) ? c : mine; }
        if (sum == G) break;
        __builtin_amdgcn_s_sleep(1);
        if ((++sp & 255u) == 0u) { if (xb_ld(&bar[XB_TMO])) break; if (sp > XB_SPIN_CAP) { atomicAdd(&bar[XB_TMO], 1u); break; } }
    }
    nloc = mine > 0u ? mine : 1u; nx = cnt > 0u ? cnt : 1u;
}
DI void xcd_barrier(const XcdBarrier& b) {
    asm volatile("s_waitcnt vmcnt(0)" ::: "memory");
    __syncthreads();
    if (threadIdx.x == 0) {
        unsigned* bar = b.bar;
        __builtin_amdgcn_s_waitcnt(0);
        unsigned nloc = b.st[0], nx = b.st[1];
        if (nloc == 0u) { xcd_barrier_complete(bar, b.x, nloc, nx); b.st[0] = nloc; b.st[1] = nx; }
        const unsigned old = xb_add(&bar[XB_XSUB(b.x)], 1u);
        const unsigned gen = old / nloc;
        if (old + 1u == (gen + 1u) * nloc) {
            __builtin_amdgcn_fence(__ATOMIC_RELEASE, "agent");
            asm volatile("s_waitcnt vmcnt(0)" ::: "memory");
            const unsigned og = xb_add(&bar[XB_TOP], 1u);
            const unsigned tg = og / nx;
            if (og + 1u == (tg + 1u) * nx) xb_add(&bar[XB_TOPGEN], 1u);
            else XB_SPIN(xb_ld(&bar[XB_TOPGEN]) == tg, bar);
            __builtin_amdgcn_fence(__ATOMIC_ACQUIRE, "agent");
            xb_add(&bar[XB_XGEN(b.x)], 1u);
            asm volatile("s_waitcnt vmcnt(0)" ::: "memory");
        } else {
            XB_SPIN(xb_ld(&bar[XB_XGEN(b.x)]) == gen, bar);
            __builtin_amdgcn_fence(__ATOMIC_ACQUIRE, "agent");
            asm volatile("s_waitcnt vmcnt(0)" ::: "memory");
        }
    }
    __syncthreads();
}

#ifdef DOUBLE_MASK
#define DRYCOND (rep_ == 0 && nrep_ == 2)
#else
#define DRYCOND false
#endif
constexpr int NPHASE = 34;
constexpr int LDS_BYTES = 65536 + 1024;
__global__ void __launch_bounds__(256, 2) mega(Params pv) {
    extern __shared__ __attribute__((aligned(16))) unsigned char smem[];
    const int ph_lo = pv.ph_lo, ph_hi = pv.ph_hi;
    volatile LAS unsigned* bar_st = (volatile LAS unsigned*)(LAS unsigned char*)(smem + 65536);
    if (threadIdx.x == 0) { bar_st[0] = 0u; bar_st[1] = 0u; }
    __syncthreads();
    XcdBarrier xbar = xcd_barrier_post((unsigned*)(pv.ws + WS_CTL) + 4096, bar_st);
    for (int ph = ph_lo; ph < ph_hi; ++ph) {
        KP p = (KP)__builtin_amdgcn_kernarg_segment_ptr();
        asm volatile("" : "+s"(p) :: "memory");
#ifdef DOUBLE_MASK
        int kind_;
        if (ph == 0) kind_ = 0; else if (ph == 1) kind_ = 1;
        else { const int rem_ = (ph - 2) % 16; kind_ = rem_ == 0 ? 2 : (rem_ == 1 ? 12 : (rem_ < 9 ? rem_ + 1 : (rem_ == 9 ? 10 : (rem_ == 10 ? 11 : (rem_ - 11 + 5))))); }
        const int nrep_ = ((DOUBLE_MASK >> kind_) & 1) ? 2 : 1;
        for (int rep_ = 0; rep_ < nrep_; ++rep_) {
        if (rep_) xcd_barrier(xbar);
#endif
        if (ph == 0) phase_pre0(p, smem);
        else if (ph == 1) phase_pre1(p);
        else {
            const int q = ph - 2, lp = q / 16, rem = q % 16;
            if (rem < 9) {
                const int l = 2 * lp;
                switch (rem) {
                    case 0: phase_g1e(p, l, smem); break;
                    case 1: phase_decay(p, l, smem); break;
                    case 2: phase_scan(p, l, smem); break;
                    case 3: phase_merge(p, l); break;
                    case 4: phase_g2(p, l, smem); break;
                    case 5: if (DRYCOND) phase_ln1r<true>(p, l, smem); else phase_ln1r<false>(p, l, smem); break;
                    case 6: phase_mg1(p, l, smem); break;
                    case 7: phase_mg2(p, l, smem); break;
                    default: if (DRYCOND) phase_ln2<true>(p, l); else phase_ln2<false>(p, l); break;
                }
            } else {
                const int l = 2 * lp + 1;
                switch (rem - 9) {
                    case 0: phase_g1o(p, l, smem); break;
                    case 1: phase_att(p, l, smem); break;
                    case 2: phase_g2(p, l, smem); break;
                    case 3: if (DRYCOND) phase_ln1r<true>(p, l, smem); else phase_ln1r<false>(p, l, smem); break;
                    case 4: phase_mg1(p, l, smem); break;
                    case 5: phase_mg2(p, l, smem); break;
                    default: if (DRYCOND) phase_ln2<true>(p, l); else phase_ln2<false>(p, l); break;
                }
            }
        }
#ifdef DOUBLE_MASK
        }
#endif
        if (ph + 1 < ph_hi) xcd_barrier(xbar);
    }
}

extern "C" void kernel_launch(void* const* d_in, const int* in_sizes, int n_in, void* d_out, int out_size, void* d_ws, size_t ws_size, hipStream_t stream) {
    static int grid_blocks = 0;
    if (grid_blocks == 0) {
        if (n_in != 32 || ws_size < WS_END) { fprintf(stderr, "kernel_launch: unexpected n_in %d or ws_size %zu\n", n_in, ws_size); grid_blocks = -1; return; }
        int dev = 0, cus = 0, per_cu = 0;
        hipGetDevice(&dev);
        hipDeviceGetAttribute(&cus, hipDeviceAttributeMultiprocessorCount, dev);
        hipFuncSetAttribute((const void*)mega, hipFuncAttributeMaxDynamicSharedMemorySize, LDS_BYTES);
        hipOccupancyMaxActiveBlocksPerMultiprocessor(&per_cu, mega, 256, LDS_BYTES);
        if (per_cu > 2) per_cu = 2;
        if (per_cu < 1) per_cu = 1;
        grid_blocks = cus * per_cu;
    }
    if (grid_blocks < 0) return;
    hipMemsetAsync((char*)d_ws + WS_CTL, 0, 32768, stream);
    Params p{};
    for (int i = 0; i < 32; ++i) p.in[i] = (const float*)d_in[i];
    p.out = (float*)d_out; p.ws = (unsigned char*)d_ws;
#if N_LAUNCH_MODE == 1
    p.ph_lo = 0; p.ph_hi = NPHASE;
    void* args[] = {&p};
    hipError_t e = hipLaunchCooperativeKernel((void*)mega, dim3(grid_blocks), dim3(256), args, LDS_BYTES, stream);
    if (e != hipSuccess) fprintf(stderr, "cooperative launch failed: %s (grid %d)\n", hipGetErrorString(e), grid_blocks);
#else
    for (int ph = 0; ph < NPHASE; ++ph) {
        p.ph_lo = ph; p.ph_hi = ph + 1;
        hipLaunchKernelGGL(mega, dim3(grid_blocks), dim3(256), LDS_BYTES, stream, p);
    }
#endif
}
```

```cpp
#include <hip/hip_runtime.h>
#include <hip/hip_cooperative_groups.h>
#include <cstdio>
#include <cstdint>
#include <type_traits>
namespace cg = cooperative_groups;

#ifndef N_LAUNCH_MODE
#define N_LAUNCH_MODE 1
#endif

#define DI __device__ __forceinline__
#define LAS __attribute__((address_space(3)))
typedef unsigned short bf16_t;
typedef short bf16x8 __attribute__((ext_vector_type(8)));
typedef short s16x4 __attribute__((ext_vector_type(4)));
typedef float f32x4 __attribute__((ext_vector_type(4)));
typedef float f32x16 __attribute__((ext_vector_type(16)));
typedef unsigned u32x4 __attribute__((ext_vector_type(4)));
typedef unsigned u32x2 __attribute__((ext_vector_type(2)));

constexpr int D = 1024, NB = 8, T = 2048, TC = 256, TA = T + TC;
constexpr int ML = NB * T, MC = NB * TC, MT = ML + MC;
constexpr int NIN = 3616, NINP = 3712, ZS = 3712;
constexpr int NSLOT = 2 * MT;
constexpr float LN_EPS = 1e-5f;
constexpr float ALPHA = 1.6817928305074290f;
constexpr float L2E = 1.4426950408889634f;

constexpr size_t MiB = 1ull << 20;
constexpr size_t WS_CTL = 0;
constexpr int CNT_WORD0 = 32768;
constexpr int CNT_STRIDE = 1088;
constexpr size_t WS_MOD = 1 * MiB;
constexpr size_t WS_ROPEA = 2 * MiB;
constexpr size_t WS_ROPEC = 3 * MiB;
constexpr size_t WS_LR = 4 * MiB;
constexpr size_t WS_SLOTW = 7 * MiB;
constexpr size_t WS_LIST = 8 * MiB;
constexpr size_t WS_WRT = 13 * MiB;
constexpr size_t WS_WIN = 16 * MiB;
constexpr size_t WS_WABO = 32 * MiB;
constexpr size_t WS_WQKV = 36 * MiB;
constexpr size_t WS_WCO = 48 * MiB;
constexpr size_t WS_WGU = 64 * MiB;
constexpr size_t WS_WD = 320 * MiB;
constexpr size_t WS_X = 448 * MiB;
constexpr size_t WS_U = 520 * MiB;
constexpr size_t WS_Y = 556 * MiB;
constexpr size_t WS_Z = 592 * MiB;
constexpr size_t WS_O = 724 * MiB;
constexpr size_t WS_QDF = 868 * MiB, WS_QDB = 886 * MiB, WS_TOT = 922 * MiB;
constexpr size_t WS_END = 923 * MiB;
constexpr size_t WS_QC = WS_Z, WS_KC = WS_Z + 36 * MiB, WS_VT = WS_Z + 72 * MiB;
constexpr size_t WS_YS = WS_Z;
constexpr size_t WS_OF = WS_O, WS_OB = WS_O + 72 * MiB, WS_P = WS_O, WS_H = WS_O + 72 * MiB;

#ifndef XRES
#define XRES 2
#endif
#if XRES == 1
typedef bf16_t xres_t;
#elif XRES == 2
typedef _Float16 xres_t;
#else
typedef float xres_t;
#endif
struct Params { const float* in[32]; float* out; unsigned char* ws; int ph_lo, ph_hi; };
typedef const __attribute__((address_space(4))) Params* KP;

DI int TIDX() { int t = threadIdx.x; asm volatile("" : "+v"(t)); return t; }
DI int BIDX() { int b = blockIdx.x; asm volatile("" : "+s"(b)); return b; }
DI unsigned pk2(float lo, float hi);
DI unsigned f2bf(float f) { return pk2(f, 0.f) & 0xffffu; }
typedef float f32x2_t __attribute__((ext_vector_type(2))); typedef __bf16 bf16x2_t __attribute__((ext_vector_type(2)));
DI unsigned pk2(float lo, float hi) { f32x2_t v = {lo, hi}; bf16x2_t b = __builtin_convertvector(v, bf16x2_t); return __builtin_bit_cast(unsigned, b); }
DI float bflo(unsigned w) { return __uint_as_float(w << 16); }
DI float bfhi(unsigned w) { return __uint_as_float(w & 0xffff0000u); }
DI u32x4 pair16(u32x2 a, u32x2 b) {
    const auto r0 = __builtin_amdgcn_permlane16_swap(a.x, b.x, false, false);
    const auto r1 = __builtin_amdgcn_permlane16_swap(a.y, b.y, false, false);
    u32x4 o; o.x = r0[0]; o.y = r1[0]; o.z = r0[1]; o.w = r1[1];
    asm volatile("" : "+v"(o.x), "+v"(o.y), "+v"(o.z), "+v"(o.w));
    return o;
}
#define ROR8_(x) __builtin_amdgcn_update_dpp(0, (int)(x), 0x128, 0xF, 0xF, true)
DI void rows128(const u32x4& p0, const u32x4& p1, int fr, u32x4& v1, u32x4& v2) {
    u32x4 r0, r1;
    r0.x = ROR8_(p0.x); r0.y = ROR8_(p0.y); r0.z = ROR8_(p0.z); r0.w = ROR8_(p0.w);
    r1.x = ROR8_(p1.x); r1.y = ROR8_(p1.y); r1.z = ROR8_(p1.z); r1.w = ROR8_(p1.w);
    asm volatile("" : "+v"(r0.x), "+v"(r0.y), "+v"(r0.z), "+v"(r0.w), "+v"(r1.x), "+v"(r1.y), "+v"(r1.z), "+v"(r1.w));
    const bool lo = fr < 8;
    v1.x = lo ? p0.x : r1.x; v1.y = lo ? p0.y : r1.y; v1.z = lo ? p0.z : r1.z; v1.w = lo ? p0.w : r1.w;
    v2.x = lo ? r0.x : p1.x; v2.y = lo ? r0.y : p1.y; v2.z = lo ? r0.z : p1.z; v2.w = lo ? r0.w : p1.w;
}
DI int pair16_col(int n, int fq) { return (n + (fq & 1)) * 16 + (fq >> 1) * 8; }
typedef _Float16 f16x4_t __attribute__((ext_vector_type(4)));
DI f32x4 xload(const xres_t* p) {
#if XRES == 1
    const u32x2 w = *(const u32x2*)p; return (f32x4){bflo(w.x), bfhi(w.x), bflo(w.y), bfhi(w.y)};
#elif XRES == 2
    const f16x4_t h = *(const f16x4_t*)p; return __builtin_convertvector(h, f32x4);
#else
    return *(const f32x4*)p;
#endif
}
DI void xstore(xres_t* p, f32x4 v) {
#if XRES == 1
    u32x2 w; w.x = pk2(v[0], v[1]); w.y = pk2(v[2], v[3]); *(u32x2*)p = w;
#elif XRES == 2
    *(f16x4_t*)p = __builtin_convertvector(v, f16x4_t);
#else
    *(f32x4*)p = v;
#endif
}
DI float wave_sum(float v) {
    int x = __float_as_int(v);
    v += __int_as_float(__builtin_amdgcn_update_dpp(x, x, 0xB1, 0xF, 0xF, false)); x = __float_as_int(v);
    v += __int_as_float(__builtin_amdgcn_update_dpp(x, x, 0x4E, 0xF, 0xF, false)); x = __float_as_int(v);
    v += __int_as_float(__builtin_amdgcn_update_dpp(x, x, 0x141, 0xF, 0xF, false)); x = __float_as_int(v);
    v += __int_as_float(__builtin_amdgcn_update_dpp(x, x, 0x140, 0xF, 0xF, false));
    { const auto r = __builtin_amdgcn_permlane16_swap(__float_as_uint(v), __float_as_uint(v), false, false); v = __uint_as_float(r[0]) + __uint_as_float(r[1]); }
    { const auto r = __builtin_amdgcn_permlane32_swap(__float_as_uint(v), __float_as_uint(v), false, false); v = __uint_as_float(r[0]) + __uint_as_float(r[1]); }
    return v;
}
#define DPP_ADD_(v, ctrl) { int x_ = __float_as_int(v); v += __int_as_float(__builtin_amdgcn_update_dpp(x_, x_, ctrl, 0xF, 0xF, false)); }
DI float sum8(float v) { DPP_ADD_(v, 0xB1) DPP_ADD_(v, 0x4E) DPP_ADD_(v, 0x141) return v; }
DI float sum32(float v) {
    DPP_ADD_(v, 0xB1) DPP_ADD_(v, 0x4E) DPP_ADD_(v, 0x141) DPP_ADD_(v, 0x140)
    const auto r = __builtin_amdgcn_permlane16_swap(__float_as_uint(v), __float_as_uint(v), false, false);
    return __uint_as_float(r[0]) + __uint_as_float(r[1]);
}
DI float siluf(float v) { return v * __builtin_amdgcn_rcpf(1.0f + __expf(-v)); }

DI int gemm_chunk(int tid) { return (tid & 7) ^ ((tid >> 4) & 7); }
template <bool TRN>
DI void gemm_tile(unsigned char* shm, const bf16_t* const (&ap)[4], const bf16_t* const (&bp)[4], int K, f32x4 (&acc)[4][4],
                  bool first, bool has_next, const bf16_t* const (&apn)[4], const bf16_t* const (&bpn)[4]) {
    const int tid = TIDX(), wid = tid >> 6, lane = tid & 63, wr = wid >> 1, wc = wid & 1, fr = lane & 15, fq = lane >> 4;
#pragma unroll
    for (int m = 0; m < 4; ++m)
#pragma unroll
        for (int n = 0; n < 4; ++n) acc[m][n] = (f32x4){0.f, 0.f, 0.f, 0.f};
    const int nt = K >> 6;
    const int sw = fr >> 1;
    const unsigned aoff = (unsigned)((wr * 64 + fr) * 128), boff = (unsigned)(16384 + (wc * 64 + fr) * 128);
#define GEMM_STAGE(buf, A_, B_, t) do { _Pragma("unroll") for (int i_ = 0; i_ < 4; ++i_) { \
        __builtin_amdgcn_global_load_lds((const unsigned*)(A_[i_] + (t) * 64), (LAS unsigned*)(shm + (buf) * 32768 + i_ * 4096 + tid * 16), 16, 0, 0); \
        __builtin_amdgcn_global_load_lds((const unsigned*)(B_[i_] + (t) * 64), (LAS unsigned*)(shm + (buf) * 32768 + 16384 + i_ * 4096 + tid * 16), 16, 0, 0); } } while (0)
    if (first) {
        GEMM_STAGE(0, ap, bp, 0);
        asm volatile("s_waitcnt vmcnt(0)" ::: "memory");
        __syncthreads();
    }
    for (int t = 0; t < nt; ++t) {
        const int cur = t & 1;
        if (t + 1 < nt) GEMM_STAGE(cur ^ 1, ap, bp, t + 1);
        else if (has_next) GEMM_STAGE(cur ^ 1, apn, bpn, 0);
        const unsigned char* base = shm + cur * 32768;
        bf16x8 At[2][4], Bt[2][4];
#pragma unroll
        for (int ks = 0; ks < 2; ++ks) {
            const unsigned co = (unsigned)(((ks * 4 + fq) ^ sw) << 4);
#pragma unroll
            for (int m = 0; m < 4; ++m) At[ks][m] = *(const bf16x8*)(base + aoff + m * 2048 + co);
#pragma unroll
            for (int n = 0; n < 4; ++n) Bt[ks][n] = *(const bf16x8*)(base + boff + n * 2048 + co);
        }
        __builtin_amdgcn_s_setprio(1);
#pragma unroll
        for (int ks = 0; ks < 2; ++ks)
#pragma unroll
            for (int m = 0; m < 4; ++m)
#pragma unroll
                for (int n = 0; n < 4; ++n)
                    acc[m][n] = TRN ? __builtin_amdgcn_mfma_f32_16x16x32_bf16(Bt[ks][n], At[ks][m], acc[m][n], 0, 0, 0)
                                    : __builtin_amdgcn_mfma_f32_16x16x32_bf16(At[ks][m], Bt[ks][n], acc[m][n], 0, 0, 0);
        __builtin_amdgcn_s_setprio(0);
        asm volatile("s_waitcnt vmcnt(0)" ::: "memory");
        __syncthreads();
    }
#undef GEMM_STAGE
}
DI void gemm_tile_n32(unsigned char* shm, const bf16_t* const (&ap)[4], const bf16_t* bp, int K, f32x4 (&acc)[2][2],
                      bool first, bool has_next, const bf16_t* const (&apn)[4], const bf16_t* bpn) {
    const int tid = TIDX(), wid = tid >> 6, lane = tid & 63, fr = lane & 15, fq = lane >> 4;
#pragma unroll
    for (int m = 0; m < 2; ++m)
#pragma unroll
        for (int n = 0; n < 2; ++n) acc[m][n] = (f32x4){0.f, 0.f, 0.f, 0.f};
    const int nt = K >> 6;
    const int sw = fr >> 1;
    const unsigned aoff = (unsigned)((wid * 32 + fr) * 128), boff = (unsigned)(16384 + fr * 128);
#define GEMM_STAGE_N(buf, A_, B_, t) do { _Pragma("unroll") for (int i_ = 0; i_ < 4; ++i_) \
        __builtin_amdgcn_global_load_lds((const unsigned*)(A_[i_] + (t) * 64), (LAS unsigned*)(shm + (buf) * 32768 + i_ * 4096 + tid * 16), 16, 0, 0); \
        __builtin_amdgcn_global_load_lds((const unsigned*)((B_) + (t) * 64), (LAS unsigned*)(shm + (buf) * 32768 + 16384 + tid * 16), 16, 0, 0); } while (0)
    if (first) {
        GEMM_STAGE_N(0, ap, bp, 0);
        asm volatile("s_waitcnt vmcnt(0)" ::: "memory");
        __syncthreads();
    }
    for (int t = 0; t < nt; ++t) {
        const int cur = t & 1;
        if (t + 1 < nt) GEMM_STAGE_N(cur ^ 1, ap, bp, t + 1);
        else if (has_next) GEMM_STAGE_N(cur ^ 1, apn, bpn, 0);
        const unsigned char* base = shm + cur * 32768;
        bf16x8 At[2][2], Bt[2][2];
#pragma unroll
        for (int ks = 0; ks < 2; ++ks) {
            const unsigned co = (unsigned)(((ks * 4 + fq) ^ sw) << 4);
#pragma unroll
            for (int m = 0; m < 2; ++m) At[ks][m] = *(const bf16x8*)(base + aoff + m * 2048 + co);
#pragma unroll
            for (int n = 0; n < 2; ++n) Bt[ks][n] = *(const bf16x8*)(base + boff + n * 2048 + co);
        }
#pragma unroll
        for (int ks = 0; ks < 2; ++ks)
#pragma unroll
            for (int m = 0; m < 2; ++m)
#pragma unroll
                for (int n = 0; n < 2; ++n) acc[m][n] = __builtin_amdgcn_mfma_f32_16x16x32_bf16(Bt[ks][n], At[ks][m], acc[m][n], 0, 0, 0);
        asm volatile("s_waitcnt vmcnt(0)" ::: "memory");
        __syncthreads();
    }
#undef GEMM_STAGE_N
}
#define GEMM_ADVANCE() do { _Pragma("unroll") for (int k_ = 0; k_ < 4; ++k_) { ap[k_] = apn[k_]; bp[k_] = bpn[k_]; } } while (0)
DI void gemm_rows(const bf16_t* base, int r0, int ld, int tid, const bf16_t* (&pp)[4]) {
    const bf16_t* q = base + (size_t)(r0 + (tid >> 3)) * ld + gemm_chunk(tid) * 8;
#pragma unroll
    for (int i = 0; i < 4; ++i) pp[i] = q + (size_t)(32 * i) * ld;
}
DI bool tile_seq(int q, int nrt, int nct, int& rt, int& ct) {
    if (q >= nrt * nct) return false;
    const int band = q / (8 * nct), rem = q - band * 8 * nct;
    const int rows = (nrt - band * 8) < 8 ? (nrt - band * 8) : 8;
    ct = rem / rows; rt = band * 8 + rem % rows;
    return true;
}
DI int xcd_seq(int i, int total) {
    const int G = gridDim.x, bid = BIDX();
    if ((G & 7) != 0) { const int q = i * G + bid; return q < total ? q : -1; }
    const int x = bid & 7, j = bid >> 3, per = (total + 7) >> 3, gx = G >> 3;
    const int q = i * gx + j;
    if (q >= per) return -1;
    const int g = x * per + q;
    return g < total ? g : -1;
}

struct TrDesc { const float* W; bf16_t* WT; int K, N, mode, item; };
DI void tr_load(const TrDesc& d, int lane, float (&wv)[32]) {
    const int nblk = d.N / 32, kb = d.item / nblk, nb = d.item % nblk, k0 = 64 * kb, n0 = 32 * nb;
    const float* src = d.W + (size_t)(k0 + (lane >> 5)) * d.N + n0 + (lane & 31);
#pragma unroll
    for (int i = 0; i < 32; ++i) wv[i] = src[(size_t)(2 * i) * d.N];
}
DI void tr_store(const TrDesc& d, int lane, float* scr, const float (&wv)[32]) {
    const int nblk = d.N / 32, kb = d.item / nblk, nb = d.item % nblk, k0 = 64 * kb, n0 = 32 * nb;
#pragma unroll
    for (int i = 0; i < 32; ++i) scr[(2 * i + (lane >> 5)) * 33 + (lane & 31)] = wv[i];
    asm volatile("s_waitcnt lgkmcnt(0)" ::: "memory");
    const int c = lane & 7;
#pragma unroll
    for (int j = 0; j < 4; ++j) {
        const int n = (lane >> 3) + 8 * j; const float* s = scr + (8 * c) * 33 + n;
        u32x4 o; o.x = pk2(s[0 * 33], s[1 * 33]); o.y = pk2(s[2 * 33], s[3 * 33]); o.z = pk2(s[4 * 33], s[5 * 33]); o.w = pk2(s[6 * 33], s[7 * 33]);
        const int nn = n0 + n;
        const int drow = (d.mode == 0) ? nn : ((nn >> 4) * 32 + (nn & 15) + (d.mode == 2 ? 16 : 0));
        *(u32x4*)(d.WT + (size_t)drow * d.K + k0 + 8 * c) = o;
    }
    asm volatile("s_waitcnt lgkmcnt(0)" ::: "memory");
}

DI void phase_pre0(KP p, unsigned char* smem) {
    const int tid = TIDX(), wave = tid >> 6, lane = tid & 63;
    unsigned char* ws = p->ws;
    if (BIDX() == 0 && tid < 128) {
        unsigned* c0 = (unsigned*)(ws + WS_CTL) + CNT_WORD0 + tid * CNT_STRIDE;
        __hip_atomic_store(c0, 0u, __ATOMIC_RELAXED, __HIP_MEMORY_SCOPE_AGENT); __hip_atomic_store(c0 + 64, 0u, __ATOMIC_RELAXED, __HIP_MEMORY_SCOPE_AGENT);
    }
    {
        float* s_sc = (float*)smem;
        float* s_red = s_sc + 9 * 1024;
        const float* c = p->in[1]; const float* cc = p->in[3];
        for (int i = tid; i < 9 * 1024; i += 256) { const int r = i >> 10, k = i & 1023; const float v = r < 8 ? c[r * 1024 + k] : cc[k]; s_sc[i] = v / (1.0f + expf(-v)); }
        __syncthreads();
        float* MOD = (float*)(ws + WS_MOD);
        for (int item = BIDX(); item < 384; item += gridDim.x) {
            const int l = item / 96, n0 = (item % 96) * 64;
            const float* W = p->in[4] + (size_t)l * 1024 * 6144 + n0 + lane;
            float acc[9];
#pragma unroll
            for (int r = 0; r < 9; ++r) acc[r] = 0.f;
#pragma unroll 16
            for (int k = wave * 256; k < wave * 256 + 256; ++k) {
                const float w = W[(size_t)k * 6144];
#pragma unroll
                for (int r = 0; r < 9; ++r) acc[r] += s_sc[r * 1024 + k] * w;
            }
#pragma unroll
            for (int r = 0; r < 9; ++r) s_red[(wave * 9 + r) * 64 + lane] = acc[r];
            __syncthreads();
            for (int i = tid; i < 9 * 64; i += 256) {
                const int r = i >> 6, ln = i & 63;
                const float v = s_red[(0 * 9 + r) * 64 + ln] + s_red[(1 * 9 + r) * 64 + ln] + s_red[(2 * 9 + r) * 64 + ln] + s_red[(3 * 9 + r) * 64 + ln];
                MOD[(size_t)(l * 9 + r) * 6144 + n0 + ln] = v + p->in[5][l * 6144 + n0 + ln];
            }
            __syncthreads();
        }
    }
    {
        const int gt = BIDX() * 256 + tid, NT = gridDim.x * 256;
        float* ca = (float*)(ws + WS_ROPEA); float* sa = ca + 2048 * 64;
        for (int i = gt; i < 2048 * 64; i += NT) {
            const int t = i >> 6, f = i & 63; const int pos = f < 32 ? (t >> 6) : (t & 63); const int ff = f & 31;
            const float inv = powf(10000.0f, -(float)ff / 32.0f); const float a = (float)pos * inv;
            ca[i] = cosf(a); sa[i] = sinf(a);
        }
        float* cc_ = (float*)(ws + WS_ROPEC); float* sc_ = cc_ + 2048 * 32;
        for (int i = gt; i < 2048 * 32; i += NT) {
            const int t = i >> 5, f = i & 31; const int pos = f < 16 ? (t >> 6) : (t & 63); const int ff = f & 15;
            const float inv = powf(10000.0f, -(float)ff / 16.0f); const float a = (float)pos * inv;
            cc_[i] = cosf(a); sc_[i] = sinf(a);
        }
        float* wrt = (float*)(ws + WS_WRT);
        for (int i = gt; i < 4 * 36 * 1024; i += NT) {
            const int l = i / 36864, rem = i % 36864, w = rem / 9216, r2 = rem % 9216, sb = r2 / 576, r3 = r2 % 576;
            int o, mq; const int e = r3 & 3;
            if (r3 < 512) { const int ln = (r3 & 255) >> 2; o = (r3 >> 8) * 16 + (ln & 15); mq = ln >> 4; }
            else { const int t = r3 - 512; mq = t >> 4; o = 32 + ((t & 15) >> 2); }
            const int k = 256 * w + 16 * sb + 4 * mq + e;
            wrt[i] = o < 4 ? p->in[25][((size_t)l * 1024 + k) * 4 + o] : p->in[27][((size_t)l * 1024 + k) * 32 + (o - 4)];
        }
        unsigned* wpad = (unsigned*)(ws + WS_WIN);
        for (int i = gt; i < 2 * 96 * 512; i += NT) { const int li = i / (96 * 512), r = i % (96 * 512); wpad[((size_t)li * NINP + NIN) * 512 + r] = 0u; }
    }
    __syncthreads();
    {
        float* scr = (float*)smem + wave * (64 * 33);
        constexpr int I_IN = 16 * 113, I_SQ = 16 * 32, I_QKV = 16 * 96, I_E = 256;
        constexpr int R0 = 2 * I_IN, R1 = R0 + 2 * I_SQ, R2 = R1 + 2 * I_QKV, R3 = R2 + 2 * I_SQ, R4 = R3 + 128 * I_E, R5 = R4 + 128 * I_E, R6 = R5 + 128 * I_E;
        auto decode = [&](int it) -> TrDesc {
            TrDesc d;
            if (it < R0) { const int i = it / I_IN; d.item = it % I_IN; d.W = p->in[10] + (size_t)i * 1024 * NIN; d.K = 1024; d.N = NIN; d.WT = (bf16_t*)(ws + WS_WIN) + (size_t)i * NINP * 1024; d.mode = 0; }
            else if (it < R1) { const int q = it - R0, i = q / I_SQ; d.item = q % I_SQ; d.W = p->in[17] + (size_t)i * 1024 * 1024; d.K = 1024; d.N = 1024; d.WT = (bf16_t*)(ws + WS_WABO) + (size_t)i * 1024 * 1024; d.mode = 0; }
            else if (it < R2) { const int q = it - R1, i = q / I_QKV; d.item = q % I_QKV; d.W = p->in[18] + (size_t)i * 1024 * 3072; d.K = 1024; d.N = 3072; d.WT = (bf16_t*)(ws + WS_WQKV) + (size_t)i * 3072 * 1024; d.mode = 0; }
            else if (it < R3) { const int q = it - R2, i = q / I_SQ; d.item = q % I_SQ; d.W = p->in[24] + (size_t)i * 1024 * 1024; d.K = 1024; d.N = 1024; d.WT = (bf16_t*)(ws + WS_WCO) + (size_t)i * 1024 * 1024; d.mode = 0; }
            else if (it < R4) { const int q = it - R3, le = q / I_E; d.item = q % I_E; d.W = p->in[29] + (size_t)le * 1024 * 512; d.K = 1024; d.N = 512; d.WT = (bf16_t*)(ws + WS_WGU) + (size_t)le * 1024 * 1024; d.mode = 1; }
            else if (it < R5) { const int q = it - R4, le = q / I_E; d.item = q % I_E; d.W = p->in[30] + (size_t)le * 1024 * 512; d.K = 1024; d.N = 512; d.WT = (bf16_t*)(ws + WS_WGU) + (size_t)le * 1024 * 1024; d.mode = 2; }
            else { const int q = it - R5, le = q / I_E; d.item = q % I_E; d.W = p->in[31] + (size_t)le * 512 * 1024; d.K = 512; d.N = 1024; d.WT = (bf16_t*)(ws + WS_WD) + (size_t)le * 1024 * 512; d.mode = 0; }
            return d;
        };
        const int istride = gridDim.x * 4;
        int it = BIDX() * 4 + wave;
        float wa[32], wb[32];
        TrDesc dc = decode(it < R6 ? it : 0);
        if (it < R6) tr_load(dc, lane, wa);
#pragma unroll 1
        for (; it < R6; it += istride) {
            const bool hn = it + istride < R6;
            const TrDesc dn = decode(hn ? it + istride : it);
            tr_load(dn, lane, wb);
            tr_store(dc, lane, scr, wa);
            dc = dn;
#pragma unroll
            for (int i = 0; i < 32; ++i) wa[i] = wb[i];
        }
    }
}

DI void phase_pre1(KP p) {
    const int tid = TIDX(), wave = tid >> 6, lane = tid & 63;
    xres_t* X = (xres_t*)(p->ws + WS_X); bf16_t* U = (bf16_t*)(p->ws + WS_U); const float* MOD = (const float*)(p->ws + WS_MOD);
    const int rstride = gridDim.x * 4;
    f32x4 rv[3][4];
#define PRE1_FETCH(R0) { _Pragma("unroll") for (int q = 0; q < 3; ++q) { const int row_ = (R0) + q * rstride; const int row = row_ < MT ? row_ : MT - 1; \
        const float* src = row < ML ? p->in[0] + (size_t)row * 1024 : p->in[2] + (size_t)(row - ML) * 1024; \
        _Pragma("unroll") for (int j = 0; j < 4; ++j) rv[q][j] = *(const f32x4*)(src + 256 * j + 4 * lane); } }
    int row0 = BIDX() * 4 + wave;
    if (row0 < MT) PRE1_FETCH(row0)
#pragma unroll 1
    for (; row0 < MT; row0 += 3 * rstride) {
        f32x4 u[3][4], xr[3][4];
#pragma unroll
        for (int q = 0; q < 3; ++q) {
            const int row_ = row0 + q * rstride; const int row = row_ < MT ? row_ : MT - 1;
            const int r = row < ML ? (row >> 11) : 8;
            const float* mod = MOD + (size_t)r * 6144;
#pragma unroll
            for (int j = 0; j < 4; ++j) {
                const int k = 256 * j + 4 * lane;
                const f32x4 sh = *(const f32x4*)(mod + k), sc = *(const f32x4*)(mod + 1024 + k);
                u[q][j] = rv[q][j] * (1.0f + sc) + sh; xr[q][j] = rv[q][j];
            }
        }
        { const int nr0 = (row0 + 3 * rstride < MT) ? row0 + 3 * rstride : row0; PRE1_FETCH(nr0) }
#pragma unroll
        for (int q = 0; q < 3; ++q) {
            const int row = row0 + q * rstride;
            if (row < MT) {
#pragma unroll
                for (int j = 0; j < 4; ++j) {
                    const int k = 256 * j + 4 * lane;
                    u32x2 w; w.x = pk2(u[q][j][0], u[q][j][1]); w.y = pk2(u[q][j][2], u[q][j][3]);
                    *(u32x2*)(U + (size_t)row * 1024 + k) = w;
                    xstore(X + (size_t)row * 1024 + k, xr[q][j]);
                }
            }
        }
    }
}

DI void phase_g1e(KP p, int l, unsigned char* smem) {
    const int tid = TIDX(), wid = tid >> 6, lane = tid & 63, wr = wid >> 1, wc = wid & 1, fr = lane & 15, fq = lane >> 4;
    const int li = l >> 1;
    const bf16_t* U = (const bf16_t*)(p->ws + WS_U); const bf16_t* W = (const bf16_t*)(p->ws + WS_WIN) + (size_t)li * NINP * 1024;
    bf16_t* Z = (bf16_t*)(p->ws + WS_Z); float* LR = (float*)(p->ws + WS_LR);
    const float* ca = (const float*)(p->ws + WS_ROPEA); const float* sa = ca + 2048 * 64;
    constexpr int NTN = 28;
    auto decode = [&](int i, int& brow, int& bcol) -> bool {
        const int q = xcd_seq(i, (MT / 128) * NTN); if (q < 0) return false;
        int rt, nt; tile_seq(q, MT / 128, NTN, rt, nt); brow = rt * 128; bcol = nt * 128; return true; };
    auto epi = [&](int brow, int bcol, f32x4 (&acc)[4][4]) {
        const int colw = bcol + wc * 64;
        if (colw >= NIN) return;
        if (colw >= 3584) {
#pragma unroll
            for (int m = 0; m < 4; ++m) { const int row = brow + wr * 64 + m * 16 + fr;
#pragma unroll
                for (int n = 0; n < 2; ++n) *(f32x4*)(LR + (size_t)row * 32 + n * 16 + fq * 4) = acc[m][n]; }
            return;
        }
        const bool ropeR = colw < 1024; const int half = (colw >> 6) & 1;
        const float scale = colw < 512 ? 0.08838834764831845f : ((colw >= 2048 && colw < 2304) ? 0.125f : 1.0f);
#pragma unroll
        for (int m = 0; m < 4; ++m) {
            const int row = brow + wr * 64 + m * 16 + fr;
            if (ropeR && row < ML) {
                const int t = row & 2047;
#pragma unroll
                for (int n = 0; n < 2; ++n) {
                    const f32x4 c4 = *(const f32x4*)(ca + t * 64 + half * 32 + n * 16 + fq * 4), s4 = *(const f32x4*)(sa + t * 64 + half * 32 + n * 16 + fq * 4);
                    const f32x4 a = acc[m][n], b = acc[m][n + 2];
                    acc[m][n] = a * c4 - b * s4; acc[m][n + 2] = b * c4 + a * s4;
                }
            }
            u32x4 pp[2];
#pragma unroll
            for (int n = 0; n < 4; n += 2) {
                const f32x4 v0 = acc[m][n] * scale, v1 = acc[m][n + 1] * scale; u32x2 w0, w1; w0.x = pk2(v0[0], v0[1]); w0.y = pk2(v0[2], v0[3]); w1.x = pk2(v1[0], v1[1]); w1.y = pk2(v1[2], v1[3]);
                pp[n >> 1] = pair16(w0, w1);
            }
            { u32x4 s1, s2; rows128(pp[0], pp[1], fr, s1, s2);
              bf16_t* zb = Z + (size_t)(row - fr + (fr & 7)) * ZS + colw + pair16_col(fr < 8 ? 0 : 2, fq);
              *(u32x4*)zb = s1; *(u32x4*)(zb + (size_t)8 * ZS) = s2; }
        }
    };
    int brow, bcol;
    if (!decode(0, brow, bcol)) return;
    const bf16_t* ap[4]; const bf16_t* bp[4]; const bf16_t* apn[4]; const bf16_t* bpn[4];
    gemm_rows(U, brow, 1024, tid, ap); gemm_rows(W, bcol, 1024, tid, bp);
    bool first = true;
    for (int i = 0;; ++i) {
        int nbrow = brow, nbcol = bcol; const bool hn = decode(i + 1, nbrow, nbcol);
        gemm_rows(U, nbrow, 1024, tid, apn); gemm_rows(W, nbcol, 1024, tid, bpn);
        f32x4 acc[4][4];
        gemm_tile<true>(smem, ap, bp, 1024, acc, first, hn, apn, bpn);
        epi(brow, bcol, acc);
        if (!hn) break;
        brow = nbrow; bcol = nbcol; GEMM_ADVANCE(); first = false;
    }
    {
        const int G = gridDim.x, bid = BIDX();
        int m0, mstep, mbase, mcount;
        if (G == 512) { const int j = bid >> 3; m0 = j - 56; mstep = 8; mbase = (bid & 7) * 18; mcount = 18; }
        else { m0 = bid; mstep = G; mbase = 0; mcount = MT / 128; }
        if (m0 >= 0 && m0 < mcount) {
            const bf16_t* Wl = W + (size_t)(3584 + (tid >> 3)) * 1024 + gemm_chunk(tid) * 8;
            __syncthreads();
            gemm_rows(U, (mbase + m0) * 128, 1024, tid, ap);
            bool firstn = true;
            for (int m = m0; m < mcount; m += mstep) {
                const bool hn = m + mstep < mcount;
                gemm_rows(U, (mbase + (hn ? m + mstep : m)) * 128, 1024, tid, apn);
                f32x4 acn[2][2];
                gemm_tile_n32(smem, ap, Wl, 1024, acn, firstn, hn, apn, Wl);
                const int rbase = (mbase + m) * 128 + wid * 32;
#pragma unroll
                for (int mm = 0; mm < 2; ++mm)
#pragma unroll
                    for (int n = 0; n < 2; ++n) *(f32x4*)(LR + (size_t)(rbase + mm * 16 + fr) * 32 + n * 16 + fq * 4) = acn[mm][n];
                GEMM_ADVANCE(); firstn = false;
            }
        }
    }
}

DI void phase_g1o(KP p, int l, unsigned char* smem) {
    const int tid = TIDX(), wid = tid >> 6, lane = tid & 63, wr = wid >> 1, wc = wid & 1, fr = lane & 15, fq = lane >> 4;
    const int li = l >> 1;
    const bf16_t* U = (const bf16_t*)(p->ws + WS_U); const bf16_t* W = (const bf16_t*)(p->ws + WS_WQKV) + (size_t)li * 3072 * 1024;
    bf16_t* Qc = (bf16_t*)(p->ws + WS_QC); bf16_t* Kc = (bf16_t*)(p->ws + WS_KC); bf16_t* Vt = (bf16_t*)(p->ws + WS_VT);
    const float* cc = (const float*)(p->ws + WS_ROPEC); const float* sc = cc + 2048 * 32;
    auto decode = [&](int i, int& brow, int& bcol) -> bool {
        const int q = xcd_seq(i, (MT / 128) * 24); if (q < 0) return false;
        int rt, nt; tile_seq(q, MT / 128, 24, rt, nt); brow = rt * 128; bcol = nt * 128; return true; };
    int brow, bcol;
    if (!decode(0, brow, bcol)) return;
    const bf16_t* ap[4]; const bf16_t* bp[4]; const bf16_t* apn[4]; const bf16_t* bpn[4];
    gemm_rows(U, brow, 1024, tid, ap); gemm_rows(W, bcol, 1024, tid, bp);
    bool first = true;
    for (int i = 0;; ++i) {
        int nbrow = brow, nbcol = bcol; const bool hn = decode(i + 1, nbrow, nbcol);
        gemm_rows(U, nbrow, 1024, tid, apn); gemm_rows(W, nbcol, 1024, tid, bpn);
        f32x4 acc[4][4];
        if (bcol < 2048) {
            gemm_tile<true>(smem, ap, bp, 1024, acc, first, hn, apn, bpn);
            const int colw = bcol + wc * 64; const bool isk = colw >= 1024; const int hc = (colw & 1023) >> 6;
            bf16_t* dst = isk ? Kc : Qc; const float scale = isk ? 1.0f : 0.125f;
#pragma unroll
            for (int m = 0; m < 4; ++m) {
                const int row = brow + wr * 64 + m * 16 + fr;
                int b, pidx;
                if (row < ML) {
                    b = row >> 11; const int t = row & 2047; pidx = 256 + t;
#pragma unroll
                    for (int n = 0; n < 4; n += 2) {
                        const f32x4 c4 = *(const f32x4*)(cc + t * 32 + (n >> 1) * 16 + fq * 4), s4 = *(const f32x4*)(sc + t * 32 + (n >> 1) * 16 + fq * 4);
                        const f32x4 a = acc[m][n], bb = acc[m][n + 1];
                        acc[m][n] = a * c4 - bb * s4; acc[m][n + 1] = bb * c4 + a * s4;
                    }
                } else { b = (row - ML) >> 8; pidx = (row - ML) & 255; }
                bf16_t* o = dst + ((size_t)(b * 16 + hc) * TA + pidx) * 64;
#pragma unroll
                for (int n = 0; n < 4; n += 2) { const f32x4 v0 = acc[m][n] * scale, v1 = acc[m][n + 1] * scale; u32x2 w0, w1; w0.x = pk2(v0[0], v0[1]); w0.y = pk2(v0[2], v0[3]); w1.x = pk2(v1[0], v1[1]); w1.y = pk2(v1[2], v1[3]);
                    *(u32x4*)(o + pair16_col(n, fq)) = pair16(w0, w1); }
            }
        } else {
            gemm_tile<false>(smem, ap, bp, 1024, acc, first, hn, apn, bpn);
#pragma unroll
            for (int mp = 0; mp < 4; mp += 2) {
                const int row0 = brow + wr * 64 + (mp + (fq >> 1)) * 16;
                int b, pidx;
                if (row0 < ML) { b = row0 >> 11; pidx = 256 + (row0 & 2047); } else { b = (row0 - ML) >> 8; pidx = (row0 - ML) & 255; }
#pragma unroll
                for (int n = 0; n < 4; ++n) {
                    const int col = bcol - 2048 + wc * 64 + n * 16 + fr; const int h = col >> 7, d = col & 127;
                    const f32x4 v0 = acc[mp][n], v1 = acc[mp + 1][n];
                    const unsigned ax = pk2(v0[0], v0[1]), ay = pk2(v0[2], v0[3]), bx = pk2(v1[0], v1[1]), by = pk2(v1[2], v1[3]);
                    const auto rx = __builtin_amdgcn_permlane32_swap(ax, bx, false, false);
                    const auto ry = __builtin_amdgcn_permlane32_swap(ay, by, false, false);
                    u32x4 w; w.x = rx[0]; w.y = ry[0]; w.z = rx[1]; w.w = ry[1];
                    asm volatile("" : "+v"(w.x), "+v"(w.y), "+v"(w.z), "+v"(w.w));
                    *(u32x4*)(Vt + ((size_t)(b * 8 + h) * 128 + d) * TA + pidx + (fq & 1) * 8) = w;
                }
            }
        }
        if (!hn) break;
        brow = nbrow; bcol = nbcol; GEMM_ADVANCE(); first = false;
    }
}

DI void phase_g2(KP p, int l, unsigned char* smem) {
    const int tid = TIDX(), wid = tid >> 6, lane = tid & 63, wr = wid >> 1, wc = wid & 1, fr = lane & 15, fq = lane >> 4;
    const int li = l >> 1;
    const bf16_t* Y = (const bf16_t*)(p->ws + WS_Y);
    const bf16_t* W = (const bf16_t*)(p->ws + ((l & 1) ? WS_WCO : WS_WABO)) + (size_t)li * 1024 * 1024;
    bf16_t* P = (bf16_t*)(p->ws + WS_P);
    const int nrt = (l == 3 ? ML : MT) / 128;
    auto decode = [&](int i, int& brow, int& bcol) -> bool {
        int q;
        if (gridDim.x == 512) {
            const int per = nrt, x = BIDX() & 7, j = BIDX() >> 3, full = per >> 6, rem = per & 63;
            int lq;
            if (i < full) lq = i * 64 + j;
            else if (i == full && rem > 32) { if (j >= rem) return false; lq = full * 64 + j; }
            else if (i == full && rem > 0) { if ((j & 1) || (j >> 1) >= rem) return false; lq = full * 64 + (j >> 1); }
            else return false;
            q = x * per + lq;
        } else { q = xcd_seq(i, nrt * 8); if (q < 0) return false; }
        int rt, nt; tile_seq(q, nrt, 8, rt, nt); brow = rt * 128; bcol = nt * 128; return true; };
    int brow, bcol;
    if (!decode(0, brow, bcol)) return;
    const bf16_t* ap[4]; const bf16_t* bp[4]; const bf16_t* apn[4]; const bf16_t* bpn[4];
    gemm_rows(Y, brow, 1024, tid, ap); gemm_rows(W, bcol, 1024, tid, bp);
    bool first = true;
    for (int i = 0;; ++i) {
        int nbrow = brow, nbcol = bcol; const bool hn = decode(i + 1, nbrow, nbcol);
        gemm_rows(Y, nbrow, 1024, tid, apn); gemm_rows(W, nbcol, 1024, tid, bpn);
        f32x4 acc[4][4];
        gemm_tile<true>(smem, ap, bp, 1024, acc, first, hn, apn, bpn);
#pragma unroll
        for (int m = 0; m < 4; ++m) { const int row = brow + wr * 64 + m * 16 + fr;
            u32x4 pp[2];
#pragma unroll
            for (int n = 0; n < 4; n += 2) { const f32x4 v0 = acc[m][n], v1 = acc[m][n + 1]; u32x2 w0, w1; w0.x = pk2(v0[0], v0[1]); w0.y = pk2(v0[2], v0[3]); w1.x = pk2(v1[0], v1[1]); w1.y = pk2(v1[2], v1[3]);
                pp[n >> 1] = pair16(w0, w1); }
            { u32x4 s1, s2; rows128(pp[0], pp[1], fr, s1, s2);
              bf16_t* pb = P + (size_t)(row - fr + (fr & 7)) * 1024 + bcol + wc * 64 + pair16_col(fr < 8 ? 0 : 2, fq);
              *(u32x4*)pb = s1; *(u32x4*)(pb + 8 * 1024) = s2; } }
        if (!hn) break;
        brow = nbrow; bcol = nbcol; GEMM_ADVANCE(); first = false;
    }
}

template <bool DRY, bool L0>
DI void phase_ln1r(KP p, int l, unsigned char* smem) {
    constexpr int US = 1028;
    constexpr int RB = 12;
    float* Us = (float*)smem;
    float* Ps = Us + RB * US;
    const int tid = TIDX(), wave = tid >> 6, lane = tid & 63;
    const xres_t* X = (const xres_t*)(p->ws + WS_X); xres_t* Xo = (xres_t*)(p->ws + (DRY ? WS_OB : WS_X)); const bf16_t* P = (const bf16_t*)(p->ws + WS_P); bf16_t* U = (bf16_t*)(p->ws + (DRY ? WS_Y : WS_U));
    const float* MOD = (const float*)(p->ws + WS_MOD); const float* WrT = (const float*)(p->ws + WS_WRT) + (size_t)l * 36 * 1024;
    const float* lng = p->in[6] + l * 1024; const float* lnb = p->in[7] + l * 1024;
    const float* bgrp = p->in[26] + l * 4; const float* brex = p->in[28] + l * 32;
    unsigned* cnt = (unsigned*)(p->ws + WS_CTL) + CNT_WORD0 + l * 32 * CNT_STRIDE + (DRY ? 64 : 0); int* list = (int*)(p->ws + WS_LIST); float* slotw = (float*)(p->ws + WS_SLOTW);
    const int rows_total = (l == 3) ? ML : MT;
    const int mi = lane & 15, mq = lane >> 4;
    int pend_slot = -1, pend_e = 0; unsigned pend_pos = 0u;
    float* Bs = Ps + 4 * RB * 36;
    float* Gs = Bs + 48;
    __syncthreads();
    if (tid < 32) Bs[tid] = brex[tid]; else if (tid < 36) Bs[tid] = bgrp[tid - 32];
    *(f32x4*)(Gs + 4 * tid) = *(const f32x4*)(lng + 4 * tid); *(f32x4*)(Gs + 1024 + 4 * tid) = *(const f32x4*)(lnb + 4 * tid);
    __syncthreads();
    constexpr bool RAW16 = (XRES == 2) && !L0;
    typedef typename std::conditional<RAW16, f16x4_t, f32x4>::type xr_t;
    xr_t rx[3][4]; u32x2 rp[3][4];
#define LN1_FETCH(IT, RR) { const int frow_ = (IT) * RB + wave * 3 + (RR); const int frow = frow_ < rows_total ? frow_ : rows_total - 1; \
        const float* xsrc = L0 ? (frow < ML ? p->in[0] + (size_t)frow * 1024 : p->in[2] + (size_t)(frow - ML) * 1024) : nullptr; \
        _Pragma("unroll") for (int j = 0; j < 4; ++j) { const int k = 256 * j + 4 * lane; \
            if constexpr (L0) rx[RR][j] = *(const f32x4*)(xsrc + k); else if constexpr (RAW16) rx[RR][j] = *(const f16x4_t*)(X + (size_t)frow * 1024 + k); else rx[RR][j] = xload(X + (size_t)frow * 1024 + k); \
            rp[RR][j] = *(const u32x2*)(P + (size_t)frow * 1024 + k); } }
    f32x4 pg1[4], psh[4], psc[4];
#define LN1_ROWR(ROW) ((ROW) < ML ? ((ROW) >> 11) : 8)
#define LN1_VFETCH(IT) { const int fr__ = (IT) * RB + wave * 3; const int fr_ = fr__ < rows_total ? fr__ : rows_total - 1; const float* m_ = MOD + (size_t)(l * 9 + LN1_ROWR(fr_)) * 6144; \
        _Pragma("unroll") for (int j = 0; j < 4; ++j) { const int k = 256 * j + 4 * lane; pg1[j] = *(const f32x4*)(m_ + 2048 + k); psh[j] = *(const f32x4*)(m_ + 3072 + k); psc[j] = *(const f32x4*)(m_ + 4096 + k); } }
    int it = BIDX();
    if (it * RB < rows_total) { LN1_FETCH(it, 0) LN1_FETCH(it, 1) LN1_FETCH(it, 2) LN1_VFETCH(it) }
#define LN1_ROW(rr, G1, SH, SC) { \
            const int rowr = row0 + (rr); const bool rvalid = rowr < rows_total; const int row = rvalid ? rowr : rows_total - 1; \
            f32x4 v[4]; float s = 0.f; \
            _Pragma("unroll") for (int j = 0; j < 4; ++j) { \
                f32x4 xv; if constexpr (RAW16) xv = __builtin_convertvector(rx[rr][j], f32x4); else xv = rx[rr][j]; \
                const u32x2 pw_ = rp[rr][j]; const f32x4 pv = (f32x4){bflo(pw_.x), bfhi(pw_.x), bflo(pw_.y), bfhi(pw_.y)}; \
                v[j] = xv * ALPHA + G1[j] * pv; s += (v[j][0] + v[j][1]) + (v[j][2] + v[j][3]); } \
            const float mean = wave_sum(s) * (1.0f / 1024.0f); float s2 = 0.f; \
            _Pragma("unroll") for (int j = 0; j < 4; ++j) { v[j] = v[j] - mean; s2 += (v[j][0] * v[j][0] + v[j][1] * v[j][1]) + (v[j][2] * v[j][2] + v[j][3] * v[j][3]); } \
            const float rstd = 1.0f / sqrtf(wave_sum(s2) * (1.0f / 1024.0f) + LN_EPS); \
            _Pragma("unroll") for (int j = 0; j < 4; ++j) { \
                const int k = 256 * j + 4 * lane; \
                const f32x4 xn = v[j] * rstd * *(const f32x4*)(Gs + k) + *(const f32x4*)(Gs + 1024 + k); \
                const f32x4 uu = xn * (1.0f + SC[j]) + SH[j]; \
                *(f32x4*)(Us + (wave * 3 + (rr)) * US + k) = uu; \
                if (rvalid) { \
                    xstore(Xo + (size_t)row * 1024 + k, xn); \
                    u32x2 w; w.x = pk2(uu[0], uu[1]); w.y = pk2(uu[2], uu[3]); \
                    *(u32x2*)(U + (size_t)row * 1024 + k) = w; } } }
#define LN1_ROW_SLOW(rr) { const int rw__ = row0 + (rr); const int rw_ = rw__ < rows_total ? rw__ : rows_total - 1; const float* m_ = MOD + (size_t)(l * 9 + LN1_ROWR(rw_)) * 6144; \
            f32x4 tg[4], th[4], tc[4]; \
            _Pragma("unroll") for (int j = 0; j < 4; ++j) { const int k = 256 * j + 4 * lane; tg[j] = *(const f32x4*)(m_ + 2048 + k); th[j] = *(const f32x4*)(m_ + 3072 + k); tc[j] = *(const f32x4*)(m_ + 4096 + k); } \
            LN1_ROW(rr, tg, th, tc) }
#pragma unroll 1
    for (; it * RB < rows_total; it += gridDim.x) {
        const int row0 = it * RB + wave * 3;
        const bool has_next = (it + (int)gridDim.x) * RB < rows_total;
        const int rlast_ = row0 + 2 < rows_total ? row0 + 2 : rows_total - 1, rfirst_ = row0 < rows_total ? row0 : rows_total - 1;
        if (LN1_ROWR(rlast_) == LN1_ROWR(rfirst_)) {
            LN1_ROW(0, pg1, psh, psc) LN1_ROW(1, pg1, psh, psc) LN1_ROW(2, pg1, psh, psc)
        } else {
            LN1_ROW_SLOW(0) LN1_ROW_SLOW(1) LN1_ROW_SLOW(2)
        }
        __syncthreads();
        {
            f32x4 acc[3] = {(f32x4){0.f, 0.f, 0.f, 0.f}, (f32x4){0.f, 0.f, 0.f, 0.f}, (f32x4){0.f, 0.f, 0.f, 0.f}};
            const float* ap = Us + (mi < RB ? mi : mi - RB) * US + 256 * wave + 4 * mq;
            const float* bp0 = WrT + (size_t)wave * 9216 + lane * 4;
            const float* bp1 = bp0 + 256;
            const float* bp2 = WrT + (size_t)wave * 9216 + 512 + (mq * 4 + (mi & 3)) * 4;
#define LN1_BATCH_LOAD(sb0, n) { _Pragma("unroll") for (int q = 0; q < (n); ++q) { bv[q][0] = *(const f32x4*)(bp0 + 576 * ((sb0) + q)); bv[q][1] = *(const f32x4*)(bp1 + 576 * ((sb0) + q)); bv[q][2] = *(const f32x4*)(bp2 + 576 * ((sb0) + q)); } }
#define LN1_BATCH_MFMA(sb0, n) { _Pragma("unroll") for (int q = 0; q < (n); ++q) { const f32x4 a = *(const f32x4*)(ap + 16 * ((sb0) + q)); _Pragma("unroll") for (int e = 0; e < 4; ++e) { \
                acc[0] = __builtin_amdgcn_mfma_f32_16x16x4f32(a[e], bv[q][0][e], acc[0], 0, 0, 0); acc[1] = __builtin_amdgcn_mfma_f32_16x16x4f32(a[e], bv[q][1][e], acc[1], 0, 0, 0); \
                acc[2] = __builtin_amdgcn_mfma_f32_16x16x4f32(a[e], bv[q][2][e], acc[2], 0, 0, 0); } } }
            {
                constexpr int NB = 4;
                f32x4 bv[NB][3];
                LN1_BATCH_LOAD(0, NB)
                __builtin_amdgcn_sched_barrier(0);
                { const int nit = has_next ? it + (int)gridDim.x : it; LN1_FETCH(nit, 0) LN1_FETCH(nit, 1) LN1_FETCH(nit, 2) }
                __builtin_amdgcn_sched_barrier(0);
                LN1_BATCH_MFMA(0, NB)
                __builtin_amdgcn_sched_barrier(0);
                LN1_BATCH_LOAD(NB, NB)
                __builtin_amdgcn_sched_barrier(0);
                LN1_BATCH_MFMA(NB, NB)
                __builtin_amdgcn_sched_barrier(0);
                LN1_BATCH_LOAD(2 * NB, NB)
                __builtin_amdgcn_sched_barrier(0);
                LN1_BATCH_MFMA(2 * NB, NB)
                __builtin_amdgcn_sched_barrier(0);
                LN1_BATCH_LOAD(3 * NB, 16 - 3 * NB)
                __builtin_amdgcn_sched_barrier(0);
                LN1_BATCH_MFMA(3 * NB, 16 - 3 * NB)
                __builtin_amdgcn_sched_barrier(0);
                { const int nit = has_next ? it + (int)gridDim.x : it; LN1_VFETCH(nit) }
            }
#undef LN1_BATCH_LOAD
#undef LN1_BATCH_MFMA
            if (mq < 3) {
#pragma unroll
                for (int nt = 0; nt < 3; ++nt)
#pragma unroll
                    for (int rg = 0; rg < 4; ++rg) if (nt < 2 || mi < 4) Ps[(wave * RB + mq * 4 + rg) * 36 + nt * 16 + mi] = acc[nt][rg];
            }
        }
        __syncthreads();
        if (wave < 2) {
            const int r = wave * 8 + (lane >> 3), c = lane & 7;
            const int rq = r < RB ? r : RB - 1;
            const int row = it * RB + rq;
            float lgv[5];
#pragma unroll
            for (int k = 0; k < 5; ++k) {
                const int o = c + 8 * k; const int oo = o < 36 ? o : 35;
                lgv[k] = (Ps[(0 * RB + rq) * 36 + oo] + Ps[(1 * RB + rq) * 36 + oo]) + (Ps[(2 * RB + rq) * 36 + oo] + Ps[(3 * RB + rq) * 36 + oo]);
            }
#define DPPF(v, ctrl) ({ float r_ = __int_as_float(__builtin_amdgcn_update_dpp(0, __float_as_int(v), ctrl, 0xF, 0xF, true)); asm volatile("" : "+v"(r_)); r_; })
#define DPPI(v, ctrl) ({ int r_ = __builtin_amdgcn_update_dpp(0, (v), ctrl, 0xF, 0xF, true); asm volatile("" : "+v"(r_)); r_; })
#define ARGMAX_STEP(V, I, ctrl) { const float ov = DPPF(V, ctrl); const int oi = DPPI(I, ctrl); if (ov > V || (ov == V && oi < I)) { V = ov; I = oi; } }
            const float bgrp_c = Bs[32 + (c & 3)];
            float gv = c < 4 ? lgv[0] + bgrp_c : -3.0e38f; int gi = c;
            ARGMAX_STEP(gv, gi, 0xB1) ARGMAX_STEP(gv, gi, 0x4E) ARGMAX_STEP(gv, gi, 0x141)
            const float gmax = gv; const int grp = gi;
            float ge = c < 4 ? expf(lgv[0] + bgrp_c - gmax) : 0.f;
            ge += DPPF(ge, 0xB1); ge += DPPF(ge, 0x4E); ge += DPPF(ge, 0x141);
            const float gw = 1.0f / ge;
            const int j = (c + 4) & 7; const int kk = c >= 4 ? grp : grp + 1;
            float ev = lgv[0];
#pragma unroll
            for (int k = 1; k < 5; ++k) ev = (kk == k) ? lgv[k] : ev;
            ev += Bs[grp * 8 + j];
            float v1 = ev; int i1 = j;
            ARGMAX_STEP(v1, i1, 0xB1) ARGMAX_STEP(v1, i1, 0x4E) ARGMAX_STEP(v1, i1, 0x141)
            float v2 = (j == i1) ? -3.0e38f : ev; int i2 = (j == i1) ? 99 : j;
            ARGMAX_STEP(v2, i2, 0xB1) ARGMAX_STEP(v2, i2, 0x4E) ARGMAX_STEP(v2, i2, 0x141)
#undef ARGMAX_STEP
#undef DPPF
#undef DPPI
            const float e2 = expf(v2 - v1);
            const float w1 = 1.0f / (1.0f + e2), w2 = e2 / (1.0f + e2);
            if (c < 2 && r < RB && row < rows_total) {
                if (pend_slot >= 0) list[(size_t)pend_e * NSLOT + pend_pos] = pend_slot;
                const int e = grp * 8 + (c ? i2 : i1); const float w = gw * (c ? w2 : w1);
                const int slot = row * 2 + c;
                slotw[slot] = w;
#ifdef DRY_NOATOM
                pend_pos = DRY ? (unsigned)slot : atomicAdd(&cnt[e * CNT_STRIDE], 1u); pend_e = e; pend_slot = slot;
#else
                pend_pos = atomicAdd(&cnt[e * CNT_STRIDE], 1u); pend_e = e; pend_slot = slot;
#endif
            }
        }
        __syncthreads();
    }
    if (pend_slot >= 0) list[(size_t)pend_e * NSLOT + pend_pos] = pend_slot;
}

DI void moe_prefix(KP p, int l, int* s_cnt, int* s_tb, int* s_rb) {
    const int tid = TIDX();
    const unsigned* cnt = (const unsigned*)(p->ws + WS_CTL) + CNT_WORD0 + l * 32 * CNT_STRIDE;
    __syncthreads();
    if (tid < 32) s_cnt[tid] = (int)__hip_atomic_load(cnt + tid * CNT_STRIDE, __ATOMIC_RELAXED, __HIP_MEMORY_SCOPE_AGENT);
    __syncthreads();
    if (tid == 0) { int tb = 0; for (int e = 0; e < 32; ++e) { s_tb[e] = tb; s_rb[e] = tb * 128; tb += (s_cnt[e] + 127) >> 7; } s_tb[32] = tb; s_rb[32] = tb * 128; }
    __syncthreads();
}
DI void phase_mg1(KP p, int l, unsigned char* smem) {
    const int tid = TIDX(), wid = tid >> 6, lane = tid & 63, wr = wid >> 1, wc = wid & 1, fr = lane & 15, fq = lane >> 4;
    int* s_cnt = (int*)(smem + 65536 + 64); int* s_tb = s_cnt + 32; int* s_rb = s_tb + 33;
    moe_prefix(p, l, s_cnt, s_tb, s_rb);
    const bf16_t* U = (const bf16_t*)(p->ws + WS_U); const int* list = (const int*)(p->ws + WS_LIST);
    bf16_t* H = (bf16_t*)(p->ws + WS_H);
    const int ntiles = s_tb[32] * 8;
    struct TI { int e, rt, nt, cnt_e; };
    auto decode = [&](int i, TI& t) -> bool {
        const int tile = xcd_seq(i, ntiles); if (tile < 0) return false;
        const int rtg = tile >> 3; t.nt = tile & 7;
        int e = 0;
        for (int q = 1; q < 32; ++q) if (rtg >= s_tb[q]) e = q;
        t.e = e; t.rt = rtg - s_tb[e]; t.cnt_e = s_cnt[e]; return true; };
    auto ltok = [&](const TI& t, bool valid, int (&tk)[4]) {
#pragma unroll
        for (int i_ = 0; i_ < 4; ++i_) {
            const int pos = t.rt * 128 + (tid >> 3) + 32 * i_;
            tk[i_] = (valid && pos < t.cnt_e) ? list[(size_t)t.e * NSLOT + pos] : 0;
        }
    };
    auto rows = [&](const TI& t, const int (&tk)[4], const bf16_t* (&a)[4], const bf16_t* (&b)[4]) {
#pragma unroll
        for (int i_ = 0; i_ < 4; ++i_) a[i_] = U + (size_t)(tk[i_] >> 1) * 1024 + gemm_chunk(tid) * 8;
        gemm_rows((const bf16_t*)(p->ws + WS_WGU) + (size_t)(l * 32 + t.e) * 1024 * 1024, t.nt * 128, 1024, tid, b); };
    TI cur, nxt, nn;
    if (!decode(0, cur)) return;
    const bf16_t* ap[4]; const bf16_t* bp[4]; const bf16_t* apn[4]; const bf16_t* bpn[4];
    int tkc[4], tkn[4], tk2[4];
    ltok(cur, true, tkc);
    nxt = cur; bool hn = decode(1, nxt);
    ltok(nxt, hn, tkn);
    rows(cur, tkc, ap, bp);
    bool first = true;
    for (int i = 0;; ++i) {
        rows(nxt, tkn, apn, bpn);
        nn = nxt; const bool hnn = hn && decode(i + 2, nn);
        ltok(nn, hnn, tk2);
        f32x4 acc[4][4];
        gemm_tile<true>(smem, ap, bp, 1024, acc, first, hn, apn, bpn);
        const int hrow0 = s_rb[cur.e] + cur.rt * 128 + wr * 64;
#pragma unroll
        for (int m = 0; m < 4; ++m) {
            bf16_t* o = H + (size_t)(hrow0 + m * 16 + fr) * 512 + cur.nt * 64 + wc * 32 + fq * 4;
            u32x2 hw[2];
#pragma unroll
            for (int n = 0; n < 4; n += 2) {
                const f32x4 g = acc[m][n], uu = acc[m][n + 1]; f32x4 h;
#pragma unroll
                for (int j = 0; j < 4; ++j) h[j] = siluf(g[j]) * uu[j];
                hw[n >> 1].x = pk2(h[0], h[1]); hw[n >> 1].y = pk2(h[2], h[3]);
            }
            *(u32x4*)(o - fq * 4 + pair16_col(0, fq)) = pair16(hw[0], hw[1]);
        }
        if (!hn) break;
        cur = nxt; nxt = nn; hn = hnn; GEMM_ADVANCE(); first = false;
#pragma unroll
        for (int i_ = 0; i_ < 4; ++i_) tkn[i_] = tk2[i_];
    }
}
DI void phase_mg2(KP p, int l, unsigned char* smem) {
    const int tid = TIDX(), wid = tid >> 6, lane = tid & 63, wr = wid >> 1, wc = wid & 1, fr = lane & 15, fq = lane >> 4;
    int* s_cnt = (int*)(smem + 65536 + 64); int* s_tb = s_cnt + 32; int* s_rb = s_tb + 33;
    moe_prefix(p, l, s_cnt, s_tb, s_rb);
    const bf16_t* H = (const bf16_t*)(p->ws + WS_H); const int* list = (const int*)(p->ws + WS_LIST); const float* slotw = (const float*)(p->ws + WS_SLOTW);
    bf16_t* YS = (bf16_t*)(p->ws + WS_YS);
    const int ntiles = s_tb[32] * 8;
    struct TI { int e, rt, nt, cnt_e; };
    auto decode = [&](int i, TI& t) -> bool {
        const int tile = xcd_seq(i, ntiles); if (tile < 0) return false;
        const int rtg = tile >> 3; t.nt = tile & 7;
        int e = 0;
        for (int q = 1; q < 32; ++q) if (rtg >= s_tb[q]) e = q;
        t.e = e; t.rt = rtg - s_tb[e]; t.cnt_e = s_cnt[e]; return true; };
    auto rows = [&](const TI& t, const bf16_t* (&a)[4], const bf16_t* (&b)[4]) {
        gemm_rows(H, s_rb[t.e] + t.rt * 128, 512, tid, a);
        gemm_rows((const bf16_t*)(p->ws + WS_WD) + (size_t)(l * 32 + t.e) * 1024 * 512, t.nt * 128, 512, tid, b); };
    TI cur, nxt;
    if (!decode(0, cur)) return;
    const bf16_t* ap[4]; const bf16_t* bp[4]; const bf16_t* apn[4]; const bf16_t* bpn[4];
    rows(cur, ap, bp);
    auto lslot = [&](const TI& t, bool valid, int (&es)[4]) {
#pragma unroll
        for (int m = 0; m < 4; ++m) {
            const int pos = t.rt * 128 + wr * 64 + m * 16 + fr;
            es[m] = (valid && pos < t.cnt_e) ? list[(size_t)t.e * NSLOT + pos] : -1;
        }
    };
    int eslot[4], eslot_n[4];
    lslot(cur, true, eslot);
    bool first = true;
    for (int i = 0;; ++i) {
        nxt = cur; const bool hn = decode(i + 1, nxt);
        rows(nxt, apn, bpn);
        float ew[4];
#pragma unroll
        for (int m = 0; m < 4; ++m) ew[m] = eslot[m] >= 0 ? slotw[eslot[m]] : 0.f;
        lslot(nxt, hn, eslot_n);
        f32x4 acc[4][4];
        gemm_tile<true>(smem, ap, bp, 512, acc, first, hn, apn, bpn);
#pragma unroll
        for (int m = 0; m < 4; ++m) {
            const float w = ew[m];
            u32x4 pw[2];
#pragma unroll
            for (int n = 0; n < 4; n += 2) { const f32x4 v0 = acc[m][n] * w, v1 = acc[m][n + 1] * w; u32x2 w0, w1; w0.x = pk2(v0[0], v0[1]); w0.y = pk2(v0[2], v0[3]); w1.x = pk2(v1[0], v1[1]); w1.y = pk2(v1[2], v1[3]);
                pw[n >> 1] = pair16(w0, w1); }
            if (eslot[m] >= 0) {
                bf16_t* o = YS + (size_t)eslot[m] * 1024 + cur.nt * 128 + wc * 64;
                *(u32x4*)(o + pair16_col(0, fq)) = pw[0]; *(u32x4*)(o + pair16_col(2, fq)) = pw[1];
            }
        }
        if (!hn) break;
        cur = nxt; GEMM_ADVANCE(); first = false;
#pragma unroll
        for (int m = 0; m < 4; ++m) eslot[m] = eslot_n[m];
    }
}

template <bool DRY>
DI void phase_ln2(KP p, int l) {
    const int tid = TIDX(), wave = tid >> 6, lane = tid & 63;
    const xres_t* X = (const xres_t*)(p->ws + WS_X); xres_t* Xo = (xres_t*)(p->ws + (DRY ? WS_OB : WS_X)); const bf16_t* YS = (const bf16_t*)(p->ws + WS_YS); bf16_t* U = (bf16_t*)(p->ws + (DRY ? WS_Y : WS_U));
    const float* MOD = (const float*)(p->ws + WS_MOD);
    const float* lng = p->in[8] + l * 1024; const float* lnb = p->in[9] + l * 1024;
    const int rows_total = (l == 3) ? ML : MT;
    static_assert(XRES == 2, "LN2 is written for the fp16 residual stream");
    u32x4 ry0[2][2], ry1[2][2], rx[2][2];
    const int rstride = gridDim.x * 8;
    int row0 = (BIDX() * 4 + wave) * 2;
#define LN2_K(j) (512 * ((j) >> 1) + 8 * lane + 4 * ((j) & 1))
    f32x4 pg2[4], psh[4], psc[4];
#define LN2_FETCH(R0) { _Pragma("unroll") for (int q = 0; q < 2; ++q) { const int row = (R0) + q; _Pragma("unroll") for (int jp = 0; jp < 2; ++jp) { const int k = 512 * jp + 8 * lane; \
        ry0[q][jp] = *(const u32x4*)(YS + (size_t)(2 * row) * 1024 + k); ry1[q][jp] = *(const u32x4*)(YS + (size_t)(2 * row + 1) * 1024 + k); rx[q][jp] = *(const u32x4*)(X + (size_t)row * 1024 + k); } } \
        const int r_ = (R0) < ML ? ((R0) >> 11) : 8; const float* modp_ = MOD + (size_t)(l * 9 + r_) * 6144; const float* modn_ = modp_ + (l + 1 < 4 ? 9 * 6144 : 0); \
        _Pragma("unroll") for (int j = 0; j < 4; ++j) { const int k = LN2_K(j); pg2[j] = *(const f32x4*)(modp_ + 5120 + k); psh[j] = *(const f32x4*)(modn_ + k); psc[j] = *(const f32x4*)(modn_ + 1024 + k); } }
    f32x4 gam[4], bet[4];
#pragma unroll
    for (int j = 0; j < 4; ++j) { gam[j] = *(const f32x4*)(lng + LN2_K(j)); bet[j] = *(const f32x4*)(lnb + LN2_K(j)); }
    if (row0 < rows_total) LN2_FETCH(row0)
#pragma unroll 1
    for (; row0 < rows_total; row0 += rstride) {
        f32x4 v[2][4]; float s[2] = {0.f, 0.f};
        f32x4 g2[4], shn[4], scn[4];
#pragma unroll
        for (int j = 0; j < 4; ++j) { g2[j] = pg2[j]; shn[j] = psh[j]; scn[j] = psc[j]; }
#pragma unroll
        for (int q = 0; q < 2; ++q) {
#pragma unroll
            for (int j = 0; j < 4; ++j) {
                const u32x4 w0 = ry0[q][j >> 1], w1 = ry1[q][j >> 1], wx = rx[q][j >> 1];
                const unsigned a0 = (j & 1) ? w0.z : w0.x, a1 = (j & 1) ? w0.w : w0.y, b0 = (j & 1) ? w1.z : w1.x, b1 = (j & 1) ? w1.w : w1.y;
                f32x4 y; y[0] = bflo(a0) + bflo(b0); y[1] = bfhi(a0) + bfhi(b0); y[2] = bflo(a1) + bflo(b1); y[3] = bfhi(a1) + bfhi(b1);
                u32x2 xh; xh.x = (j & 1) ? wx.z : wx.x; xh.y = (j & 1) ? wx.w : wx.y;
                const f32x4 xv = __builtin_convertvector(__builtin_bit_cast(f16x4_t, xh), f32x4);
                v[q][j] = xv * ALPHA + g2[j] * y; s[q] += (v[q][j][0] + v[q][j][1]) + (v[q][j][2] + v[q][j][3]);
            }
        }
        __builtin_amdgcn_sched_barrier(0);
        { const int nrow0 = (row0 + rstride < rows_total) ? row0 + rstride : row0; LN2_FETCH(nrow0) }
        __builtin_amdgcn_sched_barrier(0);
        float mean[2], rstd[2];
#pragma unroll
        for (int q = 0; q < 2; ++q) mean[q] = wave_sum(s[q]) * (1.0f / 1024.0f);
#pragma unroll
        for (int q = 0; q < 2; ++q) {
            float s2 = 0.f;
#pragma unroll
            for (int j = 0; j < 4; ++j) { v[q][j] = v[q][j] - mean[q]; s2 += (v[q][j][0] * v[q][j][0] + v[q][j][1] * v[q][j][1]) + (v[q][j][2] * v[q][j][2] + v[q][j][3] * v[q][j][3]); }
            s[q] = s2;
        }
#pragma unroll
        for (int q = 0; q < 2; ++q) rstd[q] = 1.0f / sqrtf(wave_sum(s[q]) * (1.0f / 1024.0f) + LN_EPS);
#pragma unroll
        for (int q = 0; q < 2; ++q) {
            const int row = row0 + q;
#pragma unroll
            for (int jp = 0; jp < 2; ++jp) {
                const int kp = 512 * jp + 8 * lane;
                const f32x4 xa = v[q][2 * jp] * rstd[q] * gam[2 * jp] + bet[2 * jp], xb = v[q][2 * jp + 1] * rstd[q] * gam[2 * jp + 1] + bet[2 * jp + 1];
                if (l < 3) {
                    const u32x2 ha = __builtin_bit_cast(u32x2, __builtin_convertvector(xa, f16x4_t)), hb = __builtin_bit_cast(u32x2, __builtin_convertvector(xb, f16x4_t));
                    u32x4 hx; hx.x = ha.x; hx.y = ha.y; hx.z = hb.x; hx.w = hb.y;
                    *(u32x4*)(Xo + (size_t)row * 1024 + kp) = hx;
                    const f32x4 ua = xa * (1.0f + scn[2 * jp]) + shn[2 * jp], ub = xb * (1.0f + scn[2 * jp + 1]) + shn[2 * jp + 1];
                    u32x4 w; w.x = pk2(ua[0], ua[1]); w.y = pk2(ua[2], ua[3]); w.z = pk2(ub[0], ub[1]); w.w = pk2(ub[2], ub[3]);
                    *(u32x4*)(U + (size_t)row * 1024 + kp) = w;
                } else {
                    *(f32x4*)(p->out + (size_t)row * 1024 + kp) = xa; *(f32x4*)(p->out + (size_t)row * 1024 + kp + 4) = xb;
                }
            }
        }
    }
#undef LN2_FETCH
#undef LN2_K
}

DI s16x4 tr_read(const unsigned char* ptr) {
    typedef short v4i16_t __attribute__((ext_vector_type(4)));
    return __builtin_bit_cast(s16x4, __builtin_amdgcn_ds_read_tr16_b64_v4i16((LAS v4i16_t*)ptr));
}
DI bf16x8 cat8(s16x4 a, s16x4 b) { return __builtin_shufflevector(a, b, 0, 1, 2, 3, 4, 5, 6, 7); }

DI void phase_decay(KP p, int l, unsigned char* smem, int bsel, int rsel) {
    const int tid = TIDX();
    const int li = l >> 1;
    const float* LR = (const float*)(p->ws + WS_LR); float* TOT = (float*)(p->ws + WS_TOT);
    const bf16_t* Z = (const bf16_t*)(p->ws + WS_Z);
    float* lrs = (float*)smem;
    float* cum = lrs + 64 * 16;
    float wf[16], wb[16];
#pragma unroll
    for (int r = 0; r < 16; ++r) { wf[r] = p->in[11][(size_t)li * 16 * 256 + r * 256 + tid]; wb[r] = p->in[13][(size_t)li * 16 * 256 + r * 256 + tid]; }
    const float bf = p->in[12][li * 256 + tid], bb = p->in[14][li * 256 + tid];
    const int kcount = bsel < 0 ? 2 * (MT / 64) : 72, kstep = bsel < 0 ? (int)gridDim.x : 32;
    auto item_of = [&](int kk, int& ch, int& dr) {
        if (bsel < 0) { ch = kk >> 1; dr = kk & 1; }
        else { dr = kk & 1; const int cl = kk >> 1; ch = cl < 32 ? bsel * 32 + cl : 256 + bsel * 4 + (cl - 32); } };
    auto lr_load = [&](int ch, int dr) -> f32x4 { const int tok = tid >> 2, q4 = tid & 3; return *(const f32x4*)(LR + (size_t)(ch * 64 + tok) * 32 + dr * 16 + q4 * 4); };
    int kk = bsel < 0 ? BIDX() : rsel;
    f32x4 lr_next = (f32x4){0.f, 0.f, 0.f, 0.f};
    if (kk < kcount) { int c0, d0; item_of(kk, c0, d0); lr_next = lr_load(c0, d0); }
    for (; kk < kcount; kk += kstep) {
        int ch, dr; item_of(kk, ch, dr);
        const int row0 = ch * 64;
        bf16_t* QD = (bf16_t*)(p->ws + (dr ? WS_QDB : WS_QDF)); bf16_t* KD = QD + (size_t)MT * 256;
        const f32x4 lr_cur = lr_next;
        { int cn, dn; item_of(kk + kstep < kcount ? kk + kstep : kk, cn, dn); lr_next = lr_load(cn, dn); }
        __syncthreads();
        { const int tok = tid >> 2, q4 = tid & 3; *(f32x4*)(lrs + tok * 16 + q4 * 4) = lr_cur; }
        __syncthreads();
        float run = 0.f;
#pragma unroll 1
        for (int half = 0; half < 2; ++half) {
            const int base = dr ? 32 - 32 * half : 32 * half;
            u32x4 qv[4], kv[4];
#pragma unroll
            for (int i = 0; i < 4; ++i) {
                const int id = tid + 256 * i, tokl = id >> 5, cg = id & 31;
                const size_t zr = (size_t)(row0 + base + tokl) * ZS;
                qv[i] = *(const u32x4*)(Z + zr + 2048 + cg * 8); kv[i] = *(const u32x4*)(Z + zr + 2304 + cg * 8);
            }
            if (dr == 0) {
                for (int t = base; t < base + 32; ++t) {
                    float g = bf;
#pragma unroll
                    for (int r = 0; r < 16; ++r) g += lrs[t * 16 + r] * wf[r];
                    run += (fminf(g, 0.f) - __logf(1.0f + __expf(-fabsf(g)))) * (1.0f / 16.0f);
                    cum[(t - base) * 256 + tid] = run;
                }
            } else {
                cum[32 * 256 + tid] = run;
                for (int t = base + 31; t >= base; --t) {
                    float g = bb;
#pragma unroll
                    for (int r = 0; r < 16; ++r) g += lrs[t * 16 + r] * wb[r];
                    run += (fminf(g, 0.f) - __logf(1.0f + __expf(-fabsf(g)))) * (1.0f / 16.0f);
                    cum[(t - base) * 256 + tid] = run;
                }
            }
            __syncthreads();
#pragma unroll
            for (int i = 0; i < 4; ++i) {
                const int id = tid + 256 * i, tokl = id >> 5, cg = id & 31;
                const float* ce = cum + tokl * 256 + cg * 8;
                const float* cq = dr ? ce + 256 : ce;
                const f32x4 a0 = *(const f32x4*)cq, a1 = *(const f32x4*)(cq + 4), b0 = *(const f32x4*)ce, b1 = *(const f32x4*)(ce + 4);
                float fqv[8], fkv[8];
#pragma unroll
                for (int e = 0; e < 4; ++e) { fqv[e] = __expf(a0[e]); fqv[4 + e] = __expf(a1[e]); fkv[e] = __expf(-b0[e]); fkv[4 + e] = __expf(-b1[e]); }
                const u32x4 q = qv[i], k = kv[i]; u32x4 qo, ko;
                qo.x = pk2(bflo(q.x) * fqv[0], bfhi(q.x) * fqv[1]); qo.y = pk2(bflo(q.y) * fqv[2], bfhi(q.y) * fqv[3]); qo.z = pk2(bflo(q.z) * fqv[4], bfhi(q.z) * fqv[5]); qo.w = pk2(bflo(q.w) * fqv[6], bfhi(q.w) * fqv[7]);
                ko.x = pk2(bflo(k.x) * fkv[0], bfhi(k.x) * fkv[1]); ko.y = pk2(bflo(k.y) * fkv[2], bfhi(k.y) * fkv[3]); ko.z = pk2(bflo(k.z) * fkv[4], bfhi(k.z) * fkv[5]); ko.w = pk2(bflo(k.w) * fkv[6], bfhi(k.w) * fkv[7]);
                const size_t orow = (size_t)(row0 + base + tokl) * 256 + cg * 8;
                *(u32x4*)(QD + orow) = qo; *(u32x4*)(KD + orow) = ko;
            }
            __syncthreads();
        }
        TOT[(size_t)(ch * 2 + dr) * 256 + tid] = run;
    }
}

template <int DK>
DI void scan_item(KP p, int l, int item, unsigned char* smem) {
    constexpr bool ISA = (DK == 128);
    constexpr int QS = DK * 2 + 16, KS = DK * 2 + 32, VS = 96, AS_ = 144, SS = DK * 2 + 16, NKS = DK / 32, NMT = DK / 64;
    constexpr int O_QD = 0, O_KD = O_QD + 64 * QS, O_V = O_KD + 64 * KS, O_ATT = O_V + 64 * VS, O_ST = O_ATT + 64 * AS_, O_END = O_ST + 32 * SS;
    static_assert(O_END <= 65536, "scan LDS");
    constexpr int NP = DK / 64 * 2;
    constexpr int CPR = DK / 8;
    const int tid = TIDX(), wid = tid >> 6, lane = tid & 63, fr = lane & 15, fq = lane >> 4;
    const int b = item >> 5, h = (item >> 3) & 3, dir = (item >> 2) & 1, dvq = item & 3;
    const bf16_t* Z = (const bf16_t*)(p->ws + WS_Z);
    const bf16_t* QDg = (const bf16_t*)(p->ws + (dir ? WS_QDB : WS_QDF)); const bf16_t* KDg = QDg + (size_t)MT * 256; const float* TOT = (const float*)(p->ws + WS_TOT);
    bf16_t* OUT = (bf16_t*)(p->ws + (dir ? WS_OB : WS_OF));
    const int qcol = ISA ? h * 128 : 2048 + h * 64, kcol = ISA ? 512 + h * 128 : 2304 + h * 64, vcol = (ISA ? 1024 : 2560) + h * 128 + dvq * 32;
    const int ocol = (ISA ? 0 : 512) + h * 128 + dvq * 32;
    float lam = 0.f;
    if (ISA) lam = log1pf(-exp2f(-((dir ? 5.5f : 5.0f) + (float)h)));
    f32x4 S[NMT][2];
#pragma unroll
    for (int a = 0; a < NMT; ++a) { S[a][0] = (f32x4){0.f, 0.f, 0.f, 0.f}; S[a][1] = (f32x4){0.f, 0.f, 0.f, 0.f}; }
    __syncthreads();
    for (int i = tid; i < 32 * SS / 4; i += 256) ((unsigned*)(smem + O_ST))[i] = 0u;
    auto chunk_row0 = [&](int cc) -> int {
        const int ci = dir ? 35 - cc : cc; const int pp = ci * 64;
        if (!dir) return pp < 256 ? ML + b * 256 + pp : b * 2048 + (pp - 256);
        return pp < 2048 ? b * 2048 + pp : ML + b * 256 + (pp - 2048);
    };
    u32x4 rq[NP], rk[NP], rv; f32x4 tv[NMT];
    auto fetch = [&](int cc) {
        const int row0 = chunk_row0(cc);
        if (!ISA) {
#pragma unroll
            for (int a = 0; a < NMT; ++a) tv[a] = *(const f32x4*)(TOT + (size_t)((row0 >> 6) * 2 + dir) * 256 + h * 64 + (wid * NMT + a) * 16 + fq * 4);
        }
#pragma unroll
        for (int i = 0; i < NP; ++i) {
            const int id = tid + 256 * i, tok = id / CPR, cg_ = id % CPR;
            if (ISA) {
                const size_t ro = (size_t)(row0 + tok) * ZS;
                rq[i] = *(const u32x4*)(Z + ro + qcol + cg_ * 8); rk[i] = *(const u32x4*)(Z + ro + kcol + cg_ * 8);
            } else {
                const size_t eo = (size_t)(row0 + tok) * 256 + h * 64 + cg_ * 8;
                rq[i] = *(const u32x4*)(QDg + eo); rk[i] = *(const u32x4*)(KDg + eo);
            }
        }
        { const int tok = tid >> 2, cg_ = tid & 3; rv = *(const u32x4*)(Z + (size_t)(row0 + tok) * ZS + vcol + cg_ * 8); }
    };
    float ra[NP], rc[NP];
#pragma unroll
    for (int i = 0; i < NP; ++i) {
        const int tok = (tid + 256 * i) / CPR;
        ra[i] = dir ? __expf(lam * (float)(63 - tok)) : __expf(lam * (float)(tok + 1));
        rc[i] = dir ? __expf(-lam * (float)(64 - tok)) : __expf(-lam * (float)(tok + 1));
    }
    const float decA = __expf(lam * 64.0f);
    fetch(0);
    for (int cc = 0; cc < 36; ++cc) {
        const int row0 = chunk_row0(cc);
#pragma unroll
        for (int i = 0; i < NP; ++i) {
            const int id = tid + 256 * i, tok = id / CPR, cg_ = id % CPR;
            const u32x4 q = rq[i], k = rk[i]; u32x4 qo = q, ko = k;
            if (ISA) {
                const float fqv = ra[i], fkv = rc[i];
                qo.x = pk2(bflo(q.x) * fqv, bfhi(q.x) * fqv); qo.y = pk2(bflo(q.y) * fqv, bfhi(q.y) * fqv); qo.z = pk2(bflo(q.z) * fqv, bfhi(q.z) * fqv); qo.w = pk2(bflo(q.w) * fqv, bfhi(q.w) * fqv);
                ko.x = pk2(bflo(k.x) * fkv, bfhi(k.x) * fkv); ko.y = pk2(bflo(k.y) * fkv, bfhi(k.y) * fkv); ko.z = pk2(bflo(k.z) * fkv, bfhi(k.z) * fkv); ko.w = pk2(bflo(k.w) * fkv, bfhi(k.w) * fkv);
            }
            *(u32x4*)(smem + O_QD + tok * QS + cg_ * 16) = qo;
            *(u32x4*)(smem + O_KD + tok * KS + cg_ * 16) = ko;
        }
        { const int tok = tid >> 2, cg_ = tid & 3; *(u32x4*)(smem + O_V + tok * VS + cg_ * 16) = rv; }
        f32x4 dec[NMT];
#pragma unroll
        for (int a = 0; a < NMT; ++a) {
            if (ISA) dec[a] = (f32x4){decA, decA, decA, decA};
            else dec[a] = (f32x4){__expf(tv[a][0]), __expf(tv[a][1]), __expf(tv[a][2]), __expf(tv[a][3])};
        }
        if (cc + 1 < 36) fetch(cc + 1);
        __syncthreads();
        bf16x8 qf[NKS], kf[NKS][4], vf[2][2], sf[NKS][2], ktf[NMT][2];
        {
            const int g = lane >> 4, i16 = lane & 15, q = i16 >> 2, pq = i16 & 3;
#pragma unroll
            for (int ks = 0; ks < NKS; ++ks) {
                qf[ks] = *(const bf16x8*)(smem + O_QD + (16 * wid + fr) * QS + (32 * ks + 8 * fq) * 2);
#pragma unroll
                for (int n = 0; n < 4; ++n) kf[ks][n] = *(const bf16x8*)(smem + O_KD + (16 * n + fr) * KS + (32 * ks + 8 * fq) * 2);
            }
#pragma unroll
            for (int ks = 0; ks < 2; ++ks)
#pragma unroll
                for (int n = 0; n < 2; ++n) {
                    const unsigned char* a = smem + O_V + (32 * ks + 4 * g + q) * VS + (n * 16 + 4 * pq) * 2;
                    vf[ks][n] = cat8(tr_read(a), tr_read(a + 16 * VS));
                }
        }
        __builtin_amdgcn_sched_barrier(0);
        bf16x8 afr[2];
        {
            f32x4 at[4];
#pragma unroll
            for (int n = 0; n < 4; ++n) at[n] = (f32x4){0.f, 0.f, 0.f, 0.f};
#pragma unroll
            for (int ks = 0; ks < NKS; ++ks)
#pragma unroll
                for (int n = 0; n < 4; ++n) at[n] = __builtin_amdgcn_mfma_f32_16x16x32_bf16(kf[ks][n], qf[ks], at[n], 0, 0, 0);
            {
                const int g = lane >> 4, i16 = lane & 15, q = i16 >> 2, pq = i16 & 3;
#pragma unroll
                for (int ks = 0; ks < NKS; ++ks)
#pragma unroll
                    for (int n = 0; n < 2; ++n) sf[ks][n] = *(const bf16x8*)(smem + O_ST + (16 * n + fr) * SS + (32 * ks + 8 * fq) * 2);
#pragma unroll
                for (int a = 0; a < NMT; ++a)
#pragma unroll
                    for (int ks = 0; ks < 2; ++ks) {
                        const unsigned char* ka = smem + O_KD + (32 * ks + 4 * g + q) * KS + ((wid * NMT + a) * 16 + 4 * pq) * 2;
                        ktf[a][ks] = cat8(tr_read(ka), tr_read(ka + 16 * KS));
                    }
            }
            __builtin_amdgcn_sched_barrier(0);
            const int i = 16 * wid + fr;
#pragma unroll
            for (int n = 0; n < 4; ++n)
#pragma unroll
                for (int jj = 0; jj < 4; ++jj) { const int j = n * 16 + fq * 4 + jj; const bool keep = dir ? (j > i) : (j <= i); at[n][jj] = keep ? at[n][jj] : 0.f; }
#pragma unroll
            for (int ks = 0; ks < 2; ++ks) {
                u32x4 w; w.x = pk2(at[2 * ks][0], at[2 * ks][1]); w.y = pk2(at[2 * ks][2], at[2 * ks][3]); w.z = pk2(at[2 * ks + 1][0], at[2 * ks + 1][1]); w.w = pk2(at[2 * ks + 1][2], at[2 * ks + 1][3]);
                afr[ks] = __builtin_bit_cast(bf16x8, w);
            }
        }
        {
            f32x4 oa[2] = {(f32x4){0.f, 0.f, 0.f, 0.f}, (f32x4){0.f, 0.f, 0.f, 0.f}};
#pragma unroll
            for (int ks = 0; ks < NKS; ++ks)
#pragma unroll
                for (int n = 0; n < 2; ++n) oa[n] = __builtin_amdgcn_mfma_f32_16x16x32_bf16(sf[ks][n], qf[ks], oa[n], 0, 0, 0);
#pragma unroll
            for (int ks = 0; ks < 2; ++ks)
#pragma unroll
                for (int n = 0; n < 2; ++n) oa[n] = __builtin_amdgcn_mfma_f32_16x16x32_bf16(vf[ks][n], afr[ks], oa[n], 0, 0, 0);
            bf16_t* o = OUT + (size_t)(row0 + 16 * wid + fr) * 1024 + ocol + fq * 4;
            u32x2 w0, w1; w0.x = pk2(oa[0][0], oa[0][1]); w0.y = pk2(oa[0][2], oa[0][3]); w1.x = pk2(oa[1][0], oa[1][1]); w1.y = pk2(oa[1][2], oa[1][3]);
            *(u32x4*)(o - fq * 4 + pair16_col(0, fq)) = pair16(w0, w1);
        }
#pragma unroll
        for (int a = 0; a < NMT; ++a) {
#pragma unroll
            for (int ks = 0; ks < 2; ++ks)
#pragma unroll
                for (int n = 0; n < 2; ++n) S[a][n] = __builtin_amdgcn_mfma_f32_16x16x32_bf16(ktf[a][ks], vf[ks][n], S[a][n], 0, 0, 0);
            S[a][0] *= dec[a]; S[a][1] *= dec[a];
        }
        __syncthreads();
#pragma unroll
        for (int a = 0; a < NMT; ++a) {
            const int mt = wid * NMT + a;
#pragma unroll
            for (int n = 0; n < 2; ++n) { u32x2 w; w.x = pk2(S[a][n][0], S[a][n][1]); w.y = pk2(S[a][n][2], S[a][n][3]); *(u32x2*)(smem + O_ST + (n * 16 + fr) * SS + (mt * 16 + fq * 4) * 2) = w; }
        }
    }
    __syncthreads();
}
DI void phase_scan_items(KP p, int l, unsigned char* smem) {
    for (int it = BIDX(); it < 512; it += gridDim.x) {
        const int item = (it & 7) * 32 + ((it >> 4) & 31);
        if (!((it >> 3) & 1)) scan_item<128>(p, l, item, smem); else scan_item<64>(p, l, item, smem);
    }
}

DI void phase_merge(KP p, int l) {
    const int tid = TIDX(), wave = tid >> 6, lane = tid & 63;
    const int li = l >> 1;
    const bf16_t* OF = (const bf16_t*)(p->ws + WS_OF); const bf16_t* OB = (const bf16_t*)(p->ws + WS_OB);
    const bf16_t* Z = (const bf16_t*)(p->ws + WS_Z); bf16_t* Y = (bf16_t*)(p->ws + WS_Y);
    const bool isA = lane < 32;
    const float* gnp = isA ? p->in[15] + li * 512 + lane * 16 : p->in[16] + li * 512 + (lane - 32) * 16;
    const int gcol = isA ? 1536 + lane * 16 : 3072 + (lane - 32) * 16;
    float gn[16];
#pragma unroll
    for (int e = 0; e < 16; e += 4) { const f32x4 t = *(const f32x4*)(gnp + e); gn[e] = t[0]; gn[e + 1] = t[1]; gn[e + 2] = t[2]; gn[e + 3] = t[3]; }
    const int rstride = gridDim.x * 4;
    u32x4 ra[2], rb[2], rg[2];
#define MERGE_FETCH(ROW) { _Pragma("unroll") for (int j = 0; j < 2; ++j) { ra[j] = *(const u32x4*)(OF + (size_t)(ROW) * 1024 + lane * 16 + j * 8); rb[j] = *(const u32x4*)(OB + (size_t)(ROW) * 1024 + lane * 16 + j * 8); \
        rg[j] = *(const u32x4*)(Z + (size_t)(ROW) * ZS + gcol + j * 8); } }
    int row = BIDX() * 4 + wave;
    if (row < MT) MERGE_FETCH(row)
#pragma unroll 1
    for (; row < MT; row += rstride) {
        float o[16], gt[16]; float s = 0.f;
#pragma unroll
        for (int j = 0; j < 2; ++j) {
            const u32x4 a = ra[j], bb = rb[j], g = rg[j];
            o[j * 8 + 0] = bflo(a.x) + bflo(bb.x); o[j * 8 + 1] = bfhi(a.x) + bfhi(bb.x); o[j * 8 + 2] = bflo(a.y) + bflo(bb.y); o[j * 8 + 3] = bfhi(a.y) + bfhi(bb.y);
            o[j * 8 + 4] = bflo(a.z) + bflo(bb.z); o[j * 8 + 5] = bfhi(a.z) + bfhi(bb.z); o[j * 8 + 6] = bflo(a.w) + bflo(bb.w); o[j * 8 + 7] = bfhi(a.w) + bfhi(bb.w);
            gt[j * 8 + 0] = bflo(g.x); gt[j * 8 + 1] = bfhi(g.x); gt[j * 8 + 2] = bflo(g.y); gt[j * 8 + 3] = bfhi(g.y); gt[j * 8 + 4] = bflo(g.z); gt[j * 8 + 5] = bfhi(g.z); gt[j * 8 + 6] = bflo(g.w); gt[j * 8 + 7] = bfhi(g.w);
        }
        __builtin_amdgcn_sched_barrier(0);
        { const int nrow = row + rstride < MT ? row + rstride : row; MERGE_FETCH(nrow) }
        __builtin_amdgcn_sched_barrier(0);
#pragma unroll
        for (int e = 0; e < 16; ++e) s += o[e];
        s = sum8(s);
        const float mean = isA ? s * (1.0f / 128.0f) : 0.f;
        float s2 = 0.f;
#pragma unroll
        for (int e = 0; e < 16; ++e) { o[e] -= mean; s2 += o[e] * o[e]; }
        s2 = sum8(s2);
        const float rs = 1.0f / sqrtf(s2 * (1.0f / 128.0f) + LN_EPS);
        float y[16];
#pragma unroll
        for (int e = 0; e < 16; ++e) y[e] = siluf(gt[e]) * (o[e] * rs * gn[e]);
        u32x4 w0, w1;
        w0.x = pk2(y[0], y[1]); w0.y = pk2(y[2], y[3]); w0.z = pk2(y[4], y[5]); w0.w = pk2(y[6], y[7]);
        w1.x = pk2(y[8], y[9]); w1.y = pk2(y[10], y[11]); w1.z = pk2(y[12], y[13]); w1.w = pk2(y[14], y[15]);
        *(u32x4*)(Y + (size_t)row * 1024 + lane * 16) = w0; *(u32x4*)(Y + (size_t)row * 1024 + lane * 16 + 8) = w1;
    }
#undef MERGE_FETCH
}

DI int crow(int r, int hi) { return (r & 3) + 8 * (r >> 2) + 4 * hi; }
constexpr int ATT_BUF = 24576;
DI void att_component(const bf16x8 (&qf)[4], const bf16_t* Kc, const bf16_t* Vt, unsigned char* smem, float* wsf, int b, int h, int comp, int p0, int nkv, f32x16 (&O)[4]) {
    const int tid = TIDX(), wid = tid >> 6, lane = tid & 63, r32 = lane & 31, hi = lane >> 5;
    const int hc = h * 2 + comp;
    const int gch = gemm_chunk(tid);
    const bf16_t* Kg = Kc + (size_t)(b * 16 + hc) * TA * 64 + (size_t)(tid >> 3) * 64 + gch * 8;
    const bf16_t* Vg = Vt + (size_t)(b * 8 + h) * 128 * TA + (size_t)(tid >> 3) * TA + gch * 8;
#define ATT_STAGE(buf, kt) do { \
        _Pragma("unroll") for (int i_ = 0; i_ < 2; ++i_) __builtin_amdgcn_global_load_lds((const unsigned*)(Kg + (size_t)((kt) + 32 * i_) * 64), (LAS unsigned*)(smem + (buf) * ATT_BUF + i_ * 4096 + tid * 16), 16, 0, 0); \
        _Pragma("unroll") for (int i_ = 0; i_ < 4; ++i_) __builtin_amdgcn_global_load_lds((const unsigned*)(Vg + (size_t)(32 * i_) * TA + (kt)), (LAS unsigned*)(smem + (buf) * ATT_BUF + 8192 + i_ * 4096 + tid * 16), 16, 0, 0); } while (0)
    ATT_STAGE(0, 0);
#pragma unroll
    for (int d0 = 0; d0 < 4; ++d0)
#pragma unroll
        for (int r = 0; r < 16; ++r) O[d0][r] = 0.f;
    float m_run = -1.0e30f, l_run = 0.f;
    const int sw = (r32 >> 1) & 7;
    const int nt = nkv >> 6;
    for (int t = 0; t < nt; ++t) {
        asm volatile("s_waitcnt vmcnt(0)" ::: "memory");
        __syncthreads();
        if (t + 1 < nt) ATT_STAGE((t + 1) & 1, (t + 1) * 64);
        const unsigned char* Kt = smem + (t & 1) * ATT_BUF; const unsigned char* Vtl = Kt + 8192;
        bf16x8 kf0[4], kf1[4];
#pragma unroll
        for (int ks = 0; ks < 4; ++ks) {
            const unsigned co = (unsigned)(((ks * 2 + hi) ^ sw) << 4);
            kf0[ks] = *(const bf16x8*)(Kt + r32 * 128 + co);
            kf1[ks] = *(const bf16x8*)(Kt + (32 + r32) * 128 + co);
        }
        const unsigned char* vr = Vtl + r32 * 128;
#define ATT_VLOAD(dst, st_) do { const unsigned o1_ = (unsigned)((((st_) * 2 + hi) ^ sw) << 4); \
        _Pragma("unroll") for (int d0_ = 0; d0_ < 4; ++d0_) dst[d0_] = *(const bf16x8*)(vr + d0_ * 4096 + o1_); } while (0)
        bf16x8 va[4], vb[4];
        ATT_VLOAD(va, 0);
        f32x16 s0, s1;
#pragma unroll
        for (int r = 0; r < 16; ++r) { s0[r] = 0.f; s1[r] = 0.f; }
#pragma unroll
        for (int ks = 0; ks < 4; ++ks) {
            s0 = __builtin_amdgcn_mfma_f32_32x32x16_bf16(kf0[ks], qf[ks], s0, 0, 0, 0);
            s1 = __builtin_amdgcn_mfma_f32_32x32x16_bf16(kf1[ks], qf[ks], s1, 0, 0, 0);
        }
        float mxa[8];
#pragma unroll
        for (int i_ = 0; i_ < 8; ++i_) mxa[i_] = fmaxf(fmaxf(s0[2 * i_], s0[2 * i_ + 1]), fmaxf(s1[2 * i_], s1[2 * i_ + 1]));
        float mx = fmaxf(fmaxf(fmaxf(mxa[0], mxa[1]), fmaxf(mxa[2], mxa[3])), fmaxf(fmaxf(mxa[4], mxa[5]), fmaxf(mxa[6], mxa[7])));
        { const auto rr = __builtin_amdgcn_permlane32_swap(__float_as_uint(mx), __float_as_uint(mx), false, false); mx = fmaxf(__uint_as_float(rr[0]), __uint_as_float(rr[1])); }
        if (__any(mx > m_run + 8.0f)) {
            const float m_new = fmaxf(m_run, mx);
            const float alpha = __builtin_amdgcn_exp2f((m_run - m_new) * L2E);
            l_run *= alpha; m_run = m_new;
            if (hi == 0) wsf[r32] = alpha;
            asm volatile("s_waitcnt lgkmcnt(0)" ::: "memory");
            float ar[16];
#pragma unroll
            for (int r = 0; r < 16; ++r) ar[r] = wsf[crow(r, hi)];
#pragma unroll
            for (int d0 = 0; d0 < 4; ++d0)
#pragma unroll
                for (int r = 0; r < 16; ++r) O[d0][r] *= ar[r];
            asm volatile("s_waitcnt lgkmcnt(0)" ::: "memory");
        }
        const float mb = m_run * L2E;
        float ps = 0.f;
        s0 = s0 * L2E - mb; s1 = s1 * L2E - mb;
#pragma unroll
        for (int r = 0; r < 16; ++r) { s0[r] = __builtin_amdgcn_exp2f(s0[r]); s1[r] = __builtin_amdgcn_exp2f(s1[r]); }
        { const f32x16 t_ = s0 + s1;
          ps = (((t_[0] + t_[1]) + (t_[2] + t_[3])) + ((t_[4] + t_[5]) + (t_[6] + t_[7]))) + (((t_[8] + t_[9]) + (t_[10] + t_[11])) + ((t_[12] + t_[13]) + (t_[14] + t_[15]))); }
        l_run += ps;
        u32x4 pw[4];
#pragma unroll
        for (int s = 0; s < 2; ++s) {
            pw[s].x = pk2(s0[8 * s + 0], s0[8 * s + 1]); pw[s].y = pk2(s0[8 * s + 2], s0[8 * s + 3]); pw[s].z = pk2(s0[8 * s + 4], s0[8 * s + 5]); pw[s].w = pk2(s0[8 * s + 6], s0[8 * s + 7]);
            pw[2 + s].x = pk2(s1[8 * s + 0], s1[8 * s + 1]); pw[2 + s].y = pk2(s1[8 * s + 2], s1[8 * s + 3]); pw[2 + s].z = pk2(s1[8 * s + 4], s1[8 * s + 5]); pw[2 + s].w = pk2(s1[8 * s + 6], s1[8 * s + 7]);
        }
#pragma unroll
        ATT_VLOAD(vb, 1);
#pragma unroll
        for (int d0 = 0; d0 < 4; ++d0) O[d0] = __builtin_amdgcn_mfma_f32_32x32x16_bf16(__builtin_bit_cast(bf16x8, pw[0]), va[d0], O[d0], 0, 0, 0);
        ATT_VLOAD(va, 2);
#pragma unroll
        for (int d0 = 0; d0 < 4; ++d0) O[d0] = __builtin_amdgcn_mfma_f32_32x32x16_bf16(__builtin_bit_cast(bf16x8, pw[1]), vb[d0], O[d0], 0, 0, 0);
        ATT_VLOAD(vb, 3);
#pragma unroll
        for (int d0 = 0; d0 < 4; ++d0) O[d0] = __builtin_amdgcn_mfma_f32_32x32x16_bf16(__builtin_bit_cast(bf16x8, pw[2]), va[d0], O[d0], 0, 0, 0);
#pragma unroll
        for (int d0 = 0; d0 < 4; ++d0) O[d0] = __builtin_amdgcn_mfma_f32_32x32x16_bf16(__builtin_bit_cast(bf16x8, pw[3]), vb[d0], O[d0], 0, 0, 0);
#undef ATT_VLOAD
    }
#undef ATT_STAGE
    l_run += __shfl_xor(l_run, 32);
    asm volatile("s_waitcnt lgkmcnt(0)" ::: "memory");
    if (hi == 0) wsf[r32] = 1.0f / l_run;
    asm volatile("s_waitcnt lgkmcnt(0)" ::: "memory");
    float ar[16];
#pragma unroll
    for (int r = 0; r < 16; ++r) ar[r] = wsf[crow(r, hi)];
    asm volatile("s_waitcnt lgkmcnt(0)" ::: "memory");
#pragma unroll
    for (int d0 = 0; d0 < 4; ++d0)
#pragma unroll
        for (int r = 0; r < 16; ++r) O[d0][r] *= ar[r];
}

DI void phase_att(KP p, int l, unsigned char* smem) {
    constexpr int O_WS = 2 * ATT_BUF;
    const int tid = TIDX(), wid = tid >> 6, lane = tid & 63, r32 = lane & 31, hi = lane >> 5;
    const int li = l >> 1;
    const bf16_t* Qc = (const bf16_t*)(p->ws + WS_QC); const bf16_t* Kc = (const bf16_t*)(p->ws + WS_KC); const bf16_t* Vt = (const bf16_t*)(p->ws + WS_VT);
    bf16_t* Y = (bf16_t*)(p->ws + WS_Y);
    float* stash = (float*)(p->ws + WS_P) + ((size_t)BIDX() * 256 + tid) * 32;
    const float lam_init = 0.8f - 0.6f * expf(-0.3f * (float)l);
    float* wsf = (float*)(smem + O_WS) + wid * 32;
    float* lamS = (float*)(smem + O_WS) + 4 * 32;
    __syncthreads();
#pragma unroll
    for (int hh = 0; hh < 2; ++hh) {
        const int h_ = wid * 2 + hh;
        const float* lq1 = p->in[19] + (li * 8 + h_) * 64, *lk1 = p->in[20] + (li * 8 + h_) * 64, *lq2 = p->in[21] + (li * 8 + h_) * 64, *lk2 = p->in[22] + (li * 8 + h_) * 64;
        const float d1 = wave_sum(lq1[lane] * lk1[lane]), d2 = wave_sum(lq2[lane] * lk2[lane]);
        if (lane == 0) lamS[h_] = expf(d1) - expf(d2) + lam_init;
    }
    __syncthreads();
    const int per_x = (l == 3) ? 128 : 144;
    for (int i = 0;; ++i) {
        int b, h, p0, nkv;
        {
            const int G = gridDim.x, bid = BIDX();
            int item;
            if ((G & 7) == 0) { const int x = bid & 7, q = i * (G >> 3) + (bid >> 3); if (q >= per_x) break; item = q < 128 ? x * 128 + q : 1024 + x * 16 + (q - 128); }
            else { item = i * G + bid; if (item >= 8 * per_x) break; }
            if (item < 1024) { b = item >> 7; h = (item >> 4) & 7; p0 = 256 + (item & 15) * 128; nkv = TA; }
            else { const int q = item - 1024; b = q >> 4; h = (q >> 1) & 7; p0 = (q & 1) * 128; nkv = TC; }
        }
        const float lamv = lamS[h];
        bf16x8 qf0[4], qf1[4];
        {
            const bf16_t* Qb0 = Qc + ((size_t)(b * 16 + h * 2) * TA + p0 + wid * 32 + r32) * 64; const bf16_t* Qb1 = Qb0 + (size_t)TA * 64;
#pragma unroll
            for (int ks = 0; ks < 4; ++ks) { qf0[ks] = *(const bf16x8*)(Qb0 + ks * 16 + hi * 8); qf1[ks] = *(const bf16x8*)(Qb1 + ks * 16 + hi * 8); }
        }
        f32x16 On[4];
        __syncthreads();
        att_component(qf0, Kc, Vt, smem, wsf, b, h, 0, p0, nkv, On);
#pragma unroll
        for (int d0 = 0; d0 < 4; ++d0)
#pragma unroll
            for (int r = 0; r < 16; r += 8) {
                u32x4 w; w.x = pk2(On[d0][r], On[d0][r + 1]); w.y = pk2(On[d0][r + 2], On[d0][r + 3]); w.z = pk2(On[d0][r + 4], On[d0][r + 5]); w.w = pk2(On[d0][r + 6], On[d0][r + 7]);
                *(u32x4*)(stash + (d0 * 16 + r) / 2) = w;
            }
        __syncthreads();
        att_component(qf1, Kc, Vt, smem, wsf, b, h, 1, p0, nkv, On);
#pragma unroll
        for (int d0 = 0; d0 < 4; ++d0)
#pragma unroll
            for (int r = 0; r < 16; r += 8) {
                const u32x4 w = *(const u32x4*)(stash + (d0 * 16 + r) / 2);
                On[d0][r] = bflo(w.x) - lamv * On[d0][r]; On[d0][r + 1] = bfhi(w.x) - lamv * On[d0][r + 1]; On[d0][r + 2] = bflo(w.y) - lamv * On[d0][r + 2]; On[d0][r + 3] = bfhi(w.y) - lamv * On[d0][r + 3];
                On[d0][r + 4] = bflo(w.z) - lamv * On[d0][r + 4]; On[d0][r + 5] = bfhi(w.z) - lamv * On[d0][r + 5]; On[d0][r + 6] = bflo(w.w) - lamv * On[d0][r + 6]; On[d0][r + 7] = bfhi(w.w) - lamv * On[d0][r + 7];
            }
        float ms[16];
#pragma unroll
        for (int r = 0; r < 16; ++r) {
            float s = (On[0][r] * On[0][r] + On[1][r] * On[1][r]) + (On[2][r] * On[2][r] + On[3][r] * On[3][r]);
            s = sum32(s);
            ms[r] = __builtin_amdgcn_rsqf(s * (1.0f / 128.0f) + LN_EPS);
        }
        const float* sg = p->in[23] + li * 1024 + h * 128;
        const float post = 1.0f - lam_init;
        float gsc[4];
#pragma unroll
        for (int d0 = 0; d0 < 4; ++d0) gsc[d0] = sg[d0 * 32 + r32] * post;
        __syncthreads();
        unsigned char* stg = smem + wid * 8192;
#pragma unroll
        for (int r = 0; r < 16; ++r) {
            unsigned char* sp = stg + crow(r, hi) * 256 + r32 * 2;
#pragma unroll
            for (int d0 = 0; d0 < 4; ++d0) *(unsigned short*)(sp + d0 * 64) = (unsigned short)f2bf(On[d0][r] * ms[r] * gsc[d0]);
        }
        asm volatile("s_waitcnt lgkmcnt(0)" ::: "memory");
#pragma unroll
        for (int i2 = 0; i2 < 8; ++i2) {
            const int id = lane + 64 * i2, qr = id >> 4, ch = id & 15;
            const int pq = p0 + wid * 32 + qr;
            const int row = pq < 256 ? ML + b * 256 + pq : b * 2048 + (pq - 256);
            *(u32x4*)(Y + (size_t)row * 1024 + h * 128 + ch * 8) = *(const u32x4*)(stg + qr * 256 + ch * 16);
        }
        asm volatile("s_waitcnt lgkmcnt(0)" ::: "memory");
    }
}

#define XB_TMO      128
#define XB_XCNT(j)  (256  + 64 * (j))
#define XB_XSUB(j)  (1280 + 64 * (j))
#define XB_XGEN(j)  (2304 + 64 * (j))
#define XB_TOP      3328
#define XB_TOPGEN   3392
#define XCD_BAR_WORDS 3456
#define XB_SPIN_CAP (1u << 22)
DI unsigned xb_ld(unsigned* p)              { return __hip_atomic_load(p, __ATOMIC_RELAXED, __HIP_MEMORY_SCOPE_AGENT); }
DI unsigned xb_add(unsigned* p, unsigned v) { return __hip_atomic_fetch_add(p, v, __ATOMIC_RELAXED, __HIP_MEMORY_SCOPE_AGENT); }
DI unsigned xb_xcc_id() { return (unsigned)__builtin_amdgcn_s_getreg((3 << 11) | 20) & 0xFu; }
#define XB_SPIN(cond, bar) do { unsigned _sp = 0; while (cond) { __builtin_amdgcn_s_sleep(1); \
    if ((++_sp & 255u) == 0u) { if (xb_ld(&(bar)[XB_TMO])) break; if (_sp > XB_SPIN_CAP) { atomicAdd(&(bar)[XB_TMO], 1u); break; } } } } while (0)
struct XcdBarrier { unsigned* bar; unsigned x; volatile LAS unsigned* st; };
DI XcdBarrier xcd_barrier_post(unsigned* bar, volatile LAS unsigned* st) {
    XcdBarrier b; b.bar = bar; b.x = xb_xcc_id(); b.st = st;
    if (threadIdx.x == 0) (void)xb_add(&bar[XB_XCNT(b.x)], 1u);
    return b;
}
DI void xcd_barrier_complete(unsigned* bar, unsigned x, unsigned& nloc, unsigned& nx) {
    const unsigned G = gridDim.x * gridDim.y * gridDim.z;
    unsigned sum, cnt, mine, sp = 0u;
    for (;;) {
        sum = 0u; cnt = 0u; mine = 0u;
#pragma unroll
        for (unsigned j = 0; j < 16; ++j) { const unsigned c = xb_ld(&bar[XB_XCNT(j)]); sum += c; cnt += (c > 0u) ? 1u : 0u; mine = (j == x) ? c : mine; }
        if (sum == G) break;
        __builtin_amdgcn_s_sleep(1);
        if ((++sp & 255u) == 0u) { if (xb_ld(&bar[XB_TMO])) break; if (sp > XB_SPIN_CAP) { atomicAdd(&bar[XB_TMO], 1u); break; } }
    }
    nloc = mine > 0u ? mine : 1u; nx = cnt > 0u ? cnt : 1u;
}
DI void xcd_barrier(const XcdBarrier& b) {
    asm volatile("s_waitcnt vmcnt(0)" ::: "memory");
    __syncthreads();
    if (threadIdx.x == 0) {
        unsigned* bar = b.bar;
        __builtin_amdgcn_s_waitcnt(0);
        unsigned nloc = b.st[0], nx = b.st[1];
        if (nloc == 0u) { xcd_barrier_complete(bar, b.x, nloc, nx); b.st[0] = nloc; b.st[1] = nx; }
        const unsigned old = xb_add(&bar[XB_XSUB(b.x)], 1u);
        const unsigned gen = old / nloc;
        asm volatile("buffer_inv sc1" ::: "memory");
        if (old + 1u == (gen + 1u) * nloc) {
            __builtin_amdgcn_fence(__ATOMIC_RELEASE, "agent");
            asm volatile("s_waitcnt vmcnt(0)" ::: "memory");
            const unsigned og = xb_add(&bar[XB_TOP], 1u);
            const unsigned tg = og / nx;
            if (og + 1u == (tg + 1u) * nx) xb_add(&bar[XB_TOPGEN], 1u);
            else XB_SPIN(xb_ld(&bar[XB_TOPGEN]) == tg, bar);
            xb_add(&bar[XB_XGEN(b.x)], 1u);
            asm volatile("s_waitcnt vmcnt(0)" ::: "memory");
        } else {
            XB_SPIN(xb_ld(&bar[XB_XGEN(b.x)]) == gen, bar);
            asm volatile("s_waitcnt vmcnt(0)" ::: "memory");
        }
    }
    __syncthreads();
}

constexpr int DEC_CNT_WORD0 = 2048;
DI void phase_scan(KP p, int l, unsigned char* smem, const XcdBarrier& xbar) {
    const int bid = BIDX();
    if (gridDim.x == 512) {
        if ((bid >> 3) & 1) {
            const int b = bid & 7, r = bid >> 4;
            phase_decay(p, l, smem, b, r);
            unsigned* cnt = (unsigned*)(p->ws + WS_CTL) + DEC_CNT_WORD0 + ((l >> 1) * 8 + b) * 64;
            asm volatile("s_waitcnt vmcnt(0)" ::: "memory");
            __syncthreads();
            if (TIDX() == 0) {
                __builtin_amdgcn_fence(__ATOMIC_RELEASE, "agent");
                asm volatile("s_waitcnt vmcnt(0)" ::: "memory");
                (void)xb_add(cnt, r < 8 ? 3u : 2u);
                XB_SPIN(xb_ld(cnt) < 72u, xbar.bar);
                __builtin_amdgcn_fence(__ATOMIC_ACQUIRE, "agent");
                asm volatile("s_waitcnt vmcnt(0)" ::: "memory");
            }
            __syncthreads();
        }
    } else {
        phase_decay(p, l, smem, -1, 0);
        xcd_barrier(xbar);
    }
    phase_scan_items(p, l, smem);
}

#ifdef DOUBLE_MASK
#define DRYCOND (rep_ == 0 && nrep_ == 2)
#else
#define DRYCOND false
#endif
constexpr int NPHASE = 32;
constexpr int LDS_BYTES = 65536 + 1024;
__global__ void __launch_bounds__(256, 2) mega(Params pv) {
    extern __shared__ __attribute__((aligned(16))) unsigned char smem[];
    const int ph_lo = pv.ph_lo, ph_hi = pv.ph_hi;
    volatile LAS unsigned* bar_st = (volatile LAS unsigned*)(LAS unsigned char*)(smem + 65536);
    if (threadIdx.x == 0) { bar_st[0] = 0u; bar_st[1] = 0u; }
    __syncthreads();
    XcdBarrier xbar = xcd_barrier_post((unsigned*)(pv.ws + WS_CTL) + 4096, bar_st);
    for (int ph = ph_lo; ph < ph_hi; ++ph) {
        KP p = (KP)__builtin_amdgcn_kernarg_segment_ptr();
        asm volatile("" : "+s"(p) :: "memory");
#ifdef DOUBLE_MASK
        int kind_;
        if (ph == 0) kind_ = 0; else if (ph == 1) kind_ = 1;
        else { const int rem_ = (ph - 2) % 15; kind_ = rem_ < 8 ? rem_ + 2 : (rem_ == 8 ? 10 : (rem_ == 9 ? 11 : (rem_ - 10 + 5))); }
        const int nrep_ = ((DOUBLE_MASK >> kind_) & 1) ? 2 : 1;
        for (int rep_ = 0; rep_ < nrep_; ++rep_) {
        if (rep_) xcd_barrier(xbar);
#endif
        if (ph == 0) phase_pre0(p, smem);
        else if (ph == 1) phase_pre1(p);
        else {
            const int q = ph - 2, lp = q / 15, rem = q % 15;
            if (rem < 8) {
                const int l = 2 * lp;
                switch (rem) {
                    case 0: phase_g1e(p, l, smem); break;
                    case 1: phase_scan(p, l, smem, xbar); break;
                    case 2: phase_merge(p, l); break;
                    case 3: phase_g2(p, l, smem); break;
                    case 4: if (DRYCOND) phase_ln1r<true, false>(p, l, smem); else phase_ln1r<false, false>(p, l, smem); break;
                    case 5: phase_mg1(p, l, smem); break;
                    case 6: phase_mg2(p, l, smem); break;
                    default: if (DRYCOND) phase_ln2<true>(p, l); else phase_ln2<false>(p, l); break;
                }
            } else {
                const int l = 2 * lp + 1;
                switch (rem - 8) {
                    case 0: phase_g1o(p, l, smem); break;
                    case 1: phase_att(p, l, smem); break;
                    case 2: phase_g2(p, l, smem); break;
                    case 3: if (DRYCOND) phase_ln1r<true, false>(p, l, smem); else phase_ln1r<false, false>(p, l, smem); break;
                    case 4: phase_mg1(p, l, smem); break;
                    case 5: phase_mg2(p, l, smem); break;
                    default: if (DRYCOND) phase_ln2<true>(p, l); else phase_ln2<false>(p, l); break;
                }
            }
        }
#ifdef DOUBLE_MASK
        }
#endif
        if (ph + 1 < ph_hi) xcd_barrier(xbar);
    }
}

extern "C" void kernel_launch(void* const* d_in, const int* in_sizes, int n_in, void* d_out, int out_size, void* d_ws, size_t ws_size, hipStream_t stream) {
    static int grid_blocks = 0;
    if (grid_blocks == 0) {
        if (n_in != 32 || ws_size < WS_END) { fprintf(stderr, "kernel_launch: unexpected n_in %d or ws_size %zu\n", n_in, ws_size); grid_blocks = -1; return; }
        int dev = 0, cus = 0, per_cu = 0;
        hipGetDevice(&dev);
        hipDeviceGetAttribute(&cus, hipDeviceAttributeMultiprocessorCount, dev);
        hipFuncSetAttribute((const void*)mega, hipFuncAttributeMaxDynamicSharedMemorySize, LDS_BYTES);
        hipOccupancyMaxActiveBlocksPerMultiprocessor(&per_cu, mega, 256, LDS_BYTES);
        if (per_cu > 2) per_cu = 2;
        if (per_cu < 1) per_cu = 1;
        grid_blocks = cus * per_cu;
    }
    if (grid_blocks < 0) return;
    hipMemsetAsync((char*)d_ws + WS_CTL, 0, 32768, stream);
    Params p{};
    for (int i = 0; i < 32; ++i) p.in[i] = (const float*)d_in[i];
    p.out = (float*)d_out; p.ws = (unsigned char*)d_ws;
#if N_LAUNCH_MODE == 1
    p.ph_lo = 0; p.ph_hi = NPHASE;
    void* args[] = {&p};
    hipError_t e = hipLaunchCooperativeKernel((void*)mega, dim3(grid_blocks), dim3(256), args, LDS_BYTES, stream);
    if (e != hipSuccess) fprintf(stderr, "cooperative launch failed: %s (grid %d)\n", hipGetErrorString(e), grid_blocks);
#else
    for (int ph = 0; ph < NPHASE; ++ph) {
        p.ph_lo = ph; p.ph_hi = ph + 1;
        hipLaunchKernelGGL(mega, dim3(grid_blocks), dim3(256), LDS_BYTES, stream, p);
    }
#endif
}
```
